# Optimizing an MI355X kernel written in HIP

```python
import math
import jax, jax.numpy as jnp
from jax import lax
import numpy as np

D_MODEL = 2048
BATCH = 2
SEQ = 4096
DEPTH = 4

CHUNK = 64
EPS = 1e-6

SSM_EXPAND = 2
D_INNER = SSM_EXPAND * D_MODEL
SSM_HEAD_DIM = 64
SSM_HEADS = D_INNER // SSM_HEAD_DIM
SSM_GROUPS = 8
SSM_HPG = SSM_HEADS // SSM_GROUPS
SSM_STATE = 128
SSM_CONV = 4
CONV_DIM = D_INNER + 2 * SSM_GROUPS * SSM_STATE

ATTN_HEAD_DIM = 128
ATTN_Q_HEADS = 16
ATTN_KV_HEADS = 4
ATTN_QPK = ATTN_Q_HEADS // ATTN_KV_HEADS
ATTN_SCALE = ATTN_HEAD_DIM ** -0.5
IDX_HEADS = 16
IDX_HEAD_DIM = 64
IDX_SCALE = (IDX_HEAD_DIM ** -0.5) * (IDX_HEADS ** -0.5)
TOPK_MAX = 256
Q_BLOCK = 128

N_BRANCHES = 2

D_FF = 2 * D_MODEL
FFN_CONV = 3

IN_SPLITS = (D_INNER, CONV_DIM, SSM_HEADS,
             ATTN_Q_HEADS * ATTN_HEAD_DIM, ATTN_KV_HEADS * ATTN_HEAD_DIM, ATTN_KV_HEADS * ATTN_HEAD_DIM,
             IDX_HEADS * IDX_HEAD_DIM, IDX_HEAD_DIM, IDX_HEADS,
             N_BRANCHES * D_MODEL)
D_IN_PROJ = sum(IN_SPLITS)

kernel_name = "hybrid_ssd_dsa_gated_sandwich"


def rmsnorm(x, g):
    x32 = x.astype(jnp.float32)
    y = x32 * lax.rsqrt(jnp.mean(x32 * x32, axis=-1, keepdims=True) + EPS)
    return (y * g.astype(jnp.float32)).astype(x.dtype)


def causal_dwconv(x, w, b):
    k = w.shape[0]
    length = x.shape[1]
    xp = jnp.pad(x, ((0, 0), (k - 1, 0), (0, 0)))
    y = b
    for i in range(k):
        y = y + xp[:, i:i + length] * w[i]
    return y


def split_in_proj(proj):
    offsets = [int(o) for o in np.cumsum(IN_SPLITS)[:-1]]
    return jnp.split(proj, offsets, axis=-1)


def ssd_chunked(x, dt, a, bm, cm):
    b, s = x.shape[:2]
    c = s // CHUNK
    x = x.reshape(b, c, CHUNK, SSM_GROUPS, SSM_HPG, SSM_HEAD_DIM)
    dt = dt.reshape(b, c, CHUNK, SSM_GROUPS, SSM_HPG)
    bm = bm.reshape(b, c, CHUNK, SSM_GROUPS, SSM_STATE)
    cm = cm.reshape(b, c, CHUNK, SSM_GROUPS, SSM_STATE)
    a_dt = dt * a
    xdt = x * dt[..., None]
    a_cs = jnp.cumsum(a_dt, axis=2)
    cs = jnp.moveaxis(a_cs, 2, -1)
    tri = jnp.tril(jnp.ones((CHUNK, CHUNK), dtype=bool))
    decay = jnp.exp(jnp.where(tri, cs[..., :, None] - cs[..., None, :], -jnp.inf))
    cb = jnp.einsum('bclgn,bcsgn->bcgls', cm, bm)
    y_diag = jnp.einsum('bcgls,bcgrls,bcsgrp->bclgrp', cb, decay, xdt)
    decay_to_end = jnp.exp(a_cs[:, :, -1:] - a_cs)
    states = jnp.einsum('bcsgn,bcsgr,bcsgrp->bcgrpn', bm, decay_to_end, xdt)
    chunk_decay = jnp.exp(a_cs[:, :, -1])

    def step(h, inp):
        st, dec = inp
        return h * dec[..., None, None] + st, h

    h0 = jnp.zeros((b, SSM_GROUPS, SSM_HPG, SSM_HEAD_DIM, SSM_STATE), dtype=states.dtype)
    _, h_in = lax.scan(step, h0, (jnp.moveaxis(states, 1, 0), jnp.moveaxis(chunk_decay, 1, 0)))
    h_in = jnp.moveaxis(h_in, 0, 1)
    y_off = jnp.einsum('bclgn,bcgrpn,bclgr->bclgrp', cm, h_in, jnp.exp(a_cs))
    return (y_diag + y_off).reshape(b, s, SSM_GROUPS, SSM_HPG, SSM_HEAD_DIM)


def ssd_mixer(z, xbc, dt_raw, conv_w, conv_b, dt_bias, a_log, d_skip, norm_g):
    b, s, _ = z.shape
    f32 = jnp.float32
    xbc = jax.nn.silu(causal_dwconv(xbc, conv_w, conv_b))
    xs, bm, cm = jnp.split(xbc, [D_INNER, D_INNER + SSM_GROUPS * SSM_STATE], axis=-1)
    xs = xs.reshape(b, s, SSM_GROUPS, SSM_HPG, SSM_HEAD_DIM).astype(f32)
    bm = bm.reshape(b, s, SSM_GROUPS, SSM_STATE).astype(f32)
    cm = cm.reshape(b, s, SSM_GROUPS, SSM_STATE).astype(f32)
    dt = jax.nn.softplus(dt_raw.astype(f32) + dt_bias.astype(f32)).reshape(b, s, SSM_GROUPS, SSM_HPG)
    a = -jnp.exp(a_log.astype(f32)).reshape(SSM_GROUPS, SSM_HPG)
    y = ssd_chunked(xs, dt, a, bm, cm)
    y = y + d_skip.astype(f32).reshape(SSM_GROUPS, SSM_HPG)[:, :, None] * xs
    y = y.reshape(b, s, D_INNER) * jax.nn.silu(z.astype(f32))
    yg = y.reshape(b, s, SSM_GROUPS, D_INNER // SSM_GROUPS)
    yg = yg * lax.rsqrt(jnp.mean(yg * yg, axis=-1, keepdims=True) + EPS)
    y = yg.reshape(b, s, D_INNER) * norm_g.astype(f32)
    return y.astype(z.dtype)


def dsa_mixer(q, k, v, q_idx, k_idx, w_idx):
    b, s, _ = q.shape
    f32 = jnp.float32
    top_k = min(TOPK_MAX, s // 4)
    nb = s // Q_BLOCK
    q = q.reshape(b, nb, Q_BLOCK, ATTN_KV_HEADS, ATTN_QPK, ATTN_HEAD_DIM)
    k = k.reshape(b, s, ATTN_KV_HEADS, ATTN_HEAD_DIM)
    v = v.reshape(b, s, ATTN_KV_HEADS, ATTN_HEAD_DIM)
    q_idx = q_idx.reshape(b, nb, Q_BLOCK, IDX_HEADS, IDX_HEAD_DIM)
    w_idx = w_idx.reshape(b, nb, Q_BLOCK, IDX_HEADS)
    k_idx32 = k_idx.astype(f32)
    key_pos = jnp.arange(s)

    def block(args):
        blk, qb, qib, wib = args
        qpos = blk * Q_BLOCK + jnp.arange(Q_BLOCK)
        limit = (qpos // CHUNK + 1) * CHUNK
        admissible = key_pos[None, :] < limit[:, None]
        rel = jax.nn.relu(jnp.einsum('bqhd,bkd->bqhk', qib.astype(f32), k_idx32))
        score = jnp.einsum('bqhk,bqh->bqk', rel, wib.astype(f32)) * IDX_SCALE
        score = jnp.where(admissible[None], score, -jnp.inf)
        top_val, top_idx = lax.top_k(score, top_k)
        valid = jnp.isfinite(top_val)
        kg = jax.vmap(lambda kb, ib: kb[ib])(k, top_idx)
        vg = jax.vmap(lambda vb, ib: vb[ib])(v, top_idx)
        logits = jnp.einsum('bqhgd,bqkhd->bqhgk', qb, kg).astype(f32) * ATTN_SCALE
        logits = jnp.where(valid[:, :, None, None, :], logits, -jnp.inf)
        p = jax.nn.softmax(logits, axis=-1).astype(vg.dtype)
        out = jnp.einsum('bqhgk,bqkhd->bqhgd', p, vg)
        return out.reshape(b, Q_BLOCK, ATTN_Q_HEADS * ATTN_HEAD_DIM)

    xs = (jnp.arange(nb), jnp.moveaxis(q, 1, 0), jnp.moveaxis(q_idx, 1, 0), jnp.moveaxis(w_idx, 1, 0))
    out = lax.map(block, xs)
    return jnp.moveaxis(out, 0, 1).reshape(b, s, ATTN_Q_HEADS * ATTN_HEAD_DIM)


def conv_ffn(h, w_up, conv_w, conv_b, w_down):
    u = causal_dwconv(h @ w_up, conv_w, conv_b)
    g, val = jnp.split(u, 2, axis=-1)
    return (jax.nn.gelu(g, approximate=True) * val) @ w_down


def setup_inputs(seed: int = 0) -> dict:
    key = jax.random.key(seed)
    ks = jax.random.split(key, 24)
    f32 = jnp.float32
    nrm = lambda k, shape, fan_in: jax.random.normal(k, shape, f32) * (fan_in ** -0.5)
    gain = lambda k: 1.0 + 0.02 * jax.random.normal(k, (DEPTH, D_MODEL), f32)
    dt0 = jnp.exp(jax.random.uniform(ks[9], (DEPTH, SSM_HEADS), f32) * (math.log(0.1) - math.log(0.001)) + math.log(0.001))
    dt_bias = dt0 + jnp.log(-jnp.expm1(-dt0))
    a_log = jnp.log(jax.random.uniform(ks[10], (DEPTH, SSM_HEADS), f32, 1.0, 16.0))
    return {
        "x": jax.random.normal(ks[0], (BATCH, SEQ, D_MODEL), f32),
        "norm_mix_pre": gain(ks[1]),
        "norm_mix_post": gain(ks[2]),
        "norm_ffn_pre": gain(ks[3]),
        "norm_ffn_post": gain(ks[4]),
        "w_in": nrm(ks[5], (DEPTH, D_MODEL, D_IN_PROJ), D_MODEL),
        "b_gate": 0.01 * jax.random.normal(ks[6], (DEPTH, N_BRANCHES * D_MODEL), f32),
        "conv_xbc_w": nrm(ks[7], (DEPTH, SSM_CONV, CONV_DIM), SSM_CONV),
        "conv_xbc_b": 0.01 * jax.random.normal(ks[8], (DEPTH, CONV_DIM), f32),
        "dt_bias": dt_bias,
        "a_log": a_log,
        "d_skip": 1.0 + 0.02 * jax.random.normal(ks[11], (DEPTH, SSM_HEADS), f32),
        "ssm_norm": 1.0 + 0.02 * jax.random.normal(ks[12], (DEPTH, D_INNER), f32),
        "w_ssm_out": nrm(ks[13], (DEPTH, D_INNER, D_MODEL), D_INNER),
        "w_attn_out": nrm(ks[14], (DEPTH, ATTN_Q_HEADS * ATTN_HEAD_DIM, D_MODEL), ATTN_Q_HEADS * ATTN_HEAD_DIM),
        "w_mix_out": nrm(ks[15], (DEPTH, D_MODEL, D_MODEL), D_MODEL),
        "w_up": nrm(ks[16], (DEPTH, D_MODEL, 2 * D_FF), D_MODEL),
        "conv_ffn_w": nrm(ks[17], (DEPTH, FFN_CONV, 2 * D_FF), FFN_CONV),
        "conv_ffn_b": 0.01 * jax.random.normal(ks[18], (DEPTH, 2 * D_FF), f32),
        "w_down": nrm(ks[19], (DEPTH, D_FF, D_MODEL), D_FF),
    }


def reference(x, norm_mix_pre, norm_mix_post, norm_ffn_pre, norm_ffn_post, w_in, b_gate,
              conv_xbc_w, conv_xbc_b, dt_bias, a_log, d_skip, ssm_norm, w_ssm_out, w_attn_out,
              w_mix_out, w_up, conv_ffn_w, conv_ffn_b, w_down):
    for l in range(DEPTH):
        h = rmsnorm(x, norm_mix_pre[l])
        proj = h @ w_in[l]
        z, xbc, dt_raw, q, k, v, q_idx, k_idx, w_idx, gate_logits = split_in_proj(proj)
        y_ssm = ssd_mixer(z, xbc, dt_raw, conv_xbc_w[l], conv_xbc_b[l], dt_bias[l], a_log[l],
                          d_skip[l], ssm_norm[l]) @ w_ssm_out[l]
        y_attn = dsa_mixer(q, k, v, q_idx, k_idx, w_idx) @ w_attn_out[l]
        g_ssm, g_attn = jnp.split(jax.nn.sigmoid(gate_logits + b_gate[l]), N_BRANCHES, axis=-1)
        merged = g_ssm * y_ssm + g_attn * y_attn
        x = x + rmsnorm(merged @ w_mix_out[l], norm_mix_post[l])
        h = rmsnorm(x, norm_ffn_pre[l])
        x = x + rmsnorm(conv_ffn(h, w_up[l], conv_ffn_w[l], conv_ffn_b[l], w_down[l]), norm_ffn_post[l])
    return x
```

```cpp
#include <hip/hip_runtime.h>
#include <cstdio>
#include <cstdint>
#define MK_PER_PHASE 1
namespace pg8 {
#define PG8_LAS __attribute__((address_space(3)))
typedef unsigned short bf16_t;
typedef short bf16x8 __attribute__((ext_vector_type(8)));
typedef float f32x4 __attribute__((ext_vector_type(4)));
typedef unsigned u32x4 __attribute__((ext_vector_type(4)));
constexpr int BM = 256, BK = 64, HALF = 128, HTB = HALF * BK * 2  , STAGE_BYTES = 8 * HTB, NXCD = 8, WGM = 8;

__host__ __device__ __forceinline__ int lds_byte(int r, int c) { const int st = (r >> 4) * 2 + (c >> 5), rr = r & 15, cc = c & 31, ob = rr * 64 + cc * 2; return st * 1024 + (ob ^ (((ob >> 9) & 1) << 5)); }
__host__ __device__ __forceinline__ void stage_rc(int b, int& R, int& C) { const int st = b / 1024, sb = b % 1024, swz = sb ^ (((sb >> 9) & 1) << 5); R = (st >> 1) * 16 + swz / 64; C = (st & 1) * 32 + (swz % 64) / 2; }
__host__ __device__ __forceinline__ int perm32(int rho) { const int n = rho >> 4, i = rho & 15; return 8 * (i >> 2) + 4 * n + (i & 3); }

struct Unit { int pm, pn; };
struct Gemm { const bf16_t* A; const bf16_t* Bt; int M, N, K; };

struct StaticOrder {
    int nM, nN, nwg, G, c;
    __host__ __device__ void init(int M, int N, int G_, int c_) { nM = M / BM; nN = N / BM; nwg = nM * nN; G = G_; c = c_; }
    __host__ __device__ bool next(int i, Unit& u) const {
        const long L = (long)i * G + c; if (L >= nwg) return false;
        int wgid = (int)L; { const int q = nwg / NXCD, r = nwg % NXCD, xcd = wgid % NXCD, off = wgid / NXCD; wgid = (xcd < r ? xcd * (q + 1) : r * (q + 1) + (xcd - r) * q) + off; }
        const int nig = WGM * nN, gid = wgid / nig, fm = gid * WGM, gsz = (nM - fm) < WGM ? (nM - fm) : WGM;
        u.pm = fm + ((wgid % nig) % gsz); u.pn = (wgid % nig) / gsz; return true;
    }
    __device__ __forceinline__ void a_ready(const Unit&) const {}
    __device__ __forceinline__ void done(const Unit&) const {}
};

__device__ __forceinline__ unsigned cvt_pk_bf16(float lo, float hi) { unsigned r; asm volatile("v_cvt_pk_bf16_f32 %0, %1, %2" : "=v"(r) : "v"(lo), "v"(hi)); return r; }
typedef float f32x2 __attribute__((ext_vector_type(2)));
__device__ __forceinline__ f32x2 gelu_pk(f32x2 v) {
    const f32x2 av = __builtin_elementwise_abs(v), d = av * 0.2316418882f + 1.0f;
    f32x2 t; t.x = __builtin_amdgcn_rcpf(d.x); t.y = __builtin_amdgcn_rcpf(d.y);
    f32x2 q = t * 0.5307027145f + (-0.7265760135f); q = q * t + 0.7107068705f; q = q * t + (-0.142248368f); q = q * t + 0.127414796f; q = q * t;
    const f32x2 s = (v * v) * (-0.72134752044f);
    f32x2 e; e.x = __builtin_amdgcn_exp2f(s.x); e.y = __builtin_amdgcn_exp2f(s.y);
    const f32x2 m = v * (q * e), r = v - m;
    f32x2 o; o.x = v.x < 0.f ? m.x : r.x; o.y = v.y < 0.f ? m.y : r.y; return o;
}

template <int ACT  > struct EpiBf16 {
    static constexpr bool PERM = true, AFTER_DRAIN = false; static_assert(ACT == 0 || ACT == 1, "EpiBf16: ACT is 0 (none) or 1 (gelu_pk)");
    bf16_t* O; int ldc; const float* bias; int split_cols; size_t split_stride; float scale0;
    __device__ __forceinline__ void operator()(const f32x4 (&acc)[2][2][4][2], const Unit& u, int wr, int wc, int fr, int fq) const {
        const int row0 = u.pm * BM + wr * 64 + fr; int colt = u.pn * BM; bf16_t* base = O;
        float sc = 1.f; if (split_cols) { const int t = colt / split_cols; base += (size_t)t * split_stride; colt -= t * split_cols; if (t == 0) sc = scale0; }
        const int col0 = colt + wc * 32 + 8 * fq, bcol0 = u.pn * BM + wc * 32 + 8 * fq;
        f32x4 bv[2][2];
#pragma unroll
        for (int bj = 0; bj < 2; ++bj)
#pragma unroll
            for (int n = 0; n < 2; ++n) bv[bj][n] = bias ? *(const f32x4*)(bias + bcol0 + bj * HALF + 4 * n) : (f32x4){0.f, 0.f, 0.f, 0.f};
#pragma unroll
        for (int ai = 0; ai < 2; ++ai)
#pragma unroll
            for (int m = 0; m < 4; ++m) { bf16_t* rowp = base + (size_t)(row0 + ai * HALF + m * 16) * ldc + col0;
#pragma unroll
                for (int bj = 0; bj < 2; ++bj) { f32x4 v0 = acc[ai][bj][m][0] + bv[bj][0], v1 = acc[ai][bj][m][1] + bv[bj][1];
                    if (ACT == 1) { f32x2 a = gelu_pk((f32x2){v0[0], v0[1]}), b = gelu_pk((f32x2){v0[2], v0[3]}), c = gelu_pk((f32x2){v1[0], v1[1]}), d = gelu_pk((f32x2){v1[2], v1[3]});
                        v0 = (f32x4){a.x, a.y, b.x, b.y}; v1 = (f32x4){c.x, c.y, d.x, d.y}; }
                    v0 = v0 * sc; v1 = v1 * sc; u32x4 w; w.x = cvt_pk_bf16(v0[0], v0[1]); w.y = cvt_pk_bf16(v0[2], v0[3]); w.z = cvt_pk_bf16(v1[0], v1[1]); w.w = cvt_pk_bf16(v1[2], v1[3]);
                    *(u32x4*)(rowp + bj * HALF) = w; } }
    }
};

struct EpiF32 {
    static constexpr bool PERM = false, AFTER_DRAIN = false;
    float* C; int ldc;
    __device__ __forceinline__ void operator()(const f32x4 (&acc)[2][2][4][2], const Unit& u, int wr, int wc, int fr, int fq) const {
        const int row0 = u.pm * BM + wr * 64 + fr, col0 = u.pn * BM + wc * 32 + 4 * fq;
#pragma unroll
        for (int ai = 0; ai < 2; ++ai)
#pragma unroll
            for (int m = 0; m < 4; ++m) { float* rowp = C + (size_t)(row0 + ai * HALF + m * 16) * ldc + col0;
#pragma unroll
                for (int bj = 0; bj < 2; ++bj)
#pragma unroll
                    for (int n = 0; n < 2; ++n) *(f32x4*)(rowp + bj * HALF + n * 16) = acc[ai][bj][m][n]; }
    }
};
__device__ __forceinline__ float bf_lo(unsigned w) { return __uint_as_float(w << 16); }
__device__ __forceinline__ float bf_hi(unsigned w) { return __uint_as_float(w & 0xffff0000u); }
__device__ __forceinline__ float sigmoidf_(float x) { return __builtin_amdgcn_rcpf(1.0f + __expf(-x)); }
struct EpiIn {
    static constexpr bool PERM = true, AFTER_DRAIN = false;
    bf16_t* P; int ldp; float* SM; const float* bgate; int gate_tile0, small_tile;
    __device__ __forceinline__ void operator()(const f32x4 (&acc)[2][2][4][2], const Unit& u, int wr, int wc, int fr, int fq) const {
        const int row0 = u.pm * BM + wr * 64 + fr, colt = u.pn * BM + wc * 32 + 8 * fq;
        if (u.pn < small_tile) {
            const bool gate = u.pn >= gate_tile0;
            f32x4 bv[2][2];
#pragma unroll
            for (int bj = 0; bj < 2; ++bj)
#pragma unroll
                for (int n = 0; n < 2; ++n) bv[bj][n] = gate ? *(const f32x4*)(bgate + (colt - gate_tile0 * BM) + bj * HALF + 4 * n) : (f32x4){0.f, 0.f, 0.f, 0.f};
#pragma unroll
            for (int ai = 0; ai < 2; ++ai)
#pragma unroll
                for (int m = 0; m < 4; ++m) { bf16_t* rowp = P + (size_t)(row0 + ai * HALF + m * 16) * ldp + colt;
#pragma unroll
                    for (int bj = 0; bj < 2; ++bj) { f32x4 v0 = acc[ai][bj][m][0] + bv[bj][0], v1 = acc[ai][bj][m][1] + bv[bj][1];
                        if (gate) {
#pragma unroll
                            for (int j = 0; j < 4; ++j) { v0[j] = sigmoidf_(v0[j]); v1[j] = sigmoidf_(v1[j]); } }
                        u32x4 w; w.x = cvt_pk_bf16(v0[0], v0[1]); w.y = cvt_pk_bf16(v0[2], v0[3]); w.z = cvt_pk_bf16(v1[0], v1[1]); w.w = cvt_pk_bf16(v1[2], v1[3]);
                        *(u32x4*)(rowp + bj * HALF) = w; } }
        } else {
            const int c0 = wc * 32 + 8 * fq;
#pragma unroll
            for (int ai = 0; ai < 2; ++ai)
#pragma unroll
                for (int m = 0; m < 4; ++m) { float* rowp = SM + (size_t)(row0 + ai * HALF + m * 16) * BM + c0;
#pragma unroll
                    for (int bj = 0; bj < 2; ++bj) { *(f32x4*)(rowp + bj * HALF) = acc[ai][bj][m][0]; *(f32x4*)(rowp + bj * HALF + 4) = acc[ai][bj][m][1]; } }
        }
    }
};
struct EpiGateMul {
    static constexpr bool PERM = true, AFTER_DRAIN = false;
    float* MG; int ldc; const bf16_t* G; int ldg;
    __device__ __forceinline__ void operator()(const f32x4 (&acc)[2][2][4][2], const Unit& u, int wr, int wc, int fr, int fq) const {
        const int row0 = u.pm * BM + wr * 64 + fr, colt = u.pn * BM + wc * 32 + 8 * fq;
#pragma unroll
        for (int ai = 0; ai < 2; ++ai)
#pragma unroll
            for (int m = 0; m < 4; ++m) { const size_t row = (size_t)(row0 + ai * HALF + m * 16);
#pragma unroll
                for (int bj = 0; bj < 2; ++bj) { const u32x4 g = *(const u32x4*)(G + row * ldg + colt + bj * HALF);
                    f32x4 v0 = acc[ai][bj][m][0], v1 = acc[ai][bj][m][1];
                    v0[0] *= bf_lo(g.x); v0[1] *= bf_hi(g.x); v0[2] *= bf_lo(g.y); v0[3] *= bf_hi(g.y);
                    v1[0] *= bf_lo(g.z); v1[1] *= bf_hi(g.z); v1[2] *= bf_lo(g.w); v1[3] *= bf_hi(g.w);
                    float* o = MG + row * ldc + colt + bj * HALF; *(f32x4*)o = v0; *(f32x4*)(o + 4) = v1; } }
    }
};
struct EpiGateAdd {
    static constexpr bool PERM = true, AFTER_DRAIN = false;
    const float* MG; bf16_t* O; int ldc; const bf16_t* G; int ldg;
    __device__ __forceinline__ void operator()(const f32x4 (&acc)[2][2][4][2], const Unit& u, int wr, int wc, int fr, int fq) const {
        const int row0 = u.pm * BM + wr * 64 + fr, colt = u.pn * BM + wc * 32 + 8 * fq;
#pragma unroll
        for (int ai = 0; ai < 2; ++ai)
#pragma unroll
            for (int m = 0; m < 4; ++m) { const size_t row = (size_t)(row0 + ai * HALF + m * 16);
#pragma unroll
                for (int bj = 0; bj < 2; ++bj) { const u32x4 g = *(const u32x4*)(G + row * ldg + colt + bj * HALF);
                    const float* mi = MG + row * ldc + colt + bj * HALF; f32x4 v0 = *(const f32x4*)mi, v1 = *(const f32x4*)(mi + 4);
                    const f32x4 a0 = acc[ai][bj][m][0], a1 = acc[ai][bj][m][1];
                    v0[0] += a0[0] * bf_lo(g.x); v0[1] += a0[1] * bf_hi(g.x); v0[2] += a0[2] * bf_lo(g.y); v0[3] += a0[3] * bf_hi(g.y);
                    v1[0] += a1[0] * bf_lo(g.z); v1[1] += a1[1] * bf_hi(g.z); v1[2] += a1[2] * bf_lo(g.w); v1[3] += a1[3] * bf_hi(g.w);
                    u32x4 w; w.x = cvt_pk_bf16(v0[0], v0[1]); w.y = cvt_pk_bf16(v0[2], v0[3]); w.z = cvt_pk_bf16(v1[0], v1[1]); w.w = cvt_pk_bf16(v1[2], v1[3]);
                    *(u32x4*)(O + row * ldc + colt + bj * HALF) = w; } }
    }
};
template <class Epi, class Sched, bool ALIGN_EPI = false, bool SP2 = false>
__device__ __forceinline__ void gemm_phase(PG8_LAS unsigned char* lds, const Gemm g, const Sched& S, const Epi& E) {
    int tid = threadIdx.x; asm volatile("" : "+v"(tid));
    const int wid = __builtin_amdgcn_readfirstlane(tid >> 6), lane = tid & 63, wr = wid >> 2, wc = wid & 3, fr = lane & 15, fq = lane >> 4;
    const int K = g.K, nt = K / BK;
    unsigned voffA[2], voffB[2];
#pragma unroll
    for (int i = 0; i < 2; ++i) { int R, C; stage_rc(tid * 16 + i * 8192, R, C); const int Rb = Epi::PERM ? ((R & ~31) + perm32(R & 31)) : R;
        voffA[i] = (unsigned)(R * K + C) * 2u; voffB[i] = (unsigned)(Rb * K + C) * 2u; }
    const size_t kstep = (size_t)(BK * 2);
    const size_t hstep = (size_t)HALF * K * 2;
    const size_t tstep = 2 * hstep;
    const unsigned ldsw = (unsigned)wid * 1024u;
    const int aoff = lds_byte(wr * 64 + fr, fq * 8), boff = lds_byte(wc * 32 + fr, fq * 8);
#define PG8_SA(b, h) (((b) * 2 + (h)) * HTB)
#define PG8_SB(b, h) ((4 + (b) * 2 + (h)) * HTB)
#define PG8_STAGE(bufoff, gbase, voff) do { _Pragma("unroll") for (int _i = 0; _i < 2; ++_i) \
        __builtin_amdgcn_global_load_lds((const unsigned*)((const char*)(gbase) + (voff)[_i]), (PG8_LAS unsigned*)(lds + (bufoff) + ldsw + _i * 8192), 16, 0, 0); } while (0)
#define PG8_LDA(dst, b, h) do { _Pragma("unroll") for (int m = 0; m < 4; ++m) _Pragma("unroll") for (int k = 0; k < 2; ++k) dst[m][k] = *(const PG8_LAS bf16x8*)(lds + PG8_SA(b, h) + aoff + m * 2048 + k * 1024); } while (0)
#define PG8_LDB(dst, b, h) do { _Pragma("unroll") for (int n = 0; n < 2; ++n) _Pragma("unroll") for (int k = 0; k < 2; ++k) dst[n][k] = *(const PG8_LAS bf16x8*)(lds + PG8_SB(b, h) + boff + n * 2048 + k * 1024); } while (0)
#define PG8_MMA(ai, bj, At, Bt) do { __builtin_amdgcn_s_setprio(1); _Pragma("unroll") for (int m = 0; m < 4; ++m) _Pragma("unroll") for (int n = 0; n < 2; ++n) _Pragma("unroll") for (int k = 0; k < 2; ++k) \
        acc[ai][bj][m][n] = __builtin_amdgcn_mfma_f32_16x16x32_bf16(Bt[n][k], At[m][k], acc[ai][bj][m][n], 0, 0, 0); __builtin_amdgcn_s_setprio(0); } while (0)
#define PG8_WAIT_V(n) asm volatile("s_waitcnt vmcnt(" #n ")" ::: "memory")
#define PG8_WAIT_L(n) asm volatile("s_waitcnt lgkmcnt(" #n ")" ::: "memory")
#define PG8_BAR __builtin_amdgcn_s_barrier()
#define PG8_SCHED __builtin_amdgcn_sched_barrier(0)
    Unit cur, nxt; int ui = 0;
    if (!S.next(0, cur)) return;
    f32x4 acc[2][2][4][2];
#pragma unroll
    for (int a = 0; a < 2; ++a)
#pragma unroll
        for (int b = 0; b < 2; ++b)
#pragma unroll
            for (int m = 0; m < 4; ++m)
#pragma unroll
                for (int n = 0; n < 2; ++n) acc[a][b][m][n] = (f32x4){0.f, 0.f, 0.f, 0.f};
    bf16x8 At[4][2], B0[2][2], B1[2][2];
    const char* cA = (const char*)g.A + (size_t)cur.pm * tstep; const char* cB = (const char*)g.Bt + (size_t)cur.pn * tstep;
    S.a_ready(cur);
    if constexpr (SP2) {
        PG8_STAGE(PG8_SB(0, 0), cB, voffB); PG8_STAGE(PG8_SB(0, 1), cB + hstep, voffB); PG8_STAGE(PG8_SA(0, 0), cA, voffA); PG8_STAGE(PG8_SA(0, 1), cA + hstep, voffA);
        if (wr == 1) PG8_BAR;
        PG8_WAIT_V(2); PG8_BAR;
        PG8_STAGE(PG8_SB(1, 0), cB + kstep, voffB); PG8_STAGE(PG8_SA(1, 0), cA + kstep, voffA); PG8_STAGE(PG8_SB(1, 1), cB + hstep + kstep, voffB);
        PG8_WAIT_V(6); PG8_BAR;
    } else {
        PG8_STAGE(PG8_SB(0, 0), cB, voffB); PG8_STAGE(PG8_SA(0, 0), cA, voffA); PG8_STAGE(PG8_SB(0, 1), cB + hstep, voffB); PG8_STAGE(PG8_SA(0, 1), cA + hstep, voffA);
        if (wr == 1) PG8_BAR;
        PG8_WAIT_V(4); PG8_BAR;
        PG8_STAGE(PG8_SB(1, 0), cB + kstep, voffB); PG8_STAGE(PG8_SA(1, 0), cA + kstep, voffA); PG8_STAGE(PG8_SB(1, 1), cB + hstep + kstep, voffB);
        PG8_WAIT_V(6); PG8_BAR;
    }
    for (;;) {
        const bool has_next = S.next(ui + 1, nxt);
        const char* nA = has_next ? (const char*)g.A + (size_t)nxt.pm * tstep : cA; const char* nB = has_next ? (const char*)g.Bt + (size_t)nxt.pn * tstep : cB;
        for (int t = 0; t < nt; t += 2) {
            const bool last = (t == nt - 2);
            const char* a1 = cA + (size_t)(t + 1) * kstep;
            const char* a2 = last ? nA : cA + (size_t)(t + 2) * kstep; const char* b2 = last ? nB : cB + (size_t)(t + 2) * kstep;
            const char* a3 = a2 + kstep; const char* b3 = b2 + kstep;
            if (last && has_next) S.a_ready(nxt);
            if constexpr (SP2) {
            PG8_LDB(B0, 0, 0); PG8_LDB(B1, 0, 1); PG8_SCHED; PG8_LDA(At, 0, 0); PG8_STAGE(PG8_SA(1, 1), a1 + hstep, voffA);
            PG8_WAIT_V(8); PG8_WAIT_L(0); PG8_BAR; PG8_MMA(0, 0, At, B0); PG8_MMA(0, 1, At, B1); PG8_BAR; PG8_SCHED;
            PG8_LDA(At, 0, 1); PG8_STAGE(PG8_SB(0, 0), b2, voffB); PG8_STAGE(PG8_SB(0, 1), b2 + hstep, voffB); PG8_STAGE(PG8_SA(0, 0), a2, voffA);
            PG8_WAIT_V(8); PG8_WAIT_L(0); PG8_BAR; PG8_MMA(1, 0, At, B0); PG8_MMA(1, 1, At, B1); PG8_BAR; PG8_SCHED;
            PG8_LDB(B0, 1, 0); PG8_LDB(B1, 1, 1); PG8_SCHED; PG8_LDA(At, 1, 0); PG8_STAGE(PG8_SA(0, 1), a2 + hstep, voffA);
            PG8_WAIT_V(8); PG8_WAIT_L(0); PG8_BAR; PG8_MMA(0, 0, At, B0); PG8_MMA(0, 1, At, B1); PG8_BAR; PG8_SCHED;
            PG8_LDA(At, 1, 1); PG8_STAGE(PG8_SB(1, 0), b3, voffB); PG8_STAGE(PG8_SB(1, 1), b3 + hstep, voffB); PG8_STAGE(PG8_SA(1, 0), a3, voffA);
            PG8_WAIT_V(8); PG8_WAIT_L(0); PG8_BAR; PG8_MMA(1, 0, At, B0); PG8_MMA(1, 1, At, B1); PG8_BAR; PG8_SCHED;
            } else {
            PG8_LDB(B0, 0, 0); PG8_SCHED; PG8_LDA(At, 0, 0); PG8_STAGE(PG8_SA(1, 1), a1 + hstep, voffA);
            PG8_WAIT_L(8); PG8_BAR; PG8_WAIT_L(0); PG8_MMA(0, 0, At, B0); PG8_BAR; PG8_SCHED;
            PG8_LDB(B1, 0, 1); PG8_STAGE(PG8_SB(0, 0), b2, voffB);
            PG8_BAR; PG8_WAIT_L(0); PG8_MMA(0, 1, At, B1); PG8_BAR;
            PG8_LDA(At, 0, 1); PG8_STAGE(PG8_SA(0, 0), a2, voffA);
            PG8_BAR; PG8_WAIT_L(0); PG8_MMA(1, 0, At, B0); PG8_BAR; PG8_SCHED;
            PG8_STAGE(PG8_SB(0, 1), b2 + hstep, voffB);
            PG8_WAIT_V(6); PG8_BAR; PG8_MMA(1, 1, At, B1); PG8_BAR;
            PG8_LDB(B0, 1, 0); PG8_SCHED; PG8_LDA(At, 1, 0); PG8_STAGE(PG8_SA(0, 1), a2 + hstep, voffA);
            PG8_WAIT_L(8); PG8_BAR; PG8_WAIT_L(0); PG8_MMA(0, 0, At, B0); PG8_BAR; PG8_SCHED;
            PG8_LDB(B1, 1, 1); PG8_STAGE(PG8_SB(1, 0), b3, voffB);
            PG8_BAR; PG8_WAIT_L(0); PG8_MMA(0, 1, At, B1); PG8_BAR;
            PG8_LDA(At, 1, 1); PG8_STAGE(PG8_SA(1, 0), a3, voffA);
            PG8_BAR; PG8_WAIT_L(0); PG8_MMA(1, 0, At, B0); PG8_BAR; PG8_SCHED;
            PG8_STAGE(PG8_SB(1, 1), b3 + hstep, voffB);
            PG8_WAIT_V(6); PG8_BAR; PG8_MMA(1, 1, At, B1); PG8_BAR;
            }
        }
        if constexpr (ALIGN_EPI) { if (wr == 0) PG8_BAR; }
        if constexpr (!Epi::AFTER_DRAIN) { E(acc, cur, wr, wc, fr, fq); S.done(cur); }
        if (!has_next) break;
#pragma unroll
        for (int a = 0; a < 2; ++a)
#pragma unroll
            for (int b = 0; b < 2; ++b)
#pragma unroll
                for (int m = 0; m < 4; ++m)
#pragma unroll
                    for (int n = 0; n < 2; ++n) acc[a][b][m][n] = (f32x4){0.f, 0.f, 0.f, 0.f};
        cur = nxt; cA = nA; cB = nB; ++ui;
        if constexpr (ALIGN_EPI) { if (wr == 1) PG8_BAR; }
    }
    PG8_WAIT_V(0);
    if constexpr (!ALIGN_EPI) { if (wr == 0) PG8_BAR; }
    PG8_BAR;
    if constexpr (Epi::AFTER_DRAIN) { E.fused(acc, cur, wr, wc, fr, fq, lds, wid, lane); S.done(cur); }
#undef PG8_SA
#undef PG8_SB
#undef PG8_STAGE
#undef PG8_LDA
#undef PG8_LDB
#undef PG8_MMA
#undef PG8_WAIT_V
#undef PG8_WAIT_L
#undef PG8_BAR
#undef PG8_SCHED
}
}

#ifndef MK_PER_PHASE
#define MK_PER_PHASE 0
#endif
constexpr int NWAVES = 8, NTHR = 512;
constexpr int BATCH = 2, SEQ = 4096, M = BATCH * SEQ, D = 2048, DEPTH = 4;
constexpr int DI = 4096, NH = 64, HP = 64, NG = 8, HPG = 8, NS = 128, CONVD = 6144;
constexpr int QH = 16, KVH = 4, AD = 128, IH = 16, IDD = 64, TOPK = 256;
constexpr int FF = 4096, FF2 = 8192;
constexpr int NIN = 18576, NMAIN = 18432, NPAD = 18688;
constexpr int PZ = 0, PXBC = 4096, PQ = 10240, PK = 12288, PV = 12800, PQI = 13312, PG = 14336;
constexpr int SMW = 256, SM_DT = 0, SM_KI = 64, SM_WI = 128;
constexpr float EPS = 1e-6f;
constexpr float ATTN_SCALE = 0.08838834764831845f;

constexpr size_t MiB = 1u << 20;
constexpr size_t WS_CTL = 0, CTL_ZERO_BYTES = 1 * MiB;
constexpr size_t WS_W = 2 * MiB;
constexpr size_t WL_IN = 0, WL_SSM = 73 * MiB, WL_ATT = 89 * MiB, WL_MIX = 97 * MiB, WL_UP = 105 * MiB, WL_DN = 137 * MiB, WL_SIZE = 153 * MiB;
constexpr size_t WS_H = WS_W + DEPTH * WL_SIZE;
constexpr size_t WS_P = WS_H + 32 * MiB;
constexpr size_t WS_SM = WS_P + 288 * MiB;
constexpr size_t WS_XC = WS_SM + 8 * MiB;
constexpr size_t WS_DT = WS_XC + 96 * MiB;
constexpr size_t WS_ACS = WS_DT + 2 * MiB;
constexpr size_t WS_ST = WS_ACS + 2 * MiB;
constexpr size_t WS_Y = WS_ST + 256 * MiB;
constexpr size_t WS_SC = WS_Y + 64 * MiB;
constexpr size_t WS_IDX = WS_SC + 128 * MiB;
constexpr size_t WS_CNT = WS_IDX + 8 * MiB;
constexpr size_t WS_AO = WS_CNT + 1 * MiB;
constexpr size_t WS_MG = WS_AO + 32 * MiB;
constexpr size_t WS_MGB = WS_MG + 64 * MiB;
constexpr size_t WS_YM = WS_MGB + 32 * MiB;
constexpr size_t WS_U = WS_YM + 64 * MiB;
constexpr size_t WS_ACT = WS_U + 128 * MiB;
constexpr size_t WS_KIB = WS_ACT + 64 * MiB;
constexpr size_t WS_END = WS_KIB + 1 * MiB;
constexpr int CW_BAR = 4096;

constexpr int RING_BYTES = 131072, LDSCTL_OFF = RING_BYTES, MISC_OFF = LDSCTL_OFF + 320, LDS_BYTES = 147456;

#define LAS __attribute__((address_space(3)))
typedef unsigned short bf16;
typedef float f32x4 __attribute__((ext_vector_type(4)));
typedef short bf16x8 __attribute__((ext_vector_type(8)));
typedef unsigned u32x4 __attribute__((ext_vector_type(4)));
typedef unsigned u32x2 __attribute__((ext_vector_type(2)));
#define LDS_WAIT() asm volatile("s_waitcnt lgkmcnt(0)" ::: "memory")

__device__ __forceinline__ unsigned f2bf(float f) { unsigned u = __builtin_bit_cast(unsigned, f); return (u + 0x7fffu + ((u >> 16) & 1u)) >> 16; }
__device__ __forceinline__ unsigned pk2(float lo, float hi) { return f2bf(lo) | (f2bf(hi) << 16); }
__device__ __forceinline__ float bflo(unsigned w) { return __uint_as_float(w << 16); }
__device__ __forceinline__ float bfhi(unsigned w) { return __uint_as_float(w & 0xffff0000u); }
__device__ __forceinline__ void unpack8(const u32x4 w, float (&f)[8]) { f[0] = bflo(w.x); f[1] = bfhi(w.x); f[2] = bflo(w.y); f[3] = bfhi(w.y); f[4] = bflo(w.z); f[5] = bfhi(w.z); f[6] = bflo(w.w); f[7] = bfhi(w.w); }
__device__ __forceinline__ u32x4 pack8(const float (&f)[8]) { u32x4 w; w.x = pk2(f[0], f[1]); w.y = pk2(f[2], f[3]); w.z = pk2(f[4], f[5]); w.w = pk2(f[6], f[7]); return w; }
__device__ __forceinline__ float wave_sum(float v) {
#pragma unroll
    for (int o = 1; o < 64; o <<= 1) v += __shfl_xor(v, o);
    return v;
}
__device__ __forceinline__ float wave_max(float v) {
#pragma unroll
    for (int o = 1; o < 64; o <<= 1) v = fmaxf(v, __shfl_xor(v, o));
    return v;
}
__device__ __forceinline__ float siluf_(float x) { return x / (1.0f + __expf(-x)); }

#define XB_TMO      128
#define XB_XCNT(j)  (256  + 64 * (j))
#define XB_XSUB(j)  (1280 + 64 * (j))
#define XB_XGEN(j)  (2304 + 64 * (j))
#define XB_TOP      3328
#define XB_TOPGEN   3392
#define XCD_BAR_WORDS 3456
#define XB_SPIN_CAP (1u << 18)

__device__ __forceinline__ unsigned xb_ld(unsigned* p)              { return __hip_atomic_load(p, __ATOMIC_RELAXED, __HIP_MEMORY_SCOPE_AGENT); }
__device__ __forceinline__ unsigned xb_add(unsigned* p, unsigned v) { return __hip_atomic_fetch_add(p, v, __ATOMIC_RELAXED, __HIP_MEMORY_SCOPE_AGENT); }
__device__ __forceinline__ unsigned xb_xcc_id() { return (unsigned)__builtin_amdgcn_s_getreg((3 << 11) | 20) & 0xFu; }
#define XB_SPIN(cond, bar) do { unsigned _sp = 0; while (cond) { __builtin_amdgcn_s_sleep(1); \
    if ((++_sp & 255u) == 0u) { if (xb_ld(&(bar)[XB_TMO])) break; if (_sp > XB_SPIN_CAP) { atomicAdd(&(bar)[XB_TMO], 1u); break; } } } } while (0)

struct XcdBarrier {
    unsigned* bar; unsigned x;
    volatile LAS unsigned* st;
};

__device__ __forceinline__ XcdBarrier xcd_barrier_post(unsigned* bar, volatile LAS unsigned* st) {
    XcdBarrier b; b.bar = bar; b.x = xb_xcc_id(); b.st = st;
    if (threadIdx.x == 0) (void)xb_add(&bar[XB_XCNT(b.x)], 1u);
    return b;
}
__device__ __forceinline__ void xcd_barrier_complete(unsigned* bar, unsigned x, unsigned& nloc, unsigned& nx) {
    const unsigned G = gridDim.x * gridDim.y * gridDim.z;
    unsigned sum, cnt, mine, sp = 0u;
    for (;;) {
        sum = 0u; cnt = 0u; mine = 0u;
#pragma unroll
        for (unsigned j = 0; j < 16; ++j) { const unsigned c = xb_ld(&bar[XB_XCNT(j)]); sum += c; cnt += (c > 0u) ? 1u : 0u; mine = (j == x) ? c : mine; }
        if (sum == G) break;
        __builtin_amdgcn_s_sleep(1);
        if ((++sp & 255u) == 0u) { if (xb_ld(&bar[XB_TMO])) break; if (sp > XB_SPIN_CAP) { atomicAdd(&bar[XB_TMO], 1u); break; } }
    }
    nloc = mine > 0u ? mine : 1u; nx = cnt > 0u ? cnt : 1u;
}

__device__ __forceinline__ void xcd_barrier(const XcdBarrier& b) {
    asm volatile("s_waitcnt vmcnt(0)" ::: "memory");
    __syncthreads();
    if (threadIdx.x == 0) {
        unsigned* bar = b.bar;
        __builtin_amdgcn_s_waitcnt(0);
        unsigned nloc = b.st[0], nx = b.st[1];
        if (nloc == 0u) { xcd_barrier_complete(bar, b.x, nloc, nx); b.st[0] = nloc; b.st[1] = nx; }
        const unsigned old = xb_add(&bar[XB_XSUB(b.x)], 1u);
        const unsigned gen = old / nloc;
        if (old + 1u == (gen + 1u) * nloc) {
            __builtin_amdgcn_fence(__ATOMIC_RELEASE, "agent");
            asm volatile("s_waitcnt vmcnt(0)" ::: "memory");
            const unsigned og = xb_add(&bar[XB_TOP], 1u);
            const unsigned tg = og / nx;
            if (og + 1u == (tg + 1u) * nx) xb_add(&bar[XB_TOPGEN], 1u);
            else XB_SPIN(xb_ld(&bar[XB_TOPGEN]) == tg, bar);
            __builtin_amdgcn_fence(__ATOMIC_ACQUIRE, "agent");
            xb_add(&bar[XB_XGEN(b.x)], 1u);
            asm volatile("s_waitcnt vmcnt(0)" ::: "memory");
        } else {
            XB_SPIN(xb_ld(&bar[XB_XGEN(b.x)]) == gen, bar);
            __builtin_amdgcn_fence(__ATOMIC_ACQUIRE, "agent");
            asm volatile("s_waitcnt vmcnt(0)" ::: "memory");
        }
    }
    __syncthreads();
}


__device__ __forceinline__ void ph_resid_norm(const float* Yin, const float* gpost, const float* gnext, const float* Xin, float* X, bf16* H, int gw, int ngw, int lane) {
    for (int m = gw; m < M; m += ngw) {
        const f32x4* xr = (const f32x4*)(Xin + (size_t)m * D) + lane;
        f32x4 xv[8];
#pragma unroll
        for (int j = 0; j < 8; ++j) xv[j] = xr[64 * j];
        if (Yin) {
            const f32x4* yr = (const f32x4*)(Yin + (size_t)m * D) + lane; f32x4 yv[8]; float ss = 0.f;
#pragma unroll
            for (int j = 0; j < 8; ++j) { yv[j] = yr[64 * j]; ss += (yv[j].x * yv[j].x + yv[j].y * yv[j].y) + (yv[j].z * yv[j].z + yv[j].w * yv[j].w); }
            const float rstd = rsqrtf(wave_sum(ss) * (1.0f / D) + EPS);
#pragma unroll
            for (int j = 0; j < 8; ++j) { const f32x4 g = ((const f32x4*)gpost + lane)[64 * j]; xv[j] = xv[j] + yv[j] * rstd * g; }
        }
        if (Yin || Xin != X) { f32x4* xo = (f32x4*)(X + (size_t)m * D) + lane;
#pragma unroll
            for (int j = 0; j < 8; ++j) xo[64 * j] = xv[j]; }
        if (gnext) {
            float ss = 0.f;
#pragma unroll
            for (int j = 0; j < 8; ++j) ss += (xv[j].x * xv[j].x + xv[j].y * xv[j].y) + (xv[j].z * xv[j].z + xv[j].w * xv[j].w);
            const float rstd = rsqrtf(wave_sum(ss) * (1.0f / D) + EPS);
            u32x2* ho = (u32x2*)(H + (size_t)m * D) + lane;
#pragma unroll
            for (int j = 0; j < 8; ++j) { const f32x4 g = ((const f32x4*)gnext + lane)[64 * j]; const f32x4 h = xv[j] * rstd * g; u32x2 w; w.x = pk2(h.x, h.y); w.y = pk2(h.z, h.w); ho[64 * j] = w; }
        }
    }
}

__device__ __forceinline__ void tr_item(const float* W, int ldw, int K, int k0, int nsrc, int ncols, bf16* WT, int ndst, float* scr, int lane) {
    const int j = lane & 31;
#pragma unroll 8
    for (int i = 0; i < 32; ++i) { const int kk = 2 * i + (lane >> 5); scr[kk * 33 + j] = (j < ncols) ? W[(size_t)(k0 + kk) * ldw + nsrc + j] : 0.f; }
    LDS_WAIT();
    const int c = lane & 7;
#pragma unroll
    for (int jj = 0; jj < 4; ++jj) { const int n = (lane >> 3) + 8 * jj; const float* s = scr + (8 * c) * 33 + n;
        u32x4 o; o.x = pk2(s[0 * 33], s[1 * 33]); o.y = pk2(s[2 * 33], s[3 * 33]); o.z = pk2(s[4 * 33], s[5 * 33]); o.w = pk2(s[6 * 33], s[7 * 33]);
        *(u32x4*)(WT + (size_t)(ndst + n) * K + k0 + 8 * c) = o; }
    LDS_WAIT();
}
__device__ __forceinline__ void win_map(int dstrow, int& src, int& ncols) {
    ncols = 32;
    if (dstrow < 10240) src = dstrow;
    else if (dstrow < 12288) src = dstrow - 10240 + 10304;
    else if (dstrow < 12800) src = dstrow - 12288 + 12352;
    else if (dstrow < 13312) src = dstrow - 12800 + 12864;
    else if (dstrow < 14336) src = dstrow - 13312 + 13376;
    else if (dstrow < 18432) src = dstrow - 14336 + 14480;
    else if (dstrow < 18496) src = dstrow - 18432 + 10240;
    else if (dstrow < 18560) src = dstrow - 18496 + 14400;
    else if (dstrow == 18560) { src = 14464; ncols = 16; }
    else { src = 0; ncols = 0; }
}
struct WPtrs { const float *w_in, *w_ssm, *w_att, *w_mix, *w_up, *w_dn; };
__device__ __forceinline__ void ph_weights(const WPtrs wp, unsigned char* ws, float* scr, int gw, int ngw, int lane) {
    constexpr int I_IN = (NPAD / 32) * (D / 64), I_SSM = (D / 32) * (DI / 64), I_ATT = (D / 32) * (D / 64), I_MIX = I_ATT, I_UP = (FF2 / 32) * (D / 64), I_DN = (D / 32) * (FF / 64);
    constexpr int I_L = I_IN + I_SSM + I_ATT + I_MIX + I_UP + I_DN;
    for (int it = gw; it < DEPTH * I_L; it += ngw) {
        const int layer = it / I_L; int r = it % I_L;
        unsigned char* wl = ws + WS_W + (size_t)layer * WL_SIZE;
        if (r < I_IN) { const int nblk = NPAD / 32, kb = r / nblk, nb = r % nblk; int src, nc; win_map(nb * 32, src, nc);
            tr_item(wp.w_in + (size_t)layer * D * NIN, NIN, D, kb * 64, src, nc, (bf16*)(wl + WL_IN), nb * 32, scr, lane); continue; }
        r -= I_IN;
        if (r < I_SSM) { const int nblk = D / 32, kb = r / nblk, nb = r % nblk; tr_item(wp.w_ssm + (size_t)layer * DI * D, D, DI, kb * 64, nb * 32, 32, (bf16*)(wl + WL_SSM), nb * 32, scr, lane); continue; }
        r -= I_SSM;
        if (r < I_ATT) { const int nblk = D / 32, kb = r / nblk, nb = r % nblk; tr_item(wp.w_att + (size_t)layer * D * D, D, D, kb * 64, nb * 32, 32, (bf16*)(wl + WL_ATT), nb * 32, scr, lane); continue; }
        r -= I_ATT;
        if (r < I_MIX) { const int nblk = D / 32, kb = r / nblk, nb = r % nblk; tr_item(wp.w_mix + (size_t)layer * D * D, D, D, kb * 64, nb * 32, 32, (bf16*)(wl + WL_MIX), nb * 32, scr, lane); continue; }
        r -= I_MIX;
        if (r < I_UP) { const int nblk = FF2 / 32, kb = r / nblk, nb = r % nblk; tr_item(wp.w_up + (size_t)layer * D * FF2, FF2, D, kb * 64, nb * 32, 32, (bf16*)(wl + WL_UP), nb * 32, scr, lane); continue; }
        r -= I_UP;
        { const int nblk = D / 32, kb = r / nblk, nb = r % nblk; tr_item(wp.w_dn + (size_t)layer * FF * D, D, FF, kb * 64, nb * 32, 32, (bf16*)(wl + WL_DN), nb * 32, scr, lane); }
    }
}

__device__ __forceinline__ void ph_conv_dt(const bf16* P, const float* SM, const float* cw, const float* cb, const float* dt_bias, const float* a_log,
                                           bf16* XC, float* DT, float* ACS, bf16* KIB, int gtid, int nthr) {
    constexpr int NCG = CONVD / 8;
    for (int it = gtid; it < M * NCG; it += nthr) {
        const int m = it / NCG, c0 = (it % NCG) * 8, t = m & (SEQ - 1);
        float acc[8];
        { const f32x4 b0 = *(const f32x4*)(cb + c0), b1 = *(const f32x4*)(cb + c0 + 4); acc[0] = b0.x; acc[1] = b0.y; acc[2] = b0.z; acc[3] = b0.w; acc[4] = b1.x; acc[5] = b1.y; acc[6] = b1.z; acc[7] = b1.w; }
#pragma unroll
        for (int i = 0; i < 4; ++i) { if (t - 3 + i >= 0) {
            const u32x4 xw = *(const u32x4*)(P + (size_t)(m - 3 + i) * NMAIN + PXBC + c0); float x[8]; unpack8(xw, x);
            const f32x4 w0 = *(const f32x4*)(cw + i * CONVD + c0), w1 = *(const f32x4*)(cw + i * CONVD + c0 + 4);
            acc[0] += w0.x * x[0]; acc[1] += w0.y * x[1]; acc[2] += w0.z * x[2]; acc[3] += w0.w * x[3]; acc[4] += w1.x * x[4]; acc[5] += w1.y * x[5]; acc[6] += w1.z * x[6]; acc[7] += w1.w * x[7]; } }
#pragma unroll
        for (int j = 0; j < 8; ++j) acc[j] = siluf_(acc[j]);
        *(u32x4*)(XC + (size_t)m * CONVD + c0) = pack8(acc);
    }
    for (int it = gtid; it < BATCH * 64 * NH; it += nthr) {
        const int head = it & 63, m0 = (it >> 6) * 64; const float a = -__expf(a_log[head]), bias = dt_bias[head]; float cs = 0.f;
        for (int s = 0; s < 64; ++s) { const float raw = SM[(size_t)(m0 + s) * SMW + SM_DT + head] + bias; const float dt = fmaxf(raw, 0.f) + log1pf(__expf(-fabsf(raw)));
            DT[(m0 + s) * NH + head] = dt; cs += dt * a; ACS[(m0 + s) * NH + head] = cs; }
    }
    for (int it = gtid; it < M * 8; it += nthr) { const int m = it >> 3, d0 = (it & 7) * 8; const float* s = SM + (size_t)m * SMW + SM_KI + d0;
        const f32x4 a = *(const f32x4*)s, b = *(const f32x4*)(s + 4); u32x4 w; w.x = pk2(a.x, a.y); w.y = pk2(a.z, a.w); w.z = pk2(b.x, b.y); w.w = pk2(b.z, b.w);
        *(u32x4*)(KIB + (size_t)m * IDD + d0) = w; }
}

__device__ __forceinline__ void ph_index_scores(const bf16* P, const float* SM, const bf16* KIB, float* SC, int blk, int nblk, int wave, int lane) {
    for (int u0 = blk; u0 < 256; u0 += nblk) {
#pragma unroll 1
        for (int half = 0; half < 2; ++half) {
            const int b = half, qt = half ? 255 - u0 : u0;
            const int q0 = b * SEQ + qt * 16, nkt = ((qt * 16) / 64 + 1) * 4;
            const int qrow = q0 + (lane & 15), kq = 8 * (lane >> 4);
            bf16x8 bq[IH][2]; float w[IH];
#pragma unroll
            for (int h = 0; h < IH; ++h) {
#pragma unroll
                for (int ks = 0; ks < 2; ++ks) bq[h][ks] = *(const bf16x8*)(P + (size_t)qrow * NMAIN + PQI + h * IDD + ks * 32 + kq);
                w[h] = SM[(size_t)qrow * SMW + SM_WI + h]; }
            for (int kt = wave; kt < nkt; kt += NWAVES) {
                const int key0 = kt * 16; const bf16* kp = KIB + (size_t)(b * SEQ + key0 + (lane & 15)) * IDD + kq;
                const bf16x8 a0 = *(const bf16x8*)kp, a1 = *(const bf16x8*)(kp + 32);
                f32x4 sc = (f32x4){0.f, 0.f, 0.f, 0.f};
#pragma unroll
                for (int h = 0; h < IH; ++h) { f32x4 c = (f32x4){0.f, 0.f, 0.f, 0.f};
                    c = __builtin_amdgcn_mfma_f32_16x16x32_bf16(a0, bq[h][0], c, 0, 0, 0); c = __builtin_amdgcn_mfma_f32_16x16x32_bf16(a1, bq[h][1], c, 0, 0, 0);
                    sc.x += w[h] * fmaxf(c.x, 0.f); sc.y += w[h] * fmaxf(c.y, 0.f); sc.z += w[h] * fmaxf(c.z, 0.f); sc.w += w[h] * fmaxf(c.w, 0.f); }
                *(f32x4*)(SC + (size_t)qrow * SEQ + key0 + 4 * (lane >> 4)) = sc;
            }
        }
    }
}

__device__ __forceinline__ void ph_topk(const float* SC, int* IDX, int* CNT, int gw, int ngw, int lane) {
    for (int m = gw; m < M; m += ngw) {
        const int t = m & (SEQ - 1), limit = (t / 64 + 1) * 64;
        int* out = IDX + (size_t)m * TOPK;
        if (limit <= TOPK) { for (int j = lane; j < TOPK; j += 64) out[j] = j < limit ? j : 0; if (lane == 0) CNT[m] = limit; continue; }
        unsigned u[64];
#pragma unroll
        for (int j = 0; j < 64; ++j) { const int key = j * 64 + lane; unsigned v = 0u;
            if (key < limit) { const unsigned bits = __float_as_uint(SC[(size_t)m * SEQ + key]); v = (bits & 0x80000000u) ? ~bits : (bits | 0x80000000u); }
            u[j] = v; }
        unsigned T = 0u;
#pragma unroll 1
        for (int bit = 31; bit >= 0; --bit) { const unsigned cand = T | (1u << bit); int cnt = 0;
#pragma unroll
            for (int j = 0; j < 64; ++j) cnt += __popcll(__ballot(u[j] >= cand));
            if (cnt >= TOPK) T = cand; }
        int cgt = 0;
#pragma unroll
        for (int j = 0; j < 64; ++j) cgt += __popcll(__ballot(u[j] > T));
        const int need_eq = TOPK - cgt; int base = 0, eqbase = 0;
        const unsigned long long lt_mask = (1ull << lane) - 1ull;
#pragma unroll
        for (int j = 0; j < 64; ++j) {
            const bool gt = u[j] > T, eq = u[j] == T;
            const unsigned long long eqm = __ballot(eq);
            const bool take = gt || (eq && (eqbase + __popcll(eqm & lt_mask) < need_eq));
            const unsigned long long tm = __ballot(take);
            if (take) out[base + __popcll(tm & lt_mask)] = j * 64 + lane;
            base += __popcll(tm); eqbase += __popcll(eqm);
        }
        if (lane == 0) CNT[m] = TOPK;
    }
}

__device__ __forceinline__ void ph_sparse_attn(const bf16* P, const int* IDX, const int* CNT, bf16* AO, float* wl, int gw, int ngw, int lane) {
    float* QS = wl;
    float* PL = wl + 512;
    int* IL = (int*)(wl + 1536);
    for (int item = gw; item < M * KVH; item += ngw) {
        const int m = item >> 2, kvh = item & 3, b = m >> 12, n = __builtin_amdgcn_readfirstlane(CNT[m]);
        asm volatile("" ::: "memory");
#pragma unroll
        for (int i = 0; i < 4; ++i) { const int j = lane + 64 * i; const int v = IDX[(size_t)m * TOPK + j]; IL[j] = j < n ? v : 0; }
        { const u32x4 qw = *(const u32x4*)(P + (size_t)m * NMAIN + PQ + kvh * 512 + lane * 8); float q[8]; unpack8(qw, q);
#pragma unroll
          for (int j = 0; j < 8; ++j) QS[lane * 8 + j] = q[j] * ATTN_SCALE; }
        LDS_WAIT(); __builtin_amdgcn_wave_barrier(); asm volatile("" ::: "memory");
        float lg[4][4];
#pragma unroll
        for (int i = 0; i < 4; ++i) { const int j = lane + 64 * i; const int kk = IL[j];
            const bf16* kp = P + (size_t)(b * SEQ + kk) * NMAIN + PK + kvh * AD;
            float a0 = 0.f, a1 = 0.f, a2 = 0.f, a3 = 0.f;
#pragma unroll 4
            for (int c = 0; c < 16; ++c) { const u32x4 kw = *(const u32x4*)(kp + 8 * c); float k[8]; unpack8(kw, k);
                { const f32x4 qa = *(const f32x4*)(QS + 0 * 128 + 8 * c), qb = *(const f32x4*)(QS + 0 * 128 + 8 * c + 4); a0 += (qa.x * k[0] + qa.y * k[1]) + (qa.z * k[2] + qa.w * k[3]) + (qb.x * k[4] + qb.y * k[5]) + (qb.z * k[6] + qb.w * k[7]); }
                { const f32x4 qa = *(const f32x4*)(QS + 1 * 128 + 8 * c), qb = *(const f32x4*)(QS + 1 * 128 + 8 * c + 4); a1 += (qa.x * k[0] + qa.y * k[1]) + (qa.z * k[2] + qa.w * k[3]) + (qb.x * k[4] + qb.y * k[5]) + (qb.z * k[6] + qb.w * k[7]); }
                { const f32x4 qa = *(const f32x4*)(QS + 2 * 128 + 8 * c), qb = *(const f32x4*)(QS + 2 * 128 + 8 * c + 4); a2 += (qa.x * k[0] + qa.y * k[1]) + (qa.z * k[2] + qa.w * k[3]) + (qb.x * k[4] + qb.y * k[5]) + (qb.z * k[6] + qb.w * k[7]); }
                { const f32x4 qa = *(const f32x4*)(QS + 3 * 128 + 8 * c), qb = *(const f32x4*)(QS + 3 * 128 + 8 * c + 4); a3 += (qa.x * k[0] + qa.y * k[1]) + (qa.z * k[2] + qa.w * k[3]) + (qb.x * k[4] + qb.y * k[5]) + (qb.z * k[6] + qb.w * k[7]); } }
            const bool valid = j < n; const float ninf = -__builtin_inff();
            lg[i][0] = valid ? a0 : ninf; lg[i][1] = valid ? a1 : ninf; lg[i][2] = valid ? a2 : ninf; lg[i][3] = valid ? a3 : ninf; }
        float sum[4];
#pragma unroll
        for (int g = 0; g < 4; ++g) { const float mx = wave_max(fmaxf(fmaxf(lg[0][g], lg[1][g]), fmaxf(lg[2][g], lg[3][g]))); float s = 0.f;
#pragma unroll
            for (int i = 0; i < 4; ++i) { const float p = __expf(lg[i][g] - mx); lg[i][g] = p; s += p; }
            sum[g] = wave_sum(s); }
#pragma unroll
        for (int i = 0; i < 4; ++i) *(f32x4*)(PL + (lane + 64 * i) * 4) = (f32x4){lg[i][0], lg[i][1], lg[i][2], lg[i][3]};
        LDS_WAIT(); __builtin_amdgcn_wave_barrier(); asm volatile("" ::: "memory");
        float o[4][2];
#pragma unroll
        for (int g = 0; g < 4; ++g) { o[g][0] = 0.f; o[g][1] = 0.f; }
        const bf16* vbase = P + (size_t)(b * SEQ) * NMAIN + PV + kvh * AD + 2 * lane;
#pragma unroll 4
        for (int j = 0; j < n; ++j) { const int kk = IL[j]; const unsigned vw = *(const unsigned*)(vbase + (size_t)kk * NMAIN); const f32x4 p = *(const f32x4*)(PL + j * 4);
            const float v0 = bflo(vw), v1 = bfhi(vw);
            o[0][0] += p.x * v0; o[0][1] += p.x * v1; o[1][0] += p.y * v0; o[1][1] += p.y * v1; o[2][0] += p.z * v0; o[2][1] += p.z * v1; o[3][0] += p.w * v0; o[3][1] += p.w * v1; }
#pragma unroll
        for (int g = 0; g < 4; ++g) { const float r = 1.0f / sum[g]; *(unsigned*)(AO + (size_t)m * D + (kvh * 4 + g) * AD + 2 * lane) = pk2(o[g][0] * r, o[g][1] * r); }
        LDS_WAIT(); __builtin_amdgcn_wave_barrier(); asm volatile("" ::: "memory");
    }
}

__device__ __forceinline__ void ph_ssd_states(const bf16* XC, const float* DT, const float* ACS, float* ST, float* lds, int blk, int nblk, int tid) {
    float* Bs = lds;
    float* Xw = lds + 64 * 128;
    for (int item = blk; item < BATCH * 64 * NG; item += nblk) {
        const int bc = item >> 3, g = item & 7, m0 = bc * 64;
        __syncthreads();
        { const int e = tid * 16, s = e >> 7, n = e & 127; const bf16* src = XC + (size_t)(m0 + s) * CONVD + DI + g * NS + n;
          float f[8]; unpack8(*(const u32x4*)src, f);
#pragma unroll
          for (int j = 0; j < 8; ++j) Bs[e + j] = f[j];
          unpack8(*(const u32x4*)(src + 8), f);
#pragma unroll
          for (int j = 0; j < 8; ++j) Bs[e + 8 + j] = f[j]; }
#pragma unroll 1
        for (int r = 0; r < HPG; ++r) {
            const int head = g * HPG + r;
            __syncthreads();
            { const int e = tid * 8, s = e >> 6, p = e & 63; float f[8]; unpack8(*(const u32x4*)(XC + (size_t)(m0 + s) * CONVD + head * HP + p), f);
              const float w = DT[(m0 + s) * NH + head] * __expf(ACS[(m0 + 63) * NH + head] - ACS[(m0 + s) * NH + head]);
#pragma unroll
              for (int j = 0; j < 8; ++j) Xw[e + j] = f[j] * w; }
            __syncthreads();
            const int p = tid >> 3, n0 = (tid & 7) * 16;
            f32x4 acc[4];
#pragma unroll
            for (int q = 0; q < 4; ++q) acc[q] = (f32x4){0.f, 0.f, 0.f, 0.f};
#pragma unroll 4
            for (int s = 0; s < 64; ++s) { const float x = Xw[s * 64 + p];
#pragma unroll
                for (int q = 0; q < 4; ++q) acc[q] += x * *(const f32x4*)(Bs + s * 128 + n0 + 4 * q); }
            float* dst = ST + (((size_t)bc * NH + head) * HP + p) * NS + n0;
#pragma unroll
            for (int q = 0; q < 4; ++q) *(f32x4*)(dst + 4 * q) = acc[q];
        }
    }
}

__device__ __forceinline__ void ph_ssd_scan(float* ST, const float* ACS, int gtid, int nthr) {
    for (int it = gtid; it < BATCH * NH * HP * (NS / 4); it += nthr) {
        const int n4 = it & 31, p = (it >> 5) & 63, head = (it >> 11) & 63, b = it >> 17;
        f32x4 h = (f32x4){0.f, 0.f, 0.f, 0.f};
        for (int c = 0; c < 64; ++c) { f32x4* q = (f32x4*)(ST + ((((size_t)(b * 64 + c)) * NH + head) * HP + p) * NS) + n4;
            const f32x4 v = *q; *q = h; const float dec = __expf(ACS[((b * 64 + c) * 64 + 63) * NH + head]); h = h * dec + v; }
    }
}

__device__ __forceinline__ void ph_ssd_out(const bf16* XC, const bf16* P, const float* DT, const float* ACS, const float* ST, const float* dskip, const float* gnorm, bf16* Y,
                                           float* lds, int blk, int nblk, int tid) {
    constexpr int LP = 132;
    float* Cs = lds;
    float* Bs = lds + 64 * LP;
    float* CB = lds + 2 * 64 * LP;
    float* Ls = CB + 64 * 65;
    float* Xs = Ls + 64 * 65;
    float* acsS = Xs + 64 * 64;
    float* dtS = acsS + 64;
    for (int item = blk; item < BATCH * 64 * NG; item += nblk) {
        const int bc = item >> 3, g = item & 7, m0 = bc * 64;
        __syncthreads();
        { const int e = tid * 16, s = e >> 7, n = e & 127; const bf16* srcB = XC + (size_t)(m0 + s) * CONVD + DI + g * NS + n; const bf16* srcC = srcB + NG * NS;
          float f[8];
          unpack8(*(const u32x4*)srcB, f);
#pragma unroll
          for (int j = 0; j < 8; ++j) Bs[s * LP + n + j] = f[j];
          unpack8(*(const u32x4*)(srcB + 8), f);
#pragma unroll
          for (int j = 0; j < 8; ++j) Bs[s * LP + n + 8 + j] = f[j];
          unpack8(*(const u32x4*)srcC, f);
#pragma unroll
          for (int j = 0; j < 8; ++j) Cs[s * LP + n + j] = f[j];
          unpack8(*(const u32x4*)(srcC + 8), f);
#pragma unroll
          for (int j = 0; j < 8; ++j) Cs[s * LP + n + 8 + j] = f[j]; }
        __syncthreads();
        const int l = tid >> 3, p0 = (tid & 7) * 8;
        { float a[8];
#pragma unroll
          for (int i = 0; i < 8; ++i) a[i] = 0.f;
#pragma unroll 2
          for (int n = 0; n < NS; n += 4) { const f32x4 c4 = *(const f32x4*)(Cs + l * LP + n);
#pragma unroll
              for (int i = 0; i < 8; ++i) { const f32x4 b4 = *(const f32x4*)(Bs + (p0 + i) * LP + n); a[i] += (c4.x * b4.x + c4.y * b4.y) + (c4.z * b4.z + c4.w * b4.w); } }
#pragma unroll
          for (int i = 0; i < 8; ++i) CB[l * 65 + p0 + i] = a[i]; }
        float ssq = 0.f;
#pragma unroll 1
        for (int r = 0; r < HPG; ++r) {
            const int head = g * HPG + r;
            __syncthreads();
            if (tid < 64) { acsS[tid] = ACS[(m0 + tid) * NH + head]; dtS[tid] = DT[(m0 + tid) * NH + head]; }
            { const int e = tid * 8, s = e >> 6, p = e & 63; float f[8]; unpack8(*(const u32x4*)(XC + (size_t)(m0 + s) * CONVD + head * HP + p), f);
#pragma unroll
              for (int j = 0; j < 8; ++j) Xs[e + j] = f[j]; }
            { const int e = tid * 16, p = e >> 7, n = e & 127; const float* src = ST + (((size_t)bc * NH + head) * HP + p) * NS + n;
#pragma unroll
              for (int q = 0; q < 4; ++q) *(f32x4*)(Bs + p * LP + n + 4 * q) = *(const f32x4*)(src + 4 * q); }
            __syncthreads();
            { const float al = acsS[l];
#pragma unroll
              for (int i = 0; i < 8; ++i) { const int s = p0 + i; Ls[l * 65 + s] = (s <= l) ? CB[l * 65 + s] * __expf(al - acsS[s]) * dtS[s] : 0.f; } }
            __syncthreads();
            float acc[8], acc2[8];
#pragma unroll
            for (int i = 0; i < 8; ++i) { acc[i] = 0.f; acc2[i] = 0.f; }
#pragma unroll 2
            for (int s = 0; s < 64; ++s) { const float w = Ls[l * 65 + s]; const f32x4 x0 = *(const f32x4*)(Xs + s * 64 + p0), x1 = *(const f32x4*)(Xs + s * 64 + p0 + 4);
                acc[0] += w * x0.x; acc[1] += w * x0.y; acc[2] += w * x0.z; acc[3] += w * x0.w; acc[4] += w * x1.x; acc[5] += w * x1.y; acc[6] += w * x1.z; acc[7] += w * x1.w; }
#pragma unroll 2
            for (int n = 0; n < NS; n += 4) { const f32x4 c4 = *(const f32x4*)(Cs + l * LP + n);
#pragma unroll
                for (int i = 0; i < 8; ++i) { const f32x4 h4 = *(const f32x4*)(Bs + (p0 + i) * LP + n); acc2[i] += (c4.x * h4.x + c4.y * h4.y) + (c4.z * h4.z + c4.w * h4.w); } }
            const float el = __expf(acsS[l]), dk = dskip[head];
            float z[8]; unpack8(*(const u32x4*)(P + (size_t)(m0 + l) * NMAIN + PZ + head * HP + p0), z);
            float o[8];
#pragma unroll
            for (int i = 0; i < 8; ++i) { float y = acc[i] + el * acc2[i] + dk * Xs[l * 64 + p0 + i]; y *= siluf_(z[i]); o[i] = y; ssq += y * y; }
            *(u32x4*)(Y + (size_t)(m0 + l) * DI + head * HP + p0) = pack8(o);
        }
        ssq += __shfl_xor(ssq, 1); ssq += __shfl_xor(ssq, 2); ssq += __shfl_xor(ssq, 4);
        const float rstd = rsqrtf(ssq * (1.0f / (HPG * HP)) + EPS);
#pragma unroll 1
        for (int r = 0; r < HPG; ++r) { const int ch = (g * HPG + r) * HP + p0; const f32x4 g0 = *(const f32x4*)(gnorm + ch), g1 = *(const f32x4*)(gnorm + ch + 4);
            float o[8]; unpack8(*(const u32x4*)(Y + (size_t)(m0 + l) * DI + ch), o);
            o[0] *= rstd * g0.x; o[1] *= rstd * g0.y; o[2] *= rstd * g0.z; o[3] *= rstd * g0.w; o[4] *= rstd * g1.x; o[5] *= rstd * g1.y; o[6] *= rstd * g1.z; o[7] *= rstd * g1.w;
            *(u32x4*)(Y + (size_t)(m0 + l) * DI + ch) = pack8(o); }
    }
}

__device__ __forceinline__ float gelu_tanhf_(float x) { const float u = 0.7978845608028654f * (x + 0.044715f * x * x * x); const float t = 1.0f - 2.0f / (1.0f + __expf(2.0f * u)); return 0.5f * x * (1.0f + t); }
__device__ __forceinline__ void ph_ffn_act(const bf16* U, const float* cw, const float* cb, bf16* ACT, int gtid, int nthr) {
    constexpr int NCG = FF / 8;
    for (int it = gtid; it < M * NCG; it += nthr) {
        const int m = it / NCG, c0 = (it % NCG) * 8, t = m & (SEQ - 1);
        float ag[8], av[8];
        { const f32x4 b0 = *(const f32x4*)(cb + c0), b1 = *(const f32x4*)(cb + c0 + 4), d0 = *(const f32x4*)(cb + FF + c0), d1 = *(const f32x4*)(cb + FF + c0 + 4);
          ag[0] = b0.x; ag[1] = b0.y; ag[2] = b0.z; ag[3] = b0.w; ag[4] = b1.x; ag[5] = b1.y; ag[6] = b1.z; ag[7] = b1.w;
          av[0] = d0.x; av[1] = d0.y; av[2] = d0.z; av[3] = d0.w; av[4] = d1.x; av[5] = d1.y; av[6] = d1.z; av[7] = d1.w; }
#pragma unroll
        for (int i = 0; i < 3; ++i) { if (t - 2 + i >= 0) {
            const bf16* ur = U + (size_t)(m - 2 + i) * FF2 + c0; float xg[8], xv[8]; unpack8(*(const u32x4*)ur, xg); unpack8(*(const u32x4*)(ur + FF), xv);
            const float* wg = cw + i * FF2 + c0; const float* wv = wg + FF;
#pragma unroll
            for (int j = 0; j < 8; ++j) { ag[j] += wg[j] * xg[j]; av[j] += wv[j] * xv[j]; } } }
        float o[8];
#pragma unroll
        for (int j = 0; j < 8; ++j) o[j] = gelu_tanhf_(ag[j]) * av[j];
        *(u32x4*)(ACT + (size_t)m * FF + c0) = pack8(o);
    }
}

struct Args { const float* in[20]; float* out; unsigned char* ws; int ph_lo, ph_hi; };
constexpr int NP = 12, NPHASE = 1 + DEPTH * NP;

__global__ void __launch_bounds__(NTHR, 2) fwd(Args args) {
    extern __shared__ __attribute__((aligned(16))) unsigned char lds[];
    const int G = gridDim.x, blk = blockIdx.x;
    volatile LAS unsigned* MISC = (volatile LAS unsigned*)((LAS unsigned char*)lds + MISC_OFF);
    for (int u = threadIdx.x; u < (LDS_BYTES - LDSCTL_OFF) / 4; u += NTHR) ((LAS unsigned*)((LAS unsigned char*)lds + LDSCTL_OFF))[u] = 0u;
    __syncthreads();
    XcdBarrier bar; bar.bar = (unsigned*)(args.ws + WS_CTL) + CW_BAR; bar.x = 0; bar.st = nullptr;
    if (!MK_PER_PHASE) bar = xcd_barrier_post((unsigned*)(args.ws + WS_CTL) + CW_BAR, MISC + 8);
    const int lo = args.ph_lo, hi = args.ph_hi;
#define IN(k) (lo <= (k) && (k) < hi)
#define SEAM(k) do { if (IN(k) && IN((k) + 1)) xcd_barrier(bar); } while (0)
#define PH_BEGIN \
    int tid = threadIdx.x; asm volatile("" : "+v"(tid)); \
    const int lane = tid & 63, wave = __builtin_amdgcn_readfirstlane(tid >> 6); \
    const int gw = blk * NWAVES + wave, ngw = G * NWAVES, gtid = blk * NTHR + tid, nthr = G * NTHR; \
    unsigned char* ws = args.ws; asm volatile("" : "+s"(ws)); \
    LAS unsigned char* ring = (LAS unsigned char*)lds; \
    (void)lane; (void)wave; (void)gw; (void)ngw; (void)gtid; (void)nthr; (void)ring; \
    float* X = args.out; \
    bf16* H = (bf16*)(ws + WS_H); bf16* P = (bf16*)(ws + WS_P); float* SM = (float*)(ws + WS_SM); bf16* XC = (bf16*)(ws + WS_XC); \
    float* DT = (float*)(ws + WS_DT); float* ACS = (float*)(ws + WS_ACS); float* ST = (float*)(ws + WS_ST); bf16* Y = (bf16*)(ws + WS_Y); \
    float* SC = (float*)(ws + WS_SC); int* IDX = (int*)(ws + WS_IDX); int* CNT = (int*)(ws + WS_CNT); bf16* AO = (bf16*)(ws + WS_AO); \
    float* MG = (float*)(ws + WS_MG); bf16* MGB = (bf16*)(ws + WS_MGB); float* YM = (float*)(ws + WS_YM); bf16* U = (bf16*)(ws + WS_U); \
    bf16* ACT = (bf16*)(ws + WS_ACT); bf16* KIB = (bf16*)(ws + WS_KIB); \
    (void)X; (void)H; (void)P; (void)SM; (void)XC; (void)DT; (void)ACS; (void)ST; (void)Y; (void)SC; (void)IDX; (void)CNT; (void)AO; (void)MG; (void)MGB; (void)YM; (void)U; (void)ACT; (void)KIB;

    if (IN(0)) { PH_BEGIN
        WPtrs wp{args.in[5], args.in[13], args.in[14], args.in[15], args.in[16], args.in[19]};
        ph_weights(wp, ws, (float*)lds + wave * 2176, gw, ngw, lane);
        ph_resid_norm(nullptr, nullptr, args.in[1], args.in[0], X, H, gw, ngw, lane);
    }
    SEAM(0);

#pragma unroll 1
    for (int layer = 0; layer < DEPTH; ++layer) {
        const int pb = 1 + layer * NP;
#define WL (ws + WS_W + (size_t)layer * WL_SIZE)
        if (IN(pb + 0)) { PH_BEGIN
            pg8::Gemm g{H, (const bf16*)(WL + WL_IN), M, NPAD, D}; pg8::StaticOrder S; S.init(M, NPAD, G, blk);
            pg8::EpiIn E{P, NMAIN, SM, args.in[6] + (size_t)layer * 2 * D, PG / 256, NMAIN / 256};
            pg8::gemm_phase<pg8::EpiIn, pg8::StaticOrder, true, true>(ring, g, S, E);
        }
        SEAM(pb + 0);
        if (IN(pb + 1)) { PH_BEGIN
            ph_conv_dt(P, SM, args.in[7] + (size_t)layer * 4 * CONVD, args.in[8] + (size_t)layer * CONVD, args.in[9] + layer * NH, args.in[10] + layer * NH, XC, DT, ACS, KIB, gtid, nthr); }
        SEAM(pb + 1);
        if (IN(pb + 2)) { PH_BEGIN
            ph_ssd_states(XC, DT, ACS, ST, (float*)lds, blk, G, tid); ph_index_scores(P, SM, KIB, SC, blk, G, wave, lane); }
        SEAM(pb + 2);
        if (IN(pb + 3)) { PH_BEGIN
            ph_ssd_scan(ST, ACS, gtid, nthr); ph_topk(SC, IDX, CNT, gw, ngw, lane); }
        SEAM(pb + 3);
        if (IN(pb + 4)) { PH_BEGIN
            ph_ssd_out(XC, P, DT, ACS, ST, args.in[11] + layer * NH, args.in[12] + (size_t)layer * DI, Y, (float*)lds, blk, G, tid);
            __syncthreads(); ph_sparse_attn(P, IDX, CNT, AO, (float*)lds + wave * 1792, gw, ngw, lane); __syncthreads(); }
        SEAM(pb + 4);
        if (IN(pb + 5)) {
            { PH_BEGIN
              pg8::Gemm g{Y, (const bf16*)(WL + WL_SSM), M, D, DI}; pg8::StaticOrder S; S.init(M, D, G, blk);
              pg8::EpiGateMul E{MG, D, P + PG, NMAIN}; pg8::gemm_phase<pg8::EpiGateMul, pg8::StaticOrder, false, true>(ring, g, S, E); }
            __syncthreads();
            { PH_BEGIN
              pg8::Gemm g{AO, (const bf16*)(WL + WL_ATT), M, D, D}; pg8::StaticOrder S; S.init(M, D, G, blk);
              pg8::EpiGateAdd E{MG, MGB, D, P + PG + D, NMAIN}; pg8::gemm_phase<pg8::EpiGateAdd, pg8::StaticOrder, false, true>(ring, g, S, E); }
        }
        SEAM(pb + 5);
        if (IN(pb + 6)) { PH_BEGIN
            pg8::Gemm g{MGB, (const bf16*)(WL + WL_MIX), M, D, D}; pg8::StaticOrder S; S.init(M, D, G, blk);
            pg8::EpiF32 E{YM, D}; pg8::gemm_phase<pg8::EpiF32, pg8::StaticOrder, false, true>(ring, g, S, E); }
        SEAM(pb + 6);
        if (IN(pb + 7)) { PH_BEGIN
            ph_resid_norm(YM, args.in[2] + (size_t)layer * D, args.in[3] + (size_t)layer * D, X, X, H, gw, ngw, lane); }
        SEAM(pb + 7);
        if (IN(pb + 8)) { PH_BEGIN
            pg8::Gemm g{H, (const bf16*)(WL + WL_UP), M, FF2, D}; pg8::StaticOrder S; S.init(M, FF2, G, blk);
            pg8::EpiBf16<0> E{U, FF2, nullptr, 0, 0, 1.f}; pg8::gemm_phase<pg8::EpiBf16<0>, pg8::StaticOrder, true, true>(ring, g, S, E); }
        SEAM(pb + 8);
        if (IN(pb + 9)) { PH_BEGIN
            ph_ffn_act(U, args.in[17] + (size_t)layer * 3 * FF2, args.in[18] + (size_t)layer * FF2, ACT, gtid, nthr); }
        SEAM(pb + 9);
        if (IN(pb + 10)) { PH_BEGIN
            pg8::Gemm g{ACT, (const bf16*)(WL + WL_DN), M, D, FF}; pg8::StaticOrder S; S.init(M, D, G, blk);
            pg8::EpiF32 E{YM, D}; pg8::gemm_phase<pg8::EpiF32, pg8::StaticOrder, false, true>(ring, g, S, E); }
        SEAM(pb + 10);
        if (IN(pb + 11)) { PH_BEGIN
            ph_resid_norm(YM, args.in[4] + (size_t)layer * D, layer + 1 < DEPTH ? args.in[1] + (size_t)(layer + 1) * D : nullptr, X, X, H, gw, ngw, lane); }
        SEAM(pb + 11);
    }
#undef IN
#undef SEAM
#undef WL
#undef PH_BEGIN
}

extern "C" void kernel_launch(void* const* d_in, const int* in_sizes, int n_in, void* d_out, int out_size, void* d_ws, size_t ws_size, hipStream_t stream) {
    static int grid = 0;
    if (grid == 0) {
        if (n_in != 20 || in_sizes[0] != M * D || out_size != M * D || ws_size < WS_END) { fprintf(stderr, "kernel_launch: unexpected shapes (n_in %d, in0 %d, out %d, ws %zu < %zu)\n", n_in, n_in > 0 ? in_sizes[0] : -1, out_size, ws_size, (size_t)WS_END); grid = -1; return; }
        int dev = 0, cus = 0, per_cu = 0;
        if (hipGetDevice(&dev) != hipSuccess || hipDeviceGetAttribute(&cus, hipDeviceAttributeMultiprocessorCount, dev) != hipSuccess) { grid = -1; return; }
        if (hipFuncSetAttribute((const void*)fwd, hipFuncAttributeMaxDynamicSharedMemorySize, LDS_BYTES) != hipSuccess) { fprintf(stderr, "kernel_launch: hipFuncSetAttribute failed\n"); grid = -1; return; }
        if (hipOccupancyMaxActiveBlocksPerMultiprocessor(&per_cu, (const void*)fwd, NTHR, LDS_BYTES) != hipSuccess || per_cu < 1) fprintf(stderr, "kernel_launch: occupancy query reports %d blocks per CU\n", per_cu);
        (void)hipGetLastError();
        grid = cus;
    }
    if (grid < 0) return;
    if (hipMemsetAsync((char*)d_ws + WS_CTL, 0, CTL_ZERO_BYTES, stream) != hipSuccess) return;
    Args a{};
    for (int i = 0; i < 20; ++i) a.in[i] = (const float*)d_in[i];
    a.out = (float*)d_out; a.ws = (unsigned char*)d_ws;
#if MK_PER_PHASE
    for (int ph = 0; ph < NPHASE; ++ph) { a.ph_lo = ph; a.ph_hi = ph + 1; hipLaunchKernelGGL(fwd, dim3(grid), dim3(NTHR), LDS_BYTES, stream, a); }
#else
    a.ph_lo = 0; a.ph_hi = NPHASE; hipLaunchKernelGGL(fwd, dim3(grid), dim3(NTHR), LDS_BYTES, stream, a);
#endif
}
```

```cpp
#include <hip/hip_runtime.h>
#include <cstdio>
#include <cstdint>
#define MK_PER_PHASE 0
namespace pg8 {
#define PG8_LAS __attribute__((address_space(3)))
typedef unsigned short bf16_t;
typedef short bf16x8 __attribute__((ext_vector_type(8)));
typedef float f32x4 __attribute__((ext_vector_type(4)));
typedef unsigned u32x4 __attribute__((ext_vector_type(4)));
constexpr int BM = 256, BK = 64, HALF = 128, HTB = HALF * BK * 2  , STAGE_BYTES = 8 * HTB, NXCD = 8, WGM = 8;

__host__ __device__ __forceinline__ int lds_byte(int r, int c) { const int st = (r >> 4) * 2 + (c >> 5), rr = r & 15, cc = c & 31, ob = rr * 64 + cc * 2; return st * 1024 + (ob ^ (((ob >> 9) & 1) << 5)); }
__host__ __device__ __forceinline__ void stage_rc(int b, int& R, int& C) { const int st = b / 1024, sb = b % 1024, swz = sb ^ (((sb >> 9) & 1) << 5); R = (st >> 1) * 16 + swz / 64; C = (st & 1) * 32 + (swz % 64) / 2; }
__host__ __device__ __forceinline__ int perm32(int rho) { const int n = rho >> 4, i = rho & 15; return 8 * (i >> 2) + 4 * n + (i & 3); }

struct Unit { int pm, pn; };
struct Gemm { const bf16_t* A; const bf16_t* Bt; int M, N, K; };

struct StaticOrder {
    int nM, nN, nwg, G, c;
    __host__ __device__ void init(int M, int N, int G_, int c_) { nM = M / BM; nN = N / BM; nwg = nM * nN; G = G_; c = c_; }
    __host__ __device__ bool next(int i, Unit& u) const {
        const long L = (long)i * G + c; if (L >= nwg) return false;
        int wgid = (int)L; { const int q = nwg / NXCD, r = nwg % NXCD, xcd = wgid % NXCD, off = wgid / NXCD; wgid = (xcd < r ? xcd * (q + 1) : r * (q + 1) + (xcd - r) * q) + off; }
        const int nig = WGM * nN, gid = wgid / nig, fm = gid * WGM, gsz = (nM - fm) < WGM ? (nM - fm) : WGM;
        u.pm = fm + ((wgid % nig) % gsz); u.pn = (wgid % nig) / gsz; return true;
    }
    __device__ __forceinline__ void a_ready(const Unit&) const {}
    __device__ __forceinline__ void done(const Unit&) const {}
};

__device__ __forceinline__ unsigned cvt_pk_bf16(float lo, float hi) { unsigned r; asm volatile("v_cvt_pk_bf16_f32 %0, %1, %2" : "=v"(r) : "v"(lo), "v"(hi)); return r; }
typedef float f32x2 __attribute__((ext_vector_type(2)));
__device__ __forceinline__ f32x2 gelu_pk(f32x2 v) {
    const f32x2 av = __builtin_elementwise_abs(v), d = av * 0.2316418882f + 1.0f;
    f32x2 t; t.x = __builtin_amdgcn_rcpf(d.x); t.y = __builtin_amdgcn_rcpf(d.y);
    f32x2 q = t * 0.5307027145f + (-0.7265760135f); q = q * t + 0.7107068705f; q = q * t + (-0.142248368f); q = q * t + 0.127414796f; q = q * t;
    const f32x2 s = (v * v) * (-0.72134752044f);
    f32x2 e; e.x = __builtin_amdgcn_exp2f(s.x); e.y = __builtin_amdgcn_exp2f(s.y);
    const f32x2 m = v * (q * e), r = v - m;
    f32x2 o; o.x = v.x < 0.f ? m.x : r.x; o.y = v.y < 0.f ? m.y : r.y; return o;
}

template <int ACT  > struct EpiBf16 {
    static constexpr bool PERM = true, AFTER_DRAIN = false; static_assert(ACT == 0 || ACT == 1, "EpiBf16: ACT is 0 (none) or 1 (gelu_pk)");
    bf16_t* O; int ldc; const float* bias; int split_cols; size_t split_stride; float scale0;
    __device__ __forceinline__ void operator()(const f32x4 (&acc)[2][2][4][2], const Unit& u, int wr, int wc, int fr, int fq) const {
        const int row0 = u.pm * BM + wr * 64 + fr; int colt = u.pn * BM; bf16_t* base = O;
        float sc = 1.f; if (split_cols) { const int t = colt / split_cols; base += (size_t)t * split_stride; colt -= t * split_cols; if (t == 0) sc = scale0; }
        const int col0 = colt + wc * 32 + 8 * fq, bcol0 = u.pn * BM + wc * 32 + 8 * fq;
        f32x4 bv[2][2];
#pragma unroll
        for (int bj = 0; bj < 2; ++bj)
#pragma unroll
            for (int n = 0; n < 2; ++n) bv[bj][n] = bias ? *(const f32x4*)(bias + bcol0 + bj * HALF + 4 * n) : (f32x4){0.f, 0.f, 0.f, 0.f};
#pragma unroll
        for (int ai = 0; ai < 2; ++ai)
#pragma unroll
            for (int m = 0; m < 4; ++m) { bf16_t* rowp = base + (size_t)(row0 + ai * HALF + m * 16) * ldc + col0;
#pragma unroll
                for (int bj = 0; bj < 2; ++bj) { f32x4 v0 = acc[ai][bj][m][0] + bv[bj][0], v1 = acc[ai][bj][m][1] + bv[bj][1];
                    if (ACT == 1) { f32x2 a = gelu_pk((f32x2){v0[0], v0[1]}), b = gelu_pk((f32x2){v0[2], v0[3]}), c = gelu_pk((f32x2){v1[0], v1[1]}), d = gelu_pk((f32x2){v1[2], v1[3]});
                        v0 = (f32x4){a.x, a.y, b.x, b.y}; v1 = (f32x4){c.x, c.y, d.x, d.y}; }
                    v0 = v0 * sc; v1 = v1 * sc; u32x4 w; w.x = cvt_pk_bf16(v0[0], v0[1]); w.y = cvt_pk_bf16(v0[2], v0[3]); w.z = cvt_pk_bf16(v1[0], v1[1]); w.w = cvt_pk_bf16(v1[2], v1[3]);
                    *(u32x4*)(rowp + bj * HALF) = w; } }
    }
};

struct EpiF32 {
    static constexpr bool PERM = false, AFTER_DRAIN = false;
    float* C; int ldc;
    __device__ __forceinline__ void operator()(const f32x4 (&acc)[2][2][4][2], const Unit& u, int wr, int wc, int fr, int fq) const {
        const int row0 = u.pm * BM + wr * 64 + fr, col0 = u.pn * BM + wc * 32 + 4 * fq;
#pragma unroll
        for (int ai = 0; ai < 2; ++ai)
#pragma unroll
            for (int m = 0; m < 4; ++m) { float* rowp = C + (size_t)(row0 + ai * HALF + m * 16) * ldc + col0;
#pragma unroll
                for (int bj = 0; bj < 2; ++bj)
#pragma unroll
                    for (int n = 0; n < 2; ++n) *(f32x4*)(rowp + bj * HALF + n * 16) = acc[ai][bj][m][n]; }
    }
};
__device__ __forceinline__ float bf_lo(unsigned w) { return __uint_as_float(w << 16); }
__device__ __forceinline__ float bf_hi(unsigned w) { return __uint_as_float(w & 0xffff0000u); }
__device__ __forceinline__ float sigmoidf_(float x) { return __builtin_amdgcn_rcpf(1.0f + __expf(-x)); }
struct EpiIn {
    static constexpr bool PERM = true, AFTER_DRAIN = false;
    bf16_t* P; int ldp; float* SM; const float* bgate; int gate_tile0, small_tile;
    __device__ __forceinline__ void operator()(const f32x4 (&acc)[2][2][4][2], const Unit& u, int wr, int wc, int fr, int fq) const {
        const int row0 = u.pm * BM + wr * 64 + fr, colt = u.pn * BM + wc * 32 + 8 * fq;
        if (u.pn < small_tile) {
            const bool gate = u.pn >= gate_tile0;
            f32x4 bv[2][2];
#pragma unroll
            for (int bj = 0; bj < 2; ++bj)
#pragma unroll
                for (int n = 0; n < 2; ++n) bv[bj][n] = gate ? *(const f32x4*)(bgate + (colt - gate_tile0 * BM) + bj * HALF + 4 * n) : (f32x4){0.f, 0.f, 0.f, 0.f};
#pragma unroll
            for (int ai = 0; ai < 2; ++ai)
#pragma unroll
                for (int m = 0; m < 4; ++m) { bf16_t* rowp = P + (size_t)(row0 + ai * HALF + m * 16) * ldp + colt;
#pragma unroll
                    for (int bj = 0; bj < 2; ++bj) { f32x4 v0 = acc[ai][bj][m][0] + bv[bj][0], v1 = acc[ai][bj][m][1] + bv[bj][1];
                        if (gate) {
#pragma unroll
                            for (int j = 0; j < 4; ++j) { v0[j] = sigmoidf_(v0[j]); v1[j] = sigmoidf_(v1[j]); } }
                        u32x4 w; w.x = cvt_pk_bf16(v0[0], v0[1]); w.y = cvt_pk_bf16(v0[2], v0[3]); w.z = cvt_pk_bf16(v1[0], v1[1]); w.w = cvt_pk_bf16(v1[2], v1[3]);
                        *(u32x4*)(rowp + bj * HALF) = w; } }
        } else {
            const int c0 = wc * 32 + 8 * fq;
#pragma unroll
            for (int ai = 0; ai < 2; ++ai)
#pragma unroll
                for (int m = 0; m < 4; ++m) { float* rowp = SM + (size_t)(row0 + ai * HALF + m * 16) * BM + c0;
#pragma unroll
                    for (int bj = 0; bj < 2; ++bj) { *(f32x4*)(rowp + bj * HALF) = acc[ai][bj][m][0]; *(f32x4*)(rowp + bj * HALF + 4) = acc[ai][bj][m][1]; } }
        }
    }
};
struct EpiGateMul {
    static constexpr bool PERM = true, AFTER_DRAIN = false;
    float* MG; int ldc; const bf16_t* G; int ldg;
    __device__ __forceinline__ void operator()(const f32x4 (&acc)[2][2][4][2], const Unit& u, int wr, int wc, int fr, int fq) const {
        const int row0 = u.pm * BM + wr * 64 + fr, colt = u.pn * BM + wc * 32 + 8 * fq;
#pragma unroll
        for (int ai = 0; ai < 2; ++ai)
#pragma unroll
            for (int m = 0; m < 4; ++m) { const size_t row = (size_t)(row0 + ai * HALF + m * 16);
#pragma unroll
                for (int bj = 0; bj < 2; ++bj) { const u32x4 g = *(const u32x4*)(G + row * ldg + colt + bj * HALF);
                    f32x4 v0 = acc[ai][bj][m][0], v1 = acc[ai][bj][m][1];
                    v0[0] *= bf_lo(g.x); v0[1] *= bf_hi(g.x); v0[2] *= bf_lo(g.y); v0[3] *= bf_hi(g.y);
                    v1[0] *= bf_lo(g.z); v1[1] *= bf_hi(g.z); v1[2] *= bf_lo(g.w); v1[3] *= bf_hi(g.w);
                    float* o = MG + row * ldc + colt + bj * HALF; *(f32x4*)o = v0; *(f32x4*)(o + 4) = v1; } }
    }
};
struct EpiGateAdd {
    static constexpr bool PERM = true, AFTER_DRAIN = false;
    const float* MG; bf16_t* O; int ldc; const bf16_t* G; int ldg;
    __device__ __forceinline__ void operator()(const f32x4 (&acc)[2][2][4][2], const Unit& u, int wr, int wc, int fr, int fq) const {
        const int row0 = u.pm * BM + wr * 64 + fr, colt = u.pn * BM + wc * 32 + 8 * fq;
#pragma unroll
        for (int ai = 0; ai < 2; ++ai)
#pragma unroll
            for (int m = 0; m < 4; ++m) { const size_t row = (size_t)(row0 + ai * HALF + m * 16);
#pragma unroll
                for (int bj = 0; bj < 2; ++bj) { const u32x4 g = *(const u32x4*)(G + row * ldg + colt + bj * HALF);
                    const float* mi = MG + row * ldc + colt + bj * HALF; f32x4 v0 = *(const f32x4*)mi, v1 = *(const f32x4*)(mi + 4);
                    const f32x4 a0 = acc[ai][bj][m][0], a1 = acc[ai][bj][m][1];
                    v0[0] += a0[0] * bf_lo(g.x); v0[1] += a0[1] * bf_hi(g.x); v0[2] += a0[2] * bf_lo(g.y); v0[3] += a0[3] * bf_hi(g.y);
                    v1[0] += a1[0] * bf_lo(g.z); v1[1] += a1[1] * bf_hi(g.z); v1[2] += a1[2] * bf_lo(g.w); v1[3] += a1[3] * bf_hi(g.w);
                    u32x4 w; w.x = cvt_pk_bf16(v0[0], v0[1]); w.y = cvt_pk_bf16(v0[2], v0[3]); w.z = cvt_pk_bf16(v1[0], v1[1]); w.w = cvt_pk_bf16(v1[2], v1[3]);
                    *(u32x4*)(O + row * ldc + colt + bj * HALF) = w; } }
    }
};
template <class Epi, class Sched, bool ALIGN_EPI = false, bool SP2 = false>
__device__ __forceinline__ void gemm_phase(PG8_LAS unsigned char* lds, const Gemm g, const Sched& S, const Epi& E) {
    int tid = threadIdx.x; asm volatile("" : "+v"(tid));
    const int wid = __builtin_amdgcn_readfirstlane(tid >> 6), lane = tid & 63, wr = wid >> 2, wc = wid & 3, fr = lane & 15, fq = lane >> 4;
    const int K = g.K, nt = K / BK;
    unsigned voffA[2], voffB[2];
#pragma unroll
    for (int i = 0; i < 2; ++i) { int R, C; stage_rc(tid * 16 + i * 8192, R, C); const int Rb = Epi::PERM ? ((R & ~31) + perm32(R & 31)) : R;
        voffA[i] = (unsigned)(R * K + C) * 2u; voffB[i] = (unsigned)(Rb * K + C) * 2u; }
    const size_t kstep = (size_t)(BK * 2);
    const size_t hstep = (size_t)HALF * K * 2;
    const size_t tstep = 2 * hstep;
    const unsigned ldsw = (unsigned)wid * 1024u;
    const int aoff = lds_byte(wr * 64 + fr, fq * 8), boff = lds_byte(wc * 32 + fr, fq * 8);
#define PG8_SA(b, h) (((b) * 2 + (h)) * HTB)
#define PG8_SB(b, h) ((4 + (b) * 2 + (h)) * HTB)
#define PG8_STAGE(bufoff, gbase, voff) do { _Pragma("unroll") for (int _i = 0; _i < 2; ++_i) \
        __builtin_amdgcn_global_load_lds((const unsigned*)((const char*)(gbase) + (voff)[_i]), (PG8_LAS unsigned*)(lds + (bufoff) + ldsw + _i * 8192), 16, 0, 0); } while (0)
#define PG8_LDA(dst, b, h) do { _Pragma("unroll") for (int m = 0; m < 4; ++m) _Pragma("unroll") for (int k = 0; k < 2; ++k) dst[m][k] = *(const PG8_LAS bf16x8*)(lds + PG8_SA(b, h) + aoff + m * 2048 + k * 1024); } while (0)
#define PG8_LDB(dst, b, h) do { _Pragma("unroll") for (int n = 0; n < 2; ++n) _Pragma("unroll") for (int k = 0; k < 2; ++k) dst[n][k] = *(const PG8_LAS bf16x8*)(lds + PG8_SB(b, h) + boff + n * 2048 + k * 1024); } while (0)
#define PG8_MMA(ai, bj, At, Bt) do { __builtin_amdgcn_s_setprio(1); _Pragma("unroll") for (int m = 0; m < 4; ++m) _Pragma("unroll") for (int n = 0; n < 2; ++n) _Pragma("unroll") for (int k = 0; k < 2; ++k) \
        acc[ai][bj][m][n] = __builtin_amdgcn_mfma_f32_16x16x32_bf16(Bt[n][k], At[m][k], acc[ai][bj][m][n], 0, 0, 0); __builtin_amdgcn_s_setprio(0); } while (0)
#define PG8_WAIT_V(n) asm volatile("s_waitcnt vmcnt(" #n ")" ::: "memory")
#define PG8_WAIT_L(n) asm volatile("s_waitcnt lgkmcnt(" #n ")" ::: "memory")
#define PG8_BAR __builtin_amdgcn_s_barrier()
#define PG8_SCHED __builtin_amdgcn_sched_barrier(0)
    Unit cur, nxt; int ui = 0;
    if (!S.next(0, cur)) return;
    f32x4 acc[2][2][4][2];
#pragma unroll
    for (int a = 0; a < 2; ++a)
#pragma unroll
        for (int b = 0; b < 2; ++b)
#pragma unroll
            for (int m = 0; m < 4; ++m)
#pragma unroll
                for (int n = 0; n < 2; ++n) acc[a][b][m][n] = (f32x4){0.f, 0.f, 0.f, 0.f};
    bf16x8 At[4][2], B0[2][2], B1[2][2];
    const char* cA = (const char*)g.A + (size_t)cur.pm * tstep; const char* cB = (const char*)g.Bt + (size_t)cur.pn * tstep;
    S.a_ready(cur);
    if constexpr (SP2) {
        PG8_STAGE(PG8_SB(0, 0), cB, voffB); PG8_STAGE(PG8_SB(0, 1), cB + hstep, voffB); PG8_STAGE(PG8_SA(0, 0), cA, voffA); PG8_STAGE(PG8_SA(0, 1), cA + hstep, voffA);
        if (wr == 1) PG8_BAR;
        PG8_WAIT_V(2); PG8_BAR;
        PG8_STAGE(PG8_SB(1, 0), cB + kstep, voffB); PG8_STAGE(PG8_SA(1, 0), cA + kstep, voffA); PG8_STAGE(PG8_SB(1, 1), cB + hstep + kstep, voffB);
        PG8_WAIT_V(6); PG8_BAR;
    } else {
        PG8_STAGE(PG8_SB(0, 0), cB, voffB); PG8_STAGE(PG8_SA(0, 0), cA, voffA); PG8_STAGE(PG8_SB(0, 1), cB + hstep, voffB); PG8_STAGE(PG8_SA(0, 1), cA + hstep, voffA);
        if (wr == 1) PG8_BAR;
        PG8_WAIT_V(4); PG8_BAR;
        PG8_STAGE(PG8_SB(1, 0), cB + kstep, voffB); PG8_STAGE(PG8_SA(1, 0), cA + kstep, voffA); PG8_STAGE(PG8_SB(1, 1), cB + hstep + kstep, voffB);
        PG8_WAIT_V(6); PG8_BAR;
    }
    for (;;) {
        const bool has_next = S.next(ui + 1, nxt);
        const char* nA = has_next ? (const char*)g.A + (size_t)nxt.pm * tstep : cA; const char* nB = has_next ? (const char*)g.Bt + (size_t)nxt.pn * tstep : cB;
        for (int t = 0; t < nt; t += 2) {
            const bool last = (t == nt - 2);
            const char* a1 = cA + (size_t)(t + 1) * kstep;
            const char* a2 = last ? nA : cA + (size_t)(t + 2) * kstep; const char* b2 = last ? nB : cB + (size_t)(t + 2) * kstep;
            const char* a3 = a2 + kstep; const char* b3 = b2 + kstep;
            if (last && has_next) S.a_ready(nxt);
            if constexpr (SP2) {
            PG8_LDB(B0, 0, 0); PG8_LDB(B1, 0, 1); PG8_SCHED; PG8_LDA(At, 0, 0); PG8_STAGE(PG8_SA(1, 1), a1 + hstep, voffA);
            PG8_WAIT_V(8); PG8_WAIT_L(0); PG8_BAR; PG8_MMA(0, 0, At, B0); PG8_MMA(0, 1, At, B1); PG8_BAR; PG8_SCHED;
            PG8_LDA(At, 0, 1); PG8_STAGE(PG8_SB(0, 0), b2, voffB); PG8_STAGE(PG8_SB(0, 1), b2 + hstep, voffB); PG8_STAGE(PG8_SA(0, 0), a2, voffA);
            PG8_WAIT_V(8); PG8_WAIT_L(0); PG8_BAR; PG8_MMA(1, 0, At, B0); PG8_MMA(1, 1, At, B1); PG8_BAR; PG8_SCHED;
            PG8_LDB(B0, 1, 0); PG8_LDB(B1, 1, 1); PG8_SCHED; PG8_LDA(At, 1, 0); PG8_STAGE(PG8_SA(0, 1), a2 + hstep, voffA);
            PG8_WAIT_V(8); PG8_WAIT_L(0); PG8_BAR; PG8_MMA(0, 0, At, B0); PG8_MMA(0, 1, At, B1); PG8_BAR; PG8_SCHED;
            PG8_LDA(At, 1, 1); PG8_STAGE(PG8_SB(1, 0), b3, voffB); PG8_STAGE(PG8_SB(1, 1), b3 + hstep, voffB); PG8_STAGE(PG8_SA(1, 0), a3, voffA);
            PG8_WAIT_V(8); PG8_WAIT_L(0); PG8_BAR; PG8_MMA(1, 0, At, B0); PG8_MMA(1, 1, At, B1); PG8_BAR; PG8_SCHED;
            } else {
            PG8_LDB(B0, 0, 0); PG8_SCHED; PG8_LDA(At, 0, 0); PG8_STAGE(PG8_SA(1, 1), a1 + hstep, voffA);
            PG8_WAIT_L(8); PG8_BAR; PG8_WAIT_L(0); PG8_MMA(0, 0, At, B0); PG8_BAR; PG8_SCHED;
            PG8_LDB(B1, 0, 1); PG8_STAGE(PG8_SB(0, 0), b2, voffB);
            PG8_BAR; PG8_WAIT_L(0); PG8_MMA(0, 1, At, B1); PG8_BAR;
            PG8_LDA(At, 0, 1); PG8_STAGE(PG8_SA(0, 0), a2, voffA);
            PG8_BAR; PG8_WAIT_L(0); PG8_MMA(1, 0, At, B0); PG8_BAR; PG8_SCHED;
            PG8_STAGE(PG8_SB(0, 1), b2 + hstep, voffB);
            PG8_WAIT_V(6); PG8_BAR; PG8_MMA(1, 1, At, B1); PG8_BAR;
            PG8_LDB(B0, 1, 0); PG8_SCHED; PG8_LDA(At, 1, 0); PG8_STAGE(PG8_SA(0, 1), a2 + hstep, voffA);
            PG8_WAIT_L(8); PG8_BAR; PG8_WAIT_L(0); PG8_MMA(0, 0, At, B0); PG8_BAR; PG8_SCHED;
            PG8_LDB(B1, 1, 1); PG8_STAGE(PG8_SB(1, 0), b3, voffB);
            PG8_BAR; PG8_WAIT_L(0); PG8_MMA(0, 1, At, B1); PG8_BAR;
            PG8_LDA(At, 1, 1); PG8_STAGE(PG8_SA(1, 0), a3, voffA);
            PG8_BAR; PG8_WAIT_L(0); PG8_MMA(1, 0, At, B0); PG8_BAR; PG8_SCHED;
            PG8_STAGE(PG8_SB(1, 1), b3 + hstep, voffB);
            PG8_WAIT_V(6); PG8_BAR; PG8_MMA(1, 1, At, B1); PG8_BAR;
            }
        }
        if constexpr (ALIGN_EPI) { if (wr == 0) PG8_BAR; }
        if constexpr (!Epi::AFTER_DRAIN) { E(acc, cur, wr, wc, fr, fq); S.done(cur); }
        if (!has_next) break;
#pragma unroll
        for (int a = 0; a < 2; ++a)
#pragma unroll
            for (int b = 0; b < 2; ++b)
#pragma unroll
                for (int m = 0; m < 4; ++m)
#pragma unroll
                    for (int n = 0; n < 2; ++n) acc[a][b][m][n] = (f32x4){0.f, 0.f, 0.f, 0.f};
        cur = nxt; cA = nA; cB = nB; ++ui;
        if constexpr (ALIGN_EPI) { if (wr == 1) PG8_BAR; }
    }
    PG8_WAIT_V(0);
    if constexpr (!ALIGN_EPI) { if (wr == 0) PG8_BAR; }
    PG8_BAR;
    if constexpr (Epi::AFTER_DRAIN) { E.fused(acc, cur, wr, wc, fr, fq, lds, wid, lane); S.done(cur); }
#undef PG8_SA
#undef PG8_SB
#undef PG8_STAGE
#undef PG8_LDA
#undef PG8_LDB
#undef PG8_MMA
#undef PG8_WAIT_V
#undef PG8_WAIT_L
#undef PG8_BAR
#undef PG8_SCHED
}
}

#ifndef MK_PER_PHASE
#define MK_PER_PHASE 0
#endif
#ifndef PROBE_DOUBLE
#define PROBE_DOUBLE -1
#endif
#define REP(id) for (int rep_ = 0; rep_ < ((PROBE_DOUBLE == (id)) ? 2 : 1); ++rep_)
constexpr int NWAVES = 8, NTHR = 512;
constexpr int BATCH = 2, SEQ = 4096, M = BATCH * SEQ, D = 2048, DEPTH = 4;
constexpr int DI = 4096, NH = 64, HP = 64, NG = 8, HPG = 8, NS = 128, CONVD = 6144;
constexpr int QH = 16, KVH = 4, AD = 128, IH = 16, IDD = 64, TOPK = 256;
constexpr int FF = 4096, FF2 = 8192;
constexpr int NIN = 18576, NMAIN = 18432, NPAD = 18688;
constexpr int PZ = 0, PXBC = 4096, PQ = 10240, PK = 12288, PV = 12800, PQI = 13312, PG = 14336;
constexpr int SMW = 256, SM_DT = 0, SM_KI = 64, SM_WI = 128;
constexpr float EPS = 1e-6f;
constexpr float ATTN_SCALE = 0.08838834764831845f;

constexpr size_t MiB = 1u << 20;
constexpr size_t WS_CTL = 0, CTL_ZERO_BYTES = 1 * MiB;
constexpr size_t WS_W = 2 * MiB;
constexpr size_t WL_IN = 0, WL_SSM = 73 * MiB, WL_ATT = 89 * MiB, WL_MIX = 97 * MiB, WL_UP = 105 * MiB, WL_DN = 137 * MiB, WL_SIZE = 153 * MiB;
constexpr size_t WS_H = WS_W + DEPTH * WL_SIZE;
constexpr size_t WS_P = WS_H + 32 * MiB;
constexpr size_t WS_SM = WS_P + 288 * MiB;
constexpr size_t WS_XC = WS_SM + 8 * MiB;
constexpr size_t WS_DT = WS_XC + 96 * MiB;
constexpr size_t WS_ACS = WS_DT + 2 * MiB;
constexpr size_t WS_ST = WS_ACS + 2 * MiB;
constexpr size_t WS_Y = WS_ST + 256 * MiB;
constexpr size_t WS_SC = WS_Y + 64 * MiB;
constexpr size_t WS_IDX = WS_SC + 128 * MiB;
constexpr size_t WS_CNT = WS_IDX + 8 * MiB;
constexpr size_t WS_AO = WS_CNT + 1 * MiB;
constexpr size_t WS_MG = WS_AO + 32 * MiB;
constexpr size_t WS_MGB = WS_MG + 64 * MiB;
constexpr size_t WS_YM = WS_MGB + 32 * MiB;
constexpr size_t WS_U = WS_YM + 64 * MiB;
constexpr size_t WS_ACT = WS_U + 128 * MiB;
constexpr size_t WS_KIB = WS_ACT + 64 * MiB;
constexpr size_t WS_END = WS_KIB + 1 * MiB;
constexpr int CW_BAR = 4096;

constexpr int RING_BYTES = 131072, LDSCTL_OFF = RING_BYTES, MISC_OFF = LDSCTL_OFF + 320, LDS_BYTES = 147456;

#define LAS __attribute__((address_space(3)))
typedef unsigned short bf16;
typedef float f32x4 __attribute__((ext_vector_type(4)));
typedef short bf16x8 __attribute__((ext_vector_type(8)));
typedef unsigned u32x4 __attribute__((ext_vector_type(4)));
typedef unsigned u32x2 __attribute__((ext_vector_type(2)));
#define LDS_WAIT() asm volatile("s_waitcnt lgkmcnt(0)" ::: "memory")

__device__ __forceinline__ unsigned f2bf(float f) { unsigned u = __builtin_bit_cast(unsigned, f); return (u + 0x7fffu + ((u >> 16) & 1u)) >> 16; }
__device__ __forceinline__ unsigned pk2(float lo, float hi) { return f2bf(lo) | (f2bf(hi) << 16); }
__device__ __forceinline__ float bflo(unsigned w) { return __uint_as_float(w << 16); }
__device__ __forceinline__ float bfhi(unsigned w) { return __uint_as_float(w & 0xffff0000u); }
__device__ __forceinline__ void unpack8(const u32x4 w, float (&f)[8]) { f[0] = bflo(w.x); f[1] = bfhi(w.x); f[2] = bflo(w.y); f[3] = bfhi(w.y); f[4] = bflo(w.z); f[5] = bfhi(w.z); f[6] = bflo(w.w); f[7] = bfhi(w.w); }
__device__ __forceinline__ u32x4 pack8(const float (&f)[8]) { u32x4 w; w.x = pk2(f[0], f[1]); w.y = pk2(f[2], f[3]); w.z = pk2(f[4], f[5]); w.w = pk2(f[6], f[7]); return w; }
__device__ __forceinline__ float wave_sum(float v) {
#pragma unroll
    for (int o = 1; o < 64; o <<= 1) v += __shfl_xor(v, o);
    return v;
}
__device__ __forceinline__ float wave_max(float v) {
#pragma unroll
    for (int o = 1; o < 64; o <<= 1) v = fmaxf(v, __shfl_xor(v, o));
    return v;
}
__device__ __forceinline__ float siluf_(float x) { return x / (1.0f + __expf(-x)); }

#define XB_TMO      128
#define XB_XCNT(j)  (256  + 64 * (j))
#define XB_XSUB(j)  (1280 + 64 * (j))
#define XB_XGEN(j)  (2304 + 64 * (j))
#define XB_TOP      3328
#define XB_TOPGEN   3392
#define XCD_BAR_WORDS 3456
#define XB_SPIN_CAP (1u << 18)

__device__ __forceinline__ unsigned xb_ld(unsigned* p)              { return __hip_atomic_load(p, __ATOMIC_RELAXED, __HIP_MEMORY_SCOPE_AGENT); }
__device__ __forceinline__ unsigned xb_add(unsigned* p, unsigned v) { return __hip_atomic_fetch_add(p, v, __ATOMIC_RELAXED, __HIP_MEMORY_SCOPE_AGENT); }
__device__ __forceinline__ unsigned xb_xcc_id() { return (unsigned)__builtin_amdgcn_s_getreg((3 << 11) | 20) & 0xFu; }
#define XB_SPIN(cond, bar) do { unsigned _sp = 0; while (cond) { __builtin_amdgcn_s_sleep(1); \
    if ((++_sp & 255u) == 0u) { if (xb_ld(&(bar)[XB_TMO])) break; if (_sp > XB_SPIN_CAP) { atomicAdd(&(bar)[XB_TMO], 1u); break; } } } } while (0)

struct XcdBarrier {
    unsigned* bar; unsigned x;
    volatile LAS unsigned* st;
};

__device__ __forceinline__ XcdBarrier xcd_barrier_post(unsigned* bar, volatile LAS unsigned* st) {
    XcdBarrier b; b.bar = bar; b.x = xb_xcc_id(); b.st = st;
    if (threadIdx.x == 0) (void)xb_add(&bar[XB_XCNT(b.x)], 1u);
    return b;
}
__device__ __forceinline__ void xcd_barrier_complete(unsigned* bar, unsigned x, unsigned& nloc, unsigned& nx) {
    const unsigned G = gridDim.x * gridDim.y * gridDim.z;
    unsigned sum, cnt, mine, sp = 0u;
    for (;;) {
        sum = 0u; cnt = 0u; mine = 0u;
#pragma unroll
        for (unsigned j = 0; j < 16; ++j) { const unsigned c = xb_ld(&bar[XB_XCNT(j)]); sum += c; cnt += (c > 0u) ? 1u : 0u; mine = (j == x) ? c : mine; }
        if (sum == G) break;
        __builtin_amdgcn_s_sleep(1);
        if ((++sp & 255u) == 0u) { if (xb_ld(&bar[XB_TMO])) break; if (sp > XB_SPIN_CAP) { atomicAdd(&bar[XB_TMO], 1u); break; } }
    }
    nloc = mine > 0u ? mine : 1u; nx = cnt > 0u ? cnt : 1u;
}

__device__ __forceinline__ void xcd_barrier(const XcdBarrier& b) {
    asm volatile("s_waitcnt vmcnt(0)" ::: "memory");
    __syncthreads();
    if (threadIdx.x == 0) {
        unsigned* bar = b.bar;
        __builtin_amdgcn_s_waitcnt(0);
        unsigned nloc = b.st[0], nx = b.st[1];
        if (nloc == 0u) { xcd_barrier_complete(bar, b.x, nloc, nx); b.st[0] = nloc; b.st[1] = nx; }
        const unsigned old = xb_add(&bar[XB_XSUB(b.x)], 1u);
        const unsigned gen = old / nloc;
        if (old + 1u == (gen + 1u) * nloc) {
            __builtin_amdgcn_fence(__ATOMIC_RELEASE, "agent");
            asm volatile("s_waitcnt vmcnt(0)" ::: "memory");
            const unsigned og = xb_add(&bar[XB_TOP], 1u);
            const unsigned tg = og / nx;
            if (og + 1u == (tg + 1u) * nx) xb_add(&bar[XB_TOPGEN], 1u);
            else XB_SPIN(xb_ld(&bar[XB_TOPGEN]) == tg, bar);
            __builtin_amdgcn_fence(__ATOMIC_ACQUIRE, "agent");
            xb_add(&bar[XB_XGEN(b.x)], 1u);
            asm volatile("s_waitcnt vmcnt(0)" ::: "memory");
        } else {
            XB_SPIN(xb_ld(&bar[XB_XGEN(b.x)]) == gen, bar);
            __builtin_amdgcn_fence(__ATOMIC_ACQUIRE, "agent");
            asm volatile("s_waitcnt vmcnt(0)" ::: "memory");
        }
    }
    __syncthreads();
}


__device__ __forceinline__ void ph_resid_norm(const float* Yin, const float* gpost, const float* gnext, const float* Xin, float* X, bf16* H, int gw, int ngw, int lane) {
    for (int m = gw; m < M; m += ngw) {
        const f32x4* xr = (const f32x4*)(Xin + (size_t)m * D) + lane;
        f32x4 xv[8];
#pragma unroll
        for (int j = 0; j < 8; ++j) xv[j] = xr[64 * j];
        if (Yin) {
            const f32x4* yr = (const f32x4*)(Yin + (size_t)m * D) + lane; f32x4 yv[8]; float ss = 0.f;
#pragma unroll
            for (int j = 0; j < 8; ++j) { yv[j] = yr[64 * j]; ss += (yv[j].x * yv[j].x + yv[j].y * yv[j].y) + (yv[j].z * yv[j].z + yv[j].w * yv[j].w); }
            const float rstd = rsqrtf(wave_sum(ss) * (1.0f / D) + EPS);
#pragma unroll
            for (int j = 0; j < 8; ++j) { const f32x4 g = ((const f32x4*)gpost + lane)[64 * j]; xv[j] = xv[j] + yv[j] * rstd * g; }
        }
        if (Yin || Xin != X) { f32x4* xo = (f32x4*)(X + (size_t)m * D) + lane;
#pragma unroll
            for (int j = 0; j < 8; ++j) xo[64 * j] = xv[j]; }
        if (gnext) {
            float ss = 0.f;
#pragma unroll
            for (int j = 0; j < 8; ++j) ss += (xv[j].x * xv[j].x + xv[j].y * xv[j].y) + (xv[j].z * xv[j].z + xv[j].w * xv[j].w);
            const float rstd = rsqrtf(wave_sum(ss) * (1.0f / D) + EPS);
            u32x2* ho = (u32x2*)(H + (size_t)m * D) + lane;
#pragma unroll
            for (int j = 0; j < 8; ++j) { const f32x4 g = ((const f32x4*)gnext + lane)[64 * j]; const f32x4 h = xv[j] * rstd * g; u32x2 w; w.x = pk2(h.x, h.y); w.y = pk2(h.z, h.w); ho[64 * j] = w; }
        }
    }
}

__device__ __forceinline__ void tr_item(const float* W, int ldw, int K, int k0, int nsrc, int ncols, bf16* WT, int ndst, float* scr, int lane) {
    const int j = lane & 31;
#pragma unroll 8
    for (int i = 0; i < 32; ++i) { const int kk = 2 * i + (lane >> 5); scr[kk * 33 + j] = (j < ncols) ? W[(size_t)(k0 + kk) * ldw + nsrc + j] : 0.f; }
    LDS_WAIT();
    const int c = lane & 7;
#pragma unroll
    for (int jj = 0; jj < 4; ++jj) { const int n = (lane >> 3) + 8 * jj; const float* s = scr + (8 * c) * 33 + n;
        u32x4 o; o.x = pk2(s[0 * 33], s[1 * 33]); o.y = pk2(s[2 * 33], s[3 * 33]); o.z = pk2(s[4 * 33], s[5 * 33]); o.w = pk2(s[6 * 33], s[7 * 33]);
        *(u32x4*)(WT + (size_t)(ndst + n) * K + k0 + 8 * c) = o; }
    LDS_WAIT();
}
__device__ __forceinline__ void win_map(int dstrow, int& src, int& ncols) {
    ncols = 32;
    if (dstrow < 10240) src = dstrow;
    else if (dstrow < 12288) src = dstrow - 10240 + 10304;
    else if (dstrow < 12800) src = dstrow - 12288 + 12352;
    else if (dstrow < 13312) src = dstrow - 12800 + 12864;
    else if (dstrow < 14336) src = dstrow - 13312 + 13376;
    else if (dstrow < 18432) src = dstrow - 14336 + 14480;
    else if (dstrow < 18496) src = dstrow - 18432 + 10240;
    else if (dstrow < 18560) src = dstrow - 18496 + 14400;
    else if (dstrow == 18560) { src = 14464; ncols = 16; }
    else { src = 0; ncols = 0; }
}
struct WPtrs { const float *w_in, *w_ssm, *w_att, *w_mix, *w_up, *w_dn; };
__device__ __forceinline__ void ph_weights(const WPtrs wp, unsigned char* ws, float* scr, int gw, int ngw, int lane) {
    constexpr int I_IN = (NPAD / 32) * (D / 64), I_SSM = (D / 32) * (DI / 64), I_ATT = (D / 32) * (D / 64), I_MIX = I_ATT, I_UP = (FF2 / 32) * (D / 64), I_DN = (D / 32) * (FF / 64);
    constexpr int I_L = I_IN + I_SSM + I_ATT + I_MIX + I_UP + I_DN;
    for (int it = gw; it < DEPTH * I_L; it += ngw) {
        const int layer = it / I_L; int r = it % I_L;
        unsigned char* wl = ws + WS_W + (size_t)layer * WL_SIZE;
        if (r < I_IN) { const int nblk = NPAD / 32, kb = r / nblk, nb = r % nblk; int src, nc; win_map(nb * 32, src, nc);
            tr_item(wp.w_in + (size_t)layer * D * NIN, NIN, D, kb * 64, src, nc, (bf16*)(wl + WL_IN), nb * 32, scr, lane); continue; }
        r -= I_IN;
        if (r < I_SSM) { const int nblk = D / 32, kb = r / nblk, nb = r % nblk; tr_item(wp.w_ssm + (size_t)layer * DI * D, D, DI, kb * 64, nb * 32, 32, (bf16*)(wl + WL_SSM), nb * 32, scr, lane); continue; }
        r -= I_SSM;
        if (r < I_ATT) { const int nblk = D / 32, kb = r / nblk, nb = r % nblk; tr_item(wp.w_att + (size_t)layer * D * D, D, D, kb * 64, nb * 32, 32, (bf16*)(wl + WL_ATT), nb * 32, scr, lane); continue; }
        r -= I_ATT;
        if (r < I_MIX) { const int nblk = D / 32, kb = r / nblk, nb = r % nblk; tr_item(wp.w_mix + (size_t)layer * D * D, D, D, kb * 64, nb * 32, 32, (bf16*)(wl + WL_MIX), nb * 32, scr, lane); continue; }
        r -= I_MIX;
        if (r < I_UP) { const int nblk = FF2 / 32, kb = r / nblk, nb = r % nblk; tr_item(wp.w_up + (size_t)layer * D * FF2, FF2, D, kb * 64, nb * 32, 32, (bf16*)(wl + WL_UP), nb * 32, scr, lane); continue; }
        r -= I_UP;
        { const int nblk = D / 32, kb = r / nblk, nb = r % nblk; tr_item(wp.w_dn + (size_t)layer * FF * D, D, FF, kb * 64, nb * 32, 32, (bf16*)(wl + WL_DN), nb * 32, scr, lane); }
    }
}

__device__ __forceinline__ void ph_conv_dt(const bf16* P, const float* SM, const float* cw, const float* cb, const float* dt_bias, const float* a_log,
                                           bf16* XC, float* DT, float* ACS, bf16* KIB, int gtid, int nthr) {
    constexpr int NCG = CONVD / 8;
    for (int it = gtid; it < M * NCG; it += nthr) {
        const int m = it / NCG, c0 = (it % NCG) * 8, t = m & (SEQ - 1);
        float acc[8];
        { const f32x4 b0 = *(const f32x4*)(cb + c0), b1 = *(const f32x4*)(cb + c0 + 4); acc[0] = b0.x; acc[1] = b0.y; acc[2] = b0.z; acc[3] = b0.w; acc[4] = b1.x; acc[5] = b1.y; acc[6] = b1.z; acc[7] = b1.w; }
#pragma unroll
        for (int i = 0; i < 4; ++i) { if (t - 3 + i >= 0) {
            const u32x4 xw = *(const u32x4*)(P + (size_t)(m - 3 + i) * NMAIN + PXBC + c0); float x[8]; unpack8(xw, x);
            const f32x4 w0 = *(const f32x4*)(cw + i * CONVD + c0), w1 = *(const f32x4*)(cw + i * CONVD + c0 + 4);
            acc[0] += w0.x * x[0]; acc[1] += w0.y * x[1]; acc[2] += w0.z * x[2]; acc[3] += w0.w * x[3]; acc[4] += w1.x * x[4]; acc[5] += w1.y * x[5]; acc[6] += w1.z * x[6]; acc[7] += w1.w * x[7]; } }
#pragma unroll
        for (int j = 0; j < 8; ++j) acc[j] = siluf_(acc[j]);
        *(u32x4*)(XC + (size_t)m * CONVD + c0) = pack8(acc);
    }
    for (int it = gtid; it < BATCH * 64 * NH; it += nthr) {
        const int head = it & 63, m0 = (it >> 6) * 64; const float a = -__expf(a_log[head]), bias = dt_bias[head]; float cs = 0.f;
        for (int s = 0; s < 64; ++s) { const float raw = SM[(size_t)(m0 + s) * SMW + SM_DT + head] + bias; const float dt = fmaxf(raw, 0.f) + log1pf(__expf(-fabsf(raw)));
            DT[(m0 + s) * NH + head] = dt; cs += dt * a; ACS[(m0 + s) * NH + head] = cs; }
    }
    for (int it = gtid; it < M * 8; it += nthr) { const int m = it >> 3, d0 = (it & 7) * 8; const float* s = SM + (size_t)m * SMW + SM_KI + d0;
        const f32x4 a = *(const f32x4*)s, b = *(const f32x4*)(s + 4); u32x4 w; w.x = pk2(a.x, a.y); w.y = pk2(a.z, a.w); w.z = pk2(b.x, b.y); w.w = pk2(b.z, b.w);
        *(u32x4*)(KIB + (size_t)m * IDD + d0) = w; }
}

__device__ __forceinline__ void ph_index_scores(const bf16* P, const float* SM, const bf16* KIB, float* SC, int blk, int nblk, int wave, int lane) {
    for (int u0 = blk; u0 < 256; u0 += nblk) {
#pragma unroll 1
        for (int half = 0; half < 2; ++half) {
            const int b = half, qt = half ? 255 - u0 : u0;
            const int q0 = b * SEQ + qt * 16, nkt = ((qt * 16) / 64 + 1) * 4;
            const int qrow = q0 + (lane & 15), kq = 8 * (lane >> 4);
            bf16x8 bq[IH][2]; float w[IH];
#pragma unroll
            for (int h = 0; h < IH; ++h) {
#pragma unroll
                for (int ks = 0; ks < 2; ++ks) bq[h][ks] = *(const bf16x8*)(P + (size_t)qrow * NMAIN + PQI + h * IDD + ks * 32 + kq);
                w[h] = SM[(size_t)qrow * SMW + SM_WI + h]; }
            for (int kt = wave; kt < nkt; kt += NWAVES) {
                const int key0 = kt * 16; const bf16* kp = KIB + (size_t)(b * SEQ + key0 + (lane & 15)) * IDD + kq;
                const bf16x8 a0 = *(const bf16x8*)kp, a1 = *(const bf16x8*)(kp + 32);
                f32x4 sc = (f32x4){0.f, 0.f, 0.f, 0.f};
#pragma unroll
                for (int h = 0; h < IH; ++h) { f32x4 c = (f32x4){0.f, 0.f, 0.f, 0.f};
                    c = __builtin_amdgcn_mfma_f32_16x16x32_bf16(a0, bq[h][0], c, 0, 0, 0); c = __builtin_amdgcn_mfma_f32_16x16x32_bf16(a1, bq[h][1], c, 0, 0, 0);
                    sc.x += w[h] * fmaxf(c.x, 0.f); sc.y += w[h] * fmaxf(c.y, 0.f); sc.z += w[h] * fmaxf(c.z, 0.f); sc.w += w[h] * fmaxf(c.w, 0.f); }
                *(f32x4*)(SC + (size_t)qrow * SEQ + key0 + 4 * (lane >> 4)) = sc;
            }
        }
    }
}

__device__ __forceinline__ void ph_topk(const float* SC, unsigned long long* MASKW, int gw, int ngw, int lane) {
    for (int m = gw; m < M; m += ngw) {
        const int t = m & (SEQ - 1), limit = (t / 64 + 1) * 64;
        unsigned long long* mw = MASKW + (size_t)m * 64;
        if (limit <= TOPK) { if (lane < limit / 64) mw[lane] = ~0ull; continue; }
        unsigned u[64];
#pragma unroll
        for (int j = 0; j < 64; ++j) { const int key = j * 64 + lane; unsigned v = 0u;
            if (key < limit) { const unsigned bits = __float_as_uint(SC[(size_t)m * SEQ + key]); v = (bits & 0x80000000u) ? ~bits : (bits | 0x80000000u); }
            u[j] = v; }
        unsigned T = 0u;
#pragma unroll 1
        for (int bit = 31; bit >= 0; --bit) { const unsigned cand = T | (1u << bit); int cnt = 0;
#pragma unroll
            for (int j = 0; j < 64; ++j) cnt += __popcll(__ballot(u[j] >= cand));
            if (cnt >= TOPK) T = cand; }
        int cgt = 0;
#pragma unroll
        for (int j = 0; j < 64; ++j) cgt += __popcll(__ballot(u[j] > T));
        const int need_eq = TOPK - cgt; int eqbase = 0;
        const unsigned long long lt_mask = (1ull << lane) - 1ull;
#pragma unroll
        for (int j = 0; j < 64; ++j) {
            const bool gt = u[j] > T, eq = u[j] == T;
            const unsigned long long eqm = __ballot(eq);
            const bool take = gt || (eq && (eqbase + __popcll(eqm & lt_mask) < need_eq));
            const unsigned long long tm = __ballot(take);
            if (lane == 0 && j * 64 < limit) mw[j] = tm;
            eqbase += __popcll(eqm);
        }
    }
}

typedef short s16x4 __attribute__((ext_vector_type(4)));
__device__ __forceinline__ s16x4 lds_tr4(const LAS unsigned char* p) { return __builtin_bit_cast(s16x4, __builtin_amdgcn_ds_read_tr16_b64_v4i16((LAS s16x4*)p)); }
__device__ __forceinline__ void ph_attn_dense(const bf16* P, const unsigned long long* MASKW, bf16* AO, LAS unsigned char* lds, int blk, int nblk, int tid) {
    constexpr int KS = 272, VS = 288, KBUF = 64 * KS, VBUF = 64 * VS, VOFF = 2 * KBUF;
    const int lane = tid & 63, wave = __builtin_amdgcn_readfirstlane(tid >> 6), g = lane >> 4, c16 = lane & 15;
    const int hq = wave >> 1, qh = (wave & 1) * 32;
    const float SCL = ATTN_SCALE * 1.4426950408889634f;
    for (int u0 = blk; u0 < 256; u0 += nblk) {
#pragma unroll 1
        for (int half = 0; half < 2; ++half) {
            const int b = u0 >> 7, kvh = (u0 >> 5) & 3, cc = u0 & 31, c = half ? 63 - cc : cc, nt = c + 1;
            const int m0 = b * SEQ + c * 64;
            bf16x8 qf[2][4];
#pragma unroll
            for (int qt = 0; qt < 2; ++qt)
#pragma unroll
                for (int kd = 0; kd < 4; ++kd) qf[qt][kd] = *(const bf16x8*)(P + (size_t)(m0 + qh + 16 * qt + c16) * NMAIN + PQ + (kvh * 4 + hq) * AD + 32 * kd + 8 * g);
            f32x4 O[2][8];
#pragma unroll
            for (int qt = 0; qt < 2; ++qt)
#pragma unroll
                for (int dt = 0; dt < 8; ++dt) O[qt][dt] = (f32x4){0.f, 0.f, 0.f, 0.f};
            float mrun[2] = {-__builtin_inff(), -__builtin_inff()}, lrun[2] = {0.f, 0.f};
            const bf16* kvbase = P + (size_t)(b * SEQ) * NMAIN + kvh * AD;
            u32x4 kreg[2], vreg[2];
#define ATT_LOAD(t) do { _Pragma("unroll") for (int i = 0; i < 2; ++i) { const int id = tid + 512 * i; const bf16* src = kvbase + (size_t)((t) * 64 + (id >> 4)) * NMAIN + (id & 15) * 8; \
                kreg[i] = *(const u32x4*)(src + PK); vreg[i] = *(const u32x4*)(src + PV); } } while (0)
#define ATT_STORE(buf) do { _Pragma("unroll") for (int i = 0; i < 2; ++i) { const int id = tid + 512 * i; \
                *(LAS u32x4*)(lds + (buf) * KBUF + (id >> 4) * KS + (id & 15) * 16) = kreg[i]; *(LAS u32x4*)(lds + VOFF + (buf) * VBUF + (id >> 4) * VS + (id & 15) * 16) = vreg[i]; } } while (0)
            __syncthreads();
            ATT_LOAD(0); ATT_STORE(0);
            __syncthreads();
            for (int t = 0; t < nt; ++t) {
                const int buf = t & 1;
                if (t + 1 < nt) ATT_LOAD(t + 1);
                const LAS unsigned char* kb = lds + buf * KBUF + c16 * KS + g * 16;
                const LAS unsigned char* vb = lds + VOFF + buf * VBUF + (4 * g + (c16 >> 2)) * VS + (c16 & 3) * 8;
                f32x4 S[2][4];
#pragma unroll
                for (int kt = 0; kt < 4; ++kt) {
                    bf16x8 kf[4];
#pragma unroll
                    for (int kd = 0; kd < 4; ++kd) kf[kd] = *(const LAS bf16x8*)(kb + kt * 16 * KS + kd * 64);
#pragma unroll
                    for (int qt = 0; qt < 2; ++qt) { f32x4 s = (f32x4){0.f, 0.f, 0.f, 0.f};
#pragma unroll
                        for (int kd = 0; kd < 4; ++kd) s = __builtin_amdgcn_mfma_f32_16x16x32_bf16(kf[kd], qf[qt][kd], s, 0, 0, 0);
                        S[qt][kt] = s; }
                }
                bf16x8 pf[2][2];
#pragma unroll
                for (int qt = 0; qt < 2; ++qt) {
                    const unsigned long long mw = MASKW[(size_t)(m0 + qh + 16 * qt + c16) * 64 + t] >> (4 * g);
                    const unsigned mlo = (unsigned)mw, mhi = (unsigned)(mw >> 32);
                    float mx = -__builtin_inff();
#pragma unroll
                    for (int kt = 0; kt < 4; ++kt)
#pragma unroll
                        for (int j = 0; j < 4; ++j) { const unsigned word = kt < 2 ? mlo : mhi; const bool on = (word >> ((kt & 1) * 16 + j)) & 1u;
                            const float s = on ? S[qt][kt][j] * SCL : -__builtin_inff(); S[qt][kt][j] = s; mx = fmaxf(mx, s); }
                    mx = fmaxf(mx, __shfl_xor(mx, 16)); mx = fmaxf(mx, __shfl_xor(mx, 32));
                    const float mnew = fmaxf(mrun[qt], mx), muse = (mnew == -__builtin_inff()) ? 0.f : mnew;
                    const float alpha = __builtin_amdgcn_exp2f(mrun[qt] - muse);
                    float ps = 0.f;
#pragma unroll
                    for (int kt = 0; kt < 4; ++kt)
#pragma unroll
                        for (int j = 0; j < 4; ++j) { const float p = __builtin_amdgcn_exp2f(S[qt][kt][j] - muse); S[qt][kt][j] = p; ps += p; }
                    ps += __shfl_xor(ps, 16); ps += __shfl_xor(ps, 32);
                    lrun[qt] = lrun[qt] * alpha + ps; mrun[qt] = mnew;
#pragma unroll
                    for (int dt = 0; dt < 8; ++dt) O[qt][dt] *= alpha;
#pragma unroll
                    for (int ks = 0; ks < 2; ++ks) { u32x4 w; w.x = pk2(S[qt][2 * ks][0], S[qt][2 * ks][1]); w.y = pk2(S[qt][2 * ks][2], S[qt][2 * ks][3]);
                        w.z = pk2(S[qt][2 * ks + 1][0], S[qt][2 * ks + 1][1]); w.w = pk2(S[qt][2 * ks + 1][2], S[qt][2 * ks + 1][3]); pf[qt][ks] = __builtin_bit_cast(bf16x8, w); }
                }
#pragma unroll
                for (int dt = 0; dt < 8; ++dt)
#pragma unroll
                    for (int ks = 0; ks < 2; ++ks) {
                        const s16x4 lo = lds_tr4(vb + (32 * ks) * VS + dt * 32), hi = lds_tr4(vb + (32 * ks + 16) * VS + dt * 32);
                        const bf16x8 vf = __builtin_shufflevector(lo, hi, 0, 1, 2, 3, 4, 5, 6, 7);
                        O[0][dt] = __builtin_amdgcn_mfma_f32_16x16x32_bf16(vf, pf[0][ks], O[0][dt], 0, 0, 0);
                        O[1][dt] = __builtin_amdgcn_mfma_f32_16x16x32_bf16(vf, pf[1][ks], O[1][dt], 0, 0, 0);
                    }
                if (t + 1 < nt) ATT_STORE(buf ^ 1);
                __syncthreads();
            }
#undef ATT_LOAD
#undef ATT_STORE
#pragma unroll
            for (int qt = 0; qt < 2; ++qt) { const float r = 1.0f / lrun[qt];
                bf16* op = AO + (size_t)(m0 + qh + 16 * qt + c16) * D + (kvh * 4 + hq) * AD + 4 * g;
#pragma unroll
                for (int dt = 0; dt < 8; ++dt) { const f32x4 o = O[qt][dt] * r; u32x2 w; w.x = pk2(o.x, o.y); w.y = pk2(o.z, o.w); *(u32x2*)(op + 16 * dt) = w; } }
        }
    }
}

__device__ __forceinline__ void ph_ssd_states(const bf16* XC, const float* DT, const float* ACS, float* ST, float* lds, int blk, int nblk, int tid) {
    float* Bs = lds;
    float* Xw = lds + 64 * 128;
    for (int item = blk; item < BATCH * 64 * NG; item += nblk) {
        const int bc = item >> 3, g = item & 7, m0 = bc * 64;
        __syncthreads();
        { const int e = tid * 16, s = e >> 7, n = e & 127; const bf16* src = XC + (size_t)(m0 + s) * CONVD + DI + g * NS + n;
          float f[8]; unpack8(*(const u32x4*)src, f);
#pragma unroll
          for (int j = 0; j < 8; ++j) Bs[e + j] = f[j];
          unpack8(*(const u32x4*)(src + 8), f);
#pragma unroll
          for (int j = 0; j < 8; ++j) Bs[e + 8 + j] = f[j]; }
#pragma unroll 1
        for (int r = 0; r < HPG; ++r) {
            const int head = g * HPG + r;
            __syncthreads();
            { const int e = tid * 8, s = e >> 6, p = e & 63; float f[8]; unpack8(*(const u32x4*)(XC + (size_t)(m0 + s) * CONVD + head * HP + p), f);
              const float w = DT[(m0 + s) * NH + head] * __expf(ACS[(m0 + 63) * NH + head] - ACS[(m0 + s) * NH + head]);
#pragma unroll
              for (int j = 0; j < 8; ++j) Xw[e + j] = f[j] * w; }
            __syncthreads();
            const int p = tid >> 3, n0 = (tid & 7) * 16;
            f32x4 acc[4];
#pragma unroll
            for (int q = 0; q < 4; ++q) acc[q] = (f32x4){0.f, 0.f, 0.f, 0.f};
#pragma unroll 4
            for (int s = 0; s < 64; ++s) { const float x = Xw[s * 64 + p];
#pragma unroll
                for (int q = 0; q < 4; ++q) acc[q] += x * *(const f32x4*)(Bs + s * 128 + n0 + 4 * q); }
            float* dst = ST + (((size_t)bc * NH + head) * HP + p) * NS + n0;
#pragma unroll
            for (int q = 0; q < 4; ++q) *(f32x4*)(dst + 4 * q) = acc[q];
        }
    }
}

__device__ __forceinline__ void ph_ssd_scan(float* ST, const float* ACS, int gtid, int nthr) {
    for (int it = gtid; it < BATCH * NH * HP * (NS / 4); it += nthr) {
        const int n4 = it & 31, p = (it >> 5) & 63, head = (it >> 11) & 63, b = it >> 17;
        f32x4 h = (f32x4){0.f, 0.f, 0.f, 0.f};
        for (int c = 0; c < 64; ++c) { f32x4* q = (f32x4*)(ST + ((((size_t)(b * 64 + c)) * NH + head) * HP + p) * NS) + n4;
            const f32x4 v = *q; *q = h; const float dec = __expf(ACS[((b * 64 + c) * 64 + 63) * NH + head]); h = h * dec + v; }
    }
}

__device__ __forceinline__ void ph_ssd_out(const bf16* XC, const bf16* P, const float* DT, const float* ACS, const float* ST, const float* dskip, const float* gnorm, bf16* Y,
                                           float* lds, int blk, int nblk, int tid) {
    constexpr int LP = 132;
    float* Cs = lds;
    float* Bs = lds + 64 * LP;
    float* CB = lds + 2 * 64 * LP;
    float* Ls = CB + 64 * 65;
    float* Xs = Ls + 64 * 65;
    float* acsS = Xs + 64 * 64;
    float* dtS = acsS + 64;
    for (int item = blk; item < BATCH * 64 * NG; item += nblk) {
        const int bc = item >> 3, g = item & 7, m0 = bc * 64;
        __syncthreads();
        { const int e = tid * 16, s = e >> 7, n = e & 127; const bf16* srcB = XC + (size_t)(m0 + s) * CONVD + DI + g * NS + n; const bf16* srcC = srcB + NG * NS;
          float f[8];
          unpack8(*(const u32x4*)srcB, f);
#pragma unroll
          for (int j = 0; j < 8; ++j) Bs[s * LP + n + j] = f[j];
          unpack8(*(const u32x4*)(srcB + 8), f);
#pragma unroll
          for (int j = 0; j < 8; ++j) Bs[s * LP + n + 8 + j] = f[j];
          unpack8(*(const u32x4*)srcC, f);
#pragma unroll
          for (int j = 0; j < 8; ++j) Cs[s * LP + n + j] = f[j];
          unpack8(*(const u32x4*)(srcC + 8), f);
#pragma unroll
          for (int j = 0; j < 8; ++j) Cs[s * LP + n + 8 + j] = f[j]; }
        __syncthreads();
        const int l = tid >> 3, p0 = (tid & 7) * 8;
        { float a[8];
#pragma unroll
          for (int i = 0; i < 8; ++i) a[i] = 0.f;
#pragma unroll 2
          for (int n = 0; n < NS; n += 4) { const f32x4 c4 = *(const f32x4*)(Cs + l * LP + n);
#pragma unroll
              for (int i = 0; i < 8; ++i) { const f32x4 b4 = *(const f32x4*)(Bs + (p0 + i) * LP + n); a[i] += (c4.x * b4.x + c4.y * b4.y) + (c4.z * b4.z + c4.w * b4.w); } }
#pragma unroll
          for (int i = 0; i < 8; ++i) CB[l * 65 + p0 + i] = a[i]; }
        float ssq = 0.f;
#pragma unroll 1
        for (int r = 0; r < HPG; ++r) {
            const int head = g * HPG + r;
            __syncthreads();
            if (tid < 64) { acsS[tid] = ACS[(m0 + tid) * NH + head]; dtS[tid] = DT[(m0 + tid) * NH + head]; }
            { const int e = tid * 8, s = e >> 6, p = e & 63; float f[8]; unpack8(*(const u32x4*)(XC + (size_t)(m0 + s) * CONVD + head * HP + p), f);
#pragma unroll
              for (int j = 0; j < 8; ++j) Xs[e + j] = f[j]; }
            { const int e = tid * 16, p = e >> 7, n = e & 127; const float* src = ST + (((size_t)bc * NH + head) * HP + p) * NS + n;
#pragma unroll
              for (int q = 0; q < 4; ++q) *(f32x4*)(Bs + p * LP + n + 4 * q) = *(const f32x4*)(src + 4 * q); }
            __syncthreads();
            { const float al = acsS[l];
#pragma unroll
              for (int i = 0; i < 8; ++i) { const int s = p0 + i; Ls[l * 65 + s] = (s <= l) ? CB[l * 65 + s] * __expf(al - acsS[s]) * dtS[s] : 0.f; } }
            __syncthreads();
            float acc[8], acc2[8];
#pragma unroll
            for (int i = 0; i < 8; ++i) { acc[i] = 0.f; acc2[i] = 0.f; }
#pragma unroll 2
            for (int s = 0; s < 64; ++s) { const float w = Ls[l * 65 + s]; const f32x4 x0 = *(const f32x4*)(Xs + s * 64 + p0), x1 = *(const f32x4*)(Xs + s * 64 + p0 + 4);
                acc[0] += w * x0.x; acc[1] += w * x0.y; acc[2] += w * x0.z; acc[3] += w * x0.w; acc[4] += w * x1.x; acc[5] += w * x1.y; acc[6] += w * x1.z; acc[7] += w * x1.w; }
#pragma unroll 2
            for (int n = 0; n < NS; n += 4) { const f32x4 c4 = *(const f32x4*)(Cs + l * LP + n);
#pragma unroll
                for (int i = 0; i < 8; ++i) { const f32x4 h4 = *(const f32x4*)(Bs + (p0 + i) * LP + n); acc2[i] += (c4.x * h4.x + c4.y * h4.y) + (c4.z * h4.z + c4.w * h4.w); } }
            const float el = __expf(acsS[l]), dk = dskip[head];
            float z[8]; unpack8(*(const u32x4*)(P + (size_t)(m0 + l) * NMAIN + PZ + head * HP + p0), z);
            float o[8];
#pragma unroll
            for (int i = 0; i < 8; ++i) { float y = acc[i] + el * acc2[i] + dk * Xs[l * 64 + p0 + i]; y *= siluf_(z[i]); o[i] = y; ssq += y * y; }
            *(u32x4*)(Y + (size_t)(m0 + l) * DI + head * HP + p0) = pack8(o);
        }
        ssq += __shfl_xor(ssq, 1); ssq += __shfl_xor(ssq, 2); ssq += __shfl_xor(ssq, 4);
        const float rstd = rsqrtf(ssq * (1.0f / (HPG * HP)) + EPS);
#pragma unroll 1
        for (int r = 0; r < HPG; ++r) { const int ch = (g * HPG + r) * HP + p0; const f32x4 g0 = *(const f32x4*)(gnorm + ch), g1 = *(const f32x4*)(gnorm + ch + 4);
            float o[8]; unpack8(*(const u32x4*)(Y + (size_t)(m0 + l) * DI + ch), o);
            o[0] *= rstd * g0.x; o[1] *= rstd * g0.y; o[2] *= rstd * g0.z; o[3] *= rstd * g0.w; o[4] *= rstd * g1.x; o[5] *= rstd * g1.y; o[6] *= rstd * g1.z; o[7] *= rstd * g1.w;
            *(u32x4*)(Y + (size_t)(m0 + l) * DI + ch) = pack8(o); }
    }
}

__device__ __forceinline__ float gelu_tanhf_(float x) { const float u = 0.7978845608028654f * (x + 0.044715f * x * x * x); const float t = 1.0f - 2.0f / (1.0f + __expf(2.0f * u)); return 0.5f * x * (1.0f + t); }
__device__ __forceinline__ void ph_ffn_act(const bf16* U, const float* cw, const float* cb, bf16* ACT, int gtid, int nthr) {
    constexpr int NCG = FF / 8;
    for (int it = gtid; it < M * NCG; it += nthr) {
        const int m = it / NCG, c0 = (it % NCG) * 8, t = m & (SEQ - 1);
        float ag[8], av[8];
        { const f32x4 b0 = *(const f32x4*)(cb + c0), b1 = *(const f32x4*)(cb + c0 + 4), d0 = *(const f32x4*)(cb + FF + c0), d1 = *(const f32x4*)(cb + FF + c0 + 4);
          ag[0] = b0.x; ag[1] = b0.y; ag[2] = b0.z; ag[3] = b0.w; ag[4] = b1.x; ag[5] = b1.y; ag[6] = b1.z; ag[7] = b1.w;
          av[0] = d0.x; av[1] = d0.y; av[2] = d0.z; av[3] = d0.w; av[4] = d1.x; av[5] = d1.y; av[6] = d1.z; av[7] = d1.w; }
#pragma unroll
        for (int i = 0; i < 3; ++i) { if (t - 2 + i >= 0) {
            const bf16* ur = U + (size_t)(m - 2 + i) * FF2 + c0; float xg[8], xv[8]; unpack8(*(const u32x4*)ur, xg); unpack8(*(const u32x4*)(ur + FF), xv);
            const float* wg = cw + i * FF2 + c0; const float* wv = wg + FF;
#pragma unroll
            for (int j = 0; j < 8; ++j) { ag[j] += wg[j] * xg[j]; av[j] += wv[j] * xv[j]; } } }
        float o[8];
#pragma unroll
        for (int j = 0; j < 8; ++j) o[j] = gelu_tanhf_(ag[j]) * av[j];
        *(u32x4*)(ACT + (size_t)m * FF + c0) = pack8(o);
    }
}

struct Args { const float* in[20]; float* out; unsigned char* ws; int ph_lo, ph_hi; };
constexpr int NP = 12, NPHASE = 1 + DEPTH * NP;

__global__ void __launch_bounds__(NTHR, 2) fwd(Args args) {
    extern __shared__ __attribute__((aligned(16))) unsigned char lds[];
    const int G = gridDim.x, blk = blockIdx.x;
    volatile LAS unsigned* MISC = (volatile LAS unsigned*)((LAS unsigned char*)lds + MISC_OFF);
    for (int u = threadIdx.x; u < (LDS_BYTES - LDSCTL_OFF) / 4; u += NTHR) ((LAS unsigned*)((LAS unsigned char*)lds + LDSCTL_OFF))[u] = 0u;
    __syncthreads();
    XcdBarrier bar; bar.bar = (unsigned*)(args.ws + WS_CTL) + CW_BAR; bar.x = 0; bar.st = nullptr;
    if (!MK_PER_PHASE) bar = xcd_barrier_post((unsigned*)(args.ws + WS_CTL) + CW_BAR, MISC + 8);
    const int lo = args.ph_lo, hi = args.ph_hi;
#define IN(k) (lo <= (k) && (k) < hi)
#define SEAM(k) do { if (IN(k) && IN((k) + 1)) xcd_barrier(bar); } while (0)
#define PH_BEGIN \
    int tid = threadIdx.x; asm volatile("" : "+v"(tid)); \
    const int lane = tid & 63, wave = __builtin_amdgcn_readfirstlane(tid >> 6); \
    const int gw = blk * NWAVES + wave, ngw = G * NWAVES, gtid = blk * NTHR + tid, nthr = G * NTHR; \
    unsigned char* ws = args.ws; asm volatile("" : "+s"(ws)); \
    LAS unsigned char* ring = (LAS unsigned char*)lds; \
    (void)lane; (void)wave; (void)gw; (void)ngw; (void)gtid; (void)nthr; (void)ring; \
    float* X = args.out; \
    bf16* H = (bf16*)(ws + WS_H); bf16* P = (bf16*)(ws + WS_P); float* SM = (float*)(ws + WS_SM); bf16* XC = (bf16*)(ws + WS_XC); \
    float* DT = (float*)(ws + WS_DT); float* ACS = (float*)(ws + WS_ACS); float* ST = (float*)(ws + WS_ST); bf16* Y = (bf16*)(ws + WS_Y); \
    float* SC = (float*)(ws + WS_SC); unsigned long long* MASKW = (unsigned long long*)(ws + WS_IDX); bf16* AO = (bf16*)(ws + WS_AO); \
    float* MG = (float*)(ws + WS_MG); bf16* MGB = (bf16*)(ws + WS_MGB); float* YM = (float*)(ws + WS_YM); bf16* U = (bf16*)(ws + WS_U); \
    bf16* ACT = (bf16*)(ws + WS_ACT); bf16* KIB = (bf16*)(ws + WS_KIB); \
    (void)X; (void)H; (void)P; (void)SM; (void)XC; (void)DT; (void)ACS; (void)ST; (void)Y; (void)SC; (void)MASKW; (void)AO; (void)MG; (void)MGB; (void)YM; (void)U; (void)ACT; (void)KIB;

    if (IN(0)) { PH_BEGIN
        WPtrs wp{args.in[5], args.in[13], args.in[14], args.in[15], args.in[16], args.in[19]};
        ph_weights(wp, ws, (float*)lds + wave * 2176, gw, ngw, lane);
        ph_resid_norm(nullptr, nullptr, args.in[1], args.in[0], X, H, gw, ngw, lane);
    }
    SEAM(0);

#pragma unroll 1
    for (int layer = 0; layer < DEPTH; ++layer) {
        const int pb = 1 + layer * NP;
#define WL (ws + WS_W + (size_t)layer * WL_SIZE)
        if (IN(pb + 0)) { PH_BEGIN
            pg8::Gemm g{H, (const bf16*)(WL + WL_IN), M, NPAD, D}; pg8::StaticOrder S; S.init(M, NPAD, G, blk);
            pg8::EpiIn E{P, NMAIN, SM, args.in[6] + (size_t)layer * 2 * D, PG / 256, NMAIN / 256};
            pg8::gemm_phase<pg8::EpiIn, pg8::StaticOrder, true, true>(ring, g, S, E);
        }
        SEAM(pb + 0);
        if (IN(pb + 1)) { PH_BEGIN
            REP(10) ph_conv_dt(P, SM, args.in[7] + (size_t)layer * 4 * CONVD, args.in[8] + (size_t)layer * CONVD, args.in[9] + layer * NH, args.in[10] + layer * NH, XC, DT, ACS, KIB, gtid, nthr); }
        SEAM(pb + 1);
        if (IN(pb + 2)) { PH_BEGIN
            REP(20) ph_ssd_states(XC, DT, ACS, ST, (float*)lds, blk, G, tid); REP(21) ph_index_scores(P, SM, KIB, SC, blk, G, wave, lane); }
        SEAM(pb + 2);
        if (IN(pb + 3)) { PH_BEGIN
            ph_ssd_scan(ST, ACS, gtid, nthr); REP(30) ph_topk(SC, MASKW, gw, ngw, lane); }
        SEAM(pb + 3);
        if (IN(pb + 4)) { PH_BEGIN
            REP(40) { ph_ssd_out(XC, P, DT, ACS, ST, args.in[11] + layer * NH, args.in[12] + (size_t)layer * DI, Y, (float*)lds, blk, G, tid); __syncthreads(); }
            REP(41) { ph_attn_dense(P, MASKW, AO, ring, blk, G, tid); __syncthreads(); } }
        SEAM(pb + 4);
        if (IN(pb + 5)) {
            { PH_BEGIN
              pg8::Gemm g{Y, (const bf16*)(WL + WL_SSM), M, D, DI}; pg8::StaticOrder S; S.init(M, D, G, blk);
              pg8::EpiGateMul E{MG, D, P + PG, NMAIN}; pg8::gemm_phase<pg8::EpiGateMul, pg8::StaticOrder, false, true>(ring, g, S, E); }
            __syncthreads();
            { PH_BEGIN
              pg8::Gemm g{AO, (const bf16*)(WL + WL_ATT), M, D, D}; pg8::StaticOrder S; S.init(M, D, G, blk);
              pg8::EpiGateAdd E{MG, MGB, D, P + PG + D, NMAIN}; pg8::gemm_phase<pg8::EpiGateAdd, pg8::StaticOrder, false, true>(ring, g, S, E); }
        }
        SEAM(pb + 5);
        if (IN(pb + 6)) { PH_BEGIN
            pg8::Gemm g{MGB, (const bf16*)(WL + WL_MIX), M, D, D}; pg8::StaticOrder S; S.init(M, D, G, blk);
            pg8::EpiF32 E{YM, D}; pg8::gemm_phase<pg8::EpiF32, pg8::StaticOrder, false, true>(ring, g, S, E); }
        SEAM(pb + 6);
        if (IN(pb + 7)) { PH_BEGIN
            ph_resid_norm(YM, args.in[2] + (size_t)layer * D, args.in[3] + (size_t)layer * D, X, X, H, gw, ngw, lane); }
        SEAM(pb + 7);
        if (IN(pb + 8)) { PH_BEGIN
            pg8::Gemm g{H, (const bf16*)(WL + WL_UP), M, FF2, D}; pg8::StaticOrder S; S.init(M, FF2, G, blk);
            pg8::EpiBf16<0> E{U, FF2, nullptr, 0, 0, 1.f}; pg8::gemm_phase<pg8::EpiBf16<0>, pg8::StaticOrder, true, true>(ring, g, S, E); }
        SEAM(pb + 8);
        if (IN(pb + 9)) { PH_BEGIN
            REP(90) ph_ffn_act(U, args.in[17] + (size_t)layer * 3 * FF2, args.in[18] + (size_t)layer * FF2, ACT, gtid, nthr); }
        SEAM(pb + 9);
        if (IN(pb + 10)) { PH_BEGIN
            pg8::Gemm g{ACT, (const bf16*)(WL + WL_DN), M, D, FF}; pg8::StaticOrder S; S.init(M, D, G, blk);
            pg8::EpiF32 E{YM, D}; pg8::gemm_phase<pg8::EpiF32, pg8::StaticOrder, false, true>(ring, g, S, E); }
        SEAM(pb + 10);
        if (IN(pb + 11)) { PH_BEGIN
            ph_resid_norm(YM, args.in[4] + (size_t)layer * D, layer + 1 < DEPTH ? args.in[1] + (size_t)(layer + 1) * D : nullptr, X, X, H, gw, ngw, lane); }
        SEAM(pb + 11);
    }
#undef IN
#undef SEAM
#undef WL
#undef PH_BEGIN
}

extern "C" void kernel_launch(void* const* d_in, const int* in_sizes, int n_in, void* d_out, int out_size, void* d_ws, size_t ws_size, hipStream_t stream) {
    static int grid = 0;
    if (grid == 0) {
        if (n_in != 20 || in_sizes[0] != M * D || out_size != M * D || ws_size < WS_END) { fprintf(stderr, "kernel_launch: unexpected shapes (n_in %d, in0 %d, out %d, ws %zu < %zu)\n", n_in, n_in > 0 ? in_sizes[0] : -1, out_size, ws_size, (size_t)WS_END); grid = -1; return; }
        int dev = 0, cus = 0, per_cu = 0;
        if (hipGetDevice(&dev) != hipSuccess || hipDeviceGetAttribute(&cus, hipDeviceAttributeMultiprocessorCount, dev) != hipSuccess) { grid = -1; return; }
        if (hipFuncSetAttribute((const void*)fwd, hipFuncAttributeMaxDynamicSharedMemorySize, LDS_BYTES) != hipSuccess) { fprintf(stderr, "kernel_launch: hipFuncSetAttribute failed\n"); grid = -1; return; }
        if (hipOccupancyMaxActiveBlocksPerMultiprocessor(&per_cu, (const void*)fwd, NTHR, LDS_BYTES) != hipSuccess || per_cu < 1) fprintf(stderr, "kernel_launch: occupancy query reports %d blocks per CU\n", per_cu);
        (void)hipGetLastError();
        grid = cus;
    }
    if (grid < 0) return;
    if (hipMemsetAsync((char*)d_ws + WS_CTL, 0, CTL_ZERO_BYTES, stream) != hipSuccess) return;
    Args a{};
    for (int i = 0; i < 20; ++i) a.in[i] = (const float*)d_in[i];
    a.out = (float*)d_out; a.ws = (unsigned char*)d_ws;
#if MK_PER_PHASE
    for (int ph = 0; ph < NPHASE; ++ph) { a.ph_lo = ph; a.ph_hi = ph + 1; hipLaunchKernelGGL(fwd, dim3(grid), dim3(NTHR), LDS_BYTES, stream, a); }
#else
    a.ph_lo = 0; a.ph_hi = NPHASE; hipLaunchKernelGGL(fwd, dim3(grid), dim3(NTHR), LDS_BYTES, stream, a);
#endif
}
```

```cpp
#include <hip/hip_runtime.h>
#include <cstdio>
#include <cstdint>
#define MK_PER_PHASE 0
namespace pg8 {
#define PG8_LAS __attribute__((address_space(3)))
typedef unsigned short bf16_t;
typedef short bf16x8 __attribute__((ext_vector_type(8)));
typedef float f32x4 __attribute__((ext_vector_type(4)));
typedef unsigned u32x4 __attribute__((ext_vector_type(4)));
constexpr int BM = 256, BK = 64, HALF = 128, HTB = HALF * BK * 2  , STAGE_BYTES = 8 * HTB, NXCD = 8, WGM = 8;

__host__ __device__ __forceinline__ int lds_byte(int r, int c) { const int st = (r >> 4) * 2 + (c >> 5), rr = r & 15, cc = c & 31, ob = rr * 64 + cc * 2; return st * 1024 + (ob ^ (((ob >> 9) & 1) << 5)); }
__host__ __device__ __forceinline__ void stage_rc(int b, int& R, int& C) { const int st = b / 1024, sb = b % 1024, swz = sb ^ (((sb >> 9) & 1) << 5); R = (st >> 1) * 16 + swz / 64; C = (st & 1) * 32 + (swz % 64) / 2; }
__host__ __device__ __forceinline__ int perm32(int rho) { const int n = rho >> 4, i = rho & 15; return 8 * (i >> 2) + 4 * n + (i & 3); }

struct Unit { int pm, pn; };
struct Gemm { const bf16_t* A; const bf16_t* Bt; int M, N, K; };

struct StaticOrder {
    int nM, nN, nwg, G, c;
    __host__ __device__ void init(int M, int N, int G_, int c_) { nM = M / BM; nN = N / BM; nwg = nM * nN; G = G_; c = c_; }
    __host__ __device__ bool next(int i, Unit& u) const {
        const long L = (long)i * G + c; if (L >= nwg) return false;
        int wgid = (int)L; { const int q = nwg / NXCD, r = nwg % NXCD, xcd = wgid % NXCD, off = wgid / NXCD; wgid = (xcd < r ? xcd * (q + 1) : r * (q + 1) + (xcd - r) * q) + off; }
        const int nig = WGM * nN, gid = wgid / nig, fm = gid * WGM, gsz = (nM - fm) < WGM ? (nM - fm) : WGM;
        u.pm = fm + ((wgid % nig) % gsz); u.pn = (wgid % nig) / gsz; return true;
    }
    __device__ __forceinline__ void a_ready(const Unit&) const {}
    __device__ __forceinline__ void done(const Unit&) const {}
};

__device__ __forceinline__ unsigned cvt_pk_bf16(float lo, float hi) { unsigned r; asm volatile("v_cvt_pk_bf16_f32 %0, %1, %2" : "=v"(r) : "v"(lo), "v"(hi)); return r; }
typedef float f32x2 __attribute__((ext_vector_type(2)));
__device__ __forceinline__ f32x2 gelu_pk(f32x2 v) {
    const f32x2 av = __builtin_elementwise_abs(v), d = av * 0.2316418882f + 1.0f;
    f32x2 t; t.x = __builtin_amdgcn_rcpf(d.x); t.y = __builtin_amdgcn_rcpf(d.y);
    f32x2 q = t * 0.5307027145f + (-0.7265760135f); q = q * t + 0.7107068705f; q = q * t + (-0.142248368f); q = q * t + 0.127414796f; q = q * t;
    const f32x2 s = (v * v) * (-0.72134752044f);
    f32x2 e; e.x = __builtin_amdgcn_exp2f(s.x); e.y = __builtin_amdgcn_exp2f(s.y);
    const f32x2 m = v * (q * e), r = v - m;
    f32x2 o; o.x = v.x < 0.f ? m.x : r.x; o.y = v.y < 0.f ? m.y : r.y; return o;
}

template <int ACT  > struct EpiBf16 {
    static constexpr bool PERM = true, AFTER_DRAIN = false; static_assert(ACT == 0 || ACT == 1, "EpiBf16: ACT is 0 (none) or 1 (gelu_pk)");
    bf16_t* O; int ldc; const float* bias; int split_cols; size_t split_stride; float scale0;
    __device__ __forceinline__ void operator()(const f32x4 (&acc)[2][2][4][2], const Unit& u, int wr, int wc, int fr, int fq) const {
        const int row0 = u.pm * BM + wr * 64 + fr; int colt = u.pn * BM; bf16_t* base = O;
        float sc = 1.f; if (split_cols) { const int t = colt / split_cols; base += (size_t)t * split_stride; colt -= t * split_cols; if (t == 0) sc = scale0; }
        const int col0 = colt + wc * 32 + 8 * fq, bcol0 = u.pn * BM + wc * 32 + 8 * fq;
        f32x4 bv[2][2];
#pragma unroll
        for (int bj = 0; bj < 2; ++bj)
#pragma unroll
            for (int n = 0; n < 2; ++n) bv[bj][n] = bias ? *(const f32x4*)(bias + bcol0 + bj * HALF + 4 * n) : (f32x4){0.f, 0.f, 0.f, 0.f};
#pragma unroll
        for (int ai = 0; ai < 2; ++ai)
#pragma unroll
            for (int m = 0; m < 4; ++m) { bf16_t* rowp = base + (size_t)(row0 + ai * HALF + m * 16) * ldc + col0;
#pragma unroll
                for (int bj = 0; bj < 2; ++bj) { f32x4 v0 = acc[ai][bj][m][0] + bv[bj][0], v1 = acc[ai][bj][m][1] + bv[bj][1];
                    if (ACT == 1) { f32x2 a = gelu_pk((f32x2){v0[0], v0[1]}), b = gelu_pk((f32x2){v0[2], v0[3]}), c = gelu_pk((f32x2){v1[0], v1[1]}), d = gelu_pk((f32x2){v1[2], v1[3]});
                        v0 = (f32x4){a.x, a.y, b.x, b.y}; v1 = (f32x4){c.x, c.y, d.x, d.y}; }
                    v0 = v0 * sc; v1 = v1 * sc; u32x4 w; w.x = cvt_pk_bf16(v0[0], v0[1]); w.y = cvt_pk_bf16(v0[2], v0[3]); w.z = cvt_pk_bf16(v1[0], v1[1]); w.w = cvt_pk_bf16(v1[2], v1[3]);
                    *(u32x4*)(rowp + bj * HALF) = w; } }
    }
};

struct EpiF32 {
    static constexpr bool PERM = false, AFTER_DRAIN = false;
    float* C; int ldc;
    __device__ __forceinline__ void operator()(const f32x4 (&acc)[2][2][4][2], const Unit& u, int wr, int wc, int fr, int fq) const {
        const int row0 = u.pm * BM + wr * 64 + fr, col0 = u.pn * BM + wc * 32 + 4 * fq;
#pragma unroll
        for (int ai = 0; ai < 2; ++ai)
#pragma unroll
            for (int m = 0; m < 4; ++m) { float* rowp = C + (size_t)(row0 + ai * HALF + m * 16) * ldc + col0;
#pragma unroll
                for (int bj = 0; bj < 2; ++bj)
#pragma unroll
                    for (int n = 0; n < 2; ++n) *(f32x4*)(rowp + bj * HALF + n * 16) = acc[ai][bj][m][n]; }
    }
};
__device__ __forceinline__ float bf_lo(unsigned w) { return __uint_as_float(w << 16); }
__device__ __forceinline__ float bf_hi(unsigned w) { return __uint_as_float(w & 0xffff0000u); }
__device__ __forceinline__ float sigmoidf_(float x) { return __builtin_amdgcn_rcpf(1.0f + __expf(-x)); }
struct EpiIn {
    static constexpr bool PERM = true, AFTER_DRAIN = false;
    bf16_t* P; int ldp; float* SM; const float* bgate; int gate_tile0, small_tile; bf16_t* KIB;
    __device__ __forceinline__ void operator()(const f32x4 (&acc)[2][2][4][2], const Unit& u, int wr, int wc, int fr, int fq) const {
        const int row0 = u.pm * BM + wr * 64 + fr, colt = u.pn * BM + wc * 32 + 8 * fq;
        if (u.pn < small_tile) {
            const bool gate = u.pn >= gate_tile0;
            f32x4 bv[2][2];
#pragma unroll
            for (int bj = 0; bj < 2; ++bj)
#pragma unroll
                for (int n = 0; n < 2; ++n) bv[bj][n] = gate ? *(const f32x4*)(bgate + (colt - gate_tile0 * BM) + bj * HALF + 4 * n) : (f32x4){0.f, 0.f, 0.f, 0.f};
#pragma unroll
            for (int ai = 0; ai < 2; ++ai)
#pragma unroll
                for (int m = 0; m < 4; ++m) { bf16_t* rowp = P + (size_t)(row0 + ai * HALF + m * 16) * ldp + colt;
#pragma unroll
                    for (int bj = 0; bj < 2; ++bj) { f32x4 v0 = acc[ai][bj][m][0] + bv[bj][0], v1 = acc[ai][bj][m][1] + bv[bj][1];
                        if (gate) {
#pragma unroll
                            for (int j = 0; j < 4; ++j) { v0[j] = sigmoidf_(v0[j]); v1[j] = sigmoidf_(v1[j]); } }
                        u32x4 w; w.x = cvt_pk_bf16(v0[0], v0[1]); w.y = cvt_pk_bf16(v0[2], v0[3]); w.z = cvt_pk_bf16(v1[0], v1[1]); w.w = cvt_pk_bf16(v1[2], v1[3]);
                        *(u32x4*)(rowp + bj * HALF) = w; } }
        } else {
            const int c0 = wc * 32 + 8 * fq;
#pragma unroll
            for (int ai = 0; ai < 2; ++ai)
#pragma unroll
                for (int m = 0; m < 4; ++m) { float* rowp = SM + (size_t)(row0 + ai * HALF + m * 16) * BM + c0;
#pragma unroll
                    for (int bj = 0; bj < 2; ++bj) { *(f32x4*)(rowp + bj * HALF) = acc[ai][bj][m][0]; *(f32x4*)(rowp + bj * HALF + 4) = acc[ai][bj][m][1]; }
                    if (wc >= 2) { const f32x4 v0 = acc[ai][0][m][0], v1 = acc[ai][0][m][1];
                        u32x4 w; w.x = cvt_pk_bf16(v0[0], v0[1]); w.y = cvt_pk_bf16(v0[2], v0[3]); w.z = cvt_pk_bf16(v1[0], v1[1]); w.w = cvt_pk_bf16(v1[2], v1[3]);
                        *(u32x4*)(KIB + (size_t)(row0 + ai * HALF + m * 16) * 64 + (c0 - 64)) = w; } }
        }
    }
};
struct EpiGateMul {
    static constexpr bool PERM = true, AFTER_DRAIN = false;
    float* MG; int ldc; const bf16_t* G; int ldg;
    __device__ __forceinline__ void operator()(const f32x4 (&acc)[2][2][4][2], const Unit& u, int wr, int wc, int fr, int fq) const {
        const int row0 = u.pm * BM + wr * 64 + fr, colt = u.pn * BM + wc * 32 + 8 * fq;
#pragma unroll
        for (int ai = 0; ai < 2; ++ai)
#pragma unroll
            for (int m = 0; m < 4; ++m) { const size_t row = (size_t)(row0 + ai * HALF + m * 16);
#pragma unroll
                for (int bj = 0; bj < 2; ++bj) { const u32x4 g = *(const u32x4*)(G + row * ldg + colt + bj * HALF);
                    f32x4 v0 = acc[ai][bj][m][0], v1 = acc[ai][bj][m][1];
                    v0[0] *= bf_lo(g.x); v0[1] *= bf_hi(g.x); v0[2] *= bf_lo(g.y); v0[3] *= bf_hi(g.y);
                    v1[0] *= bf_lo(g.z); v1[1] *= bf_hi(g.z); v1[2] *= bf_lo(g.w); v1[3] *= bf_hi(g.w);
                    float* o = MG + row * ldc + colt + bj * HALF; *(f32x4*)o = v0; *(f32x4*)(o + 4) = v1; } }
    }
};
struct EpiGateAdd {
    static constexpr bool PERM = true, AFTER_DRAIN = false;
    const float* MG; bf16_t* O; int ldc; const bf16_t* G; int ldg;
    __device__ __forceinline__ void operator()(const f32x4 (&acc)[2][2][4][2], const Unit& u, int wr, int wc, int fr, int fq) const {
        const int row0 = u.pm * BM + wr * 64 + fr, colt = u.pn * BM + wc * 32 + 8 * fq;
#pragma unroll
        for (int ai = 0; ai < 2; ++ai)
#pragma unroll
            for (int m = 0; m < 4; ++m) { const size_t row = (size_t)(row0 + ai * HALF + m * 16);
#pragma unroll
                for (int bj = 0; bj < 2; ++bj) { const u32x4 g = *(const u32x4*)(G + row * ldg + colt + bj * HALF);
                    const float* mi = MG + row * ldc + colt + bj * HALF; f32x4 v0 = *(const f32x4*)mi, v1 = *(const f32x4*)(mi + 4);
                    const f32x4 a0 = acc[ai][bj][m][0], a1 = acc[ai][bj][m][1];
                    v0[0] += a0[0] * bf_lo(g.x); v0[1] += a0[1] * bf_hi(g.x); v0[2] += a0[2] * bf_lo(g.y); v0[3] += a0[3] * bf_hi(g.y);
                    v1[0] += a1[0] * bf_lo(g.z); v1[1] += a1[1] * bf_hi(g.z); v1[2] += a1[2] * bf_lo(g.w); v1[3] += a1[3] * bf_hi(g.w);
                    u32x4 w; w.x = cvt_pk_bf16(v0[0], v0[1]); w.y = cvt_pk_bf16(v0[2], v0[3]); w.z = cvt_pk_bf16(v1[0], v1[1]); w.w = cvt_pk_bf16(v1[2], v1[3]);
                    *(u32x4*)(O + row * ldc + colt + bj * HALF) = w; } }
    }
};
template <class Epi, class Sched, bool ALIGN_EPI = false, bool SP2 = false>
__device__ __forceinline__ void gemm_phase(PG8_LAS unsigned char* lds, const Gemm g, const Sched& S, const Epi& E) {
    int tid = threadIdx.x; asm volatile("" : "+v"(tid));
    const int wid = __builtin_amdgcn_readfirstlane(tid >> 6), lane = tid & 63, wr = wid >> 2, wc = wid & 3, fr = lane & 15, fq = lane >> 4;
    const int K = g.K, nt = K / BK;
    unsigned voffA[2], voffB[2];
#pragma unroll
    for (int i = 0; i < 2; ++i) { int R, C; stage_rc(tid * 16 + i * 8192, R, C); const int Rb = Epi::PERM ? ((R & ~31) + perm32(R & 31)) : R;
        voffA[i] = (unsigned)(R * K + C) * 2u; voffB[i] = (unsigned)(Rb * K + C) * 2u; }
    const size_t kstep = (size_t)(BK * 2);
    const size_t hstep = (size_t)HALF * K * 2;
    const size_t tstep = 2 * hstep;
    const unsigned ldsw = (unsigned)wid * 1024u;
    const int aoff = lds_byte(wr * 64 + fr, fq * 8), boff = lds_byte(wc * 32 + fr, fq * 8);
#define PG8_SA(b, h) (((b) * 2 + (h)) * HTB)
#define PG8_SB(b, h) ((4 + (b) * 2 + (h)) * HTB)
#define PG8_STAGE(bufoff, gbase, voff) do { _Pragma("unroll") for (int _i = 0; _i < 2; ++_i) \
        __builtin_amdgcn_global_load_lds((const unsigned*)((const char*)(gbase) + (voff)[_i]), (PG8_LAS unsigned*)(lds + (bufoff) + ldsw + _i * 8192), 16, 0, 0); } while (0)
#define PG8_LDA(dst, b, h) do { _Pragma("unroll") for (int m = 0; m < 4; ++m) _Pragma("unroll") for (int k = 0; k < 2; ++k) dst[m][k] = *(const PG8_LAS bf16x8*)(lds + PG8_SA(b, h) + aoff + m * 2048 + k * 1024); } while (0)
#define PG8_LDB(dst, b, h) do { _Pragma("unroll") for (int n = 0; n < 2; ++n) _Pragma("unroll") for (int k = 0; k < 2; ++k) dst[n][k] = *(const PG8_LAS bf16x8*)(lds + PG8_SB(b, h) + boff + n * 2048 + k * 1024); } while (0)
#define PG8_MMA(ai, bj, At, Bt) do { __builtin_amdgcn_s_setprio(1); _Pragma("unroll") for (int m = 0; m < 4; ++m) _Pragma("unroll") for (int n = 0; n < 2; ++n) _Pragma("unroll") for (int k = 0; k < 2; ++k) \
        acc[ai][bj][m][n] = __builtin_amdgcn_mfma_f32_16x16x32_bf16(Bt[n][k], At[m][k], acc[ai][bj][m][n], 0, 0, 0); __builtin_amdgcn_s_setprio(0); } while (0)
#define PG8_WAIT_V(n) asm volatile("s_waitcnt vmcnt(" #n ")" ::: "memory")
#define PG8_WAIT_L(n) asm volatile("s_waitcnt lgkmcnt(" #n ")" ::: "memory")
#define PG8_BAR __builtin_amdgcn_s_barrier()
#define PG8_SCHED __builtin_amdgcn_sched_barrier(0)
    Unit cur, nxt; int ui = 0;
    if (!S.next(0, cur)) return;
    f32x4 acc[2][2][4][2];
#pragma unroll
    for (int a = 0; a < 2; ++a)
#pragma unroll
        for (int b = 0; b < 2; ++b)
#pragma unroll
            for (int m = 0; m < 4; ++m)
#pragma unroll
                for (int n = 0; n < 2; ++n) acc[a][b][m][n] = (f32x4){0.f, 0.f, 0.f, 0.f};
    bf16x8 At[4][2], B0[2][2], B1[2][2];
    const char* cA = (const char*)g.A + (size_t)cur.pm * tstep; const char* cB = (const char*)g.Bt + (size_t)cur.pn * tstep;
    S.a_ready(cur);
    if constexpr (SP2) {
        PG8_STAGE(PG8_SB(0, 0), cB, voffB); PG8_STAGE(PG8_SB(0, 1), cB + hstep, voffB); PG8_STAGE(PG8_SA(0, 0), cA, voffA); PG8_STAGE(PG8_SA(0, 1), cA + hstep, voffA);
        if (wr == 1) PG8_BAR;
        PG8_WAIT_V(2); PG8_BAR;
        PG8_STAGE(PG8_SB(1, 0), cB + kstep, voffB); PG8_STAGE(PG8_SA(1, 0), cA + kstep, voffA); PG8_STAGE(PG8_SB(1, 1), cB + hstep + kstep, voffB);
        PG8_WAIT_V(6); PG8_BAR;
    } else {
        PG8_STAGE(PG8_SB(0, 0), cB, voffB); PG8_STAGE(PG8_SA(0, 0), cA, voffA); PG8_STAGE(PG8_SB(0, 1), cB + hstep, voffB); PG8_STAGE(PG8_SA(0, 1), cA + hstep, voffA);
        if (wr == 1) PG8_BAR;
        PG8_WAIT_V(4); PG8_BAR;
        PG8_STAGE(PG8_SB(1, 0), cB + kstep, voffB); PG8_STAGE(PG8_SA(1, 0), cA + kstep, voffA); PG8_STAGE(PG8_SB(1, 1), cB + hstep + kstep, voffB);
        PG8_WAIT_V(6); PG8_BAR;
    }
    for (;;) {
        const bool has_next = S.next(ui + 1, nxt);
        const char* nA = has_next ? (const char*)g.A + (size_t)nxt.pm * tstep : cA; const char* nB = has_next ? (const char*)g.Bt + (size_t)nxt.pn * tstep : cB;
        for (int t = 0; t < nt; t += 2) {
            const bool last = (t == nt - 2);
            const char* a1 = cA + (size_t)(t + 1) * kstep;
            const char* a2 = last ? nA : cA + (size_t)(t + 2) * kstep; const char* b2 = last ? nB : cB + (size_t)(t + 2) * kstep;
            const char* a3 = a2 + kstep; const char* b3 = b2 + kstep;
            if (last && has_next) S.a_ready(nxt);
            if constexpr (SP2) {
            PG8_LDB(B0, 0, 0); PG8_LDB(B1, 0, 1); PG8_SCHED; PG8_LDA(At, 0, 0); PG8_STAGE(PG8_SA(1, 1), a1 + hstep, voffA);
            PG8_WAIT_V(8); PG8_WAIT_L(0); PG8_BAR; PG8_MMA(0, 0, At, B0); PG8_MMA(0, 1, At, B1); PG8_BAR; PG8_SCHED;
            PG8_LDA(At, 0, 1); PG8_STAGE(PG8_SB(0, 0), b2, voffB); PG8_STAGE(PG8_SB(0, 1), b2 + hstep, voffB); PG8_STAGE(PG8_SA(0, 0), a2, voffA);
            PG8_WAIT_V(8); PG8_WAIT_L(0); PG8_BAR; PG8_MMA(1, 0, At, B0); PG8_MMA(1, 1, At, B1); PG8_BAR; PG8_SCHED;
            PG8_LDB(B0, 1, 0); PG8_LDB(B1, 1, 1); PG8_SCHED; PG8_LDA(At, 1, 0); PG8_STAGE(PG8_SA(0, 1), a2 + hstep, voffA);
            PG8_WAIT_V(8); PG8_WAIT_L(0); PG8_BAR; PG8_MMA(0, 0, At, B0); PG8_MMA(0, 1, At, B1); PG8_BAR; PG8_SCHED;
            PG8_LDA(At, 1, 1); PG8_STAGE(PG8_SB(1, 0), b3, voffB); PG8_STAGE(PG8_SB(1, 1), b3 + hstep, voffB); PG8_STAGE(PG8_SA(1, 0), a3, voffA);
            PG8_WAIT_V(8); PG8_WAIT_L(0); PG8_BAR; PG8_MMA(1, 0, At, B0); PG8_MMA(1, 1, At, B1); PG8_BAR; PG8_SCHED;
            } else {
            PG8_LDB(B0, 0, 0); PG8_SCHED; PG8_LDA(At, 0, 0); PG8_STAGE(PG8_SA(1, 1), a1 + hstep, voffA);
            PG8_WAIT_L(8); PG8_BAR; PG8_WAIT_L(0); PG8_MMA(0, 0, At, B0); PG8_BAR; PG8_SCHED;
            PG8_LDB(B1, 0, 1); PG8_STAGE(PG8_SB(0, 0), b2, voffB);
            PG8_BAR; PG8_WAIT_L(0); PG8_MMA(0, 1, At, B1); PG8_BAR;
            PG8_LDA(At, 0, 1); PG8_STAGE(PG8_SA(0, 0), a2, voffA);
            PG8_BAR; PG8_WAIT_L(0); PG8_MMA(1, 0, At, B0); PG8_BAR; PG8_SCHED;
            PG8_STAGE(PG8_SB(0, 1), b2 + hstep, voffB);
            PG8_WAIT_V(6); PG8_BAR; PG8_MMA(1, 1, At, B1); PG8_BAR;
            PG8_LDB(B0, 1, 0); PG8_SCHED; PG8_LDA(At, 1, 0); PG8_STAGE(PG8_SA(0, 1), a2 + hstep, voffA);
            PG8_WAIT_L(8); PG8_BAR; PG8_WAIT_L(0); PG8_MMA(0, 0, At, B0); PG8_BAR; PG8_SCHED;
            PG8_LDB(B1, 1, 1); PG8_STAGE(PG8_SB(1, 0), b3, voffB);
            PG8_BAR; PG8_WAIT_L(0); PG8_MMA(0, 1, At, B1); PG8_BAR;
            PG8_LDA(At, 1, 1); PG8_STAGE(PG8_SA(1, 0), a3, voffA);
            PG8_BAR; PG8_WAIT_L(0); PG8_MMA(1, 0, At, B0); PG8_BAR; PG8_SCHED;
            PG8_STAGE(PG8_SB(1, 1), b3 + hstep, voffB);
            PG8_WAIT_V(6); PG8_BAR; PG8_MMA(1, 1, At, B1); PG8_BAR;
            }
        }
        if constexpr (ALIGN_EPI) { if (wr == 0) PG8_BAR; }
        if constexpr (!Epi::AFTER_DRAIN) { E(acc, cur, wr, wc, fr, fq); S.done(cur); }
        if (!has_next) break;
#pragma unroll
        for (int a = 0; a < 2; ++a)
#pragma unroll
            for (int b = 0; b < 2; ++b)
#pragma unroll
                for (int m = 0; m < 4; ++m)
#pragma unroll
                    for (int n = 0; n < 2; ++n) acc[a][b][m][n] = (f32x4){0.f, 0.f, 0.f, 0.f};
        cur = nxt; cA = nA; cB = nB; ++ui;
        if constexpr (ALIGN_EPI) { if (wr == 1) PG8_BAR; }
    }
    PG8_WAIT_V(0);
    if constexpr (!ALIGN_EPI) { if (wr == 0) PG8_BAR; }
    PG8_BAR;
    if constexpr (Epi::AFTER_DRAIN) { E.fused(acc, cur, wr, wc, fr, fq, lds, wid, lane); S.done(cur); }
#undef PG8_SA
#undef PG8_SB
#undef PG8_STAGE
#undef PG8_LDA
#undef PG8_LDB
#undef PG8_MMA
#undef PG8_WAIT_V
#undef PG8_WAIT_L
#undef PG8_BAR
#undef PG8_SCHED
}
}

#ifndef MK_PER_PHASE
#define MK_PER_PHASE 0
#endif
#ifndef PROBE_DOUBLE
#define PROBE_DOUBLE -1
#endif
#define REP(id) for (int rep_ = 0; rep_ < ((PROBE_DOUBLE == (id)) ? 2 : 1); ++rep_)
constexpr int NWAVES = 8, NTHR = 512;
constexpr int BATCH = 2, SEQ = 4096, M = BATCH * SEQ, D = 2048, DEPTH = 4;
constexpr int DI = 4096, NH = 64, HP = 64, NG = 8, HPG = 8, NS = 128, CONVD = 6144;
constexpr int QH = 16, KVH = 4, AD = 128, IH = 16, IDD = 64, TOPK = 256;
constexpr int FF = 4096, FF2 = 8192;
constexpr int NIN = 18576, NMAIN = 18432, NPAD = 18688;
constexpr int PZ = 0, PXBC = 4096, PQ = 10240, PK = 12288, PV = 12800, PQI = 13312, PG = 14336;
constexpr int SMW = 256, SM_DT = 0, SM_KI = 64, SM_WI = 128;
constexpr float EPS = 1e-6f;
constexpr float ATTN_SCALE = 0.08838834764831845f;

constexpr size_t MiB = 1u << 20;
constexpr size_t WS_CTL = 0, CTL_ZERO_BYTES = 1 * MiB;
constexpr size_t WS_W = 2 * MiB;
constexpr size_t WL_IN = 0, WL_SSM = 73 * MiB, WL_ATT = 89 * MiB, WL_MIX = 97 * MiB, WL_UP = 105 * MiB, WL_DN = 137 * MiB, WL_SIZE = 153 * MiB;
constexpr size_t WS_H = WS_W + DEPTH * WL_SIZE;
constexpr size_t WS_P = WS_H + 32 * MiB;
constexpr size_t WS_SM = WS_P + 288 * MiB;
constexpr size_t WS_XC = WS_SM + 8 * MiB;
constexpr size_t WS_DT = WS_XC + 96 * MiB;
constexpr size_t WS_ACS = WS_DT + 2 * MiB;
constexpr size_t WS_ST = WS_ACS + 2 * MiB;
constexpr size_t WS_Y = WS_ST + 256 * MiB;
constexpr size_t WS_SC = WS_Y + 64 * MiB;
constexpr size_t WS_IDX = WS_SC + 128 * MiB;
constexpr size_t WS_CNT = WS_IDX + 8 * MiB;
constexpr size_t WS_AO = WS_CNT + 1 * MiB;
constexpr size_t WS_MG = WS_AO + 32 * MiB;
constexpr size_t WS_MGB = WS_MG + 64 * MiB;
constexpr size_t WS_YM = WS_MGB + 32 * MiB;
constexpr size_t WS_U = WS_YM + 64 * MiB;
constexpr size_t WS_ACT = WS_U + 128 * MiB;
constexpr size_t WS_KIB = WS_ACT + 64 * MiB;
constexpr size_t WS_END = WS_KIB + 1 * MiB;
constexpr int CW_BAR = 4096;

constexpr int RING_BYTES = 131072, LDSCTL_OFF = RING_BYTES, MISC_OFF = LDSCTL_OFF + 320, LDS_BYTES = 147456;

#define LAS __attribute__((address_space(3)))
typedef unsigned short bf16;
typedef float f32x4 __attribute__((ext_vector_type(4)));
typedef short bf16x8 __attribute__((ext_vector_type(8)));
typedef unsigned u32x4 __attribute__((ext_vector_type(4)));
typedef unsigned u32x2 __attribute__((ext_vector_type(2)));
#define LDS_WAIT() asm volatile("s_waitcnt lgkmcnt(0)" ::: "memory")

__device__ __forceinline__ unsigned f2bf(float f) { unsigned u = __builtin_bit_cast(unsigned, f); return (u + 0x7fffu + ((u >> 16) & 1u)) >> 16; }
__device__ __forceinline__ unsigned pk2(float lo, float hi) { return f2bf(lo) | (f2bf(hi) << 16); }
__device__ __forceinline__ float bflo(unsigned w) { return __uint_as_float(w << 16); }
__device__ __forceinline__ float bfhi(unsigned w) { return __uint_as_float(w & 0xffff0000u); }
__device__ __forceinline__ void unpack8(const u32x4 w, float (&f)[8]) { f[0] = bflo(w.x); f[1] = bfhi(w.x); f[2] = bflo(w.y); f[3] = bfhi(w.y); f[4] = bflo(w.z); f[5] = bfhi(w.z); f[6] = bflo(w.w); f[7] = bfhi(w.w); }
__device__ __forceinline__ u32x4 pack8(const float (&f)[8]) { u32x4 w; w.x = pk2(f[0], f[1]); w.y = pk2(f[2], f[3]); w.z = pk2(f[4], f[5]); w.w = pk2(f[6], f[7]); return w; }
__device__ __forceinline__ float wave_sum(float v) {
#pragma unroll
    for (int o = 1; o < 64; o <<= 1) v += __shfl_xor(v, o);
    return v;
}
__device__ __forceinline__ float wave_max(float v) {
#pragma unroll
    for (int o = 1; o < 64; o <<= 1) v = fmaxf(v, __shfl_xor(v, o));
    return v;
}
__device__ __forceinline__ float siluf_(float x) { return x / (1.0f + __expf(-x)); }

#define XB_TMO      128
#define XB_XCNT(j)  (256  + 64 * (j))
#define XB_XSUB(j)  (1280 + 64 * (j))
#define XB_XGEN(j)  (2304 + 64 * (j))
#define XB_TOP      3328
#define XB_TOPGEN   3392
#define XCD_BAR_WORDS 3456
#define XB_SPIN_CAP (1u << 18)

__device__ __forceinline__ unsigned xb_ld(unsigned* p)              { return __hip_atomic_load(p, __ATOMIC_RELAXED, __HIP_MEMORY_SCOPE_AGENT); }
__device__ __forceinline__ unsigned xb_add(unsigned* p, unsigned v) { return __hip_atomic_fetch_add(p, v, __ATOMIC_RELAXED, __HIP_MEMORY_SCOPE_AGENT); }
__device__ __forceinline__ unsigned xb_xcc_id() { return (unsigned)__builtin_amdgcn_s_getreg((3 << 11) | 20) & 0xFu; }
#define XB_SPIN(cond, bar) do { unsigned _sp = 0; while (cond) { __builtin_amdgcn_s_sleep(1); \
    if ((++_sp & 255u) == 0u) { if (xb_ld(&(bar)[XB_TMO])) break; if (_sp > XB_SPIN_CAP) { atomicAdd(&(bar)[XB_TMO], 1u); break; } } } } while (0)

struct XcdBarrier {
    unsigned* bar; unsigned x;
    volatile LAS unsigned* st;
};

__device__ __forceinline__ XcdBarrier xcd_barrier_post(unsigned* bar, volatile LAS unsigned* st) {
    XcdBarrier b; b.bar = bar; b.x = xb_xcc_id(); b.st = st;
    if (threadIdx.x == 0) (void)xb_add(&bar[XB_XCNT(b.x)], 1u);
    return b;
}
__device__ __forceinline__ void xcd_barrier_complete(unsigned* bar, unsigned x, unsigned& nloc, unsigned& nx) {
    const unsigned G = gridDim.x * gridDim.y * gridDim.z;
    unsigned sum, cnt, mine, sp = 0u;
    for (;;) {
        sum = 0u; cnt = 0u; mine = 0u;
#pragma unroll
        for (unsigned j = 0; j < 16; ++j) { const unsigned c = xb_ld(&bar[XB_XCNT(j)]); sum += c; cnt += (c > 0u) ? 1u : 0u; mine = (j == x) ? c : mine; }
        if (sum == G) break;
        __builtin_amdgcn_s_sleep(1);
        if ((++sp & 255u) == 0u) { if (xb_ld(&bar[XB_TMO])) break; if (sp > XB_SPIN_CAP) { atomicAdd(&bar[XB_TMO], 1u); break; } }
    }
    nloc = mine > 0u ? mine : 1u; nx = cnt > 0u ? cnt : 1u;
}

__device__ __forceinline__ void xcd_barrier(const XcdBarrier& b) {
    asm volatile("s_waitcnt vmcnt(0)" ::: "memory");
    __syncthreads();
    if (threadIdx.x == 0) {
        unsigned* bar = b.bar;
        __builtin_amdgcn_s_waitcnt(0);
        unsigned nloc = b.st[0], nx = b.st[1];
        if (nloc == 0u) { xcd_barrier_complete(bar, b.x, nloc, nx); b.st[0] = nloc; b.st[1] = nx; }
        const unsigned old = xb_add(&bar[XB_XSUB(b.x)], 1u);
        const unsigned gen = old / nloc;
        if (old + 1u == (gen + 1u) * nloc) {
            __builtin_amdgcn_fence(__ATOMIC_RELEASE, "agent");
            asm volatile("s_waitcnt vmcnt(0)" ::: "memory");
            const unsigned og = xb_add(&bar[XB_TOP], 1u);
            const unsigned tg = og / nx;
            if (og + 1u == (tg + 1u) * nx) xb_add(&bar[XB_TOPGEN], 1u);
            else XB_SPIN(xb_ld(&bar[XB_TOPGEN]) == tg, bar);
            __builtin_amdgcn_fence(__ATOMIC_ACQUIRE, "agent");
            xb_add(&bar[XB_XGEN(b.x)], 1u);
            asm volatile("s_waitcnt vmcnt(0)" ::: "memory");
        } else {
            XB_SPIN(xb_ld(&bar[XB_XGEN(b.x)]) == gen, bar);
            __builtin_amdgcn_fence(__ATOMIC_ACQUIRE, "agent");
            asm volatile("s_waitcnt vmcnt(0)" ::: "memory");
        }
    }
    __syncthreads();
}


__device__ __forceinline__ void ph_resid_norm(const float* Yin, const float* gpost, const float* gnext, const float* Xin, float* X, bf16* H, int gw, int ngw, int lane) {
    for (int m = gw; m < M; m += ngw) {
        const f32x4* xr = (const f32x4*)(Xin + (size_t)m * D) + lane;
        f32x4 xv[8];
#pragma unroll
        for (int j = 0; j < 8; ++j) xv[j] = xr[64 * j];
        if (Yin) {
            const f32x4* yr = (const f32x4*)(Yin + (size_t)m * D) + lane; f32x4 yv[8]; float ss = 0.f;
#pragma unroll
            for (int j = 0; j < 8; ++j) { yv[j] = yr[64 * j]; ss += (yv[j].x * yv[j].x + yv[j].y * yv[j].y) + (yv[j].z * yv[j].z + yv[j].w * yv[j].w); }
            const float rstd = rsqrtf(wave_sum(ss) * (1.0f / D) + EPS);
#pragma unroll
            for (int j = 0; j < 8; ++j) { const f32x4 g = ((const f32x4*)gpost + lane)[64 * j]; xv[j] = xv[j] + yv[j] * rstd * g; }
        }
        if (Yin || Xin != X) { f32x4* xo = (f32x4*)(X + (size_t)m * D) + lane;
#pragma unroll
            for (int j = 0; j < 8; ++j) xo[64 * j] = xv[j]; }
        if (gnext) {
            float ss = 0.f;
#pragma unroll
            for (int j = 0; j < 8; ++j) ss += (xv[j].x * xv[j].x + xv[j].y * xv[j].y) + (xv[j].z * xv[j].z + xv[j].w * xv[j].w);
            const float rstd = rsqrtf(wave_sum(ss) * (1.0f / D) + EPS);
            u32x2* ho = (u32x2*)(H + (size_t)m * D) + lane;
#pragma unroll
            for (int j = 0; j < 8; ++j) { const f32x4 g = ((const f32x4*)gnext + lane)[64 * j]; const f32x4 h = xv[j] * rstd * g; u32x2 w; w.x = pk2(h.x, h.y); w.y = pk2(h.z, h.w); ho[64 * j] = w; }
        }
    }
}

__device__ __forceinline__ void tr_item(const float* W, int ldw, int K, int k0, int nsrc, int ncols, bf16* WT, int ndst, float* scr, int lane) {
    const int j = lane & 31;
#pragma unroll 8
    for (int i = 0; i < 32; ++i) { const int kk = 2 * i + (lane >> 5); scr[kk * 33 + j] = (j < ncols) ? W[(size_t)(k0 + kk) * ldw + nsrc + j] : 0.f; }
    LDS_WAIT();
    const int c = lane & 7;
#pragma unroll
    for (int jj = 0; jj < 4; ++jj) { const int n = (lane >> 3) + 8 * jj; const float* s = scr + (8 * c) * 33 + n;
        u32x4 o; o.x = pk2(s[0 * 33], s[1 * 33]); o.y = pk2(s[2 * 33], s[3 * 33]); o.z = pk2(s[4 * 33], s[5 * 33]); o.w = pk2(s[6 * 33], s[7 * 33]);
        *(u32x4*)(WT + (size_t)(ndst + n) * K + k0 + 8 * c) = o; }
    LDS_WAIT();
}
__device__ __forceinline__ void win_map(int dstrow, int& src, int& ncols) {
    ncols = 32;
    if (dstrow < 10240) src = dstrow;
    else if (dstrow < 12288) src = dstrow - 10240 + 10304;
    else if (dstrow < 12800) src = dstrow - 12288 + 12352;
    else if (dstrow < 13312) src = dstrow - 12800 + 12864;
    else if (dstrow < 14336) src = dstrow - 13312 + 13376;
    else if (dstrow < 18432) src = dstrow - 14336 + 14480;
    else if (dstrow < 18496) src = dstrow - 18432 + 10240;
    else if (dstrow < 18560) src = dstrow - 18496 + 14400;
    else if (dstrow == 18560) { src = 14464; ncols = 16; }
    else { src = 0; ncols = 0; }
}
struct WPtrs { const float *w_in, *w_ssm, *w_att, *w_mix, *w_up, *w_dn; };
__device__ __forceinline__ void ph_weights(const WPtrs wp, unsigned char* ws, float* scr, int gw, int ngw, int lane) {
    constexpr int I_IN = (NPAD / 32) * (D / 64), I_SSM = (D / 32) * (DI / 64), I_ATT = (D / 32) * (D / 64), I_MIX = I_ATT, I_UP = (FF2 / 32) * (D / 64), I_DN = (D / 32) * (FF / 64);
    constexpr int I_L = I_IN + I_SSM + I_ATT + I_MIX + I_UP + I_DN;
    for (int it = gw; it < DEPTH * I_L; it += ngw) {
        const int layer = it / I_L; int r = it % I_L;
        unsigned char* wl = ws + WS_W + (size_t)layer * WL_SIZE;
        if (r < I_IN) { const int nblk = NPAD / 32, kb = r / nblk, nb = r % nblk; int src, nc; win_map(nb * 32, src, nc);
            tr_item(wp.w_in + (size_t)layer * D * NIN, NIN, D, kb * 64, src, nc, (bf16*)(wl + WL_IN), nb * 32, scr, lane); continue; }
        r -= I_IN;
        if (r < I_SSM) { const int nblk = D / 32, kb = r / nblk, nb = r % nblk; tr_item(wp.w_ssm + (size_t)layer * DI * D, D, DI, kb * 64, nb * 32, 32, (bf16*)(wl + WL_SSM), nb * 32, scr, lane); continue; }
        r -= I_SSM;
        if (r < I_ATT) { const int nblk = D / 32, kb = r / nblk, nb = r % nblk; tr_item(wp.w_att + (size_t)layer * D * D, D, D, kb * 64, nb * 32, 32, (bf16*)(wl + WL_ATT), nb * 32, scr, lane); continue; }
        r -= I_ATT;
        if (r < I_MIX) { const int nblk = D / 32, kb = r / nblk, nb = r % nblk; tr_item(wp.w_mix + (size_t)layer * D * D, D, D, kb * 64, nb * 32, 32, (bf16*)(wl + WL_MIX), nb * 32, scr, lane); continue; }
        r -= I_MIX;
        if (r < I_UP) { const int nblk = FF2 / 32, kb = r / nblk, nb = r % nblk; tr_item(wp.w_up + (size_t)layer * D * FF2, FF2, D, kb * 64, nb * 32, 32, (bf16*)(wl + WL_UP), nb * 32, scr, lane); continue; }
        r -= I_UP;
        { const int nblk = D / 32, kb = r / nblk, nb = r % nblk; tr_item(wp.w_dn + (size_t)layer * FF * D, D, FF, kb * 64, nb * 32, 32, (bf16*)(wl + WL_DN), nb * 32, scr, lane); }
    }
}

__device__ __forceinline__ void ph_index_scores(const bf16* P, const float* SM, const bf16* KIB, float* SC, int blk, int nblk, int wave, int lane) {
    for (int u0 = blk; u0 < 256; u0 += nblk) {
#pragma unroll 1
        for (int half = 0; half < 2; ++half) {
            const int b = half, qt = half ? 255 - u0 : u0;
            const int q0 = b * SEQ + qt * 16, nkt = ((qt * 16) / 64 + 1) * 4;
            const int qrow = q0 + (lane & 15), kq = 8 * (lane >> 4);
            bf16x8 bq[IH][2]; float w[IH];
#pragma unroll
            for (int h = 0; h < IH; ++h) {
#pragma unroll
                for (int ks = 0; ks < 2; ++ks) bq[h][ks] = *(const bf16x8*)(P + (size_t)qrow * NMAIN + PQI + h * IDD + ks * 32 + kq);
                w[h] = SM[(size_t)qrow * SMW + SM_WI + h]; }
            for (int kt = wave; kt < nkt; kt += NWAVES) {
                const int key0 = kt * 16; const bf16* kp = KIB + (size_t)(b * SEQ + key0 + (lane & 15)) * IDD + kq;
                const bf16x8 a0 = *(const bf16x8*)kp, a1 = *(const bf16x8*)(kp + 32);
                f32x4 sc = (f32x4){0.f, 0.f, 0.f, 0.f};
#pragma unroll
                for (int h = 0; h < IH; ++h) { f32x4 c = (f32x4){0.f, 0.f, 0.f, 0.f};
                    c = __builtin_amdgcn_mfma_f32_16x16x32_bf16(a0, bq[h][0], c, 0, 0, 0); c = __builtin_amdgcn_mfma_f32_16x16x32_bf16(a1, bq[h][1], c, 0, 0, 0);
                    sc.x += w[h] * fmaxf(c.x, 0.f); sc.y += w[h] * fmaxf(c.y, 0.f); sc.z += w[h] * fmaxf(c.z, 0.f); sc.w += w[h] * fmaxf(c.w, 0.f); }
                *(f32x4*)(SC + (size_t)qrow * SEQ + key0 + 4 * (lane >> 4)) = sc;
            }
        }
    }
}

__device__ __forceinline__ void ph_topk(const float* SC, unsigned long long* MASKW, int gw, int ngw, int lane) {
    for (int m = gw; m < M; m += ngw) {
        const int t = m & (SEQ - 1), limit = (t / 64 + 1) * 64;
        unsigned long long* mw = MASKW + (size_t)m * 64;
        if (limit <= TOPK) { if (lane < limit / 64) mw[lane] = ~0ull; continue; }
        unsigned u[64];
#pragma unroll
        for (int j = 0; j < 64; ++j) { const int key = j * 64 + lane; unsigned v = 0u;
            if (key < limit) { const unsigned bits = __float_as_uint(SC[(size_t)m * SEQ + key]); v = (bits & 0x80000000u) ? ~bits : (bits | 0x80000000u); }
            u[j] = v; }
        unsigned T = 0u;
#pragma unroll 1
        for (int bit = 31; bit >= 0; --bit) { const unsigned cand = T | (1u << bit); int cnt = 0;
#pragma unroll
            for (int j = 0; j < 64; ++j) cnt += __popcll(__ballot(u[j] >= cand));
            if (cnt >= TOPK) T = cand; }
        int cgt = 0;
#pragma unroll
        for (int j = 0; j < 64; ++j) cgt += __popcll(__ballot(u[j] > T));
        const int need_eq = TOPK - cgt; int eqbase = 0;
        const unsigned long long lt_mask = (1ull << lane) - 1ull;
#pragma unroll
        for (int j = 0; j < 64; ++j) {
            const bool gt = u[j] > T, eq = u[j] == T;
            const unsigned long long eqm = __ballot(eq);
            const bool take = gt || (eq && (eqbase + __popcll(eqm & lt_mask) < need_eq));
            const unsigned long long tm = __ballot(take);
            if (lane == 0 && j * 64 < limit) mw[j] = tm;
            eqbase += __popcll(eqm);
        }
    }
}

typedef short s16x4 __attribute__((ext_vector_type(4)));
__device__ __forceinline__ s16x4 lds_tr4(const LAS unsigned char* p) { return __builtin_bit_cast(s16x4, __builtin_amdgcn_ds_read_tr16_b64_v4i16((LAS s16x4*)p)); }
__device__ __forceinline__ void ph_attn_dense(const bf16* P, const unsigned long long* MASKW, bf16* AO, LAS unsigned char* lds, int blk, int nblk, int tid) {
    constexpr int KS = 272, VS = 288, KBUF = 64 * KS, VBUF = 64 * VS, VOFF = 2 * KBUF;
    const int lane = tid & 63, wave = __builtin_amdgcn_readfirstlane(tid >> 6), g = lane >> 4, c16 = lane & 15;
    const int hq = wave >> 1, qh = (wave & 1) * 32;
    const float SCL = ATTN_SCALE * 1.4426950408889634f;
    for (int u0 = blk; u0 < 256; u0 += nblk) {
#pragma unroll 1
        for (int half = 0; half < 2; ++half) {
            const int b = u0 >> 7, kvh = (u0 >> 5) & 3, cc = u0 & 31, c = half ? 63 - cc : cc, nt = c + 1;
            const int m0 = b * SEQ + c * 64;
            bf16x8 qf[2][4];
#pragma unroll
            for (int qt = 0; qt < 2; ++qt)
#pragma unroll
                for (int kd = 0; kd < 4; ++kd) qf[qt][kd] = *(const bf16x8*)(P + (size_t)(m0 + qh + 16 * qt + c16) * NMAIN + PQ + (kvh * 4 + hq) * AD + 32 * kd + 8 * g);
            f32x4 O[2][8];
#pragma unroll
            for (int qt = 0; qt < 2; ++qt)
#pragma unroll
                for (int dt = 0; dt < 8; ++dt) O[qt][dt] = (f32x4){0.f, 0.f, 0.f, 0.f};
            float mrun[2] = {-__builtin_inff(), -__builtin_inff()}, lrun[2] = {0.f, 0.f};
            const bf16* kvbase = P + (size_t)(b * SEQ) * NMAIN + kvh * AD;
            u32x4 kreg[2], vreg[2];
#define ATT_LOAD(t) do { _Pragma("unroll") for (int i = 0; i < 2; ++i) { const int id = tid + 512 * i; const bf16* src = kvbase + (size_t)((t) * 64 + (id >> 4)) * NMAIN + (id & 15) * 8; \
                kreg[i] = *(const u32x4*)(src + PK); vreg[i] = *(const u32x4*)(src + PV); } } while (0)
#define ATT_STORE(buf) do { _Pragma("unroll") for (int i = 0; i < 2; ++i) { const int id = tid + 512 * i; \
                *(LAS u32x4*)(lds + (buf) * KBUF + (id >> 4) * KS + (id & 15) * 16) = kreg[i]; *(LAS u32x4*)(lds + VOFF + (buf) * VBUF + (id >> 4) * VS + (id & 15) * 16) = vreg[i]; } } while (0)
            __syncthreads();
            ATT_LOAD(0); ATT_STORE(0);
            __syncthreads();
            for (int t = 0; t < nt; ++t) {
                const int buf = t & 1;
                if (t + 1 < nt) ATT_LOAD(t + 1);
                const LAS unsigned char* kb = lds + buf * KBUF + c16 * KS + g * 16;
                const LAS unsigned char* vb = lds + VOFF + buf * VBUF + (4 * g + (c16 >> 2)) * VS + (c16 & 3) * 8;
                f32x4 S[2][4];
#pragma unroll
                for (int kt = 0; kt < 4; ++kt) {
                    bf16x8 kf[4];
#pragma unroll
                    for (int kd = 0; kd < 4; ++kd) kf[kd] = *(const LAS bf16x8*)(kb + kt * 16 * KS + kd * 64);
#pragma unroll
                    for (int qt = 0; qt < 2; ++qt) { f32x4 s = (f32x4){0.f, 0.f, 0.f, 0.f};
#pragma unroll
                        for (int kd = 0; kd < 4; ++kd) s = __builtin_amdgcn_mfma_f32_16x16x32_bf16(kf[kd], qf[qt][kd], s, 0, 0, 0);
                        S[qt][kt] = s; }
                }
                bf16x8 pf[2][2];
#pragma unroll
                for (int qt = 0; qt < 2; ++qt) {
                    const unsigned long long mw = MASKW[(size_t)(m0 + qh + 16 * qt + c16) * 64 + t] >> (4 * g);
                    const unsigned mlo = (unsigned)mw, mhi = (unsigned)(mw >> 32);
                    float mx = -__builtin_inff();
#pragma unroll
                    for (int kt = 0; kt < 4; ++kt)
#pragma unroll
                        for (int j = 0; j < 4; ++j) { const unsigned word = kt < 2 ? mlo : mhi; const bool on = (word >> ((kt & 1) * 16 + j)) & 1u;
                            const float s = on ? S[qt][kt][j] * SCL : -__builtin_inff(); S[qt][kt][j] = s; mx = fmaxf(mx, s); }
                    mx = fmaxf(mx, __shfl_xor(mx, 16)); mx = fmaxf(mx, __shfl_xor(mx, 32));
                    const float mnew = fmaxf(mrun[qt], mx), muse = (mnew == -__builtin_inff()) ? 0.f : mnew;
                    const float alpha = __builtin_amdgcn_exp2f(mrun[qt] - muse);
                    float ps = 0.f;
#pragma unroll
                    for (int kt = 0; kt < 4; ++kt)
#pragma unroll
                        for (int j = 0; j < 4; ++j) { const float p = __builtin_amdgcn_exp2f(S[qt][kt][j] - muse); S[qt][kt][j] = p; ps += p; }
                    ps += __shfl_xor(ps, 16); ps += __shfl_xor(ps, 32);
                    lrun[qt] = lrun[qt] * alpha + ps; mrun[qt] = mnew;
#pragma unroll
                    for (int dt = 0; dt < 8; ++dt) O[qt][dt] *= alpha;
#pragma unroll
                    for (int ks = 0; ks < 2; ++ks) { u32x4 w; w.x = pk2(S[qt][2 * ks][0], S[qt][2 * ks][1]); w.y = pk2(S[qt][2 * ks][2], S[qt][2 * ks][3]);
                        w.z = pk2(S[qt][2 * ks + 1][0], S[qt][2 * ks + 1][1]); w.w = pk2(S[qt][2 * ks + 1][2], S[qt][2 * ks + 1][3]); pf[qt][ks] = __builtin_bit_cast(bf16x8, w); }
                }
#pragma unroll
                for (int dt = 0; dt < 8; ++dt)
#pragma unroll
                    for (int ks = 0; ks < 2; ++ks) {
                        const s16x4 lo = lds_tr4(vb + (32 * ks) * VS + dt * 32), hi = lds_tr4(vb + (32 * ks + 16) * VS + dt * 32);
                        const bf16x8 vf = __builtin_shufflevector(lo, hi, 0, 1, 2, 3, 4, 5, 6, 7);
                        O[0][dt] = __builtin_amdgcn_mfma_f32_16x16x32_bf16(vf, pf[0][ks], O[0][dt], 0, 0, 0);
                        O[1][dt] = __builtin_amdgcn_mfma_f32_16x16x32_bf16(vf, pf[1][ks], O[1][dt], 0, 0, 0);
                    }
                if (t + 1 < nt) ATT_STORE(buf ^ 1);
                __syncthreads();
            }
#undef ATT_LOAD
#undef ATT_STORE
#pragma unroll
            for (int qt = 0; qt < 2; ++qt) { const float r = 1.0f / lrun[qt];
                bf16* op = AO + (size_t)(m0 + qh + 16 * qt + c16) * D + (kvh * 4 + hq) * AD + 4 * g;
#pragma unroll
                for (int dt = 0; dt < 8; ++dt) { const f32x4 o = O[qt][dt] * r; u32x2 w; w.x = pk2(o.x, o.y); w.y = pk2(o.z, o.w); *(u32x2*)(op + 16 * dt) = w; } }
        }
    }
}

__device__ __forceinline__ void stage_conv(const bf16* P, const float* cw, const float* cb, int m0, int tpos0, int ch0, int nch, LAS unsigned char* dst, int stride, int tid) {
    const int cpr = nch >> 3;
    for (int id = tid; id < 64 * cpr; id += NTHR) {
        const int s = id / cpr, k = id - s * cpr, ch = ch0 + 8 * k;
        float acc[8];
        { const f32x4 b0 = *(const f32x4*)(cb + ch), b1 = *(const f32x4*)(cb + ch + 4); acc[0] = b0.x; acc[1] = b0.y; acc[2] = b0.z; acc[3] = b0.w; acc[4] = b1.x; acc[5] = b1.y; acc[6] = b1.z; acc[7] = b1.w; }
#pragma unroll
        for (int i = 0; i < 4; ++i) { if (tpos0 + s - 3 + i >= 0) {
            float x[8]; unpack8(*(const u32x4*)(P + (size_t)(m0 + s - 3 + i) * NMAIN + PXBC + ch), x);
            const f32x4 w0 = *(const f32x4*)(cw + i * CONVD + ch), w1 = *(const f32x4*)(cw + i * CONVD + ch + 4);
            acc[0] += w0.x * x[0]; acc[1] += w0.y * x[1]; acc[2] += w0.z * x[2]; acc[3] += w0.w * x[3]; acc[4] += w1.x * x[4]; acc[5] += w1.y * x[5]; acc[6] += w1.z * x[6]; acc[7] += w1.w * x[7]; } }
#pragma unroll
        for (int j = 0; j < 8; ++j) acc[j] = siluf_(acc[j]);
        *(LAS u32x4*)(dst + s * stride + k * 16) = pack8(acc);
    }
}
__device__ __forceinline__ void wave_dt_acs(const float* SM, const float* dt_bias, const float* a_log, int m0, int head, LAS float* dtw, LAS float* acsw, int lane) {
    const float raw = SM[(size_t)(m0 + lane) * SMW + SM_DT + head] + dt_bias[head];
    const float dt = fmaxf(raw, 0.f) + log1pf(__expf(-fabsf(raw)));
    float x = dt * (-__expf(a_log[head]));
#pragma unroll
    for (int o = 1; o < 64; o <<= 1) { const float v = __shfl_up(x, o); if (lane >= o) x += v; }
    dtw[lane] = dt; acsw[lane] = x;
}
__device__ __forceinline__ bf16x8 tr8(const LAS unsigned char* p, int off_lo, int off_hi) {
    const s16x4 lo = lds_tr4(p + off_lo), hi = lds_tr4(p + off_hi); return __builtin_shufflevector(lo, hi, 0, 1, 2, 3, 4, 5, 6, 7);
}
__device__ __forceinline__ void ph_ssd_states(const bf16* P, const float* SM, const float* cw, const float* cb, const float* dt_bias, const float* a_log, bf16* ST, float* CD,
                                              LAS unsigned char* lds, int blk, int nblk, int tid) {
    constexpr int RSX = 1056, RSB = 288, O_BM = 64 * RSX, O_DT = O_BM + 64 * RSB, O_ACS = O_DT + 2048;
    const int lane = tid & 63, wave = __builtin_amdgcn_readfirstlane(tid >> 6), gq = lane >> 4, c16 = lane & 15;
    for (int item = blk; item < BATCH * 64 * NG; item += nblk) {
        const int bc = item >> 3, g = item & 7, m0 = bc * 64, tpos0 = (bc & 63) * 64, head = g * HPG + wave;
        __syncthreads();
        stage_conv(P, cw, cb, m0, tpos0, g * 512, 512, lds, RSX, tid);
        stage_conv(P, cw, cb, m0, tpos0, DI + g * NS, NS, lds + O_BM, RSB, tid);
        LAS float* dtw = (LAS float*)(lds + O_DT) + wave * 64; LAS float* acsw = (LAS float*)(lds + O_ACS) + wave * 64;
        wave_dt_acs(SM, dt_bias, a_log, m0, head, dtw, acsw, lane);
        __syncthreads();
        const float aend = acsw[63];
        if (lane == 0) CD[bc * NH + head] = __expf(aend);
        const LAS unsigned char* xb = lds + (4 * gq + (c16 >> 2)) * RSX + wave * 128 + (c16 & 3) * 8;
        const LAS unsigned char* bb = lds + O_BM + (4 * gq + (c16 >> 2)) * RSB + (c16 & 3) * 8;
        bf16x8 xf[4][2];
#pragma unroll
        for (int ks = 0; ks < 2; ++ks) { float w[8];
#pragma unroll
            for (int j = 0; j < 8; ++j) { const int s = 32 * ks + 16 * (j >> 2) + 4 * gq + (j & 3); w[j] = dtw[s] * __expf(aend - acsw[s]); }
#pragma unroll
            for (int pt = 0; pt < 4; ++pt) { const bf16x8 r = tr8(xb + pt * 32, (32 * ks) * RSX, (32 * ks + 16) * RSX); float f[8]; unpack8(__builtin_bit_cast(u32x4, r), f);
#pragma unroll
                for (int j = 0; j < 8; ++j) f[j] *= w[j];
                xf[pt][ks] = __builtin_bit_cast(bf16x8, pack8(f)); } }
        bf16* dst = ST + (((size_t)bc * NH + head) * HP + c16) * NS + 4 * gq;
#pragma unroll 2
        for (int nt = 0; nt < 8; ++nt) {
            const bf16x8 a0 = tr8(bb + nt * 32, 0, 16 * RSB), a1 = tr8(bb + nt * 32, 32 * RSB, 48 * RSB);
#pragma unroll
            for (int pt = 0; pt < 4; ++pt) { f32x4 acc = (f32x4){0.f, 0.f, 0.f, 0.f};
                acc = __builtin_amdgcn_mfma_f32_16x16x32_bf16(a0, xf[pt][0], acc, 0, 0, 0); acc = __builtin_amdgcn_mfma_f32_16x16x32_bf16(a1, xf[pt][1], acc, 0, 0, 0);
                u32x2 o; o.x = pk2(acc.x, acc.y); o.y = pk2(acc.z, acc.w); *(u32x2*)(dst + (size_t)(16 * pt) * NS + 16 * nt) = o; }
        }
    }
}
__device__ __forceinline__ void ph_ssd_scan(bf16* ST, const float* CD, int gtid, int nthr) {
    for (int it = gtid; it < BATCH * NH * HP * (NS / 8); it += nthr) {
        const int n8 = it & 15, p = (it >> 4) & 63, head = (it >> 10) & 63, b = it >> 16;
        float h[8];
#pragma unroll
        for (int j = 0; j < 8; ++j) h[j] = 0.f;
#pragma unroll 8
        for (int c = 0; c < 64; ++c) { u32x4* q = (u32x4*)(ST + ((((size_t)(b * 64 + c)) * NH + head) * HP + p) * NS) + n8;
            float v[8]; unpack8(*q, v); *q = pack8(h); const float dec = CD[(b * 64 + c) * NH + head];
#pragma unroll
            for (int j = 0; j < 8; ++j) h[j] = h[j] * dec + v[j]; }
    }
}
__device__ __forceinline__ void ph_ssd_out(const bf16* P, const float* SM, const float* cw, const float* cb, const float* dt_bias, const float* a_log, const bf16* ST,
                                           const float* dskip, const float* gnorm, bf16* Y, LAS unsigned char* lds, int blk, int nblk, int tid) {
    constexpr int RSX = 1056, RSR = 272, O_BM = 64 * RSX, O_CM = O_BM + 64 * RSR, O_DT = O_CM + 64 * RSR, O_ACS = O_DT + 2048, O_SSQ = O_ACS + 2048;
    const int lane = tid & 63, wave = __builtin_amdgcn_readfirstlane(tid >> 6), gq = lane >> 4, c16 = lane & 15;
    for (int item = blk; item < BATCH * 64 * NG; item += nblk) {
        const int bc = item >> 3, g = item & 7, m0 = bc * 64, tpos0 = (bc & 63) * 64, head = g * HPG + wave;
        __syncthreads();
        stage_conv(P, cw, cb, m0, tpos0, g * 512, 512, lds, RSX, tid);
        stage_conv(P, cw, cb, m0, tpos0, DI + g * NS, NS, lds + O_BM, RSR, tid);
        stage_conv(P, cw, cb, m0, tpos0, DI + NG * NS + g * NS, NS, lds + O_CM, RSR, tid);
        LAS float* dtw = (LAS float*)(lds + O_DT) + wave * 64; LAS float* acsw = (LAS float*)(lds + O_ACS) + wave * 64;
        wave_dt_acs(SM, dt_bias, a_log, m0, head, dtw, acsw, lane);
        __syncthreads();
        bf16x8 cf[4][4];
#pragma unroll
        for (int lt = 0; lt < 4; ++lt)
#pragma unroll
            for (int kn = 0; kn < 4; ++kn) cf[lt][kn] = *(const LAS bf16x8*)(lds + O_CM + (16 * lt + c16) * RSR + kn * 64 + gq * 16);
        float al[4];
#pragma unroll
        for (int lt = 0; lt < 4; ++lt) al[lt] = acsw[16 * lt + c16];
        bf16x8 lf[2][4];
#pragma unroll
        for (int ks = 0; ks < 2; ++ks) {
            f32x4 lt4[2][4];
#pragma unroll
            for (int h2 = 0; h2 < 2; ++h2) { const int st = 2 * ks + h2;
                bf16x8 bfr[4];
#pragma unroll
                for (int kn = 0; kn < 4; ++kn) bfr[kn] = *(const LAS bf16x8*)(lds + O_BM + (16 * st + c16) * RSR + kn * 64 + gq * 16);
                float as_[4], ds_[4];
#pragma unroll
                for (int j = 0; j < 4; ++j) { as_[j] = acsw[16 * st + 4 * gq + j]; ds_[j] = dtw[16 * st + 4 * gq + j]; }
#pragma unroll
                for (int lt = 0; lt < 4; ++lt) { f32x4 t4 = (f32x4){0.f, 0.f, 0.f, 0.f};
                    if (lt >= st) {
#pragma unroll
                        for (int kn = 0; kn < 4; ++kn) t4 = __builtin_amdgcn_mfma_f32_16x16x32_bf16(bfr[kn], cf[lt][kn], t4, 0, 0, 0);
#pragma unroll
                        for (int j = 0; j < 4; ++j) { const float e = __expf(fminf(al[lt] - as_[j], 0.f)) * ds_[j]; const bool ok = (lt > st) || (4 * gq + j <= c16); t4[j] = ok ? t4[j] * e : 0.f; } }
                    lt4[h2][lt] = t4; } }
#pragma unroll
            for (int lt = 0; lt < 4; ++lt) { u32x4 w; w.x = pk2(lt4[0][lt][0], lt4[0][lt][1]); w.y = pk2(lt4[0][lt][2], lt4[0][lt][3]); w.z = pk2(lt4[1][lt][0], lt4[1][lt][1]); w.w = pk2(lt4[1][lt][2], lt4[1][lt][3]);
                lf[ks][lt] = __builtin_bit_cast(bf16x8, w); }
        }
        f32x4 acc[4][4];
        const bf16* hsrc = ST + (((size_t)bc * NH + head) * HP + c16) * NS + 8 * gq;
#pragma unroll
        for (int pt = 0; pt < 4; ++pt) { bf16x8 hf[4];
#pragma unroll
            for (int kn = 0; kn < 4; ++kn) hf[kn] = *(const bf16x8*)(hsrc + (size_t)(16 * pt) * NS + 32 * kn);
#pragma unroll
            for (int lt = 0; lt < 4; ++lt) { f32x4 t4 = (f32x4){0.f, 0.f, 0.f, 0.f};
#pragma unroll
                for (int kn = 0; kn < 4; ++kn) t4 = __builtin_amdgcn_mfma_f32_16x16x32_bf16(hf[kn], cf[lt][kn], t4, 0, 0, 0);
                acc[pt][lt] = t4 * __expf(al[lt]); } }
        const LAS unsigned char* xb = lds + (4 * gq + (c16 >> 2)) * RSX + wave * 128 + (c16 & 3) * 8;
#pragma unroll
        for (int pt = 0; pt < 4; ++pt) {
            const bf16x8 x0 = tr8(xb + pt * 32, 0, 16 * RSX), x1 = tr8(xb + pt * 32, 32 * RSX, 48 * RSX);
#pragma unroll
            for (int lt = 0; lt < 4; ++lt) { acc[pt][lt] = __builtin_amdgcn_mfma_f32_16x16x32_bf16(x0, lf[0][lt], acc[pt][lt], 0, 0, 0);
                if (lt >= 2) acc[pt][lt] = __builtin_amdgcn_mfma_f32_16x16x32_bf16(x1, lf[1][lt], acc[pt][lt], 0, 0, 0); } }
        const float dk = dskip[head]; float ssq[4] = {0.f, 0.f, 0.f, 0.f};
#pragma unroll
        for (int lt = 0; lt < 4; ++lt) { const int l = 16 * lt + c16;
#pragma unroll
            for (int pt = 0; pt < 4; ++pt) { const int p0 = 16 * pt + 4 * gq;
                const u32x2 xw = *(const LAS u32x2*)(lds + l * RSX + (wave * 64 + p0) * 2); const u32x2 zw = *(const u32x2*)(P + (size_t)(m0 + l) * NMAIN + PZ + head * HP + p0);
                const float xs4[4] = {bflo(xw.x), bfhi(xw.x), bflo(xw.y), bfhi(xw.y)}, z4[4] = {bflo(zw.x), bfhi(zw.x), bflo(zw.y), bfhi(zw.y)};
#pragma unroll
                for (int j = 0; j < 4; ++j) { const float y = (acc[pt][lt][j] + dk * xs4[j]) * siluf_(z4[j]); acc[pt][lt][j] = y; ssq[lt] += y * y; } } }
        LAS float* ssqs = (LAS float*)(lds + O_SSQ);
#pragma unroll
        for (int lt = 0; lt < 4; ++lt) { float v = ssq[lt]; v += __shfl_xor(v, 16); v += __shfl_xor(v, 32); if (gq == 0) ssqs[wave * 64 + 16 * lt + c16] = v; }
        __syncthreads();
#pragma unroll
        for (int lt = 0; lt < 4; ++lt) { const int l = 16 * lt + c16; float tot = 0.f;
#pragma unroll
            for (int w8 = 0; w8 < 8; ++w8) tot += ssqs[w8 * 64 + l];
            const float rstd = rsqrtf(tot * (1.0f / (HPG * HP)) + EPS);
#pragma unroll
            for (int pt = 0; pt < 4; ++pt) { const int ch = head * HP + 16 * pt + 4 * gq; const f32x4 gn = *(const f32x4*)(gnorm + ch); const f32x4 o = acc[pt][lt] * rstd * gn;
                u32x2 w; w.x = pk2(o.x, o.y); w.y = pk2(o.z, o.w); *(u32x2*)(Y + (size_t)(m0 + l) * DI + ch) = w; } }
    }
}

__device__ __forceinline__ float gelu_tanhf_(float x) { const float u = 0.7978845608028654f * (x + 0.044715f * x * x * x); const float t = 1.0f - 2.0f / (1.0f + __expf(2.0f * u)); return 0.5f * x * (1.0f + t); }
__device__ __forceinline__ void ph_ffn_act(const bf16* U, const float* cw, const float* cb, bf16* ACT, int gtid, int nthr) {
    constexpr int NCG = FF / 8;
    for (int it = gtid; it < M * NCG; it += nthr) {
        const int m = it / NCG, c0 = (it % NCG) * 8, t = m & (SEQ - 1);
        float ag[8], av[8];
        { const f32x4 b0 = *(const f32x4*)(cb + c0), b1 = *(const f32x4*)(cb + c0 + 4), d0 = *(const f32x4*)(cb + FF + c0), d1 = *(const f32x4*)(cb + FF + c0 + 4);
          ag[0] = b0.x; ag[1] = b0.y; ag[2] = b0.z; ag[3] = b0.w; ag[4] = b1.x; ag[5] = b1.y; ag[6] = b1.z; ag[7] = b1.w;
          av[0] = d0.x; av[1] = d0.y; av[2] = d0.z; av[3] = d0.w; av[4] = d1.x; av[5] = d1.y; av[6] = d1.z; av[7] = d1.w; }
#pragma unroll
        for (int i = 0; i < 3; ++i) { if (t - 2 + i >= 0) {
            const bf16* ur = U + (size_t)(m - 2 + i) * FF2 + c0; float xg[8], xv[8]; unpack8(*(const u32x4*)ur, xg); unpack8(*(const u32x4*)(ur + FF), xv);
            const float* wg = cw + i * FF2 + c0; const float* wv = wg + FF;
#pragma unroll
            for (int j = 0; j < 8; ++j) { ag[j] += wg[j] * xg[j]; av[j] += wv[j] * xv[j]; } } }
        float o[8];
#pragma unroll
        for (int j = 0; j < 8; ++j) o[j] = gelu_tanhf_(ag[j]) * av[j];
        *(u32x4*)(ACT + (size_t)m * FF + c0) = pack8(o);
    }
}

struct Args { const float* in[20]; float* out; unsigned char* ws; int ph_lo, ph_hi; };
constexpr int NP = 11, NPHASE = 1 + DEPTH * NP;

__global__ void __launch_bounds__(NTHR, 2) fwd(Args args) {
    extern __shared__ __attribute__((aligned(16))) unsigned char lds[];
    const int G = gridDim.x, blk = blockIdx.x;
    volatile LAS unsigned* MISC = (volatile LAS unsigned*)((LAS unsigned char*)lds + MISC_OFF);
    for (int u = threadIdx.x; u < (LDS_BYTES - LDSCTL_OFF) / 4; u += NTHR) ((LAS unsigned*)((LAS unsigned char*)lds + LDSCTL_OFF))[u] = 0u;
    __syncthreads();
    XcdBarrier bar; bar.bar = (unsigned*)(args.ws + WS_CTL) + CW_BAR; bar.x = 0; bar.st = nullptr;
    if (!MK_PER_PHASE) bar = xcd_barrier_post((unsigned*)(args.ws + WS_CTL) + CW_BAR, MISC + 8);
    const int lo = args.ph_lo, hi = args.ph_hi;
#define IN(k) (lo <= (k) && (k) < hi)
#define SEAM(k) do { if (IN(k) && IN((k) + 1)) xcd_barrier(bar); } while (0)
#define PH_BEGIN \
    int tid = threadIdx.x; asm volatile("" : "+v"(tid)); \
    const int lane = tid & 63, wave = __builtin_amdgcn_readfirstlane(tid >> 6); \
    const int gw = blk * NWAVES + wave, ngw = G * NWAVES, gtid = blk * NTHR + tid, nthr = G * NTHR; \
    unsigned char* ws = args.ws; asm volatile("" : "+s"(ws)); \
    LAS unsigned char* ring = (LAS unsigned char*)lds; \
    (void)lane; (void)wave; (void)gw; (void)ngw; (void)gtid; (void)nthr; (void)ring; \
    float* X = args.out; \
    bf16* H = (bf16*)(ws + WS_H); bf16* P = (bf16*)(ws + WS_P); float* SM = (float*)(ws + WS_SM); \
    float* CD = (float*)(ws + WS_DT); bf16* STB = (bf16*)(ws + WS_ST); bf16* Y = (bf16*)(ws + WS_Y); \
    float* SC = (float*)(ws + WS_SC); unsigned long long* MASKW = (unsigned long long*)(ws + WS_IDX); bf16* AO = (bf16*)(ws + WS_AO); \
    float* MG = (float*)(ws + WS_MG); bf16* MGB = (bf16*)(ws + WS_MGB); float* YM = (float*)(ws + WS_YM); bf16* U = (bf16*)(ws + WS_U); \
    bf16* ACT = (bf16*)(ws + WS_ACT); bf16* KIB = (bf16*)(ws + WS_KIB); \
    (void)X; (void)H; (void)P; (void)SM; (void)CD; (void)STB; (void)Y; (void)SC; (void)MASKW; (void)AO; (void)MG; (void)MGB; (void)YM; (void)U; (void)ACT; (void)KIB;

    if (IN(0)) { PH_BEGIN
        WPtrs wp{args.in[5], args.in[13], args.in[14], args.in[15], args.in[16], args.in[19]};
        ph_weights(wp, ws, (float*)lds + wave * 2176, gw, ngw, lane);
        ph_resid_norm(nullptr, nullptr, args.in[1], args.in[0], X, H, gw, ngw, lane);
    }
    SEAM(0);

#pragma unroll 1
    for (int layer = 0; layer < DEPTH; ++layer) {
        const int pb = 1 + layer * NP;
#define WL (ws + WS_W + (size_t)layer * WL_SIZE)
        if (IN(pb + 0)) { PH_BEGIN
            pg8::Gemm g{H, (const bf16*)(WL + WL_IN), M, NPAD, D}; pg8::StaticOrder S; S.init(M, NPAD, G, blk);
            pg8::EpiIn E{P, NMAIN, SM, args.in[6] + (size_t)layer * 2 * D, PG / 256, NMAIN / 256, KIB};
            pg8::gemm_phase<pg8::EpiIn, pg8::StaticOrder, true, true>(ring, g, S, E);
        }
        SEAM(pb + 0);
        if (IN(pb + 1)) { PH_BEGIN
            REP(20) { ph_ssd_states(P, SM, args.in[7] + (size_t)layer * 4 * CONVD, args.in[8] + (size_t)layer * CONVD, args.in[9] + layer * NH, args.in[10] + layer * NH, STB, CD, ring, blk, G, tid); __syncthreads(); }
            REP(21) ph_index_scores(P, SM, KIB, SC, blk, G, wave, lane); }
        SEAM(pb + 1);
        if (IN(pb + 2)) { PH_BEGIN
            ph_ssd_scan(STB, CD, gtid, nthr); REP(30) ph_topk(SC, MASKW, gw, ngw, lane); }
        SEAM(pb + 2);
        if (IN(pb + 3)) { PH_BEGIN
            REP(40) { ph_ssd_out(P, SM, args.in[7] + (size_t)layer * 4 * CONVD, args.in[8] + (size_t)layer * CONVD, args.in[9] + layer * NH, args.in[10] + layer * NH, STB,
                                 args.in[11] + layer * NH, args.in[12] + (size_t)layer * DI, Y, ring, blk, G, tid); __syncthreads(); }
            REP(41) { ph_attn_dense(P, MASKW, AO, ring, blk, G, tid); __syncthreads(); } }
        SEAM(pb + 3);
        if (IN(pb + 4)) {
            { PH_BEGIN
              pg8::Gemm g{Y, (const bf16*)(WL + WL_SSM), M, D, DI}; pg8::StaticOrder S; S.init(M, D, G, blk);
              pg8::EpiGateMul E{MG, D, P + PG, NMAIN}; pg8::gemm_phase<pg8::EpiGateMul, pg8::StaticOrder, false, true>(ring, g, S, E); }
            __syncthreads();
            { PH_BEGIN
              pg8::Gemm g{AO, (const bf16*)(WL + WL_ATT), M, D, D}; pg8::StaticOrder S; S.init(M, D, G, blk);
              pg8::EpiGateAdd E{MG, MGB, D, P + PG + D, NMAIN}; pg8::gemm_phase<pg8::EpiGateAdd, pg8::StaticOrder, false, true>(ring, g, S, E); }
        }
        SEAM(pb + 4);
        if (IN(pb + 5)) { PH_BEGIN
            pg8::Gemm g{MGB, (const bf16*)(WL + WL_MIX), M, D, D}; pg8::StaticOrder S; S.init(M, D, G, blk);
            pg8::EpiF32 E{YM, D}; pg8::gemm_phase<pg8::EpiF32, pg8::StaticOrder, false, true>(ring, g, S, E); }
        SEAM(pb + 5);
        if (IN(pb + 6)) { PH_BEGIN
            ph_resid_norm(YM, args.in[2] + (size_t)layer * D, args.in[3] + (size_t)layer * D, X, X, H, gw, ngw, lane); }
        SEAM(pb + 6);
        if (IN(pb + 7)) { PH_BEGIN
            pg8::Gemm g{H, (const bf16*)(WL + WL_UP), M, FF2, D}; pg8::StaticOrder S; S.init(M, FF2, G, blk);
            pg8::EpiBf16<0> E{U, FF2, nullptr, 0, 0, 1.f}; pg8::gemm_phase<pg8::EpiBf16<0>, pg8::StaticOrder, true, true>(ring, g, S, E); }
        SEAM(pb + 7);
        if (IN(pb + 8)) { PH_BEGIN
            REP(90) ph_ffn_act(U, args.in[17] + (size_t)layer * 3 * FF2, args.in[18] + (size_t)layer * FF2, ACT, gtid, nthr); }
        SEAM(pb + 8);
        if (IN(pb + 9)) { PH_BEGIN
            pg8::Gemm g{ACT, (const bf16*)(WL + WL_DN), M, D, FF}; pg8::StaticOrder S; S.init(M, D, G, blk);
            pg8::EpiF32 E{YM, D}; pg8::gemm_phase<pg8::EpiF32, pg8::StaticOrder, false, true>(ring, g, S, E); }
        SEAM(pb + 9);
        if (IN(pb + 10)) { PH_BEGIN
            ph_resid_norm(YM, args.in[4] + (size_t)layer * D, layer + 1 < DEPTH ? args.in[1] + (size_t)(layer + 1) * D : nullptr, X, X, H, gw, ngw, lane); }
        SEAM(pb + 10);
    }
#undef IN
#undef SEAM
#undef WL
#undef PH_BEGIN
}

extern "C" void kernel_launch(void* const* d_in, const int* in_sizes, int n_in, void* d_out, int out_size, void* d_ws, size_t ws_size, hipStream_t stream) {
    static int grid = 0;
    if (grid == 0) {
        if (n_in != 20 || in_sizes[0] != M * D || out_size != M * D || ws_size < WS_END) { fprintf(stderr, "kernel_launch: unexpected shapes (n_in %d, in0 %d, out %d, ws %zu < %zu)\n", n_in, n_in > 0 ? in_sizes[0] : -1, out_size, ws_size, (size_t)WS_END); grid = -1; return; }
        int dev = 0, cus = 0, per_cu = 0;
        if (hipGetDevice(&dev) != hipSuccess || hipDeviceGetAttribute(&cus, hipDeviceAttributeMultiprocessorCount, dev) != hipSuccess) { grid = -1; return; }
        if (hipFuncSetAttribute((const void*)fwd, hipFuncAttributeMaxDynamicSharedMemorySize, LDS_BYTES) != hipSuccess) { fprintf(stderr, "kernel_launch: hipFuncSetAttribute failed\n"); grid = -1; return; }
        if (hipOccupancyMaxActiveBlocksPerMultiprocessor(&per_cu, (const void*)fwd, NTHR, LDS_BYTES) != hipSuccess || per_cu < 1) fprintf(stderr, "kernel_launch: occupancy query reports %d blocks per CU\n", per_cu);
        (void)hipGetLastError();
        grid = cus;
    }
    if (grid < 0) return;
    if (hipMemsetAsync((char*)d_ws + WS_CTL, 0, CTL_ZERO_BYTES, stream) != hipSuccess) return;
    Args a{};
    for (int i = 0; i < 20; ++i) a.in[i] = (const float*)d_in[i];
    a.out = (float*)d_out; a.ws = (unsigned char*)d_ws;
#if MK_PER_PHASE
    for (int ph = 0; ph < NPHASE; ++ph) { a.ph_lo = ph; a.ph_hi = ph + 1; hipLaunchKernelGGL(fwd, dim3(grid), dim3(NTHR), LDS_BYTES, stream, a); }
#else
    a.ph_lo = 0; a.ph_hi = NPHASE; hipLaunchKernelGGL(fwd, dim3(grid), dim3(NTHR), LDS_BYTES, stream, a);
#endif
}
```

```cpp
#include <hip/hip_runtime.h>
#include <cstdio>
#include <cstdint>
#define MK_PER_PHASE 0
namespace pg8 {
#define PG8_LAS __attribute__((address_space(3)))
typedef unsigned short bf16_t;
typedef short bf16x8 __attribute__((ext_vector_type(8)));
typedef float f32x4 __attribute__((ext_vector_type(4)));
typedef unsigned u32x4 __attribute__((ext_vector_type(4)));
constexpr int BM = 256, BK = 64, HALF = 128, HTB = HALF * BK * 2  , STAGE_BYTES = 8 * HTB, NXCD = 8, WGM = 8;

__host__ __device__ __forceinline__ int lds_byte(int r, int c) { const int st = (r >> 4) * 2 + (c >> 5), rr = r & 15, cc = c & 31, ob = rr * 64 + cc * 2; return st * 1024 + (ob ^ (((ob >> 9) & 1) << 5)); }
__host__ __device__ __forceinline__ void stage_rc(int b, int& R, int& C) { const int st = b / 1024, sb = b % 1024, swz = sb ^ (((sb >> 9) & 1) << 5); R = (st >> 1) * 16 + swz / 64; C = (st & 1) * 32 + (swz % 64) / 2; }
__host__ __device__ __forceinline__ int perm32(int rho) { const int n = rho >> 4, i = rho & 15; return 8 * (i >> 2) + 4 * n + (i & 3); }

struct Unit { int pm, pn; };
struct Gemm { const bf16_t* A; const bf16_t* Bt; int M, N, K; };

struct StaticOrder {
    int nM, nN, nwg, G, c;
    __host__ __device__ void init(int M, int N, int G_, int c_) { nM = M / BM; nN = N / BM; nwg = nM * nN; G = G_; c = c_; }
    __host__ __device__ bool next(int i, Unit& u) const {
        const long L = (long)i * G + c; if (L >= nwg) return false;
        int wgid = (int)L; { const int q = nwg / NXCD, r = nwg % NXCD, xcd = wgid % NXCD, off = wgid / NXCD; wgid = (xcd < r ? xcd * (q + 1) : r * (q + 1) + (xcd - r) * q) + off; }
        const int nig = WGM * nN, gid = wgid / nig, fm = gid * WGM, gsz = (nM - fm) < WGM ? (nM - fm) : WGM;
        u.pm = fm + ((wgid % nig) % gsz); u.pn = (wgid % nig) / gsz; return true;
    }
    __device__ __forceinline__ void a_ready(const Unit&) const {}
    __device__ __forceinline__ void done(const Unit&) const {}
};

__device__ __forceinline__ unsigned cvt_pk_bf16(float lo, float hi) { unsigned r; asm volatile("v_cvt_pk_bf16_f32 %0, %1, %2" : "=v"(r) : "v"(lo), "v"(hi)); return r; }
typedef float f32x2 __attribute__((ext_vector_type(2)));
__device__ __forceinline__ f32x2 gelu_pk(f32x2 v) {
    const f32x2 av = __builtin_elementwise_abs(v), d = av * 0.2316418882f + 1.0f;
    f32x2 t; t.x = __builtin_amdgcn_rcpf(d.x); t.y = __builtin_amdgcn_rcpf(d.y);
    f32x2 q = t * 0.5307027145f + (-0.7265760135f); q = q * t + 0.7107068705f; q = q * t + (-0.142248368f); q = q * t + 0.127414796f; q = q * t;
    const f32x2 s = (v * v) * (-0.72134752044f);
    f32x2 e; e.x = __builtin_amdgcn_exp2f(s.x); e.y = __builtin_amdgcn_exp2f(s.y);
    const f32x2 m = v * (q * e), r = v - m;
    f32x2 o; o.x = v.x < 0.f ? m.x : r.x; o.y = v.y < 0.f ? m.y : r.y; return o;
}

template <int ACT  > struct EpiBf16 {
    static constexpr bool PERM = true, AFTER_DRAIN = false; static_assert(ACT == 0 || ACT == 1, "EpiBf16: ACT is 0 (none) or 1 (gelu_pk)");
    bf16_t* O; int ldc; const float* bias; int split_cols; size_t split_stride; float scale0;
    __device__ __forceinline__ void operator()(const f32x4 (&acc)[2][2][4][2], const Unit& u, int wr, int wc, int fr, int fq) const {
        const int row0 = u.pm * BM + wr * 64 + fr; int colt = u.pn * BM; bf16_t* base = O;
        float sc = 1.f; if (split_cols) { const int t = colt / split_cols; base += (size_t)t * split_stride; colt -= t * split_cols; if (t == 0) sc = scale0; }
        const int col0 = colt + wc * 32 + 8 * fq, bcol0 = u.pn * BM + wc * 32 + 8 * fq;
        f32x4 bv[2][2];
#pragma unroll
        for (int bj = 0; bj < 2; ++bj)
#pragma unroll
            for (int n = 0; n < 2; ++n) bv[bj][n] = bias ? *(const f32x4*)(bias + bcol0 + bj * HALF + 4 * n) : (f32x4){0.f, 0.f, 0.f, 0.f};
#pragma unroll
        for (int ai = 0; ai < 2; ++ai)
#pragma unroll
            for (int m = 0; m < 4; ++m) { bf16_t* rowp = base + (size_t)(row0 + ai * HALF + m * 16) * ldc + col0;
#pragma unroll
                for (int bj = 0; bj < 2; ++bj) { f32x4 v0 = acc[ai][bj][m][0] + bv[bj][0], v1 = acc[ai][bj][m][1] + bv[bj][1];
                    if (ACT == 1) { f32x2 a = gelu_pk((f32x2){v0[0], v0[1]}), b = gelu_pk((f32x2){v0[2], v0[3]}), c = gelu_pk((f32x2){v1[0], v1[1]}), d = gelu_pk((f32x2){v1[2], v1[3]});
                        v0 = (f32x4){a.x, a.y, b.x, b.y}; v1 = (f32x4){c.x, c.y, d.x, d.y}; }
                    v0 = v0 * sc; v1 = v1 * sc; u32x4 w; w.x = cvt_pk_bf16(v0[0], v0[1]); w.y = cvt_pk_bf16(v0[2], v0[3]); w.z = cvt_pk_bf16(v1[0], v1[1]); w.w = cvt_pk_bf16(v1[2], v1[3]);
                    *(u32x4*)(rowp + bj * HALF) = w; } }
    }
};

struct EpiF32 {
    static constexpr bool PERM = false, AFTER_DRAIN = false;
    float* C; int ldc;
    __device__ __forceinline__ void operator()(const f32x4 (&acc)[2][2][4][2], const Unit& u, int wr, int wc, int fr, int fq) const {
        const int row0 = u.pm * BM + wr * 64 + fr, col0 = u.pn * BM + wc * 32 + 4 * fq;
#pragma unroll
        for (int ai = 0; ai < 2; ++ai)
#pragma unroll
            for (int m = 0; m < 4; ++m) { float* rowp = C + (size_t)(row0 + ai * HALF + m * 16) * ldc + col0;
#pragma unroll
                for (int bj = 0; bj < 2; ++bj)
#pragma unroll
                    for (int n = 0; n < 2; ++n) *(f32x4*)(rowp + bj * HALF + n * 16) = acc[ai][bj][m][n]; }
    }
};
__device__ __forceinline__ float bf_lo(unsigned w) { return __uint_as_float(w << 16); }
__device__ __forceinline__ float bf_hi(unsigned w) { return __uint_as_float(w & 0xffff0000u); }
__device__ __forceinline__ float sigmoidf_(float x) { return __builtin_amdgcn_rcpf(1.0f + __expf(-x)); }
struct EpiIn {
    static constexpr bool PERM = true, AFTER_DRAIN = false;
    bf16_t* P; int ldp; float* SM; const float* bgate; int gate_tile0, small_tile; bf16_t* KIB;
    __device__ __forceinline__ void operator()(const f32x4 (&acc)[2][2][4][2], const Unit& u, int wr, int wc, int fr, int fq) const {
        const int row0 = u.pm * BM + wr * 64 + fr, colt = u.pn * BM + wc * 32 + 8 * fq;
        if (u.pn < small_tile) {
            const bool gate = u.pn >= gate_tile0;
            f32x4 bv[2][2];
#pragma unroll
            for (int bj = 0; bj < 2; ++bj)
#pragma unroll
                for (int n = 0; n < 2; ++n) bv[bj][n] = gate ? *(const f32x4*)(bgate + (colt - gate_tile0 * BM) + bj * HALF + 4 * n) : (f32x4){0.f, 0.f, 0.f, 0.f};
#pragma unroll
            for (int ai = 0; ai < 2; ++ai)
#pragma unroll
                for (int m = 0; m < 4; ++m) { bf16_t* rowp = P + (size_t)(row0 + ai * HALF + m * 16) * ldp + colt;
#pragma unroll
                    for (int bj = 0; bj < 2; ++bj) { f32x4 v0 = acc[ai][bj][m][0] + bv[bj][0], v1 = acc[ai][bj][m][1] + bv[bj][1];
                        if (gate) {
#pragma unroll
                            for (int j = 0; j < 4; ++j) { v0[j] = sigmoidf_(v0[j]); v1[j] = sigmoidf_(v1[j]); } }
                        u32x4 w; w.x = cvt_pk_bf16(v0[0], v0[1]); w.y = cvt_pk_bf16(v0[2], v0[3]); w.z = cvt_pk_bf16(v1[0], v1[1]); w.w = cvt_pk_bf16(v1[2], v1[3]);
                        *(u32x4*)(rowp + bj * HALF) = w; } }
        } else {
            const int c0 = wc * 32 + 8 * fq;
#pragma unroll
            for (int ai = 0; ai < 2; ++ai)
#pragma unroll
                for (int m = 0; m < 4; ++m) { float* rowp = SM + (size_t)(row0 + ai * HALF + m * 16) * BM + c0;
#pragma unroll
                    for (int bj = 0; bj < 2; ++bj) { *(f32x4*)(rowp + bj * HALF) = acc[ai][bj][m][0]; *(f32x4*)(rowp + bj * HALF + 4) = acc[ai][bj][m][1]; }
                    if (wc >= 2) { const f32x4 v0 = acc[ai][0][m][0], v1 = acc[ai][0][m][1];
                        u32x4 w; w.x = cvt_pk_bf16(v0[0], v0[1]); w.y = cvt_pk_bf16(v0[2], v0[3]); w.z = cvt_pk_bf16(v1[0], v1[1]); w.w = cvt_pk_bf16(v1[2], v1[3]);
                        *(u32x4*)(KIB + (size_t)(row0 + ai * HALF + m * 16) * 64 + (c0 - 64)) = w; } }
        }
    }
};
struct EpiGateMul {
    static constexpr bool PERM = true, AFTER_DRAIN = false;
    float* MG; int ldc; const bf16_t* G; int ldg;
    __device__ __forceinline__ void operator()(const f32x4 (&acc)[2][2][4][2], const Unit& u, int wr, int wc, int fr, int fq) const {
        const int row0 = u.pm * BM + wr * 64 + fr, colt = u.pn * BM + wc * 32 + 8 * fq;
#pragma unroll
        for (int ai = 0; ai < 2; ++ai)
#pragma unroll
            for (int m = 0; m < 4; ++m) { const size_t row = (size_t)(row0 + ai * HALF + m * 16);
#pragma unroll
                for (int bj = 0; bj < 2; ++bj) { const u32x4 g = *(const u32x4*)(G + row * ldg + colt + bj * HALF);
                    f32x4 v0 = acc[ai][bj][m][0], v1 = acc[ai][bj][m][1];
                    v0[0] *= bf_lo(g.x); v0[1] *= bf_hi(g.x); v0[2] *= bf_lo(g.y); v0[3] *= bf_hi(g.y);
                    v1[0] *= bf_lo(g.z); v1[1] *= bf_hi(g.z); v1[2] *= bf_lo(g.w); v1[3] *= bf_hi(g.w);
                    float* o = MG + row * ldc + colt + bj * HALF; *(f32x4*)o = v0; *(f32x4*)(o + 4) = v1; } }
    }
};
struct EpiGateAdd {
    static constexpr bool PERM = true, AFTER_DRAIN = false;
    const float* MG; bf16_t* O; int ldc; const bf16_t* G; int ldg;
    __device__ __forceinline__ void operator()(const f32x4 (&acc)[2][2][4][2], const Unit& u, int wr, int wc, int fr, int fq) const {
        const int row0 = u.pm * BM + wr * 64 + fr, colt = u.pn * BM + wc * 32 + 8 * fq;
#pragma unroll
        for (int ai = 0; ai < 2; ++ai)
#pragma unroll
            for (int m = 0; m < 4; ++m) { const size_t row = (size_t)(row0 + ai * HALF + m * 16);
#pragma unroll
                for (int bj = 0; bj < 2; ++bj) { const u32x4 g = *(const u32x4*)(G + row * ldg + colt + bj * HALF);
                    const float* mi = MG + row * ldc + colt + bj * HALF; f32x4 v0 = *(const f32x4*)mi, v1 = *(const f32x4*)(mi + 4);
                    const f32x4 a0 = acc[ai][bj][m][0], a1 = acc[ai][bj][m][1];
                    v0[0] += a0[0] * bf_lo(g.x); v0[1] += a0[1] * bf_hi(g.x); v0[2] += a0[2] * bf_lo(g.y); v0[3] += a0[3] * bf_hi(g.y);
                    v1[0] += a1[0] * bf_lo(g.z); v1[1] += a1[1] * bf_hi(g.z); v1[2] += a1[2] * bf_lo(g.w); v1[3] += a1[3] * bf_hi(g.w);
                    u32x4 w; w.x = cvt_pk_bf16(v0[0], v0[1]); w.y = cvt_pk_bf16(v0[2], v0[3]); w.z = cvt_pk_bf16(v1[0], v1[1]); w.w = cvt_pk_bf16(v1[2], v1[3]);
                    *(u32x4*)(O + row * ldc + colt + bj * HALF) = w; } }
    }
};
template <class Epi, class Sched, bool ALIGN_EPI = false, bool SP2 = false>
__device__ __forceinline__ void gemm_phase(PG8_LAS unsigned char* lds, const Gemm g, const Sched& S, const Epi& E) {
    int tid = threadIdx.x; asm volatile("" : "+v"(tid));
    const int wid = __builtin_amdgcn_readfirstlane(tid >> 6), lane = tid & 63, wr = wid >> 2, wc = wid & 3, fr = lane & 15, fq = lane >> 4;
    const int K = g.K, nt = K / BK;
    unsigned voffA[2], voffB[2];
#pragma unroll
    for (int i = 0; i < 2; ++i) { int R, C; stage_rc(tid * 16 + i * 8192, R, C); const int Rb = Epi::PERM ? ((R & ~31) + perm32(R & 31)) : R;
        voffA[i] = (unsigned)(R * K + C) * 2u; voffB[i] = (unsigned)(Rb * K + C) * 2u; }
    const size_t kstep = (size_t)(BK * 2);
    const size_t hstep = (size_t)HALF * K * 2;
    const size_t tstep = 2 * hstep;
    const unsigned ldsw = (unsigned)wid * 1024u;
    const int aoff = lds_byte(wr * 64 + fr, fq * 8), boff = lds_byte(wc * 32 + fr, fq * 8);
#define PG8_SA(b, h) (((b) * 2 + (h)) * HTB)
#define PG8_SB(b, h) ((4 + (b) * 2 + (h)) * HTB)
#define PG8_STAGE(bufoff, gbase, voff) do { _Pragma("unroll") for (int _i = 0; _i < 2; ++_i) \
        __builtin_amdgcn_global_load_lds((const unsigned*)((const char*)(gbase) + (voff)[_i]), (PG8_LAS unsigned*)(lds + (bufoff) + ldsw + _i * 8192), 16, 0, 0); } while (0)
#define PG8_LDA(dst, b, h) do { _Pragma("unroll") for (int m = 0; m < 4; ++m) _Pragma("unroll") for (int k = 0; k < 2; ++k) dst[m][k] = *(const PG8_LAS bf16x8*)(lds + PG8_SA(b, h) + aoff + m * 2048 + k * 1024); } while (0)
#define PG8_LDB(dst, b, h) do { _Pragma("unroll") for (int n = 0; n < 2; ++n) _Pragma("unroll") for (int k = 0; k < 2; ++k) dst[n][k] = *(const PG8_LAS bf16x8*)(lds + PG8_SB(b, h) + boff + n * 2048 + k * 1024); } while (0)
#define PG8_MMA(ai, bj, At, Bt) do { __builtin_amdgcn_s_setprio(1); _Pragma("unroll") for (int m = 0; m < 4; ++m) _Pragma("unroll") for (int n = 0; n < 2; ++n) _Pragma("unroll") for (int k = 0; k < 2; ++k) \
        acc[ai][bj][m][n] = __builtin_amdgcn_mfma_f32_16x16x32_bf16(Bt[n][k], At[m][k], acc[ai][bj][m][n], 0, 0, 0); __builtin_amdgcn_s_setprio(0); } while (0)
#define PG8_WAIT_V(n) asm volatile("s_waitcnt vmcnt(" #n ")" ::: "memory")
#define PG8_WAIT_L(n) asm volatile("s_waitcnt lgkmcnt(" #n ")" ::: "memory")
#define PG8_BAR __builtin_amdgcn_s_barrier()
#define PG8_SCHED __builtin_amdgcn_sched_barrier(0)
    Unit cur, nxt; int ui = 0;
    if (!S.next(0, cur)) return;
    f32x4 acc[2][2][4][2];
#pragma unroll
    for (int a = 0; a < 2; ++a)
#pragma unroll
        for (int b = 0; b < 2; ++b)
#pragma unroll
            for (int m = 0; m < 4; ++m)
#pragma unroll
                for (int n = 0; n < 2; ++n) acc[a][b][m][n] = (f32x4){0.f, 0.f, 0.f, 0.f};
    bf16x8 At[4][2], B0[2][2], B1[2][2];
    const char* cA = (const char*)g.A + (size_t)cur.pm * tstep; const char* cB = (const char*)g.Bt + (size_t)cur.pn * tstep;
    S.a_ready(cur);
    if constexpr (SP2) {
        PG8_STAGE(PG8_SB(0, 0), cB, voffB); PG8_STAGE(PG8_SB(0, 1), cB + hstep, voffB); PG8_STAGE(PG8_SA(0, 0), cA, voffA); PG8_STAGE(PG8_SA(0, 1), cA + hstep, voffA);
        if (wr == 1) PG8_BAR;
        PG8_WAIT_V(2); PG8_BAR;
        PG8_STAGE(PG8_SB(1, 0), cB + kstep, voffB); PG8_STAGE(PG8_SA(1, 0), cA + kstep, voffA); PG8_STAGE(PG8_SB(1, 1), cB + hstep + kstep, voffB);
        PG8_WAIT_V(6); PG8_BAR;
    } else {
        PG8_STAGE(PG8_SB(0, 0), cB, voffB); PG8_STAGE(PG8_SA(0, 0), cA, voffA); PG8_STAGE(PG8_SB(0, 1), cB + hstep, voffB); PG8_STAGE(PG8_SA(0, 1), cA + hstep, voffA);
        if (wr == 1) PG8_BAR;
        PG8_WAIT_V(4); PG8_BAR;
        PG8_STAGE(PG8_SB(1, 0), cB + kstep, voffB); PG8_STAGE(PG8_SA(1, 0), cA + kstep, voffA); PG8_STAGE(PG8_SB(1, 1), cB + hstep + kstep, voffB);
        PG8_WAIT_V(6); PG8_BAR;
    }
    for (;;) {
        const bool has_next = S.next(ui + 1, nxt);
        const char* nA = has_next ? (const char*)g.A + (size_t)nxt.pm * tstep : cA; const char* nB = has_next ? (const char*)g.Bt + (size_t)nxt.pn * tstep : cB;
        for (int t = 0; t < nt; t += 2) {
            const bool last = (t == nt - 2);
            const char* a1 = cA + (size_t)(t + 1) * kstep;
            const char* a2 = last ? nA : cA + (size_t)(t + 2) * kstep; const char* b2 = last ? nB : cB + (size_t)(t + 2) * kstep;
            const char* a3 = a2 + kstep; const char* b3 = b2 + kstep;
            if (last && has_next) S.a_ready(nxt);
            if constexpr (SP2) {
            PG8_LDB(B0, 0, 0); PG8_LDB(B1, 0, 1); PG8_SCHED; PG8_LDA(At, 0, 0); PG8_STAGE(PG8_SA(1, 1), a1 + hstep, voffA);
            PG8_WAIT_V(8); PG8_WAIT_L(0); PG8_BAR; PG8_MMA(0, 0, At, B0); PG8_MMA(0, 1, At, B1); PG8_BAR; PG8_SCHED;
            PG8_LDA(At, 0, 1); PG8_STAGE(PG8_SB(0, 0), b2, voffB); PG8_STAGE(PG8_SB(0, 1), b2 + hstep, voffB); PG8_STAGE(PG8_SA(0, 0), a2, voffA);
            PG8_WAIT_V(8); PG8_WAIT_L(0); PG8_BAR; PG8_MMA(1, 0, At, B0); PG8_MMA(1, 1, At, B1); PG8_BAR; PG8_SCHED;
            PG8_LDB(B0, 1, 0); PG8_LDB(B1, 1, 1); PG8_SCHED; PG8_LDA(At, 1, 0); PG8_STAGE(PG8_SA(0, 1), a2 + hstep, voffA);
            PG8_WAIT_V(8); PG8_WAIT_L(0); PG8_BAR; PG8_MMA(0, 0, At, B0); PG8_MMA(0, 1, At, B1); PG8_BAR; PG8_SCHED;
            PG8_LDA(At, 1, 1); PG8_STAGE(PG8_SB(1, 0), b3, voffB); PG8_STAGE(PG8_SB(1, 1), b3 + hstep, voffB); PG8_STAGE(PG8_SA(1, 0), a3, voffA);
            PG8_WAIT_V(8); PG8_WAIT_L(0); PG8_BAR; PG8_MMA(1, 0, At, B0); PG8_MMA(1, 1, At, B1); PG8_BAR; PG8_SCHED;
            } else {
            PG8_LDB(B0, 0, 0); PG8_SCHED; PG8_LDA(At, 0, 0); PG8_STAGE(PG8_SA(1, 1), a1 + hstep, voffA);
            PG8_WAIT_L(8); PG8_BAR; PG8_WAIT_L(0); PG8_MMA(0, 0, At, B0); PG8_BAR; PG8_SCHED;
            PG8_LDB(B1, 0, 1); PG8_STAGE(PG8_SB(0, 0), b2, voffB);
            PG8_BAR; PG8_WAIT_L(0); PG8_MMA(0, 1, At, B1); PG8_BAR;
            PG8_LDA(At, 0, 1); PG8_STAGE(PG8_SA(0, 0), a2, voffA);
            PG8_BAR; PG8_WAIT_L(0); PG8_MMA(1, 0, At, B0); PG8_BAR; PG8_SCHED;
            PG8_STAGE(PG8_SB(0, 1), b2 + hstep, voffB);
            PG8_WAIT_V(6); PG8_BAR; PG8_MMA(1, 1, At, B1); PG8_BAR;
            PG8_LDB(B0, 1, 0); PG8_SCHED; PG8_LDA(At, 1, 0); PG8_STAGE(PG8_SA(0, 1), a2 + hstep, voffA);
            PG8_WAIT_L(8); PG8_BAR; PG8_WAIT_L(0); PG8_MMA(0, 0, At, B0); PG8_BAR; PG8_SCHED;
            PG8_LDB(B1, 1, 1); PG8_STAGE(PG8_SB(1, 0), b3, voffB);
            PG8_BAR; PG8_WAIT_L(0); PG8_MMA(0, 1, At, B1); PG8_BAR;
            PG8_LDA(At, 1, 1); PG8_STAGE(PG8_SA(1, 0), a3, voffA);
            PG8_BAR; PG8_WAIT_L(0); PG8_MMA(1, 0, At, B0); PG8_BAR; PG8_SCHED;
            PG8_STAGE(PG8_SB(1, 1), b3 + hstep, voffB);
            PG8_WAIT_V(6); PG8_BAR; PG8_MMA(1, 1, At, B1); PG8_BAR;
            }
        }
        if constexpr (ALIGN_EPI) { if (wr == 0) PG8_BAR; }
        if constexpr (!Epi::AFTER_DRAIN) { E(acc, cur, wr, wc, fr, fq); S.done(cur); }
        if (!has_next) break;
#pragma unroll
        for (int a = 0; a < 2; ++a)
#pragma unroll
            for (int b = 0; b < 2; ++b)
#pragma unroll
                for (int m = 0; m < 4; ++m)
#pragma unroll
                    for (int n = 0; n < 2; ++n) acc[a][b][m][n] = (f32x4){0.f, 0.f, 0.f, 0.f};
        cur = nxt; cA = nA; cB = nB; ++ui;
        if constexpr (ALIGN_EPI) { if (wr == 1) PG8_BAR; }
    }
    PG8_WAIT_V(0);
    if constexpr (!ALIGN_EPI) { if (wr == 0) PG8_BAR; }
    PG8_BAR;
    if constexpr (Epi::AFTER_DRAIN) { E.fused(acc, cur, wr, wc, fr, fq, lds, wid, lane); S.done(cur); }
#undef PG8_SA
#undef PG8_SB
#undef PG8_STAGE
#undef PG8_LDA
#undef PG8_LDB
#undef PG8_MMA
#undef PG8_WAIT_V
#undef PG8_WAIT_L
#undef PG8_BAR
#undef PG8_SCHED
}
}

#ifndef MK_PER_PHASE
#define MK_PER_PHASE 0
#endif
#ifndef PROBE_DOUBLE
#define PROBE_DOUBLE -1
#endif
#define REP(id) for (int rep_ = 0; rep_ < ((PROBE_DOUBLE == (id)) ? 2 : 1); ++rep_)
constexpr int NWAVES = 8, NTHR = 512;
constexpr int BATCH = 2, SEQ = 4096, M = BATCH * SEQ, D = 2048, DEPTH = 4;
constexpr int DI = 4096, NH = 64, HP = 64, NG = 8, HPG = 8, NS = 128, CONVD = 6144;
constexpr int QH = 16, KVH = 4, AD = 128, IH = 16, IDD = 64, TOPK = 256;
constexpr int FF = 4096, FF2 = 8192;
constexpr int NIN = 18576, NMAIN = 18432, NPAD = 18688;
constexpr int PZ = 0, PXBC = 4096, PQ = 10240, PK = 12288, PV = 12800, PQI = 13312, PG = 14336;
constexpr int SMW = 256, SM_DT = 0, SM_KI = 64, SM_WI = 128;
constexpr float EPS = 1e-6f;
constexpr float ATTN_SCALE = 0.08838834764831845f;

constexpr size_t MiB = 1u << 20;
constexpr size_t WS_CTL = 0, CTL_ZERO_BYTES = 1 * MiB;
constexpr size_t WS_W = 2 * MiB;
constexpr size_t WL_IN = 0, WL_SSM = 73 * MiB, WL_ATT = 89 * MiB, WL_MIX = 97 * MiB, WL_UP = 105 * MiB, WL_DN = 137 * MiB, WL_SIZE = 153 * MiB;
constexpr size_t WS_H = WS_W + DEPTH * WL_SIZE;
constexpr size_t WS_P = WS_H + 32 * MiB;
constexpr size_t WS_SM = WS_P + 288 * MiB;
constexpr size_t WS_XC = WS_SM + 8 * MiB;
constexpr size_t WS_DT = WS_XC + 96 * MiB;
constexpr size_t WS_ACS = WS_DT + 2 * MiB;
constexpr size_t WS_ST = WS_ACS + 2 * MiB;
constexpr size_t WS_Y = WS_ST + 256 * MiB;
constexpr size_t WS_SC = WS_Y + 64 * MiB;
constexpr size_t WS_IDX = WS_SC + 128 * MiB;
constexpr size_t WS_CNT = WS_IDX + 8 * MiB;
constexpr size_t WS_AO = WS_CNT + 1 * MiB;
constexpr size_t WS_MG = WS_AO + 32 * MiB;
constexpr size_t WS_MGB = WS_MG + 64 * MiB;
constexpr size_t WS_YM = WS_MGB + 32 * MiB;
constexpr size_t WS_U = WS_YM + 64 * MiB;
constexpr size_t WS_ACT = WS_U + 128 * MiB;
constexpr size_t WS_KIB = WS_ACT + 64 * MiB;
constexpr size_t WS_END = WS_KIB + 1 * MiB;
constexpr int CW_BAR = 4096;

constexpr int RING_BYTES = 131072, LDSCTL_OFF = RING_BYTES, MISC_OFF = LDSCTL_OFF + 320, LDS_BYTES = 147456;

#define LAS __attribute__((address_space(3)))
typedef unsigned short bf16;
typedef float f32x4 __attribute__((ext_vector_type(4)));
typedef short bf16x8 __attribute__((ext_vector_type(8)));
typedef unsigned u32x4 __attribute__((ext_vector_type(4)));
typedef unsigned u32x2 __attribute__((ext_vector_type(2)));
#define LDS_WAIT() asm volatile("s_waitcnt lgkmcnt(0)" ::: "memory")

__device__ __forceinline__ unsigned f2bf(float f) { unsigned u = __builtin_bit_cast(unsigned, f); return (u + 0x7fffu + ((u >> 16) & 1u)) >> 16; }
__device__ __forceinline__ unsigned pk2(float lo, float hi) { return f2bf(lo) | (f2bf(hi) << 16); }
__device__ __forceinline__ float bflo(unsigned w) { return __uint_as_float(w << 16); }
__device__ __forceinline__ float bfhi(unsigned w) { return __uint_as_float(w & 0xffff0000u); }
__device__ __forceinline__ void unpack8(const u32x4 w, float (&f)[8]) { f[0] = bflo(w.x); f[1] = bfhi(w.x); f[2] = bflo(w.y); f[3] = bfhi(w.y); f[4] = bflo(w.z); f[5] = bfhi(w.z); f[6] = bflo(w.w); f[7] = bfhi(w.w); }
__device__ __forceinline__ u32x4 pack8(const float (&f)[8]) { u32x4 w; w.x = pk2(f[0], f[1]); w.y = pk2(f[2], f[3]); w.z = pk2(f[4], f[5]); w.w = pk2(f[6], f[7]); return w; }
__device__ __forceinline__ float wave_sum(float v) {
#pragma unroll
    for (int o = 1; o < 64; o <<= 1) v += __shfl_xor(v, o);
    return v;
}
__device__ __forceinline__ float wave_max(float v) {
#pragma unroll
    for (int o = 1; o < 64; o <<= 1) v = fmaxf(v, __shfl_xor(v, o));
    return v;
}
__device__ __forceinline__ float siluf_(float x) { return x / (1.0f + __expf(-x)); }

#define XB_TMO      128
#define XB_XCNT(j)  (256  + 64 * (j))
#define XB_XSUB(j)  (1280 + 64 * (j))
#define XB_XGEN(j)  (2304 + 64 * (j))
#define XB_TOP      3328
#define XB_TOPGEN   3392
#define XCD_BAR_WORDS 3456
#define XB_SPIN_CAP (1u << 18)

__device__ __forceinline__ unsigned xb_ld(unsigned* p)              { return __hip_atomic_load(p, __ATOMIC_RELAXED, __HIP_MEMORY_SCOPE_AGENT); }
__device__ __forceinline__ unsigned xb_add(unsigned* p, unsigned v) { return __hip_atomic_fetch_add(p, v, __ATOMIC_RELAXED, __HIP_MEMORY_SCOPE_AGENT); }
__device__ __forceinline__ unsigned xb_xcc_id() { return (unsigned)__builtin_amdgcn_s_getreg((3 << 11) | 20) & 0xFu; }
#define XB_SPIN(cond, bar) do { unsigned _sp = 0; while (cond) { __builtin_amdgcn_s_sleep(1); \
    if ((++_sp & 255u) == 0u) { if (xb_ld(&(bar)[XB_TMO])) break; if (_sp > XB_SPIN_CAP) { atomicAdd(&(bar)[XB_TMO], 1u); break; } } } } while (0)

struct XcdBarrier {
    unsigned* bar; unsigned x;
    volatile LAS unsigned* st;
};

__device__ __forceinline__ XcdBarrier xcd_barrier_post(unsigned* bar, volatile LAS unsigned* st) {
    XcdBarrier b; b.bar = bar; b.x = xb_xcc_id(); b.st = st;
    if (threadIdx.x == 0) (void)xb_add(&bar[XB_XCNT(b.x)], 1u);
    return b;
}
__device__ __forceinline__ void xcd_barrier_complete(unsigned* bar, unsigned x, unsigned& nloc, unsigned& nx) {
    const unsigned G = gridDim.x * gridDim.y * gridDim.z;
    unsigned sum, cnt, mine, sp = 0u;
    for (;;) {
        sum = 0u; cnt = 0u; mine = 0u;
#pragma unroll
        for (unsigned j = 0; j < 16; ++j) { const unsigned c = xb_ld(&bar[XB_XCNT(j)]); sum += c; cnt += (c > 0u) ? 1u : 0u; mine = (j == x) ? c : mine; }
        if (sum == G) break;
        __builtin_amdgcn_s_sleep(1);
        if ((++sp & 255u) == 0u) { if (xb_ld(&bar[XB_TMO])) break; if (sp > XB_SPIN_CAP) { atomicAdd(&bar[XB_TMO], 1u); break; } }
    }
    nloc = mine > 0u ? mine : 1u; nx = cnt > 0u ? cnt : 1u;
}

__device__ __forceinline__ void xcd_barrier(const XcdBarrier& b) {
    asm volatile("s_waitcnt vmcnt(0)" ::: "memory");
    __syncthreads();
    if (threadIdx.x == 0) {
        unsigned* bar = b.bar;
        __builtin_amdgcn_s_waitcnt(0);
        unsigned nloc = b.st[0], nx = b.st[1];
        if (nloc == 0u) { xcd_barrier_complete(bar, b.x, nloc, nx); b.st[0] = nloc; b.st[1] = nx; }
        const unsigned old = xb_add(&bar[XB_XSUB(b.x)], 1u);
        const unsigned gen = old / nloc;
        if (old + 1u == (gen + 1u) * nloc) {
            __builtin_amdgcn_fence(__ATOMIC_RELEASE, "agent");
            asm volatile("s_waitcnt vmcnt(0)" ::: "memory");
            const unsigned og = xb_add(&bar[XB_TOP], 1u);
            const unsigned tg = og / nx;
            if (og + 1u == (tg + 1u) * nx) xb_add(&bar[XB_TOPGEN], 1u);
            else XB_SPIN(xb_ld(&bar[XB_TOPGEN]) == tg, bar);
            __builtin_amdgcn_fence(__ATOMIC_ACQUIRE, "agent");
            xb_add(&bar[XB_XGEN(b.x)], 1u);
            asm volatile("s_waitcnt vmcnt(0)" ::: "memory");
        } else {
            XB_SPIN(xb_ld(&bar[XB_XGEN(b.x)]) == gen, bar);
            __builtin_amdgcn_fence(__ATOMIC_ACQUIRE, "agent");
            asm volatile("s_waitcnt vmcnt(0)" ::: "memory");
        }
    }
    __syncthreads();
}


__device__ __forceinline__ void ph_resid_norm(const float* Yin, const float* gpost, const float* gnext, const float* Xin, float* X, bf16* H, int gw, int ngw, int lane) {
    for (int m = gw; m < M; m += ngw) {
        const f32x4* xr = (const f32x4*)(Xin + (size_t)m * D) + lane;
        f32x4 xv[8];
#pragma unroll
        for (int j = 0; j < 8; ++j) xv[j] = xr[64 * j];
        if (Yin) {
            const f32x4* yr = (const f32x4*)(Yin + (size_t)m * D) + lane; f32x4 yv[8]; float ss = 0.f;
#pragma unroll
            for (int j = 0; j < 8; ++j) { yv[j] = yr[64 * j]; ss += (yv[j].x * yv[j].x + yv[j].y * yv[j].y) + (yv[j].z * yv[j].z + yv[j].w * yv[j].w); }
            const float rstd = rsqrtf(wave_sum(ss) * (1.0f / D) + EPS);
#pragma unroll
            for (int j = 0; j < 8; ++j) { const f32x4 g = ((const f32x4*)gpost + lane)[64 * j]; xv[j] = xv[j] + yv[j] * rstd * g; }
        }
        if (Yin || Xin != X) { f32x4* xo = (f32x4*)(X + (size_t)m * D) + lane;
#pragma unroll
            for (int j = 0; j < 8; ++j) xo[64 * j] = xv[j]; }
        if (gnext) {
            float ss = 0.f;
#pragma unroll
            for (int j = 0; j < 8; ++j) ss += (xv[j].x * xv[j].x + xv[j].y * xv[j].y) + (xv[j].z * xv[j].z + xv[j].w * xv[j].w);
            const float rstd = rsqrtf(wave_sum(ss) * (1.0f / D) + EPS);
            u32x2* ho = (u32x2*)(H + (size_t)m * D) + lane;
#pragma unroll
            for (int j = 0; j < 8; ++j) { const f32x4 g = ((const f32x4*)gnext + lane)[64 * j]; const f32x4 h = xv[j] * rstd * g; u32x2 w; w.x = pk2(h.x, h.y); w.y = pk2(h.z, h.w); ho[64 * j] = w; }
        }
    }
}

__device__ __forceinline__ void tr_item(const float* W, int ldw, int K, int k0, int nsrc, int ncols, bf16* WT, int ndst, float* scr, int lane) {
    const int j = lane & 31;
#pragma unroll 8
    for (int i = 0; i < 32; ++i) { const int kk = 2 * i + (lane >> 5); scr[kk * 33 + j] = (j < ncols) ? W[(size_t)(k0 + kk) * ldw + nsrc + j] : 0.f; }
    LDS_WAIT();
    const int c = lane & 7;
#pragma unroll
    for (int jj = 0; jj < 4; ++jj) { const int n = (lane >> 3) + 8 * jj; const float* s = scr + (8 * c) * 33 + n;
        u32x4 o; o.x = pk2(s[0 * 33], s[1 * 33]); o.y = pk2(s[2 * 33], s[3 * 33]); o.z = pk2(s[4 * 33], s[5 * 33]); o.w = pk2(s[6 * 33], s[7 * 33]);
        *(u32x4*)(WT + (size_t)(ndst + n) * K + k0 + 8 * c) = o; }
    LDS_WAIT();
}
__device__ __forceinline__ void win_map(int dstrow, int& src, int& ncols) {
    ncols = 32;
    if (dstrow < 10240) src = dstrow;
    else if (dstrow < 12288) src = dstrow - 10240 + 10304;
    else if (dstrow < 12800) src = dstrow - 12288 + 12352;
    else if (dstrow < 13312) src = dstrow - 12800 + 12864;
    else if (dstrow < 14336) src = dstrow - 13312 + 13376;
    else if (dstrow < 18432) src = dstrow - 14336 + 14480;
    else if (dstrow < 18496) src = dstrow - 18432 + 10240;
    else if (dstrow < 18560) src = dstrow - 18496 + 14400;
    else if (dstrow == 18560) { src = 14464; ncols = 16; }
    else { src = 0; ncols = 0; }
}
struct WPtrs { const float *w_in, *w_ssm, *w_att, *w_mix, *w_up, *w_dn; };
__device__ __forceinline__ void ph_weights(const WPtrs wp, unsigned char* ws, float* scr, int gw, int ngw, int lane) {
    constexpr int I_IN = (NPAD / 32) * (D / 64), I_SSM = (D / 32) * (DI / 64), I_ATT = (D / 32) * (D / 64), I_MIX = I_ATT, I_UP = (FF2 / 32) * (D / 64), I_DN = (D / 32) * (FF / 64);
    constexpr int I_L = I_IN + I_SSM + I_ATT + I_MIX + I_UP + I_DN;
    for (int it = gw; it < DEPTH * I_L; it += ngw) {
        const int layer = it / I_L; int r = it % I_L;
        unsigned char* wl = ws + WS_W + (size_t)layer * WL_SIZE;
        if (r < I_IN) { const int nblk = NPAD / 32, kb = r / nblk, nb = r % nblk; int src, nc; win_map(nb * 32, src, nc);
            tr_item(wp.w_in + (size_t)layer * D * NIN, NIN, D, kb * 64, src, nc, (bf16*)(wl + WL_IN), nb * 32, scr, lane); continue; }
        r -= I_IN;
        if (r < I_SSM) { const int nblk = D / 32, kb = r / nblk, nb = r % nblk; tr_item(wp.w_ssm + (size_t)layer * DI * D, D, DI, kb * 64, nb * 32, 32, (bf16*)(wl + WL_SSM), nb * 32, scr, lane); continue; }
        r -= I_SSM;
        if (r < I_ATT) { const int nblk = D / 32, kb = r / nblk, nb = r % nblk; tr_item(wp.w_att + (size_t)layer * D * D, D, D, kb * 64, nb * 32, 32, (bf16*)(wl + WL_ATT), nb * 32, scr, lane); continue; }
        r -= I_ATT;
        if (r < I_MIX) { const int nblk = D / 32, kb = r / nblk, nb = r % nblk; tr_item(wp.w_mix + (size_t)layer * D * D, D, D, kb * 64, nb * 32, 32, (bf16*)(wl + WL_MIX), nb * 32, scr, lane); continue; }
        r -= I_MIX;
        if (r < I_UP) { const int nblk = FF2 / 32, kb = r / nblk, nb = r % nblk; tr_item(wp.w_up + (size_t)layer * D * FF2, FF2, D, kb * 64, nb * 32, 32, (bf16*)(wl + WL_UP), nb * 32, scr, lane); continue; }
        r -= I_UP;
        { const int nblk = D / 32, kb = r / nblk, nb = r % nblk; tr_item(wp.w_dn + (size_t)layer * FF * D, D, FF, kb * 64, nb * 32, 32, (bf16*)(wl + WL_DN), nb * 32, scr, lane); }
    }
}

__device__ __forceinline__ void ph_index_scores(const bf16* P, const float* SM, const bf16* KIB, float* SC, int blk, int nblk, int wave, int lane) {
    for (int u0 = blk; u0 < 256; u0 += nblk) {
#pragma unroll 1
        for (int half = 0; half < 2; ++half) {
            const int b = half, qt = half ? 255 - u0 : u0;
            const int q0 = b * SEQ + qt * 16, nkt = ((qt * 16) / 64 + 1) * 4;
            const int qrow = q0 + (lane & 15), kq = 8 * (lane >> 4);
            bf16x8 bq[IH][2]; float w[IH];
#pragma unroll
            for (int h = 0; h < IH; ++h) {
#pragma unroll
                for (int ks = 0; ks < 2; ++ks) bq[h][ks] = *(const bf16x8*)(P + (size_t)qrow * NMAIN + PQI + h * IDD + ks * 32 + kq);
                w[h] = SM[(size_t)qrow * SMW + SM_WI + h]; }
            for (int kt = wave; kt < nkt; kt += NWAVES) {
                const int key0 = kt * 16; const bf16* kp = KIB + (size_t)(b * SEQ + key0 + (lane & 15)) * IDD + kq;
                const bf16x8 a0 = *(const bf16x8*)kp, a1 = *(const bf16x8*)(kp + 32);
                f32x4 sc = (f32x4){0.f, 0.f, 0.f, 0.f};
#pragma unroll
                for (int h = 0; h < IH; ++h) { f32x4 c = (f32x4){0.f, 0.f, 0.f, 0.f};
                    c = __builtin_amdgcn_mfma_f32_16x16x32_bf16(a0, bq[h][0], c, 0, 0, 0); c = __builtin_amdgcn_mfma_f32_16x16x32_bf16(a1, bq[h][1], c, 0, 0, 0);
                    sc.x += w[h] * fmaxf(c.x, 0.f); sc.y += w[h] * fmaxf(c.y, 0.f); sc.z += w[h] * fmaxf(c.z, 0.f); sc.w += w[h] * fmaxf(c.w, 0.f); }
                *(f32x4*)(SC + (size_t)qrow * SEQ + key0 + 4 * (lane >> 4)) = sc;
            }
        }
    }
}

__device__ __forceinline__ void topk_bitwise(const float* srow, unsigned long long* mw, int limit, int lane) {
    unsigned u[64];
#pragma unroll
    for (int j = 0; j < 64; ++j) { const int key = j * 64 + lane; unsigned v = 0u;
        if (key < limit) { const unsigned bits = __float_as_uint(srow[key]); v = (bits & 0x80000000u) ? ~bits : (bits | 0x80000000u); }
        u[j] = v; }
    unsigned T = 0u;
#pragma unroll 1
    for (int bit = 31; bit >= 0; --bit) { const unsigned cand = T | (1u << bit); int cnt = 0;
#pragma unroll
        for (int j = 0; j < 64; ++j) cnt += __popcll(__ballot(u[j] >= cand));
        if (cnt >= TOPK) T = cand; }
    int cgt = 0;
#pragma unroll
    for (int j = 0; j < 64; ++j) cgt += __popcll(__ballot(u[j] > T));
    const int need_eq = TOPK - cgt; int eqbase = 0;
    const unsigned long long lt_mask = (1ull << lane) - 1ull;
#pragma unroll
    for (int j = 0; j < 64; ++j) {
        const bool gt = u[j] > T, eq = u[j] == T;
        const unsigned long long eqm = __ballot(eq);
        const bool take = gt || (eq && (eqbase + __popcll(eqm & lt_mask) < need_eq));
        const unsigned long long tm = __ballot(take);
        if (lane == 0 && j * 64 < limit) mw[j] = tm;
        eqbase += __popcll(eqm);
    }
}
__device__ __forceinline__ void ph_topk(const float* SC, unsigned long long* MASKW, LAS unsigned char* wl, int gw, int ngw, int lane) {
    constexpr int CAP = 1024;
    LAS unsigned* hist = (LAS unsigned*)wl;
    LAS unsigned* maskc = (LAS unsigned*)(wl + 1024);
    LAS float* cval = (LAS float*)(wl + 1536);
    LAS unsigned* ckey = (LAS unsigned*)(wl + 1536 + 4 * CAP);
    const unsigned long long lt_mask = (1ull << lane) - 1ull;
    for (int m = gw; m < M; m += ngw) {
        const int t = m & (SEQ - 1), limit = (t / 64 + 1) * 64, nw = limit / 64;
        unsigned long long* mw = MASKW + (size_t)m * 64;
        if (limit <= TOPK) { unsigned ones = 0xffffffffu; asm volatile("" : "+v"(ones)); if (lane < nw) mw[lane] = ((unsigned long long)ones << 32) | ones; continue; }
        const float* srow = SC + (size_t)m * SEQ;
        float s[64]; float smax = -__builtin_inff(), smin = __builtin_inff();
#pragma unroll
        for (int j = 0; j < 64; ++j) { s[j] = (j < nw) ? srow[j * 64 + lane] : 0.f; if (j < nw) { smax = fmaxf(smax, s[j]); smin = fminf(smin, s[j]); } }
        smax = wave_max(smax); smin = -wave_max(-smin);
        const float scale = smax > smin ? 255.0f / (smax - smin) : 0.f;
        asm volatile("" ::: "memory");
        hist[lane] = 0u; hist[lane + 64] = 0u; hist[lane + 128] = 0u; hist[lane + 192] = 0u; maskc[lane] = 0u; maskc[lane + 64] = 0u;
        LDS_WAIT();
#pragma unroll
        for (int j = 0; j < 64; ++j) if (j < nw) { const int b = min(255, (int)((s[j] - smin) * scale)); __hip_atomic_fetch_add(&hist[b], 1u, __ATOMIC_RELAXED, __HIP_MEMORY_SCOPE_WORKGROUP); }
        LDS_WAIT();
        const unsigned c0 = hist[4 * lane], c1 = hist[4 * lane + 1], c2 = hist[4 * lane + 2], c3 = hist[4 * lane + 3];
        unsigned suf = c0 + c1 + c2 + c3;
#pragma unroll
        for (int o = 1; o < 64; o <<= 1) { const unsigned v = __shfl_down(suf, o); if (lane + o < 64) suf += v; }
        const unsigned above = suf - (c0 + c1 + c2 + c3);
        int bstar = -1; unsigned cab = 0u;
        { unsigned cum = above;
          if (cum < TOPK && cum + c3 >= TOPK) { bstar = 4 * lane + 3; cab = cum; } cum += c3;
          if (bstar < 0 && cum < TOPK && cum + c2 >= TOPK) { bstar = 4 * lane + 2; cab = cum; } cum += c2;
          if (bstar < 0 && cum < TOPK && cum + c1 >= TOPK) { bstar = 4 * lane + 1; cab = cum; } cum += c1;
          if (bstar < 0 && cum < TOPK && cum + c0 >= TOPK) { bstar = 4 * lane + 0; cab = cum; } }
        const unsigned long long who = __ballot(bstar >= 0);
        const int src = __builtin_ctzll(who);
        bstar = __shfl(bstar, src); cab = __shfl(cab, src);
        const int need = TOPK - (int)cab;
        const unsigned ncand = hist[bstar];
        if (ncand > (unsigned)CAP) { topk_bitwise(srow, mw, limit, lane); continue; }
        unsigned long long myword = 0ull; int base = 0;
#pragma unroll
        for (int j = 0; j < 64; ++j) if (j < nw) {
            const int b = min(255, (int)((s[j] - smin) * scale));
            const unsigned long long gm = __ballot(b > bstar), em = __ballot(b == bstar);
            if (lane == j) myword = gm;
            if (b == bstar) { const int pos = base + __popcll(em & lt_mask); cval[pos] = s[j]; ckey[pos] = (unsigned)(j * 64 + lane); }
            base += __popcll(em);
        }
        LDS_WAIT();
        for (int i = lane; i < base; i += 64) { const float vi = cval[i]; const unsigned ki = ckey[i]; int rank = 0;
            if (need < base) { for (int q = 0; q < base; ++q) { const float vq = cval[q]; const unsigned kq = ckey[q]; rank += (vq > vi || (vq == vi && kq < ki)) ? 1 : 0; } }
            if (rank < need) __hip_atomic_fetch_or(&maskc[ki >> 5], 1u << (ki & 31), __ATOMIC_RELAXED, __HIP_MEMORY_SCOPE_WORKGROUP); }
        LDS_WAIT();
        if (lane < nw) { const unsigned long long cw_ = ((unsigned long long)maskc[2 * lane + 1] << 32) | maskc[2 * lane]; mw[lane] = myword | cw_; }
        LDS_WAIT(); asm volatile("" ::: "memory");
    }
}

typedef short s16x4 __attribute__((ext_vector_type(4)));
__device__ __forceinline__ s16x4 lds_tr4(const LAS unsigned char* p) { return __builtin_bit_cast(s16x4, __builtin_amdgcn_ds_read_tr16_b64_v4i16((LAS s16x4*)p)); }
__device__ __forceinline__ void ph_attn_dense(const bf16* P, const unsigned long long* MASKW, bf16* AO, LAS unsigned char* lds, int blk, int nblk, int tid) {
    constexpr int KS = 272, VS = 288, KBUF = 64 * KS, VBUF = 64 * VS, VOFF = 2 * KBUF;
    const int lane = tid & 63, wave = __builtin_amdgcn_readfirstlane(tid >> 6), g = lane >> 4, c16 = lane & 15;
    const int hq = wave >> 1, qh = (wave & 1) * 32;
    const float SCL = ATTN_SCALE * 1.4426950408889634f;
    for (int u0 = blk; u0 < 256; u0 += nblk) {
#pragma unroll 1
        for (int half = 0; half < 2; ++half) {
            const int b = u0 >> 7, kvh = (u0 >> 5) & 3, cc = u0 & 31, c = half ? 63 - cc : cc, nt = c + 1;
            const int m0 = b * SEQ + c * 64;
            bf16x8 qf[2][4];
#pragma unroll
            for (int qt = 0; qt < 2; ++qt)
#pragma unroll
                for (int kd = 0; kd < 4; ++kd) qf[qt][kd] = *(const bf16x8*)(P + (size_t)(m0 + qh + 16 * qt + c16) * NMAIN + PQ + (kvh * 4 + hq) * AD + 32 * kd + 8 * g);
            f32x4 O[2][8];
#pragma unroll
            for (int qt = 0; qt < 2; ++qt)
#pragma unroll
                for (int dt = 0; dt < 8; ++dt) O[qt][dt] = (f32x4){0.f, 0.f, 0.f, 0.f};
            float mrun[2] = {-__builtin_inff(), -__builtin_inff()}, lrun[2] = {0.f, 0.f};
            const bf16* kvbase = P + (size_t)(b * SEQ) * NMAIN + kvh * AD;
            u32x4 kreg[2], vreg[2];
#define ATT_LOAD(t) do { _Pragma("unroll") for (int i = 0; i < 2; ++i) { const int id = tid + 512 * i; const bf16* src = kvbase + (size_t)((t) * 64 + (id >> 4)) * NMAIN + (id & 15) * 8; \
                kreg[i] = *(const u32x4*)(src + PK); vreg[i] = *(const u32x4*)(src + PV); } } while (0)
#define ATT_STORE(buf) do { _Pragma("unroll") for (int i = 0; i < 2; ++i) { const int id = tid + 512 * i; \
                *(LAS u32x4*)(lds + (buf) * KBUF + (id >> 4) * KS + (id & 15) * 16) = kreg[i]; *(LAS u32x4*)(lds + VOFF + (buf) * VBUF + (id >> 4) * VS + (id & 15) * 16) = vreg[i]; } } while (0)
            __syncthreads();
            ATT_LOAD(0); ATT_STORE(0);
            __syncthreads();
            for (int t = 0; t < nt; ++t) {
                const int buf = t & 1;
                if (t + 1 < nt) ATT_LOAD(t + 1);
                const LAS unsigned char* kb = lds + buf * KBUF + c16 * KS + g * 16;
                const LAS unsigned char* vb = lds + VOFF + buf * VBUF + (4 * g + (c16 >> 2)) * VS + (c16 & 3) * 8;
                f32x4 S[2][4];
#pragma unroll
                for (int kt = 0; kt < 4; ++kt) {
                    bf16x8 kf[4];
#pragma unroll
                    for (int kd = 0; kd < 4; ++kd) kf[kd] = *(const LAS bf16x8*)(kb + kt * 16 * KS + kd * 64);
#pragma unroll
                    for (int qt = 0; qt < 2; ++qt) { f32x4 s = (f32x4){0.f, 0.f, 0.f, 0.f};
#pragma unroll
                        for (int kd = 0; kd < 4; ++kd) s = __builtin_amdgcn_mfma_f32_16x16x32_bf16(kf[kd], qf[qt][kd], s, 0, 0, 0);
                        S[qt][kt] = s; }
                }
                bf16x8 pf[2][2];
#pragma unroll
                for (int qt = 0; qt < 2; ++qt) {
                    const unsigned long long mw = MASKW[(size_t)(m0 + qh + 16 * qt + c16) * 64 + t] >> (4 * g);
                    const unsigned mlo = (unsigned)mw, mhi = (unsigned)(mw >> 32);
                    float mx = -__builtin_inff();
#pragma unroll
                    for (int kt = 0; kt < 4; ++kt)
#pragma unroll
                        for (int j = 0; j < 4; ++j) { const unsigned word = kt < 2 ? mlo : mhi; const bool on = (word >> ((kt & 1) * 16 + j)) & 1u;
                            const float s = on ? S[qt][kt][j] * SCL : -__builtin_inff(); S[qt][kt][j] = s; mx = fmaxf(mx, s); }
                    mx = fmaxf(mx, __shfl_xor(mx, 16)); mx = fmaxf(mx, __shfl_xor(mx, 32));
                    const float mnew = fmaxf(mrun[qt], mx), muse = (mnew == -__builtin_inff()) ? 0.f : mnew;
                    const float alpha = __builtin_amdgcn_exp2f(mrun[qt] - muse);
                    float ps = 0.f;
#pragma unroll
                    for (int kt = 0; kt < 4; ++kt)
#pragma unroll
                        for (int j = 0; j < 4; ++j) { const float p = __builtin_amdgcn_exp2f(S[qt][kt][j] - muse); S[qt][kt][j] = p; ps += p; }
                    ps += __shfl_xor(ps, 16); ps += __shfl_xor(ps, 32);
                    lrun[qt] = lrun[qt] * alpha + ps; mrun[qt] = mnew;
#pragma unroll
                    for (int dt = 0; dt < 8; ++dt) O[qt][dt] *= alpha;
#pragma unroll
                    for (int ks = 0; ks < 2; ++ks) { u32x4 w; w.x = pk2(S[qt][2 * ks][0], S[qt][2 * ks][1]); w.y = pk2(S[qt][2 * ks][2], S[qt][2 * ks][3]);
                        w.z = pk2(S[qt][2 * ks + 1][0], S[qt][2 * ks + 1][1]); w.w = pk2(S[qt][2 * ks + 1][2], S[qt][2 * ks + 1][3]); pf[qt][ks] = __builtin_bit_cast(bf16x8, w); }
                }
#pragma unroll
                for (int dt = 0; dt < 8; ++dt)
#pragma unroll
                    for (int ks = 0; ks < 2; ++ks) {
                        const s16x4 lo = lds_tr4(vb + (32 * ks) * VS + dt * 32), hi = lds_tr4(vb + (32 * ks + 16) * VS + dt * 32);
                        const bf16x8 vf = __builtin_shufflevector(lo, hi, 0, 1, 2, 3, 4, 5, 6, 7);
                        O[0][dt] = __builtin_amdgcn_mfma_f32_16x16x32_bf16(vf, pf[0][ks], O[0][dt], 0, 0, 0);
                        O[1][dt] = __builtin_amdgcn_mfma_f32_16x16x32_bf16(vf, pf[1][ks], O[1][dt], 0, 0, 0);
                    }
                if (t + 1 < nt) ATT_STORE(buf ^ 1);
                __syncthreads();
            }
#undef ATT_LOAD
#undef ATT_STORE
#pragma unroll
            for (int qt = 0; qt < 2; ++qt) { const float r = 1.0f / lrun[qt];
                bf16* op = AO + (size_t)(m0 + qh + 16 * qt + c16) * D + (kvh * 4 + hq) * AD + 4 * g;
#pragma unroll
                for (int dt = 0; dt < 8; ++dt) { const f32x4 o = O[qt][dt] * r; u32x2 w; w.x = pk2(o.x, o.y); w.y = pk2(o.z, o.w); *(u32x2*)(op + 16 * dt) = w; } }
        }
    }
}

__device__ __forceinline__ void stage_conv(const bf16* P, const float* cw, const float* cb, int m0, int tpos0, int ch0, int nch, LAS unsigned char* dst, int stride, int tid) {
    const int cpr = nch >> 3;
    for (int id = tid; id < 64 * cpr; id += NTHR) {
        const int s = id / cpr, k = id - s * cpr, ch = ch0 + 8 * k;
        float acc[8];
        { const f32x4 b0 = *(const f32x4*)(cb + ch), b1 = *(const f32x4*)(cb + ch + 4); acc[0] = b0.x; acc[1] = b0.y; acc[2] = b0.z; acc[3] = b0.w; acc[4] = b1.x; acc[5] = b1.y; acc[6] = b1.z; acc[7] = b1.w; }
#pragma unroll
        for (int i = 0; i < 4; ++i) { if (tpos0 + s - 3 + i >= 0) {
            float x[8]; unpack8(*(const u32x4*)(P + (size_t)(m0 + s - 3 + i) * NMAIN + PXBC + ch), x);
            const f32x4 w0 = *(const f32x4*)(cw + i * CONVD + ch), w1 = *(const f32x4*)(cw + i * CONVD + ch + 4);
            acc[0] += w0.x * x[0]; acc[1] += w0.y * x[1]; acc[2] += w0.z * x[2]; acc[3] += w0.w * x[3]; acc[4] += w1.x * x[4]; acc[5] += w1.y * x[5]; acc[6] += w1.z * x[6]; acc[7] += w1.w * x[7]; } }
#pragma unroll
        for (int j = 0; j < 8; ++j) acc[j] = siluf_(acc[j]);
        *(LAS u32x4*)(dst + s * stride + k * 16) = pack8(acc);
    }
}
__device__ __forceinline__ void wave_dt_acs(const float* SM, const float* dt_bias, const float* a_log, int m0, int head, LAS float* dtw, LAS float* acsw, int lane) {
    const float raw = SM[(size_t)(m0 + lane) * SMW + SM_DT + head] + dt_bias[head];
    const float dt = fmaxf(raw, 0.f) + log1pf(__expf(-fabsf(raw)));
    float x = dt * (-__expf(a_log[head]));
#pragma unroll
    for (int o = 1; o < 64; o <<= 1) { const float v = __shfl_up(x, o); if (lane >= o) x += v; }
    dtw[lane] = dt; acsw[lane] = x;
}
__device__ __forceinline__ bf16x8 tr8(const LAS unsigned char* p, int off_lo, int off_hi) {
    const s16x4 lo = lds_tr4(p + off_lo), hi = lds_tr4(p + off_hi); return __builtin_shufflevector(lo, hi, 0, 1, 2, 3, 4, 5, 6, 7);
}
template <int NOUT> __device__ __forceinline__ void conv_strip(const bf16* src, int tpos_first_raw, const float* cw, const float* cb, u32x4 (&out)[NOUT]) {
    u32x4 raw[NOUT + 3];
#pragma unroll
    for (int i = 0; i < NOUT + 3; ++i) { const int tp = tpos_first_raw + i; raw[i] = *(const u32x4*)(src + (size_t)(tp < 0 ? 3 : i) * NMAIN); if (tp < 0) raw[i] = (u32x4){0u, 0u, 0u, 0u}; }
    f32x4 w[4][2];
#pragma unroll
    for (int t = 0; t < 4; ++t) { w[t][0] = *(const f32x4*)(cw + t * CONVD); w[t][1] = *(const f32x4*)(cw + t * CONVD + 4); }
    const f32x4 b0 = *(const f32x4*)cb, b1 = *(const f32x4*)(cb + 4);
#pragma unroll
    for (int o = 0; o < NOUT; ++o) { f32x4 a0 = b0, a1 = b1;
#pragma unroll
        for (int t = 0; t < 4; ++t) { float x[8]; unpack8(raw[o + t], x); a0 += w[t][0] * (f32x4){x[0], x[1], x[2], x[3]}; a1 += w[t][1] * (f32x4){x[4], x[5], x[6], x[7]}; }
        float f[8] = {a0.x, a0.y, a0.z, a0.w, a1.x, a1.y, a1.z, a1.w};
#pragma unroll
        for (int j = 0; j < 8; ++j) f[j] = f[j] * __builtin_amdgcn_rcpf(1.0f + __expf(-f[j]));
        out[o] = pack8(f); }
}
__device__ __forceinline__ void ph_ssd_states(const bf16* P, const float* SM, const float* cw, const float* cb, const float* dt_bias, const float* a_log, bf16* XC, bf16* ST, float* CD,
                                              LAS unsigned char* lds, int blk, int nblk, int tid) {
    constexpr int RSW = 160, XW = 64 * RSW, RSB = 288, BMB = 64 * RSB, O_BM = 8 * XW, O_DT = O_BM + 2 * BMB, O_ACS = O_DT + 2048;
    const int lane = tid & 63, wave = __builtin_amdgcn_readfirstlane(tid >> 6), gq = lane >> 4, c16 = lane & 15;
    LAS unsigned char* xw = lds + wave * XW;
    LAS float* dtw = (LAS float*)(lds + O_DT) + wave * 64; LAS float* acsw = (LAS float*)(lds + O_ACS) + wave * 64;
    int par = 0;
    for (int item = blk; item < BATCH * 64 * NG; item += nblk, par ^= 1) {
        const int bc = item >> 3, g = item & 7, m0 = bc * 64, tpos0 = (bc & 63) * 64, head = g * HPG + wave;
        LAS unsigned char* bm = lds + O_BM + par * BMB;
        asm volatile("" ::: "memory");
        { const int k16 = lane & 15, r0 = 8 * wave + 2 * gq, chB = DI + g * NS + 8 * k16;
          const bf16* base = P + (size_t)(m0 + r0 - 3) * NMAIN + PXBC + chB;
          u32x4 ob[2], oc[2];
          conv_strip<2>(base, tpos0 + r0 - 3, cw + chB, cb + chB, ob);
          conv_strip<2>(base + NG * NS, tpos0 + r0 - 3, cw + chB + NG * NS, cb + chB + NG * NS, oc);
#pragma unroll
          for (int o = 0; o < 2; ++o) { *(LAS u32x4*)(bm + (r0 + o) * RSB + k16 * 16) = ob[o];
              *(u32x4*)(XC + (size_t)(m0 + r0 + o) * CONVD + chB) = ob[o]; *(u32x4*)(XC + (size_t)(m0 + r0 + o) * CONVD + chB + NG * NS) = oc[o]; } }
        { const int k8 = lane & 7, r0 = 8 * (lane >> 3), ch = head * HP + 8 * k8;
          u32x4 ox[8];
          conv_strip<8>(P + (size_t)(m0 + r0 - 3) * NMAIN + PXBC + ch, tpos0 + r0 - 3, cw + ch, cb + ch, ox);
#pragma unroll
          for (int o = 0; o < 8; ++o) { *(LAS u32x4*)(xw + (r0 + o) * RSW + k8 * 16) = ox[o]; *(u32x4*)(XC + (size_t)(m0 + r0 + o) * CONVD + ch) = ox[o]; } }
        wave_dt_acs(SM, dt_bias, a_log, m0, head, dtw, acsw, lane);
        LDS_WAIT();
        __syncthreads();
        const float aend = acsw[63];
        if (lane == 0) CD[bc * NH + head] = __expf(aend);
        const LAS unsigned char* xb = xw + (4 * gq + (c16 >> 2)) * RSW + (c16 & 3) * 8;
        const LAS unsigned char* bb = bm + (4 * gq + (c16 >> 2)) * RSB + (c16 & 3) * 8;
        bf16x8 xf[4][2];
#pragma unroll
        for (int ks = 0; ks < 2; ++ks) { float w[8];
#pragma unroll
            for (int j = 0; j < 8; ++j) { const int s = 32 * ks + 16 * (j >> 2) + 4 * gq + (j & 3); w[j] = dtw[s] * __expf(aend - acsw[s]); }
#pragma unroll
            for (int pt = 0; pt < 4; ++pt) { const bf16x8 r = tr8(xb + pt * 32, (32 * ks) * RSW, (32 * ks + 16) * RSW); float f[8]; unpack8(__builtin_bit_cast(u32x4, r), f);
#pragma unroll
                for (int j = 0; j < 8; ++j) f[j] *= w[j];
                xf[pt][ks] = __builtin_bit_cast(bf16x8, pack8(f)); } }
        bf16* dst = ST + (((size_t)bc * NH + head) * HP + c16) * NS + 4 * gq;
#pragma unroll 2
        for (int nt = 0; nt < 8; ++nt) {
            const bf16x8 a0 = tr8(bb + nt * 32, 0, 16 * RSB), a1 = tr8(bb + nt * 32, 32 * RSB, 48 * RSB);
#pragma unroll
            for (int pt = 0; pt < 4; ++pt) { f32x4 acc = (f32x4){0.f, 0.f, 0.f, 0.f};
                acc = __builtin_amdgcn_mfma_f32_16x16x32_bf16(a0, xf[pt][0], acc, 0, 0, 0); acc = __builtin_amdgcn_mfma_f32_16x16x32_bf16(a1, xf[pt][1], acc, 0, 0, 0);
                u32x2 o; o.x = pk2(acc.x, acc.y); o.y = pk2(acc.z, acc.w); *(u32x2*)(dst + (size_t)(16 * pt) * NS + 16 * nt) = o; }
        }
        LDS_WAIT(); asm volatile("" ::: "memory");
    }
}
__device__ __forceinline__ void ph_ssd_scan(bf16* ST, const float* CD, int gtid, int nthr) {
    for (int it = gtid; it < BATCH * NH * HP * (NS / 8); it += nthr) {
        const int n8 = it & 15, p = (it >> 4) & 63, head = (it >> 10) & 63, b = it >> 16;
        float h[8];
#pragma unroll
        for (int j = 0; j < 8; ++j) h[j] = 0.f;
#pragma unroll 8
        for (int c = 0; c < 64; ++c) { u32x4* q = (u32x4*)(ST + ((((size_t)(b * 64 + c)) * NH + head) * HP + p) * NS) + n8;
            float v[8]; unpack8(*q, v); *q = pack8(h); const float dec = CD[(b * 64 + c) * NH + head];
#pragma unroll
            for (int j = 0; j < 8; ++j) h[j] = h[j] * dec + v[j]; }
    }
}
__device__ __forceinline__ void ph_ssd_out(const bf16* P, const float* SM, const bf16* XC, const float* dt_bias, const float* a_log, const bf16* ST,
                                           const float* dskip, const float* gnorm, bf16* Y, LAS unsigned char* lds, int blk, int nblk, int tid) {
    constexpr int RSW = 160, XW = 64 * RSW, O_DT = 8 * XW, O_ACS = O_DT + 2048, O_SSQ = O_ACS + 2048;
    const int lane = tid & 63, wave = __builtin_amdgcn_readfirstlane(tid >> 6), gq = lane >> 4, c16 = lane & 15;
    LAS unsigned char* xw = lds + wave * XW;
    LAS float* dtw = (LAS float*)(lds + O_DT) + wave * 64; LAS float* acsw = (LAS float*)(lds + O_ACS) + wave * 64;
    int par = 0;
    for (int item = blk; item < BATCH * 64 * NG; item += nblk, par ^= 1) {
        const int bc = item >> 3, g = item & 7, m0 = bc * 64, head = g * HPG + wave;
        asm volatile("" ::: "memory");
        { u32x4 xr[8];
#pragma unroll
          for (int i = 0; i < 8; ++i) xr[i] = *(const u32x4*)(XC + (size_t)(m0 + (lane >> 3) + 8 * i) * CONVD + head * HP + (lane & 7) * 8);
#pragma unroll
          for (int i = 0; i < 8; ++i) *(LAS u32x4*)(xw + ((lane >> 3) + 8 * i) * RSW + (lane & 7) * 16) = xr[i]; }
        wave_dt_acs(SM, dt_bias, a_log, m0, head, dtw, acsw, lane);
        const bf16* cbase = XC + (size_t)(m0 + c16) * CONVD + DI + NG * NS + g * NS + 8 * gq;
        const bf16* bbase = cbase - NG * NS;
        bf16x8 cf[4][4];
#pragma unroll
        for (int lt = 0; lt < 4; ++lt)
#pragma unroll
            for (int kn = 0; kn < 4; ++kn) cf[lt][kn] = *(const bf16x8*)(cbase + (size_t)(16 * lt) * CONVD + 32 * kn);
        LDS_WAIT(); asm volatile("" ::: "memory");
        float al[4];
#pragma unroll
        for (int lt = 0; lt < 4; ++lt) al[lt] = acsw[16 * lt + c16];
        bf16x8 lf[2][4];
#pragma unroll
        for (int ks = 0; ks < 2; ++ks) {
            f32x4 lt4[2][4];
#pragma unroll
            for (int h2 = 0; h2 < 2; ++h2) { const int st = 2 * ks + h2;
                bf16x8 bfr[4];
#pragma unroll
                for (int kn = 0; kn < 4; ++kn) bfr[kn] = *(const bf16x8*)(bbase + (size_t)(16 * st) * CONVD + 32 * kn);
                float as_[4], ds_[4];
#pragma unroll
                for (int j = 0; j < 4; ++j) { as_[j] = acsw[16 * st + 4 * gq + j]; ds_[j] = dtw[16 * st + 4 * gq + j]; }
#pragma unroll
                for (int lt = 0; lt < 4; ++lt) { f32x4 t4 = (f32x4){0.f, 0.f, 0.f, 0.f};
                    if (lt >= st) {
#pragma unroll
                        for (int kn = 0; kn < 4; ++kn) t4 = __builtin_amdgcn_mfma_f32_16x16x32_bf16(bfr[kn], cf[lt][kn], t4, 0, 0, 0);
#pragma unroll
                        for (int j = 0; j < 4; ++j) { const float e = __expf(fminf(al[lt] - as_[j], 0.f)) * ds_[j]; const bool ok = (lt > st) || (4 * gq + j <= c16); t4[j] = ok ? t4[j] * e : 0.f; } }
                    lt4[h2][lt] = t4; } }
#pragma unroll
            for (int lt = 0; lt < 4; ++lt) { u32x4 w; w.x = pk2(lt4[0][lt][0], lt4[0][lt][1]); w.y = pk2(lt4[0][lt][2], lt4[0][lt][3]); w.z = pk2(lt4[1][lt][0], lt4[1][lt][1]); w.w = pk2(lt4[1][lt][2], lt4[1][lt][3]);
                lf[ks][lt] = __builtin_bit_cast(bf16x8, w); }
        }
        f32x4 acc[4][4];
        const bf16* hsrc = ST + (((size_t)bc * NH + head) * HP + c16) * NS + 8 * gq;
#pragma unroll
        for (int pt = 0; pt < 4; ++pt) { bf16x8 hf[4];
#pragma unroll
            for (int kn = 0; kn < 4; ++kn) hf[kn] = *(const bf16x8*)(hsrc + (size_t)(16 * pt) * NS + 32 * kn);
#pragma unroll
            for (int lt = 0; lt < 4; ++lt) { f32x4 t4 = (f32x4){0.f, 0.f, 0.f, 0.f};
#pragma unroll
                for (int kn = 0; kn < 4; ++kn) t4 = __builtin_amdgcn_mfma_f32_16x16x32_bf16(hf[kn], cf[lt][kn], t4, 0, 0, 0);
                acc[pt][lt] = t4 * __expf(al[lt]); } }
        const LAS unsigned char* xb = xw + (4 * gq + (c16 >> 2)) * RSW + (c16 & 3) * 8;
#pragma unroll
        for (int pt = 0; pt < 4; ++pt) {
            const bf16x8 x0 = tr8(xb + pt * 32, 0, 16 * RSW), x1 = tr8(xb + pt * 32, 32 * RSW, 48 * RSW);
#pragma unroll
            for (int lt = 0; lt < 4; ++lt) { acc[pt][lt] = __builtin_amdgcn_mfma_f32_16x16x32_bf16(x0, lf[0][lt], acc[pt][lt], 0, 0, 0);
                if (lt >= 2) acc[pt][lt] = __builtin_amdgcn_mfma_f32_16x16x32_bf16(x1, lf[1][lt], acc[pt][lt], 0, 0, 0); } }
        const float dk = dskip[head]; float ssq[4] = {0.f, 0.f, 0.f, 0.f};
#pragma unroll
        for (int lt = 0; lt < 4; ++lt) { const int l = 16 * lt + c16;
#pragma unroll
            for (int pt = 0; pt < 4; ++pt) { const int p0 = 16 * pt + 4 * gq;
                const u32x2 xv = *(const LAS u32x2*)(xw + l * RSW + p0 * 2); const u32x2 zw = *(const u32x2*)(P + (size_t)(m0 + l) * NMAIN + PZ + head * HP + p0);
                const float xs4[4] = {bflo(xv.x), bfhi(xv.x), bflo(xv.y), bfhi(xv.y)}, z4[4] = {bflo(zw.x), bfhi(zw.x), bflo(zw.y), bfhi(zw.y)};
#pragma unroll
                for (int j = 0; j < 4; ++j) { const float y = (acc[pt][lt][j] + dk * xs4[j]) * z4[j] * __builtin_amdgcn_rcpf(1.0f + __expf(-z4[j])); acc[pt][lt][j] = y; ssq[lt] += y * y; } } }
        LAS float* ssqs = (LAS float*)(lds + O_SSQ) + par * 512;
#pragma unroll
        for (int lt = 0; lt < 4; ++lt) { float v = ssq[lt]; v += __shfl_xor(v, 16); v += __shfl_xor(v, 32); if (gq == 0) ssqs[wave * 64 + 16 * lt + c16] = v; }
        LDS_WAIT();
        __syncthreads();
#pragma unroll
        for (int lt = 0; lt < 4; ++lt) { const int l = 16 * lt + c16; float tot = 0.f;
#pragma unroll
            for (int w8 = 0; w8 < 8; ++w8) tot += ssqs[w8 * 64 + l];
            const float rstd = rsqrtf(tot * (1.0f / (HPG * HP)) + EPS);
#pragma unroll
            for (int pt = 0; pt < 4; ++pt) { const int ch = head * HP + 16 * pt + 4 * gq; const f32x4 gn = *(const f32x4*)(gnorm + ch); const f32x4 o = acc[pt][lt] * rstd * gn;
                u32x2 w; w.x = pk2(o.x, o.y); w.y = pk2(o.z, o.w); *(u32x2*)(Y + (size_t)(m0 + l) * DI + ch) = w; } }
        LDS_WAIT(); asm volatile("" ::: "memory");
    }
}

__device__ __forceinline__ float gelu_tanhf_(float x) { const float u = 0.7978845608028654f * (x + 0.044715f * x * x * x); const float t = 1.0f - 2.0f / (1.0f + __expf(2.0f * u)); return 0.5f * x * (1.0f + t); }
__device__ __forceinline__ void ph_ffn_act(const bf16* U, const float* cw, const float* cb, bf16* ACT, int gtid, int nthr) {
    constexpr int NCG = FF / 8;
    for (int it = gtid; it < M * NCG; it += nthr) {
        const int m = it / NCG, c0 = (it % NCG) * 8, t = m & (SEQ - 1);
        float ag[8], av[8];
        { const f32x4 b0 = *(const f32x4*)(cb + c0), b1 = *(const f32x4*)(cb + c0 + 4), d0 = *(const f32x4*)(cb + FF + c0), d1 = *(const f32x4*)(cb + FF + c0 + 4);
          ag[0] = b0.x; ag[1] = b0.y; ag[2] = b0.z; ag[3] = b0.w; ag[4] = b1.x; ag[5] = b1.y; ag[6] = b1.z; ag[7] = b1.w;
          av[0] = d0.x; av[1] = d0.y; av[2] = d0.z; av[3] = d0.w; av[4] = d1.x; av[5] = d1.y; av[6] = d1.z; av[7] = d1.w; }
#pragma unroll
        for (int i = 0; i < 3; ++i) { if (t - 2 + i >= 0) {
            const bf16* ur = U + (size_t)(m - 2 + i) * FF2 + c0; float xg[8], xv[8]; unpack8(*(const u32x4*)ur, xg); unpack8(*(const u32x4*)(ur + FF), xv);
            const float* wg = cw + i * FF2 + c0; const float* wv = wg + FF;
#pragma unroll
            for (int j = 0; j < 8; ++j) { ag[j] += wg[j] * xg[j]; av[j] += wv[j] * xv[j]; } } }
        float o[8];
#pragma unroll
        for (int j = 0; j < 8; ++j) o[j] = gelu_tanhf_(ag[j]) * av[j];
        *(u32x4*)(ACT + (size_t)m * FF + c0) = pack8(o);
    }
}

struct Args { const float* in[20]; float* out; unsigned char* ws; int ph_lo, ph_hi; };
constexpr int NP = 11, NPHASE = 1 + DEPTH * NP;

__global__ void __launch_bounds__(NTHR, 2) fwd(Args args) {
    extern __shared__ __attribute__((aligned(16))) unsigned char lds[];
    const int G = gridDim.x, blk = blockIdx.x;
    volatile LAS unsigned* MISC = (volatile LAS unsigned*)((LAS unsigned char*)lds + MISC_OFF);
    for (int u = threadIdx.x; u < (LDS_BYTES - LDSCTL_OFF) / 4; u += NTHR) ((LAS unsigned*)((LAS unsigned char*)lds + LDSCTL_OFF))[u] = 0u;
    __syncthreads();
    XcdBarrier bar; bar.bar = (unsigned*)(args.ws + WS_CTL) + CW_BAR; bar.x = 0; bar.st = nullptr;
    if (!MK_PER_PHASE) bar = xcd_barrier_post((unsigned*)(args.ws + WS_CTL) + CW_BAR, MISC + 8);
    const int lo = args.ph_lo, hi = args.ph_hi;
#define IN(k) (lo <= (k) && (k) < hi)
#define SEAM(k) do { if (IN(k) && IN((k) + 1)) xcd_barrier(bar); } while (0)
#define PH_BEGIN \
    int tid = threadIdx.x; asm volatile("" : "+v"(tid)); \
    const int lane = tid & 63, wave = __builtin_amdgcn_readfirstlane(tid >> 6); \
    const int gw = blk * NWAVES + wave, ngw = G * NWAVES, gtid = blk * NTHR + tid, nthr = G * NTHR; \
    unsigned char* ws = args.ws; asm volatile("" : "+s"(ws)); \
    LAS unsigned char* ring = (LAS unsigned char*)lds; \
    (void)lane; (void)wave; (void)gw; (void)ngw; (void)gtid; (void)nthr; (void)ring; \
    float* X = args.out; \
    bf16* H = (bf16*)(ws + WS_H); bf16* P = (bf16*)(ws + WS_P); float* SM = (float*)(ws + WS_SM); bf16* XC = (bf16*)(ws + WS_XC); \
    float* CD = (float*)(ws + WS_DT); bf16* STB = (bf16*)(ws + WS_ST); bf16* Y = (bf16*)(ws + WS_Y); \
    float* SC = (float*)(ws + WS_SC); unsigned long long* MASKW = (unsigned long long*)(ws + WS_IDX); bf16* AO = (bf16*)(ws + WS_AO); \
    float* MG = (float*)(ws + WS_MG); bf16* MGB = (bf16*)(ws + WS_MGB); float* YM = (float*)(ws + WS_YM); bf16* U = (bf16*)(ws + WS_U); \
    bf16* ACT = (bf16*)(ws + WS_ACT); bf16* KIB = (bf16*)(ws + WS_KIB); \
    (void)X; (void)H; (void)P; (void)SM; (void)XC; (void)CD; (void)STB; (void)Y; (void)SC; (void)MASKW; (void)AO; (void)MG; (void)MGB; (void)YM; (void)U; (void)ACT; (void)KIB;

    if (IN(0)) { PH_BEGIN
        WPtrs wp{args.in[5], args.in[13], args.in[14], args.in[15], args.in[16], args.in[19]};
        ph_weights(wp, ws, (float*)lds + wave * 2176, gw, ngw, lane);
        ph_resid_norm(nullptr, nullptr, args.in[1], args.in[0], X, H, gw, ngw, lane);
    }
    SEAM(0);

#pragma unroll 1
    for (int layer = 0; layer < DEPTH; ++layer) {
        const int pb = 1 + layer * NP;
#define WL (ws + WS_W + (size_t)layer * WL_SIZE)
        if (IN(pb + 0)) { PH_BEGIN
            pg8::Gemm g{H, (const bf16*)(WL + WL_IN), M, NPAD, D}; pg8::StaticOrder S; S.init(M, NPAD, G, blk);
            pg8::EpiIn E{P, NMAIN, SM, args.in[6] + (size_t)layer * 2 * D, PG / 256, NMAIN / 256, KIB};
            REP(1) { pg8::gemm_phase<pg8::EpiIn, pg8::StaticOrder, true, true>(ring, g, S, E); __syncthreads(); }
        }
        SEAM(pb + 0);
        if (IN(pb + 1)) { PH_BEGIN
            REP(20) { ph_ssd_states(P, SM, args.in[7] + (size_t)layer * 4 * CONVD, args.in[8] + (size_t)layer * CONVD, args.in[9] + layer * NH, args.in[10] + layer * NH, XC, STB, CD, ring, blk, G, tid); __syncthreads(); }
            REP(21) ph_index_scores(P, SM, KIB, SC, blk, G, wave, lane); }
        SEAM(pb + 1);
        if (IN(pb + 2)) { PH_BEGIN
            ph_ssd_scan(STB, CD, gtid, nthr); REP(30) ph_topk(SC, MASKW, ring + wave * 9728, gw, ngw, lane); }
        SEAM(pb + 2);
        if (IN(pb + 3)) { PH_BEGIN
            REP(40) { ph_ssd_out(P, SM, XC, args.in[9] + layer * NH, args.in[10] + layer * NH, STB,
                                 args.in[11] + layer * NH, args.in[12] + (size_t)layer * DI, Y, ring, blk, G, tid); __syncthreads(); }
            REP(41) { ph_attn_dense(P, MASKW, AO, ring, blk, G, tid); __syncthreads(); } }
        SEAM(pb + 3);
        if (IN(pb + 4)) {
            { PH_BEGIN
              pg8::Gemm g{Y, (const bf16*)(WL + WL_SSM), M, D, DI}; pg8::StaticOrder S; S.init(M, D, G, blk);
              pg8::EpiGateMul E{MG, D, P + PG, NMAIN}; pg8::gemm_phase<pg8::EpiGateMul, pg8::StaticOrder, false, true>(ring, g, S, E); }
            __syncthreads();
            { PH_BEGIN
              pg8::Gemm g{AO, (const bf16*)(WL + WL_ATT), M, D, D}; pg8::StaticOrder S; S.init(M, D, G, blk);
              pg8::EpiGateAdd E{MG, MGB, D, P + PG + D, NMAIN}; pg8::gemm_phase<pg8::EpiGateAdd, pg8::StaticOrder, false, true>(ring, g, S, E); }
        }
        SEAM(pb + 4);
        if (IN(pb + 5)) { PH_BEGIN
            pg8::Gemm g{MGB, (const bf16*)(WL + WL_MIX), M, D, D}; pg8::StaticOrder S; S.init(M, D, G, blk);
            pg8::EpiF32 E{YM, D}; REP(60) { pg8::gemm_phase<pg8::EpiF32, pg8::StaticOrder, false, true>(ring, g, S, E); __syncthreads(); } }
        SEAM(pb + 5);
        if (IN(pb + 6)) { PH_BEGIN
            ph_resid_norm(YM, args.in[2] + (size_t)layer * D, args.in[3] + (size_t)layer * D, X, X, H, gw, ngw, lane); }
        SEAM(pb + 6);
        if (IN(pb + 7)) { PH_BEGIN
            pg8::Gemm g{H, (const bf16*)(WL + WL_UP), M, FF2, D}; pg8::StaticOrder S; S.init(M, FF2, G, blk);
            pg8::EpiBf16<0> E{U, FF2, nullptr, 0, 0, 1.f}; REP(80) { pg8::gemm_phase<pg8::EpiBf16<0>, pg8::StaticOrder, true, true>(ring, g, S, E); __syncthreads(); } }
        SEAM(pb + 7);
        if (IN(pb + 8)) { PH_BEGIN
            REP(90) ph_ffn_act(U, args.in[17] + (size_t)layer * 3 * FF2, args.in[18] + (size_t)layer * FF2, ACT, gtid, nthr); }
        SEAM(pb + 8);
        if (IN(pb + 9)) { PH_BEGIN
            pg8::Gemm g{ACT, (const bf16*)(WL + WL_DN), M, D, FF}; pg8::StaticOrder S; S.init(M, D, G, blk);
            pg8::EpiF32 E{YM, D}; REP(100) { pg8::gemm_phase<pg8::EpiF32, pg8::StaticOrder, false, true>(ring, g, S, E); __syncthreads(); } }
        SEAM(pb + 9);
        if (IN(pb + 10)) { PH_BEGIN
            ph_resid_norm(YM, args.in[4] + (size_t)layer * D, layer + 1 < DEPTH ? args.in[1] + (size_t)(layer + 1) * D : nullptr, X, X, H, gw, ngw, lane); }
        SEAM(pb + 10);
    }
#undef IN
#undef SEAM
#undef WL
#undef PH_BEGIN
}

extern "C" void kernel_launch(void* const* d_in, const int* in_sizes, int n_in, void* d_out, int out_size, void* d_ws, size_t ws_size, hipStream_t stream) {
    static int grid = 0;
    if (grid == 0) {
        if (n_in != 20 || in_sizes[0] != M * D || out_size != M * D || ws_size < WS_END) { fprintf(stderr, "kernel_launch: unexpected shapes (n_in %d, in0 %d, out %d, ws %zu < %zu)\n", n_in, n_in > 0 ? in_sizes[0] : -1, out_size, ws_size, (size_t)WS_END); grid = -1; return; }
        int dev = 0, cus = 0, per_cu = 0;
        if (hipGetDevice(&dev) != hipSuccess || hipDeviceGetAttribute(&cus, hipDeviceAttributeMultiprocessorCount, dev) != hipSuccess) { grid = -1; return; }
        if (hipFuncSetAttribute((const void*)fwd, hipFuncAttributeMaxDynamicSharedMemorySize, LDS_BYTES) != hipSuccess) { fprintf(stderr, "kernel_launch: hipFuncSetAttribute failed\n"); grid = -1; return; }
        if (hipOccupancyMaxActiveBlocksPerMultiprocessor(&per_cu, (const void*)fwd, NTHR, LDS_BYTES) != hipSuccess || per_cu < 1) fprintf(stderr, "kernel_launch: occupancy query reports %d blocks per CU\n", per_cu);
        (void)hipGetLastError();
        grid = cus;
    }
    if (grid < 0) return;
    if (hipMemsetAsync((char*)d_ws + WS_CTL, 0, CTL_ZERO_BYTES, stream) != hipSuccess) return;
    Args a{};
    for (int i = 0; i < 20; ++i) a.in[i] = (const float*)d_in[i];
    a.out = (float*)d_out; a.ws = (unsigned char*)d_ws;
#if MK_PER_PHASE
    for (int ph = 0; ph < NPHASE; ++ph) { a.ph_lo = ph; a.ph_hi = ph + 1; hipLaunchKernelGGL(fwd, dim3(grid), dim3(NTHR), LDS_BYTES, stream, a); }
#else
    a.ph_lo = 0; a.ph_hi = NPHASE; hipLaunchKernelGGL(fwd, dim3(grid), dim3(NTHR), LDS_BYTES, stream, a);
#endif
}
```

```cpp
#include <hip/hip_runtime.h>
#include <cstdio>
#include <cstdint>
#define MK_PER_PHASE 0
namespace pg8 {
#define PG8_LAS __attribute__((address_space(3)))
#define PG8_GAS __attribute__((address_space(1)))
typedef unsigned short bf16_t;
typedef short bf16x8 __attribute__((ext_vector_type(8)));
typedef float f32x4 __attribute__((ext_vector_type(4)));
typedef unsigned u32x4 __attribute__((ext_vector_type(4)));
constexpr int BM = 256, BK = 64, HALF = 128, HTB = HALF * BK * 2  , STAGE_BYTES = 8 * HTB, NXCD = 8, WGM = 8;

__host__ __device__ __forceinline__ int lds_byte(int r, int c) { const int st = (r >> 4) * 2 + (c >> 5), rr = r & 15, cc = c & 31, ob = rr * 64 + cc * 2; return st * 1024 + (ob ^ (((ob >> 9) & 1) << 5)); }
__host__ __device__ __forceinline__ void stage_rc(int b, int& R, int& C) { const int st = b / 1024, sb = b % 1024, swz = sb ^ (((sb >> 9) & 1) << 5); R = (st >> 1) * 16 + swz / 64; C = (st & 1) * 32 + (swz % 64) / 2; }
__host__ __device__ __forceinline__ int perm32(int rho) { const int n = rho >> 4, i = rho & 15; return 8 * (i >> 2) + 4 * n + (i & 3); }

struct Unit { int pm, pn; };
struct Gemm { const PG8_GAS bf16_t* A; const PG8_GAS bf16_t* Bt; int M, N, K; };

struct StaticOrder {
    int nM, nN, nwg, G, c;
    __host__ __device__ void init(int M, int N, int G_, int c_) { nM = M / BM; nN = N / BM; nwg = nM * nN; G = G_; c = c_; }
    __host__ __device__ bool next(int i, Unit& u) const {
        const long L = (long)i * G + c; if (L >= nwg) return false;
        int wgid = (int)L; { const int q = nwg / NXCD, r = nwg % NXCD, xcd = wgid % NXCD, off = wgid / NXCD; wgid = (xcd < r ? xcd * (q + 1) : r * (q + 1) + (xcd - r) * q) + off; }
        const int nig = WGM * nN, gid = wgid / nig, fm = gid * WGM, gsz = (nM - fm) < WGM ? (nM - fm) : WGM;
        u.pm = fm + ((wgid % nig) % gsz); u.pn = (wgid % nig) / gsz; return true;
    }
    __device__ __forceinline__ void a_ready(const Unit&) const {}
    __device__ __forceinline__ void done(const Unit&) const {}
};

__device__ __forceinline__ unsigned cvt_pk_bf16(float lo, float hi) { unsigned r; asm volatile("v_cvt_pk_bf16_f32 %0, %1, %2" : "=v"(r) : "v"(lo), "v"(hi)); return r; }
typedef float f32x2 __attribute__((ext_vector_type(2)));
__device__ __forceinline__ f32x2 gelu_pk(f32x2 v) {
    const f32x2 av = __builtin_elementwise_abs(v), d = av * 0.2316418882f + 1.0f;
    f32x2 t; t.x = __builtin_amdgcn_rcpf(d.x); t.y = __builtin_amdgcn_rcpf(d.y);
    f32x2 q = t * 0.5307027145f + (-0.7265760135f); q = q * t + 0.7107068705f; q = q * t + (-0.142248368f); q = q * t + 0.127414796f; q = q * t;
    const f32x2 s = (v * v) * (-0.72134752044f);
    f32x2 e; e.x = __builtin_amdgcn_exp2f(s.x); e.y = __builtin_amdgcn_exp2f(s.y);
    const f32x2 m = v * (q * e), r = v - m;
    f32x2 o; o.x = v.x < 0.f ? m.x : r.x; o.y = v.y < 0.f ? m.y : r.y; return o;
}

template <int ACT  > struct EpiBf16 {
    static constexpr bool PERM = true, AFTER_DRAIN = false; static_assert(ACT == 0 || ACT == 1, "EpiBf16: ACT is 0 (none) or 1 (gelu_pk)");
    PG8_GAS bf16_t* O; int ldc; const PG8_GAS float* bias; int split_cols; size_t split_stride; float scale0;
    __device__ __forceinline__ void operator()(const f32x4 (&acc)[2][2][4][2], const Unit& u, int wr, int wc, int fr, int fq) const {
        const int row0 = u.pm * BM + wr * 64 + fr; int colt = u.pn * BM; PG8_GAS bf16_t* base = O;
        float sc = 1.f; if (split_cols) { const int t = colt / split_cols; base += (size_t)t * split_stride; colt -= t * split_cols; if (t == 0) sc = scale0; }
        const int col0 = colt + wc * 32 + 8 * fq, bcol0 = u.pn * BM + wc * 32 + 8 * fq;
        f32x4 bv[2][2];
#pragma unroll
        for (int bj = 0; bj < 2; ++bj)
#pragma unroll
            for (int n = 0; n < 2; ++n) bv[bj][n] = bias ? *(const PG8_GAS f32x4*)(bias + bcol0 + bj * HALF + 4 * n) : (f32x4){0.f, 0.f, 0.f, 0.f};
#pragma unroll
        for (int ai = 0; ai < 2; ++ai)
#pragma unroll
            for (int m = 0; m < 4; ++m) { PG8_GAS bf16_t* rowp = base + (size_t)(row0 + ai * HALF + m * 16) * ldc + col0;
#pragma unroll
                for (int bj = 0; bj < 2; ++bj) { f32x4 v0 = acc[ai][bj][m][0] + bv[bj][0], v1 = acc[ai][bj][m][1] + bv[bj][1];
                    if (ACT == 1) { f32x2 a = gelu_pk((f32x2){v0[0], v0[1]}), b = gelu_pk((f32x2){v0[2], v0[3]}), c = gelu_pk((f32x2){v1[0], v1[1]}), d = gelu_pk((f32x2){v1[2], v1[3]});
                        v0 = (f32x4){a.x, a.y, b.x, b.y}; v1 = (f32x4){c.x, c.y, d.x, d.y}; }
                    v0 = v0 * sc; v1 = v1 * sc; u32x4 w; w.x = cvt_pk_bf16(v0[0], v0[1]); w.y = cvt_pk_bf16(v0[2], v0[3]); w.z = cvt_pk_bf16(v1[0], v1[1]); w.w = cvt_pk_bf16(v1[2], v1[3]);
                    *(PG8_GAS u32x4*)(rowp + bj * HALF) = w; } }
    }
};

struct EpiF32 {
    static constexpr bool PERM = false, AFTER_DRAIN = false;
    PG8_GAS float* C; int ldc;
    __device__ __forceinline__ void operator()(const f32x4 (&acc)[2][2][4][2], const Unit& u, int wr, int wc, int fr, int fq) const {
        const int row0 = u.pm * BM + wr * 64 + fr, col0 = u.pn * BM + wc * 32 + 4 * fq;
#pragma unroll
        for (int ai = 0; ai < 2; ++ai)
#pragma unroll
            for (int m = 0; m < 4; ++m) { PG8_GAS float* rowp = C + (size_t)(row0 + ai * HALF + m * 16) * ldc + col0;
#pragma unroll
                for (int bj = 0; bj < 2; ++bj)
#pragma unroll
                    for (int n = 0; n < 2; ++n) *(PG8_GAS f32x4*)(rowp + bj * HALF + n * 16) = acc[ai][bj][m][n]; }
    }
};
__device__ __forceinline__ float bf_lo(unsigned w) { return __uint_as_float(w << 16); }
__device__ __forceinline__ float bf_hi(unsigned w) { return __uint_as_float(w & 0xffff0000u); }
__device__ __forceinline__ float sigmoidf_(float x) { return __builtin_amdgcn_rcpf(1.0f + __expf(-x)); }
struct EpiIn {
    static constexpr bool PERM = true, AFTER_DRAIN = false;
    PG8_GAS bf16_t* P; int ldp; PG8_GAS float* SM; const PG8_GAS float* bgate; int gate_tile0, small_tile; PG8_GAS bf16_t* KIB;
    __device__ __forceinline__ void operator()(const f32x4 (&acc)[2][2][4][2], const Unit& u, int wr, int wc, int fr, int fq) const {
        const int row0 = u.pm * BM + wr * 64 + fr, colt = u.pn * BM + wc * 32 + 8 * fq;
        if (u.pn < small_tile) {
            const bool gate = u.pn >= gate_tile0;
            f32x4 bv[2][2];
#pragma unroll
            for (int bj = 0; bj < 2; ++bj)
#pragma unroll
                for (int n = 0; n < 2; ++n) bv[bj][n] = gate ? *(const PG8_GAS f32x4*)(bgate + (colt - gate_tile0 * BM) + bj * HALF + 4 * n) : (f32x4){0.f, 0.f, 0.f, 0.f};
#pragma unroll
            for (int ai = 0; ai < 2; ++ai)
#pragma unroll
                for (int m = 0; m < 4; ++m) { PG8_GAS bf16_t* rowp = P + (size_t)(row0 + ai * HALF + m * 16) * ldp + colt;
#pragma unroll
                    for (int bj = 0; bj < 2; ++bj) { f32x4 v0 = acc[ai][bj][m][0] + bv[bj][0], v1 = acc[ai][bj][m][1] + bv[bj][1];
                        if (gate) {
#pragma unroll
                            for (int j = 0; j < 4; ++j) { v0[j] = sigmoidf_(v0[j]); v1[j] = sigmoidf_(v1[j]); } }
                        u32x4 w; w.x = cvt_pk_bf16(v0[0], v0[1]); w.y = cvt_pk_bf16(v0[2], v0[3]); w.z = cvt_pk_bf16(v1[0], v1[1]); w.w = cvt_pk_bf16(v1[2], v1[3]);
                        *(PG8_GAS u32x4*)(rowp + bj * HALF) = w; } }
        } else {
            const int c0 = wc * 32 + 8 * fq;
#pragma unroll
            for (int ai = 0; ai < 2; ++ai)
#pragma unroll
                for (int m = 0; m < 4; ++m) { PG8_GAS float* rowp = SM + (size_t)(row0 + ai * HALF + m * 16) * BM + c0;
#pragma unroll
                    for (int bj = 0; bj < 2; ++bj) { *(PG8_GAS f32x4*)(rowp + bj * HALF) = acc[ai][bj][m][0]; *(PG8_GAS f32x4*)(rowp + bj * HALF + 4) = acc[ai][bj][m][1]; }
                    if (wc >= 2) { const f32x4 v0 = acc[ai][0][m][0], v1 = acc[ai][0][m][1];
                        u32x4 w; w.x = cvt_pk_bf16(v0[0], v0[1]); w.y = cvt_pk_bf16(v0[2], v0[3]); w.z = cvt_pk_bf16(v1[0], v1[1]); w.w = cvt_pk_bf16(v1[2], v1[3]);
                        *(PG8_GAS u32x4*)(KIB + (size_t)(row0 + ai * HALF + m * 16) * 64 + (c0 - 64)) = w; } }
        }
    }
};
struct EpiGateMul {
    static constexpr bool PERM = true, AFTER_DRAIN = false;
    PG8_GAS float* MG; int ldc; const PG8_GAS bf16_t* G; int ldg;
    __device__ __forceinline__ void operator()(const f32x4 (&acc)[2][2][4][2], const Unit& u, int wr, int wc, int fr, int fq) const {
        const int row0 = u.pm * BM + wr * 64 + fr, colt = u.pn * BM + wc * 32 + 8 * fq;
#pragma unroll
        for (int ai = 0; ai < 2; ++ai)
#pragma unroll
            for (int m = 0; m < 4; ++m) { const size_t row = (size_t)(row0 + ai * HALF + m * 16);
#pragma unroll
                for (int bj = 0; bj < 2; ++bj) { const u32x4 g = *(const PG8_GAS u32x4*)(G + row * ldg + colt + bj * HALF);
                    f32x4 v0 = acc[ai][bj][m][0], v1 = acc[ai][bj][m][1];
                    v0[0] *= bf_lo(g.x); v0[1] *= bf_hi(g.x); v0[2] *= bf_lo(g.y); v0[3] *= bf_hi(g.y);
                    v1[0] *= bf_lo(g.z); v1[1] *= bf_hi(g.z); v1[2] *= bf_lo(g.w); v1[3] *= bf_hi(g.w);
                    PG8_GAS float* o = MG + row * ldc + colt + bj * HALF; *(PG8_GAS f32x4*)o = v0; *(PG8_GAS f32x4*)(o + 4) = v1; } }
    }
};
struct EpiGateAdd {
    static constexpr bool PERM = true, AFTER_DRAIN = false;
    const PG8_GAS float* MG; PG8_GAS bf16_t* O; int ldc; const PG8_GAS bf16_t* G; int ldg;
    __device__ __forceinline__ void operator()(const f32x4 (&acc)[2][2][4][2], const Unit& u, int wr, int wc, int fr, int fq) const {
        const int row0 = u.pm * BM + wr * 64 + fr, colt = u.pn * BM + wc * 32 + 8 * fq;
#pragma unroll
        for (int ai = 0; ai < 2; ++ai)
#pragma unroll
            for (int m = 0; m < 4; ++m) { const size_t row = (size_t)(row0 + ai * HALF + m * 16);
#pragma unroll
                for (int bj = 0; bj < 2; ++bj) { const u32x4 g = *(const PG8_GAS u32x4*)(G + row * ldg + colt + bj * HALF);
                    const PG8_GAS float* mi = MG + row * ldc + colt + bj * HALF; f32x4 v0 = *(const PG8_GAS f32x4*)mi, v1 = *(const PG8_GAS f32x4*)(mi + 4);
                    const f32x4 a0 = acc[ai][bj][m][0], a1 = acc[ai][bj][m][1];
                    v0[0] += a0[0] * bf_lo(g.x); v0[1] += a0[1] * bf_hi(g.x); v0[2] += a0[2] * bf_lo(g.y); v0[3] += a0[3] * bf_hi(g.y);
                    v1[0] += a1[0] * bf_lo(g.z); v1[1] += a1[1] * bf_hi(g.z); v1[2] += a1[2] * bf_lo(g.w); v1[3] += a1[3] * bf_hi(g.w);
                    u32x4 w; w.x = cvt_pk_bf16(v0[0], v0[1]); w.y = cvt_pk_bf16(v0[2], v0[3]); w.z = cvt_pk_bf16(v1[0], v1[1]); w.w = cvt_pk_bf16(v1[2], v1[3]);
                    *(PG8_GAS u32x4*)(O + row * ldc + colt + bj * HALF) = w; } }
    }
};
template <class Epi, class Sched, bool ALIGN_EPI = false, bool SP2 = false>
__device__ __forceinline__ void gemm_phase(PG8_LAS unsigned char* lds, const Gemm g, const Sched& S, const Epi& E) {
    int tid = threadIdx.x; asm volatile("" : "+v"(tid));
    const int wid = __builtin_amdgcn_readfirstlane(tid >> 6), lane = tid & 63, wr = wid >> 2, wc = wid & 3, fr = lane & 15, fq = lane >> 4;
    const int K = g.K, nt = K / BK;
    unsigned voffA[2], voffB[2];
#pragma unroll
    for (int i = 0; i < 2; ++i) { int R, C; stage_rc(tid * 16 + i * 8192, R, C); const int Rb = Epi::PERM ? ((R & ~31) + perm32(R & 31)) : R;
        voffA[i] = (unsigned)(R * K + C) * 2u; voffB[i] = (unsigned)(Rb * K + C) * 2u; }
    const size_t kstep = (size_t)(BK * 2);
    const size_t hstep = (size_t)HALF * K * 2;
    const size_t tstep = 2 * hstep;
    const unsigned ldsw = (unsigned)wid * 1024u;
    const int aoff = lds_byte(wr * 64 + fr, fq * 8), boff = lds_byte(wc * 32 + fr, fq * 8);
#define PG8_SA(b, h) (((b) * 2 + (h)) * HTB)
#define PG8_SB(b, h) ((4 + (b) * 2 + (h)) * HTB)
#define PG8_STAGE(bufoff, gbase, voff) do { _Pragma("unroll") for (int _i = 0; _i < 2; ++_i) \
        __builtin_amdgcn_global_load_lds((const PG8_GAS unsigned*)((const PG8_GAS char*)(gbase) + (voff)[_i]), (PG8_LAS unsigned*)(lds + (bufoff) + ldsw + _i * 8192), 16, 0, 0); } while (0)
#define PG8_LDA(dst, b, h) do { _Pragma("unroll") for (int m = 0; m < 4; ++m) _Pragma("unroll") for (int k = 0; k < 2; ++k) dst[m][k] = *(const PG8_LAS bf16x8*)(lds + PG8_SA(b, h) + aoff + m * 2048 + k * 1024); } while (0)
#define PG8_LDB(dst, b, h) do { _Pragma("unroll") for (int n = 0; n < 2; ++n) _Pragma("unroll") for (int k = 0; k < 2; ++k) dst[n][k] = *(const PG8_LAS bf16x8*)(lds + PG8_SB(b, h) + boff + n * 2048 + k * 1024); } while (0)
#define PG8_MMA(ai, bj, At, Bt) do { __builtin_amdgcn_s_setprio(1); _Pragma("unroll") for (int m = 0; m < 4; ++m) _Pragma("unroll") for (int n = 0; n < 2; ++n) _Pragma("unroll") for (int k = 0; k < 2; ++k) \
        acc[ai][bj][m][n] = __builtin_amdgcn_mfma_f32_16x16x32_bf16(Bt[n][k], At[m][k], acc[ai][bj][m][n], 0, 0, 0); __builtin_amdgcn_s_setprio(0); } while (0)
#define PG8_WAIT_V(n) asm volatile("s_waitcnt vmcnt(" #n ")" ::: "memory")
#define PG8_WAIT_L(n) asm volatile("s_waitcnt lgkmcnt(" #n ")" ::: "memory")
#define PG8_BAR __builtin_amdgcn_s_barrier()
#define PG8_SCHED __builtin_amdgcn_sched_barrier(0)
    Unit cur, nxt; int ui = 0;
    if (!S.next(0, cur)) return;
    f32x4 acc[2][2][4][2];
#pragma unroll
    for (int a = 0; a < 2; ++a)
#pragma unroll
        for (int b = 0; b < 2; ++b)
#pragma unroll
            for (int m = 0; m < 4; ++m)
#pragma unroll
                for (int n = 0; n < 2; ++n) acc[a][b][m][n] = (f32x4){0.f, 0.f, 0.f, 0.f};
    bf16x8 At[4][2], B0[2][2], B1[2][2];
    const PG8_GAS char* cA = (const PG8_GAS char*)g.A + (size_t)cur.pm * tstep; const PG8_GAS char* cB = (const PG8_GAS char*)g.Bt + (size_t)cur.pn * tstep;
    S.a_ready(cur);
    if constexpr (SP2) {
        PG8_STAGE(PG8_SB(0, 0), cB, voffB); PG8_STAGE(PG8_SB(0, 1), cB + hstep, voffB); PG8_STAGE(PG8_SA(0, 0), cA, voffA); PG8_STAGE(PG8_SA(0, 1), cA + hstep, voffA);
        if (wr == 1) PG8_BAR;
        PG8_WAIT_V(2); PG8_BAR;
        PG8_STAGE(PG8_SB(1, 0), cB + kstep, voffB); PG8_STAGE(PG8_SA(1, 0), cA + kstep, voffA); PG8_STAGE(PG8_SB(1, 1), cB + hstep + kstep, voffB);
        PG8_WAIT_V(6); PG8_BAR;
    } else {
        PG8_STAGE(PG8_SB(0, 0), cB, voffB); PG8_STAGE(PG8_SA(0, 0), cA, voffA); PG8_STAGE(PG8_SB(0, 1), cB + hstep, voffB); PG8_STAGE(PG8_SA(0, 1), cA + hstep, voffA);
        if (wr == 1) PG8_BAR;
        PG8_WAIT_V(4); PG8_BAR;
        PG8_STAGE(PG8_SB(1, 0), cB + kstep, voffB); PG8_STAGE(PG8_SA(1, 0), cA + kstep, voffA); PG8_STAGE(PG8_SB(1, 1), cB + hstep + kstep, voffB);
        PG8_WAIT_V(6); PG8_BAR;
    }
    for (;;) {
        const bool has_next = S.next(ui + 1, nxt);
        const PG8_GAS char* nA = has_next ? (const PG8_GAS char*)g.A + (size_t)nxt.pm * tstep : cA; const PG8_GAS char* nB = has_next ? (const PG8_GAS char*)g.Bt + (size_t)nxt.pn * tstep : cB;
        for (int t = 0; t < nt; t += 2) {
            const bool last = (t == nt - 2);
            const PG8_GAS char* a1 = cA + (size_t)(t + 1) * kstep;
            const PG8_GAS char* a2 = last ? nA : cA + (size_t)(t + 2) * kstep; const PG8_GAS char* b2 = last ? nB : cB + (size_t)(t + 2) * kstep;
            const PG8_GAS char* a3 = a2 + kstep; const PG8_GAS char* b3 = b2 + kstep;
            if (last && has_next) S.a_ready(nxt);
            if constexpr (SP2) {
            PG8_LDB(B0, 0, 0); PG8_LDB(B1, 0, 1); PG8_SCHED; PG8_LDA(At, 0, 0); PG8_STAGE(PG8_SA(1, 1), a1 + hstep, voffA);
            PG8_WAIT_V(8); PG8_WAIT_L(0); PG8_BAR; PG8_MMA(0, 0, At, B0); PG8_MMA(0, 1, At, B1); PG8_BAR; PG8_SCHED;
            PG8_LDA(At, 0, 1); PG8_STAGE(PG8_SB(0, 0), b2, voffB); PG8_STAGE(PG8_SB(0, 1), b2 + hstep, voffB); PG8_STAGE(PG8_SA(0, 0), a2, voffA);
            PG8_WAIT_V(8); PG8_WAIT_L(0); PG8_BAR; PG8_MMA(1, 0, At, B0); PG8_MMA(1, 1, At, B1); PG8_BAR; PG8_SCHED;
            PG8_LDB(B0, 1, 0); PG8_LDB(B1, 1, 1); PG8_SCHED; PG8_LDA(At, 1, 0); PG8_STAGE(PG8_SA(0, 1), a2 + hstep, voffA);
            PG8_WAIT_V(8); PG8_WAIT_L(0); PG8_BAR; PG8_MMA(0, 0, At, B0); PG8_MMA(0, 1, At, B1); PG8_BAR; PG8_SCHED;
            PG8_LDA(At, 1, 1); PG8_STAGE(PG8_SB(1, 0), b3, voffB); PG8_STAGE(PG8_SB(1, 1), b3 + hstep, voffB); PG8_STAGE(PG8_SA(1, 0), a3, voffA);
            PG8_WAIT_V(8); PG8_WAIT_L(0); PG8_BAR; PG8_MMA(1, 0, At, B0); PG8_MMA(1, 1, At, B1); PG8_BAR; PG8_SCHED;
            } else {
            PG8_LDB(B0, 0, 0); PG8_SCHED; PG8_LDA(At, 0, 0); PG8_STAGE(PG8_SA(1, 1), a1 + hstep, voffA);
            PG8_WAIT_L(8); PG8_BAR; PG8_WAIT_L(0); PG8_MMA(0, 0, At, B0); PG8_BAR; PG8_SCHED;
            PG8_LDB(B1, 0, 1); PG8_STAGE(PG8_SB(0, 0), b2, voffB);
            PG8_BAR; PG8_WAIT_L(0); PG8_MMA(0, 1, At, B1); PG8_BAR;
            PG8_LDA(At, 0, 1); PG8_STAGE(PG8_SA(0, 0), a2, voffA);
            PG8_BAR; PG8_WAIT_L(0); PG8_MMA(1, 0, At, B0); PG8_BAR; PG8_SCHED;
            PG8_STAGE(PG8_SB(0, 1), b2 + hstep, voffB);
            PG8_WAIT_V(6); PG8_BAR; PG8_MMA(1, 1, At, B1); PG8_BAR;
            PG8_LDB(B0, 1, 0); PG8_SCHED; PG8_LDA(At, 1, 0); PG8_STAGE(PG8_SA(0, 1), a2 + hstep, voffA);
            PG8_WAIT_L(8); PG8_BAR; PG8_WAIT_L(0); PG8_MMA(0, 0, At, B0); PG8_BAR; PG8_SCHED;
            PG8_LDB(B1, 1, 1); PG8_STAGE(PG8_SB(1, 0), b3, voffB);
            PG8_BAR; PG8_WAIT_L(0); PG8_MMA(0, 1, At, B1); PG8_BAR;
            PG8_LDA(At, 1, 1); PG8_STAGE(PG8_SA(1, 0), a3, voffA);
            PG8_BAR; PG8_WAIT_L(0); PG8_MMA(1, 0, At, B0); PG8_BAR; PG8_SCHED;
            PG8_STAGE(PG8_SB(1, 1), b3 + hstep, voffB);
            PG8_WAIT_V(6); PG8_BAR; PG8_MMA(1, 1, At, B1); PG8_BAR;
            }
        }
        if constexpr (ALIGN_EPI) { if (wr == 0) PG8_BAR; }
        if constexpr (!Epi::AFTER_DRAIN) { E(acc, cur, wr, wc, fr, fq); S.done(cur); }
        if (!has_next) break;
#pragma unroll
        for (int a = 0; a < 2; ++a)
#pragma unroll
            for (int b = 0; b < 2; ++b)
#pragma unroll
                for (int m = 0; m < 4; ++m)
#pragma unroll
                    for (int n = 0; n < 2; ++n) acc[a][b][m][n] = (f32x4){0.f, 0.f, 0.f, 0.f};
        cur = nxt; cA = nA; cB = nB; ++ui;
        if constexpr (ALIGN_EPI) { if (wr == 1) PG8_BAR; }
    }
    PG8_WAIT_V(0);
    if constexpr (!ALIGN_EPI) { if (wr == 0) PG8_BAR; }
    PG8_BAR;
    if constexpr (Epi::AFTER_DRAIN) { E.fused(acc, cur, wr, wc, fr, fq, lds, wid, lane); S.done(cur); }
#undef PG8_SA
#undef PG8_SB
#undef PG8_STAGE
#undef PG8_LDA
#undef PG8_LDB
#undef PG8_MMA
#undef PG8_WAIT_V
#undef PG8_WAIT_L
#undef PG8_BAR
#undef PG8_SCHED
}
}

#ifndef MK_PER_PHASE
#define MK_PER_PHASE 0
#endif
#ifndef PROBE_DOUBLE
#define PROBE_DOUBLE -1
#endif
#define REP(id) for (int rep_ = 0; rep_ < ((PROBE_DOUBLE == (id)) ? 2 : 1); ++rep_)
constexpr int NWAVES = 8, NTHR = 512;
constexpr int BATCH = 2, SEQ = 4096, M = BATCH * SEQ, D = 2048, DEPTH = 4;
constexpr int DI = 4096, NH = 64, HP = 64, NG = 8, HPG = 8, NS = 128, CONVD = 6144;
constexpr int QH = 16, KVH = 4, AD = 128, IH = 16, IDD = 64, TOPK = 256;
constexpr int FF = 4096, FF2 = 8192;
constexpr int NIN = 18576, NMAIN = 18432, NPAD = 18688;
constexpr int PZ = 0, PXBC = 4096, PQ = 10240, PK = 12288, PV = 12800, PQI = 13312, PG = 14336;
constexpr int SMW = 256, SM_DT = 0, SM_KI = 64, SM_WI = 128;
constexpr float EPS = 1e-6f;
constexpr float ATTN_SCALE = 0.08838834764831845f;

constexpr size_t MiB = 1u << 20;
constexpr size_t WS_CTL = 0, CTL_ZERO_BYTES = 1 * MiB;
constexpr size_t WS_W = 2 * MiB;
constexpr size_t WL_IN = 0, WL_SSM = 73 * MiB, WL_ATT = 89 * MiB, WL_MIX = 97 * MiB, WL_UP = 105 * MiB, WL_DN = 137 * MiB, WL_SIZE = 153 * MiB;
constexpr size_t WS_H = WS_W + DEPTH * WL_SIZE;
constexpr size_t WS_P = WS_H + 32 * MiB;
constexpr size_t WS_SM = WS_P + 288 * MiB;
constexpr size_t WS_XC = WS_SM + 8 * MiB;
constexpr size_t WS_DT = WS_XC + 96 * MiB;
constexpr size_t WS_ACS = WS_DT + 2 * MiB;
constexpr size_t WS_ST = WS_ACS + 2 * MiB;
constexpr size_t WS_Y = WS_ST + 256 * MiB;
constexpr size_t WS_SC = WS_Y + 64 * MiB;
constexpr size_t WS_IDX = WS_SC + 128 * MiB;
constexpr size_t WS_CNT = WS_IDX + 8 * MiB;
constexpr size_t WS_AO = WS_CNT + 1 * MiB;
constexpr size_t WS_MG = WS_AO + 32 * MiB;
constexpr size_t WS_MGB = WS_MG + 64 * MiB;
constexpr size_t WS_YM = WS_MGB + 32 * MiB;
constexpr size_t WS_U = WS_YM + 64 * MiB;
constexpr size_t WS_ACT = WS_U + 128 * MiB;
constexpr size_t WS_KIB = WS_ACT + 64 * MiB;
constexpr size_t WS_END = WS_KIB + 1 * MiB;
constexpr int CW_BAR = 4096;

constexpr int RING_BYTES = 131072, LDSCTL_OFF = RING_BYTES, MISC_OFF = LDSCTL_OFF + 320, LDS_BYTES = 147456;

#define LAS __attribute__((address_space(3)))
#define GAS __attribute__((address_space(1)))
typedef unsigned short bf16;
typedef float f32x4 __attribute__((ext_vector_type(4)));
typedef short bf16x8 __attribute__((ext_vector_type(8)));
typedef unsigned u32x4 __attribute__((ext_vector_type(4)));
typedef unsigned u32x2 __attribute__((ext_vector_type(2)));
#define LDS_WAIT() asm volatile("s_waitcnt lgkmcnt(0)" ::: "memory")

__device__ __forceinline__ unsigned f2bf(float f) { unsigned u = __builtin_bit_cast(unsigned, f); return (u + 0x7fffu + ((u >> 16) & 1u)) >> 16; }
__device__ __forceinline__ unsigned pk2(float lo, float hi) { return f2bf(lo) | (f2bf(hi) << 16); }
__device__ __forceinline__ float bflo(unsigned w) { return __uint_as_float(w << 16); }
__device__ __forceinline__ float bfhi(unsigned w) { return __uint_as_float(w & 0xffff0000u); }
__device__ __forceinline__ void unpack8(const u32x4 w, float (&f)[8]) { f[0] = bflo(w.x); f[1] = bfhi(w.x); f[2] = bflo(w.y); f[3] = bfhi(w.y); f[4] = bflo(w.z); f[5] = bfhi(w.z); f[6] = bflo(w.w); f[7] = bfhi(w.w); }
__device__ __forceinline__ u32x4 pack8(const float (&f)[8]) { u32x4 w; w.x = pk2(f[0], f[1]); w.y = pk2(f[2], f[3]); w.z = pk2(f[4], f[5]); w.w = pk2(f[6], f[7]); return w; }
__device__ __forceinline__ float wave_sum(float v) {
#pragma unroll
    for (int o = 1; o < 64; o <<= 1) v += __shfl_xor(v, o);
    return v;
}
__device__ __forceinline__ float wave_max(float v) {
#pragma unroll
    for (int o = 1; o < 64; o <<= 1) v = fmaxf(v, __shfl_xor(v, o));
    return v;
}
__device__ __forceinline__ float siluf_(float x) { return x / (1.0f + __expf(-x)); }

#define XB_TMO      128
#define XB_XCNT(j)  (256  + 64 * (j))
#define XB_XSUB(j)  (1280 + 64 * (j))
#define XB_XGEN(j)  (2304 + 64 * (j))
#define XB_TOP      3328
#define XB_TOPGEN   3392
#define XCD_BAR_WORDS 3456
#define XB_SPIN_CAP (1u << 18)

__device__ __forceinline__ unsigned xb_ld(unsigned* p)              { return __hip_atomic_load(p, __ATOMIC_RELAXED, __HIP_MEMORY_SCOPE_AGENT); }
__device__ __forceinline__ unsigned xb_add(unsigned* p, unsigned v) { return __hip_atomic_fetch_add(p, v, __ATOMIC_RELAXED, __HIP_MEMORY_SCOPE_AGENT); }
__device__ __forceinline__ unsigned xb_xcc_id() { return (unsigned)__builtin_amdgcn_s_getreg((3 << 11) | 20) & 0xFu; }
#define XB_SPIN(cond, bar) do { unsigned _sp = 0; while (cond) { __builtin_amdgcn_s_sleep(1); \
    if ((++_sp & 255u) == 0u) { if (xb_ld(&(bar)[XB_TMO])) break; if (_sp > XB_SPIN_CAP) { atomicAdd(&(bar)[XB_TMO], 1u); break; } } } } while (0)

struct XcdBarrier {
    unsigned* bar; unsigned x;
    volatile LAS unsigned* st;
};

__device__ __forceinline__ XcdBarrier xcd_barrier_post(unsigned* bar, volatile LAS unsigned* st) {
    XcdBarrier b; b.bar = bar; b.x = xb_xcc_id(); b.st = st;
    if (threadIdx.x == 0) (void)xb_add(&bar[XB_XCNT(b.x)], 1u);
    return b;
}
__device__ __forceinline__ void xcd_barrier_complete(unsigned* bar, unsigned x, unsigned& nloc, unsigned& nx) {
    const unsigned G = gridDim.x * gridDim.y * gridDim.z;
    unsigned sum, cnt, mine, sp = 0u;
    for (;;) {
        sum = 0u; cnt = 0u; mine = 0u;
#pragma unroll
        for (unsigned j = 0; j < 16; ++j) { const unsigned c = xb_ld(&bar[XB_XCNT(j)]); sum += c; cnt += (c > 0u) ? 1u : 0u; mine = (j == x) ? c : mine; }
        if (sum == G) break;
        __builtin_amdgcn_s_sleep(1);
        if ((++sp & 255u) == 0u) { if (xb_ld(&bar[XB_TMO])) break; if (sp > XB_SPIN_CAP) { atomicAdd(&bar[XB_TMO], 1u); break; } }
    }
    nloc = mine > 0u ? mine : 1u; nx = cnt > 0u ? cnt : 1u;
}

__device__ __forceinline__ void xcd_barrier(const XcdBarrier& b) {
    asm volatile("s_waitcnt vmcnt(0)" ::: "memory");
    __syncthreads();
    if (threadIdx.x == 0) {
        unsigned* bar = b.bar;
        __builtin_amdgcn_s_waitcnt(0);
        unsigned nloc = b.st[0], nx = b.st[1];
        if (nloc == 0u) { xcd_barrier_complete(bar, b.x, nloc, nx); b.st[0] = nloc; b.st[1] = nx; }
        const unsigned old = xb_add(&bar[XB_XSUB(b.x)], 1u);
        const unsigned gen = old / nloc;
        if (old + 1u == (gen + 1u) * nloc) {
            __builtin_amdgcn_fence(__ATOMIC_RELEASE, "agent");
            asm volatile("s_waitcnt vmcnt(0)" ::: "memory");
            const unsigned og = xb_add(&bar[XB_TOP], 1u);
            const unsigned tg = og / nx;
            if (og + 1u == (tg + 1u) * nx) xb_add(&bar[XB_TOPGEN], 1u);
            else XB_SPIN(xb_ld(&bar[XB_TOPGEN]) == tg, bar);
            __builtin_amdgcn_fence(__ATOMIC_ACQUIRE, "agent");
            xb_add(&bar[XB_XGEN(b.x)], 1u);
            asm volatile("s_waitcnt vmcnt(0)" ::: "memory");
        } else {
            XB_SPIN(xb_ld(&bar[XB_XGEN(b.x)]) == gen, bar);
            __builtin_amdgcn_fence(__ATOMIC_ACQUIRE, "agent");
            asm volatile("s_waitcnt vmcnt(0)" ::: "memory");
        }
    }
    __syncthreads();
}


__device__ __forceinline__ void ph_resid_norm(const GAS float* Yin, const GAS float* gpost, const GAS float* gnext, const GAS float* Xin, GAS float* X, GAS bf16* H, int gw, int ngw, int lane) {
    for (int m = gw; m < M; m += ngw) {
        const GAS f32x4* xr = (const GAS f32x4*)(Xin + (size_t)m * D) + lane;
        f32x4 xv[8];
#pragma unroll
        for (int j = 0; j < 8; ++j) xv[j] = xr[64 * j];
        if (Yin) {
            const GAS f32x4* yr = (const GAS f32x4*)(Yin + (size_t)m * D) + lane; f32x4 yv[8]; float ss = 0.f;
#pragma unroll
            for (int j = 0; j < 8; ++j) { yv[j] = yr[64 * j]; ss += (yv[j].x * yv[j].x + yv[j].y * yv[j].y) + (yv[j].z * yv[j].z + yv[j].w * yv[j].w); }
            const float rstd = rsqrtf(wave_sum(ss) * (1.0f / D) + EPS);
#pragma unroll
            for (int j = 0; j < 8; ++j) { const f32x4 g = ((const GAS f32x4*)gpost + lane)[64 * j]; xv[j] = xv[j] + yv[j] * rstd * g; }
        }
        if (Yin || Xin != X) { GAS f32x4* xo = (GAS f32x4*)(X + (size_t)m * D) + lane;
#pragma unroll
            for (int j = 0; j < 8; ++j) xo[64 * j] = xv[j]; }
        if (gnext) {
            float ss = 0.f;
#pragma unroll
            for (int j = 0; j < 8; ++j) ss += (xv[j].x * xv[j].x + xv[j].y * xv[j].y) + (xv[j].z * xv[j].z + xv[j].w * xv[j].w);
            const float rstd = rsqrtf(wave_sum(ss) * (1.0f / D) + EPS);
            GAS u32x2* ho = (GAS u32x2*)(H + (size_t)m * D) + lane;
#pragma unroll
            for (int j = 0; j < 8; ++j) { const f32x4 g = ((const GAS f32x4*)gnext + lane)[64 * j]; const f32x4 h = xv[j] * rstd * g; u32x2 w; w.x = pk2(h.x, h.y); w.y = pk2(h.z, h.w); ho[64 * j] = w; }
        }
    }
}

__device__ __forceinline__ void tr_item(const GAS float* W, int ldw, int K, int k0, int nsrc, int ncols, GAS bf16* WT, int ndst, LAS float* scr, int lane) {
    const int j = lane & 31;
#pragma unroll 8
    for (int i = 0; i < 32; ++i) { const int kk = 2 * i + (lane >> 5); scr[kk * 33 + j] = (j < ncols) ? W[(size_t)(k0 + kk) * ldw + nsrc + j] : 0.f; }
    LDS_WAIT();
    const int c = lane & 7;
#pragma unroll
    for (int jj = 0; jj < 4; ++jj) { const int n = (lane >> 3) + 8 * jj; const LAS float* s = scr + (8 * c) * 33 + n;
        u32x4 o; o.x = pk2(s[0 * 33], s[1 * 33]); o.y = pk2(s[2 * 33], s[3 * 33]); o.z = pk2(s[4 * 33], s[5 * 33]); o.w = pk2(s[6 * 33], s[7 * 33]);
        *(GAS u32x4*)(WT + (size_t)(ndst + n) * K + k0 + 8 * c) = o; }
    LDS_WAIT();
}
__device__ __forceinline__ void win_map(int dstrow, int& src, int& ncols) {
    ncols = 32;
    if (dstrow < 10240) src = dstrow;
    else if (dstrow < 12288) src = dstrow - 10240 + 10304;
    else if (dstrow < 12800) src = dstrow - 12288 + 12352;
    else if (dstrow < 13312) src = dstrow - 12800 + 12864;
    else if (dstrow < 14336) src = dstrow - 13312 + 13376;
    else if (dstrow < 18432) src = dstrow - 14336 + 14480;
    else if (dstrow < 18496) src = dstrow - 18432 + 10240;
    else if (dstrow < 18560) src = dstrow - 18496 + 14400;
    else if (dstrow == 18560) { src = 14464; ncols = 16; }
    else { src = 0; ncols = 0; }
}
struct WPtrs { const GAS float *w_in, *w_ssm, *w_att, *w_mix, *w_up, *w_dn; };
__device__ __forceinline__ void ph_weights(const WPtrs wp, GAS unsigned char* ws, LAS float* scr, int gw, int ngw, int lane) {
    constexpr int I_IN = (NPAD / 32) * (D / 64), I_SSM = (D / 32) * (DI / 64), I_ATT = (D / 32) * (D / 64), I_MIX = I_ATT, I_UP = (FF2 / 32) * (D / 64), I_DN = (D / 32) * (FF / 64);
    constexpr int I_L = I_IN + I_SSM + I_ATT + I_MIX + I_UP + I_DN;
    for (int it = gw; it < DEPTH * I_L; it += ngw) {
        const int layer = it / I_L; int r = it % I_L;
        GAS unsigned char* wl = ws + WS_W + (size_t)layer * WL_SIZE;
        if (r < I_IN) { const int nblk = NPAD / 32, kb = r / nblk, nb = r % nblk; int src, nc; win_map(nb * 32, src, nc);
            tr_item(wp.w_in + (size_t)layer * D * NIN, NIN, D, kb * 64, src, nc, (GAS bf16*)(wl + WL_IN), nb * 32, scr, lane); continue; }
        r -= I_IN;
        if (r < I_SSM) { const int nblk = D / 32, kb = r / nblk, nb = r % nblk; tr_item(wp.w_ssm + (size_t)layer * DI * D, D, DI, kb * 64, nb * 32, 32, (GAS bf16*)(wl + WL_SSM), nb * 32, scr, lane); continue; }
        r -= I_SSM;
        if (r < I_ATT) { const int nblk = D / 32, kb = r / nblk, nb = r % nblk; tr_item(wp.w_att + (size_t)layer * D * D, D, D, kb * 64, nb * 32, 32, (GAS bf16*)(wl + WL_ATT), nb * 32, scr, lane); continue; }
        r -= I_ATT;
        if (r < I_MIX) { const int nblk = D / 32, kb = r / nblk, nb = r % nblk; tr_item(wp.w_mix + (size_t)layer * D * D, D, D, kb * 64, nb * 32, 32, (GAS bf16*)(wl + WL_MIX), nb * 32, scr, lane); continue; }
        r -= I_MIX;
        if (r < I_UP) { const int nblk = FF2 / 32, kb = r / nblk, nb = r % nblk; tr_item(wp.w_up + (size_t)layer * D * FF2, FF2, D, kb * 64, nb * 32, 32, (GAS bf16*)(wl + WL_UP), nb * 32, scr, lane); continue; }
        r -= I_UP;
        { const int nblk = D / 32, kb = r / nblk, nb = r % nblk; tr_item(wp.w_dn + (size_t)layer * FF * D, D, FF, kb * 64, nb * 32, 32, (GAS bf16*)(wl + WL_DN), nb * 32, scr, lane); }
    }
}

__device__ __forceinline__ void ph_index_scores(const GAS bf16* P, const GAS float* SM, const GAS bf16* KIB, GAS float* SC, int blk, int nblk, int wave, int lane) {
    for (int u0 = blk; u0 < 256; u0 += nblk) {
#pragma unroll 1
        for (int half = 0; half < 2; ++half) {
            const int b = half, qt = half ? 255 - u0 : u0;
            const int q0 = b * SEQ + qt * 16, nkt = ((qt * 16) / 64 + 1) * 4;
            const int qrow = q0 + (lane & 15), kq = 8 * (lane >> 4);
            bf16x8 bq[IH][2]; float w[IH];
#pragma unroll
            for (int h = 0; h < IH; ++h) {
#pragma unroll
                for (int ks = 0; ks < 2; ++ks) bq[h][ks] = *(const GAS bf16x8*)(P + (size_t)qrow * NMAIN + PQI + h * IDD + ks * 32 + kq);
                w[h] = SM[(size_t)qrow * SMW + SM_WI + h]; }
            for (int kt = wave; kt < nkt; kt += NWAVES) {
                const int key0 = kt * 16; const GAS bf16* kp = KIB + (size_t)(b * SEQ + key0 + (lane & 15)) * IDD + kq;
                const bf16x8 a0 = *(const GAS bf16x8*)kp, a1 = *(const GAS bf16x8*)(kp + 32);
                f32x4 sc = (f32x4){0.f, 0.f, 0.f, 0.f};
#pragma unroll
                for (int h = 0; h < IH; ++h) { f32x4 c = (f32x4){0.f, 0.f, 0.f, 0.f};
                    c = __builtin_amdgcn_mfma_f32_16x16x32_bf16(a0, bq[h][0], c, 0, 0, 0); c = __builtin_amdgcn_mfma_f32_16x16x32_bf16(a1, bq[h][1], c, 0, 0, 0);
                    sc.x += w[h] * fmaxf(c.x, 0.f); sc.y += w[h] * fmaxf(c.y, 0.f); sc.z += w[h] * fmaxf(c.z, 0.f); sc.w += w[h] * fmaxf(c.w, 0.f); }
                *(GAS f32x4*)(SC + (size_t)qrow * SEQ + key0 + 4 * (lane >> 4)) = sc;
            }
        }
    }
}

__device__ __forceinline__ void topk_bitwise(const GAS float* srow, GAS unsigned long long* mw, int limit, int lane) {
    unsigned u[64];
#pragma unroll
    for (int j = 0; j < 64; ++j) { const int key = j * 64 + lane; unsigned v = 0u;
        if (key < limit) { const unsigned bits = __float_as_uint(srow[key]); v = (bits & 0x80000000u) ? ~bits : (bits | 0x80000000u); }
        u[j] = v; }
    unsigned T = 0u;
#pragma unroll 1
    for (int bit = 31; bit >= 0; --bit) { const unsigned cand = T | (1u << bit); int cnt = 0;
#pragma unroll
        for (int j = 0; j < 64; ++j) cnt += __popcll(__ballot(u[j] >= cand));
        if (cnt >= TOPK) T = cand; }
    int cgt = 0;
#pragma unroll
    for (int j = 0; j < 64; ++j) cgt += __popcll(__ballot(u[j] > T));
    const int need_eq = TOPK - cgt; int eqbase = 0;
    const unsigned long long lt_mask = (1ull << lane) - 1ull;
#pragma unroll
    for (int j = 0; j < 64; ++j) {
        const bool gt = u[j] > T, eq = u[j] == T;
        const unsigned long long eqm = __ballot(eq);
        const bool take = gt || (eq && (eqbase + __popcll(eqm & lt_mask) < need_eq));
        const unsigned long long tm = __ballot(take);
        if (lane == 0 && j * 64 < limit) mw[j] = tm;
        eqbase += __popcll(eqm);
    }
}
__device__ __forceinline__ void ph_topk(const GAS float* SC, GAS unsigned long long* MASKW, LAS unsigned char* wl, int gw, int ngw, int lane) {
    constexpr int CAP = 1024;
    LAS unsigned* hist = (LAS unsigned*)wl;
    LAS unsigned* maskc = (LAS unsigned*)(wl + 1024);
    LAS float* cval = (LAS float*)(wl + 1536);
    LAS unsigned* ckey = (LAS unsigned*)(wl + 1536 + 4 * CAP);
    const unsigned long long lt_mask = (1ull << lane) - 1ull;
    for (int m = gw; m < M; m += ngw) {
        const int t = m & (SEQ - 1), limit = (t / 64 + 1) * 64, nw = limit / 64;
        GAS unsigned long long* mw = MASKW + (size_t)m * 64;
        if (limit <= TOPK) { unsigned ones = 0xffffffffu; asm volatile("" : "+v"(ones)); if (lane < nw) mw[lane] = ((unsigned long long)ones << 32) | ones; continue; }
        const GAS float* srow = SC + (size_t)m * SEQ;
        float s[64]; float smax = -__builtin_inff(), smin = __builtin_inff();
#pragma unroll
        for (int j = 0; j < 64; ++j) { s[j] = (j < nw) ? srow[j * 64 + lane] : 0.f; if (j < nw) { smax = fmaxf(smax, s[j]); smin = fminf(smin, s[j]); } }
        smax = wave_max(smax); smin = -wave_max(-smin);
        const float scale = smax > smin ? 255.0f / (smax - smin) : 0.f;
        asm volatile("" ::: "memory");
        hist[lane] = 0u; hist[lane + 64] = 0u; hist[lane + 128] = 0u; hist[lane + 192] = 0u; maskc[lane] = 0u; maskc[lane + 64] = 0u;
        LDS_WAIT();
#pragma unroll
        for (int j = 0; j < 64; ++j) if (j < nw) { const int b = min(255, (int)((s[j] - smin) * scale)); __hip_atomic_fetch_add(&hist[b], 1u, __ATOMIC_RELAXED, __HIP_MEMORY_SCOPE_WORKGROUP); }
        LDS_WAIT();
        const unsigned c0 = hist[4 * lane], c1 = hist[4 * lane + 1], c2 = hist[4 * lane + 2], c3 = hist[4 * lane + 3];
        unsigned suf = c0 + c1 + c2 + c3;
#pragma unroll
        for (int o = 1; o < 64; o <<= 1) { const unsigned v = __shfl_down(suf, o); if (lane + o < 64) suf += v; }
        const unsigned above = suf - (c0 + c1 + c2 + c3);
        int bstar = -1; unsigned cab = 0u;
        { unsigned cum = above;
          if (cum < TOPK && cum + c3 >= TOPK) { bstar = 4 * lane + 3; cab = cum; } cum += c3;
          if (bstar < 0 && cum < TOPK && cum + c2 >= TOPK) { bstar = 4 * lane + 2; cab = cum; } cum += c2;
          if (bstar < 0 && cum < TOPK && cum + c1 >= TOPK) { bstar = 4 * lane + 1; cab = cum; } cum += c1;
          if (bstar < 0 && cum < TOPK && cum + c0 >= TOPK) { bstar = 4 * lane + 0; cab = cum; } }
        const unsigned long long who = __ballot(bstar >= 0);
        const int src = __builtin_ctzll(who);
        bstar = __shfl(bstar, src); cab = __shfl(cab, src);
        const int need = TOPK - (int)cab;
        const unsigned ncand = hist[bstar];
        if (ncand > (unsigned)CAP) { topk_bitwise(srow, mw, limit, lane); continue; }
        unsigned long long myword = 0ull; int base = 0;
#pragma unroll
        for (int j = 0; j < 64; ++j) if (j < nw) {
            const int b = min(255, (int)((s[j] - smin) * scale));
            const unsigned long long gm = __ballot(b > bstar), em = __ballot(b == bstar);
            if (lane == j) myword = gm;
            if (b == bstar) { const int pos = base + __popcll(em & lt_mask); cval[pos] = s[j]; ckey[pos] = (unsigned)(j * 64 + lane); }
            base += __popcll(em);
        }
        LDS_WAIT();
        for (int i = lane; i < base; i += 64) { const float vi = cval[i]; const unsigned ki = ckey[i]; int rank = 0;
            if (need < base) { for (int q = 0; q < base; ++q) { const float vq = cval[q]; const unsigned kq = ckey[q]; rank += (vq > vi || (vq == vi && kq < ki)) ? 1 : 0; } }
            if (rank < need) __hip_atomic_fetch_or(&maskc[ki >> 5], 1u << (ki & 31), __ATOMIC_RELAXED, __HIP_MEMORY_SCOPE_WORKGROUP); }
        LDS_WAIT();
        if (lane < nw) { const unsigned long long cw_ = ((unsigned long long)maskc[2 * lane + 1] << 32) | maskc[2 * lane]; mw[lane] = myword | cw_; }
        LDS_WAIT(); asm volatile("" ::: "memory");
    }
}

typedef short s16x4 __attribute__((ext_vector_type(4)));
__device__ __forceinline__ s16x4 lds_tr4(const LAS unsigned char* p) { return __builtin_bit_cast(s16x4, __builtin_amdgcn_ds_read_tr16_b64_v4i16((LAS s16x4*)p)); }
__device__ __forceinline__ unsigned cvtpk(float lo, float hi) { unsigned r; asm("v_cvt_pk_bf16_f32 %0, %1, %2" : "=v"(r) : "v"(lo), "v"(hi)); return r; }
__device__ __forceinline__ float xmax16(float x) { auto r = __builtin_amdgcn_permlane16_swap(__float_as_uint(x), __float_as_uint(x), false, false); return fmaxf(__uint_as_float(r[0]), __uint_as_float(r[1])); }
__device__ __forceinline__ float xmax32(float x) { auto r = __builtin_amdgcn_permlane32_swap(__float_as_uint(x), __float_as_uint(x), false, false); return fmaxf(__uint_as_float(r[0]), __uint_as_float(r[1])); }
__device__ __forceinline__ float xsum16(float x) { auto r = __builtin_amdgcn_permlane16_swap(__float_as_uint(x), __float_as_uint(x), false, false); return __uint_as_float(r[0]) + __uint_as_float(r[1]); }
__device__ __forceinline__ float xsum32(float x) { auto r = __builtin_amdgcn_permlane32_swap(__float_as_uint(x), __float_as_uint(x), false, false); return __uint_as_float(r[0]) + __uint_as_float(r[1]); }
template <int VAR> __device__ __forceinline__ void ph_attn_dense(const GAS bf16* P, const GAS unsigned long long* MASKW, GAS bf16* AO, LAS unsigned char* lds, int blk, int nblk, int tid) {
    constexpr int KS = 272, VS = 288, KBUF = 64 * KS, VBUF = 64 * VS, VOFF = 2 * KBUF, MOFF = VOFF + 2 * VBUF;
    const int lane = tid & 63, wave = __builtin_amdgcn_readfirstlane(tid >> 6), g = lane >> 4, c16 = lane & 15;
    const int hq = wave >> 1, qh = (wave & 1) * 32;
    const float SCL = ATTN_SCALE * 1.4426950408889634f;
    for (int u0 = blk; u0 < 256; u0 += nblk) {
#pragma unroll 1
        for (int half = 0; half < 2; ++half) {
            const int b = (u0 >> 2) & 1, kvh = u0 & 3, cc = u0 >> 3, c = half ? 63 - cc : cc, nt = c + 1;
            const int m0 = b * SEQ + c * 64;
            bf16x8 qf[2][4];
#pragma unroll
            for (int qt = 0; qt < 2; ++qt)
#pragma unroll
                for (int kd = 0; kd < 4; ++kd) qf[qt][kd] = *(const GAS bf16x8*)(P + (size_t)(m0 + qh + 16 * qt + c16) * NMAIN + PQ + (kvh * 4 + hq) * AD + 32 * kd + 8 * g);
            f32x4 O[2][8];
#pragma unroll
            for (int qt = 0; qt < 2; ++qt)
#pragma unroll
                for (int dt = 0; dt < 8; ++dt) O[qt][dt] = (f32x4){0.f, 0.f, 0.f, 0.f};
            float mrun[2] = {-1e30f, -1e30f}, lrun[2] = {0.f, 0.f};
            const GAS bf16* kvbase = P + (size_t)(b * SEQ) * NMAIN + kvh * AD;
            u32x4 kreg[2], vreg[2];
#define ATT_LOAD(t) do { _Pragma("unroll") for (int i = 0; i < 2; ++i) { const int id = tid + 512 * i; const GAS bf16* src = kvbase + (size_t)((t) * 64 + (id >> 4)) * NMAIN + (id & 15) * 8; \
                kreg[i] = *(const GAS u32x4*)(src + PK); vreg[i] = *(const GAS u32x4*)(src + PV); } } while (0)
#define ATT_STORE(buf) do { _Pragma("unroll") for (int i = 0; i < 2; ++i) { const int id = tid + 512 * i; \
                *(LAS u32x4*)(lds + (buf) * KBUF + (id >> 4) * KS + (id & 15) * 16) = kreg[i]; *(LAS u32x4*)(lds + VOFF + (buf) * VBUF + (id >> 4) * VS + (id & 15) * 16) = vreg[i]; } } while (0)
            __syncthreads();
            ATT_LOAD(0); ATT_STORE(0);
#pragma unroll
            for (int i = 0; i < 4; ++i) { const int id = tid + 512 * i; *(LAS u32x4*)(lds + MOFF + id * 16) = *(const GAS u32x4*)((const GAS unsigned char*)(MASKW + (size_t)m0 * 64) + id * 16); }
            const LAS unsigned long long* mrow0 = (const LAS unsigned long long*)(lds + MOFF) + (qh + c16) * 64; const LAS unsigned long long* mrow1 = mrow0 + 16 * 64;
            __syncthreads();
            for (int t = 0; t < nt; ++t) {
                const int buf = (VAR & 1) ? 0 : (t & 1);
                if (!(VAR & 1) && t + 1 < nt) ATT_LOAD(t + 1);
                const LAS unsigned char* kb = lds + buf * KBUF + c16 * KS + g * 16;
                const LAS unsigned char* vb = lds + VOFF + buf * VBUF + (4 * g + (c16 >> 2)) * VS + (c16 & 3) * 8;
                f32x4 S[2][4];
                bf16x8 kf[2][4];
#pragma unroll
                for (int kd = 0; kd < 4; ++kd) kf[0][kd] = *(const LAS bf16x8*)(kb + kd * 64);
#pragma unroll
                for (int kt = 0; kt < 4; ++kt) {
                    if (kt < 3) {
#pragma unroll
                        for (int kd = 0; kd < 4; ++kd) kf[(kt + 1) & 1][kd] = *(const LAS bf16x8*)(kb + (kt + 1) * 16 * KS + kd * 64); }
#pragma unroll
                    for (int qt = 0; qt < 2; ++qt) { f32x4 s = (f32x4){0.f, 0.f, 0.f, 0.f};
#pragma unroll
                        for (int kd = 0; kd < 4; ++kd) { if (!(VAR & 8)) s = __builtin_amdgcn_mfma_f32_16x16x32_bf16(kf[kt & 1][kd], qf[qt][kd], s, 0, 0, 0); else s += __builtin_bit_cast(f32x4, kf[kt & 1][kd]); }
                        S[qt][kt] = s; }
                }
                s16x4 vlo[8][2], vhi[8][2];
#pragma unroll
                for (int dt = 0; dt < 4; ++dt)
#pragma unroll
                    for (int ks = 0; ks < 2; ++ks) { vlo[dt][ks] = lds_tr4(vb + (32 * ks) * VS + dt * 32); vhi[dt][ks] = lds_tr4(vb + (32 * ks + 16) * VS + dt * 32); }
                bf16x8 pf[2][2];
#pragma unroll
                for (int qt = 0; qt < 2; ++qt) {
                    const unsigned long long mw = (qt ? mrow1[t] : mrow0[t]) >> (4 * g);
                    const int mlo = (int)(unsigned)mw, mhi = (int)(unsigned)(mw >> 32);
                    float mx = fmaxf(fmaxf(S[qt][0][0], S[qt][0][1]), fmaxf(S[qt][0][2], S[qt][0][3]));
#pragma unroll
                    for (int kt = 1; kt < 4; ++kt) mx = fmaxf(fmaxf(mx, S[qt][kt][0]), fmaxf(fmaxf(S[qt][kt][1], S[qt][kt][2]), S[qt][kt][3]));
                    mx = xmax16(mx); mx = xmax32(mx);
                    const float mnew = fmaxf(mrun[qt], mx * SCL);
                    const float alpha = __builtin_amdgcn_exp2f(mrun[qt] - mnew);
                    float ps = 0.f;
#pragma unroll
                    for (int kt = 0; kt < 4; ++kt)
#pragma unroll
                        for (int j = 0; j < 4; ++j) { const int sel = __builtin_amdgcn_sbfe(kt < 2 ? mlo : mhi, (kt & 1) * 16 + j, 1);
                            const float p = (VAR & 2) ? S[qt][kt][j] : __uint_as_float(__float_as_uint(__builtin_amdgcn_exp2f(__builtin_fmaf(S[qt][kt][j], SCL, -mnew))) & (unsigned)sel); S[qt][kt][j] = p; ps += p; }
                    ps = xsum16(ps); ps = xsum32(ps);
                    lrun[qt] = lrun[qt] * alpha + ps; mrun[qt] = mnew;
                    if (!__all(alpha == 1.0f)) {
#pragma unroll
                        for (int dt = 0; dt < 8; ++dt) O[qt][dt] *= alpha; }
#pragma unroll
                    for (int ks = 0; ks < 2; ++ks) { u32x4 w; w.x = cvtpk(S[qt][2 * ks][0], S[qt][2 * ks][1]); w.y = cvtpk(S[qt][2 * ks][2], S[qt][2 * ks][3]);
                        w.z = cvtpk(S[qt][2 * ks + 1][0], S[qt][2 * ks + 1][1]); w.w = cvtpk(S[qt][2 * ks + 1][2], S[qt][2 * ks + 1][3]); pf[qt][ks] = __builtin_bit_cast(bf16x8, w); }
                }
#pragma unroll
                for (int dt = 4; dt < 8; ++dt)
#pragma unroll
                    for (int ks = 0; ks < 2; ++ks) { vlo[dt][ks] = lds_tr4(vb + (32 * ks) * VS + dt * 32); vhi[dt][ks] = lds_tr4(vb + (32 * ks + 16) * VS + dt * 32); }
#pragma unroll
                for (int dt = 0; dt < 8; ++dt)
#pragma unroll
                    for (int ks = 0; ks < 2; ++ks) {
                        const bf16x8 vf = __builtin_shufflevector(vlo[dt][ks], vhi[dt][ks], 0, 1, 2, 3, 4, 5, 6, 7);
                        if (!(VAR & 4)) { O[0][dt] = __builtin_amdgcn_mfma_f32_16x16x32_bf16(vf, pf[0][ks], O[0][dt], 0, 0, 0);
                        O[1][dt] = __builtin_amdgcn_mfma_f32_16x16x32_bf16(vf, pf[1][ks], O[1][dt], 0, 0, 0); } else { O[0][dt] += __builtin_bit_cast(f32x4, pf[0][ks]); O[1][dt] += __builtin_bit_cast(f32x4, pf[1][ks]); }
                    }
                if (!(VAR & 1) && t + 1 < nt) ATT_STORE(buf ^ 1);
                __syncthreads();
            }
#undef ATT_LOAD
#undef ATT_STORE
#pragma unroll
            for (int qt = 0; qt < 2; ++qt) { const float r = 1.0f / lrun[qt];
                GAS bf16* op = AO + (size_t)(m0 + qh + 16 * qt + c16) * D + (kvh * 4 + hq) * AD + 4 * g;
#pragma unroll
                for (int dt = 0; dt < 8; ++dt) { const f32x4 o = O[qt][dt] * r; u32x2 w; w.x = pk2(o.x, o.y); w.y = pk2(o.z, o.w); *(GAS u32x2*)(op + 16 * dt) = w; } }
        }
    }
}

__device__ __forceinline__ void stage_conv(const GAS bf16* P, const GAS float* cw, const GAS float* cb, int m0, int tpos0, int ch0, int nch, LAS unsigned char* dst, int stride, int tid) {
    const int cpr = nch >> 3;
    for (int id = tid; id < 64 * cpr; id += NTHR) {
        const int s = id / cpr, k = id - s * cpr, ch = ch0 + 8 * k;
        float acc[8];
        { const f32x4 b0 = *(const GAS f32x4*)(cb + ch), b1 = *(const GAS f32x4*)(cb + ch + 4); acc[0] = b0.x; acc[1] = b0.y; acc[2] = b0.z; acc[3] = b0.w; acc[4] = b1.x; acc[5] = b1.y; acc[6] = b1.z; acc[7] = b1.w; }
#pragma unroll
        for (int i = 0; i < 4; ++i) { if (tpos0 + s - 3 + i >= 0) {
            float x[8]; unpack8(*(const GAS u32x4*)(P + (size_t)(m0 + s - 3 + i) * NMAIN + PXBC + ch), x);
            const f32x4 w0 = *(const GAS f32x4*)(cw + i * CONVD + ch), w1 = *(const GAS f32x4*)(cw + i * CONVD + ch + 4);
            acc[0] += w0.x * x[0]; acc[1] += w0.y * x[1]; acc[2] += w0.z * x[2]; acc[3] += w0.w * x[3]; acc[4] += w1.x * x[4]; acc[5] += w1.y * x[5]; acc[6] += w1.z * x[6]; acc[7] += w1.w * x[7]; } }
#pragma unroll
        for (int j = 0; j < 8; ++j) acc[j] = siluf_(acc[j]);
        *(LAS u32x4*)(dst + s * stride + k * 16) = pack8(acc);
    }
}
__device__ __forceinline__ void wave_dt_acs(const GAS float* SM, const GAS float* dt_bias, const GAS float* a_log, int m0, int head, LAS float* dtw, LAS float* acsw, int lane) {
    const float raw = SM[(size_t)(m0 + lane) * SMW + SM_DT + head] + dt_bias[head];
    const float dt = fmaxf(raw, 0.f) + log1pf(__expf(-fabsf(raw)));
    float x = dt * (-__expf(a_log[head]));
#pragma unroll
    for (int o = 1; o < 64; o <<= 1) { const float v = __shfl_up(x, o); if (lane >= o) x += v; }
    dtw[lane] = dt; acsw[lane] = x;
}
__device__ __forceinline__ bf16x8 tr8(const LAS unsigned char* p, int off_lo, int off_hi) {
    const s16x4 lo = lds_tr4(p + off_lo), hi = lds_tr4(p + off_hi); return __builtin_shufflevector(lo, hi, 0, 1, 2, 3, 4, 5, 6, 7);
}
template <int NOUT> __device__ __forceinline__ void conv_strip(const GAS bf16* src, int tpos_first_raw, const GAS float* cw, const GAS float* cb, u32x4 (&out)[NOUT]) {
    u32x4 raw[NOUT + 3];
#pragma unroll
    for (int i = 0; i < NOUT + 3; ++i) { const int tp = tpos_first_raw + i; raw[i] = *(const GAS u32x4*)(src + (size_t)(tp < 0 ? 3 : i) * NMAIN); if (tp < 0) raw[i] = (u32x4){0u, 0u, 0u, 0u}; }
    f32x4 w[4][2];
#pragma unroll
    for (int t = 0; t < 4; ++t) { w[t][0] = *(const GAS f32x4*)(cw + t * CONVD); w[t][1] = *(const GAS f32x4*)(cw + t * CONVD + 4); }
    const f32x4 b0 = *(const GAS f32x4*)cb, b1 = *(const GAS f32x4*)(cb + 4);
#pragma unroll
    for (int o = 0; o < NOUT; ++o) { f32x4 a0 = b0, a1 = b1;
#pragma unroll
        for (int t = 0; t < 4; ++t) { float x[8]; unpack8(raw[o + t], x); a0 += w[t][0] * (f32x4){x[0], x[1], x[2], x[3]}; a1 += w[t][1] * (f32x4){x[4], x[5], x[6], x[7]}; }
        float f[8] = {a0.x, a0.y, a0.z, a0.w, a1.x, a1.y, a1.z, a1.w};
#pragma unroll
        for (int j = 0; j < 8; ++j) f[j] = f[j] * __builtin_amdgcn_rcpf(1.0f + __expf(-f[j]));
        out[o] = pack8(f); }
}
__device__ __forceinline__ void ph_ssd_states(const GAS bf16* P, const GAS float* SM, const GAS float* cw, const GAS float* cb, const GAS float* dt_bias, const GAS float* a_log, GAS bf16* XC, GAS bf16* ST, GAS float* CD,
                                              LAS unsigned char* lds, int blk, int nblk, int tid) {
    constexpr int RSW = 160, XW = 64 * RSW, RSB = 288, BMB = 64 * RSB, O_BM = 8 * XW, O_DT = O_BM + 2 * BMB, O_ACS = O_DT + 2048;
    const int lane = tid & 63, wave = __builtin_amdgcn_readfirstlane(tid >> 6), gq = lane >> 4, c16 = lane & 15;
    LAS unsigned char* xw = lds + wave * XW;
    LAS float* dtw = (LAS float*)(lds + O_DT) + wave * 64; LAS float* acsw = (LAS float*)(lds + O_ACS) + wave * 64;
    int par = 0;
    for (int item = blk; item < BATCH * 64 * NG; item += nblk, par ^= 1) {
        const int bc = item >> 3, g = item & 7, m0 = bc * 64, tpos0 = (bc & 63) * 64, head = g * HPG + wave;
        LAS unsigned char* bm = lds + O_BM + par * BMB;
        asm volatile("" ::: "memory");
        { const int k16 = lane & 15, r0 = 8 * wave + 2 * gq, chB = DI + g * NS + 8 * k16;
          const GAS bf16* base = P + (size_t)(m0 + r0 - 3) * NMAIN + PXBC + chB;
          u32x4 ob[2], oc[2];
          conv_strip<2>(base, tpos0 + r0 - 3, cw + chB, cb + chB, ob);
          conv_strip<2>(base + NG * NS, tpos0 + r0 - 3, cw + chB + NG * NS, cb + chB + NG * NS, oc);
#pragma unroll
          for (int o = 0; o < 2; ++o) { *(LAS u32x4*)(bm + (r0 + o) * RSB + k16 * 16) = ob[o];
              *(GAS u32x4*)(XC + (size_t)(m0 + r0 + o) * CONVD + chB) = ob[o]; *(GAS u32x4*)(XC + (size_t)(m0 + r0 + o) * CONVD + chB + NG * NS) = oc[o]; } }
        { const int k8 = lane & 7, r0 = 8 * (lane >> 3), ch = head * HP + 8 * k8;
          u32x4 ox[8];
          conv_strip<8>(P + (size_t)(m0 + r0 - 3) * NMAIN + PXBC + ch, tpos0 + r0 - 3, cw + ch, cb + ch, ox);
#pragma unroll
          for (int o = 0; o < 8; ++o) { *(LAS u32x4*)(xw + (r0 + o) * RSW + k8 * 16) = ox[o]; *(GAS u32x4*)(XC + (size_t)(m0 + r0 + o) * CONVD + ch) = ox[o]; } }
        wave_dt_acs(SM, dt_bias, a_log, m0, head, dtw, acsw, lane);
        LDS_WAIT();
        __syncthreads();
        const float aend = acsw[63];
        if (lane == 0) CD[bc * NH + head] = __expf(aend);
        const LAS unsigned char* xb = xw + (4 * gq + (c16 >> 2)) * RSW + (c16 & 3) * 8;
        const LAS unsigned char* bb = bm + (4 * gq + (c16 >> 2)) * RSB + (c16 & 3) * 8;
        bf16x8 xf[4][2];
#pragma unroll
        for (int ks = 0; ks < 2; ++ks) { float w[8];
#pragma unroll
            for (int j = 0; j < 8; ++j) { const int s = 32 * ks + 16 * (j >> 2) + 4 * gq + (j & 3); w[j] = dtw[s] * __expf(aend - acsw[s]); }
#pragma unroll
            for (int pt = 0; pt < 4; ++pt) { const bf16x8 r = tr8(xb + pt * 32, (32 * ks) * RSW, (32 * ks + 16) * RSW); float f[8]; unpack8(__builtin_bit_cast(u32x4, r), f);
#pragma unroll
                for (int j = 0; j < 8; ++j) f[j] *= w[j];
                xf[pt][ks] = __builtin_bit_cast(bf16x8, pack8(f)); } }
        GAS bf16* dst = ST + (((size_t)bc * NH + head) * HP + c16) * NS + 4 * gq;
#pragma unroll 2
        for (int nt = 0; nt < 8; ++nt) {
            const bf16x8 a0 = tr8(bb + nt * 32, 0, 16 * RSB), a1 = tr8(bb + nt * 32, 32 * RSB, 48 * RSB);
#pragma unroll
            for (int pt = 0; pt < 4; ++pt) { f32x4 acc = (f32x4){0.f, 0.f, 0.f, 0.f};
                acc = __builtin_amdgcn_mfma_f32_16x16x32_bf16(a0, xf[pt][0], acc, 0, 0, 0); acc = __builtin_amdgcn_mfma_f32_16x16x32_bf16(a1, xf[pt][1], acc, 0, 0, 0);
                u32x2 o; o.x = pk2(acc.x, acc.y); o.y = pk2(acc.z, acc.w); *(GAS u32x2*)(dst + (size_t)(16 * pt) * NS + 16 * nt) = o; }
        }
        LDS_WAIT(); asm volatile("" ::: "memory");
    }
}
__device__ __forceinline__ void ph_ssd_scan(GAS bf16* ST, const GAS float* CD, int gtid, int nthr) {
    for (int it = gtid; it < BATCH * NH * HP * (NS / 8); it += nthr) {
        const int n8 = it & 15, p = (it >> 4) & 63, head = (it >> 10) & 63, b = it >> 16;
        float h[8];
#pragma unroll
        for (int j = 0; j < 8; ++j) h[j] = 0.f;
#pragma unroll 8
        for (int c = 0; c < 64; ++c) { GAS u32x4* q = (GAS u32x4*)(ST + ((((size_t)(b * 64 + c)) * NH + head) * HP + p) * NS) + n8;
            float v[8]; unpack8(*q, v); *q = pack8(h); const float dec = CD[(b * 64 + c) * NH + head];
#pragma unroll
            for (int j = 0; j < 8; ++j) h[j] = h[j] * dec + v[j]; }
    }
}
__device__ __forceinline__ void ph_ssd_out(const GAS bf16* P, const GAS float* SM, const GAS bf16* XC, const GAS float* dt_bias, const GAS float* a_log, const GAS bf16* ST,
                                           const GAS float* dskip, const GAS float* gnorm, GAS bf16* Y, LAS unsigned char* lds, int blk, int nblk, int tid) {
    constexpr int RSW = 160, XW = 64 * RSW, O_DT = 8 * XW, O_ACS = O_DT + 2048, O_SSQ = O_ACS + 2048;
    const int lane = tid & 63, wave = __builtin_amdgcn_readfirstlane(tid >> 6), gq = lane >> 4, c16 = lane & 15;
    LAS unsigned char* xw = lds + wave * XW;
    LAS float* dtw = (LAS float*)(lds + O_DT) + wave * 64; LAS float* acsw = (LAS float*)(lds + O_ACS) + wave * 64;
    int par = 0;
    for (int item = blk; item < BATCH * 64 * NG; item += nblk, par ^= 1) {
        const int bc = item >> 3, g = item & 7, m0 = bc * 64, head = g * HPG + wave;
        asm volatile("" ::: "memory");
        { u32x4 xr[8];
#pragma unroll
          for (int i = 0; i < 8; ++i) xr[i] = *(const GAS u32x4*)(XC + (size_t)(m0 + (lane >> 3) + 8 * i) * CONVD + head * HP + (lane & 7) * 8);
#pragma unroll
          for (int i = 0; i < 8; ++i) *(LAS u32x4*)(xw + ((lane >> 3) + 8 * i) * RSW + (lane & 7) * 16) = xr[i]; }
        wave_dt_acs(SM, dt_bias, a_log, m0, head, dtw, acsw, lane);
        const GAS bf16* cbase = XC + (size_t)(m0 + c16) * CONVD + DI + NG * NS + g * NS + 8 * gq;
        const GAS bf16* bbase = cbase - NG * NS;
        bf16x8 cf[4][4];
#pragma unroll
        for (int lt = 0; lt < 4; ++lt)
#pragma unroll
            for (int kn = 0; kn < 4; ++kn) cf[lt][kn] = *(const GAS bf16x8*)(cbase + (size_t)(16 * lt) * CONVD + 32 * kn);
        LDS_WAIT(); asm volatile("" ::: "memory");
        float al[4];
#pragma unroll
        for (int lt = 0; lt < 4; ++lt) al[lt] = acsw[16 * lt + c16];
        bf16x8 lf[2][4];
#pragma unroll
        for (int ks = 0; ks < 2; ++ks) {
            f32x4 lt4[2][4];
#pragma unroll
            for (int h2 = 0; h2 < 2; ++h2) { const int st = 2 * ks + h2;
                bf16x8 bfr[4];
#pragma unroll
                for (int kn = 0; kn < 4; ++kn) bfr[kn] = *(const GAS bf16x8*)(bbase + (size_t)(16 * st) * CONVD + 32 * kn);
                float as_[4], ds_[4];
#pragma unroll
                for (int j = 0; j < 4; ++j) { as_[j] = acsw[16 * st + 4 * gq + j]; ds_[j] = dtw[16 * st + 4 * gq + j]; }
#pragma unroll
                for (int lt = 0; lt < 4; ++lt) { f32x4 t4 = (f32x4){0.f, 0.f, 0.f, 0.f};
                    if (lt >= st) {
#pragma unroll
                        for (int kn = 0; kn < 4; ++kn) t4 = __builtin_amdgcn_mfma_f32_16x16x32_bf16(bfr[kn], cf[lt][kn], t4, 0, 0, 0);
#pragma unroll
                        for (int j = 0; j < 4; ++j) { const float e = __expf(fminf(al[lt] - as_[j], 0.f)) * ds_[j]; const bool ok = (lt > st) || (4 * gq + j <= c16); t4[j] = ok ? t4[j] * e : 0.f; } }
                    lt4[h2][lt] = t4; } }
#pragma unroll
            for (int lt = 0; lt < 4; ++lt) { u32x4 w; w.x = pk2(lt4[0][lt][0], lt4[0][lt][1]); w.y = pk2(lt4[0][lt][2], lt4[0][lt][3]); w.z = pk2(lt4[1][lt][0], lt4[1][lt][1]); w.w = pk2(lt4[1][lt][2], lt4[1][lt][3]);
                lf[ks][lt] = __builtin_bit_cast(bf16x8, w); }
        }
        f32x4 acc[4][4];
        const GAS bf16* hsrc = ST + (((size_t)bc * NH + head) * HP + c16) * NS + 8 * gq;
#pragma unroll
        for (int pt = 0; pt < 4; ++pt) { bf16x8 hf[4];
#pragma unroll
            for (int kn = 0; kn < 4; ++kn) hf[kn] = *(const GAS bf16x8*)(hsrc + (size_t)(16 * pt) * NS + 32 * kn);
#pragma unroll
            for (int lt = 0; lt < 4; ++lt) { f32x4 t4 = (f32x4){0.f, 0.f, 0.f, 0.f};
#pragma unroll
                for (int kn = 0; kn < 4; ++kn) t4 = __builtin_amdgcn_mfma_f32_16x16x32_bf16(hf[kn], cf[lt][kn], t4, 0, 0, 0);
                acc[pt][lt] = t4 * __expf(al[lt]); } }
        const LAS unsigned char* xb = xw + (4 * gq + (c16 >> 2)) * RSW + (c16 & 3) * 8;
#pragma unroll
        for (int pt = 0; pt < 4; ++pt) {
            const bf16x8 x0 = tr8(xb + pt * 32, 0, 16 * RSW), x1 = tr8(xb + pt * 32, 32 * RSW, 48 * RSW);
#pragma unroll
            for (int lt = 0; lt < 4; ++lt) { acc[pt][lt] = __builtin_amdgcn_mfma_f32_16x16x32_bf16(x0, lf[0][lt], acc[pt][lt], 0, 0, 0);
                if (lt >= 2) acc[pt][lt] = __builtin_amdgcn_mfma_f32_16x16x32_bf16(x1, lf[1][lt], acc[pt][lt], 0, 0, 0); } }
        const float dk = dskip[head]; float ssq[4] = {0.f, 0.f, 0.f, 0.f};
#pragma unroll
        for (int lt = 0; lt < 4; ++lt) { const int l = 16 * lt + c16;
#pragma unroll
            for (int pt = 0; pt < 4; ++pt) { const int p0 = 16 * pt + 4 * gq;
                const u32x2 xv = *(const LAS u32x2*)(xw + l * RSW + p0 * 2); const u32x2 zw = *(const GAS u32x2*)(P + (size_t)(m0 + l) * NMAIN + PZ + head * HP + p0);
                const float xs4[4] = {bflo(xv.x), bfhi(xv.x), bflo(xv.y), bfhi(xv.y)}, z4[4] = {bflo(zw.x), bfhi(zw.x), bflo(zw.y), bfhi(zw.y)};
#pragma unroll
                for (int j = 0; j < 4; ++j) { const float y = (acc[pt][lt][j] + dk * xs4[j]) * z4[j] * __builtin_amdgcn_rcpf(1.0f + __expf(-z4[j])); acc[pt][lt][j] = y; ssq[lt] += y * y; } } }
        LAS float* ssqs = (LAS float*)(lds + O_SSQ) + par * 512;
#pragma unroll
        for (int lt = 0; lt < 4; ++lt) { float v = ssq[lt]; v += __shfl_xor(v, 16); v += __shfl_xor(v, 32); if (gq == 0) ssqs[wave * 64 + 16 * lt + c16] = v; }
        LDS_WAIT();
        __syncthreads();
#pragma unroll
        for (int lt = 0; lt < 4; ++lt) { const int l = 16 * lt + c16; float tot = 0.f;
#pragma unroll
            for (int w8 = 0; w8 < 8; ++w8) tot += ssqs[w8 * 64 + l];
            const float rstd = rsqrtf(tot * (1.0f / (HPG * HP)) + EPS);
#pragma unroll
            for (int pt = 0; pt < 4; ++pt) { const int ch = head * HP + 16 * pt + 4 * gq; const f32x4 gn = *(const GAS f32x4*)(gnorm + ch); const f32x4 o = acc[pt][lt] * rstd * gn;
                u32x2 w; w.x = pk2(o.x, o.y); w.y = pk2(o.z, o.w); *(GAS u32x2*)(Y + (size_t)(m0 + l) * DI + ch) = w; } }
        LDS_WAIT(); asm volatile("" ::: "memory");
    }
}

__device__ __forceinline__ float gelu_tanhf_(float x) { const float u = 0.7978845608028654f * (x + 0.044715f * x * x * x); return x * __builtin_amdgcn_rcpf(1.0f + __expf(-2.0f * u)); }
__device__ __forceinline__ void ph_ffn_act(const GAS bf16* U, const GAS float* cw, const GAS float* cb, GAS bf16* ACT, int gtid, int nthr) {
    constexpr int NCG = FF / 8, R = 8;
    for (int it = gtid; it < (M / R) * NCG; it += nthr) {
        const int c0 = (it % NCG) * 8, m0 = (it / NCG) * R, t0 = m0 & (SEQ - 1);
        f32x4 wg[3][2], wv[3][2];
#pragma unroll
        for (int i = 0; i < 3; ++i) { wg[i][0] = *(const GAS f32x4*)(cw + i * FF2 + c0); wg[i][1] = *(const GAS f32x4*)(cw + i * FF2 + c0 + 4); wv[i][0] = *(const GAS f32x4*)(cw + i * FF2 + FF + c0); wv[i][1] = *(const GAS f32x4*)(cw + i * FF2 + FF + c0 + 4); }
        const f32x4 bg0 = *(const GAS f32x4*)(cb + c0), bg1 = *(const GAS f32x4*)(cb + c0 + 4), bv0 = *(const GAS f32x4*)(cb + FF + c0), bv1 = *(const GAS f32x4*)(cb + FF + c0 + 4);
        u32x4 rg[R + 2], rv[R + 2];
#pragma unroll
        for (int i = 0; i < R + 2; ++i) { const bool ok = (t0 + i - 2) >= 0; const GAS bf16* ur = U + (size_t)(m0 + (ok ? i - 2 : 0)) * FF2 + c0;
            rg[i] = *(const GAS u32x4*)ur; rv[i] = *(const GAS u32x4*)(ur + FF); if (!ok) { rg[i] = (u32x4){0u, 0u, 0u, 0u}; rv[i] = (u32x4){0u, 0u, 0u, 0u}; } }
#pragma unroll
        for (int o = 0; o < R; ++o) { f32x4 g0 = bg0, g1 = bg1, v0 = bv0, v1 = bv1;
#pragma unroll
            for (int i = 0; i < 3; ++i) { float xg[8], xv[8]; unpack8(rg[o + i], xg); unpack8(rv[o + i], xv);
                g0 += wg[i][0] * (f32x4){xg[0], xg[1], xg[2], xg[3]}; g1 += wg[i][1] * (f32x4){xg[4], xg[5], xg[6], xg[7]};
                v0 += wv[i][0] * (f32x4){xv[0], xv[1], xv[2], xv[3]}; v1 += wv[i][1] * (f32x4){xv[4], xv[5], xv[6], xv[7]}; }
            float r[8] = {gelu_tanhf_(g0.x) * v0.x, gelu_tanhf_(g0.y) * v0.y, gelu_tanhf_(g0.z) * v0.z, gelu_tanhf_(g0.w) * v0.w, gelu_tanhf_(g1.x) * v1.x, gelu_tanhf_(g1.y) * v1.y, gelu_tanhf_(g1.z) * v1.z, gelu_tanhf_(g1.w) * v1.w};
            *(GAS u32x4*)(ACT + (size_t)(m0 + o) * FF + c0) = pack8(r); }
    }
}

struct Args { const float* in[20]; float* out; unsigned char* ws; int ph_lo, ph_hi; };
constexpr int NP = 11, NPHASE = 1 + DEPTH * NP;

#define AIN(i) ((const GAS float*)args.in[i])
__global__ void __launch_bounds__(NTHR, 2) fwd(Args args) {
    extern __shared__ __attribute__((aligned(16))) unsigned char lds[];
    const int G = gridDim.x, blk = blockIdx.x;
    volatile LAS unsigned* MISC = (volatile LAS unsigned*)((LAS unsigned char*)lds + MISC_OFF);
    for (int u = threadIdx.x; u < (LDS_BYTES - LDSCTL_OFF) / 4; u += NTHR) ((LAS unsigned*)((LAS unsigned char*)lds + LDSCTL_OFF))[u] = 0u;
    __syncthreads();
    XcdBarrier bar; bar.bar = (unsigned*)(args.ws + WS_CTL) + CW_BAR; bar.x = 0; bar.st = nullptr;
    if (!MK_PER_PHASE) bar = xcd_barrier_post((unsigned*)(args.ws + WS_CTL) + CW_BAR, MISC + 8);
    const int lo = args.ph_lo, hi = args.ph_hi;
#define IN(k) (lo <= (k) && (k) < hi)
#define SEAM(k) do { if (IN(k) && IN((k) + 1)) xcd_barrier(bar); } while (0)
#define PH_BEGIN \
    int tid = threadIdx.x; asm volatile("" : "+v"(tid)); \
    const int lane = tid & 63, wave = __builtin_amdgcn_readfirstlane(tid >> 6); \
    const int gw = blk * NWAVES + wave, ngw = G * NWAVES, gtid = blk * NTHR + tid, nthr = G * NTHR; \
    GAS unsigned char* ws = (GAS unsigned char*)args.ws; asm volatile("" : "+s"(ws)); \
    LAS unsigned char* ring = (LAS unsigned char*)lds; \
    (void)lane; (void)wave; (void)gw; (void)ngw; (void)gtid; (void)nthr; (void)ring; \
    GAS float* X = (GAS float*)args.out; \
    GAS bf16* H = (GAS bf16*)(ws + WS_H); GAS bf16* P = (GAS bf16*)(ws + WS_P); GAS float* SM = (GAS float*)(ws + WS_SM); GAS bf16* XC = (GAS bf16*)(ws + WS_XC); \
    GAS float* CD = (GAS float*)(ws + WS_DT); GAS bf16* STB = (GAS bf16*)(ws + WS_ST); GAS bf16* Y = (GAS bf16*)(ws + WS_Y); \
    GAS float* SC = (GAS float*)(ws + WS_SC); GAS unsigned long long* MASKW = (GAS unsigned long long*)(ws + WS_IDX); GAS bf16* AO = (GAS bf16*)(ws + WS_AO); \
    GAS float* MG = (GAS float*)(ws + WS_MG); GAS bf16* MGB = (GAS bf16*)(ws + WS_MGB); GAS float* YM = (GAS float*)(ws + WS_YM); GAS bf16* U = (GAS bf16*)(ws + WS_U); \
    GAS bf16* ACT = (GAS bf16*)(ws + WS_ACT); GAS bf16* KIB = (GAS bf16*)(ws + WS_KIB); \
    (void)X; (void)H; (void)P; (void)SM; (void)XC; (void)CD; (void)STB; (void)Y; (void)SC; (void)MASKW; (void)AO; (void)MG; (void)MGB; (void)YM; (void)U; (void)ACT; (void)KIB;

    if (IN(0)) { PH_BEGIN
        WPtrs wp{AIN(5), AIN(13), AIN(14), AIN(15), AIN(16), AIN(19)};
        ph_weights(wp, ws, (LAS float*)lds + wave * 2176, gw, ngw, lane);
        ph_resid_norm(nullptr, nullptr, AIN(1), AIN(0), X, H, gw, ngw, lane);
    }
    SEAM(0);

#pragma unroll 1
    for (int layer = 0; layer < DEPTH; ++layer) {
        const int pb = 1 + layer * NP;
#define WL (ws + WS_W + (size_t)layer * WL_SIZE)
        if (IN(pb + 0)) { PH_BEGIN
            pg8::Gemm g{H, (const GAS bf16*)(WL + WL_IN), M, NPAD, D}; pg8::StaticOrder S; S.init(M, NPAD, G, blk);
            pg8::EpiIn E{P, NMAIN, SM, AIN(6) + (size_t)layer * 2 * D, PG / 256, NMAIN / 256, KIB};
            REP(1) { pg8::gemm_phase<pg8::EpiIn, pg8::StaticOrder, true, true>(ring, g, S, E); __syncthreads(); }
        }
        SEAM(pb + 0);
        if (IN(pb + 1)) { PH_BEGIN
            REP(20) { ph_ssd_states(P, SM, AIN(7) + (size_t)layer * 4 * CONVD, AIN(8) + (size_t)layer * CONVD, AIN(9) + layer * NH, AIN(10) + layer * NH, XC, STB, CD, ring, blk, G, tid); __syncthreads(); }
            REP(21) ph_index_scores(P, SM, KIB, SC, blk, G, wave, lane); }
        SEAM(pb + 1);
        if (IN(pb + 2)) { PH_BEGIN
            ph_ssd_scan(STB, CD, gtid, nthr); REP(30) ph_topk(SC, MASKW, ring + wave * 9728, gw, ngw, lane); }
        SEAM(pb + 2);
        if (IN(pb + 3)) { PH_BEGIN
            REP(40) { ph_ssd_out(P, SM, XC, AIN(9) + layer * NH, AIN(10) + layer * NH, STB,
                                 AIN(11) + layer * NH, AIN(12) + (size_t)layer * DI, Y, ring, blk, G, tid); __syncthreads(); }
            REP(41) { ph_attn_dense<0>(P, MASKW, AO, ring, blk, G, tid); __syncthreads(); }
#if PROBE_DOUBLE >= 1000
            { ph_attn_dense<PROBE_DOUBLE - 1000>(P, MASKW, (GAS bf16*)U, ring, blk, G, tid); __syncthreads(); }
#endif
            }
        SEAM(pb + 3);
        if (IN(pb + 4)) {
            { PH_BEGIN
              pg8::Gemm g{Y, (const GAS bf16*)(WL + WL_SSM), M, D, DI}; pg8::StaticOrder S; S.init(M, D, G, blk);
              pg8::EpiGateMul E{MG, D, P + PG, NMAIN}; pg8::gemm_phase<pg8::EpiGateMul, pg8::StaticOrder, false, true>(ring, g, S, E); }
            __syncthreads();
            { PH_BEGIN
              pg8::Gemm g{AO, (const GAS bf16*)(WL + WL_ATT), M, D, D}; pg8::StaticOrder S; S.init(M, D, G, blk);
              pg8::EpiGateAdd E{MG, MGB, D, P + PG + D, NMAIN}; pg8::gemm_phase<pg8::EpiGateAdd, pg8::StaticOrder, false, true>(ring, g, S, E); }
        }
        SEAM(pb + 4);
        if (IN(pb + 5)) { PH_BEGIN
            pg8::Gemm g{MGB, (const GAS bf16*)(WL + WL_MIX), M, D, D}; pg8::StaticOrder S; S.init(M, D, G, blk);
            pg8::EpiF32 E{YM, D}; REP(60) { pg8::gemm_phase<pg8::EpiF32, pg8::StaticOrder, false, true>(ring, g, S, E); __syncthreads(); } }
        SEAM(pb + 5);
        if (IN(pb + 6)) { PH_BEGIN
            ph_resid_norm(YM, AIN(2) + (size_t)layer * D, AIN(3) + (size_t)layer * D, X, X, H, gw, ngw, lane); }
        SEAM(pb + 6);
        if (IN(pb + 7)) { PH_BEGIN
            pg8::Gemm g{H, (const GAS bf16*)(WL + WL_UP), M, FF2, D}; pg8::StaticOrder S; S.init(M, FF2, G, blk);
            pg8::EpiBf16<0> E{U, FF2, nullptr, 0, 0, 1.f}; REP(80) { pg8::gemm_phase<pg8::EpiBf16<0>, pg8::StaticOrder, true, true>(ring, g, S, E); __syncthreads(); } }
        SEAM(pb + 7);
        if (IN(pb + 8)) { PH_BEGIN
            REP(90) ph_ffn_act(U, AIN(17) + (size_t)layer * 3 * FF2, AIN(18) + (size_t)layer * FF2, ACT, gtid, nthr); }
        SEAM(pb + 8);
        if (IN(pb + 9)) { PH_BEGIN
            pg8::Gemm g{ACT, (const GAS bf16*)(WL + WL_DN), M, D, FF}; pg8::StaticOrder S; S.init(M, D, G, blk);
            pg8::EpiF32 E{YM, D}; REP(100) { pg8::gemm_phase<pg8::EpiF32, pg8::StaticOrder, false, true>(ring, g, S, E); __syncthreads(); } }
        SEAM(pb + 9);
        if (IN(pb + 10)) { PH_BEGIN
            ph_resid_norm(YM, AIN(4) + (size_t)layer * D, layer + 1 < DEPTH ? AIN(1) + (size_t)(layer + 1) * D : nullptr, X, X, H, gw, ngw, lane); }
        SEAM(pb + 10);
    }
#undef IN
#undef SEAM
#undef WL
#undef PH_BEGIN
}

extern "C" void kernel_launch(void* const* d_in, const int* in_sizes, int n_in, void* d_out, int out_size, void* d_ws, size_t ws_size, hipStream_t stream) {
    static int grid = 0;
    if (grid == 0) {
        if (n_in != 20 || in_sizes[0] != M * D || out_size != M * D || ws_size < WS_END) { fprintf(stderr, "kernel_launch: unexpected shapes (n_in %d, in0 %d, out %d, ws %zu < %zu)\n", n_in, n_in > 0 ? in_sizes[0] : -1, out_size, ws_size, (size_t)WS_END); grid = -1; return; }
        int dev = 0, cus = 0, per_cu = 0;
        if (hipGetDevice(&dev) != hipSuccess || hipDeviceGetAttribute(&cus, hipDeviceAttributeMultiprocessorCount, dev) != hipSuccess) { grid = -1; return; }
        if (hipFuncSetAttribute((const void*)fwd, hipFuncAttributeMaxDynamicSharedMemorySize, LDS_BYTES) != hipSuccess) { fprintf(stderr, "kernel_launch: hipFuncSetAttribute failed\n"); grid = -1; return; }
        if (hipOccupancyMaxActiveBlocksPerMultiprocessor(&per_cu, (const void*)fwd, NTHR, LDS_BYTES) != hipSuccess || per_cu < 1) fprintf(stderr, "kernel_launch: occupancy query reports %d blocks per CU\n", per_cu);
        (void)hipGetLastError();
        grid = cus;
    }
    if (grid < 0) return;
    if (hipMemsetAsync((char*)d_ws + WS_CTL, 0, CTL_ZERO_BYTES, stream) != hipSuccess) return;
    Args a{};
    for (int i = 0; i < 20; ++i) a.in[i] = (const float*)d_in[i];
    a.out = (float*)d_out; a.ws = (unsigned char*)d_ws;
#if MK_PER_PHASE
    for (int ph = 0; ph < NPHASE; ++ph) { a.ph_lo = ph; a.ph_hi = ph + 1; hipLaunchKernelGGL(fwd, dim3(grid), dim3(NTHR), LDS_BYTES, stream, a); }
#else
    a.ph_lo = 0; a.ph_hi = NPHASE; hipLaunchKernelGGL(fwd, dim3(grid), dim3(NTHR), LDS_BYTES, stream, a);
#endif
}
```

```cpp
#include <hip/hip_runtime.h>
#include <cstdio>
#include <cstdint>
#define MK_PER_PHASE 0
namespace pg8 {
#define PG8_LAS __attribute__((address_space(3)))
#define PG8_GAS __attribute__((address_space(1)))
typedef unsigned short bf16_t;
typedef short bf16x8 __attribute__((ext_vector_type(8)));
typedef float f32x4 __attribute__((ext_vector_type(4)));
typedef unsigned u32x4 __attribute__((ext_vector_type(4)));
constexpr int BM = 256, BK = 64, HALF = 128, HTB = HALF * BK * 2  , STAGE_BYTES = 8 * HTB, NXCD = 8, WGM = 8;

__host__ __device__ __forceinline__ int lds_byte(int r, int c) { const int st = (r >> 4) * 2 + (c >> 5), rr = r & 15, cc = c & 31, ob = rr * 64 + cc * 2; return st * 1024 + (ob ^ (((ob >> 9) & 1) << 5)); }
__host__ __device__ __forceinline__ void stage_rc(int b, int& R, int& C) { const int st = b / 1024, sb = b % 1024, swz = sb ^ (((sb >> 9) & 1) << 5); R = (st >> 1) * 16 + swz / 64; C = (st & 1) * 32 + (swz % 64) / 2; }
__host__ __device__ __forceinline__ int perm32(int rho) { const int n = rho >> 4, i = rho & 15; return 8 * (i >> 2) + 4 * n + (i & 3); }

struct Unit { int pm, pn; };
struct Gemm { const PG8_GAS bf16_t* A; const PG8_GAS bf16_t* Bt; int M, N, K; };

struct StaticOrder {
    int nM, nN, nwg, G, c;
    __host__ __device__ void init(int M, int N, int G_, int c_) { nM = M / BM; nN = N / BM; nwg = nM * nN; G = G_; c = c_; }
    __host__ __device__ bool next(int i, Unit& u) const {
        const long L = (long)i * G + c; if (L >= nwg) return false;
        int wgid = (int)L; { const int q = nwg / NXCD, r = nwg % NXCD, xcd = wgid % NXCD, off = wgid / NXCD; wgid = (xcd < r ? xcd * (q + 1) : r * (q + 1) + (xcd - r) * q) + off; }
        const int nig = WGM * nN, gid = wgid / nig, fm = gid * WGM, gsz = (nM - fm) < WGM ? (nM - fm) : WGM;
        u.pm = fm + ((wgid % nig) % gsz); u.pn = (wgid % nig) / gsz; return true;
    }
    __device__ __forceinline__ void a_ready(const Unit&) const {}
    __device__ __forceinline__ void done(const Unit&) const {}
};

__device__ __forceinline__ unsigned cvt_pk_bf16(float lo, float hi) { unsigned r; asm volatile("v_cvt_pk_bf16_f32 %0, %1, %2" : "=v"(r) : "v"(lo), "v"(hi)); return r; }
typedef float f32x2 __attribute__((ext_vector_type(2)));
__device__ __forceinline__ f32x2 gelu_pk(f32x2 v) {
    const f32x2 av = __builtin_elementwise_abs(v), d = av * 0.2316418882f + 1.0f;
    f32x2 t; t.x = __builtin_amdgcn_rcpf(d.x); t.y = __builtin_amdgcn_rcpf(d.y);
    f32x2 q = t * 0.5307027145f + (-0.7265760135f); q = q * t + 0.7107068705f; q = q * t + (-0.142248368f); q = q * t + 0.127414796f; q = q * t;
    const f32x2 s = (v * v) * (-0.72134752044f);
    f32x2 e; e.x = __builtin_amdgcn_exp2f(s.x); e.y = __builtin_amdgcn_exp2f(s.y);
    const f32x2 m = v * (q * e), r = v - m;
    f32x2 o; o.x = v.x < 0.f ? m.x : r.x; o.y = v.y < 0.f ? m.y : r.y; return o;
}

template <int ACT  > struct EpiBf16 {
    static constexpr bool PERM = true, AFTER_DRAIN = false; static_assert(ACT == 0 || ACT == 1, "EpiBf16: ACT is 0 (none) or 1 (gelu_pk)");
    PG8_GAS bf16_t* O; int ldc; const PG8_GAS float* bias; int split_cols; size_t split_stride; float scale0;
    __device__ __forceinline__ void operator()(const f32x4 (&acc)[2][2][4][2], const Unit& u, int wr, int wc, int fr, int fq) const {
        const int row0 = u.pm * BM + wr * 64 + fr; int colt = u.pn * BM; PG8_GAS bf16_t* base = O;
        float sc = 1.f; if (split_cols) { const int t = colt / split_cols; base += (size_t)t * split_stride; colt -= t * split_cols; if (t == 0) sc = scale0; }
        const int col0 = colt + wc * 32 + 8 * fq, bcol0 = u.pn * BM + wc * 32 + 8 * fq;
        f32x4 bv[2][2];
#pragma unroll
        for (int bj = 0; bj < 2; ++bj)
#pragma unroll
            for (int n = 0; n < 2; ++n) bv[bj][n] = bias ? *(const PG8_GAS f32x4*)(bias + bcol0 + bj * HALF + 4 * n) : (f32x4){0.f, 0.f, 0.f, 0.f};
#pragma unroll
        for (int ai = 0; ai < 2; ++ai)
#pragma unroll
            for (int m = 0; m < 4; ++m) { PG8_GAS bf16_t* rowp = base + (size_t)(row0 + ai * HALF + m * 16) * ldc + col0;
#pragma unroll
                for (int bj = 0; bj < 2; ++bj) { f32x4 v0 = acc[ai][bj][m][0] + bv[bj][0], v1 = acc[ai][bj][m][1] + bv[bj][1];
                    if (ACT == 1) { f32x2 a = gelu_pk((f32x2){v0[0], v0[1]}), b = gelu_pk((f32x2){v0[2], v0[3]}), c = gelu_pk((f32x2){v1[0], v1[1]}), d = gelu_pk((f32x2){v1[2], v1[3]});
                        v0 = (f32x4){a.x, a.y, b.x, b.y}; v1 = (f32x4){c.x, c.y, d.x, d.y}; }
                    v0 = v0 * sc; v1 = v1 * sc; u32x4 w; w.x = cvt_pk_bf16(v0[0], v0[1]); w.y = cvt_pk_bf16(v0[2], v0[3]); w.z = cvt_pk_bf16(v1[0], v1[1]); w.w = cvt_pk_bf16(v1[2], v1[3]);
                    *(PG8_GAS u32x4*)(rowp + bj * HALF) = w; } }
    }
};

struct EpiF32 {
    static constexpr bool PERM = false, AFTER_DRAIN = false;
    PG8_GAS float* C; int ldc;
    __device__ __forceinline__ void operator()(const f32x4 (&acc)[2][2][4][2], const Unit& u, int wr, int wc, int fr, int fq) const {
        const int row0 = u.pm * BM + wr * 64 + fr, col0 = u.pn * BM + wc * 32 + 4 * fq;
#pragma unroll
        for (int ai = 0; ai < 2; ++ai)
#pragma unroll
            for (int m = 0; m < 4; ++m) { PG8_GAS float* rowp = C + (size_t)(row0 + ai * HALF + m * 16) * ldc + col0;
#pragma unroll
                for (int bj = 0; bj < 2; ++bj)
#pragma unroll
                    for (int n = 0; n < 2; ++n) *(PG8_GAS f32x4*)(rowp + bj * HALF + n * 16) = acc[ai][bj][m][n]; }
    }
};
__device__ __forceinline__ float bf_lo(unsigned w) { return __uint_as_float(w << 16); }
__device__ __forceinline__ float bf_hi(unsigned w) { return __uint_as_float(w & 0xffff0000u); }
__device__ __forceinline__ float sigmoidf_(float x) { return __builtin_amdgcn_rcpf(1.0f + __expf(-x)); }
struct EpiIn {
    static constexpr bool PERM = true, AFTER_DRAIN = false;
    PG8_GAS bf16_t* P; int ldp; const PG8_GAS float* bgate; int gate_tile0;
    __device__ __forceinline__ void operator()(const f32x4 (&acc)[2][2][4][2], const Unit& u, int wr, int wc, int fr, int fq) const {
        const int row0 = u.pm * BM + wr * 64 + fr, colt = u.pn * BM + wc * 32 + 8 * fq;
        {
            const bool gate = u.pn >= gate_tile0;
            f32x4 bv[2][2];
#pragma unroll
            for (int bj = 0; bj < 2; ++bj)
#pragma unroll
                for (int n = 0; n < 2; ++n) bv[bj][n] = gate ? *(const PG8_GAS f32x4*)(bgate + (colt - gate_tile0 * BM) + bj * HALF + 4 * n) : (f32x4){0.f, 0.f, 0.f, 0.f};
#pragma unroll
            for (int ai = 0; ai < 2; ++ai)
#pragma unroll
                for (int m = 0; m < 4; ++m) { PG8_GAS bf16_t* rowp = P + (size_t)(row0 + ai * HALF + m * 16) * ldp + colt;
#pragma unroll
                    for (int bj = 0; bj < 2; ++bj) { f32x4 v0 = acc[ai][bj][m][0] + bv[bj][0], v1 = acc[ai][bj][m][1] + bv[bj][1];
                        if (gate) {
#pragma unroll
                            for (int j = 0; j < 4; ++j) { v0[j] = sigmoidf_(v0[j]); v1[j] = sigmoidf_(v1[j]); } }
                        u32x4 w; w.x = cvt_pk_bf16(v0[0], v0[1]); w.y = cvt_pk_bf16(v0[2], v0[3]); w.z = cvt_pk_bf16(v1[0], v1[1]); w.w = cvt_pk_bf16(v1[2], v1[3]);
                        *(PG8_GAS u32x4*)(rowp + bj * HALF) = w; } }
        }
    }
};
struct EpiGateMul {
    static constexpr bool PERM = true, AFTER_DRAIN = false;
    PG8_GAS float* MG; int ldc; const PG8_GAS bf16_t* G; int ldg;
    __device__ __forceinline__ void operator()(const f32x4 (&acc)[2][2][4][2], const Unit& u, int wr, int wc, int fr, int fq) const {
        const int row0 = u.pm * BM + wr * 64 + fr, colt = u.pn * BM + wc * 32 + 8 * fq;
#pragma unroll
        for (int ai = 0; ai < 2; ++ai)
#pragma unroll
            for (int m = 0; m < 4; ++m) { const size_t row = (size_t)(row0 + ai * HALF + m * 16);
#pragma unroll
                for (int bj = 0; bj < 2; ++bj) { const u32x4 g = *(const PG8_GAS u32x4*)(G + row * ldg + colt + bj * HALF);
                    f32x4 v0 = acc[ai][bj][m][0], v1 = acc[ai][bj][m][1];
                    v0[0] *= bf_lo(g.x); v0[1] *= bf_hi(g.x); v0[2] *= bf_lo(g.y); v0[3] *= bf_hi(g.y);
                    v1[0] *= bf_lo(g.z); v1[1] *= bf_hi(g.z); v1[2] *= bf_lo(g.w); v1[3] *= bf_hi(g.w);
                    PG8_GAS float* o = MG + row * ldc + colt + bj * HALF; *(PG8_GAS f32x4*)o = v0; *(PG8_GAS f32x4*)(o + 4) = v1; } }
    }
};
struct EpiGateAdd {
    static constexpr bool PERM = true, AFTER_DRAIN = false;
    const PG8_GAS float* MG; PG8_GAS bf16_t* O; int ldc; const PG8_GAS bf16_t* G; int ldg;
    __device__ __forceinline__ void operator()(const f32x4 (&acc)[2][2][4][2], const Unit& u, int wr, int wc, int fr, int fq) const {
        const int row0 = u.pm * BM + wr * 64 + fr, colt = u.pn * BM + wc * 32 + 8 * fq;
#pragma unroll
        for (int ai = 0; ai < 2; ++ai)
#pragma unroll
            for (int m = 0; m < 4; ++m) { const size_t row = (size_t)(row0 + ai * HALF + m * 16);
#pragma unroll
                for (int bj = 0; bj < 2; ++bj) { const u32x4 g = *(const PG8_GAS u32x4*)(G + row * ldg + colt + bj * HALF);
                    const PG8_GAS float* mi = MG + row * ldc + colt + bj * HALF; f32x4 v0 = *(const PG8_GAS f32x4*)mi, v1 = *(const PG8_GAS f32x4*)(mi + 4);
                    const f32x4 a0 = acc[ai][bj][m][0], a1 = acc[ai][bj][m][1];
                    v0[0] += a0[0] * bf_lo(g.x); v0[1] += a0[1] * bf_hi(g.x); v0[2] += a0[2] * bf_lo(g.y); v0[3] += a0[3] * bf_hi(g.y);
                    v1[0] += a1[0] * bf_lo(g.z); v1[1] += a1[1] * bf_hi(g.z); v1[2] += a1[2] * bf_lo(g.w); v1[3] += a1[3] * bf_hi(g.w);
                    u32x4 w; w.x = cvt_pk_bf16(v0[0], v0[1]); w.y = cvt_pk_bf16(v0[2], v0[3]); w.z = cvt_pk_bf16(v1[0], v1[1]); w.w = cvt_pk_bf16(v1[2], v1[3]);
                    *(PG8_GAS u32x4*)(O + row * ldc + colt + bj * HALF) = w; } }
    }
};
template <class Epi, class Sched, bool ALIGN_EPI = false, bool SP2 = false>
__device__ __forceinline__ void gemm_phase(PG8_LAS unsigned char* lds, const Gemm g, const Sched& S, const Epi& E) {
    int tid = threadIdx.x; asm volatile("" : "+v"(tid));
    const int wid = __builtin_amdgcn_readfirstlane(tid >> 6), lane = tid & 63, wr = wid >> 2, wc = wid & 3, fr = lane & 15, fq = lane >> 4;
    const int K = g.K, nt = K / BK;
    unsigned voffA[2], voffB[2];
#pragma unroll
    for (int i = 0; i < 2; ++i) { int R, C; stage_rc(tid * 16 + i * 8192, R, C); const int Rb = Epi::PERM ? ((R & ~31) + perm32(R & 31)) : R;
        voffA[i] = (unsigned)(R * K + C) * 2u; voffB[i] = (unsigned)(Rb * K + C) * 2u; }
    const size_t kstep = (size_t)(BK * 2);
    const size_t hstep = (size_t)HALF * K * 2;
    const size_t tstep = 2 * hstep;
    const unsigned ldsw = (unsigned)wid * 1024u;
    const int aoff = lds_byte(wr * 64 + fr, fq * 8), boff = lds_byte(wc * 32 + fr, fq * 8);
#define PG8_SA(b, h) (((b) * 2 + (h)) * HTB)
#define PG8_SB(b, h) ((4 + (b) * 2 + (h)) * HTB)
#define PG8_STAGE(bufoff, gbase, voff) do { _Pragma("unroll") for (int _i = 0; _i < 2; ++_i) \
        __builtin_amdgcn_global_load_lds((const PG8_GAS unsigned*)((const PG8_GAS char*)(gbase) + (voff)[_i]), (PG8_LAS unsigned*)(lds + (bufoff) + ldsw + _i * 8192), 16, 0, 0); } while (0)
#define PG8_LDA(dst, b, h) do { _Pragma("unroll") for (int m = 0; m < 4; ++m) _Pragma("unroll") for (int k = 0; k < 2; ++k) dst[m][k] = *(const PG8_LAS bf16x8*)(lds + PG8_SA(b, h) + aoff + m * 2048 + k * 1024); } while (0)
#define PG8_LDB(dst, b, h) do { _Pragma("unroll") for (int n = 0; n < 2; ++n) _Pragma("unroll") for (int k = 0; k < 2; ++k) dst[n][k] = *(const PG8_LAS bf16x8*)(lds + PG8_SB(b, h) + boff + n * 2048 + k * 1024); } while (0)
#define PG8_MMA(ai, bj, At, Bt) do { __builtin_amdgcn_s_setprio(1); _Pragma("unroll") for (int m = 0; m < 4; ++m) _Pragma("unroll") for (int n = 0; n < 2; ++n) _Pragma("unroll") for (int k = 0; k < 2; ++k) \
        acc[ai][bj][m][n] = __builtin_amdgcn_mfma_f32_16x16x32_bf16(Bt[n][k], At[m][k], acc[ai][bj][m][n], 0, 0, 0); __builtin_amdgcn_s_setprio(0); } while (0)
#define PG8_WAIT_V(n) asm volatile("s_waitcnt vmcnt(" #n ")" ::: "memory")
#define PG8_WAIT_L(n) asm volatile("s_waitcnt lgkmcnt(" #n ")" ::: "memory")
#define PG8_BAR __builtin_amdgcn_s_barrier()
#define PG8_SCHED __builtin_amdgcn_sched_barrier(0)
    Unit cur, nxt; int ui = 0;
    if (!S.next(0, cur)) return;
    f32x4 acc[2][2][4][2];
#pragma unroll
    for (int a = 0; a < 2; ++a)
#pragma unroll
        for (int b = 0; b < 2; ++b)
#pragma unroll
            for (int m = 0; m < 4; ++m)
#pragma unroll
                for (int n = 0; n < 2; ++n) acc[a][b][m][n] = (f32x4){0.f, 0.f, 0.f, 0.f};
    bf16x8 At[4][2], B0[2][2], B1[2][2];
    const PG8_GAS char* cA = (const PG8_GAS char*)g.A + (size_t)cur.pm * tstep; const PG8_GAS char* cB = (const PG8_GAS char*)g.Bt + (size_t)cur.pn * tstep;
    S.a_ready(cur);
    if constexpr (SP2) {
        PG8_STAGE(PG8_SB(0, 0), cB, voffB); PG8_STAGE(PG8_SB(0, 1), cB + hstep, voffB); PG8_STAGE(PG8_SA(0, 0), cA, voffA); PG8_STAGE(PG8_SA(0, 1), cA + hstep, voffA);
        if (wr == 1) PG8_BAR;
        PG8_WAIT_V(2); PG8_BAR;
        PG8_STAGE(PG8_SB(1, 0), cB + kstep, voffB); PG8_STAGE(PG8_SA(1, 0), cA + kstep, voffA); PG8_STAGE(PG8_SB(1, 1), cB + hstep + kstep, voffB);
        PG8_WAIT_V(6); PG8_BAR;
    } else {
        PG8_STAGE(PG8_SB(0, 0), cB, voffB); PG8_STAGE(PG8_SA(0, 0), cA, voffA); PG8_STAGE(PG8_SB(0, 1), cB + hstep, voffB); PG8_STAGE(PG8_SA(0, 1), cA + hstep, voffA);
        if (wr == 1) PG8_BAR;
        PG8_WAIT_V(4); PG8_BAR;
        PG8_STAGE(PG8_SB(1, 0), cB + kstep, voffB); PG8_STAGE(PG8_SA(1, 0), cA + kstep, voffA); PG8_STAGE(PG8_SB(1, 1), cB + hstep + kstep, voffB);
        PG8_WAIT_V(6); PG8_BAR;
    }
    for (;;) {
        const bool has_next = S.next(ui + 1, nxt);
        const PG8_GAS char* nA = has_next ? (const PG8_GAS char*)g.A + (size_t)nxt.pm * tstep : cA; const PG8_GAS char* nB = has_next ? (const PG8_GAS char*)g.Bt + (size_t)nxt.pn * tstep : cB;
        for (int t = 0; t < nt; t += 2) {
            const bool last = (t == nt - 2);
            const PG8_GAS char* a1 = cA + (size_t)(t + 1) * kstep;
            const PG8_GAS char* a2 = last ? nA : cA + (size_t)(t + 2) * kstep; const PG8_GAS char* b2 = last ? nB : cB + (size_t)(t + 2) * kstep;
            const PG8_GAS char* a3 = a2 + kstep; const PG8_GAS char* b3 = b2 + kstep;
            if (last && has_next) S.a_ready(nxt);
            if constexpr (SP2) {
            PG8_LDB(B0, 0, 0); PG8_LDB(B1, 0, 1); PG8_SCHED; PG8_LDA(At, 0, 0); PG8_STAGE(PG8_SA(1, 1), a1 + hstep, voffA);
            PG8_WAIT_V(8); PG8_WAIT_L(0); PG8_BAR; PG8_MMA(0, 0, At, B0); PG8_MMA(0, 1, At, B1); PG8_BAR; PG8_SCHED;
            PG8_LDA(At, 0, 1); PG8_STAGE(PG8_SB(0, 0), b2, voffB); PG8_STAGE(PG8_SB(0, 1), b2 + hstep, voffB); PG8_STAGE(PG8_SA(0, 0), a2, voffA);
            PG8_WAIT_V(8); PG8_WAIT_L(0); PG8_BAR; PG8_MMA(1, 0, At, B0); PG8_MMA(1, 1, At, B1); PG8_BAR; PG8_SCHED;
            PG8_LDB(B0, 1, 0); PG8_LDB(B1, 1, 1); PG8_SCHED; PG8_LDA(At, 1, 0); PG8_STAGE(PG8_SA(0, 1), a2 + hstep, voffA);
            PG8_WAIT_V(8); PG8_WAIT_L(0); PG8_BAR; PG8_MMA(0, 0, At, B0); PG8_MMA(0, 1, At, B1); PG8_BAR; PG8_SCHED;
            PG8_LDA(At, 1, 1); PG8_STAGE(PG8_SB(1, 0), b3, voffB); PG8_STAGE(PG8_SB(1, 1), b3 + hstep, voffB); PG8_STAGE(PG8_SA(1, 0), a3, voffA);
            PG8_WAIT_V(8); PG8_WAIT_L(0); PG8_BAR; PG8_MMA(1, 0, At, B0); PG8_MMA(1, 1, At, B1); PG8_BAR; PG8_SCHED;
            } else {
            PG8_LDB(B0, 0, 0); PG8_SCHED; PG8_LDA(At, 0, 0); PG8_STAGE(PG8_SA(1, 1), a1 + hstep, voffA);
            PG8_WAIT_L(8); PG8_BAR; PG8_WAIT_L(0); PG8_MMA(0, 0, At, B0); PG8_BAR; PG8_SCHED;
            PG8_LDB(B1, 0, 1); PG8_STAGE(PG8_SB(0, 0), b2, voffB);
            PG8_BAR; PG8_WAIT_L(0); PG8_MMA(0, 1, At, B1); PG8_BAR;
            PG8_LDA(At, 0, 1); PG8_STAGE(PG8_SA(0, 0), a2, voffA);
            PG8_BAR; PG8_WAIT_L(0); PG8_MMA(1, 0, At, B0); PG8_BAR; PG8_SCHED;
            PG8_STAGE(PG8_SB(0, 1), b2 + hstep, voffB);
            PG8_WAIT_V(6); PG8_BAR; PG8_MMA(1, 1, At, B1); PG8_BAR;
            PG8_LDB(B0, 1, 0); PG8_SCHED; PG8_LDA(At, 1, 0); PG8_STAGE(PG8_SA(0, 1), a2 + hstep, voffA);
            PG8_WAIT_L(8); PG8_BAR; PG8_WAIT_L(0); PG8_MMA(0, 0, At, B0); PG8_BAR; PG8_SCHED;
            PG8_LDB(B1, 1, 1); PG8_STAGE(PG8_SB(1, 0), b3, voffB);
            PG8_BAR; PG8_WAIT_L(0); PG8_MMA(0, 1, At, B1); PG8_BAR;
            PG8_LDA(At, 1, 1); PG8_STAGE(PG8_SA(1, 0), a3, voffA);
            PG8_BAR; PG8_WAIT_L(0); PG8_MMA(1, 0, At, B0); PG8_BAR; PG8_SCHED;
            PG8_STAGE(PG8_SB(1, 1), b3 + hstep, voffB);
            PG8_WAIT_V(6); PG8_BAR; PG8_MMA(1, 1, At, B1); PG8_BAR;
            }
        }
        if constexpr (ALIGN_EPI) { if (wr == 0) PG8_BAR; }
        if constexpr (!Epi::AFTER_DRAIN) { E(acc, cur, wr, wc, fr, fq); S.done(cur); }
        if (!has_next) break;
#pragma unroll
        for (int a = 0; a < 2; ++a)
#pragma unroll
            for (int b = 0; b < 2; ++b)
#pragma unroll
                for (int m = 0; m < 4; ++m)
#pragma unroll
                    for (int n = 0; n < 2; ++n) acc[a][b][m][n] = (f32x4){0.f, 0.f, 0.f, 0.f};
        cur = nxt; cA = nA; cB = nB; ++ui;
        if constexpr (ALIGN_EPI) { if (wr == 1) PG8_BAR; }
    }
    PG8_WAIT_V(0);
    if constexpr (!ALIGN_EPI) { if (wr == 0) PG8_BAR; }
    PG8_BAR;
    if constexpr (Epi::AFTER_DRAIN) { E.fused(acc, cur, wr, wc, fr, fq, lds, wid, lane); S.done(cur); }
#undef PG8_SA
#undef PG8_SB
#undef PG8_STAGE
#undef PG8_LDA
#undef PG8_LDB
#undef PG8_MMA
#undef PG8_WAIT_V
#undef PG8_WAIT_L
#undef PG8_BAR
#undef PG8_SCHED
}
}

#ifndef MK_PER_PHASE
#define MK_PER_PHASE 0
#endif
#ifndef PROBE_DOUBLE
#define PROBE_DOUBLE -1
#endif
#define REP(id) for (int rep_ = 0; rep_ < ((PROBE_DOUBLE == (id)) ? 2 : 1); ++rep_)
constexpr int NWAVES = 8, NTHR = 512;
constexpr int BATCH = 2, SEQ = 4096, M = BATCH * SEQ, D = 2048, DEPTH = 4;
constexpr int DI = 4096, NH = 64, HP = 64, NG = 8, HPG = 8, NS = 128, CONVD = 6144;
constexpr int QH = 16, KVH = 4, AD = 128, IH = 16, IDD = 64, TOPK = 256;
constexpr int FF = 4096, FF2 = 8192;
constexpr int NIN = 18576, NMAIN = 18432, NPAD = 18688;
constexpr int PZ = 0, PXBC = 4096, PQ = 10240, PK = 12288, PV = 12800, PQI = 13312, PG = 14336;
constexpr int SMW = 256, SM_DT = 0, SM_KI = 64, SM_WI = 128;
constexpr float EPS = 1e-6f;
constexpr float ATTN_SCALE = 0.08838834764831845f;

constexpr size_t MiB = 1u << 20;
constexpr size_t WS_CTL = 0, CTL_ZERO_BYTES = 1 * MiB;
constexpr size_t WS_W = 2 * MiB;
constexpr size_t WL_IN = 0, WL_SSM = 73 * MiB, WL_ATT = 89 * MiB, WL_MIX = 97 * MiB, WL_UP = 105 * MiB, WL_DN = 137 * MiB, WL_SIZE = 153 * MiB;
constexpr size_t WS_H = WS_W + DEPTH * WL_SIZE;
constexpr size_t WS_P = WS_H + 32 * MiB;
constexpr size_t WS_SM = WS_P + 288 * MiB;
constexpr size_t WS_XC = WS_SM + 8 * MiB;
constexpr size_t WS_DT = WS_XC + 96 * MiB;
constexpr size_t WS_ACS = WS_DT + 2 * MiB;
constexpr size_t WS_ST = WS_ACS + 2 * MiB;
constexpr size_t WS_Y = WS_ST + 256 * MiB;
constexpr size_t WS_SC = WS_Y + 64 * MiB;
constexpr size_t WS_IDX = WS_SC + 128 * MiB;
constexpr size_t WS_CNT = WS_IDX + 8 * MiB;
constexpr size_t WS_AO = WS_CNT + 1 * MiB;
constexpr size_t WS_MG = WS_AO + 32 * MiB;
constexpr size_t WS_MGB = WS_MG + 64 * MiB;
constexpr size_t WS_YM = WS_MGB + 32 * MiB;
constexpr size_t WS_U = WS_YM + 64 * MiB;
constexpr size_t WS_ACT = WS_U + 128 * MiB;
constexpr size_t WS_KIB = WS_ACT + 64 * MiB;
constexpr size_t WS_END = WS_KIB + 1 * MiB;
constexpr int CW_BAR = 4096;

constexpr int RING_BYTES = 139264, LDSCTL_OFF = RING_BYTES, MISC_OFF = LDSCTL_OFF + 320, LDS_BYTES = 147456;

#define LAS __attribute__((address_space(3)))
#define GAS __attribute__((address_space(1)))
typedef unsigned short bf16;
typedef float f32x4 __attribute__((ext_vector_type(4)));
typedef short bf16x8 __attribute__((ext_vector_type(8)));
typedef unsigned u32x4 __attribute__((ext_vector_type(4)));
typedef unsigned u32x2 __attribute__((ext_vector_type(2)));
#define LDS_WAIT() asm volatile("s_waitcnt lgkmcnt(0)" ::: "memory")

__device__ __forceinline__ unsigned f2bf(float f) { unsigned u = __builtin_bit_cast(unsigned, f); return (u + 0x7fffu + ((u >> 16) & 1u)) >> 16; }
__device__ __forceinline__ unsigned pk2(float lo, float hi) { return f2bf(lo) | (f2bf(hi) << 16); }
__device__ __forceinline__ unsigned cvtpk(float lo, float hi) { unsigned r; asm("v_cvt_pk_bf16_f32 %0, %1, %2" : "=v"(r) : "v"(lo), "v"(hi)); return r; }
__device__ __forceinline__ float bflo(unsigned w) { return __uint_as_float(w << 16); }
__device__ __forceinline__ float bfhi(unsigned w) { return __uint_as_float(w & 0xffff0000u); }
__device__ __forceinline__ void unpack8(const u32x4 w, float (&f)[8]) { f[0] = bflo(w.x); f[1] = bfhi(w.x); f[2] = bflo(w.y); f[3] = bfhi(w.y); f[4] = bflo(w.z); f[5] = bfhi(w.z); f[6] = bflo(w.w); f[7] = bfhi(w.w); }
__device__ __forceinline__ u32x4 pack8(const float (&f)[8]) { u32x4 w; w.x = pk2(f[0], f[1]); w.y = pk2(f[2], f[3]); w.z = pk2(f[4], f[5]); w.w = pk2(f[6], f[7]); return w; }
__device__ __forceinline__ float wave_sum(float v) {
#pragma unroll
    for (int o = 1; o < 64; o <<= 1) v += __shfl_xor(v, o);
    return v;
}
__device__ __forceinline__ float wave_max(float v) {
#pragma unroll
    for (int o = 1; o < 64; o <<= 1) v = fmaxf(v, __shfl_xor(v, o));
    return v;
}
__device__ __forceinline__ float siluf_(float x) { return x / (1.0f + __expf(-x)); }

#define XB_TMO      128
#define XB_XCNT(j)  (256  + 64 * (j))
#define XB_XSUB(j)  (1280 + 64 * (j))
#define XB_XGEN(j)  (2304 + 64 * (j))
#define XB_TOP      3328
#define XB_TOPGEN   3392
#define XCD_BAR_WORDS 3456
#define XB_SPIN_CAP (1u << 18)

__device__ __forceinline__ unsigned xb_ld(unsigned* p)              { return __hip_atomic_load(p, __ATOMIC_RELAXED, __HIP_MEMORY_SCOPE_AGENT); }
__device__ __forceinline__ unsigned xb_add(unsigned* p, unsigned v) { return __hip_atomic_fetch_add(p, v, __ATOMIC_RELAXED, __HIP_MEMORY_SCOPE_AGENT); }
__device__ __forceinline__ unsigned xb_xcc_id() { return (unsigned)__builtin_amdgcn_s_getreg((3 << 11) | 20) & 0xFu; }
#define XB_SPIN(cond, bar) do { unsigned _sp = 0; while (cond) { __builtin_amdgcn_s_sleep(1); \
    if ((++_sp & 255u) == 0u) { if (xb_ld(&(bar)[XB_TMO])) break; if (_sp > XB_SPIN_CAP) { atomicAdd(&(bar)[XB_TMO], 1u); break; } } } } while (0)

struct XcdBarrier {
    unsigned* bar; unsigned x;
    volatile LAS unsigned* st;
};

__device__ __forceinline__ XcdBarrier xcd_barrier_post(unsigned* bar, volatile LAS unsigned* st) {
    XcdBarrier b; b.bar = bar; b.x = xb_xcc_id(); b.st = st;
    if (threadIdx.x == 0) (void)xb_add(&bar[XB_XCNT(b.x)], 1u);
    return b;
}
__device__ __forceinline__ void xcd_barrier_complete(unsigned* bar, unsigned x, unsigned& nloc, unsigned& nx) {
    const unsigned G = gridDim.x * gridDim.y * gridDim.z;
    unsigned sum, cnt, mine, sp = 0u;
    for (;;) {
        sum = 0u; cnt = 0u; mine = 0u;
#pragma unroll
        for (unsigned j = 0; j < 16; ++j) { const unsigned c = xb_ld(&bar[XB_XCNT(j)]); sum += c; cnt += (c > 0u) ? 1u : 0u; mine = (j == x) ? c : mine; }
        if (sum == G) break;
        __builtin_amdgcn_s_sleep(1);
        if ((++sp & 255u) == 0u) { if (xb_ld(&bar[XB_TMO])) break; if (sp > XB_SPIN_CAP) { atomicAdd(&bar[XB_TMO], 1u); break; } }
    }
    nloc = mine > 0u ? mine : 1u; nx = cnt > 0u ? cnt : 1u;
}

__device__ __forceinline__ void xcd_barrier(const XcdBarrier& b) {
    asm volatile("s_waitcnt vmcnt(0)" ::: "memory");
    __syncthreads();
    if (threadIdx.x == 0) {
        unsigned* bar = b.bar;
        __builtin_amdgcn_s_waitcnt(0);
        unsigned nloc = b.st[0], nx = b.st[1];
        if (nloc == 0u) { xcd_barrier_complete(bar, b.x, nloc, nx); b.st[0] = nloc; b.st[1] = nx; }
        const unsigned old = xb_add(&bar[XB_XSUB(b.x)], 1u);
        const unsigned gen = old / nloc;
        if (old + 1u == (gen + 1u) * nloc) {
            __builtin_amdgcn_fence(__ATOMIC_RELEASE, "agent");
            asm volatile("s_waitcnt vmcnt(0)" ::: "memory");
            const unsigned og = xb_add(&bar[XB_TOP], 1u);
            const unsigned tg = og / nx;
            if (og + 1u == (tg + 1u) * nx) xb_add(&bar[XB_TOPGEN], 1u);
            else XB_SPIN(xb_ld(&bar[XB_TOPGEN]) == tg, bar);
            __builtin_amdgcn_fence(__ATOMIC_ACQUIRE, "agent");
            xb_add(&bar[XB_XGEN(b.x)], 1u);
            asm volatile("s_waitcnt vmcnt(0)" ::: "memory");
        } else {
            XB_SPIN(xb_ld(&bar[XB_XGEN(b.x)]) == gen, bar);
            __builtin_amdgcn_fence(__ATOMIC_ACQUIRE, "agent");
            asm volatile("s_waitcnt vmcnt(0)" ::: "memory");
        }
    }
    __syncthreads();
}


__device__ __forceinline__ void ph_resid_norm(const GAS float* Yin, const GAS float* gpost, const GAS float* gnext, const GAS float* Xin, GAS float* X, GAS bf16* H, int gw, int ngw, int lane) {
    for (int m = gw; m < M; m += ngw) {
        const GAS f32x4* xr = (const GAS f32x4*)(Xin + (size_t)m * D) + lane;
        f32x4 xv[8];
#pragma unroll
        for (int j = 0; j < 8; ++j) xv[j] = xr[64 * j];
        if (Yin) {
            const GAS f32x4* yr = (const GAS f32x4*)(Yin + (size_t)m * D) + lane; f32x4 yv[8]; float ss = 0.f;
#pragma unroll
            for (int j = 0; j < 8; ++j) { yv[j] = yr[64 * j]; ss += (yv[j].x * yv[j].x + yv[j].y * yv[j].y) + (yv[j].z * yv[j].z + yv[j].w * yv[j].w); }
            const float rstd = rsqrtf(wave_sum(ss) * (1.0f / D) + EPS);
#pragma unroll
            for (int j = 0; j < 8; ++j) { const f32x4 g = ((const GAS f32x4*)gpost + lane)[64 * j]; xv[j] = xv[j] + yv[j] * rstd * g; }
        }
        if (Yin || Xin != X) { GAS f32x4* xo = (GAS f32x4*)(X + (size_t)m * D) + lane;
#pragma unroll
            for (int j = 0; j < 8; ++j) xo[64 * j] = xv[j]; }
        if (gnext) {
            float ss = 0.f;
#pragma unroll
            for (int j = 0; j < 8; ++j) ss += (xv[j].x * xv[j].x + xv[j].y * xv[j].y) + (xv[j].z * xv[j].z + xv[j].w * xv[j].w);
            const float rstd = rsqrtf(wave_sum(ss) * (1.0f / D) + EPS);
            GAS u32x2* ho = (GAS u32x2*)(H + (size_t)m * D) + lane;
#pragma unroll
            for (int j = 0; j < 8; ++j) { const f32x4 g = ((const GAS f32x4*)gnext + lane)[64 * j]; const f32x4 h = xv[j] * rstd * g; u32x2 w; w.x = pk2(h.x, h.y); w.y = pk2(h.z, h.w); ho[64 * j] = w; }
        }
    }
}

__device__ __forceinline__ void tr_item(const GAS float* W, int ldw, int K, int k0, int nsrc, int ncols, GAS bf16* WT, int ndst, LAS float* scr, int lane) {
    const int j = lane & 31;
#pragma unroll 8
    for (int i = 0; i < 32; ++i) { const int kk = 2 * i + (lane >> 5); scr[kk * 33 + j] = (j < ncols) ? W[(size_t)(k0 + kk) * ldw + nsrc + j] : 0.f; }
    LDS_WAIT();
    const int c = lane & 7;
#pragma unroll
    for (int jj = 0; jj < 4; ++jj) { const int n = (lane >> 3) + 8 * jj; const LAS float* s = scr + (8 * c) * 33 + n;
        u32x4 o; o.x = pk2(s[0 * 33], s[1 * 33]); o.y = pk2(s[2 * 33], s[3 * 33]); o.z = pk2(s[4 * 33], s[5 * 33]); o.w = pk2(s[6 * 33], s[7 * 33]);
        *(GAS u32x4*)(WT + (size_t)(ndst + n) * K + k0 + 8 * c) = o; }
    LDS_WAIT();
}
__device__ __forceinline__ void win_map(int dstrow, int& src, int& ncols) {
    ncols = 32;
    if (dstrow < 10240) src = dstrow;
    else if (dstrow < 12288) src = dstrow - 10240 + 10304;
    else if (dstrow < 12800) src = dstrow - 12288 + 12352;
    else if (dstrow < 13312) src = dstrow - 12800 + 12864;
    else if (dstrow < 14336) src = dstrow - 13312 + 13376;
    else if (dstrow < 18432) src = dstrow - 14336 + 14480;
    else if (dstrow < 18496) src = dstrow - 18432 + 10240;
    else if (dstrow < 18560) src = dstrow - 18496 + 14400;
    else if (dstrow == 18560) { src = 14464; ncols = 16; }
    else { src = 0; ncols = 0; }
}
struct WPtrs { const GAS float *w_in, *w_ssm, *w_att, *w_mix, *w_up, *w_dn; };
__device__ __forceinline__ void ph_weights(const WPtrs wp, GAS unsigned char* ws, LAS float* scr, int gw, int ngw, int lane) {
    constexpr int I_IN = (NPAD / 32) * (D / 64), I_SSM = (D / 32) * (DI / 64), I_ATT = (D / 32) * (D / 64), I_MIX = I_ATT, I_UP = (FF2 / 32) * (D / 64), I_DN = (D / 32) * (FF / 64);
    constexpr int I_L = I_IN + I_SSM + I_ATT + I_MIX + I_UP + I_DN;
    for (int it = gw; it < DEPTH * I_L; it += ngw) {
        const int layer = it / I_L; int r = it % I_L;
        GAS unsigned char* wl = ws + WS_W + (size_t)layer * WL_SIZE;
        if (r < I_IN) { const int nblk = NPAD / 32, kb = r / nblk, nb = r % nblk; int src, nc; win_map(nb * 32, src, nc);
            tr_item(wp.w_in + (size_t)layer * D * NIN, NIN, D, kb * 64, src, nc, (GAS bf16*)(wl + WL_IN), nb * 32, scr, lane); continue; }
        r -= I_IN;
        if (r < I_SSM) { const int nblk = D / 32, kb = r / nblk, nb = r % nblk; tr_item(wp.w_ssm + (size_t)layer * DI * D, D, DI, kb * 64, nb * 32, 32, (GAS bf16*)(wl + WL_SSM), nb * 32, scr, lane); continue; }
        r -= I_SSM;
        if (r < I_ATT) { const int nblk = D / 32, kb = r / nblk, nb = r % nblk; tr_item(wp.w_att + (size_t)layer * D * D, D, D, kb * 64, nb * 32, 32, (GAS bf16*)(wl + WL_ATT), nb * 32, scr, lane); continue; }
        r -= I_ATT;
        if (r < I_MIX) { const int nblk = D / 32, kb = r / nblk, nb = r % nblk; tr_item(wp.w_mix + (size_t)layer * D * D, D, D, kb * 64, nb * 32, 32, (GAS bf16*)(wl + WL_MIX), nb * 32, scr, lane); continue; }
        r -= I_MIX;
        if (r < I_UP) { const int nblk = FF2 / 32, kb = r / nblk, nb = r % nblk; tr_item(wp.w_up + (size_t)layer * D * FF2, FF2, D, kb * 64, nb * 32, 32, (GAS bf16*)(wl + WL_UP), nb * 32, scr, lane); continue; }
        r -= I_UP;
        { const int nblk = D / 32, kb = r / nblk, nb = r % nblk; tr_item(wp.w_dn + (size_t)layer * FF * D, D, FF, kb * 64, nb * 32, 32, (GAS bf16*)(wl + WL_DN), nb * 32, scr, lane); }
    }
}

__device__ __forceinline__ void ph_small_proj(const GAS bf16* H, const GAS bf16* Ws, GAS float* SM, GAS bf16* KIB, LAS unsigned char* lds, int blk, int nblk, int tid) {
    constexpr int HS = 4112;
    const int lane = tid & 63, wave = __builtin_amdgcn_readfirstlane(tid >> 6), g = lane >> 4, c16 = lane & 15;
    for (int rb = blk; rb < M / 32; rb += nblk) {
        __syncthreads();
#pragma unroll
        for (int i = 0; i < 16; ++i) { const int id = tid + 512 * i, r = id >> 8, ch = id & 255;
            *(LAS u32x4*)(lds + r * HS + ch * 16) = *(const GAS u32x4*)(H + (size_t)(rb * 32 + r) * D + ch * 8); }
        __syncthreads();
        f32x4 acc[2] = {(f32x4){0.f, 0.f, 0.f, 0.f}, (f32x4){0.f, 0.f, 0.f, 0.f}}, acc9[2] = {(f32x4){0.f, 0.f, 0.f, 0.f}, (f32x4){0.f, 0.f, 0.f, 0.f}};
        const GAS bf16* wrow = Ws + (size_t)(16 * wave + c16) * D + 8 * g;
        const GAS bf16* w9 = Ws + (size_t)(128 + c16) * D + 256 * wave + 8 * g;
        const LAS unsigned char* hb = lds + c16 * HS + g * 16;
#pragma unroll 8
        for (int ks = 0; ks < 64; ++ks) {
            const bf16x8 wf = *(const GAS bf16x8*)(wrow + 32 * ks);
            const bf16x8 h0 = *(const LAS bf16x8*)(hb + ks * 64), h1 = *(const LAS bf16x8*)(hb + 16 * HS + ks * 64);
            acc[0] = __builtin_amdgcn_mfma_f32_16x16x32_bf16(wf, h0, acc[0], 0, 0, 0); acc[1] = __builtin_amdgcn_mfma_f32_16x16x32_bf16(wf, h1, acc[1], 0, 0, 0);
        }
#pragma unroll
        for (int k8 = 0; k8 < 8; ++k8) { const int ks = 8 * wave + k8;
            const bf16x8 wf = *(const GAS bf16x8*)(w9 + 32 * k8);
            const bf16x8 h0 = *(const LAS bf16x8*)(hb + ks * 64), h1 = *(const LAS bf16x8*)(hb + 16 * HS + ks * 64);
            acc9[0] = __builtin_amdgcn_mfma_f32_16x16x32_bf16(wf, h0, acc9[0], 0, 0, 0); acc9[1] = __builtin_amdgcn_mfma_f32_16x16x32_bf16(wf, h1, acc9[1], 0, 0, 0);
        }
#pragma unroll
        for (int rt = 0; rt < 2; ++rt) { const size_t row = (size_t)(rb * 32 + 16 * rt + c16);
            *(GAS f32x4*)(SM + row * SMW + 16 * wave + 4 * g) = acc[rt];
            if (wave >= 4) { u32x2 w; w.x = cvtpk(acc[rt].x, acc[rt].y); w.y = cvtpk(acc[rt].z, acc[rt].w); *(GAS u32x2*)(KIB + row * IDD + 16 * (wave - 4) + 4 * g) = w; } }
        __syncthreads();
        *(LAS f32x4*)(lds + ((wave * 2 + 0) * 64 + lane) * 16) = acc9[0]; *(LAS f32x4*)(lds + ((wave * 2 + 1) * 64 + lane) * 16) = acc9[1];
        __syncthreads();
        if (wave < 2) { f32x4 s = (f32x4){0.f, 0.f, 0.f, 0.f};
#pragma unroll
            for (int w8 = 0; w8 < 8; ++w8) s += *(const LAS f32x4*)(lds + ((w8 * 2 + wave) * 64 + lane) * 16);
            *(GAS f32x4*)(SM + (size_t)(rb * 32 + 16 * wave + c16) * SMW + 128 + 4 * g) = s; }
    }
}

__device__ __forceinline__ void ph_index_scores(const GAS bf16* P, const GAS float* SM, const GAS bf16* KIB, GAS float* SC, LAS unsigned char* lds, int blk, int nblk, int tid) {
    constexpr int QS = 1040;
    const int lane = tid & 63, wave = __builtin_amdgcn_readfirstlane(tid >> 6);
    for (int u0 = blk; u0 < 256; u0 += nblk) {
#pragma unroll 1
        for (int half = 0; half < 2; ++half) {
            const int b = half, qt = half ? 255 - u0 : u0;
            const int q0 = b * SEQ + qt * 16, nkt = ((qt * 16) / 64 + 1) * 4;
            const int qrow = q0 + (lane & 15), kq = 8 * (lane >> 4);
            __syncthreads();
#pragma unroll
            for (int i = 0; i < 2; ++i) { const int id = tid + 512 * i, q = id >> 6, ch = id & 63;
                *(LAS u32x4*)(lds + q * QS + ch * 16) = *(const GAS u32x4*)(P + (size_t)(q0 + q) * NMAIN + PQI + 8 * IDD + ch * 8); }
            bf16x8 bq[8][2]; float w[IH];
#pragma unroll
            for (int h = 0; h < IH; ++h) {
                if (h < 8) {
#pragma unroll
                    for (int ks = 0; ks < 2; ++ks) bq[h][ks] = *(const GAS bf16x8*)(P + (size_t)qrow * NMAIN + PQI + h * IDD + ks * 32 + kq); }
                w[h] = SM[(size_t)qrow * SMW + SM_WI + h]; }
            __syncthreads();
            const LAS unsigned char* qb = lds + (lane & 15) * QS + kq * 2;
            for (int kt = wave; kt < nkt; kt += NWAVES) {
                const int key0 = kt * 16; const GAS bf16* kp = KIB + (size_t)(b * SEQ + key0 + (lane & 15)) * IDD + kq;
                const bf16x8 a0 = *(const GAS bf16x8*)kp, a1 = *(const GAS bf16x8*)(kp + 32);
                f32x4 sc = (f32x4){0.f, 0.f, 0.f, 0.f};
#pragma unroll
                for (int h = 0; h < IH; ++h) { f32x4 c = (f32x4){0.f, 0.f, 0.f, 0.f};
                    const bf16x8 b0 = h < 8 ? bq[h & 7][0] : *(const LAS bf16x8*)(qb + (h - 8) * 128), b1 = h < 8 ? bq[h & 7][1] : *(const LAS bf16x8*)(qb + (h - 8) * 128 + 64);
                    c = __builtin_amdgcn_mfma_f32_16x16x32_bf16(a0, b0, c, 0, 0, 0); c = __builtin_amdgcn_mfma_f32_16x16x32_bf16(a1, b1, c, 0, 0, 0);
                    sc.x += w[h] * fmaxf(c.x, 0.f); sc.y += w[h] * fmaxf(c.y, 0.f); sc.z += w[h] * fmaxf(c.z, 0.f); sc.w += w[h] * fmaxf(c.w, 0.f); }
                *(GAS f32x4*)(SC + (size_t)qrow * SEQ + key0 + 4 * (lane >> 4)) = sc;
            }
        }
    }
}

__device__ __forceinline__ void topk_bitwise(const GAS float* srow, GAS unsigned long long* mw, int limit, int lane) {
    unsigned u[64];
#pragma unroll
    for (int j = 0; j < 64; ++j) { const int key = j * 64 + lane; unsigned v = 0u;
        if (key < limit) { const unsigned bits = __float_as_uint(srow[key]); v = (bits & 0x80000000u) ? ~bits : (bits | 0x80000000u); }
        u[j] = v; }
    unsigned T = 0u;
#pragma unroll 1
    for (int bit = 31; bit >= 0; --bit) { const unsigned cand = T | (1u << bit); int cnt = 0;
#pragma unroll
        for (int j = 0; j < 64; ++j) cnt += __popcll(__ballot(u[j] >= cand));
        if (cnt >= TOPK) T = cand; }
    int cgt = 0;
#pragma unroll
    for (int j = 0; j < 64; ++j) cgt += __popcll(__ballot(u[j] > T));
    const int need_eq = TOPK - cgt; int eqbase = 0;
    const unsigned long long lt_mask = (1ull << lane) - 1ull;
#pragma unroll
    for (int j = 0; j < 64; ++j) {
        const bool gt = u[j] > T, eq = u[j] == T;
        const unsigned long long eqm = __ballot(eq);
        const bool take = gt || (eq && (eqbase + __popcll(eqm & lt_mask) < need_eq));
        const unsigned long long tm = __ballot(take);
        if (lane == 0 && j * 64 < limit) mw[j] = tm;
        eqbase += __popcll(eqm);
    }
}
__device__ __forceinline__ void ph_topk(const GAS float* SC, GAS unsigned long long* MASKW, LAS unsigned char* wl, int gw, int ngw, int lane) {
    constexpr int CAP = 1024;
    LAS unsigned* hist = (LAS unsigned*)wl;
    LAS unsigned* maskc = (LAS unsigned*)(wl + 1024);
    LAS float* cval = (LAS float*)(wl + 1536);
    LAS unsigned* ckey = (LAS unsigned*)(wl + 1536 + 4 * CAP);
    const unsigned long long lt_mask = (1ull << lane) - 1ull;
    for (int m = gw; m < M; m += ngw) {
        const int t = m & (SEQ - 1), limit = (t / 64 + 1) * 64, nw = limit / 64;
        GAS unsigned long long* mw = MASKW + (size_t)m * 64;
        if (limit <= TOPK) { unsigned ones = 0xffffffffu; asm volatile("" : "+v"(ones)); if (lane < nw) mw[lane] = ((unsigned long long)ones << 32) | ones; continue; }
        const GAS float* srow = SC + (size_t)m * SEQ;
        float s[64]; float smax = -__builtin_inff(), smin = __builtin_inff();
#pragma unroll
        for (int j = 0; j < 64; ++j) { s[j] = (j < nw) ? srow[j * 64 + lane] : 0.f; if (j < nw) { smax = fmaxf(smax, s[j]); smin = fminf(smin, s[j]); } }
        smax = wave_max(smax); smin = -wave_max(-smin);
        const float scale = smax > smin ? 255.0f / (smax - smin) : 0.f;
        asm volatile("" ::: "memory");
        hist[lane] = 0u; hist[lane + 64] = 0u; hist[lane + 128] = 0u; hist[lane + 192] = 0u; maskc[lane] = 0u; maskc[lane + 64] = 0u;
        LDS_WAIT();
#pragma unroll
        for (int j = 0; j < 64; ++j) if (j < nw) { const int b = min(255, (int)((s[j] - smin) * scale)); __hip_atomic_fetch_add(&hist[b], 1u, __ATOMIC_RELAXED, __HIP_MEMORY_SCOPE_WORKGROUP); }
        LDS_WAIT();
        const unsigned c0 = hist[4 * lane], c1 = hist[4 * lane + 1], c2 = hist[4 * lane + 2], c3 = hist[4 * lane + 3];
        unsigned suf = c0 + c1 + c2 + c3;
#pragma unroll
        for (int o = 1; o < 64; o <<= 1) { const unsigned v = __shfl_down(suf, o); if (lane + o < 64) suf += v; }
        const unsigned above = suf - (c0 + c1 + c2 + c3);
        int bstar = -1; unsigned cab = 0u;
        { unsigned cum = above;
          if (cum < TOPK && cum + c3 >= TOPK) { bstar = 4 * lane + 3; cab = cum; } cum += c3;
          if (bstar < 0 && cum < TOPK && cum + c2 >= TOPK) { bstar = 4 * lane + 2; cab = cum; } cum += c2;
          if (bstar < 0 && cum < TOPK && cum + c1 >= TOPK) { bstar = 4 * lane + 1; cab = cum; } cum += c1;
          if (bstar < 0 && cum < TOPK && cum + c0 >= TOPK) { bstar = 4 * lane + 0; cab = cum; } }
        const unsigned long long who = __ballot(bstar >= 0);
        const int src = __builtin_ctzll(who);
        bstar = __shfl(bstar, src); cab = __shfl(cab, src);
        const int need = TOPK - (int)cab;
        const unsigned ncand = hist[bstar];
        if (ncand > (unsigned)CAP) { topk_bitwise(srow, mw, limit, lane); continue; }
        unsigned long long myword = 0ull; int base = 0;
#pragma unroll
        for (int j = 0; j < 64; ++j) if (j < nw) {
            const int b = min(255, (int)((s[j] - smin) * scale));
            const unsigned long long gm = __ballot(b > bstar), em = __ballot(b == bstar);
            if (lane == j) myword = gm;
            if (b == bstar) { const int pos = base + __popcll(em & lt_mask); cval[pos] = s[j]; ckey[pos] = (unsigned)(j * 64 + lane); }
            base += __popcll(em);
        }
        LDS_WAIT();
        for (int i = lane; i < base; i += 64) { const float vi = cval[i]; const unsigned ki = ckey[i]; int rank = 0;
            if (need < base) { for (int q = 0; q < base; ++q) { const float vq = cval[q]; const unsigned kq = ckey[q]; rank += (vq > vi || (vq == vi && kq < ki)) ? 1 : 0; } }
            if (rank < need) __hip_atomic_fetch_or(&maskc[ki >> 5], 1u << (ki & 31), __ATOMIC_RELAXED, __HIP_MEMORY_SCOPE_WORKGROUP); }
        LDS_WAIT();
        if (lane < nw) { const unsigned long long cw_ = ((unsigned long long)maskc[2 * lane + 1] << 32) | maskc[2 * lane]; mw[lane] = myword | cw_; }
        LDS_WAIT(); asm volatile("" ::: "memory");
    }
}

typedef short s16x4 __attribute__((ext_vector_type(4)));
__device__ __forceinline__ s16x4 lds_tr4(const LAS unsigned char* p) { return __builtin_bit_cast(s16x4, __builtin_amdgcn_ds_read_tr16_b64_v4i16((LAS s16x4*)p)); }
__device__ __forceinline__ float xmax16(float x) { auto r = __builtin_amdgcn_permlane16_swap(__float_as_uint(x), __float_as_uint(x), false, false); return fmaxf(__uint_as_float(r[0]), __uint_as_float(r[1])); }
__device__ __forceinline__ float xmax32(float x) { auto r = __builtin_amdgcn_permlane32_swap(__float_as_uint(x), __float_as_uint(x), false, false); return fmaxf(__uint_as_float(r[0]), __uint_as_float(r[1])); }
__device__ __forceinline__ float xsum16(float x) { auto r = __builtin_amdgcn_permlane16_swap(__float_as_uint(x), __float_as_uint(x), false, false); return __uint_as_float(r[0]) + __uint_as_float(r[1]); }
__device__ __forceinline__ float xsum32(float x) { auto r = __builtin_amdgcn_permlane32_swap(__float_as_uint(x), __float_as_uint(x), false, false); return __uint_as_float(r[0]) + __uint_as_float(r[1]); }
template <int VAR> __device__ __forceinline__ void ph_attn_dense(const GAS bf16* P, const GAS unsigned long long* MASKW, GAS bf16* AO, LAS unsigned char* lds, int blk, int nblk, int tid) {
    constexpr int KS = 272, VS = 288, KBUF = 64 * KS, VBUF = 64 * VS, VOFF = 2 * KBUF, MOFF = VOFF + 2 * VBUF;
    const int lane = tid & 63, wave = __builtin_amdgcn_readfirstlane(tid >> 6), g = lane >> 4, c16 = lane & 15;
    const int hq = wave >> 1, qh = (wave & 1) * 32;
    const float SCL = ATTN_SCALE * 1.4426950408889634f;
    for (int u0 = blk; u0 < 256; u0 += nblk) {
#pragma unroll 1
        for (int half = 0; half < 2; ++half) {
            const int b = (u0 >> 2) & 1, kvh = u0 & 3, cc = u0 >> 3, c = half ? 63 - cc : cc, nt = c + 1;
            const int m0 = b * SEQ + c * 64;
            bf16x8 qf[2][4];
#pragma unroll
            for (int qt = 0; qt < 2; ++qt)
#pragma unroll
                for (int kd = 0; kd < 4; ++kd) qf[qt][kd] = *(const GAS bf16x8*)(P + (size_t)(m0 + qh + 16 * qt + c16) * NMAIN + PQ + (kvh * 4 + hq) * AD + 32 * kd + 8 * g);
            f32x4 O[2][8];
#pragma unroll
            for (int qt = 0; qt < 2; ++qt)
#pragma unroll
                for (int dt = 0; dt < 8; ++dt) O[qt][dt] = (f32x4){0.f, 0.f, 0.f, 0.f};
            float mrun[2] = {-1e30f, -1e30f}, lrun[2] = {0.f, 0.f};
            const GAS bf16* kvbase = P + (size_t)(b * SEQ) * NMAIN + kvh * AD;
            u32x4 kreg[2], vreg[2];
#define ATT_LOAD(t) do { _Pragma("unroll") for (int i = 0; i < 2; ++i) { const int id = tid + 512 * i; const GAS bf16* src = kvbase + (size_t)((t) * 64 + (id >> 4)) * NMAIN + (id & 15) * 8; \
                kreg[i] = *(const GAS u32x4*)(src + PK); vreg[i] = *(const GAS u32x4*)(src + PV); } } while (0)
#define ATT_STORE(buf) do { _Pragma("unroll") for (int i = 0; i < 2; ++i) { const int id = tid + 512 * i; \
                *(LAS u32x4*)(lds + (buf) * KBUF + (id >> 4) * KS + (id & 15) * 16) = kreg[i]; *(LAS u32x4*)(lds + VOFF + (buf) * VBUF + (id >> 4) * VS + (id & 15) * 16) = vreg[i]; } } while (0)
            __syncthreads();
            ATT_LOAD(0); ATT_STORE(0);
#pragma unroll
            for (int i = 0; i < 4; ++i) { const int id = tid + 512 * i; *(LAS u32x4*)(lds + MOFF + id * 16) = *(const GAS u32x4*)((const GAS unsigned char*)(MASKW + (size_t)m0 * 64) + id * 16); }
            const LAS unsigned long long* mrow0 = (const LAS unsigned long long*)(lds + MOFF) + (qh + c16) * 64; const LAS unsigned long long* mrow1 = mrow0 + 16 * 64;
            __syncthreads();
            for (int t = 0; t < nt; ++t) {
                const int buf = (VAR & 1) ? 0 : (t & 1);
                if (!(VAR & 1) && t + 1 < nt) ATT_LOAD(t + 1);
                const LAS unsigned char* kb = lds + buf * KBUF + c16 * KS + g * 16;
                const LAS unsigned char* vb = lds + VOFF + buf * VBUF + (4 * g + (c16 >> 2)) * VS + (c16 & 3) * 8;
                f32x4 S[2][4];
                bf16x8 kf[2][4];
#pragma unroll
                for (int kd = 0; kd < 4; ++kd) kf[0][kd] = *(const LAS bf16x8*)(kb + kd * 64);
#pragma unroll
                for (int kt = 0; kt < 4; ++kt) {
                    if (kt < 3) {
#pragma unroll
                        for (int kd = 0; kd < 4; ++kd) kf[(kt + 1) & 1][kd] = *(const LAS bf16x8*)(kb + (kt + 1) * 16 * KS + kd * 64); }
#pragma unroll
                    for (int qt = 0; qt < 2; ++qt) { f32x4 s = (f32x4){0.f, 0.f, 0.f, 0.f};
#pragma unroll
                        for (int kd = 0; kd < 4; ++kd) { if (!(VAR & 8)) s = __builtin_amdgcn_mfma_f32_16x16x32_bf16(kf[kt & 1][kd], qf[qt][kd], s, 0, 0, 0); else s += __builtin_bit_cast(f32x4, kf[kt & 1][kd]); }
                        S[qt][kt] = s; }
                }
                s16x4 vlo[8][2], vhi[8][2];
#pragma unroll
                for (int dt = 0; dt < 4; ++dt)
#pragma unroll
                    for (int ks = 0; ks < 2; ++ks) { vlo[dt][ks] = lds_tr4(vb + (32 * ks) * VS + dt * 32); vhi[dt][ks] = lds_tr4(vb + (32 * ks + 16) * VS + dt * 32); }
                bf16x8 pf[2][2];
#pragma unroll
                for (int qt = 0; qt < 2; ++qt) {
                    const unsigned long long mw = (qt ? mrow1[t] : mrow0[t]) >> (4 * g);
                    const int mlo = (int)(unsigned)mw, mhi = (int)(unsigned)(mw >> 32);
                    float mx = fmaxf(fmaxf(S[qt][0][0], S[qt][0][1]), fmaxf(S[qt][0][2], S[qt][0][3]));
#pragma unroll
                    for (int kt = 1; kt < 4; ++kt) mx = fmaxf(fmaxf(mx, S[qt][kt][0]), fmaxf(fmaxf(S[qt][kt][1], S[qt][kt][2]), S[qt][kt][3]));
                    mx = xmax16(mx); mx = xmax32(mx);
                    const float mnew = fmaxf(mrun[qt], mx * SCL);
                    const float alpha = __builtin_amdgcn_exp2f(mrun[qt] - mnew);
                    float ps = 0.f;
#pragma unroll
                    for (int kt = 0; kt < 4; ++kt)
#pragma unroll
                        for (int j = 0; j < 4; ++j) { const int sel = __builtin_amdgcn_sbfe(kt < 2 ? mlo : mhi, (kt & 1) * 16 + j, 1);
                            const float p = (VAR & 2) ? S[qt][kt][j] : __uint_as_float(__float_as_uint(__builtin_amdgcn_exp2f(__builtin_fmaf(S[qt][kt][j], SCL, -mnew))) & (unsigned)sel); S[qt][kt][j] = p; ps += p; }
                    ps = xsum16(ps); ps = xsum32(ps);
                    lrun[qt] = lrun[qt] * alpha + ps; mrun[qt] = mnew;
                    if (!__all(alpha == 1.0f)) {
#pragma unroll
                        for (int dt = 0; dt < 8; ++dt) O[qt][dt] *= alpha; }
#pragma unroll
                    for (int ks = 0; ks < 2; ++ks) { u32x4 w; w.x = cvtpk(S[qt][2 * ks][0], S[qt][2 * ks][1]); w.y = cvtpk(S[qt][2 * ks][2], S[qt][2 * ks][3]);
                        w.z = cvtpk(S[qt][2 * ks + 1][0], S[qt][2 * ks + 1][1]); w.w = cvtpk(S[qt][2 * ks + 1][2], S[qt][2 * ks + 1][3]); pf[qt][ks] = __builtin_bit_cast(bf16x8, w); }
                }
#pragma unroll
                for (int dt = 4; dt < 8; ++dt)
#pragma unroll
                    for (int ks = 0; ks < 2; ++ks) { vlo[dt][ks] = lds_tr4(vb + (32 * ks) * VS + dt * 32); vhi[dt][ks] = lds_tr4(vb + (32 * ks + 16) * VS + dt * 32); }
#pragma unroll
                for (int dt = 0; dt < 8; ++dt)
#pragma unroll
                    for (int ks = 0; ks < 2; ++ks) {
                        const bf16x8 vf = __builtin_shufflevector(vlo[dt][ks], vhi[dt][ks], 0, 1, 2, 3, 4, 5, 6, 7);
                        if (!(VAR & 4)) { O[0][dt] = __builtin_amdgcn_mfma_f32_16x16x32_bf16(vf, pf[0][ks], O[0][dt], 0, 0, 0);
                        O[1][dt] = __builtin_amdgcn_mfma_f32_16x16x32_bf16(vf, pf[1][ks], O[1][dt], 0, 0, 0); } else { O[0][dt] += __builtin_bit_cast(f32x4, pf[0][ks]); O[1][dt] += __builtin_bit_cast(f32x4, pf[1][ks]); }
                    }
                if (!(VAR & 1) && t + 1 < nt) ATT_STORE(buf ^ 1);
                __syncthreads();
            }
#undef ATT_LOAD
#undef ATT_STORE
#pragma unroll
            for (int qt = 0; qt < 2; ++qt) { const float r = 1.0f / lrun[qt];
                GAS bf16* op = AO + (size_t)(m0 + qh + 16 * qt + c16) * D + (kvh * 4 + hq) * AD + 4 * g;
#pragma unroll
                for (int dt = 0; dt < 8; ++dt) { const f32x4 o = O[qt][dt] * r; u32x2 w; w.x = pk2(o.x, o.y); w.y = pk2(o.z, o.w); *(GAS u32x2*)(op + 16 * dt) = w; } }
        }
    }
}

__device__ __forceinline__ void stage_conv(const GAS bf16* P, const GAS float* cw, const GAS float* cb, int m0, int tpos0, int ch0, int nch, LAS unsigned char* dst, int stride, int tid) {
    const int cpr = nch >> 3;
    for (int id = tid; id < 64 * cpr; id += NTHR) {
        const int s = id / cpr, k = id - s * cpr, ch = ch0 + 8 * k;
        float acc[8];
        { const f32x4 b0 = *(const GAS f32x4*)(cb + ch), b1 = *(const GAS f32x4*)(cb + ch + 4); acc[0] = b0.x; acc[1] = b0.y; acc[2] = b0.z; acc[3] = b0.w; acc[4] = b1.x; acc[5] = b1.y; acc[6] = b1.z; acc[7] = b1.w; }
#pragma unroll
        for (int i = 0; i < 4; ++i) { if (tpos0 + s - 3 + i >= 0) {
            float x[8]; unpack8(*(const GAS u32x4*)(P + (size_t)(m0 + s - 3 + i) * NMAIN + PXBC + ch), x);
            const f32x4 w0 = *(const GAS f32x4*)(cw + i * CONVD + ch), w1 = *(const GAS f32x4*)(cw + i * CONVD + ch + 4);
            acc[0] += w0.x * x[0]; acc[1] += w0.y * x[1]; acc[2] += w0.z * x[2]; acc[3] += w0.w * x[3]; acc[4] += w1.x * x[4]; acc[5] += w1.y * x[5]; acc[6] += w1.z * x[6]; acc[7] += w1.w * x[7]; } }
#pragma unroll
        for (int j = 0; j < 8; ++j) acc[j] = siluf_(acc[j]);
        *(LAS u32x4*)(dst + s * stride + k * 16) = pack8(acc);
    }
}
__device__ __forceinline__ void wave_dt_acs(const GAS float* SM, const GAS float* dt_bias, const GAS float* a_log, int m0, int head, LAS float* dtw, LAS float* acsw, int lane) {
    const float raw = SM[(size_t)(m0 + lane) * SMW + SM_DT + head] + dt_bias[head];
    const float dt = fmaxf(raw, 0.f) + log1pf(__expf(-fabsf(raw)));
    float x = dt * (-__expf(a_log[head]));
#pragma unroll
    for (int o = 1; o < 64; o <<= 1) { const float v = __shfl_up(x, o); if (lane >= o) x += v; }
    dtw[lane] = dt; acsw[lane] = x;
}
__device__ __forceinline__ bf16x8 tr8(const LAS unsigned char* p, int off_lo, int off_hi) {
    const s16x4 lo = lds_tr4(p + off_lo), hi = lds_tr4(p + off_hi); return __builtin_shufflevector(lo, hi, 0, 1, 2, 3, 4, 5, 6, 7);
}
template <int NOUT> __device__ __forceinline__ void conv_strip(const GAS bf16* src, int tpos_first_raw, const GAS float* cw, const GAS float* cb, u32x4 (&out)[NOUT]) {
    u32x4 raw[NOUT + 3];
#pragma unroll
    for (int i = 0; i < NOUT + 3; ++i) { const int tp = tpos_first_raw + i; raw[i] = *(const GAS u32x4*)(src + (size_t)(tp < 0 ? 3 : i) * NMAIN); if (tp < 0) raw[i] = (u32x4){0u, 0u, 0u, 0u}; }
    f32x4 w[4][2];
#pragma unroll
    for (int t = 0; t < 4; ++t) { w[t][0] = *(const GAS f32x4*)(cw + t * CONVD); w[t][1] = *(const GAS f32x4*)(cw + t * CONVD + 4); }
    const f32x4 b0 = *(const GAS f32x4*)cb, b1 = *(const GAS f32x4*)(cb + 4);
#pragma unroll
    for (int o = 0; o < NOUT; ++o) { f32x4 a0 = b0, a1 = b1;
#pragma unroll
        for (int t = 0; t < 4; ++t) { float x[8]; unpack8(raw[o + t], x); a0 += w[t][0] * (f32x4){x[0], x[1], x[2], x[3]}; a1 += w[t][1] * (f32x4){x[4], x[5], x[6], x[7]}; }
        float f[8] = {a0.x, a0.y, a0.z, a0.w, a1.x, a1.y, a1.z, a1.w};
#pragma unroll
        for (int j = 0; j < 8; ++j) f[j] = f[j] * __builtin_amdgcn_rcpf(1.0f + __expf(-f[j]));
        out[o] = pack8(f); }
}
__device__ __forceinline__ void ph_ssd_states(const GAS bf16* P, const GAS float* SM, const GAS float* cw, const GAS float* cb, const GAS float* dt_bias, const GAS float* a_log, GAS bf16* XC, GAS bf16* ST, GAS float* CD,
                                              LAS unsigned char* lds, int blk, int nblk, int tid) {
    constexpr int RSW = 160, XW = 64 * RSW, RSB = 288, BMB = 64 * RSB, O_BM = 8 * XW, O_DT = O_BM + 2 * BMB, O_ACS = O_DT + 2048;
    const int lane = tid & 63, wave = __builtin_amdgcn_readfirstlane(tid >> 6), gq = lane >> 4, c16 = lane & 15;
    LAS unsigned char* xw = lds + wave * XW;
    LAS float* dtw = (LAS float*)(lds + O_DT) + wave * 64; LAS float* acsw = (LAS float*)(lds + O_ACS) + wave * 64;
    int par = 0;
    for (int item = blk; item < BATCH * 64 * NG; item += nblk, par ^= 1) {
        const int bc = item >> 3, g = item & 7, m0 = bc * 64, tpos0 = (bc & 63) * 64, head = g * HPG + wave;
        LAS unsigned char* bm = lds + O_BM + par * BMB;
        asm volatile("" ::: "memory");
        { const int k16 = lane & 15, r0 = 8 * wave + 2 * gq, chB = DI + g * NS + 8 * k16;
          const GAS bf16* base = P + (size_t)(m0 + r0 - 3) * NMAIN + PXBC + chB;
          u32x4 ob[2], oc[2];
          conv_strip<2>(base, tpos0 + r0 - 3, cw + chB, cb + chB, ob);
          conv_strip<2>(base + NG * NS, tpos0 + r0 - 3, cw + chB + NG * NS, cb + chB + NG * NS, oc);
#pragma unroll
          for (int o = 0; o < 2; ++o) { *(LAS u32x4*)(bm + (r0 + o) * RSB + k16 * 16) = ob[o];
              *(GAS u32x4*)(XC + (size_t)(m0 + r0 + o) * CONVD + chB) = ob[o]; *(GAS u32x4*)(XC + (size_t)(m0 + r0 + o) * CONVD + chB + NG * NS) = oc[o]; } }
        { const int k8 = lane & 7, r0 = 8 * (lane >> 3), ch = head * HP + 8 * k8;
          u32x4 ox[8];
          conv_strip<8>(P + (size_t)(m0 + r0 - 3) * NMAIN + PXBC + ch, tpos0 + r0 - 3, cw + ch, cb + ch, ox);
#pragma unroll
          for (int o = 0; o < 8; ++o) { *(LAS u32x4*)(xw + (r0 + o) * RSW + k8 * 16) = ox[o]; *(GAS u32x4*)(XC + (size_t)(m0 + r0 + o) * CONVD + ch) = ox[o]; } }
        wave_dt_acs(SM, dt_bias, a_log, m0, head, dtw, acsw, lane);
        LDS_WAIT();
        __syncthreads();
        const float aend = acsw[63];
        if (lane == 0) CD[bc * NH + head] = __expf(aend);
        const LAS unsigned char* xb = xw + (4 * gq + (c16 >> 2)) * RSW + (c16 & 3) * 8;
        const LAS unsigned char* bb = bm + (4 * gq + (c16 >> 2)) * RSB + (c16 & 3) * 8;
        bf16x8 xf[4][2];
#pragma unroll
        for (int ks = 0; ks < 2; ++ks) { float w[8];
#pragma unroll
            for (int j = 0; j < 8; ++j) { const int s = 32 * ks + 16 * (j >> 2) + 4 * gq + (j & 3); w[j] = dtw[s] * __expf(aend - acsw[s]); }
#pragma unroll
            for (int pt = 0; pt < 4; ++pt) { const bf16x8 r = tr8(xb + pt * 32, (32 * ks) * RSW, (32 * ks + 16) * RSW); float f[8]; unpack8(__builtin_bit_cast(u32x4, r), f);
#pragma unroll
                for (int j = 0; j < 8; ++j) f[j] *= w[j];
                xf[pt][ks] = __builtin_bit_cast(bf16x8, pack8(f)); } }
        GAS bf16* dst = ST + (((size_t)bc * NH + head) * HP + c16) * NS + 4 * gq;
#pragma unroll 2
        for (int nt = 0; nt < 8; ++nt) {
            const bf16x8 a0 = tr8(bb + nt * 32, 0, 16 * RSB), a1 = tr8(bb + nt * 32, 32 * RSB, 48 * RSB);
#pragma unroll
            for (int pt = 0; pt < 4; ++pt) { f32x4 acc = (f32x4){0.f, 0.f, 0.f, 0.f};
                acc = __builtin_amdgcn_mfma_f32_16x16x32_bf16(a0, xf[pt][0], acc, 0, 0, 0); acc = __builtin_amdgcn_mfma_f32_16x16x32_bf16(a1, xf[pt][1], acc, 0, 0, 0);
                u32x2 o; o.x = pk2(acc.x, acc.y); o.y = pk2(acc.z, acc.w); *(GAS u32x2*)(dst + (size_t)(16 * pt) * NS + 16 * nt) = o; }
        }
        LDS_WAIT(); asm volatile("" ::: "memory");
    }
}
__device__ __forceinline__ void ph_ssd_scan(GAS bf16* ST, const GAS float* CD, int gtid, int nthr) {
    for (int it = gtid; it < BATCH * NH * HP * (NS / 8); it += nthr) {
        const int n8 = it & 15, p = (it >> 4) & 63, head = (it >> 10) & 63, b = it >> 16;
        float h[8];
#pragma unroll
        for (int j = 0; j < 8; ++j) h[j] = 0.f;
#pragma unroll 8
        for (int c = 0; c < 64; ++c) { GAS u32x4* q = (GAS u32x4*)(ST + ((((size_t)(b * 64 + c)) * NH + head) * HP + p) * NS) + n8;
            float v[8]; unpack8(*q, v); *q = pack8(h); const float dec = CD[(b * 64 + c) * NH + head];
#pragma unroll
            for (int j = 0; j < 8; ++j) h[j] = h[j] * dec + v[j]; }
    }
}
__device__ __forceinline__ void ph_ssd_out(const GAS bf16* P, const GAS float* SM, const GAS bf16* XC, const GAS float* dt_bias, const GAS float* a_log, const GAS bf16* ST,
                                           const GAS float* dskip, const GAS float* gnorm, GAS bf16* Y, LAS unsigned char* lds, int blk, int nblk, int tid) {
    constexpr int RSW = 160, XW = 64 * RSW, O_DT = 8 * XW, O_ACS = O_DT + 2048, O_SSQ = O_ACS + 2048;
    const int lane = tid & 63, wave = __builtin_amdgcn_readfirstlane(tid >> 6), gq = lane >> 4, c16 = lane & 15;
    LAS unsigned char* xw = lds + wave * XW;
    LAS float* dtw = (LAS float*)(lds + O_DT) + wave * 64; LAS float* acsw = (LAS float*)(lds + O_ACS) + wave * 64;
    int par = 0;
    for (int item = blk; item < BATCH * 64 * NG; item += nblk, par ^= 1) {
        const int bc = item >> 3, g = item & 7, m0 = bc * 64, head = g * HPG + wave;
        asm volatile("" ::: "memory");
        { u32x4 xr[8];
#pragma unroll
          for (int i = 0; i < 8; ++i) xr[i] = *(const GAS u32x4*)(XC + (size_t)(m0 + (lane >> 3) + 8 * i) * CONVD + head * HP + (lane & 7) * 8);
#pragma unroll
          for (int i = 0; i < 8; ++i) *(LAS u32x4*)(xw + ((lane >> 3) + 8 * i) * RSW + (lane & 7) * 16) = xr[i]; }
        wave_dt_acs(SM, dt_bias, a_log, m0, head, dtw, acsw, lane);
        const GAS bf16* cbase = XC + (size_t)(m0 + c16) * CONVD + DI + NG * NS + g * NS + 8 * gq;
        const GAS bf16* bbase = cbase - NG * NS;
        bf16x8 cf[4][4];
#pragma unroll
        for (int lt = 0; lt < 4; ++lt)
#pragma unroll
            for (int kn = 0; kn < 4; ++kn) cf[lt][kn] = *(const GAS bf16x8*)(cbase + (size_t)(16 * lt) * CONVD + 32 * kn);
        LDS_WAIT(); asm volatile("" ::: "memory");
        float al[4];
#pragma unroll
        for (int lt = 0; lt < 4; ++lt) al[lt] = acsw[16 * lt + c16];
        bf16x8 lf[2][4];
#pragma unroll
        for (int ks = 0; ks < 2; ++ks) {
            f32x4 lt4[2][4];
#pragma unroll
            for (int h2 = 0; h2 < 2; ++h2) { const int st = 2 * ks + h2;
                bf16x8 bfr[4];
#pragma unroll
                for (int kn = 0; kn < 4; ++kn) bfr[kn] = *(const GAS bf16x8*)(bbase + (size_t)(16 * st) * CONVD + 32 * kn);
                float as_[4], ds_[4];
#pragma unroll
                for (int j = 0; j < 4; ++j) { as_[j] = acsw[16 * st + 4 * gq + j]; ds_[j] = dtw[16 * st + 4 * gq + j]; }
#pragma unroll
                for (int lt = 0; lt < 4; ++lt) { f32x4 t4 = (f32x4){0.f, 0.f, 0.f, 0.f};
                    if (lt >= st) {
#pragma unroll
                        for (int kn = 0; kn < 4; ++kn) t4 = __builtin_amdgcn_mfma_f32_16x16x32_bf16(bfr[kn], cf[lt][kn], t4, 0, 0, 0);
#pragma unroll
                        for (int j = 0; j < 4; ++j) { const float e = __expf(fminf(al[lt] - as_[j], 0.f)) * ds_[j]; const bool ok = (lt > st) || (4 * gq + j <= c16); t4[j] = ok ? t4[j] * e : 0.f; } }
                    lt4[h2][lt] = t4; } }
#pragma unroll
            for (int lt = 0; lt < 4; ++lt) { u32x4 w; w.x = pk2(lt4[0][lt][0], lt4[0][lt][1]); w.y = pk2(lt4[0][lt][2], lt4[0][lt][3]); w.z = pk2(lt4[1][lt][0], lt4[1][lt][1]); w.w = pk2(lt4[1][lt][2], lt4[1][lt][3]);
                lf[ks][lt] = __builtin_bit_cast(bf16x8, w); }
        }
        f32x4 acc[4][4];
        const GAS bf16* hsrc = ST + (((size_t)bc * NH + head) * HP + c16) * NS + 8 * gq;
#pragma unroll
        for (int pt = 0; pt < 4; ++pt) { bf16x8 hf[4];
#pragma unroll
            for (int kn = 0; kn < 4; ++kn) hf[kn] = *(const GAS bf16x8*)(hsrc + (size_t)(16 * pt) * NS + 32 * kn);
#pragma unroll
            for (int lt = 0; lt < 4; ++lt) { f32x4 t4 = (f32x4){0.f, 0.f, 0.f, 0.f};
#pragma unroll
                for (int kn = 0; kn < 4; ++kn) t4 = __builtin_amdgcn_mfma_f32_16x16x32_bf16(hf[kn], cf[lt][kn], t4, 0, 0, 0);
                acc[pt][lt] = t4 * __expf(al[lt]); }
            asm volatile("" ::: "memory"); }
        const LAS unsigned char* xb = xw + (4 * gq + (c16 >> 2)) * RSW + (c16 & 3) * 8;
#pragma unroll
        for (int pt = 0; pt < 4; ++pt) {
            const bf16x8 x0 = tr8(xb + pt * 32, 0, 16 * RSW), x1 = tr8(xb + pt * 32, 32 * RSW, 48 * RSW);
#pragma unroll
            for (int lt = 0; lt < 4; ++lt) { acc[pt][lt] = __builtin_amdgcn_mfma_f32_16x16x32_bf16(x0, lf[0][lt], acc[pt][lt], 0, 0, 0);
                if (lt >= 2) acc[pt][lt] = __builtin_amdgcn_mfma_f32_16x16x32_bf16(x1, lf[1][lt], acc[pt][lt], 0, 0, 0); } }
        const float dk = dskip[head]; float ssq[4] = {0.f, 0.f, 0.f, 0.f};
#pragma unroll
        for (int lt = 0; lt < 4; ++lt) { const int l = 16 * lt + c16;
#pragma unroll
            for (int pt = 0; pt < 4; ++pt) { const int p0 = 16 * pt + 4 * gq;
                const u32x2 xv = *(const LAS u32x2*)(xw + l * RSW + p0 * 2); const u32x2 zw = *(const GAS u32x2*)(P + (size_t)(m0 + l) * NMAIN + PZ + head * HP + p0);
                const float xs4[4] = {bflo(xv.x), bfhi(xv.x), bflo(xv.y), bfhi(xv.y)}, z4[4] = {bflo(zw.x), bfhi(zw.x), bflo(zw.y), bfhi(zw.y)};
#pragma unroll
                for (int j = 0; j < 4; ++j) { const float y = (acc[pt][lt][j] + dk * xs4[j]) * z4[j] * __builtin_amdgcn_rcpf(1.0f + __expf(-z4[j])); acc[pt][lt][j] = y; ssq[lt] += y * y; } } }
        LAS float* ssqs = (LAS float*)(lds + O_SSQ) + par * 512;
#pragma unroll
        for (int lt = 0; lt < 4; ++lt) { float v = ssq[lt]; v += __shfl_xor(v, 16); v += __shfl_xor(v, 32); if (gq == 0) ssqs[wave * 64 + 16 * lt + c16] = v; }
        LDS_WAIT();
        __syncthreads();
#pragma unroll
        for (int lt = 0; lt < 4; ++lt) { const int l = 16 * lt + c16; float tot = 0.f;
#pragma unroll
            for (int w8 = 0; w8 < 8; ++w8) tot += ssqs[w8 * 64 + l];
            const float rstd = rsqrtf(tot * (1.0f / (HPG * HP)) + EPS);
#pragma unroll
            for (int pt = 0; pt < 4; ++pt) { const int ch = head * HP + 16 * pt + 4 * gq; const f32x4 gn = *(const GAS f32x4*)(gnorm + ch); const f32x4 o = acc[pt][lt] * rstd * gn;
                u32x2 w; w.x = pk2(o.x, o.y); w.y = pk2(o.z, o.w); *(GAS u32x2*)(Y + (size_t)(m0 + l) * DI + ch) = w; } }
        LDS_WAIT(); asm volatile("" ::: "memory");
    }
}

__device__ __forceinline__ float gelu_tanhf_(float x) { const float u = 0.7978845608028654f * (x + 0.044715f * x * x * x); return x * __builtin_amdgcn_rcpf(1.0f + __expf(-2.0f * u)); }
__device__ __forceinline__ void ph_ffn_act(const GAS bf16* U, const GAS float* cw, const GAS float* cb, GAS bf16* ACT, int gtid, int nthr) {
    constexpr int NCG = FF / 8, R = 8;
    for (int it = gtid; it < (M / R) * NCG; it += nthr) {
        const int c0 = (it % NCG) * 8, m0 = (it / NCG) * R, t0 = m0 & (SEQ - 1);
        f32x4 wg[3][2], wv[3][2];
#pragma unroll
        for (int i = 0; i < 3; ++i) { wg[i][0] = *(const GAS f32x4*)(cw + i * FF2 + c0); wg[i][1] = *(const GAS f32x4*)(cw + i * FF2 + c0 + 4); wv[i][0] = *(const GAS f32x4*)(cw + i * FF2 + FF + c0); wv[i][1] = *(const GAS f32x4*)(cw + i * FF2 + FF + c0 + 4); }
        const f32x4 bg0 = *(const GAS f32x4*)(cb + c0), bg1 = *(const GAS f32x4*)(cb + c0 + 4), bv0 = *(const GAS f32x4*)(cb + FF + c0), bv1 = *(const GAS f32x4*)(cb + FF + c0 + 4);
        u32x4 rg[R + 2], rv[R + 2];
#pragma unroll
        for (int i = 0; i < R + 2; ++i) { const bool ok = (t0 + i - 2) >= 0; const GAS bf16* ur = U + (size_t)(m0 + (ok ? i - 2 : 0)) * FF2 + c0;
            rg[i] = *(const GAS u32x4*)ur; rv[i] = *(const GAS u32x4*)(ur + FF); if (!ok) { rg[i] = (u32x4){0u, 0u, 0u, 0u}; rv[i] = (u32x4){0u, 0u, 0u, 0u}; } }
#pragma unroll
        for (int o = 0; o < R; ++o) { f32x4 g0 = bg0, g1 = bg1, v0 = bv0, v1 = bv1;
#pragma unroll
            for (int i = 0; i < 3; ++i) { float xg[8], xv[8]; unpack8(rg[o + i], xg); unpack8(rv[o + i], xv);
                g0 += wg[i][0] * (f32x4){xg[0], xg[1], xg[2], xg[3]}; g1 += wg[i][1] * (f32x4){xg[4], xg[5], xg[6], xg[7]};
                v0 += wv[i][0] * (f32x4){xv[0], xv[1], xv[2], xv[3]}; v1 += wv[i][1] * (f32x4){xv[4], xv[5], xv[6], xv[7]}; }
            float r[8] = {gelu_tanhf_(g0.x) * v0.x, gelu_tanhf_(g0.y) * v0.y, gelu_tanhf_(g0.z) * v0.z, gelu_tanhf_(g0.w) * v0.w, gelu_tanhf_(g1.x) * v1.x, gelu_tanhf_(g1.y) * v1.y, gelu_tanhf_(g1.z) * v1.z, gelu_tanhf_(g1.w) * v1.w};
            *(GAS u32x4*)(ACT + (size_t)(m0 + o) * FF + c0) = pack8(r); }
    }
}

struct Args { const float* in[20]; float* out; unsigned char* ws; int ph_lo, ph_hi; };
constexpr int NP = 11, NPHASE = 1 + DEPTH * NP;

#define AIN(i) ((const GAS float*)args.in[i])
__global__ void __launch_bounds__(NTHR, 2) fwd(Args args) {
    extern __shared__ __attribute__((aligned(16))) unsigned char lds[];
    const int G = gridDim.x, blk = blockIdx.x;
    volatile LAS unsigned* MISC = (volatile LAS unsigned*)((LAS unsigned char*)lds + MISC_OFF);
    for (int u = threadIdx.x; u < (LDS_BYTES - LDSCTL_OFF) / 4; u += NTHR) ((LAS unsigned*)((LAS unsigned char*)lds + LDSCTL_OFF))[u] = 0u;
    __syncthreads();
    XcdBarrier bar; bar.bar = (unsigned*)(args.ws + WS_CTL) + CW_BAR; bar.x = 0; bar.st = nullptr;
    if (!MK_PER_PHASE) bar = xcd_barrier_post((unsigned*)(args.ws + WS_CTL) + CW_BAR, MISC + 8);
    const int lo = args.ph_lo, hi = args.ph_hi;
#define IN(k) (lo <= (k) && (k) < hi)
#define SEAM(k) do { if (IN(k) && IN((k) + 1)) xcd_barrier(bar); } while (0)
#define PH_BEGIN \
    int tid = threadIdx.x; asm volatile("" : "+v"(tid)); \
    const int lane = tid & 63, wave = __builtin_amdgcn_readfirstlane(tid >> 6); \
    const int gw = blk * NWAVES + wave, ngw = G * NWAVES, gtid = blk * NTHR + tid, nthr = G * NTHR; \
    GAS unsigned char* ws = (GAS unsigned char*)args.ws; asm volatile("" : "+s"(ws)); \
    LAS unsigned char* ring = (LAS unsigned char*)lds; \
    (void)lane; (void)wave; (void)gw; (void)ngw; (void)gtid; (void)nthr; (void)ring; \
    GAS float* X = (GAS float*)args.out; \
    GAS bf16* H = (GAS bf16*)(ws + WS_H); GAS bf16* P = (GAS bf16*)(ws + WS_P); GAS float* SM = (GAS float*)(ws + WS_SM); GAS bf16* XC = (GAS bf16*)(ws + WS_XC); \
    GAS float* CD = (GAS float*)(ws + WS_DT); GAS bf16* STB = (GAS bf16*)(ws + WS_ST); GAS bf16* Y = (GAS bf16*)(ws + WS_Y); \
    GAS float* SC = (GAS float*)(ws + WS_SC); GAS unsigned long long* MASKW = (GAS unsigned long long*)(ws + WS_IDX); GAS bf16* AO = (GAS bf16*)(ws + WS_AO); \
    GAS float* MG = (GAS float*)(ws + WS_MG); GAS bf16* MGB = (GAS bf16*)(ws + WS_MGB); GAS float* YM = (GAS float*)(ws + WS_YM); GAS bf16* U = (GAS bf16*)(ws + WS_U); \
    GAS bf16* ACT = (GAS bf16*)(ws + WS_ACT); GAS bf16* KIB = (GAS bf16*)(ws + WS_KIB); \
    (void)X; (void)H; (void)P; (void)SM; (void)XC; (void)CD; (void)STB; (void)Y; (void)SC; (void)MASKW; (void)AO; (void)MG; (void)MGB; (void)YM; (void)U; (void)ACT; (void)KIB;

    if (IN(0)) { PH_BEGIN
        WPtrs wp{AIN(5), AIN(13), AIN(14), AIN(15), AIN(16), AIN(19)};
        ph_weights(wp, ws, (LAS float*)lds + wave * 2176, gw, ngw, lane);
        ph_resid_norm(nullptr, nullptr, AIN(1), AIN(0), X, H, gw, ngw, lane);
    }
    SEAM(0);

#pragma unroll 1
    for (int layer = 0; layer < DEPTH; ++layer) {
        const int pb = 1 + layer * NP;
#define WL (ws + WS_W + (size_t)layer * WL_SIZE)
        if (IN(pb + 0)) { PH_BEGIN
            { pg8::Gemm g{H, (const GAS bf16*)(WL + WL_IN), M, NMAIN, D}; pg8::StaticOrder S; S.init(M, NMAIN, G, blk);
              pg8::EpiIn E{P, NMAIN, AIN(6) + (size_t)layer * 2 * D, PG / 256};
              REP(1) { pg8::gemm_phase<pg8::EpiIn, pg8::StaticOrder, true, true>(ring, g, S, E); __syncthreads(); } }
            REP(2) { ph_small_proj(H, (const GAS bf16*)(WL + WL_IN) + (size_t)NMAIN * D, SM, KIB, ring, blk, G, tid); __syncthreads(); }
        }
        SEAM(pb + 0);
        if (IN(pb + 1)) { PH_BEGIN
            REP(20) { ph_ssd_states(P, SM, AIN(7) + (size_t)layer * 4 * CONVD, AIN(8) + (size_t)layer * CONVD, AIN(9) + layer * NH, AIN(10) + layer * NH, XC, STB, CD, ring, blk, G, tid); __syncthreads(); }
            REP(21) { ph_index_scores(P, SM, KIB, SC, ring, blk, G, tid); __syncthreads(); } }
        SEAM(pb + 1);
        if (IN(pb + 2)) { PH_BEGIN
            ph_ssd_scan(STB, CD, gtid, nthr); REP(30) ph_topk(SC, MASKW, ring + wave * 9728, gw, ngw, lane); }
        SEAM(pb + 2);
        if (IN(pb + 3)) { PH_BEGIN
            REP(40) { ph_ssd_out(P, SM, XC, AIN(9) + layer * NH, AIN(10) + layer * NH, STB,
                                 AIN(11) + layer * NH, AIN(12) + (size_t)layer * DI, Y, ring, blk, G, tid); __syncthreads(); }
            REP(41) { ph_attn_dense<0>(P, MASKW, AO, ring, blk, G, tid); __syncthreads(); }
#if PROBE_DOUBLE >= 1000
            { ph_attn_dense<PROBE_DOUBLE - 1000>(P, MASKW, (GAS bf16*)U, ring, blk, G, tid); __syncthreads(); }
#endif
            }
        SEAM(pb + 3);
        if (IN(pb + 4)) {
            { PH_BEGIN
              pg8::Gemm g{Y, (const GAS bf16*)(WL + WL_SSM), M, D, DI}; pg8::StaticOrder S; S.init(M, D, G, blk);
              pg8::EpiGateMul E{MG, D, P + PG, NMAIN}; pg8::gemm_phase<pg8::EpiGateMul, pg8::StaticOrder, false, true>(ring, g, S, E); }
            __syncthreads();
            { PH_BEGIN
              pg8::Gemm g{AO, (const GAS bf16*)(WL + WL_ATT), M, D, D}; pg8::StaticOrder S; S.init(M, D, G, blk);
              pg8::EpiGateAdd E{MG, MGB, D, P + PG + D, NMAIN}; pg8::gemm_phase<pg8::EpiGateAdd, pg8::StaticOrder, false, true>(ring, g, S, E); }
        }
        SEAM(pb + 4);
        if (IN(pb + 5)) { PH_BEGIN
            pg8::Gemm g{MGB, (const GAS bf16*)(WL + WL_MIX), M, D, D}; pg8::StaticOrder S; S.init(M, D, G, blk);
            pg8::EpiF32 E{YM, D}; REP(60) { pg8::gemm_phase<pg8::EpiF32, pg8::StaticOrder, false, true>(ring, g, S, E); __syncthreads(); } }
        SEAM(pb + 5);
        if (IN(pb + 6)) { PH_BEGIN
            ph_resid_norm(YM, AIN(2) + (size_t)layer * D, AIN(3) + (size_t)layer * D, X, X, H, gw, ngw, lane); }
        SEAM(pb + 6);
        if (IN(pb + 7)) { PH_BEGIN
            pg8::Gemm g{H, (const GAS bf16*)(WL + WL_UP), M, FF2, D}; pg8::StaticOrder S; S.init(M, FF2, G, blk);
            pg8::EpiBf16<0> E{U, FF2, nullptr, 0, 0, 1.f}; REP(80) { pg8::gemm_phase<pg8::EpiBf16<0>, pg8::StaticOrder, true, true>(ring, g, S, E); __syncthreads(); } }
        SEAM(pb + 7);
        if (IN(pb + 8)) { PH_BEGIN
            REP(90) ph_ffn_act(U, AIN(17) + (size_t)layer * 3 * FF2, AIN(18) + (size_t)layer * FF2, ACT, gtid, nthr); }
        SEAM(pb + 8);
        if (IN(pb + 9)) { PH_BEGIN
            pg8::Gemm g{ACT, (const GAS bf16*)(WL + WL_DN), M, D, FF}; pg8::StaticOrder S; S.init(M, D, G, blk);
            pg8::EpiF32 E{YM, D}; REP(100) { pg8::gemm_phase<pg8::EpiF32, pg8::StaticOrder, false, true>(ring, g, S, E); __syncthreads(); } }
        SEAM(pb + 9);
        if (IN(pb + 10)) { PH_BEGIN
            ph_resid_norm(YM, AIN(4) + (size_t)layer * D, layer + 1 < DEPTH ? AIN(1) + (size_t)(layer + 1) * D : nullptr, X, X, H, gw, ngw, lane); }
        SEAM(pb + 10);
    }
#undef IN
#undef SEAM
#undef WL
#undef PH_BEGIN
}

extern "C" void kernel_launch(void* const* d_in, const int* in_sizes, int n_in, void* d_out, int out_size, void* d_ws, size_t ws_size, hipStream_t stream) {
    static int grid = 0;
    if (grid == 0) {
        if (n_in != 20 || in_sizes[0] != M * D || out_size != M * D || ws_size < WS_END) { fprintf(stderr, "kernel_launch: unexpected shapes (n_in %d, in0 %d, out %d, ws %zu < %zu)\n", n_in, n_in > 0 ? in_sizes[0] : -1, out_size, ws_size, (size_t)WS_END); grid = -1; return; }
        int dev = 0, cus = 0, per_cu = 0;
        if (hipGetDevice(&dev) != hipSuccess || hipDeviceGetAttribute(&cus, hipDeviceAttributeMultiprocessorCount, dev) != hipSuccess) { grid = -1; return; }
        if (hipFuncSetAttribute((const void*)fwd, hipFuncAttributeMaxDynamicSharedMemorySize, LDS_BYTES) != hipSuccess) { fprintf(stderr, "kernel_launch: hipFuncSetAttribute failed\n"); grid = -1; return; }
        if (hipOccupancyMaxActiveBlocksPerMultiprocessor(&per_cu, (const void*)fwd, NTHR, LDS_BYTES) != hipSuccess || per_cu < 1) fprintf(stderr, "kernel_launch: occupancy query reports %d blocks per CU\n", per_cu);
        (void)hipGetLastError();
        grid = cus;
    }
    if (grid < 0) return;
    if (hipMemsetAsync((char*)d_ws + WS_CTL, 0, CTL_ZERO_BYTES, stream) != hipSuccess) return;
    Args a{};
    for (int i = 0; i < 20; ++i) a.in[i] = (const float*)d_in[i];
    a.out = (float*)d_out; a.ws = (unsigned char*)d_ws;
#if MK_PER_PHASE
    for (int ph = 0; ph < NPHASE; ++ph) { a.ph_lo = ph; a.ph_hi = ph + 1; hipLaunchKernelGGL(fwd, dim3(grid), dim3(NTHR), LDS_BYTES, stream, a); }
#else
    a.ph_lo = 0; a.ph_hi = NPHASE; hipLaunchKernelGGL(fwd, dim3(grid), dim3(NTHR), LDS_BYTES, stream, a);
#endif
}
```

```cpp
#include <hip/hip_runtime.h>
#include <cstdio>
#include <cstdint>
#define MK_PER_PHASE 0
namespace pg8 {
#define PG8_LAS __attribute__((address_space(3)))
#define PG8_GAS __attribute__((address_space(1)))
typedef unsigned short bf16_t;
typedef short bf16x8 __attribute__((ext_vector_type(8)));
typedef float f32x4 __attribute__((ext_vector_type(4)));
typedef unsigned u32x4 __attribute__((ext_vector_type(4)));
constexpr int BM = 256, BK = 64, HALF = 128, HTB = HALF * BK * 2  , STAGE_BYTES = 8 * HTB, NXCD = 8, WGM = 8;

__host__ __device__ __forceinline__ int lds_byte(int r, int c) { const int st = (r >> 4) * 2 + (c >> 5), rr = r & 15, cc = c & 31, ob = rr * 64 + cc * 2; return st * 1024 + (ob ^ (((ob >> 9) & 1) << 5)); }
__host__ __device__ __forceinline__ void stage_rc(int b, int& R, int& C) { const int st = b / 1024, sb = b % 1024, swz = sb ^ (((sb >> 9) & 1) << 5); R = (st >> 1) * 16 + swz / 64; C = (st & 1) * 32 + (swz % 64) / 2; }
__host__ __device__ __forceinline__ int perm32(int rho) { const int n = rho >> 4, i = rho & 15; return 8 * (i >> 2) + 4 * n + (i & 3); }

struct Unit { int pm, pn; };
struct Gemm { const PG8_GAS bf16_t* A; const PG8_GAS bf16_t* Bt; int M, N, K; };

struct StaticOrder {
    int nM, nN, nwg, G, c;
    __host__ __device__ void init(int M, int N, int G_, int c_) { nM = M / BM; nN = N / BM; nwg = nM * nN; G = G_; c = c_; }
    __host__ __device__ bool next(int i, Unit& u) const {
        const long L = (long)i * G + c; if (L >= nwg) return false;
        int wgid = (int)L; { const int q = nwg / NXCD, r = nwg % NXCD, xcd = wgid % NXCD, off = wgid / NXCD; wgid = (xcd < r ? xcd * (q + 1) : r * (q + 1) + (xcd - r) * q) + off; }
        const int nig = WGM * nN, gid = wgid / nig, fm = gid * WGM, gsz = (nM - fm) < WGM ? (nM - fm) : WGM;
        u.pm = fm + ((wgid % nig) % gsz); u.pn = (wgid % nig) / gsz; return true;
    }
    __device__ __forceinline__ void a_ready(const Unit&) const {}
    __device__ __forceinline__ void done(const Unit&) const {}
};

__device__ __forceinline__ unsigned cvt_pk_bf16(float lo, float hi) { unsigned r; asm volatile("v_cvt_pk_bf16_f32 %0, %1, %2" : "=v"(r) : "v"(lo), "v"(hi)); return r; }
typedef float f32x2 __attribute__((ext_vector_type(2)));
__device__ __forceinline__ f32x2 gelu_pk(f32x2 v) {
    const f32x2 av = __builtin_elementwise_abs(v), d = av * 0.2316418882f + 1.0f;
    f32x2 t; t.x = __builtin_amdgcn_rcpf(d.x); t.y = __builtin_amdgcn_rcpf(d.y);
    f32x2 q = t * 0.5307027145f + (-0.7265760135f); q = q * t + 0.7107068705f; q = q * t + (-0.142248368f); q = q * t + 0.127414796f; q = q * t;
    const f32x2 s = (v * v) * (-0.72134752044f);
    f32x2 e; e.x = __builtin_amdgcn_exp2f(s.x); e.y = __builtin_amdgcn_exp2f(s.y);
    const f32x2 m = v * (q * e), r = v - m;
    f32x2 o; o.x = v.x < 0.f ? m.x : r.x; o.y = v.y < 0.f ? m.y : r.y; return o;
}

template <int ACT  > struct EpiBf16 {
    static constexpr bool PERM = true, AFTER_DRAIN = false; static_assert(ACT == 0 || ACT == 1, "EpiBf16: ACT is 0 (none) or 1 (gelu_pk)");
    PG8_GAS bf16_t* O; int ldc; const PG8_GAS float* bias; int split_cols; size_t split_stride; float scale0;
    __device__ __forceinline__ void operator()(const f32x4 (&acc)[2][2][4][2], const Unit& u, int wr, int wc, int fr, int fq) const {
        const int row0 = u.pm * BM + wr * 64 + fr; int colt = u.pn * BM; PG8_GAS bf16_t* base = O;
        float sc = 1.f; if (split_cols) { const int t = colt / split_cols; base += (size_t)t * split_stride; colt -= t * split_cols; if (t == 0) sc = scale0; }
        const int col0 = colt + wc * 32 + 8 * fq, bcol0 = u.pn * BM + wc * 32 + 8 * fq;
        f32x4 bv[2][2];
#pragma unroll
        for (int bj = 0; bj < 2; ++bj)
#pragma unroll
            for (int n = 0; n < 2; ++n) bv[bj][n] = bias ? *(const PG8_GAS f32x4*)(bias + bcol0 + bj * HALF + 4 * n) : (f32x4){0.f, 0.f, 0.f, 0.f};
#pragma unroll
        for (int ai = 0; ai < 2; ++ai)
#pragma unroll
            for (int m = 0; m < 4; ++m) { PG8_GAS bf16_t* rowp = base + (size_t)(row0 + ai * HALF + m * 16) * ldc + col0;
#pragma unroll
                for (int bj = 0; bj < 2; ++bj) { f32x4 v0 = acc[ai][bj][m][0] + bv[bj][0], v1 = acc[ai][bj][m][1] + bv[bj][1];
                    if (ACT == 1) { f32x2 a = gelu_pk((f32x2){v0[0], v0[1]}), b = gelu_pk((f32x2){v0[2], v0[3]}), c = gelu_pk((f32x2){v1[0], v1[1]}), d = gelu_pk((f32x2){v1[2], v1[3]});
                        v0 = (f32x4){a.x, a.y, b.x, b.y}; v1 = (f32x4){c.x, c.y, d.x, d.y}; }
                    v0 = v0 * sc; v1 = v1 * sc; u32x4 w; w.x = cvt_pk_bf16(v0[0], v0[1]); w.y = cvt_pk_bf16(v0[2], v0[3]); w.z = cvt_pk_bf16(v1[0], v1[1]); w.w = cvt_pk_bf16(v1[2], v1[3]);
                    *(PG8_GAS u32x4*)(rowp + bj * HALF) = w; } }
    }
};

struct EpiF32 {
    static constexpr bool PERM = false, AFTER_DRAIN = false;
    PG8_GAS float* C; int ldc;
    __device__ __forceinline__ void operator()(const f32x4 (&acc)[2][2][4][2], const Unit& u, int wr, int wc, int fr, int fq) const {
        const int row0 = u.pm * BM + wr * 64 + fr, col0 = u.pn * BM + wc * 32 + 4 * fq;
#pragma unroll
        for (int ai = 0; ai < 2; ++ai)
#pragma unroll
            for (int m = 0; m < 4; ++m) { PG8_GAS float* rowp = C + (size_t)(row0 + ai * HALF + m * 16) * ldc + col0;
#pragma unroll
                for (int bj = 0; bj < 2; ++bj)
#pragma unroll
                    for (int n = 0; n < 2; ++n) *(PG8_GAS f32x4*)(rowp + bj * HALF + n * 16) = acc[ai][bj][m][n]; }
    }
};
__device__ __forceinline__ float bf_lo(unsigned w) { return __uint_as_float(w << 16); }
__device__ __forceinline__ float bf_hi(unsigned w) { return __uint_as_float(w & 0xffff0000u); }
__device__ __forceinline__ float sigmoidf_(float x) { return __builtin_amdgcn_rcpf(1.0f + __expf(-x)); }
struct EpiIn {
    static constexpr bool PERM = true, AFTER_DRAIN = false;
    PG8_GAS bf16_t* P; int ldp; const PG8_GAS float* bgate; int gate_tile0;
    __device__ __forceinline__ void operator()(const f32x4 (&acc)[2][2][4][2], const Unit& u, int wr, int wc, int fr, int fq) const {
        const int row0 = u.pm * BM + wr * 64 + fr, colt = u.pn * BM + wc * 32 + 8 * fq;
        {
            const bool gate = u.pn >= gate_tile0;
            f32x4 bv[2][2];
#pragma unroll
            for (int bj = 0; bj < 2; ++bj)
#pragma unroll
                for (int n = 0; n < 2; ++n) bv[bj][n] = gate ? *(const PG8_GAS f32x4*)(bgate + (colt - gate_tile0 * BM) + bj * HALF + 4 * n) : (f32x4){0.f, 0.f, 0.f, 0.f};
#pragma unroll
            for (int ai = 0; ai < 2; ++ai)
#pragma unroll
                for (int m = 0; m < 4; ++m) { PG8_GAS bf16_t* rowp = P + (size_t)(row0 + ai * HALF + m * 16) * ldp + colt;
#pragma unroll
                    for (int bj = 0; bj < 2; ++bj) { f32x4 v0 = acc[ai][bj][m][0] + bv[bj][0], v1 = acc[ai][bj][m][1] + bv[bj][1];
                        if (gate) {
#pragma unroll
                            for (int j = 0; j < 4; ++j) { v0[j] = sigmoidf_(v0[j]); v1[j] = sigmoidf_(v1[j]); } }
                        u32x4 w; w.x = cvt_pk_bf16(v0[0], v0[1]); w.y = cvt_pk_bf16(v0[2], v0[3]); w.z = cvt_pk_bf16(v1[0], v1[1]); w.w = cvt_pk_bf16(v1[2], v1[3]);
                        *(PG8_GAS u32x4*)(rowp + bj * HALF) = w; } }
        }
    }
};
struct EpiGateMul {
    static constexpr bool PERM = true, AFTER_DRAIN = false;
    PG8_GAS float* MG; int ldc; const PG8_GAS bf16_t* G; int ldg;
    __device__ __forceinline__ void operator()(const f32x4 (&acc)[2][2][4][2], const Unit& u, int wr, int wc, int fr, int fq) const {
        const int row0 = u.pm * BM + wr * 64 + fr, colt = u.pn * BM + wc * 32 + 8 * fq;
#pragma unroll
        for (int ai = 0; ai < 2; ++ai)
#pragma unroll
            for (int m = 0; m < 4; ++m) { const size_t row = (size_t)(row0 + ai * HALF + m * 16);
#pragma unroll
                for (int bj = 0; bj < 2; ++bj) { const u32x4 g = *(const PG8_GAS u32x4*)(G + row * ldg + colt + bj * HALF);
                    f32x4 v0 = acc[ai][bj][m][0], v1 = acc[ai][bj][m][1];
                    v0[0] *= bf_lo(g.x); v0[1] *= bf_hi(g.x); v0[2] *= bf_lo(g.y); v0[3] *= bf_hi(g.y);
                    v1[0] *= bf_lo(g.z); v1[1] *= bf_hi(g.z); v1[2] *= bf_lo(g.w); v1[3] *= bf_hi(g.w);
                    PG8_GAS float* o = MG + row * ldc + colt + bj * HALF; *(PG8_GAS f32x4*)o = v0; *(PG8_GAS f32x4*)(o + 4) = v1; } }
    }
};
struct EpiGateAdd {
    static constexpr bool PERM = true, AFTER_DRAIN = false;
    const PG8_GAS float* MG; PG8_GAS bf16_t* O; int ldc; const PG8_GAS bf16_t* G; int ldg;
    __device__ __forceinline__ void operator()(const f32x4 (&acc)[2][2][4][2], const Unit& u, int wr, int wc, int fr, int fq) const {
        const int row0 = u.pm * BM + wr * 64 + fr, colt = u.pn * BM + wc * 32 + 8 * fq;
#pragma unroll
        for (int ai = 0; ai < 2; ++ai)
#pragma unroll
            for (int m = 0; m < 4; ++m) { const size_t row = (size_t)(row0 + ai * HALF + m * 16);
#pragma unroll
                for (int bj = 0; bj < 2; ++bj) { const u32x4 g = *(const PG8_GAS u32x4*)(G + row * ldg + colt + bj * HALF);
                    const PG8_GAS float* mi = MG + row * ldc + colt + bj * HALF; f32x4 v0 = *(const PG8_GAS f32x4*)mi, v1 = *(const PG8_GAS f32x4*)(mi + 4);
                    const f32x4 a0 = acc[ai][bj][m][0], a1 = acc[ai][bj][m][1];
                    v0[0] += a0[0] * bf_lo(g.x); v0[1] += a0[1] * bf_hi(g.x); v0[2] += a0[2] * bf_lo(g.y); v0[3] += a0[3] * bf_hi(g.y);
                    v1[0] += a1[0] * bf_lo(g.z); v1[1] += a1[1] * bf_hi(g.z); v1[2] += a1[2] * bf_lo(g.w); v1[3] += a1[3] * bf_hi(g.w);
                    u32x4 w; w.x = cvt_pk_bf16(v0[0], v0[1]); w.y = cvt_pk_bf16(v0[2], v0[3]); w.z = cvt_pk_bf16(v1[0], v1[1]); w.w = cvt_pk_bf16(v1[2], v1[3]);
                    *(PG8_GAS u32x4*)(O + row * ldc + colt + bj * HALF) = w; } }
    }
};
template <class Epi, class Sched, bool ALIGN_EPI = false, bool SP2 = false>
__device__ __forceinline__ void gemm_phase(PG8_LAS unsigned char* lds, const Gemm g, const Sched& S, const Epi& E) {
    int tid = threadIdx.x; asm volatile("" : "+v"(tid));
    const int wid = __builtin_amdgcn_readfirstlane(tid >> 6), lane = tid & 63, wr = wid >> 2, wc = wid & 3, fr = lane & 15, fq = lane >> 4;
    const int K = g.K, nt = K / BK;
    unsigned voffA[2], voffB[2];
#pragma unroll
    for (int i = 0; i < 2; ++i) { int R, C; stage_rc(tid * 16 + i * 8192, R, C); const int Rb = Epi::PERM ? ((R & ~31) + perm32(R & 31)) : R;
        voffA[i] = (unsigned)(R * K + C) * 2u; voffB[i] = (unsigned)(Rb * K + C) * 2u; }
    const size_t kstep = (size_t)(BK * 2);
    const size_t hstep = (size_t)HALF * K * 2;
    const size_t tstep = 2 * hstep;
    const unsigned ldsw = (unsigned)wid * 1024u;
    const int aoff = lds_byte(wr * 64 + fr, fq * 8), boff = lds_byte(wc * 32 + fr, fq * 8);
#define PG8_SA(b, h) (((b) * 2 + (h)) * HTB)
#define PG8_SB(b, h) ((4 + (b) * 2 + (h)) * HTB)
#define PG8_STAGE(bufoff, gbase, voff) do { _Pragma("unroll") for (int _i = 0; _i < 2; ++_i) \
        __builtin_amdgcn_global_load_lds((const PG8_GAS unsigned*)((const PG8_GAS char*)(gbase) + (voff)[_i]), (PG8_LAS unsigned*)(lds + (bufoff) + ldsw + _i * 8192), 16, 0, 0); } while (0)
#define PG8_LDA(dst, b, h) do { _Pragma("unroll") for (int m = 0; m < 4; ++m) _Pragma("unroll") for (int k = 0; k < 2; ++k) dst[m][k] = *(const PG8_LAS bf16x8*)(lds + PG8_SA(b, h) + aoff + m * 2048 + k * 1024); } while (0)
#define PG8_LDB(dst, b, h) do { _Pragma("unroll") for (int n = 0; n < 2; ++n) _Pragma("unroll") for (int k = 0; k < 2; ++k) dst[n][k] = *(const PG8_LAS bf16x8*)(lds + PG8_SB(b, h) + boff + n * 2048 + k * 1024); } while (0)
#define PG8_MMA(ai, bj, At, Bt) do { __builtin_amdgcn_s_setprio(1); _Pragma("unroll") for (int m = 0; m < 4; ++m) _Pragma("unroll") for (int n = 0; n < 2; ++n) _Pragma("unroll") for (int k = 0; k < 2; ++k) \
        acc[ai][bj][m][n] = __builtin_amdgcn_mfma_f32_16x16x32_bf16(Bt[n][k], At[m][k], acc[ai][bj][m][n], 0, 0, 0); __builtin_amdgcn_s_setprio(0); } while (0)
#define PG8_WAIT_V(n) asm volatile("s_waitcnt vmcnt(" #n ")" ::: "memory")
#define PG8_WAIT_L(n) asm volatile("s_waitcnt lgkmcnt(" #n ")" ::: "memory")
#define PG8_BAR __builtin_amdgcn_s_barrier()
#define PG8_SCHED __builtin_amdgcn_sched_barrier(0)
    Unit cur, nxt; int ui = 0;
    if (!S.next(0, cur)) return;
    f32x4 acc[2][2][4][2];
#pragma unroll
    for (int a = 0; a < 2; ++a)
#pragma unroll
        for (int b = 0; b < 2; ++b)
#pragma unroll
            for (int m = 0; m < 4; ++m)
#pragma unroll
                for (int n = 0; n < 2; ++n) acc[a][b][m][n] = (f32x4){0.f, 0.f, 0.f, 0.f};
    bf16x8 At[4][2], B0[2][2], B1[2][2];
    const PG8_GAS char* cA = (const PG8_GAS char*)g.A + (size_t)cur.pm * tstep; const PG8_GAS char* cB = (const PG8_GAS char*)g.Bt + (size_t)cur.pn * tstep;
    S.a_ready(cur);
    if constexpr (SP2) {
        PG8_STAGE(PG8_SB(0, 0), cB, voffB); PG8_STAGE(PG8_SB(0, 1), cB + hstep, voffB); PG8_STAGE(PG8_SA(0, 0), cA, voffA); PG8_STAGE(PG8_SA(0, 1), cA + hstep, voffA);
        if (wr == 1) PG8_BAR;
        PG8_WAIT_V(2); PG8_BAR;
        PG8_STAGE(PG8_SB(1, 0), cB + kstep, voffB); PG8_STAGE(PG8_SA(1, 0), cA + kstep, voffA); PG8_STAGE(PG8_SB(1, 1), cB + hstep + kstep, voffB);
        PG8_WAIT_V(6); PG8_BAR;
    } else {
        PG8_STAGE(PG8_SB(0, 0), cB, voffB); PG8_STAGE(PG8_SA(0, 0), cA, voffA); PG8_STAGE(PG8_SB(0, 1), cB + hstep, voffB); PG8_STAGE(PG8_SA(0, 1), cA + hstep, voffA);
        if (wr == 1) PG8_BAR;
        PG8_WAIT_V(4); PG8_BAR;
        PG8_STAGE(PG8_SB(1, 0), cB + kstep, voffB); PG8_STAGE(PG8_SA(1, 0), cA + kstep, voffA); PG8_STAGE(PG8_SB(1, 1), cB + hstep + kstep, voffB);
        PG8_WAIT_V(6); PG8_BAR;
    }
    for (;;) {
        const bool has_next = S.next(ui + 1, nxt);
        const PG8_GAS char* nA = has_next ? (const PG8_GAS char*)g.A + (size_t)nxt.pm * tstep : cA; const PG8_GAS char* nB = has_next ? (const PG8_GAS char*)g.Bt + (size_t)nxt.pn * tstep : cB;
        for (int t = 0; t < nt; t += 2) {
            const bool last = (t == nt - 2);
            const PG8_GAS char* a1 = cA + (size_t)(t + 1) * kstep;
            const PG8_GAS char* a2 = last ? nA : cA + (size_t)(t + 2) * kstep; const PG8_GAS char* b2 = last ? nB : cB + (size_t)(t + 2) * kstep;
            const PG8_GAS char* a3 = a2 + kstep; const PG8_GAS char* b3 = b2 + kstep;
            if (last && has_next) S.a_ready(nxt);
            if constexpr (SP2) {
            PG8_LDB(B0, 0, 0); PG8_LDB(B1, 0, 1); PG8_SCHED; PG8_LDA(At, 0, 0); PG8_STAGE(PG8_SA(1, 1), a1 + hstep, voffA);
            PG8_WAIT_V(8); PG8_WAIT_L(0); PG8_BAR; PG8_MMA(0, 0, At, B0); PG8_MMA(0, 1, At, B1); PG8_BAR; PG8_SCHED;
            PG8_LDA(At, 0, 1); PG8_STAGE(PG8_SB(0, 0), b2, voffB); PG8_STAGE(PG8_SB(0, 1), b2 + hstep, voffB); PG8_STAGE(PG8_SA(0, 0), a2, voffA);
            PG8_WAIT_V(8); PG8_WAIT_L(0); PG8_BAR; PG8_MMA(1, 0, At, B0); PG8_MMA(1, 1, At, B1); PG8_BAR; PG8_SCHED;
            PG8_LDB(B0, 1, 0); PG8_LDB(B1, 1, 1); PG8_SCHED; PG8_LDA(At, 1, 0); PG8_STAGE(PG8_SA(0, 1), a2 + hstep, voffA);
            PG8_WAIT_V(8); PG8_WAIT_L(0); PG8_BAR; PG8_MMA(0, 0, At, B0); PG8_MMA(0, 1, At, B1); PG8_BAR; PG8_SCHED;
            PG8_LDA(At, 1, 1); PG8_STAGE(PG8_SB(1, 0), b3, voffB); PG8_STAGE(PG8_SB(1, 1), b3 + hstep, voffB); PG8_STAGE(PG8_SA(1, 0), a3, voffA);
            PG8_WAIT_V(8); PG8_WAIT_L(0); PG8_BAR; PG8_MMA(1, 0, At, B0); PG8_MMA(1, 1, At, B1); PG8_BAR; PG8_SCHED;
            } else {
            PG8_LDB(B0, 0, 0); PG8_SCHED; PG8_LDA(At, 0, 0); PG8_STAGE(PG8_SA(1, 1), a1 + hstep, voffA);
            PG8_WAIT_L(8); PG8_BAR; PG8_WAIT_L(0); PG8_MMA(0, 0, At, B0); PG8_BAR; PG8_SCHED;
            PG8_LDB(B1, 0, 1); PG8_STAGE(PG8_SB(0, 0), b2, voffB);
            PG8_BAR; PG8_WAIT_L(0); PG8_MMA(0, 1, At, B1); PG8_BAR;
            PG8_LDA(At, 0, 1); PG8_STAGE(PG8_SA(0, 0), a2, voffA);
            PG8_BAR; PG8_WAIT_L(0); PG8_MMA(1, 0, At, B0); PG8_BAR; PG8_SCHED;
            PG8_STAGE(PG8_SB(0, 1), b2 + hstep, voffB);
            PG8_WAIT_V(6); PG8_BAR; PG8_MMA(1, 1, At, B1); PG8_BAR;
            PG8_LDB(B0, 1, 0); PG8_SCHED; PG8_LDA(At, 1, 0); PG8_STAGE(PG8_SA(0, 1), a2 + hstep, voffA);
            PG8_WAIT_L(8); PG8_BAR; PG8_WAIT_L(0); PG8_MMA(0, 0, At, B0); PG8_BAR; PG8_SCHED;
            PG8_LDB(B1, 1, 1); PG8_STAGE(PG8_SB(1, 0), b3, voffB);
            PG8_BAR; PG8_WAIT_L(0); PG8_MMA(0, 1, At, B1); PG8_BAR;
            PG8_LDA(At, 1, 1); PG8_STAGE(PG8_SA(1, 0), a3, voffA);
            PG8_BAR; PG8_WAIT_L(0); PG8_MMA(1, 0, At, B0); PG8_BAR; PG8_SCHED;
            PG8_STAGE(PG8_SB(1, 1), b3 + hstep, voffB);
            PG8_WAIT_V(6); PG8_BAR; PG8_MMA(1, 1, At, B1); PG8_BAR;
            }
        }
        if constexpr (ALIGN_EPI) { if (wr == 0) PG8_BAR; }
        if constexpr (!Epi::AFTER_DRAIN) { E(acc, cur, wr, wc, fr, fq); S.done(cur); }
        if (!has_next) break;
#pragma unroll
        for (int a = 0; a < 2; ++a)
#pragma unroll
            for (int b = 0; b < 2; ++b)
#pragma unroll
                for (int m = 0; m < 4; ++m)
#pragma unroll
                    for (int n = 0; n < 2; ++n) acc[a][b][m][n] = (f32x4){0.f, 0.f, 0.f, 0.f};
        cur = nxt; cA = nA; cB = nB; ++ui;
        if constexpr (ALIGN_EPI) { if (wr == 1) PG8_BAR; }
    }
    PG8_WAIT_V(0);
    if constexpr (!ALIGN_EPI) { if (wr == 0) PG8_BAR; }
    PG8_BAR;
    if constexpr (Epi::AFTER_DRAIN) { E.fused(acc, cur, wr, wc, fr, fq, lds, wid, lane); S.done(cur); }
#undef PG8_SA
#undef PG8_SB
#undef PG8_STAGE
#undef PG8_LDA
#undef PG8_LDB
#undef PG8_MMA
#undef PG8_WAIT_V
#undef PG8_WAIT_L
#undef PG8_BAR
#undef PG8_SCHED
}
}

#ifndef MK_PER_PHASE
#define MK_PER_PHASE 0
#endif
#ifndef PROBE_DOUBLE
#define PROBE_DOUBLE -1
#endif
#define REP(id) for (int rep_ = 0; rep_ < ((PROBE_DOUBLE == (id)) ? 2 : 1); ++rep_)
constexpr int NWAVES = 8, NTHR = 512;
constexpr int BATCH = 2, SEQ = 4096, M = BATCH * SEQ, D = 2048, DEPTH = 4;
constexpr int DI = 4096, NH = 64, HP = 64, NG = 8, HPG = 8, NS = 128, CONVD = 6144;
constexpr int QH = 16, KVH = 4, AD = 128, IH = 16, IDD = 64, TOPK = 256;
constexpr int FF = 4096, FF2 = 8192;
constexpr int NIN = 18576, NMAIN = 18432, NPAD = 18688;
constexpr int PZ = 0, PXBC = 4096, PQ = 10240, PK = 12288, PV = 12800, PQI = 13312, PG = 14336;
constexpr int SMW = 256, SM_DT = 0, SM_KI = 64, SM_WI = 128;
constexpr float EPS = 1e-6f;
constexpr float ATTN_SCALE = 0.08838834764831845f;

constexpr size_t MiB = 1u << 20;
constexpr size_t WS_CTL = 0, CTL_ZERO_BYTES = 1 * MiB;
constexpr size_t WS_W = 2 * MiB;
constexpr size_t WL_IN = 0, WL_SSM = 73 * MiB, WL_ATT = 89 * MiB, WL_MIX = 97 * MiB, WL_UP = 105 * MiB, WL_DN = 137 * MiB, WL_SIZE = 153 * MiB;
constexpr size_t WS_H = WS_W + DEPTH * WL_SIZE;
constexpr size_t WS_P = WS_H + 32 * MiB;
constexpr size_t WS_SM = WS_P + 288 * MiB;
constexpr size_t WS_XC = WS_SM + 8 * MiB;
constexpr size_t WS_DT = WS_XC + 96 * MiB;
constexpr size_t WS_ACS = WS_DT + 2 * MiB;
constexpr size_t WS_ST = WS_ACS + 2 * MiB;
constexpr size_t WS_Y = WS_ST + 256 * MiB;
constexpr size_t WS_SC = WS_Y + 64 * MiB;
constexpr size_t WS_IDX = WS_SC + 128 * MiB;
constexpr size_t WS_CNT = WS_IDX + 8 * MiB;
constexpr size_t WS_AO = WS_CNT + 1 * MiB;
constexpr size_t WS_MG = WS_AO + 32 * MiB;
constexpr size_t WS_MGB = WS_MG + 64 * MiB;
constexpr size_t WS_YM = WS_MGB + 32 * MiB;
constexpr size_t WS_U = WS_YM + 64 * MiB;
constexpr size_t WS_ACT = WS_U + 128 * MiB;
constexpr size_t WS_KIB = WS_ACT + 64 * MiB;
constexpr size_t WS_END = WS_KIB + 1 * MiB;
constexpr int CW_BAR = 4096;

constexpr int RING_BYTES = 139264, LDSCTL_OFF = RING_BYTES, MISC_OFF = LDSCTL_OFF + 320, LDS_BYTES = 147456;

#define LAS __attribute__((address_space(3)))
#define GAS __attribute__((address_space(1)))
typedef unsigned short bf16;
typedef float f32x4 __attribute__((ext_vector_type(4)));
typedef short bf16x8 __attribute__((ext_vector_type(8)));
typedef unsigned u32x4 __attribute__((ext_vector_type(4)));
typedef unsigned u32x2 __attribute__((ext_vector_type(2)));
#define LDS_WAIT() asm volatile("s_waitcnt lgkmcnt(0)" ::: "memory")

__device__ __forceinline__ unsigned f2bf(float f) { unsigned u = __builtin_bit_cast(unsigned, f); return (u + 0x7fffu + ((u >> 16) & 1u)) >> 16; }
__device__ __forceinline__ unsigned pk2(float lo, float hi) { return f2bf(lo) | (f2bf(hi) << 16); }
__device__ __forceinline__ unsigned cvtpk(float lo, float hi) { unsigned r; asm("v_cvt_pk_bf16_f32 %0, %1, %2" : "=v"(r) : "v"(lo), "v"(hi)); return r; }
__device__ __forceinline__ float bflo(unsigned w) { return __uint_as_float(w << 16); }
__device__ __forceinline__ float bfhi(unsigned w) { return __uint_as_float(w & 0xffff0000u); }
__device__ __forceinline__ void unpack8(const u32x4 w, float (&f)[8]) { f[0] = bflo(w.x); f[1] = bfhi(w.x); f[2] = bflo(w.y); f[3] = bfhi(w.y); f[4] = bflo(w.z); f[5] = bfhi(w.z); f[6] = bflo(w.w); f[7] = bfhi(w.w); }
__device__ __forceinline__ u32x4 pack8(const float (&f)[8]) { u32x4 w; w.x = pk2(f[0], f[1]); w.y = pk2(f[2], f[3]); w.z = pk2(f[4], f[5]); w.w = pk2(f[6], f[7]); return w; }
__device__ __forceinline__ float wave_sum(float v) {
#pragma unroll
    for (int o = 1; o < 64; o <<= 1) v += __shfl_xor(v, o);
    return v;
}
__device__ __forceinline__ float wave_max(float v) {
#pragma unroll
    for (int o = 1; o < 64; o <<= 1) v = fmaxf(v, __shfl_xor(v, o));
    return v;
}
__device__ __forceinline__ float siluf_(float x) { return x / (1.0f + __expf(-x)); }

#define XB_TMO      128
#define XB_XCNT(j)  (256  + 64 * (j))
#define XB_XSUB(j)  (1280 + 64 * (j))
#define XB_XGEN(j)  (2304 + 64 * (j))
#define XB_TOP      3328
#define XB_TOPGEN   3392
#define XCD_BAR_WORDS 3456
#define XB_SPIN_CAP (1u << 18)

__device__ __forceinline__ unsigned xb_ld(unsigned* p)              { return __hip_atomic_load(p, __ATOMIC_RELAXED, __HIP_MEMORY_SCOPE_AGENT); }
__device__ __forceinline__ unsigned xb_add(unsigned* p, unsigned v) { return __hip_atomic_fetch_add(p, v, __ATOMIC_RELAXED, __HIP_MEMORY_SCOPE_AGENT); }
__device__ __forceinline__ unsigned xb_xcc_id() { return (unsigned)__builtin_amdgcn_s_getreg((3 << 11) | 20) & 0xFu; }
#define XB_SPIN(cond, bar) do { unsigned _sp = 0; while (cond) { __builtin_amdgcn_s_sleep(1); \
    if ((++_sp & 255u) == 0u) { if (xb_ld(&(bar)[XB_TMO])) break; if (_sp > XB_SPIN_CAP) { atomicAdd(&(bar)[XB_TMO], 1u); break; } } } } while (0)

struct XcdBarrier {
    unsigned* bar; unsigned x;
    volatile LAS unsigned* st;
};

__device__ __forceinline__ XcdBarrier xcd_barrier_post(unsigned* bar, volatile LAS unsigned* st) {
    XcdBarrier b; b.bar = bar; b.x = xb_xcc_id(); b.st = st;
    if (threadIdx.x == 0) (void)xb_add(&bar[XB_XCNT(b.x)], 1u);
    return b;
}
__device__ __forceinline__ void xcd_barrier_complete(unsigned* bar, unsigned x, unsigned& nloc, unsigned& nx) {
    const unsigned G = gridDim.x * gridDim.y * gridDim.z;
    unsigned sum, cnt, mine, sp = 0u;
    for (;;) {
        sum = 0u; cnt = 0u; mine = 0u;
#pragma unroll
        for (unsigned j = 0; j < 16; ++j) { const unsigned c = xb_ld(&bar[XB_XCNT(j)]); sum += c; cnt += (c > 0u) ? 1u : 0u; mine = (j == x) ? c : mine; }
        if (sum == G) break;
        __builtin_amdgcn_s_sleep(1);
        if ((++sp & 255u) == 0u) { if (xb_ld(&bar[XB_TMO])) break; if (sp > XB_SPIN_CAP) { atomicAdd(&bar[XB_TMO], 1u); break; } }
    }
    nloc = mine > 0u ? mine : 1u; nx = cnt > 0u ? cnt : 1u;
}

__device__ __forceinline__ void xcd_barrier(const XcdBarrier& b) {
    asm volatile("s_waitcnt vmcnt(0)" ::: "memory");
    __syncthreads();
    if (threadIdx.x == 0) {
        unsigned* bar = b.bar;
        __builtin_amdgcn_s_waitcnt(0);
        unsigned nloc = b.st[0], nx = b.st[1];
        if (nloc == 0u) { xcd_barrier_complete(bar, b.x, nloc, nx); b.st[0] = nloc; b.st[1] = nx; }
        const unsigned old = xb_add(&bar[XB_XSUB(b.x)], 1u);
        const unsigned gen = old / nloc;
        if (old + 1u == (gen + 1u) * nloc) {
            __builtin_amdgcn_fence(__ATOMIC_RELEASE, "agent");
            asm volatile("s_waitcnt vmcnt(0)" ::: "memory");
            const unsigned og = xb_add(&bar[XB_TOP], 1u);
            const unsigned tg = og / nx;
            if (og + 1u == (tg + 1u) * nx) xb_add(&bar[XB_TOPGEN], 1u);
            else XB_SPIN(xb_ld(&bar[XB_TOPGEN]) == tg, bar);
            __builtin_amdgcn_fence(__ATOMIC_ACQUIRE, "agent");
            xb_add(&bar[XB_XGEN(b.x)], 1u);
            asm volatile("s_waitcnt vmcnt(0)" ::: "memory");
        } else {
            XB_SPIN(xb_ld(&bar[XB_XGEN(b.x)]) == gen, bar);
            __builtin_amdgcn_fence(__ATOMIC_ACQUIRE, "agent");
            asm volatile("s_waitcnt vmcnt(0)" ::: "memory");
        }
    }
    __syncthreads();
}


template <bool XF32IN, bool HASY, bool XF32OUT>
__device__ __forceinline__ void ph_resid_norm(const GAS bf16* Yb, const GAS float* gpost, const GAS float* gnext, const GAS float* Xf_in, const GAS bf16* Xb_in, GAS float* Xf_out, GAS bf16* Xb_out, GAS bf16* H,
                                              int gw, int ngw, int lane) {
    for (int m = gw; m < M; m += ngw) {
        float xv[4][8];
#pragma unroll
        for (int j = 0; j < 4; ++j) { const size_t e = (size_t)m * D + 8 * (lane + 64 * j);
            if (XF32IN) { const f32x4 a = *(const GAS f32x4*)(Xf_in + e), c = *(const GAS f32x4*)(Xf_in + e + 4); xv[j][0] = a.x; xv[j][1] = a.y; xv[j][2] = a.z; xv[j][3] = a.w; xv[j][4] = c.x; xv[j][5] = c.y; xv[j][6] = c.z; xv[j][7] = c.w; }
            else unpack8(*(const GAS u32x4*)(Xb_in + e), xv[j]); }
        if (HASY) {
            float yv[4][8]; float ss = 0.f;
#pragma unroll
            for (int j = 0; j < 4; ++j) { unpack8(*(const GAS u32x4*)(Yb + (size_t)m * D + 8 * (lane + 64 * j)), yv[j]);
#pragma unroll
                for (int i = 0; i < 8; ++i) ss += yv[j][i] * yv[j][i]; }
            const float rstd = rsqrtf(wave_sum(ss) * (1.0f / D) + EPS);
#pragma unroll
            for (int j = 0; j < 4; ++j) { const GAS float* gp = gpost + 8 * (lane + 64 * j); const f32x4 g0 = *(const GAS f32x4*)gp, g1 = *(const GAS f32x4*)(gp + 4);
                xv[j][0] += yv[j][0] * rstd * g0.x; xv[j][1] += yv[j][1] * rstd * g0.y; xv[j][2] += yv[j][2] * rstd * g0.z; xv[j][3] += yv[j][3] * rstd * g0.w;
                xv[j][4] += yv[j][4] * rstd * g1.x; xv[j][5] += yv[j][5] * rstd * g1.y; xv[j][6] += yv[j][6] * rstd * g1.z; xv[j][7] += yv[j][7] * rstd * g1.w; }
        }
#pragma unroll
        for (int j = 0; j < 4; ++j) { const size_t e = (size_t)m * D + 8 * (lane + 64 * j);
            if (XF32OUT) { *(GAS f32x4*)(Xf_out + e) = (f32x4){xv[j][0], xv[j][1], xv[j][2], xv[j][3]}; *(GAS f32x4*)(Xf_out + e + 4) = (f32x4){xv[j][4], xv[j][5], xv[j][6], xv[j][7]}; }
            else *(GAS u32x4*)(Xb_out + e) = pack8(xv[j]); }
        if (gnext) {
            float ss = 0.f;
#pragma unroll
            for (int j = 0; j < 4; ++j)
#pragma unroll
                for (int i = 0; i < 8; ++i) ss += xv[j][i] * xv[j][i];
            const float rstd = rsqrtf(wave_sum(ss) * (1.0f / D) + EPS);
#pragma unroll
            for (int j = 0; j < 4; ++j) { const GAS float* gp = gnext + 8 * (lane + 64 * j); const f32x4 g0 = *(const GAS f32x4*)gp, g1 = *(const GAS f32x4*)(gp + 4);
                float h[8] = {xv[j][0] * rstd * g0.x, xv[j][1] * rstd * g0.y, xv[j][2] * rstd * g0.z, xv[j][3] * rstd * g0.w, xv[j][4] * rstd * g1.x, xv[j][5] * rstd * g1.y, xv[j][6] * rstd * g1.z, xv[j][7] * rstd * g1.w};
                *(GAS u32x4*)(H + (size_t)m * D + 8 * (lane + 64 * j)) = pack8(h); }
        }
    }
}

__device__ __forceinline__ void tr_item(const GAS float* W, int ldw, int K, int k0, int nsrc, int ncols, GAS bf16* WT, int ndst, LAS float* scr, int lane) {
    const int j = lane & 31;
#pragma unroll 8
    for (int i = 0; i < 32; ++i) { const int kk = 2 * i + (lane >> 5); scr[kk * 33 + j] = (j < ncols) ? W[(size_t)(k0 + kk) * ldw + nsrc + j] : 0.f; }
    LDS_WAIT();
    const int c = lane & 7;
#pragma unroll
    for (int jj = 0; jj < 4; ++jj) { const int n = (lane >> 3) + 8 * jj; const LAS float* s = scr + (8 * c) * 33 + n;
        u32x4 o; o.x = pk2(s[0 * 33], s[1 * 33]); o.y = pk2(s[2 * 33], s[3 * 33]); o.z = pk2(s[4 * 33], s[5 * 33]); o.w = pk2(s[6 * 33], s[7 * 33]);
        *(GAS u32x4*)(WT + (size_t)(ndst + n) * K + k0 + 8 * c) = o; }
    LDS_WAIT();
}
__device__ __forceinline__ void win_map(int dstrow, int& src, int& ncols) {
    ncols = 32;
    if (dstrow < 10240) src = dstrow;
    else if (dstrow < 12288) src = dstrow - 10240 + 10304;
    else if (dstrow < 12800) src = dstrow - 12288 + 12352;
    else if (dstrow < 13312) src = dstrow - 12800 + 12864;
    else if (dstrow < 14336) src = dstrow - 13312 + 13376;
    else if (dstrow < 18432) src = dstrow - 14336 + 14480;
    else if (dstrow < 18496) src = dstrow - 18432 + 10240;
    else if (dstrow < 18560) src = dstrow - 18496 + 14400;
    else if (dstrow == 18560) { src = 14464; ncols = 16; }
    else { src = 0; ncols = 0; }
}
struct WPtrs { const GAS float *w_in, *w_ssm, *w_att, *w_mix, *w_up, *w_dn; };
__device__ __forceinline__ void ph_weights(const WPtrs wp, GAS unsigned char* ws, LAS float* scr, int gw, int ngw, int lane) {
    constexpr int I_IN = (NPAD / 32) * (D / 64), I_SSM = (D / 32) * (DI / 64), I_ATT = (D / 32) * (D / 64), I_MIX = I_ATT, I_UP = (FF2 / 32) * (D / 64), I_DN = (D / 32) * (FF / 64);
    constexpr int I_L = I_IN + I_SSM + I_ATT + I_MIX + I_UP + I_DN;
    for (int it = gw; it < DEPTH * I_L; it += ngw) {
        const int layer = it / I_L; int r = it % I_L;
        GAS unsigned char* wl = ws + WS_W + (size_t)layer * WL_SIZE;
        if (r < I_IN) { const int nblk = NPAD / 32, kb = r / nblk, nb = r % nblk; int src, nc; win_map(nb * 32, src, nc);
            tr_item(wp.w_in + (size_t)layer * D * NIN, NIN, D, kb * 64, src, nc, (GAS bf16*)(wl + WL_IN), nb * 32, scr, lane); continue; }
        r -= I_IN;
        if (r < I_SSM) { const int nblk = D / 32, kb = r / nblk, nb = r % nblk; tr_item(wp.w_ssm + (size_t)layer * DI * D, D, DI, kb * 64, nb * 32, 32, (GAS bf16*)(wl + WL_SSM), nb * 32, scr, lane); continue; }
        r -= I_SSM;
        if (r < I_ATT) { const int nblk = D / 32, kb = r / nblk, nb = r % nblk; tr_item(wp.w_att + (size_t)layer * D * D, D, D, kb * 64, nb * 32, 32, (GAS bf16*)(wl + WL_ATT), nb * 32, scr, lane); continue; }
        r -= I_ATT;
        if (r < I_MIX) { const int nblk = D / 32, kb = r / nblk, nb = r % nblk; tr_item(wp.w_mix + (size_t)layer * D * D, D, D, kb * 64, nb * 32, 32, (GAS bf16*)(wl + WL_MIX), nb * 32, scr, lane); continue; }
        r -= I_MIX;
        if (r < I_UP) { const int nblk = FF2 / 32, kb = r / nblk, nb = r % nblk; tr_item(wp.w_up + (size_t)layer * D * FF2, FF2, D, kb * 64, nb * 32, 32, (GAS bf16*)(wl + WL_UP), nb * 32, scr, lane); continue; }
        r -= I_UP;
        { const int nblk = D / 32, kb = r / nblk, nb = r % nblk; tr_item(wp.w_dn + (size_t)layer * FF * D, D, FF, kb * 64, nb * 32, 32, (GAS bf16*)(wl + WL_DN), nb * 32, scr, lane); }
    }
}

__device__ __forceinline__ void ph_small_proj(const GAS bf16* H, const GAS bf16* Ws, GAS float* SM, GAS bf16* KIB, LAS unsigned char* lds, int blk, int nblk, int tid) {
    constexpr int HS = 4112;
    const int lane = tid & 63, wave = __builtin_amdgcn_readfirstlane(tid >> 6), g = lane >> 4, c16 = lane & 15;
    for (int rb = blk; rb < M / 32; rb += nblk) {
        __syncthreads();
#pragma unroll
        for (int i = 0; i < 16; ++i) { const int id = tid + 512 * i, r = id >> 8, ch = id & 255;
            *(LAS u32x4*)(lds + r * HS + ch * 16) = *(const GAS u32x4*)(H + (size_t)(rb * 32 + r) * D + ch * 8); }
        __syncthreads();
        f32x4 acc[2] = {(f32x4){0.f, 0.f, 0.f, 0.f}, (f32x4){0.f, 0.f, 0.f, 0.f}}, acc9[2] = {(f32x4){0.f, 0.f, 0.f, 0.f}, (f32x4){0.f, 0.f, 0.f, 0.f}};
        const GAS bf16* wrow = Ws + (size_t)(16 * wave + c16) * D + 8 * g;
        const GAS bf16* w9 = Ws + (size_t)(128 + c16) * D + 256 * wave + 8 * g;
        const LAS unsigned char* hb = lds + c16 * HS + g * 16;
#pragma unroll 8
        for (int ks = 0; ks < 64; ++ks) {
            const bf16x8 wf = *(const GAS bf16x8*)(wrow + 32 * ks);
            const bf16x8 h0 = *(const LAS bf16x8*)(hb + ks * 64), h1 = *(const LAS bf16x8*)(hb + 16 * HS + ks * 64);
            acc[0] = __builtin_amdgcn_mfma_f32_16x16x32_bf16(wf, h0, acc[0], 0, 0, 0); acc[1] = __builtin_amdgcn_mfma_f32_16x16x32_bf16(wf, h1, acc[1], 0, 0, 0);
        }
#pragma unroll
        for (int k8 = 0; k8 < 8; ++k8) { const int ks = 8 * wave + k8;
            const bf16x8 wf = *(const GAS bf16x8*)(w9 + 32 * k8);
            const bf16x8 h0 = *(const LAS bf16x8*)(hb + ks * 64), h1 = *(const LAS bf16x8*)(hb + 16 * HS + ks * 64);
            acc9[0] = __builtin_amdgcn_mfma_f32_16x16x32_bf16(wf, h0, acc9[0], 0, 0, 0); acc9[1] = __builtin_amdgcn_mfma_f32_16x16x32_bf16(wf, h1, acc9[1], 0, 0, 0);
        }
#pragma unroll
        for (int rt = 0; rt < 2; ++rt) { const size_t row = (size_t)(rb * 32 + 16 * rt + c16);
            *(GAS f32x4*)(SM + row * SMW + 16 * wave + 4 * g) = acc[rt];
            if (wave >= 4) { u32x2 w; w.x = cvtpk(acc[rt].x, acc[rt].y); w.y = cvtpk(acc[rt].z, acc[rt].w); *(GAS u32x2*)(KIB + row * IDD + 16 * (wave - 4) + 4 * g) = w; } }
        __syncthreads();
        *(LAS f32x4*)(lds + ((wave * 2 + 0) * 64 + lane) * 16) = acc9[0]; *(LAS f32x4*)(lds + ((wave * 2 + 1) * 64 + lane) * 16) = acc9[1];
        __syncthreads();
        if (wave < 2) { f32x4 s = (f32x4){0.f, 0.f, 0.f, 0.f};
#pragma unroll
            for (int w8 = 0; w8 < 8; ++w8) s += *(const LAS f32x4*)(lds + ((w8 * 2 + wave) * 64 + lane) * 16);
            *(GAS f32x4*)(SM + (size_t)(rb * 32 + 16 * wave + c16) * SMW + 128 + 4 * g) = s; }
    }
}

__device__ __forceinline__ void ph_index_scores(const GAS bf16* P, const GAS float* SM, const GAS bf16* KIB, GAS float* SC, LAS unsigned char* lds, int blk, int nblk, int tid) {
    constexpr int QS = 1040;
    const int lane = tid & 63, wave = __builtin_amdgcn_readfirstlane(tid >> 6);
    for (int u0 = blk; u0 < 256; u0 += nblk) {
#pragma unroll 1
        for (int half = 0; half < 2; ++half) {
            const int b = half, qt = half ? 255 - u0 : u0;
            const int q0 = b * SEQ + qt * 16, nkt = ((qt * 16) / 64 + 1) * 4;
            const int qrow = q0 + (lane & 15), kq = 8 * (lane >> 4);
            __syncthreads();
#pragma unroll
            for (int i = 0; i < 2; ++i) { const int id = tid + 512 * i, q = id >> 6, ch = id & 63;
                *(LAS u32x4*)(lds + q * QS + ch * 16) = *(const GAS u32x4*)(P + (size_t)(q0 + q) * NMAIN + PQI + 8 * IDD + ch * 8); }
            bf16x8 bq[8][2]; float w[IH];
#pragma unroll
            for (int h = 0; h < IH; ++h) {
                if (h < 8) {
#pragma unroll
                    for (int ks = 0; ks < 2; ++ks) bq[h][ks] = *(const GAS bf16x8*)(P + (size_t)qrow * NMAIN + PQI + h * IDD + ks * 32 + kq); }
                w[h] = SM[(size_t)qrow * SMW + SM_WI + h]; }
            __syncthreads();
            const LAS unsigned char* qb = lds + (lane & 15) * QS + kq * 2;
            for (int kt = wave; kt < nkt; kt += NWAVES) {
                const int key0 = kt * 16; const GAS bf16* kp = KIB + (size_t)(b * SEQ + key0 + (lane & 15)) * IDD + kq;
                const bf16x8 a0 = *(const GAS bf16x8*)kp, a1 = *(const GAS bf16x8*)(kp + 32);
                f32x4 sc = (f32x4){0.f, 0.f, 0.f, 0.f};
#pragma unroll
                for (int h = 0; h < IH; ++h) { f32x4 c = (f32x4){0.f, 0.f, 0.f, 0.f};
                    const bf16x8 b0 = h < 8 ? bq[h & 7][0] : *(const LAS bf16x8*)(qb + (h - 8) * 128), b1 = h < 8 ? bq[h & 7][1] : *(const LAS bf16x8*)(qb + (h - 8) * 128 + 64);
                    c = __builtin_amdgcn_mfma_f32_16x16x32_bf16(a0, b0, c, 0, 0, 0); c = __builtin_amdgcn_mfma_f32_16x16x32_bf16(a1, b1, c, 0, 0, 0);
                    sc.x += w[h] * fmaxf(c.x, 0.f); sc.y += w[h] * fmaxf(c.y, 0.f); sc.z += w[h] * fmaxf(c.z, 0.f); sc.w += w[h] * fmaxf(c.w, 0.f); }
                *(GAS f32x4*)(SC + (size_t)qrow * SEQ + key0 + 4 * (lane >> 4)) = sc;
            }
        }
    }
}

__device__ __forceinline__ void topk_bitwise(const GAS float* srow, GAS unsigned long long* mw, int limit, int lane) {
    unsigned u[64];
#pragma unroll
    for (int j = 0; j < 64; ++j) { const int key = j * 64 + lane; unsigned v = 0u;
        if (key < limit) { const unsigned bits = __float_as_uint(srow[key]); v = (bits & 0x80000000u) ? ~bits : (bits | 0x80000000u); }
        u[j] = v; }
    unsigned T = 0u;
#pragma unroll 1
    for (int bit = 31; bit >= 0; --bit) { const unsigned cand = T | (1u << bit); int cnt = 0;
#pragma unroll
        for (int j = 0; j < 64; ++j) cnt += __popcll(__ballot(u[j] >= cand));
        if (cnt >= TOPK) T = cand; }
    int cgt = 0;
#pragma unroll
    for (int j = 0; j < 64; ++j) cgt += __popcll(__ballot(u[j] > T));
    const int need_eq = TOPK - cgt; int eqbase = 0;
    const unsigned long long lt_mask = (1ull << lane) - 1ull;
#pragma unroll
    for (int j = 0; j < 64; ++j) {
        const bool gt = u[j] > T, eq = u[j] == T;
        const unsigned long long eqm = __ballot(eq);
        const bool take = gt || (eq && (eqbase + __popcll(eqm & lt_mask) < need_eq));
        const unsigned long long tm = __ballot(take);
        if (lane == 0 && j * 64 < limit) mw[j] = tm;
        eqbase += __popcll(eqm);
    }
}
__device__ __forceinline__ void ph_topk(const GAS float* SC, GAS unsigned long long* MASKW, LAS unsigned char* wl, int gw, int ngw, int lane) {
    constexpr int CAP = 1024;
    LAS unsigned* hist = (LAS unsigned*)wl;
    LAS unsigned* maskc = (LAS unsigned*)(wl + 1024);
    LAS float* cval = (LAS float*)(wl + 1536);
    LAS unsigned* ckey = (LAS unsigned*)(wl + 1536 + 4 * CAP);
    const unsigned long long lt_mask = (1ull << lane) - 1ull;
    for (int m = gw; m < M; m += ngw) {
        const int t = m & (SEQ - 1), limit = (t / 64 + 1) * 64, nw = limit / 64;
        GAS unsigned long long* mw = MASKW + (size_t)m * 64;
        if (limit <= TOPK) { unsigned ones = 0xffffffffu; asm volatile("" : "+v"(ones)); if (lane < nw) mw[lane] = ((unsigned long long)ones << 32) | ones; continue; }
        const GAS float* srow = SC + (size_t)m * SEQ;
        float s[64]; float smax = -__builtin_inff(), smin = __builtin_inff();
#pragma unroll
        for (int j = 0; j < 64; ++j) { s[j] = (j < nw) ? srow[j * 64 + lane] : 0.f; if (j < nw) { smax = fmaxf(smax, s[j]); smin = fminf(smin, s[j]); } }
        smax = wave_max(smax); smin = -wave_max(-smin);
        const float scale = smax > smin ? 255.0f / (smax - smin) : 0.f;
        asm volatile("" ::: "memory");
        hist[lane] = 0u; hist[lane + 64] = 0u; hist[lane + 128] = 0u; hist[lane + 192] = 0u; maskc[lane] = 0u; maskc[lane + 64] = 0u;
        LDS_WAIT();
#pragma unroll
        for (int j = 0; j < 64; ++j) if (j < nw) { const int b = min(255, (int)((s[j] - smin) * scale)); __hip_atomic_fetch_add(&hist[b], 1u, __ATOMIC_RELAXED, __HIP_MEMORY_SCOPE_WORKGROUP); }
        LDS_WAIT();
        const unsigned c0 = hist[4 * lane], c1 = hist[4 * lane + 1], c2 = hist[4 * lane + 2], c3 = hist[4 * lane + 3];
        unsigned suf = c0 + c1 + c2 + c3;
#pragma unroll
        for (int o = 1; o < 64; o <<= 1) { const unsigned v = __shfl_down(suf, o); if (lane + o < 64) suf += v; }
        const unsigned above = suf - (c0 + c1 + c2 + c3);
        int bstar = -1; unsigned cab = 0u;
        { unsigned cum = above;
          if (cum < TOPK && cum + c3 >= TOPK) { bstar = 4 * lane + 3; cab = cum; } cum += c3;
          if (bstar < 0 && cum < TOPK && cum + c2 >= TOPK) { bstar = 4 * lane + 2; cab = cum; } cum += c2;
          if (bstar < 0 && cum < TOPK && cum + c1 >= TOPK) { bstar = 4 * lane + 1; cab = cum; } cum += c1;
          if (bstar < 0 && cum < TOPK && cum + c0 >= TOPK) { bstar = 4 * lane + 0; cab = cum; } }
        const unsigned long long who = __ballot(bstar >= 0);
        const int src = __builtin_ctzll(who);
        bstar = __shfl(bstar, src); cab = __shfl(cab, src);
        const int need = TOPK - (int)cab;
        const unsigned ncand = hist[bstar];
        if (ncand > (unsigned)CAP) { topk_bitwise(srow, mw, limit, lane); continue; }
        unsigned long long myword = 0ull; int base = 0;
#pragma unroll
        for (int j = 0; j < 64; ++j) if (j < nw) {
            const int b = min(255, (int)((s[j] - smin) * scale));
            const unsigned long long gm = __ballot(b > bstar), em = __ballot(b == bstar);
            if (lane == j) myword = gm;
            if (b == bstar) { const int pos = base + __popcll(em & lt_mask); cval[pos] = s[j]; ckey[pos] = (unsigned)(j * 64 + lane); }
            base += __popcll(em);
        }
        LDS_WAIT();
        for (int i = lane; i < base; i += 64) { const float vi = cval[i]; const unsigned ki = ckey[i]; int rank = 0;
            if (need < base) { for (int q = 0; q < base; ++q) { const float vq = cval[q]; const unsigned kq = ckey[q]; rank += (vq > vi || (vq == vi && kq < ki)) ? 1 : 0; } }
            if (rank < need) __hip_atomic_fetch_or(&maskc[ki >> 5], 1u << (ki & 31), __ATOMIC_RELAXED, __HIP_MEMORY_SCOPE_WORKGROUP); }
        LDS_WAIT();
        if (lane < nw) { const unsigned long long cw_ = ((unsigned long long)maskc[2 * lane + 1] << 32) | maskc[2 * lane]; mw[lane] = myword | cw_; }
        LDS_WAIT(); asm volatile("" ::: "memory");
    }
}

typedef short s16x4 __attribute__((ext_vector_type(4)));
__device__ __forceinline__ s16x4 lds_tr4(const LAS unsigned char* p) { return __builtin_bit_cast(s16x4, __builtin_amdgcn_ds_read_tr16_b64_v4i16((LAS s16x4*)p)); }
__device__ __forceinline__ float xmax16(float x) { auto r = __builtin_amdgcn_permlane16_swap(__float_as_uint(x), __float_as_uint(x), false, false); return fmaxf(__uint_as_float(r[0]), __uint_as_float(r[1])); }
__device__ __forceinline__ float xmax32(float x) { auto r = __builtin_amdgcn_permlane32_swap(__float_as_uint(x), __float_as_uint(x), false, false); return fmaxf(__uint_as_float(r[0]), __uint_as_float(r[1])); }
__device__ __forceinline__ float xsum16(float x) { auto r = __builtin_amdgcn_permlane16_swap(__float_as_uint(x), __float_as_uint(x), false, false); return __uint_as_float(r[0]) + __uint_as_float(r[1]); }
__device__ __forceinline__ float xsum32(float x) { auto r = __builtin_amdgcn_permlane32_swap(__float_as_uint(x), __float_as_uint(x), false, false); return __uint_as_float(r[0]) + __uint_as_float(r[1]); }
template <int VAR> __device__ __forceinline__ void ph_attn_dense(const GAS bf16* P, const GAS unsigned long long* MASKW, GAS bf16* AO, LAS unsigned char* lds, int blk, int nblk, int tid) {
    constexpr int KS = 272, VS = 288, KBUF = 64 * KS, VBUF = 64 * VS, VOFF = 2 * KBUF, MOFF = VOFF + 2 * VBUF;
    const int lane = tid & 63, wave = __builtin_amdgcn_readfirstlane(tid >> 6), g = lane >> 4, c16 = lane & 15;
    const int hq = wave >> 1, qh = (wave & 1) * 32;
    const float SCL = ATTN_SCALE * 1.4426950408889634f;
    for (int u0 = blk; u0 < 256; u0 += nblk) {
#pragma unroll 1
        for (int half = 0; half < 2; ++half) {
            const int b = (u0 >> 2) & 1, kvh = u0 & 3, cc = u0 >> 3, c = half ? 63 - cc : cc, nt = c + 1;
            const int m0 = b * SEQ + c * 64;
            bf16x8 qf[2][4];
#pragma unroll
            for (int qt = 0; qt < 2; ++qt)
#pragma unroll
                for (int kd = 0; kd < 4; ++kd) qf[qt][kd] = *(const GAS bf16x8*)(P + (size_t)(m0 + qh + 16 * qt + c16) * NMAIN + PQ + (kvh * 4 + hq) * AD + 32 * kd + 8 * g);
            f32x4 O[2][8];
#pragma unroll
            for (int qt = 0; qt < 2; ++qt)
#pragma unroll
                for (int dt = 0; dt < 8; ++dt) O[qt][dt] = (f32x4){0.f, 0.f, 0.f, 0.f};
            float mrun[2] = {-1e30f, -1e30f}, lrun[2] = {0.f, 0.f};
            const GAS bf16* kvbase = P + (size_t)(b * SEQ) * NMAIN + kvh * AD;
            u32x4 kreg[2], vreg[2];
#define ATT_LOAD(t) do { _Pragma("unroll") for (int i = 0; i < 2; ++i) { const int id = tid + 512 * i; const GAS bf16* src = kvbase + (size_t)((t) * 64 + (id >> 4)) * NMAIN + (id & 15) * 8; \
                kreg[i] = *(const GAS u32x4*)(src + PK); vreg[i] = *(const GAS u32x4*)(src + PV); } } while (0)
#define ATT_STORE(buf) do { _Pragma("unroll") for (int i = 0; i < 2; ++i) { const int id = tid + 512 * i; \
                *(LAS u32x4*)(lds + (buf) * KBUF + (id >> 4) * KS + (id & 15) * 16) = kreg[i]; *(LAS u32x4*)(lds + VOFF + (buf) * VBUF + (id >> 4) * VS + (id & 15) * 16) = vreg[i]; } } while (0)
            __syncthreads();
            ATT_LOAD(0); ATT_STORE(0);
#pragma unroll
            for (int i = 0; i < 4; ++i) { const int id = tid + 512 * i; *(LAS u32x4*)(lds + MOFF + id * 16) = *(const GAS u32x4*)((const GAS unsigned char*)(MASKW + (size_t)m0 * 64) + id * 16); }
            const LAS unsigned long long* mrow0 = (const LAS unsigned long long*)(lds + MOFF) + (qh + c16) * 64; const LAS unsigned long long* mrow1 = mrow0 + 16 * 64;
            __syncthreads();
            for (int t = 0; t < nt; ++t) {
                const int buf = (VAR & 1) ? 0 : (t & 1);
                if (!(VAR & 1) && t + 1 < nt) ATT_LOAD(t + 1);
                const LAS unsigned char* kb = lds + buf * KBUF + c16 * KS + g * 16;
                const LAS unsigned char* vb = lds + VOFF + buf * VBUF + (4 * g + (c16 >> 2)) * VS + (c16 & 3) * 8;
                f32x4 S[2][4];
                bf16x8 kf[2][4];
#pragma unroll
                for (int kd = 0; kd < 4; ++kd) kf[0][kd] = *(const LAS bf16x8*)(kb + kd * 64);
#pragma unroll
                for (int kt = 0; kt < 4; ++kt) {
                    if (kt < 3) {
#pragma unroll
                        for (int kd = 0; kd < 4; ++kd) kf[(kt + 1) & 1][kd] = *(const LAS bf16x8*)(kb + (kt + 1) * 16 * KS + kd * 64); }
#pragma unroll
                    for (int qt = 0; qt < 2; ++qt) { f32x4 s = (f32x4){0.f, 0.f, 0.f, 0.f};
#pragma unroll
                        for (int kd = 0; kd < 4; ++kd) { if (!(VAR & 8)) s = __builtin_amdgcn_mfma_f32_16x16x32_bf16(kf[kt & 1][kd], qf[qt][kd], s, 0, 0, 0); else s += __builtin_bit_cast(f32x4, kf[kt & 1][kd]); }
                        S[qt][kt] = s; }
                }
                s16x4 vlo[8][2], vhi[8][2];
#pragma unroll
                for (int dt = 0; dt < 4; ++dt)
#pragma unroll
                    for (int ks = 0; ks < 2; ++ks) { vlo[dt][ks] = lds_tr4(vb + (32 * ks) * VS + dt * 32); vhi[dt][ks] = lds_tr4(vb + (32 * ks + 16) * VS + dt * 32); }
                bf16x8 pf[2][2];
#pragma unroll
                for (int qt = 0; qt < 2; ++qt) {
                    const unsigned long long mw = (qt ? mrow1[t] : mrow0[t]) >> (4 * g);
                    const int mlo = (int)(unsigned)mw, mhi = (int)(unsigned)(mw >> 32);
                    float mx = fmaxf(fmaxf(S[qt][0][0], S[qt][0][1]), fmaxf(S[qt][0][2], S[qt][0][3]));
#pragma unroll
                    for (int kt = 1; kt < 4; ++kt) mx = fmaxf(fmaxf(mx, S[qt][kt][0]), fmaxf(fmaxf(S[qt][kt][1], S[qt][kt][2]), S[qt][kt][3]));
                    mx = xmax16(mx); mx = xmax32(mx);
                    const float mnew = fmaxf(mrun[qt], mx * SCL);
                    const float alpha = __builtin_amdgcn_exp2f(mrun[qt] - mnew);
                    float ps = 0.f;
#pragma unroll
                    for (int kt = 0; kt < 4; ++kt)
#pragma unroll
                        for (int j = 0; j < 4; ++j) { const int sel = __builtin_amdgcn_sbfe(kt < 2 ? mlo : mhi, (kt & 1) * 16 + j, 1);
                            const float p = (VAR & 2) ? S[qt][kt][j] : __uint_as_float(__float_as_uint(__builtin_amdgcn_exp2f(__builtin_fmaf(S[qt][kt][j], SCL, -mnew))) & (unsigned)sel); S[qt][kt][j] = p; ps += p; }
                    ps = xsum16(ps); ps = xsum32(ps);
                    lrun[qt] = lrun[qt] * alpha + ps; mrun[qt] = mnew;
                    if (!__all(alpha == 1.0f)) {
#pragma unroll
                        for (int dt = 0; dt < 8; ++dt) O[qt][dt] *= alpha; }
#pragma unroll
                    for (int ks = 0; ks < 2; ++ks) { u32x4 w; w.x = cvtpk(S[qt][2 * ks][0], S[qt][2 * ks][1]); w.y = cvtpk(S[qt][2 * ks][2], S[qt][2 * ks][3]);
                        w.z = cvtpk(S[qt][2 * ks + 1][0], S[qt][2 * ks + 1][1]); w.w = cvtpk(S[qt][2 * ks + 1][2], S[qt][2 * ks + 1][3]); pf[qt][ks] = __builtin_bit_cast(bf16x8, w); }
                }
#pragma unroll
                for (int dt = 4; dt < 8; ++dt)
#pragma unroll
                    for (int ks = 0; ks < 2; ++ks) { vlo[dt][ks] = lds_tr4(vb + (32 * ks) * VS + dt * 32); vhi[dt][ks] = lds_tr4(vb + (32 * ks + 16) * VS + dt * 32); }
#pragma unroll
                for (int dt = 0; dt < 8; ++dt)
#pragma unroll
                    for (int ks = 0; ks < 2; ++ks) {
                        const bf16x8 vf = __builtin_shufflevector(vlo[dt][ks], vhi[dt][ks], 0, 1, 2, 3, 4, 5, 6, 7);
                        if (!(VAR & 4)) { O[0][dt] = __builtin_amdgcn_mfma_f32_16x16x32_bf16(vf, pf[0][ks], O[0][dt], 0, 0, 0);
                        O[1][dt] = __builtin_amdgcn_mfma_f32_16x16x32_bf16(vf, pf[1][ks], O[1][dt], 0, 0, 0); } else { O[0][dt] += __builtin_bit_cast(f32x4, pf[0][ks]); O[1][dt] += __builtin_bit_cast(f32x4, pf[1][ks]); }
                    }
                if (!(VAR & 1) && t + 1 < nt) ATT_STORE(buf ^ 1);
                __syncthreads();
            }
#undef ATT_LOAD
#undef ATT_STORE
#pragma unroll
            for (int qt = 0; qt < 2; ++qt) { const float r = 1.0f / lrun[qt];
                GAS bf16* op = AO + (size_t)(m0 + qh + 16 * qt + c16) * D + (kvh * 4 + hq) * AD + 4 * g;
#pragma unroll
                for (int dt = 0; dt < 8; ++dt) { const f32x4 o = O[qt][dt] * r; u32x2 w; w.x = pk2(o.x, o.y); w.y = pk2(o.z, o.w); *(GAS u32x2*)(op + 16 * dt) = w; } }
        }
    }
}

__device__ __forceinline__ void stage_conv(const GAS bf16* P, const GAS float* cw, const GAS float* cb, int m0, int tpos0, int ch0, int nch, LAS unsigned char* dst, int stride, int tid) {
    const int cpr = nch >> 3;
    for (int id = tid; id < 64 * cpr; id += NTHR) {
        const int s = id / cpr, k = id - s * cpr, ch = ch0 + 8 * k;
        float acc[8];
        { const f32x4 b0 = *(const GAS f32x4*)(cb + ch), b1 = *(const GAS f32x4*)(cb + ch + 4); acc[0] = b0.x; acc[1] = b0.y; acc[2] = b0.z; acc[3] = b0.w; acc[4] = b1.x; acc[5] = b1.y; acc[6] = b1.z; acc[7] = b1.w; }
#pragma unroll
        for (int i = 0; i < 4; ++i) { if (tpos0 + s - 3 + i >= 0) {
            float x[8]; unpack8(*(const GAS u32x4*)(P + (size_t)(m0 + s - 3 + i) * NMAIN + PXBC + ch), x);
            const f32x4 w0 = *(const GAS f32x4*)(cw + i * CONVD + ch), w1 = *(const GAS f32x4*)(cw + i * CONVD + ch + 4);
            acc[0] += w0.x * x[0]; acc[1] += w0.y * x[1]; acc[2] += w0.z * x[2]; acc[3] += w0.w * x[3]; acc[4] += w1.x * x[4]; acc[5] += w1.y * x[5]; acc[6] += w1.z * x[6]; acc[7] += w1.w * x[7]; } }
#pragma unroll
        for (int j = 0; j < 8; ++j) acc[j] = siluf_(acc[j]);
        *(LAS u32x4*)(dst + s * stride + k * 16) = pack8(acc);
    }
}
__device__ __forceinline__ void wave_dt_acs(const GAS float* SM, const GAS float* dt_bias, const GAS float* a_log, int m0, int head, LAS float* dtw, LAS float* acsw, int lane) {
    const float raw = SM[(size_t)(m0 + lane) * SMW + SM_DT + head] + dt_bias[head];
    const float dt = fmaxf(raw, 0.f) + log1pf(__expf(-fabsf(raw)));
    float x = dt * (-__expf(a_log[head]));
#pragma unroll
    for (int o = 1; o < 64; o <<= 1) { const float v = __shfl_up(x, o); if (lane >= o) x += v; }
    dtw[lane] = dt; acsw[lane] = x;
}
__device__ __forceinline__ bf16x8 tr8(const LAS unsigned char* p, int off_lo, int off_hi) {
    const s16x4 lo = lds_tr4(p + off_lo), hi = lds_tr4(p + off_hi); return __builtin_shufflevector(lo, hi, 0, 1, 2, 3, 4, 5, 6, 7);
}
template <int NOUT> __device__ __forceinline__ void conv_strip(const GAS bf16* src, int tpos_first_raw, const GAS float* cw, const GAS float* cb, u32x4 (&out)[NOUT]) {
    u32x4 raw[NOUT + 3];
#pragma unroll
    for (int i = 0; i < NOUT + 3; ++i) { const int tp = tpos_first_raw + i; raw[i] = *(const GAS u32x4*)(src + (size_t)(tp < 0 ? 3 : i) * NMAIN); if (tp < 0) raw[i] = (u32x4){0u, 0u, 0u, 0u}; }
    f32x4 w[4][2];
#pragma unroll
    for (int t = 0; t < 4; ++t) { w[t][0] = *(const GAS f32x4*)(cw + t * CONVD); w[t][1] = *(const GAS f32x4*)(cw + t * CONVD + 4); }
    const f32x4 b0 = *(const GAS f32x4*)cb, b1 = *(const GAS f32x4*)(cb + 4);
#pragma unroll
    for (int o = 0; o < NOUT; ++o) { f32x4 a0 = b0, a1 = b1;
#pragma unroll
        for (int t = 0; t < 4; ++t) { float x[8]; unpack8(raw[o + t], x); a0 += w[t][0] * (f32x4){x[0], x[1], x[2], x[3]}; a1 += w[t][1] * (f32x4){x[4], x[5], x[6], x[7]}; }
        float f[8] = {a0.x, a0.y, a0.z, a0.w, a1.x, a1.y, a1.z, a1.w};
#pragma unroll
        for (int j = 0; j < 8; ++j) f[j] = f[j] * __builtin_amdgcn_rcpf(1.0f + __expf(-f[j]));
        out[o] = pack8(f); }
}
__device__ __forceinline__ void ph_ssd_states(const GAS bf16* P, const GAS float* SM, const GAS float* cw, const GAS float* cb, const GAS float* dt_bias, const GAS float* a_log, GAS bf16* XC, GAS bf16* ST, GAS float* CD,
                                              LAS unsigned char* lds, int blk, int nblk, int tid) {
    constexpr int RSW = 160, XW = 64 * RSW, RSB = 288, BMB = 64 * RSB, O_BM = 8 * XW, O_DT = O_BM + 2 * BMB, O_ACS = O_DT + 2048;
    const int lane = tid & 63, wave = __builtin_amdgcn_readfirstlane(tid >> 6), gq = lane >> 4, c16 = lane & 15;
    LAS unsigned char* xw = lds + wave * XW;
    LAS float* dtw = (LAS float*)(lds + O_DT) + wave * 64; LAS float* acsw = (LAS float*)(lds + O_ACS) + wave * 64;
    int par = 0;
    for (int item = blk; item < BATCH * 64 * NG; item += nblk, par ^= 1) {
        const int bc = item >> 3, g = item & 7, m0 = bc * 64, tpos0 = (bc & 63) * 64, head = g * HPG + wave;
        LAS unsigned char* bm = lds + O_BM + par * BMB;
        asm volatile("" ::: "memory");
        { const int k16 = lane & 15, r0 = 8 * wave + 2 * gq, chB = DI + g * NS + 8 * k16;
          const GAS bf16* base = P + (size_t)(m0 + r0 - 3) * NMAIN + PXBC + chB;
          u32x4 ob[2], oc[2];
          conv_strip<2>(base, tpos0 + r0 - 3, cw + chB, cb + chB, ob);
          conv_strip<2>(base + NG * NS, tpos0 + r0 - 3, cw + chB + NG * NS, cb + chB + NG * NS, oc);
#pragma unroll
          for (int o = 0; o < 2; ++o) { *(LAS u32x4*)(bm + (r0 + o) * RSB + k16 * 16) = ob[o];
              *(GAS u32x4*)(XC + (size_t)(m0 + r0 + o) * CONVD + chB) = ob[o]; *(GAS u32x4*)(XC + (size_t)(m0 + r0 + o) * CONVD + chB + NG * NS) = oc[o]; } }
        { const int k8 = lane & 7, r0 = 8 * (lane >> 3), ch = head * HP + 8 * k8;
          u32x4 ox[8];
          conv_strip<8>(P + (size_t)(m0 + r0 - 3) * NMAIN + PXBC + ch, tpos0 + r0 - 3, cw + ch, cb + ch, ox);
#pragma unroll
          for (int o = 0; o < 8; ++o) { *(LAS u32x4*)(xw + (r0 + o) * RSW + k8 * 16) = ox[o]; *(GAS u32x4*)(XC + (size_t)(m0 + r0 + o) * CONVD + ch) = ox[o]; } }
        wave_dt_acs(SM, dt_bias, a_log, m0, head, dtw, acsw, lane);
        LDS_WAIT();
        __syncthreads();
        const float aend = acsw[63];
        if (lane == 0) CD[bc * NH + head] = __expf(aend);
        const LAS unsigned char* xb = xw + (4 * gq + (c16 >> 2)) * RSW + (c16 & 3) * 8;
        const LAS unsigned char* bb = bm + (4 * gq + (c16 >> 2)) * RSB + (c16 & 3) * 8;
        bf16x8 xf[4][2];
#pragma unroll
        for (int ks = 0; ks < 2; ++ks) { float w[8];
#pragma unroll
            for (int j = 0; j < 8; ++j) { const int s = 32 * ks + 16 * (j >> 2) + 4 * gq + (j & 3); w[j] = dtw[s] * __expf(aend - acsw[s]); }
#pragma unroll
            for (int pt = 0; pt < 4; ++pt) { const bf16x8 r = tr8(xb + pt * 32, (32 * ks) * RSW, (32 * ks + 16) * RSW); float f[8]; unpack8(__builtin_bit_cast(u32x4, r), f);
#pragma unroll
                for (int j = 0; j < 8; ++j) f[j] *= w[j];
                xf[pt][ks] = __builtin_bit_cast(bf16x8, pack8(f)); } }
        GAS bf16* dst = ST + (((size_t)bc * NH + head) * HP + c16) * NS + 4 * gq;
#pragma unroll 2
        for (int nt = 0; nt < 8; ++nt) {
            const bf16x8 a0 = tr8(bb + nt * 32, 0, 16 * RSB), a1 = tr8(bb + nt * 32, 32 * RSB, 48 * RSB);
#pragma unroll
            for (int pt = 0; pt < 4; ++pt) { f32x4 acc = (f32x4){0.f, 0.f, 0.f, 0.f};
                acc = __builtin_amdgcn_mfma_f32_16x16x32_bf16(a0, xf[pt][0], acc, 0, 0, 0); acc = __builtin_amdgcn_mfma_f32_16x16x32_bf16(a1, xf[pt][1], acc, 0, 0, 0);
                u32x2 o; o.x = pk2(acc.x, acc.y); o.y = pk2(acc.z, acc.w); *(GAS u32x2*)(dst + (size_t)(16 * pt) * NS + 16 * nt) = o; }
        }
        LDS_WAIT(); asm volatile("" ::: "memory");
    }
}
__device__ __forceinline__ void ph_ssd_scan(GAS bf16* ST, const GAS float* CD, int gtid, int nthr) {
    for (int it = gtid; it < BATCH * NH * HP * (NS / 8); it += nthr) {
        const int n8 = it & 15, p = (it >> 4) & 63, head = (it >> 10) & 63, b = it >> 16;
        float h[8];
#pragma unroll
        for (int j = 0; j < 8; ++j) h[j] = 0.f;
#pragma unroll 8
        for (int c = 0; c < 64; ++c) { GAS u32x4* q = (GAS u32x4*)(ST + ((((size_t)(b * 64 + c)) * NH + head) * HP + p) * NS) + n8;
            float v[8]; unpack8(*q, v); *q = pack8(h); const float dec = CD[(b * 64 + c) * NH + head];
#pragma unroll
            for (int j = 0; j < 8; ++j) h[j] = h[j] * dec + v[j]; }
    }
}
__device__ __forceinline__ void ph_ssd_out(const GAS bf16* P, const GAS float* SM, const GAS bf16* XC, const GAS float* dt_bias, const GAS float* a_log, const GAS bf16* ST,
                                           const GAS float* dskip, const GAS float* gnorm, GAS bf16* Y, LAS unsigned char* lds, int blk, int nblk, int tid) {
    constexpr int RSW = 160, XW = 64 * RSW, O_DT = 8 * XW, O_ACS = O_DT + 2048, O_SSQ = O_ACS + 2048;
    const int lane = tid & 63, wave = __builtin_amdgcn_readfirstlane(tid >> 6), gq = lane >> 4, c16 = lane & 15;
    LAS unsigned char* xw = lds + wave * XW;
    LAS float* dtw = (LAS float*)(lds + O_DT) + wave * 64; LAS float* acsw = (LAS float*)(lds + O_ACS) + wave * 64;
    int par = 0;
    for (int item = blk; item < BATCH * 64 * NG; item += nblk, par ^= 1) {
        const int bc = item >> 3, g = item & 7, m0 = bc * 64, head = g * HPG + wave;
        asm volatile("" ::: "memory");
        { u32x4 xr[8];
#pragma unroll
          for (int i = 0; i < 8; ++i) xr[i] = *(const GAS u32x4*)(XC + (size_t)(m0 + (lane >> 3) + 8 * i) * CONVD + head * HP + (lane & 7) * 8);
#pragma unroll
          for (int i = 0; i < 8; ++i) *(LAS u32x4*)(xw + ((lane >> 3) + 8 * i) * RSW + (lane & 7) * 16) = xr[i]; }
        wave_dt_acs(SM, dt_bias, a_log, m0, head, dtw, acsw, lane);
        const GAS bf16* cbase = XC + (size_t)(m0 + c16) * CONVD + DI + NG * NS + g * NS + 8 * gq;
        const GAS bf16* bbase = cbase - NG * NS;
        bf16x8 cf[4][4];
#pragma unroll
        for (int lt = 0; lt < 4; ++lt)
#pragma unroll
            for (int kn = 0; kn < 4; ++kn) cf[lt][kn] = *(const GAS bf16x8*)(cbase + (size_t)(16 * lt) * CONVD + 32 * kn);
        LDS_WAIT(); asm volatile("" ::: "memory");
        float al[4];
#pragma unroll
        for (int lt = 0; lt < 4; ++lt) al[lt] = acsw[16 * lt + c16];
        bf16x8 lf[2][4];
#pragma unroll
        for (int ks = 0; ks < 2; ++ks) {
            f32x4 lt4[2][4];
#pragma unroll
            for (int h2 = 0; h2 < 2; ++h2) { const int st = 2 * ks + h2;
                bf16x8 bfr[4];
#pragma unroll
                for (int kn = 0; kn < 4; ++kn) bfr[kn] = *(const GAS bf16x8*)(bbase + (size_t)(16 * st) * CONVD + 32 * kn);
                float as_[4], ds_[4];
#pragma unroll
                for (int j = 0; j < 4; ++j) { as_[j] = acsw[16 * st + 4 * gq + j]; ds_[j] = dtw[16 * st + 4 * gq + j]; }
#pragma unroll
                for (int lt = 0; lt < 4; ++lt) { f32x4 t4 = (f32x4){0.f, 0.f, 0.f, 0.f};
                    if (lt >= st) {
#pragma unroll
                        for (int kn = 0; kn < 4; ++kn) t4 = __builtin_amdgcn_mfma_f32_16x16x32_bf16(bfr[kn], cf[lt][kn], t4, 0, 0, 0);
#pragma unroll
                        for (int j = 0; j < 4; ++j) { const float e = __expf(fminf(al[lt] - as_[j], 0.f)) * ds_[j]; const bool ok = (lt > st) || (4 * gq + j <= c16); t4[j] = ok ? t4[j] * e : 0.f; } }
                    lt4[h2][lt] = t4; } }
#pragma unroll
            for (int lt = 0; lt < 4; ++lt) { u32x4 w; w.x = pk2(lt4[0][lt][0], lt4[0][lt][1]); w.y = pk2(lt4[0][lt][2], lt4[0][lt][3]); w.z = pk2(lt4[1][lt][0], lt4[1][lt][1]); w.w = pk2(lt4[1][lt][2], lt4[1][lt][3]);
                lf[ks][lt] = __builtin_bit_cast(bf16x8, w); }
        }
        f32x4 acc[4][4];
        const GAS bf16* hsrc = ST + (((size_t)bc * NH + head) * HP + c16) * NS + 8 * gq;
#pragma unroll
        for (int pt = 0; pt < 4; ++pt) { bf16x8 hf[4];
#pragma unroll
            for (int kn = 0; kn < 4; ++kn) hf[kn] = *(const GAS bf16x8*)(hsrc + (size_t)(16 * pt) * NS + 32 * kn);
#pragma unroll
            for (int lt = 0; lt < 4; ++lt) { f32x4 t4 = (f32x4){0.f, 0.f, 0.f, 0.f};
#pragma unroll
                for (int kn = 0; kn < 4; ++kn) t4 = __builtin_amdgcn_mfma_f32_16x16x32_bf16(hf[kn], cf[lt][kn], t4, 0, 0, 0);
                acc[pt][lt] = t4 * __expf(al[lt]); }
            asm volatile("" ::: "memory"); }
        const LAS unsigned char* xb = xw + (4 * gq + (c16 >> 2)) * RSW + (c16 & 3) * 8;
#pragma unroll
        for (int pt = 0; pt < 4; ++pt) {
            const bf16x8 x0 = tr8(xb + pt * 32, 0, 16 * RSW), x1 = tr8(xb + pt * 32, 32 * RSW, 48 * RSW);
#pragma unroll
            for (int lt = 0; lt < 4; ++lt) { acc[pt][lt] = __builtin_amdgcn_mfma_f32_16x16x32_bf16(x0, lf[0][lt], acc[pt][lt], 0, 0, 0);
                if (lt >= 2) acc[pt][lt] = __builtin_amdgcn_mfma_f32_16x16x32_bf16(x1, lf[1][lt], acc[pt][lt], 0, 0, 0); } }
        const float dk = dskip[head]; float ssq[4] = {0.f, 0.f, 0.f, 0.f};
#pragma unroll
        for (int lt = 0; lt < 4; ++lt) { const int l = 16 * lt + c16;
#pragma unroll
            for (int pt = 0; pt < 4; ++pt) { const int p0 = 16 * pt + 4 * gq;
                const u32x2 xv = *(const LAS u32x2*)(xw + l * RSW + p0 * 2); const u32x2 zw = *(const GAS u32x2*)(P + (size_t)(m0 + l) * NMAIN + PZ + head * HP + p0);
                const float xs4[4] = {bflo(xv.x), bfhi(xv.x), bflo(xv.y), bfhi(xv.y)}, z4[4] = {bflo(zw.x), bfhi(zw.x), bflo(zw.y), bfhi(zw.y)};
#pragma unroll
                for (int j = 0; j < 4; ++j) { const float y = (acc[pt][lt][j] + dk * xs4[j]) * z4[j] * __builtin_amdgcn_rcpf(1.0f + __expf(-z4[j])); acc[pt][lt][j] = y; ssq[lt] += y * y; } } }
        LAS float* ssqs = (LAS float*)(lds + O_SSQ) + par * 512;
#pragma unroll
        for (int lt = 0; lt < 4; ++lt) { float v = ssq[lt]; v += __shfl_xor(v, 16); v += __shfl_xor(v, 32); if (gq == 0) ssqs[wave * 64 + 16 * lt + c16] = v; }
        LDS_WAIT();
        __syncthreads();
#pragma unroll
        for (int lt = 0; lt < 4; ++lt) { const int l = 16 * lt + c16; float tot = 0.f;
#pragma unroll
            for (int w8 = 0; w8 < 8; ++w8) tot += ssqs[w8 * 64 + l];
            const float rstd = rsqrtf(tot * (1.0f / (HPG * HP)) + EPS);
#pragma unroll
            for (int pt = 0; pt < 4; ++pt) { const int ch = head * HP + 16 * pt + 4 * gq; const f32x4 gn = *(const GAS f32x4*)(gnorm + ch); const f32x4 o = acc[pt][lt] * rstd * gn;
                u32x2 w; w.x = pk2(o.x, o.y); w.y = pk2(o.z, o.w); *(GAS u32x2*)(Y + (size_t)(m0 + l) * DI + ch) = w; } }
        LDS_WAIT(); asm volatile("" ::: "memory");
    }
}

__device__ __forceinline__ float gelu_tanhf_(float x) { const float u = 0.7978845608028654f * (x + 0.044715f * x * x * x); return x * __builtin_amdgcn_rcpf(1.0f + __expf(-2.0f * u)); }
__device__ __forceinline__ void ph_ffn_act(const GAS bf16* U, const GAS float* cw, const GAS float* cb, GAS bf16* ACT, int gtid, int nthr) {
    constexpr int NCG = FF / 8, R = 8;
    for (int it = gtid; it < (M / R) * NCG; it += nthr) {
        const int c0 = (it % NCG) * 8, m0 = (it / NCG) * R, t0 = m0 & (SEQ - 1);
        f32x4 wg[3][2], wv[3][2];
#pragma unroll
        for (int i = 0; i < 3; ++i) { wg[i][0] = *(const GAS f32x4*)(cw + i * FF2 + c0); wg[i][1] = *(const GAS f32x4*)(cw + i * FF2 + c0 + 4); wv[i][0] = *(const GAS f32x4*)(cw + i * FF2 + FF + c0); wv[i][1] = *(const GAS f32x4*)(cw + i * FF2 + FF + c0 + 4); }
        const f32x4 bg0 = *(const GAS f32x4*)(cb + c0), bg1 = *(const GAS f32x4*)(cb + c0 + 4), bv0 = *(const GAS f32x4*)(cb + FF + c0), bv1 = *(const GAS f32x4*)(cb + FF + c0 + 4);
        u32x4 rg[R + 2], rv[R + 2];
#pragma unroll
        for (int i = 0; i < R + 2; ++i) { const bool ok = (t0 + i - 2) >= 0; const GAS bf16* ur = U + (size_t)(m0 + (ok ? i - 2 : 0)) * FF2 + c0;
            rg[i] = *(const GAS u32x4*)ur; rv[i] = *(const GAS u32x4*)(ur + FF); if (!ok) { rg[i] = (u32x4){0u, 0u, 0u, 0u}; rv[i] = (u32x4){0u, 0u, 0u, 0u}; } }
#pragma unroll
        for (int o = 0; o < R; ++o) { f32x4 g0 = bg0, g1 = bg1, v0 = bv0, v1 = bv1;
#pragma unroll
            for (int i = 0; i < 3; ++i) { float xg[8], xv[8]; unpack8(rg[o + i], xg); unpack8(rv[o + i], xv);
                g0 += wg[i][0] * (f32x4){xg[0], xg[1], xg[2], xg[3]}; g1 += wg[i][1] * (f32x4){xg[4], xg[5], xg[6], xg[7]};
                v0 += wv[i][0] * (f32x4){xv[0], xv[1], xv[2], xv[3]}; v1 += wv[i][1] * (f32x4){xv[4], xv[5], xv[6], xv[7]}; }
            float r[8] = {gelu_tanhf_(g0.x) * v0.x, gelu_tanhf_(g0.y) * v0.y, gelu_tanhf_(g0.z) * v0.z, gelu_tanhf_(g0.w) * v0.w, gelu_tanhf_(g1.x) * v1.x, gelu_tanhf_(g1.y) * v1.y, gelu_tanhf_(g1.z) * v1.z, gelu_tanhf_(g1.w) * v1.w};
            *(GAS u32x4*)(ACT + (size_t)(m0 + o) * FF + c0) = pack8(r); }
    }
}

struct Args { const float* in[20]; float* out; unsigned char* ws; int ph_lo, ph_hi; };
constexpr int NP = 11, NPHASE = 1 + DEPTH * NP;

#define AIN(i) ((const GAS float*)args.in[i])
__global__ void __launch_bounds__(NTHR, 2) fwd(Args args) {
    extern __shared__ __attribute__((aligned(16))) unsigned char lds[];
    const int G = gridDim.x, blk = blockIdx.x;
    volatile LAS unsigned* MISC = (volatile LAS unsigned*)((LAS unsigned char*)lds + MISC_OFF);
    for (int u = threadIdx.x; u < (LDS_BYTES - LDSCTL_OFF) / 4; u += NTHR) ((LAS unsigned*)((LAS unsigned char*)lds + LDSCTL_OFF))[u] = 0u;
    __syncthreads();
    XcdBarrier bar; bar.bar = (unsigned*)(args.ws + WS_CTL) + CW_BAR; bar.x = 0; bar.st = nullptr;
    if (!MK_PER_PHASE) bar = xcd_barrier_post((unsigned*)(args.ws + WS_CTL) + CW_BAR, MISC + 8);
    const int lo = args.ph_lo, hi = args.ph_hi;
#define IN(k) (lo <= (k) && (k) < hi)
#define SEAM(k) do { if (IN(k) && IN((k) + 1)) xcd_barrier(bar); } while (0)
#define PH_BEGIN \
    int tid = threadIdx.x; asm volatile("" : "+v"(tid)); \
    const int lane = tid & 63, wave = __builtin_amdgcn_readfirstlane(tid >> 6); \
    const int gw = blk * NWAVES + wave, ngw = G * NWAVES, gtid = blk * NTHR + tid, nthr = G * NTHR; \
    GAS unsigned char* ws = (GAS unsigned char*)args.ws; asm volatile("" : "+s"(ws)); \
    LAS unsigned char* ring = (LAS unsigned char*)lds; \
    (void)lane; (void)wave; (void)gw; (void)ngw; (void)gtid; (void)nthr; (void)ring; \
    GAS float* X = (GAS float*)args.out; \
    GAS bf16* H = (GAS bf16*)(ws + WS_H); GAS bf16* P = (GAS bf16*)(ws + WS_P); GAS float* SM = (GAS float*)(ws + WS_SM); GAS bf16* XC = (GAS bf16*)(ws + WS_XC); \
    GAS float* CD = (GAS float*)(ws + WS_DT); GAS bf16* STB = (GAS bf16*)(ws + WS_ST); GAS bf16* Y = (GAS bf16*)(ws + WS_Y); \
    GAS float* SC = (GAS float*)(ws + WS_SC); GAS unsigned long long* MASKW = (GAS unsigned long long*)(ws + WS_IDX); GAS bf16* AO = (GAS bf16*)(ws + WS_AO); \
    GAS float* MG = (GAS float*)(ws + WS_MG); GAS bf16* MGB = (GAS bf16*)(ws + WS_MGB); GAS bf16* YMB = (GAS bf16*)(ws + WS_YM); GAS bf16* XB = (GAS bf16*)(ws + WS_YM + 32 * MiB); GAS bf16* U = (GAS bf16*)(ws + WS_U); \
    GAS bf16* ACT = (GAS bf16*)(ws + WS_ACT); GAS bf16* KIB = (GAS bf16*)(ws + WS_KIB); \
    (void)X; (void)H; (void)P; (void)SM; (void)XC; (void)CD; (void)STB; (void)Y; (void)SC; (void)MASKW; (void)AO; (void)MG; (void)MGB; (void)YMB; (void)XB; (void)U; (void)ACT; (void)KIB;

    if (IN(0)) { PH_BEGIN
        WPtrs wp{AIN(5), AIN(13), AIN(14), AIN(15), AIN(16), AIN(19)};
        ph_weights(wp, ws, (LAS float*)lds + wave * 2176, gw, ngw, lane);
        ph_resid_norm<true, false, false>(nullptr, nullptr, AIN(1), AIN(0), nullptr, nullptr, XB, H, gw, ngw, lane);
    }
    SEAM(0);

#pragma unroll 1
    for (int layer = 0; layer < DEPTH; ++layer) {
        const int pb = 1 + layer * NP;
#define WL (ws + WS_W + (size_t)layer * WL_SIZE)
        if (IN(pb + 0)) { PH_BEGIN
            { pg8::Gemm g{H, (const GAS bf16*)(WL + WL_IN), M, NMAIN, D}; pg8::StaticOrder S; S.init(M, NMAIN, G, blk);
              pg8::EpiIn E{P, NMAIN, AIN(6) + (size_t)layer * 2 * D, PG / 256};
              REP(1) { pg8::gemm_phase<pg8::EpiIn, pg8::StaticOrder, true, true>(ring, g, S, E); __syncthreads(); } }
            REP(2) { ph_small_proj(H, (const GAS bf16*)(WL + WL_IN) + (size_t)NMAIN * D, SM, KIB, ring, blk, G, tid); __syncthreads(); }
        }
        SEAM(pb + 0);
        if (IN(pb + 1)) { PH_BEGIN
            REP(20) { ph_ssd_states(P, SM, AIN(7) + (size_t)layer * 4 * CONVD, AIN(8) + (size_t)layer * CONVD, AIN(9) + layer * NH, AIN(10) + layer * NH, XC, STB, CD, ring, blk, G, tid); __syncthreads(); }
            REP(21) { ph_index_scores(P, SM, KIB, SC, ring, blk, G, tid); __syncthreads(); } }
        SEAM(pb + 1);
        if (IN(pb + 2)) { PH_BEGIN
            ph_ssd_scan(STB, CD, gtid, nthr); REP(30) ph_topk(SC, MASKW, ring + wave * 9728, gw, ngw, lane); }
        SEAM(pb + 2);
        if (IN(pb + 3)) { PH_BEGIN
            REP(40) { ph_ssd_out(P, SM, XC, AIN(9) + layer * NH, AIN(10) + layer * NH, STB,
                                 AIN(11) + layer * NH, AIN(12) + (size_t)layer * DI, Y, ring, blk, G, tid); __syncthreads(); }
            REP(41) { ph_attn_dense<0>(P, MASKW, AO, ring, blk, G, tid); __syncthreads(); }
#if PROBE_DOUBLE >= 1000
            { ph_attn_dense<PROBE_DOUBLE - 1000>(P, MASKW, (GAS bf16*)U, ring, blk, G, tid); __syncthreads(); }
#endif
            }
        SEAM(pb + 3);
        if (IN(pb + 4)) {
            { PH_BEGIN
              pg8::Gemm g{Y, (const GAS bf16*)(WL + WL_SSM), M, D, DI}; pg8::StaticOrder S; S.init(M, D, G, blk);
              pg8::EpiGateMul E{MG, D, P + PG, NMAIN}; pg8::gemm_phase<pg8::EpiGateMul, pg8::StaticOrder, false, true>(ring, g, S, E); }
            __syncthreads();
            { PH_BEGIN
              pg8::Gemm g{AO, (const GAS bf16*)(WL + WL_ATT), M, D, D}; pg8::StaticOrder S; S.init(M, D, G, blk);
              pg8::EpiGateAdd E{MG, MGB, D, P + PG + D, NMAIN}; pg8::gemm_phase<pg8::EpiGateAdd, pg8::StaticOrder, false, true>(ring, g, S, E); }
        }
        SEAM(pb + 4);
        if (IN(pb + 5)) { PH_BEGIN
            pg8::Gemm g{MGB, (const GAS bf16*)(WL + WL_MIX), M, D, D}; pg8::StaticOrder S; S.init(M, D, G, blk);
            pg8::EpiBf16<0> E{YMB, D, nullptr, 0, 0, 1.f}; REP(60) { pg8::gemm_phase<pg8::EpiBf16<0>, pg8::StaticOrder, false, true>(ring, g, S, E); __syncthreads(); } }
        SEAM(pb + 5);
        if (IN(pb + 6)) { PH_BEGIN
            ph_resid_norm<false, true, false>(YMB, AIN(2) + (size_t)layer * D, AIN(3) + (size_t)layer * D, nullptr, XB, nullptr, XB, H, gw, ngw, lane); }
        SEAM(pb + 6);
        if (IN(pb + 7)) { PH_BEGIN
            pg8::Gemm g{H, (const GAS bf16*)(WL + WL_UP), M, FF2, D}; pg8::StaticOrder S; S.init(M, FF2, G, blk);
            pg8::EpiBf16<0> E{U, FF2, nullptr, 0, 0, 1.f}; REP(80) { pg8::gemm_phase<pg8::EpiBf16<0>, pg8::StaticOrder, true, true>(ring, g, S, E); __syncthreads(); } }
        SEAM(pb + 7);
        if (IN(pb + 8)) { PH_BEGIN
            REP(90) ph_ffn_act(U, AIN(17) + (size_t)layer * 3 * FF2, AIN(18) + (size_t)layer * FF2, ACT, gtid, nthr); }
        SEAM(pb + 8);
        if (IN(pb + 9)) { PH_BEGIN
            pg8::Gemm g{ACT, (const GAS bf16*)(WL + WL_DN), M, D, FF}; pg8::StaticOrder S; S.init(M, D, G, blk);
            pg8::EpiBf16<0> E{YMB, D, nullptr, 0, 0, 1.f}; REP(100) { pg8::gemm_phase<pg8::EpiBf16<0>, pg8::StaticOrder, false, true>(ring, g, S, E); __syncthreads(); } }
        SEAM(pb + 9);
        if (IN(pb + 10)) { PH_BEGIN
            if (layer + 1 < DEPTH) ph_resid_norm<false, true, false>(YMB, AIN(4) + (size_t)layer * D, AIN(1) + (size_t)(layer + 1) * D, nullptr, XB, nullptr, XB, H, gw, ngw, lane);
            else ph_resid_norm<false, true, true>(YMB, AIN(4) + (size_t)layer * D, nullptr, nullptr, XB, X, nullptr, H, gw, ngw, lane); }
        SEAM(pb + 10);
    }
#undef IN
#undef SEAM
#undef WL
#undef PH_BEGIN
}

extern "C" void kernel_launch(void* const* d_in, const int* in_sizes, int n_in, void* d_out, int out_size, void* d_ws, size_t ws_size, hipStream_t stream) {
    static int grid = 0;
    if (grid == 0) {
        if (n_in != 20 || in_sizes[0] != M * D || out_size != M * D || ws_size < WS_END) { fprintf(stderr, "kernel_launch: unexpected shapes (n_in %d, in0 %d, out %d, ws %zu < %zu)\n", n_in, n_in > 0 ? in_sizes[0] : -1, out_size, ws_size, (size_t)WS_END); grid = -1; return; }
        int dev = 0, cus = 0, per_cu = 0;
        if (hipGetDevice(&dev) != hipSuccess || hipDeviceGetAttribute(&cus, hipDeviceAttributeMultiprocessorCount, dev) != hipSuccess) { grid = -1; return; }
        if (hipFuncSetAttribute((const void*)fwd, hipFuncAttributeMaxDynamicSharedMemorySize, LDS_BYTES) != hipSuccess) { fprintf(stderr, "kernel_launch: hipFuncSetAttribute failed\n"); grid = -1; return; }
        if (hipOccupancyMaxActiveBlocksPerMultiprocessor(&per_cu, (const void*)fwd, NTHR, LDS_BYTES) != hipSuccess || per_cu < 1) fprintf(stderr, "kernel_launch: occupancy query reports %d blocks per CU\n", per_cu);
        (void)hipGetLastError();
        grid = cus;
    }
    if (grid < 0) return;
    if (hipMemsetAsync((char*)d_ws + WS_CTL, 0, CTL_ZERO_BYTES, stream) != hipSuccess) return;
    Args a{};
    for (int i = 0; i < 20; ++i) a.in[i] = (const float*)d_in[i];
    a.out = (float*)d_out; a.ws = (unsigned char*)d_ws;
#if MK_PER_PHASE
    for (int ph = 0; ph < NPHASE; ++ph) { a.ph_lo = ph; a.ph_hi = ph + 1; hipLaunchKernelGGL(fwd, dim3(grid), dim3(NTHR), LDS_BYTES, stream, a); }
#else
    a.ph_lo = 0; a.ph_hi = NPHASE; hipLaunchKernelGGL(fwd, dim3(grid), dim3(NTHR), LDS_BYTES, stream, a);
#endif
}
```

```cpp
#include <hip/hip_runtime.h>
#include <cstdio>
#include <cstdint>
#define MK_PER_PHASE 0
namespace pg8 {
#define PG8_LAS __attribute__((address_space(3)))
#define PG8_GAS __attribute__((address_space(1)))
typedef unsigned short bf16_t;
typedef short bf16x8 __attribute__((ext_vector_type(8)));
typedef float f32x4 __attribute__((ext_vector_type(4)));
typedef unsigned u32x4 __attribute__((ext_vector_type(4)));
constexpr int BM = 256, BK = 64, HALF = 128, HTB = HALF * BK * 2  , STAGE_BYTES = 8 * HTB, NXCD = 8, WGM = 8;

__host__ __device__ __forceinline__ int lds_byte(int r, int c) { const int st = (r >> 4) * 2 + (c >> 5), rr = r & 15, cc = c & 31, ob = rr * 64 + cc * 2; return st * 1024 + (ob ^ (((ob >> 9) & 1) << 5)); }
__host__ __device__ __forceinline__ void stage_rc(int b, int& R, int& C) { const int st = b / 1024, sb = b % 1024, swz = sb ^ (((sb >> 9) & 1) << 5); R = (st >> 1) * 16 + swz / 64; C = (st & 1) * 32 + (swz % 64) / 2; }
__host__ __device__ __forceinline__ int perm32(int rho) { const int n = rho >> 4, i = rho & 15; return 8 * (i >> 2) + 4 * n + (i & 3); }

struct Unit { int pm, pn; };
struct Gemm { const PG8_GAS bf16_t* A; const PG8_GAS bf16_t* Bt; int M, N, K; };

struct StaticOrder {
    int nM, nN, nwg, G, c;
    __host__ __device__ void init(int M, int N, int G_, int c_) { nM = M / BM; nN = N / BM; nwg = nM * nN; G = G_; c = c_; }
    __host__ __device__ bool next(int i, Unit& u) const {
        const long L = (long)i * G + c; if (L >= nwg) return false;
        int wgid = (int)L; { const int q = nwg / NXCD, r = nwg % NXCD, xcd = wgid % NXCD, off = wgid / NXCD; wgid = (xcd < r ? xcd * (q + 1) : r * (q + 1) + (xcd - r) * q) + off; }
        const int nig = WGM * nN, gid = wgid / nig, fm = gid * WGM, gsz = (nM - fm) < WGM ? (nM - fm) : WGM;
        u.pm = fm + ((wgid % nig) % gsz); u.pn = (wgid % nig) / gsz; return true;
    }
    __device__ __forceinline__ void a_ready(const Unit&) const {}
    __device__ __forceinline__ void done(const Unit&) const {}
};

__device__ __forceinline__ unsigned cvt_pk_bf16(float lo, float hi) { unsigned r; asm volatile("v_cvt_pk_bf16_f32 %0, %1, %2" : "=v"(r) : "v"(lo), "v"(hi)); return r; }
typedef float f32x2 __attribute__((ext_vector_type(2)));
__device__ __forceinline__ f32x2 gelu_pk(f32x2 v) {
    const f32x2 av = __builtin_elementwise_abs(v), d = av * 0.2316418882f + 1.0f;
    f32x2 t; t.x = __builtin_amdgcn_rcpf(d.x); t.y = __builtin_amdgcn_rcpf(d.y);
    f32x2 q = t * 0.5307027145f + (-0.7265760135f); q = q * t + 0.7107068705f; q = q * t + (-0.142248368f); q = q * t + 0.127414796f; q = q * t;
    const f32x2 s = (v * v) * (-0.72134752044f);
    f32x2 e; e.x = __builtin_amdgcn_exp2f(s.x); e.y = __builtin_amdgcn_exp2f(s.y);
    const f32x2 m = v * (q * e), r = v - m;
    f32x2 o; o.x = v.x < 0.f ? m.x : r.x; o.y = v.y < 0.f ? m.y : r.y; return o;
}

template <int ACT  > struct EpiBf16 {
    static constexpr bool PERM = true, AFTER_DRAIN = false; static_assert(ACT == 0 || ACT == 1, "EpiBf16: ACT is 0 (none) or 1 (gelu_pk)");
    PG8_GAS bf16_t* O; int ldc; const PG8_GAS float* bias; int split_cols; size_t split_stride; float scale0;
    __device__ __forceinline__ void operator()(const f32x4 (&acc)[2][2][4][2], const Unit& u, int wr, int wc, int fr, int fq) const {
        const int row0 = u.pm * BM + wr * 64 + fr; int colt = u.pn * BM; PG8_GAS bf16_t* base = O;
        float sc = 1.f; if (split_cols) { const int t = colt / split_cols; base += (size_t)t * split_stride; colt -= t * split_cols; if (t == 0) sc = scale0; }
        const int col0 = colt + wc * 32 + 8 * fq, bcol0 = u.pn * BM + wc * 32 + 8 * fq;
        f32x4 bv[2][2];
#pragma unroll
        for (int bj = 0; bj < 2; ++bj)
#pragma unroll
            for (int n = 0; n < 2; ++n) bv[bj][n] = bias ? *(const PG8_GAS f32x4*)(bias + bcol0 + bj * HALF + 4 * n) : (f32x4){0.f, 0.f, 0.f, 0.f};
#pragma unroll
        for (int ai = 0; ai < 2; ++ai)
#pragma unroll
            for (int m = 0; m < 4; ++m) { PG8_GAS bf16_t* rowp = base + (size_t)(row0 + ai * HALF + m * 16) * ldc + col0;
#pragma unroll
                for (int bj = 0; bj < 2; ++bj) { f32x4 v0 = acc[ai][bj][m][0] + bv[bj][0], v1 = acc[ai][bj][m][1] + bv[bj][1];
                    if (ACT == 1) { f32x2 a = gelu_pk((f32x2){v0[0], v0[1]}), b = gelu_pk((f32x2){v0[2], v0[3]}), c = gelu_pk((f32x2){v1[0], v1[1]}), d = gelu_pk((f32x2){v1[2], v1[3]});
                        v0 = (f32x4){a.x, a.y, b.x, b.y}; v1 = (f32x4){c.x, c.y, d.x, d.y}; }
                    v0 = v0 * sc; v1 = v1 * sc; u32x4 w; w.x = cvt_pk_bf16(v0[0], v0[1]); w.y = cvt_pk_bf16(v0[2], v0[3]); w.z = cvt_pk_bf16(v1[0], v1[1]); w.w = cvt_pk_bf16(v1[2], v1[3]);
                    *(PG8_GAS u32x4*)(rowp + bj * HALF) = w; } }
    }
};

struct EpiF32 {
    static constexpr bool PERM = false, AFTER_DRAIN = false;
    PG8_GAS float* C; int ldc;
    __device__ __forceinline__ void operator()(const f32x4 (&acc)[2][2][4][2], const Unit& u, int wr, int wc, int fr, int fq) const {
        const int row0 = u.pm * BM + wr * 64 + fr, col0 = u.pn * BM + wc * 32 + 4 * fq;
#pragma unroll
        for (int ai = 0; ai < 2; ++ai)
#pragma unroll
            for (int m = 0; m < 4; ++m) { PG8_GAS float* rowp = C + (size_t)(row0 + ai * HALF + m * 16) * ldc + col0;
#pragma unroll
                for (int bj = 0; bj < 2; ++bj)
#pragma unroll
                    for (int n = 0; n < 2; ++n) *(PG8_GAS f32x4*)(rowp + bj * HALF + n * 16) = acc[ai][bj][m][n]; }
    }
};
__device__ __forceinline__ float bf_lo(unsigned w) { return __uint_as_float(w << 16); }
__device__ __forceinline__ float bf_hi(unsigned w) { return __uint_as_float(w & 0xffff0000u); }
__device__ __forceinline__ float sigmoidf_(float x) { return __builtin_amdgcn_rcpf(1.0f + __expf(-x)); }
struct EpiIn {
    static constexpr bool PERM = true, AFTER_DRAIN = false;
    PG8_GAS bf16_t* P; int ldp; const PG8_GAS float* bgate; int gate_tile0;
    __device__ __forceinline__ void operator()(const f32x4 (&acc)[2][2][4][2], const Unit& u, int wr, int wc, int fr, int fq) const {
        const int row0 = u.pm * BM + wr * 64 + fr, colt = u.pn * BM + wc * 32 + 8 * fq;
        {
            const bool gate = u.pn >= gate_tile0;
            f32x4 bv[2][2];
#pragma unroll
            for (int bj = 0; bj < 2; ++bj)
#pragma unroll
                for (int n = 0; n < 2; ++n) bv[bj][n] = gate ? *(const PG8_GAS f32x4*)(bgate + (colt - gate_tile0 * BM) + bj * HALF + 4 * n) : (f32x4){0.f, 0.f, 0.f, 0.f};
#pragma unroll
            for (int ai = 0; ai < 2; ++ai)
#pragma unroll
                for (int m = 0; m < 4; ++m) { PG8_GAS bf16_t* rowp = P + (size_t)(row0 + ai * HALF + m * 16) * ldp + colt;
#pragma unroll
                    for (int bj = 0; bj < 2; ++bj) { f32x4 v0 = acc[ai][bj][m][0] + bv[bj][0], v1 = acc[ai][bj][m][1] + bv[bj][1];
                        if (gate) {
#pragma unroll
                            for (int j = 0; j < 4; ++j) { v0[j] = sigmoidf_(v0[j]); v1[j] = sigmoidf_(v1[j]); } }
                        u32x4 w; w.x = cvt_pk_bf16(v0[0], v0[1]); w.y = cvt_pk_bf16(v0[2], v0[3]); w.z = cvt_pk_bf16(v1[0], v1[1]); w.w = cvt_pk_bf16(v1[2], v1[3]);
                        *(PG8_GAS u32x4*)(rowp + bj * HALF) = w; } }
        }
    }
};
struct EpiGateMul {
    static constexpr bool PERM = true, AFTER_DRAIN = false;
    PG8_GAS float* MG; int ldc; const PG8_GAS bf16_t* G; int ldg;
    __device__ __forceinline__ void operator()(const f32x4 (&acc)[2][2][4][2], const Unit& u, int wr, int wc, int fr, int fq) const {
        const int row0 = u.pm * BM + wr * 64 + fr, colt = u.pn * BM + wc * 32 + 8 * fq;
#pragma unroll
        for (int ai = 0; ai < 2; ++ai)
#pragma unroll
            for (int m = 0; m < 4; ++m) { const size_t row = (size_t)(row0 + ai * HALF + m * 16);
#pragma unroll
                for (int bj = 0; bj < 2; ++bj) { const u32x4 g = *(const PG8_GAS u32x4*)(G + row * ldg + colt + bj * HALF);
                    f32x4 v0 = acc[ai][bj][m][0], v1 = acc[ai][bj][m][1];
                    v0[0] *= bf_lo(g.x); v0[1] *= bf_hi(g.x); v0[2] *= bf_lo(g.y); v0[3] *= bf_hi(g.y);
                    v1[0] *= bf_lo(g.z); v1[1] *= bf_hi(g.z); v1[2] *= bf_lo(g.w); v1[3] *= bf_hi(g.w);
                    PG8_GAS float* o = MG + row * ldc + colt + bj * HALF; *(PG8_GAS f32x4*)o = v0; *(PG8_GAS f32x4*)(o + 4) = v1; } }
    }
};
struct EpiGateAdd {
    static constexpr bool PERM = true, AFTER_DRAIN = false;
    const PG8_GAS float* MG; PG8_GAS bf16_t* O; int ldc; const PG8_GAS bf16_t* G; int ldg;
    __device__ __forceinline__ void operator()(const f32x4 (&acc)[2][2][4][2], const Unit& u, int wr, int wc, int fr, int fq) const {
        const int row0 = u.pm * BM + wr * 64 + fr, colt = u.pn * BM + wc * 32 + 8 * fq;
#pragma unroll
        for (int ai = 0; ai < 2; ++ai)
#pragma unroll
            for (int m = 0; m < 4; ++m) { const size_t row = (size_t)(row0 + ai * HALF + m * 16);
#pragma unroll
                for (int bj = 0; bj < 2; ++bj) { const u32x4 g = *(const PG8_GAS u32x4*)(G + row * ldg + colt + bj * HALF);
                    const PG8_GAS float* mi = MG + row * ldc + colt + bj * HALF; f32x4 v0 = *(const PG8_GAS f32x4*)mi, v1 = *(const PG8_GAS f32x4*)(mi + 4);
                    const f32x4 a0 = acc[ai][bj][m][0], a1 = acc[ai][bj][m][1];
                    v0[0] += a0[0] * bf_lo(g.x); v0[1] += a0[1] * bf_hi(g.x); v0[2] += a0[2] * bf_lo(g.y); v0[3] += a0[3] * bf_hi(g.y);
                    v1[0] += a1[0] * bf_lo(g.z); v1[1] += a1[1] * bf_hi(g.z); v1[2] += a1[2] * bf_lo(g.w); v1[3] += a1[3] * bf_hi(g.w);
                    u32x4 w; w.x = cvt_pk_bf16(v0[0], v0[1]); w.y = cvt_pk_bf16(v0[2], v0[3]); w.z = cvt_pk_bf16(v1[0], v1[1]); w.w = cvt_pk_bf16(v1[2], v1[3]);
                    *(PG8_GAS u32x4*)(O + row * ldc + colt + bj * HALF) = w; } }
    }
};
template <class Epi, class Sched, bool ALIGN_EPI = false, bool SP2 = false>
__device__ __forceinline__ void gemm_phase(PG8_LAS unsigned char* lds, const Gemm g, const Sched& S, const Epi& E) {
    int tid = threadIdx.x; asm volatile("" : "+v"(tid));
    const int wid = __builtin_amdgcn_readfirstlane(tid >> 6), lane = tid & 63, wr = wid >> 2, wc = wid & 3, fr = lane & 15, fq = lane >> 4;
    const int K = g.K, nt = K / BK;
    unsigned voffA[2], voffB[2];
#pragma unroll
    for (int i = 0; i < 2; ++i) { int R, C; stage_rc(tid * 16 + i * 8192, R, C); const int Rb = Epi::PERM ? ((R & ~31) + perm32(R & 31)) : R;
        voffA[i] = (unsigned)(R * K + C) * 2u; voffB[i] = (unsigned)(Rb * K + C) * 2u; }
    const size_t kstep = (size_t)(BK * 2);
    const size_t hstep = (size_t)HALF * K * 2;
    const size_t tstep = 2 * hstep;
    const unsigned ldsw = (unsigned)wid * 1024u;
    const int aoff = lds_byte(wr * 64 + fr, fq * 8), boff = lds_byte(wc * 32 + fr, fq * 8);
#define PG8_SA(b, h) (((b) * 2 + (h)) * HTB)
#define PG8_SB(b, h) ((4 + (b) * 2 + (h)) * HTB)
#define PG8_STAGE(bufoff, gbase, voff) do { _Pragma("unroll") for (int _i = 0; _i < 2; ++_i) \
        __builtin_amdgcn_global_load_lds((const PG8_GAS unsigned*)((const PG8_GAS char*)(gbase) + (voff)[_i]), (PG8_LAS unsigned*)(lds + (bufoff) + ldsw + _i * 8192), 16, 0, 0); } while (0)
#define PG8_LDA(dst, b, h) do { _Pragma("unroll") for (int m = 0; m < 4; ++m) _Pragma("unroll") for (int k = 0; k < 2; ++k) dst[m][k] = *(const PG8_LAS bf16x8*)(lds + PG8_SA(b, h) + aoff + m * 2048 + k * 1024); } while (0)
#define PG8_LDB(dst, b, h) do { _Pragma("unroll") for (int n = 0; n < 2; ++n) _Pragma("unroll") for (int k = 0; k < 2; ++k) dst[n][k] = *(const PG8_LAS bf16x8*)(lds + PG8_SB(b, h) + boff + n * 2048 + k * 1024); } while (0)
#define PG8_MMA(ai, bj, At, Bt) do { __builtin_amdgcn_s_setprio(1); _Pragma("unroll") for (int m = 0; m < 4; ++m) _Pragma("unroll") for (int n = 0; n < 2; ++n) _Pragma("unroll") for (int k = 0; k < 2; ++k) \
        acc[ai][bj][m][n] = __builtin_amdgcn_mfma_f32_16x16x32_bf16(Bt[n][k], At[m][k], acc[ai][bj][m][n], 0, 0, 0); __builtin_amdgcn_s_setprio(0); } while (0)
#define PG8_WAIT_V(n) asm volatile("s_waitcnt vmcnt(" #n ")" ::: "memory")
#define PG8_WAIT_L(n) asm volatile("s_waitcnt lgkmcnt(" #n ")" ::: "memory")
#define PG8_BAR __builtin_amdgcn_s_barrier()
#define PG8_SCHED __builtin_amdgcn_sched_barrier(0)
    Unit cur, nxt; int ui = 0;
    if (!S.next(0, cur)) return;
    f32x4 acc[2][2][4][2];
#pragma unroll
    for (int a = 0; a < 2; ++a)
#pragma unroll
        for (int b = 0; b < 2; ++b)
#pragma unroll
            for (int m = 0; m < 4; ++m)
#pragma unroll
                for (int n = 0; n < 2; ++n) acc[a][b][m][n] = (f32x4){0.f, 0.f, 0.f, 0.f};
    bf16x8 At[4][2], B0[2][2], B1[2][2];
    const PG8_GAS char* cA = (const PG8_GAS char*)g.A + (size_t)cur.pm * tstep; const PG8_GAS char* cB = (const PG8_GAS char*)g.Bt + (size_t)cur.pn * tstep;
    S.a_ready(cur);
    if constexpr (SP2) {
        PG8_STAGE(PG8_SB(0, 0), cB, voffB); PG8_STAGE(PG8_SB(0, 1), cB + hstep, voffB); PG8_STAGE(PG8_SA(0, 0), cA, voffA); PG8_STAGE(PG8_SA(0, 1), cA + hstep, voffA);
        if (wr == 1) PG8_BAR;
        PG8_WAIT_V(2); PG8_BAR;
        PG8_STAGE(PG8_SB(1, 0), cB + kstep, voffB); PG8_STAGE(PG8_SA(1, 0), cA + kstep, voffA); PG8_STAGE(PG8_SB(1, 1), cB + hstep + kstep, voffB);
        PG8_WAIT_V(6); PG8_BAR;
    } else {
        PG8_STAGE(PG8_SB(0, 0), cB, voffB); PG8_STAGE(PG8_SA(0, 0), cA, voffA); PG8_STAGE(PG8_SB(0, 1), cB + hstep, voffB); PG8_STAGE(PG8_SA(0, 1), cA + hstep, voffA);
        if (wr == 1) PG8_BAR;
        PG8_WAIT_V(4); PG8_BAR;
        PG8_STAGE(PG8_SB(1, 0), cB + kstep, voffB); PG8_STAGE(PG8_SA(1, 0), cA + kstep, voffA); PG8_STAGE(PG8_SB(1, 1), cB + hstep + kstep, voffB);
        PG8_WAIT_V(6); PG8_BAR;
    }
    for (;;) {
        const bool has_next = S.next(ui + 1, nxt);
        const PG8_GAS char* nA = has_next ? (const PG8_GAS char*)g.A + (size_t)nxt.pm * tstep : cA; const PG8_GAS char* nB = has_next ? (const PG8_GAS char*)g.Bt + (size_t)nxt.pn * tstep : cB;
        for (int t = 0; t < nt; t += 2) {
            const bool last = (t == nt - 2);
            const PG8_GAS char* a1 = cA + (size_t)(t + 1) * kstep;
            const PG8_GAS char* a2 = last ? nA : cA + (size_t)(t + 2) * kstep; const PG8_GAS char* b2 = last ? nB : cB + (size_t)(t + 2) * kstep;
            const PG8_GAS char* a3 = a2 + kstep; const PG8_GAS char* b3 = b2 + kstep;
            if (last && has_next) S.a_ready(nxt);
            if constexpr (SP2) {
            PG8_LDB(B0, 0, 0); PG8_LDB(B1, 0, 1); PG8_SCHED; PG8_LDA(At, 0, 0); PG8_STAGE(PG8_SA(1, 1), a1 + hstep, voffA);
            PG8_WAIT_V(8); PG8_WAIT_L(0); PG8_BAR; PG8_MMA(0, 0, At, B0); PG8_MMA(0, 1, At, B1); PG8_BAR; PG8_SCHED;
            PG8_LDA(At, 0, 1); PG8_STAGE(PG8_SB(0, 0), b2, voffB); PG8_STAGE(PG8_SB(0, 1), b2 + hstep, voffB); PG8_STAGE(PG8_SA(0, 0), a2, voffA);
            PG8_WAIT_V(8); PG8_WAIT_L(0); PG8_BAR; PG8_MMA(1, 0, At, B0); PG8_MMA(1, 1, At, B1); PG8_BAR; PG8_SCHED;
            PG8_LDB(B0, 1, 0); PG8_LDB(B1, 1, 1); PG8_SCHED; PG8_LDA(At, 1, 0); PG8_STAGE(PG8_SA(0, 1), a2 + hstep, voffA);
            PG8_WAIT_V(8); PG8_WAIT_L(0); PG8_BAR; PG8_MMA(0, 0, At, B0); PG8_MMA(0, 1, At, B1); PG8_BAR; PG8_SCHED;
            PG8_LDA(At, 1, 1); PG8_STAGE(PG8_SB(1, 0), b3, voffB); PG8_STAGE(PG8_SB(1, 1), b3 + hstep, voffB); PG8_STAGE(PG8_SA(1, 0), a3, voffA);
            PG8_WAIT_V(8); PG8_WAIT_L(0); PG8_BAR; PG8_MMA(1, 0, At, B0); PG8_MMA(1, 1, At, B1); PG8_BAR; PG8_SCHED;
            } else {
            PG8_LDB(B0, 0, 0); PG8_SCHED; PG8_LDA(At, 0, 0); PG8_STAGE(PG8_SA(1, 1), a1 + hstep, voffA);
            PG8_WAIT_L(8); PG8_BAR; PG8_WAIT_L(0); PG8_MMA(0, 0, At, B0); PG8_BAR; PG8_SCHED;
            PG8_LDB(B1, 0, 1); PG8_STAGE(PG8_SB(0, 0), b2, voffB);
            PG8_BAR; PG8_WAIT_L(0); PG8_MMA(0, 1, At, B1); PG8_BAR;
            PG8_LDA(At, 0, 1); PG8_STAGE(PG8_SA(0, 0), a2, voffA);
            PG8_BAR; PG8_WAIT_L(0); PG8_MMA(1, 0, At, B0); PG8_BAR; PG8_SCHED;
            PG8_STAGE(PG8_SB(0, 1), b2 + hstep, voffB);
            PG8_WAIT_V(6); PG8_BAR; PG8_MMA(1, 1, At, B1); PG8_BAR;
            PG8_LDB(B0, 1, 0); PG8_SCHED; PG8_LDA(At, 1, 0); PG8_STAGE(PG8_SA(0, 1), a2 + hstep, voffA);
            PG8_WAIT_L(8); PG8_BAR; PG8_WAIT_L(0); PG8_MMA(0, 0, At, B0); PG8_BAR; PG8_SCHED;
            PG8_LDB(B1, 1, 1); PG8_STAGE(PG8_SB(1, 0), b3, voffB);
            PG8_BAR; PG8_WAIT_L(0); PG8_MMA(0, 1, At, B1); PG8_BAR;
            PG8_LDA(At, 1, 1); PG8_STAGE(PG8_SA(1, 0), a3, voffA);
            PG8_BAR; PG8_WAIT_L(0); PG8_MMA(1, 0, At, B0); PG8_BAR; PG8_SCHED;
            PG8_STAGE(PG8_SB(1, 1), b3 + hstep, voffB);
            PG8_WAIT_V(6); PG8_BAR; PG8_MMA(1, 1, At, B1); PG8_BAR;
            }
        }
        if constexpr (ALIGN_EPI) { if (wr == 0) PG8_BAR; }
        if constexpr (!Epi::AFTER_DRAIN) { E(acc, cur, wr, wc, fr, fq); S.done(cur); }
        if (!has_next) break;
#pragma unroll
        for (int a = 0; a < 2; ++a)
#pragma unroll
            for (int b = 0; b < 2; ++b)
#pragma unroll
                for (int m = 0; m < 4; ++m)
#pragma unroll
                    for (int n = 0; n < 2; ++n) acc[a][b][m][n] = (f32x4){0.f, 0.f, 0.f, 0.f};
        cur = nxt; cA = nA; cB = nB; ++ui;
        if constexpr (ALIGN_EPI) { if (wr == 1) PG8_BAR; }
    }
    PG8_WAIT_V(0);
    if constexpr (!ALIGN_EPI) { if (wr == 0) PG8_BAR; }
    PG8_BAR;
    if constexpr (Epi::AFTER_DRAIN) { E.fused(acc, cur, wr, wc, fr, fq, lds, wid, lane); S.done(cur); }
#undef PG8_SA
#undef PG8_SB
#undef PG8_STAGE
#undef PG8_LDA
#undef PG8_LDB
#undef PG8_MMA
#undef PG8_WAIT_V
#undef PG8_WAIT_L
#undef PG8_BAR
#undef PG8_SCHED
}
}

#ifndef MK_PER_PHASE
#define MK_PER_PHASE 0
#endif
#ifndef PROBE_DOUBLE
#define PROBE_DOUBLE -1
#endif
#define REP(id) for (int rep_ = 0; rep_ < ((PROBE_DOUBLE == (id)) ? 2 : 1); ++rep_)
constexpr int NWAVES = 8, NTHR = 512;
constexpr int BATCH = 2, SEQ = 4096, M = BATCH * SEQ, D = 2048, DEPTH = 4;
constexpr int DI = 4096, NH = 64, HP = 64, NG = 8, HPG = 8, NS = 128, CONVD = 6144;
constexpr int QH = 16, KVH = 4, AD = 128, IH = 16, IDD = 64, TOPK = 256;
constexpr int FF = 4096, FF2 = 8192;
constexpr int NIN = 18576, NMAIN = 18432, NPAD = 18688;
constexpr int PZ = 0, PXBC = 4096, PQ = 10240, PK = 12288, PV = 12800, PQI = 13312, PG = 14336;
constexpr int SMW = 256, SM_DT = 0, SM_KI = 64, SM_WI = 128;
constexpr float EPS = 1e-6f;
constexpr float ATTN_SCALE = 0.08838834764831845f;

constexpr size_t MiB = 1u << 20;
constexpr size_t WS_CTL = 0, CTL_ZERO_BYTES = 1 * MiB;
constexpr size_t WS_W = 2 * MiB;
constexpr size_t WL_IN = 0, WL_SSM = 73 * MiB, WL_ATT = 89 * MiB, WL_MIX = 97 * MiB, WL_UP = 105 * MiB, WL_DN = 137 * MiB, WL_SIZE = 153 * MiB;
constexpr size_t WS_H = WS_W + DEPTH * WL_SIZE;
constexpr size_t WS_P = WS_H + 32 * MiB;
constexpr size_t WS_SM = WS_P + 288 * MiB;
constexpr size_t WS_XC = WS_SM + 8 * MiB;
constexpr size_t WS_DT = WS_XC + 96 * MiB;
constexpr size_t WS_ACS = WS_DT + 2 * MiB;
constexpr size_t WS_ST = WS_ACS + 2 * MiB;
constexpr size_t WS_Y = WS_ST + 256 * MiB;
constexpr size_t WS_SC = WS_Y + 64 * MiB;
constexpr size_t WS_IDX = WS_SC + 128 * MiB;
constexpr size_t WS_CNT = WS_IDX + 8 * MiB;
constexpr size_t WS_AO = WS_CNT + 1 * MiB;
constexpr size_t WS_MG = WS_AO + 32 * MiB;
constexpr size_t WS_MGB = WS_MG + 64 * MiB;
constexpr size_t WS_YM = WS_MGB + 32 * MiB;
constexpr size_t WS_U = WS_YM + 64 * MiB;
constexpr size_t WS_ACT = WS_U + 128 * MiB;
constexpr size_t WS_KIB = WS_ACT + 64 * MiB;
constexpr size_t WS_END = WS_KIB + 1 * MiB;
constexpr int CW_BAR = 4096;

constexpr int RING_BYTES = 139264, LDSCTL_OFF = RING_BYTES, MISC_OFF = LDSCTL_OFF + 320, LDS_BYTES = 147456;

#define LAS __attribute__((address_space(3)))
#define GAS __attribute__((address_space(1)))
typedef unsigned short bf16;
typedef float f32x4 __attribute__((ext_vector_type(4)));
typedef short bf16x8 __attribute__((ext_vector_type(8)));
typedef unsigned u32x4 __attribute__((ext_vector_type(4)));
typedef unsigned u32x2 __attribute__((ext_vector_type(2)));
#define LDS_WAIT() asm volatile("s_waitcnt lgkmcnt(0)" ::: "memory")

__device__ __forceinline__ unsigned f2bf(float f) { unsigned u = __builtin_bit_cast(unsigned, f); return (u + 0x7fffu + ((u >> 16) & 1u)) >> 16; }
__device__ __forceinline__ unsigned pk2(float lo, float hi) { return f2bf(lo) | (f2bf(hi) << 16); }
__device__ __forceinline__ unsigned cvtpk(float lo, float hi) { unsigned r; asm("v_cvt_pk_bf16_f32 %0, %1, %2" : "=v"(r) : "v"(lo), "v"(hi)); return r; }
__device__ __forceinline__ float bflo(unsigned w) { return __uint_as_float(w << 16); }
__device__ __forceinline__ float bfhi(unsigned w) { return __uint_as_float(w & 0xffff0000u); }
__device__ __forceinline__ void unpack8(const u32x4 w, float (&f)[8]) { f[0] = bflo(w.x); f[1] = bfhi(w.x); f[2] = bflo(w.y); f[3] = bfhi(w.y); f[4] = bflo(w.z); f[5] = bfhi(w.z); f[6] = bflo(w.w); f[7] = bfhi(w.w); }
__device__ __forceinline__ u32x4 pack8(const float (&f)[8]) { u32x4 w; w.x = pk2(f[0], f[1]); w.y = pk2(f[2], f[3]); w.z = pk2(f[4], f[5]); w.w = pk2(f[6], f[7]); return w; }
__device__ __forceinline__ float wave_sum(float v) {
#pragma unroll
    for (int o = 1; o < 64; o <<= 1) v += __shfl_xor(v, o);
    return v;
}
__device__ __forceinline__ float wave_max(float v) {
#pragma unroll
    for (int o = 1; o < 64; o <<= 1) v = fmaxf(v, __shfl_xor(v, o));
    return v;
}
__device__ __forceinline__ float siluf_(float x) { return x / (1.0f + __expf(-x)); }
typedef short s16x4 __attribute__((ext_vector_type(4)));
__device__ __forceinline__ s16x4 lds_tr4(const LAS unsigned char* p) { return __builtin_bit_cast(s16x4, __builtin_amdgcn_ds_read_tr16_b64_v4i16((LAS s16x4*)p)); }

#define XB_TMO      128
#define XB_XCNT(j)  (256  + 64 * (j))
#define XB_XSUB(j)  (1280 + 64 * (j))
#define XB_XGEN(j)  (2304 + 64 * (j))
#define XB_TOP      3328
#define XB_TOPGEN   3392
#define XCD_BAR_WORDS 3456
#define XB_SPIN_CAP (1u << 18)

__device__ __forceinline__ unsigned xb_ld(unsigned* p)              { return __hip_atomic_load(p, __ATOMIC_RELAXED, __HIP_MEMORY_SCOPE_AGENT); }
__device__ __forceinline__ unsigned xb_add(unsigned* p, unsigned v) { return __hip_atomic_fetch_add(p, v, __ATOMIC_RELAXED, __HIP_MEMORY_SCOPE_AGENT); }
__device__ __forceinline__ unsigned xb_xcc_id() { return (unsigned)__builtin_amdgcn_s_getreg((3 << 11) | 20) & 0xFu; }
#define XB_SPIN(cond, bar) do { unsigned _sp = 0; while (cond) { __builtin_amdgcn_s_sleep(1); \
    if ((++_sp & 255u) == 0u) { if (xb_ld(&(bar)[XB_TMO])) break; if (_sp > XB_SPIN_CAP) { atomicAdd(&(bar)[XB_TMO], 1u); break; } } } } while (0)

struct XcdBarrier {
    unsigned* bar; unsigned x;
    volatile LAS unsigned* st;
};

__device__ __forceinline__ XcdBarrier xcd_barrier_post(unsigned* bar, volatile LAS unsigned* st) {
    XcdBarrier b; b.bar = bar; b.x = xb_xcc_id(); b.st = st;
    if (threadIdx.x == 0) (void)xb_add(&bar[XB_XCNT(b.x)], 1u);
    return b;
}
__device__ __forceinline__ void xcd_barrier_complete(unsigned* bar, unsigned x, unsigned& nloc, unsigned& nx) {
    const unsigned G = gridDim.x * gridDim.y * gridDim.z;
    unsigned sum, cnt, mine, sp = 0u;
    for (;;) {
        sum = 0u; cnt = 0u; mine = 0u;
#pragma unroll
        for (unsigned j = 0; j < 16; ++j) { const unsigned c = xb_ld(&bar[XB_XCNT(j)]); sum += c; cnt += (c > 0u) ? 1u : 0u; mine = (j == x) ? c : mine; }
        if (sum == G) break;
        __builtin_amdgcn_s_sleep(1);
        if ((++sp & 255u) == 0u) { if (xb_ld(&bar[XB_TMO])) break; if (sp > XB_SPIN_CAP) { atomicAdd(&bar[XB_TMO], 1u); break; } }
    }
    nloc = mine > 0u ? mine : 1u; nx = cnt > 0u ? cnt : 1u;
}

__device__ __forceinline__ void xcd_barrier(const XcdBarrier& b) {
    asm volatile("s_waitcnt vmcnt(0)" ::: "memory");
    __syncthreads();
    if (threadIdx.x == 0) {
        unsigned* bar = b.bar;
        __builtin_amdgcn_s_waitcnt(0);
        unsigned nloc = b.st[0], nx = b.st[1];
        if (nloc == 0u) { xcd_barrier_complete(bar, b.x, nloc, nx); b.st[0] = nloc; b.st[1] = nx; }
        const unsigned old = xb_add(&bar[XB_XSUB(b.x)], 1u);
        const unsigned gen = old / nloc;
        if (old + 1u == (gen + 1u) * nloc) {
            __builtin_amdgcn_fence(__ATOMIC_RELEASE, "agent");
            asm volatile("s_waitcnt vmcnt(0)" ::: "memory");
            const unsigned og = xb_add(&bar[XB_TOP], 1u);
            const unsigned tg = og / nx;
            if (og + 1u == (tg + 1u) * nx) xb_add(&bar[XB_TOPGEN], 1u);
            else XB_SPIN(xb_ld(&bar[XB_TOPGEN]) == tg, bar);
            __builtin_amdgcn_fence(__ATOMIC_ACQUIRE, "agent");
            xb_add(&bar[XB_XGEN(b.x)], 1u);
            asm volatile("s_waitcnt vmcnt(0)" ::: "memory");
        } else {
            XB_SPIN(xb_ld(&bar[XB_XGEN(b.x)]) == gen, bar);
            __builtin_amdgcn_fence(__ATOMIC_ACQUIRE, "agent");
            asm volatile("s_waitcnt vmcnt(0)" ::: "memory");
        }
    }
    __syncthreads();
}


template <bool XF32IN, bool HASY, bool XF32OUT>
__device__ __forceinline__ void ph_resid_norm(const GAS bf16* Yb, const GAS float* gpost, const GAS float* gnext, const GAS float* Xf_in, const GAS bf16* Xb_in, GAS float* Xf_out, GAS bf16* Xb_out, GAS bf16* H,
                                              int gw, int ngw, int lane) {
    for (int m = gw; m < M; m += ngw) {
        float xv[4][8];
#pragma unroll
        for (int j = 0; j < 4; ++j) { const size_t e = (size_t)m * D + 8 * (lane + 64 * j);
            if (XF32IN) { const f32x4 a = *(const GAS f32x4*)(Xf_in + e), c = *(const GAS f32x4*)(Xf_in + e + 4); xv[j][0] = a.x; xv[j][1] = a.y; xv[j][2] = a.z; xv[j][3] = a.w; xv[j][4] = c.x; xv[j][5] = c.y; xv[j][6] = c.z; xv[j][7] = c.w; }
            else unpack8(*(const GAS u32x4*)(Xb_in + e), xv[j]); }
        if (HASY) {
            float yv[4][8]; float ss = 0.f;
#pragma unroll
            for (int j = 0; j < 4; ++j) { unpack8(*(const GAS u32x4*)(Yb + (size_t)m * D + 8 * (lane + 64 * j)), yv[j]);
#pragma unroll
                for (int i = 0; i < 8; ++i) ss += yv[j][i] * yv[j][i]; }
            const float rstd = rsqrtf(wave_sum(ss) * (1.0f / D) + EPS);
#pragma unroll
            for (int j = 0; j < 4; ++j) { const GAS float* gp = gpost + 8 * (lane + 64 * j); const f32x4 g0 = *(const GAS f32x4*)gp, g1 = *(const GAS f32x4*)(gp + 4);
                xv[j][0] += yv[j][0] * rstd * g0.x; xv[j][1] += yv[j][1] * rstd * g0.y; xv[j][2] += yv[j][2] * rstd * g0.z; xv[j][3] += yv[j][3] * rstd * g0.w;
                xv[j][4] += yv[j][4] * rstd * g1.x; xv[j][5] += yv[j][5] * rstd * g1.y; xv[j][6] += yv[j][6] * rstd * g1.z; xv[j][7] += yv[j][7] * rstd * g1.w; }
        }
#pragma unroll
        for (int j = 0; j < 4; ++j) { const size_t e = (size_t)m * D + 8 * (lane + 64 * j);
            if (XF32OUT) { *(GAS f32x4*)(Xf_out + e) = (f32x4){xv[j][0], xv[j][1], xv[j][2], xv[j][3]}; *(GAS f32x4*)(Xf_out + e + 4) = (f32x4){xv[j][4], xv[j][5], xv[j][6], xv[j][7]}; }
            else *(GAS u32x4*)(Xb_out + e) = pack8(xv[j]); }
        if (gnext) {
            float ss = 0.f;
#pragma unroll
            for (int j = 0; j < 4; ++j)
#pragma unroll
                for (int i = 0; i < 8; ++i) ss += xv[j][i] * xv[j][i];
            const float rstd = rsqrtf(wave_sum(ss) * (1.0f / D) + EPS);
#pragma unroll
            for (int j = 0; j < 4; ++j) { const GAS float* gp = gnext + 8 * (lane + 64 * j); const f32x4 g0 = *(const GAS f32x4*)gp, g1 = *(const GAS f32x4*)(gp + 4);
                float h[8] = {xv[j][0] * rstd * g0.x, xv[j][1] * rstd * g0.y, xv[j][2] * rstd * g0.z, xv[j][3] * rstd * g0.w, xv[j][4] * rstd * g1.x, xv[j][5] * rstd * g1.y, xv[j][6] * rstd * g1.z, xv[j][7] * rstd * g1.w};
                *(GAS u32x4*)(H + (size_t)m * D + 8 * (lane + 64 * j)) = pack8(h); }
        }
    }
}

__device__ __forceinline__ void tr_item(const GAS float* W, int ldw, int K, int k0, int nsrc, int ncols, GAS bf16* WT, int ndst, LAS unsigned char* tile, int lane) {
    const int c4 = (lane & 15) * 4, kr = lane >> 4;
    f32x4 v[16];
#pragma unroll
    for (int i = 0; i < 16; ++i) v[i] = (c4 < ncols) ? *(const GAS f32x4*)(W + (size_t)(k0 + 4 * i + kr) * ldw + nsrc + c4) : (f32x4){0.f, 0.f, 0.f, 0.f};
#pragma unroll
    for (int i = 0; i < 16; ++i) { u32x2 w; w.x = cvtpk(v[i].x, v[i].y); w.y = cvtpk(v[i].z, v[i].w); *(LAS u32x2*)(tile + (4 * i + kr) * 160 + (lane & 15) * 8) = w; }
    LDS_WAIT();
    const int g = lane >> 4, c16 = lane & 15;
    const LAS unsigned char* tb = tile + (8 * g + (c16 >> 2)) * 160 + (c16 & 3) * 8;
#pragma unroll
    for (int nt = 0; nt < 4; ++nt)
#pragma unroll
        for (int kh = 0; kh < 2; ++kh) {
            const s16x4 lo = lds_tr4(tb + (32 * kh) * 160 + nt * 32), hi = lds_tr4(tb + (32 * kh + 4) * 160 + nt * 32);
            *(GAS bf16x8*)(WT + (size_t)(ndst + 16 * nt + c16) * K + k0 + 32 * kh + 8 * g) = __builtin_shufflevector(lo, hi, 0, 1, 2, 3, 4, 5, 6, 7); }
    LDS_WAIT();
}
__device__ __forceinline__ void win_map(int dstrow, int& src, int& ncols) {
    ncols = 64;
    if (dstrow < 10240) src = dstrow;
    else if (dstrow < 12288) src = dstrow - 10240 + 10304;
    else if (dstrow < 12800) src = dstrow - 12288 + 12352;
    else if (dstrow < 13312) src = dstrow - 12800 + 12864;
    else if (dstrow < 14336) src = dstrow - 13312 + 13376;
    else if (dstrow < 18432) src = dstrow - 14336 + 14480;
    else if (dstrow < 18496) src = dstrow - 18432 + 10240;
    else if (dstrow < 18560) src = dstrow - 18496 + 14400;
    else if (dstrow == 18560) { src = 14464; ncols = 16; }
    else { src = 0; ncols = 0; }
}
struct WPtrs { const GAS float *w_in, *w_ssm, *w_att, *w_mix, *w_up, *w_dn; };
__device__ __forceinline__ void ph_weights(const WPtrs wp, GAS unsigned char* ws, LAS unsigned char* tile, int gw, int ngw, int lane) {
    constexpr int I_IN = (NPAD / 64) * (D / 64), I_SSM = (D / 64) * (DI / 64), I_ATT = (D / 64) * (D / 64), I_MIX = I_ATT, I_UP = (FF2 / 64) * (D / 64), I_DN = (D / 64) * (FF / 64);
    constexpr int I_L = I_IN + I_SSM + I_ATT + I_MIX + I_UP + I_DN;
    for (int it = gw; it < DEPTH * I_L; it += ngw) {
        const int layer = it / I_L; int r = it % I_L;
        GAS unsigned char* wl = ws + WS_W + (size_t)layer * WL_SIZE;
        if (r < I_IN) { const int nblk = NPAD / 64, kb = r / nblk, nb = r % nblk; int src, nc; win_map(nb * 64, src, nc);
            tr_item(wp.w_in + (size_t)layer * D * NIN, NIN, D, kb * 64, src, nc, (GAS bf16*)(wl + WL_IN), nb * 64, tile, lane); continue; }
        r -= I_IN;
        if (r < I_SSM) { const int nblk = D / 64, kb = r / nblk, nb = r % nblk; tr_item(wp.w_ssm + (size_t)layer * DI * D, D, DI, kb * 64, nb * 64, 64, (GAS bf16*)(wl + WL_SSM), nb * 64, tile, lane); continue; }
        r -= I_SSM;
        if (r < I_ATT) { const int nblk = D / 64, kb = r / nblk, nb = r % nblk; tr_item(wp.w_att + (size_t)layer * D * D, D, D, kb * 64, nb * 64, 64, (GAS bf16*)(wl + WL_ATT), nb * 64, tile, lane); continue; }
        r -= I_ATT;
        if (r < I_MIX) { const int nblk = D / 64, kb = r / nblk, nb = r % nblk; tr_item(wp.w_mix + (size_t)layer * D * D, D, D, kb * 64, nb * 64, 64, (GAS bf16*)(wl + WL_MIX), nb * 64, tile, lane); continue; }
        r -= I_MIX;
        if (r < I_UP) { const int nblk = FF2 / 64, kb = r / nblk, nb = r % nblk; tr_item(wp.w_up + (size_t)layer * D * FF2, FF2, D, kb * 64, nb * 64, 64, (GAS bf16*)(wl + WL_UP), nb * 64, tile, lane); continue; }
        r -= I_UP;
        { const int nblk = D / 64, kb = r / nblk, nb = r % nblk; tr_item(wp.w_dn + (size_t)layer * FF * D, D, FF, kb * 64, nb * 64, 64, (GAS bf16*)(wl + WL_DN), nb * 64, tile, lane); }
    }
}

__device__ __forceinline__ void ph_small_proj(const GAS bf16* H, const GAS bf16* Ws, GAS float* SM, GAS bf16* KIB, LAS unsigned char* lds, int blk, int nblk, int tid) {
    constexpr int HS = 4112;
    const int lane = tid & 63, wave = __builtin_amdgcn_readfirstlane(tid >> 6), g = lane >> 4, c16 = lane & 15;
    for (int rb = blk; rb < M / 32; rb += nblk) {
        __syncthreads();
#pragma unroll
        for (int i = 0; i < 16; ++i) { const int id = tid + 512 * i, r = id >> 8, ch = id & 255;
            *(LAS u32x4*)(lds + r * HS + ch * 16) = *(const GAS u32x4*)(H + (size_t)(rb * 32 + r) * D + ch * 8); }
        __syncthreads();
        f32x4 acc[2] = {(f32x4){0.f, 0.f, 0.f, 0.f}, (f32x4){0.f, 0.f, 0.f, 0.f}}, acc9[2] = {(f32x4){0.f, 0.f, 0.f, 0.f}, (f32x4){0.f, 0.f, 0.f, 0.f}};
        const GAS bf16* wrow = Ws + (size_t)(16 * wave + c16) * D + 8 * g;
        const GAS bf16* w9 = Ws + (size_t)(128 + c16) * D + 256 * wave + 8 * g;
        const LAS unsigned char* hb = lds + c16 * HS + g * 16;
#pragma unroll 8
        for (int ks = 0; ks < 64; ++ks) {
            const bf16x8 wf = *(const GAS bf16x8*)(wrow + 32 * ks);
            const bf16x8 h0 = *(const LAS bf16x8*)(hb + ks * 64), h1 = *(const LAS bf16x8*)(hb + 16 * HS + ks * 64);
            acc[0] = __builtin_amdgcn_mfma_f32_16x16x32_bf16(wf, h0, acc[0], 0, 0, 0); acc[1] = __builtin_amdgcn_mfma_f32_16x16x32_bf16(wf, h1, acc[1], 0, 0, 0);
        }
#pragma unroll
        for (int k8 = 0; k8 < 8; ++k8) { const int ks = 8 * wave + k8;
            const bf16x8 wf = *(const GAS bf16x8*)(w9 + 32 * k8);
            const bf16x8 h0 = *(const LAS bf16x8*)(hb + ks * 64), h1 = *(const LAS bf16x8*)(hb + 16 * HS + ks * 64);
            acc9[0] = __builtin_amdgcn_mfma_f32_16x16x32_bf16(wf, h0, acc9[0], 0, 0, 0); acc9[1] = __builtin_amdgcn_mfma_f32_16x16x32_bf16(wf, h1, acc9[1], 0, 0, 0);
        }
#pragma unroll
        for (int rt = 0; rt < 2; ++rt) { const size_t row = (size_t)(rb * 32 + 16 * rt + c16);
            *(GAS f32x4*)(SM + row * SMW + 16 * wave + 4 * g) = acc[rt];
            if (wave >= 4) { u32x2 w; w.x = cvtpk(acc[rt].x, acc[rt].y); w.y = cvtpk(acc[rt].z, acc[rt].w); *(GAS u32x2*)(KIB + row * IDD + 16 * (wave - 4) + 4 * g) = w; } }
        __syncthreads();
        *(LAS f32x4*)(lds + ((wave * 2 + 0) * 64 + lane) * 16) = acc9[0]; *(LAS f32x4*)(lds + ((wave * 2 + 1) * 64 + lane) * 16) = acc9[1];
        __syncthreads();
        if (wave < 2) { f32x4 s = (f32x4){0.f, 0.f, 0.f, 0.f};
#pragma unroll
            for (int w8 = 0; w8 < 8; ++w8) s += *(const LAS f32x4*)(lds + ((w8 * 2 + wave) * 64 + lane) * 16);
            *(GAS f32x4*)(SM + (size_t)(rb * 32 + 16 * wave + c16) * SMW + 128 + 4 * g) = s; }
    }
}

__device__ __forceinline__ void ph_index_scores(const GAS bf16* P, const GAS float* SM, const GAS bf16* KIB, GAS float* SC, LAS unsigned char* lds, int blk, int nblk, int tid) {
    constexpr int QS = 1040;
    const int lane = tid & 63, wave = __builtin_amdgcn_readfirstlane(tid >> 6);
    for (int u0 = blk; u0 < 256; u0 += nblk) {
#pragma unroll 1
        for (int half = 0; half < 2; ++half) {
            const int b = half, qt = half ? 255 - u0 : u0;
            const int q0 = b * SEQ + qt * 16, nkt = ((qt * 16) / 64 + 1) * 4;
            const int qrow = q0 + (lane & 15), kq = 8 * (lane >> 4);
            __syncthreads();
#pragma unroll
            for (int i = 0; i < 2; ++i) { const int id = tid + 512 * i, q = id >> 6, ch = id & 63;
                *(LAS u32x4*)(lds + q * QS + ch * 16) = *(const GAS u32x4*)(P + (size_t)(q0 + q) * NMAIN + PQI + 8 * IDD + ch * 8); }
            bf16x8 bq[8][2]; float w[IH];
#pragma unroll
            for (int h = 0; h < IH; ++h) {
                if (h < 8) {
#pragma unroll
                    for (int ks = 0; ks < 2; ++ks) bq[h][ks] = *(const GAS bf16x8*)(P + (size_t)qrow * NMAIN + PQI + h * IDD + ks * 32 + kq); }
                w[h] = SM[(size_t)qrow * SMW + SM_WI + h]; }
            __syncthreads();
            const LAS unsigned char* qb = lds + (lane & 15) * QS + kq * 2;
            for (int kt = wave; kt < nkt; kt += NWAVES) {
                const int key0 = kt * 16; const GAS bf16* kp = KIB + (size_t)(b * SEQ + key0 + (lane & 15)) * IDD + kq;
                const bf16x8 a0 = *(const GAS bf16x8*)kp, a1 = *(const GAS bf16x8*)(kp + 32);
                f32x4 sc = (f32x4){0.f, 0.f, 0.f, 0.f};
#pragma unroll
                for (int h = 0; h < IH; ++h) { f32x4 c = (f32x4){0.f, 0.f, 0.f, 0.f};
                    const bf16x8 b0 = h < 8 ? bq[h & 7][0] : *(const LAS bf16x8*)(qb + (h - 8) * 128), b1 = h < 8 ? bq[h & 7][1] : *(const LAS bf16x8*)(qb + (h - 8) * 128 + 64);
                    c = __builtin_amdgcn_mfma_f32_16x16x32_bf16(a0, b0, c, 0, 0, 0); c = __builtin_amdgcn_mfma_f32_16x16x32_bf16(a1, b1, c, 0, 0, 0);
                    sc.x += w[h] * fmaxf(c.x, 0.f); sc.y += w[h] * fmaxf(c.y, 0.f); sc.z += w[h] * fmaxf(c.z, 0.f); sc.w += w[h] * fmaxf(c.w, 0.f); }
                *(GAS f32x4*)(SC + (size_t)qrow * SEQ + key0 + 4 * (lane >> 4)) = sc;
            }
        }
    }
}

__device__ __forceinline__ void topk_bitwise(const GAS float* srow, GAS unsigned long long* mw, int limit, int lane) {
    unsigned u[64];
#pragma unroll
    for (int j = 0; j < 64; ++j) { const int key = j * 64 + lane; unsigned v = 0u;
        if (key < limit) { const unsigned bits = __float_as_uint(srow[key]); v = (bits & 0x80000000u) ? ~bits : (bits | 0x80000000u); }
        u[j] = v; }
    unsigned T = 0u;
#pragma unroll 1
    for (int bit = 31; bit >= 0; --bit) { const unsigned cand = T | (1u << bit); int cnt = 0;
#pragma unroll
        for (int j = 0; j < 64; ++j) cnt += __popcll(__ballot(u[j] >= cand));
        if (cnt >= TOPK) T = cand; }
    int cgt = 0;
#pragma unroll
    for (int j = 0; j < 64; ++j) cgt += __popcll(__ballot(u[j] > T));
    const int need_eq = TOPK - cgt; int eqbase = 0;
    const unsigned long long lt_mask = (1ull << lane) - 1ull;
#pragma unroll
    for (int j = 0; j < 64; ++j) {
        const bool gt = u[j] > T, eq = u[j] == T;
        const unsigned long long eqm = __ballot(eq);
        const bool take = gt || (eq && (eqbase + __popcll(eqm & lt_mask) < need_eq));
        const unsigned long long tm = __ballot(take);
        if (lane == 0 && j * 64 < limit) mw[j] = tm;
        eqbase += __popcll(eqm);
    }
}
__device__ __forceinline__ void ph_topk(const GAS float* SC, GAS unsigned long long* MASKW, LAS unsigned char* wl, int gw, int ngw, int lane) {
    constexpr int CAP = 1024;
    LAS unsigned* hist = (LAS unsigned*)wl;
    LAS unsigned* maskc = (LAS unsigned*)(wl + 1024);
    LAS float* cval = (LAS float*)(wl + 1536);
    LAS unsigned* ckey = (LAS unsigned*)(wl + 1536 + 4 * CAP);
    const unsigned long long lt_mask = (1ull << lane) - 1ull;
    for (int m = gw; m < M; m += ngw) {
        const int t = m & (SEQ - 1), limit = (t / 64 + 1) * 64, nw = limit / 64;
        GAS unsigned long long* mw = MASKW + (size_t)m * 64;
        if (limit <= TOPK) { unsigned ones = 0xffffffffu; asm volatile("" : "+v"(ones)); if (lane < nw) mw[lane] = ((unsigned long long)ones << 32) | ones; continue; }
        const GAS float* srow = SC + (size_t)m * SEQ;
        float s[64]; float smax = -__builtin_inff(), smin = __builtin_inff();
#pragma unroll
        for (int j = 0; j < 64; ++j) { s[j] = (j < nw) ? srow[j * 64 + lane] : 0.f; if (j < nw) { smax = fmaxf(smax, s[j]); smin = fminf(smin, s[j]); } }
        smax = wave_max(smax); smin = -wave_max(-smin);
        const float scale = smax > smin ? 255.0f / (smax - smin) : 0.f;
        asm volatile("" ::: "memory");
        hist[lane] = 0u; hist[lane + 64] = 0u; hist[lane + 128] = 0u; hist[lane + 192] = 0u; maskc[lane] = 0u; maskc[lane + 64] = 0u;
        LDS_WAIT();
#pragma unroll
        for (int j = 0; j < 64; ++j) if (j < nw) { const int b = min(255, (int)((s[j] - smin) * scale)); __hip_atomic_fetch_add(&hist[b], 1u, __ATOMIC_RELAXED, __HIP_MEMORY_SCOPE_WORKGROUP); }
        LDS_WAIT();
        const unsigned c0 = hist[4 * lane], c1 = hist[4 * lane + 1], c2 = hist[4 * lane + 2], c3 = hist[4 * lane + 3];
        unsigned suf = c0 + c1 + c2 + c3;
#pragma unroll
        for (int o = 1; o < 64; o <<= 1) { const unsigned v = __shfl_down(suf, o); if (lane + o < 64) suf += v; }
        const unsigned above = suf - (c0 + c1 + c2 + c3);
        int bstar = -1; unsigned cab = 0u;
        { unsigned cum = above;
          if (cum < TOPK && cum + c3 >= TOPK) { bstar = 4 * lane + 3; cab = cum; } cum += c3;
          if (bstar < 0 && cum < TOPK && cum + c2 >= TOPK) { bstar = 4 * lane + 2; cab = cum; } cum += c2;
          if (bstar < 0 && cum < TOPK && cum + c1 >= TOPK) { bstar = 4 * lane + 1; cab = cum; } cum += c1;
          if (bstar < 0 && cum < TOPK && cum + c0 >= TOPK) { bstar = 4 * lane + 0; cab = cum; } }
        const unsigned long long who = __ballot(bstar >= 0);
        const int src = __builtin_ctzll(who);
        bstar = __shfl(bstar, src); cab = __shfl(cab, src);
        const int need = TOPK - (int)cab;
        const unsigned ncand = hist[bstar];
        if (ncand > (unsigned)CAP) { topk_bitwise(srow, mw, limit, lane); continue; }
        unsigned long long myword = 0ull; int base = 0;
#pragma unroll
        for (int j = 0; j < 64; ++j) if (j < nw) {
            const int b = min(255, (int)((s[j] - smin) * scale));
            const unsigned long long gm = __ballot(b > bstar), em = __ballot(b == bstar);
            if (lane == j) myword = gm;
            if (b == bstar) { const int pos = base + __popcll(em & lt_mask); cval[pos] = s[j]; ckey[pos] = (unsigned)(j * 64 + lane); }
            base += __popcll(em);
        }
        LDS_WAIT();
        for (int i = lane; i < base; i += 64) { const float vi = cval[i]; const unsigned ki = ckey[i]; int rank = 0;
            if (need < base) { for (int q = 0; q < base; ++q) { const float vq = cval[q]; const unsigned kq = ckey[q]; rank += (vq > vi || (vq == vi && kq < ki)) ? 1 : 0; } }
            if (rank < need) __hip_atomic_fetch_or(&maskc[ki >> 5], 1u << (ki & 31), __ATOMIC_RELAXED, __HIP_MEMORY_SCOPE_WORKGROUP); }
        LDS_WAIT();
        if (lane < nw) { const unsigned long long cw_ = ((unsigned long long)maskc[2 * lane + 1] << 32) | maskc[2 * lane]; mw[lane] = myword | cw_; }
        LDS_WAIT(); asm volatile("" ::: "memory");
    }
}

__device__ __forceinline__ float xmax16(float x) { auto r = __builtin_amdgcn_permlane16_swap(__float_as_uint(x), __float_as_uint(x), false, false); return fmaxf(__uint_as_float(r[0]), __uint_as_float(r[1])); }
__device__ __forceinline__ float xmax32(float x) { auto r = __builtin_amdgcn_permlane32_swap(__float_as_uint(x), __float_as_uint(x), false, false); return fmaxf(__uint_as_float(r[0]), __uint_as_float(r[1])); }
__device__ __forceinline__ float xsum16(float x) { auto r = __builtin_amdgcn_permlane16_swap(__float_as_uint(x), __float_as_uint(x), false, false); return __uint_as_float(r[0]) + __uint_as_float(r[1]); }
__device__ __forceinline__ float xsum32(float x) { auto r = __builtin_amdgcn_permlane32_swap(__float_as_uint(x), __float_as_uint(x), false, false); return __uint_as_float(r[0]) + __uint_as_float(r[1]); }
template <int VAR> __device__ __forceinline__ void ph_attn_dense(const GAS bf16* P, const GAS unsigned long long* MASKW, GAS bf16* AO, LAS unsigned char* lds, int blk, int nblk, int tid) {
    constexpr int KS = 272, VS = 288, KBUF = 64 * KS, VBUF = 64 * VS, VOFF = 2 * KBUF, MOFF = VOFF + 2 * VBUF;
    const int lane = tid & 63, wave = __builtin_amdgcn_readfirstlane(tid >> 6), g = lane >> 4, c16 = lane & 15;
    const int hq = wave >> 1, qh = (wave & 1) * 32;
    const float SCL = ATTN_SCALE * 1.4426950408889634f;
    for (int u0 = blk; u0 < 256; u0 += nblk) {
#pragma unroll 1
        for (int half = 0; half < 2; ++half) {
            const int b = (u0 >> 2) & 1, kvh = u0 & 3, cc = u0 >> 3, c = half ? 63 - cc : cc, nt = c + 1;
            const int m0 = b * SEQ + c * 64;
            bf16x8 qf[2][4];
#pragma unroll
            for (int qt = 0; qt < 2; ++qt)
#pragma unroll
                for (int kd = 0; kd < 4; ++kd) qf[qt][kd] = *(const GAS bf16x8*)(P + (size_t)(m0 + qh + 16 * qt + c16) * NMAIN + PQ + (kvh * 4 + hq) * AD + 32 * kd + 8 * g);
            f32x4 O[2][8];
#pragma unroll
            for (int qt = 0; qt < 2; ++qt)
#pragma unroll
                for (int dt = 0; dt < 8; ++dt) O[qt][dt] = (f32x4){0.f, 0.f, 0.f, 0.f};
            float mrun[2] = {-1e30f, -1e30f}, lrun[2] = {0.f, 0.f};
            const GAS bf16* kvbase = P + (size_t)(b * SEQ) * NMAIN + kvh * AD;
            u32x4 kreg[2], vreg[2];
#define ATT_LOAD(t) do { _Pragma("unroll") for (int i = 0; i < 2; ++i) { const int id = tid + 512 * i; const GAS bf16* src = kvbase + (size_t)((t) * 64 + (id >> 4)) * NMAIN + (id & 15) * 8; \
                kreg[i] = *(const GAS u32x4*)(src + PK); vreg[i] = *(const GAS u32x4*)(src + PV); } } while (0)
#define ATT_STORE(buf) do { _Pragma("unroll") for (int i = 0; i < 2; ++i) { const int id = tid + 512 * i; \
                *(LAS u32x4*)(lds + (buf) * KBUF + (id >> 4) * KS + (id & 15) * 16) = kreg[i]; *(LAS u32x4*)(lds + VOFF + (buf) * VBUF + (id >> 4) * VS + (id & 15) * 16) = vreg[i]; } } while (0)
            __syncthreads();
            ATT_LOAD(0); ATT_STORE(0);
#pragma unroll
            for (int i = 0; i < 4; ++i) { const int id = tid + 512 * i; *(LAS u32x4*)(lds + MOFF + id * 16) = *(const GAS u32x4*)((const GAS unsigned char*)(MASKW + (size_t)m0 * 64) + id * 16); }
            const LAS unsigned long long* mrow0 = (const LAS unsigned long long*)(lds + MOFF) + (qh + c16) * 64; const LAS unsigned long long* mrow1 = mrow0 + 16 * 64;
            __syncthreads();
            for (int t = 0; t < nt; ++t) {
                const int buf = (VAR & 1) ? 0 : (t & 1);
                if (!(VAR & 1) && t + 1 < nt) ATT_LOAD(t + 1);
                const LAS unsigned char* kb = lds + buf * KBUF + c16 * KS + g * 16;
                const LAS unsigned char* vb = lds + VOFF + buf * VBUF + (4 * g + (c16 >> 2)) * VS + (c16 & 3) * 8;
                f32x4 S[2][4];
                bf16x8 kf[2][4];
#pragma unroll
                for (int kd = 0; kd < 4; ++kd) kf[0][kd] = *(const LAS bf16x8*)(kb + kd * 64);
#pragma unroll
                for (int kt = 0; kt < 4; ++kt) {
                    if (kt < 3) {
#pragma unroll
                        for (int kd = 0; kd < 4; ++kd) kf[(kt + 1) & 1][kd] = *(const LAS bf16x8*)(kb + (kt + 1) * 16 * KS + kd * 64); }
#pragma unroll
                    for (int qt = 0; qt < 2; ++qt) { f32x4 s = (f32x4){0.f, 0.f, 0.f, 0.f};
#pragma unroll
                        for (int kd = 0; kd < 4; ++kd) { if (!(VAR & 8)) s = __builtin_amdgcn_mfma_f32_16x16x32_bf16(kf[kt & 1][kd], qf[qt][kd], s, 0, 0, 0); else s += __builtin_bit_cast(f32x4, kf[kt & 1][kd]); }
                        S[qt][kt] = s; }
                }
                s16x4 vlo[8][2], vhi[8][2];
#pragma unroll
                for (int dt = 0; dt < 4; ++dt)
#pragma unroll
                    for (int ks = 0; ks < 2; ++ks) { vlo[dt][ks] = lds_tr4(vb + (32 * ks) * VS + dt * 32); vhi[dt][ks] = lds_tr4(vb + (32 * ks + 16) * VS + dt * 32); }
                bf16x8 pf[2][2];
#pragma unroll
                for (int qt = 0; qt < 2; ++qt) {
                    const unsigned long long mw = (qt ? mrow1[t] : mrow0[t]) >> (4 * g);
                    const int mlo = (int)(unsigned)mw, mhi = (int)(unsigned)(mw >> 32);
                    float mx = fmaxf(fmaxf(S[qt][0][0], S[qt][0][1]), fmaxf(S[qt][0][2], S[qt][0][3]));
#pragma unroll
                    for (int kt = 1; kt < 4; ++kt) mx = fmaxf(fmaxf(mx, S[qt][kt][0]), fmaxf(fmaxf(S[qt][kt][1], S[qt][kt][2]), S[qt][kt][3]));
                    mx = xmax16(mx); mx = xmax32(mx);
                    const float mnew = fmaxf(mrun[qt], mx * SCL);
                    const float alpha = __builtin_amdgcn_exp2f(mrun[qt] - mnew);
                    float ps = 0.f;
#pragma unroll
                    for (int kt = 0; kt < 4; ++kt)
#pragma unroll
                        for (int j = 0; j < 4; ++j) { const int sel = __builtin_amdgcn_sbfe(kt < 2 ? mlo : mhi, (kt & 1) * 16 + j, 1);
                            const float p = (VAR & 2) ? S[qt][kt][j] : __uint_as_float(__float_as_uint(__builtin_amdgcn_exp2f(__builtin_fmaf(S[qt][kt][j], SCL, -mnew))) & (unsigned)sel); S[qt][kt][j] = p; ps += p; }
                    ps = xsum16(ps); ps = xsum32(ps);
                    lrun[qt] = lrun[qt] * alpha + ps; mrun[qt] = mnew;
                    if (!__all(alpha == 1.0f)) {
#pragma unroll
                        for (int dt = 0; dt < 8; ++dt) O[qt][dt] *= alpha; }
#pragma unroll
                    for (int ks = 0; ks < 2; ++ks) { u32x4 w; w.x = cvtpk(S[qt][2 * ks][0], S[qt][2 * ks][1]); w.y = cvtpk(S[qt][2 * ks][2], S[qt][2 * ks][3]);
                        w.z = cvtpk(S[qt][2 * ks + 1][0], S[qt][2 * ks + 1][1]); w.w = cvtpk(S[qt][2 * ks + 1][2], S[qt][2 * ks + 1][3]); pf[qt][ks] = __builtin_bit_cast(bf16x8, w); }
                }
#pragma unroll
                for (int dt = 4; dt < 8; ++dt)
#pragma unroll
                    for (int ks = 0; ks < 2; ++ks) { vlo[dt][ks] = lds_tr4(vb + (32 * ks) * VS + dt * 32); vhi[dt][ks] = lds_tr4(vb + (32 * ks + 16) * VS + dt * 32); }
#pragma unroll
                for (int dt = 0; dt < 8; ++dt)
#pragma unroll
                    for (int ks = 0; ks < 2; ++ks) {
                        const bf16x8 vf = __builtin_shufflevector(vlo[dt][ks], vhi[dt][ks], 0, 1, 2, 3, 4, 5, 6, 7);
                        if (!(VAR & 4)) { O[0][dt] = __builtin_amdgcn_mfma_f32_16x16x32_bf16(vf, pf[0][ks], O[0][dt], 0, 0, 0);
                        O[1][dt] = __builtin_amdgcn_mfma_f32_16x16x32_bf16(vf, pf[1][ks], O[1][dt], 0, 0, 0); } else { O[0][dt] += __builtin_bit_cast(f32x4, pf[0][ks]); O[1][dt] += __builtin_bit_cast(f32x4, pf[1][ks]); }
                    }
                if (!(VAR & 1) && t + 1 < nt) ATT_STORE(buf ^ 1);
                __syncthreads();
            }
#undef ATT_LOAD
#undef ATT_STORE
#pragma unroll
            for (int qt = 0; qt < 2; ++qt) { const float r = 1.0f / lrun[qt];
                GAS bf16* op = AO + (size_t)(m0 + qh + 16 * qt + c16) * D + (kvh * 4 + hq) * AD + 4 * g;
#pragma unroll
                for (int dt = 0; dt < 8; ++dt) { const f32x4 o = O[qt][dt] * r; u32x2 w; w.x = pk2(o.x, o.y); w.y = pk2(o.z, o.w); *(GAS u32x2*)(op + 16 * dt) = w; } }
        }
    }
}

__device__ __forceinline__ void stage_conv(const GAS bf16* P, const GAS float* cw, const GAS float* cb, int m0, int tpos0, int ch0, int nch, LAS unsigned char* dst, int stride, int tid) {
    const int cpr = nch >> 3;
    for (int id = tid; id < 64 * cpr; id += NTHR) {
        const int s = id / cpr, k = id - s * cpr, ch = ch0 + 8 * k;
        float acc[8];
        { const f32x4 b0 = *(const GAS f32x4*)(cb + ch), b1 = *(const GAS f32x4*)(cb + ch + 4); acc[0] = b0.x; acc[1] = b0.y; acc[2] = b0.z; acc[3] = b0.w; acc[4] = b1.x; acc[5] = b1.y; acc[6] = b1.z; acc[7] = b1.w; }
#pragma unroll
        for (int i = 0; i < 4; ++i) { if (tpos0 + s - 3 + i >= 0) {
            float x[8]; unpack8(*(const GAS u32x4*)(P + (size_t)(m0 + s - 3 + i) * NMAIN + PXBC + ch), x);
            const f32x4 w0 = *(const GAS f32x4*)(cw + i * CONVD + ch), w1 = *(const GAS f32x4*)(cw + i * CONVD + ch + 4);
            acc[0] += w0.x * x[0]; acc[1] += w0.y * x[1]; acc[2] += w0.z * x[2]; acc[3] += w0.w * x[3]; acc[4] += w1.x * x[4]; acc[5] += w1.y * x[5]; acc[6] += w1.z * x[6]; acc[7] += w1.w * x[7]; } }
#pragma unroll
        for (int j = 0; j < 8; ++j) acc[j] = siluf_(acc[j]);
        *(LAS u32x4*)(dst + s * stride + k * 16) = pack8(acc);
    }
}
__device__ __forceinline__ void wave_dt_acs(const GAS float* SM, const GAS float* dt_bias, const GAS float* a_log, int m0, int head, LAS float* dtw, LAS float* acsw, int lane) {
    const float raw = SM[(size_t)(m0 + lane) * SMW + SM_DT + head] + dt_bias[head];
    const float dt = fmaxf(raw, 0.f) + log1pf(__expf(-fabsf(raw)));
    float x = dt * (-__expf(a_log[head]));
#pragma unroll
    for (int o = 1; o < 64; o <<= 1) { const float v = __shfl_up(x, o); if (lane >= o) x += v; }
    dtw[lane] = dt; acsw[lane] = x;
}
__device__ __forceinline__ bf16x8 tr8(const LAS unsigned char* p, int off_lo, int off_hi) {
    const s16x4 lo = lds_tr4(p + off_lo), hi = lds_tr4(p + off_hi); return __builtin_shufflevector(lo, hi, 0, 1, 2, 3, 4, 5, 6, 7);
}
template <int NOUT> __device__ __forceinline__ void conv_strip(const GAS bf16* src, int tpos_first_raw, const GAS float* cw, const GAS float* cb, u32x4 (&out)[NOUT]) {
    u32x4 raw[NOUT + 3];
#pragma unroll
    for (int i = 0; i < NOUT + 3; ++i) { const int tp = tpos_first_raw + i; raw[i] = *(const GAS u32x4*)(src + (size_t)(tp < 0 ? 3 : i) * NMAIN); if (tp < 0) raw[i] = (u32x4){0u, 0u, 0u, 0u}; }
    f32x4 w[4][2];
#pragma unroll
    for (int t = 0; t < 4; ++t) { w[t][0] = *(const GAS f32x4*)(cw + t * CONVD); w[t][1] = *(const GAS f32x4*)(cw + t * CONVD + 4); }
    const f32x4 b0 = *(const GAS f32x4*)cb, b1 = *(const GAS f32x4*)(cb + 4);
#pragma unroll
    for (int o = 0; o < NOUT; ++o) { f32x4 a0 = b0, a1 = b1;
#pragma unroll
        for (int t = 0; t < 4; ++t) { float x[8]; unpack8(raw[o + t], x); a0 += w[t][0] * (f32x4){x[0], x[1], x[2], x[3]}; a1 += w[t][1] * (f32x4){x[4], x[5], x[6], x[7]}; }
        float f[8] = {a0.x, a0.y, a0.z, a0.w, a1.x, a1.y, a1.z, a1.w};
#pragma unroll
        for (int j = 0; j < 8; ++j) f[j] = f[j] * __builtin_amdgcn_rcpf(1.0f + __expf(-f[j]));
        out[o] = pack8(f); }
}
__device__ __forceinline__ void ph_ssd_states(const GAS bf16* P, const GAS float* SM, const GAS float* cw, const GAS float* cb, const GAS float* dt_bias, const GAS float* a_log, GAS bf16* XC, GAS bf16* ST, GAS float* CD,
                                              LAS unsigned char* lds, int blk, int nblk, int tid) {
    constexpr int RSW = 160, XW = 64 * RSW, RSB = 288, BMB = 64 * RSB, O_BM = 8 * XW, O_DT = O_BM + 2 * BMB, O_ACS = O_DT + 2048;
    const int lane = tid & 63, wave = __builtin_amdgcn_readfirstlane(tid >> 6), gq = lane >> 4, c16 = lane & 15;
    LAS unsigned char* xw = lds + wave * XW;
    LAS float* dtw = (LAS float*)(lds + O_DT) + wave * 64; LAS float* acsw = (LAS float*)(lds + O_ACS) + wave * 64;
    int par = 0;
    for (int item = blk; item < BATCH * 64 * NG; item += nblk, par ^= 1) {
        const int bc = item >> 3, g = item & 7, m0 = bc * 64, tpos0 = (bc & 63) * 64, head = g * HPG + wave;
        LAS unsigned char* bm = lds + O_BM + par * BMB;
        asm volatile("" ::: "memory");
        { const int k16 = lane & 15, r0 = 8 * wave + 2 * gq, chB = DI + g * NS + 8 * k16;
          const GAS bf16* base = P + (size_t)(m0 + r0 - 3) * NMAIN + PXBC + chB;
          u32x4 ob[2], oc[2];
          conv_strip<2>(base, tpos0 + r0 - 3, cw + chB, cb + chB, ob);
          conv_strip<2>(base + NG * NS, tpos0 + r0 - 3, cw + chB + NG * NS, cb + chB + NG * NS, oc);
#pragma unroll
          for (int o = 0; o < 2; ++o) { *(LAS u32x4*)(bm + (r0 + o) * RSB + k16 * 16) = ob[o];
              *(GAS u32x4*)(XC + (size_t)(m0 + r0 + o) * CONVD + chB) = ob[o]; *(GAS u32x4*)(XC + (size_t)(m0 + r0 + o) * CONVD + chB + NG * NS) = oc[o]; } }
        { const int k8 = lane & 7, r0 = 8 * (lane >> 3), ch = head * HP + 8 * k8;
          u32x4 ox[8];
          conv_strip<8>(P + (size_t)(m0 + r0 - 3) * NMAIN + PXBC + ch, tpos0 + r0 - 3, cw + ch, cb + ch, ox);
#pragma unroll
          for (int o = 0; o < 8; ++o) { *(LAS u32x4*)(xw + (r0 + o) * RSW + k8 * 16) = ox[o]; *(GAS u32x4*)(XC + (size_t)(m0 + r0 + o) * CONVD + ch) = ox[o]; } }
        wave_dt_acs(SM, dt_bias, a_log, m0, head, dtw, acsw, lane);
        LDS_WAIT();
        __syncthreads();
        const float aend = acsw[63];
        if (lane == 0) CD[bc * NH + head] = __expf(aend);
        const LAS unsigned char* xb = xw + (4 * gq + (c16 >> 2)) * RSW + (c16 & 3) * 8;
        const LAS unsigned char* bb = bm + (4 * gq + (c16 >> 2)) * RSB + (c16 & 3) * 8;
        bf16x8 xf[4][2];
#pragma unroll
        for (int ks = 0; ks < 2; ++ks) { float w[8];
#pragma unroll
            for (int j = 0; j < 8; ++j) { const int s = 32 * ks + 16 * (j >> 2) + 4 * gq + (j & 3); w[j] = dtw[s] * __expf(aend - acsw[s]); }
#pragma unroll
            for (int pt = 0; pt < 4; ++pt) { const bf16x8 r = tr8(xb + pt * 32, (32 * ks) * RSW, (32 * ks + 16) * RSW); float f[8]; unpack8(__builtin_bit_cast(u32x4, r), f);
#pragma unroll
                for (int j = 0; j < 8; ++j) f[j] *= w[j];
                xf[pt][ks] = __builtin_bit_cast(bf16x8, pack8(f)); } }
        GAS bf16* dst = ST + (((size_t)bc * NH + head) * HP + c16) * NS + 4 * gq;
#pragma unroll 2
        for (int nt = 0; nt < 8; ++nt) {
            const bf16x8 a0 = tr8(bb + nt * 32, 0, 16 * RSB), a1 = tr8(bb + nt * 32, 32 * RSB, 48 * RSB);
#pragma unroll
            for (int pt = 0; pt < 4; ++pt) { f32x4 acc = (f32x4){0.f, 0.f, 0.f, 0.f};
                acc = __builtin_amdgcn_mfma_f32_16x16x32_bf16(a0, xf[pt][0], acc, 0, 0, 0); acc = __builtin_amdgcn_mfma_f32_16x16x32_bf16(a1, xf[pt][1], acc, 0, 0, 0);
                u32x2 o; o.x = pk2(acc.x, acc.y); o.y = pk2(acc.z, acc.w); *(GAS u32x2*)(dst + (size_t)(16 * pt) * NS + 16 * nt) = o; }
        }
        LDS_WAIT(); asm volatile("" ::: "memory");
    }
}
__device__ __forceinline__ void ph_ssd_scan(GAS bf16* ST, const GAS float* CD, int gtid, int nthr) {
    for (int it = gtid; it < BATCH * NH * HP * (NS / 8); it += nthr) {
        const int n8 = it & 15, p = (it >> 4) & 63, head = (it >> 10) & 63, b = it >> 16;
        float h[8];
#pragma unroll
        for (int j = 0; j < 8; ++j) h[j] = 0.f;
#pragma unroll 8
        for (int c = 0; c < 64; ++c) { GAS u32x4* q = (GAS u32x4*)(ST + ((((size_t)(b * 64 + c)) * NH + head) * HP + p) * NS) + n8;
            float v[8]; unpack8(*q, v); *q = pack8(h); const float dec = CD[(b * 64 + c) * NH + head];
#pragma unroll
            for (int j = 0; j < 8; ++j) h[j] = h[j] * dec + v[j]; }
    }
}
__device__ __forceinline__ void ph_ssd_out(const GAS bf16* P, const GAS float* SM, const GAS bf16* XC, const GAS float* dt_bias, const GAS float* a_log, const GAS bf16* ST,
                                           const GAS float* dskip, const GAS float* gnorm, GAS bf16* Y, LAS unsigned char* lds, int blk, int nblk, int tid) {
    constexpr int RSW = 160, XW = 64 * RSW, O_DT = 8 * XW, O_ACS = O_DT + 2048, O_SSQ = O_ACS + 2048;
    const int lane = tid & 63, wave = __builtin_amdgcn_readfirstlane(tid >> 6), gq = lane >> 4, c16 = lane & 15;
    LAS unsigned char* xw = lds + wave * XW;
    LAS float* dtw = (LAS float*)(lds + O_DT) + wave * 64; LAS float* acsw = (LAS float*)(lds + O_ACS) + wave * 64;
    int par = 0;
    for (int item = blk; item < BATCH * 64 * NG; item += nblk, par ^= 1) {
        const int bc = item >> 3, g = item & 7, m0 = bc * 64, head = g * HPG + wave;
        asm volatile("" ::: "memory");
        { u32x4 xr[8];
#pragma unroll
          for (int i = 0; i < 8; ++i) xr[i] = *(const GAS u32x4*)(XC + (size_t)(m0 + (lane >> 3) + 8 * i) * CONVD + head * HP + (lane & 7) * 8);
#pragma unroll
          for (int i = 0; i < 8; ++i) *(LAS u32x4*)(xw + ((lane >> 3) + 8 * i) * RSW + (lane & 7) * 16) = xr[i]; }
        wave_dt_acs(SM, dt_bias, a_log, m0, head, dtw, acsw, lane);
        const GAS bf16* cbase = XC + (size_t)(m0 + c16) * CONVD + DI + NG * NS + g * NS + 8 * gq;
        const GAS bf16* bbase = cbase - NG * NS;
        bf16x8 cf[4][4];
#pragma unroll
        for (int lt = 0; lt < 4; ++lt)
#pragma unroll
            for (int kn = 0; kn < 4; ++kn) cf[lt][kn] = *(const GAS bf16x8*)(cbase + (size_t)(16 * lt) * CONVD + 32 * kn);
        LDS_WAIT(); asm volatile("" ::: "memory");
        float al[4];
#pragma unroll
        for (int lt = 0; lt < 4; ++lt) al[lt] = acsw[16 * lt + c16];
        bf16x8 lf[2][4];
#pragma unroll
        for (int ks = 0; ks < 2; ++ks) {
            f32x4 lt4[2][4];
#pragma unroll
            for (int h2 = 0; h2 < 2; ++h2) { const int st = 2 * ks + h2;
                bf16x8 bfr[4];
#pragma unroll
                for (int kn = 0; kn < 4; ++kn) bfr[kn] = *(const GAS bf16x8*)(bbase + (size_t)(16 * st) * CONVD + 32 * kn);
                float as_[4], ds_[4];
#pragma unroll
                for (int j = 0; j < 4; ++j) { as_[j] = acsw[16 * st + 4 * gq + j]; ds_[j] = dtw[16 * st + 4 * gq + j]; }
#pragma unroll
                for (int lt = 0; lt < 4; ++lt) { f32x4 t4 = (f32x4){0.f, 0.f, 0.f, 0.f};
                    if (lt >= st) {
#pragma unroll
                        for (int kn = 0; kn < 4; ++kn) t4 = __builtin_amdgcn_mfma_f32_16x16x32_bf16(bfr[kn], cf[lt][kn], t4, 0, 0, 0);
#pragma unroll
                        for (int j = 0; j < 4; ++j) { const float e = __expf(fminf(al[lt] - as_[j], 0.f)) * ds_[j]; const bool ok = (lt > st) || (4 * gq + j <= c16); t4[j] = ok ? t4[j] * e : 0.f; } }
                    lt4[h2][lt] = t4; } }
#pragma unroll
            for (int lt = 0; lt < 4; ++lt) { u32x4 w; w.x = pk2(lt4[0][lt][0], lt4[0][lt][1]); w.y = pk2(lt4[0][lt][2], lt4[0][lt][3]); w.z = pk2(lt4[1][lt][0], lt4[1][lt][1]); w.w = pk2(lt4[1][lt][2], lt4[1][lt][3]);
                lf[ks][lt] = __builtin_bit_cast(bf16x8, w); }
        }
        f32x4 acc[4][4];
        const GAS bf16* hsrc = ST + (((size_t)bc * NH + head) * HP + c16) * NS + 8 * gq;
#pragma unroll
        for (int pt = 0; pt < 4; ++pt) { bf16x8 hf[4];
#pragma unroll
            for (int kn = 0; kn < 4; ++kn) hf[kn] = *(const GAS bf16x8*)(hsrc + (size_t)(16 * pt) * NS + 32 * kn);
#pragma unroll
            for (int lt = 0; lt < 4; ++lt) { f32x4 t4 = (f32x4){0.f, 0.f, 0.f, 0.f};
#pragma unroll
                for (int kn = 0; kn < 4; ++kn) t4 = __builtin_amdgcn_mfma_f32_16x16x32_bf16(hf[kn], cf[lt][kn], t4, 0, 0, 0);
                acc[pt][lt] = t4 * __expf(al[lt]); }
            asm volatile("" ::: "memory"); }
        const LAS unsigned char* xb = xw + (4 * gq + (c16 >> 2)) * RSW + (c16 & 3) * 8;
#pragma unroll
        for (int pt = 0; pt < 4; ++pt) {
            const bf16x8 x0 = tr8(xb + pt * 32, 0, 16 * RSW), x1 = tr8(xb + pt * 32, 32 * RSW, 48 * RSW);
#pragma unroll
            for (int lt = 0; lt < 4; ++lt) { acc[pt][lt] = __builtin_amdgcn_mfma_f32_16x16x32_bf16(x0, lf[0][lt], acc[pt][lt], 0, 0, 0);
                if (lt >= 2) acc[pt][lt] = __builtin_amdgcn_mfma_f32_16x16x32_bf16(x1, lf[1][lt], acc[pt][lt], 0, 0, 0); } }
        const float dk = dskip[head]; float ssq[4] = {0.f, 0.f, 0.f, 0.f};
#pragma unroll
        for (int lt = 0; lt < 4; ++lt) { const int l = 16 * lt + c16;
#pragma unroll
            for (int pt = 0; pt < 4; ++pt) { const int p0 = 16 * pt + 4 * gq;
                const u32x2 xv = *(const LAS u32x2*)(xw + l * RSW + p0 * 2); const u32x2 zw = *(const GAS u32x2*)(P + (size_t)(m0 + l) * NMAIN + PZ + head * HP + p0);
                const float xs4[4] = {bflo(xv.x), bfhi(xv.x), bflo(xv.y), bfhi(xv.y)}, z4[4] = {bflo(zw.x), bfhi(zw.x), bflo(zw.y), bfhi(zw.y)};
#pragma unroll
                for (int j = 0; j < 4; ++j) { const float y = (acc[pt][lt][j] + dk * xs4[j]) * z4[j] * __builtin_amdgcn_rcpf(1.0f + __expf(-z4[j])); acc[pt][lt][j] = y; ssq[lt] += y * y; } } }
        LAS float* ssqs = (LAS float*)(lds + O_SSQ) + par * 512;
#pragma unroll
        for (int lt = 0; lt < 4; ++lt) { float v = ssq[lt]; v += __shfl_xor(v, 16); v += __shfl_xor(v, 32); if (gq == 0) ssqs[wave * 64 + 16 * lt + c16] = v; }
        LDS_WAIT();
        __syncthreads();
#pragma unroll
        for (int lt = 0; lt < 4; ++lt) { const int l = 16 * lt + c16; float tot = 0.f;
#pragma unroll
            for (int w8 = 0; w8 < 8; ++w8) tot += ssqs[w8 * 64 + l];
            const float rstd = rsqrtf(tot * (1.0f / (HPG * HP)) + EPS);
#pragma unroll
            for (int pt = 0; pt < 4; ++pt) { const int ch = head * HP + 16 * pt + 4 * gq; const f32x4 gn = *(const GAS f32x4*)(gnorm + ch); const f32x4 o = acc[pt][lt] * rstd * gn;
                u32x2 w; w.x = pk2(o.x, o.y); w.y = pk2(o.z, o.w); *(GAS u32x2*)(Y + (size_t)(m0 + l) * DI + ch) = w; } }
        LDS_WAIT(); asm volatile("" ::: "memory");
    }
}

__device__ __forceinline__ float gelu_tanhf_(float x) { const float u = 0.7978845608028654f * (x + 0.044715f * x * x * x); return x * __builtin_amdgcn_rcpf(1.0f + __expf(-2.0f * u)); }
__device__ __forceinline__ void ph_ffn_act(const GAS bf16* U, const GAS float* cw, const GAS float* cb, GAS bf16* ACT, int gtid, int nthr) {
    constexpr int NCG = FF / 8, R = 8;
    for (int it = gtid; it < (M / R) * NCG; it += nthr) {
        const int c0 = (it % NCG) * 8, m0 = (it / NCG) * R, t0 = m0 & (SEQ - 1);
        f32x4 wg[3][2], wv[3][2];
#pragma unroll
        for (int i = 0; i < 3; ++i) { wg[i][0] = *(const GAS f32x4*)(cw + i * FF2 + c0); wg[i][1] = *(const GAS f32x4*)(cw + i * FF2 + c0 + 4); wv[i][0] = *(const GAS f32x4*)(cw + i * FF2 + FF + c0); wv[i][1] = *(const GAS f32x4*)(cw + i * FF2 + FF + c0 + 4); }
        const f32x4 bg0 = *(const GAS f32x4*)(cb + c0), bg1 = *(const GAS f32x4*)(cb + c0 + 4), bv0 = *(const GAS f32x4*)(cb + FF + c0), bv1 = *(const GAS f32x4*)(cb + FF + c0 + 4);
        u32x4 rg[R + 2], rv[R + 2];
#pragma unroll
        for (int i = 0; i < R + 2; ++i) { const bool ok = (t0 + i - 2) >= 0; const GAS bf16* ur = U + (size_t)(m0 + (ok ? i - 2 : 0)) * FF2 + c0;
            rg[i] = *(const GAS u32x4*)ur; rv[i] = *(const GAS u32x4*)(ur + FF); if (!ok) { rg[i] = (u32x4){0u, 0u, 0u, 0u}; rv[i] = (u32x4){0u, 0u, 0u, 0u}; } }
#pragma unroll
        for (int o = 0; o < R; ++o) { f32x4 g0 = bg0, g1 = bg1, v0 = bv0, v1 = bv1;
#pragma unroll
            for (int i = 0; i < 3; ++i) { float xg[8], xv[8]; unpack8(rg[o + i], xg); unpack8(rv[o + i], xv);
                g0 += wg[i][0] * (f32x4){xg[0], xg[1], xg[2], xg[3]}; g1 += wg[i][1] * (f32x4){xg[4], xg[5], xg[6], xg[7]};
                v0 += wv[i][0] * (f32x4){xv[0], xv[1], xv[2], xv[3]}; v1 += wv[i][1] * (f32x4){xv[4], xv[5], xv[6], xv[7]}; }
            float r[8] = {gelu_tanhf_(g0.x) * v0.x, gelu_tanhf_(g0.y) * v0.y, gelu_tanhf_(g0.z) * v0.z, gelu_tanhf_(g0.w) * v0.w, gelu_tanhf_(g1.x) * v1.x, gelu_tanhf_(g1.y) * v1.y, gelu_tanhf_(g1.z) * v1.z, gelu_tanhf_(g1.w) * v1.w};
            *(GAS u32x4*)(ACT + (size_t)(m0 + o) * FF + c0) = pack8(r); }
    }
}

struct Args { const float* in[20]; float* out; unsigned char* ws; int ph_lo, ph_hi; };
constexpr int NP = 11, NPHASE = 1 + DEPTH * NP;

#define AIN(i) ((const GAS float*)args.in[i])
__global__ void __launch_bounds__(NTHR, 2) fwd(Args args) {
    extern __shared__ __attribute__((aligned(16))) unsigned char lds[];
    const int G = gridDim.x, blk = blockIdx.x;
    volatile LAS unsigned* MISC = (volatile LAS unsigned*)((LAS unsigned char*)lds + MISC_OFF);
    for (int u = threadIdx.x; u < (LDS_BYTES - LDSCTL_OFF) / 4; u += NTHR) ((LAS unsigned*)((LAS unsigned char*)lds + LDSCTL_OFF))[u] = 0u;
    __syncthreads();
    XcdBarrier bar; bar.bar = (unsigned*)(args.ws + WS_CTL) + CW_BAR; bar.x = 0; bar.st = nullptr;
    if (!MK_PER_PHASE) bar = xcd_barrier_post((unsigned*)(args.ws + WS_CTL) + CW_BAR, MISC + 8);
    const int lo = args.ph_lo, hi = args.ph_hi;
#define IN(k) (lo <= (k) && (k) < hi)
#define SEAM(k) do { if (IN(k) && IN((k) + 1)) xcd_barrier(bar); } while (0)
#define PH_BEGIN \
    int tid = threadIdx.x; asm volatile("" : "+v"(tid)); \
    const int lane = tid & 63, wave = __builtin_amdgcn_readfirstlane(tid >> 6); \
    const int gw = blk * NWAVES + wave, ngw = G * NWAVES, gtid = blk * NTHR + tid, nthr = G * NTHR; \
    GAS unsigned char* ws = (GAS unsigned char*)args.ws; asm volatile("" : "+s"(ws)); \
    LAS unsigned char* ring = (LAS unsigned char*)lds; \
    (void)lane; (void)wave; (void)gw; (void)ngw; (void)gtid; (void)nthr; (void)ring; \
    GAS float* X = (GAS float*)args.out; \
    GAS bf16* H = (GAS bf16*)(ws + WS_H); GAS bf16* P = (GAS bf16*)(ws + WS_P); GAS float* SM = (GAS float*)(ws + WS_SM); GAS bf16* XC = (GAS bf16*)(ws + WS_XC); \
    GAS float* CD = (GAS float*)(ws + WS_DT); GAS bf16* STB = (GAS bf16*)(ws + WS_ST); GAS bf16* Y = (GAS bf16*)(ws + WS_Y); \
    GAS float* SC = (GAS float*)(ws + WS_SC); GAS unsigned long long* MASKW = (GAS unsigned long long*)(ws + WS_IDX); GAS bf16* AO = (GAS bf16*)(ws + WS_AO); \
    GAS float* MG = (GAS float*)(ws + WS_MG); GAS bf16* MGB = (GAS bf16*)(ws + WS_MGB); GAS bf16* YMB = (GAS bf16*)(ws + WS_YM); GAS bf16* XB = (GAS bf16*)(ws + WS_YM + 32 * MiB); GAS bf16* U = (GAS bf16*)(ws + WS_U); \
    GAS bf16* ACT = (GAS bf16*)(ws + WS_ACT); GAS bf16* KIB = (GAS bf16*)(ws + WS_KIB); \
    (void)X; (void)H; (void)P; (void)SM; (void)XC; (void)CD; (void)STB; (void)Y; (void)SC; (void)MASKW; (void)AO; (void)MG; (void)MGB; (void)YMB; (void)XB; (void)U; (void)ACT; (void)KIB;

    if (IN(0)) { PH_BEGIN
        WPtrs wp{AIN(5), AIN(13), AIN(14), AIN(15), AIN(16), AIN(19)};
        REP(5) ph_weights(wp, ws, ring + wave * 10240, gw, ngw, lane);
        ph_resid_norm<true, false, false>(nullptr, nullptr, AIN(1), AIN(0), nullptr, nullptr, XB, H, gw, ngw, lane);
    }
    SEAM(0);

#pragma unroll 1
    for (int layer = 0; layer < DEPTH; ++layer) {
        const int pb = 1 + layer * NP;
#define WL (ws + WS_W + (size_t)layer * WL_SIZE)
        if (IN(pb + 0)) { PH_BEGIN
            { pg8::Gemm g{H, (const GAS bf16*)(WL + WL_IN), M, NMAIN, D}; pg8::StaticOrder S; S.init(M, NMAIN, G, blk);
              pg8::EpiIn E{P, NMAIN, AIN(6) + (size_t)layer * 2 * D, PG / 256};
              REP(1) { pg8::gemm_phase<pg8::EpiIn, pg8::StaticOrder, true, true>(ring, g, S, E); __syncthreads(); } }
            REP(2) { ph_small_proj(H, (const GAS bf16*)(WL + WL_IN) + (size_t)NMAIN * D, SM, KIB, ring, blk, G, tid); __syncthreads(); }
        }
        SEAM(pb + 0);
        if (IN(pb + 1)) { PH_BEGIN
            REP(20) { ph_ssd_states(P, SM, AIN(7) + (size_t)layer * 4 * CONVD, AIN(8) + (size_t)layer * CONVD, AIN(9) + layer * NH, AIN(10) + layer * NH, XC, STB, CD, ring, blk, G, tid); __syncthreads(); }
            REP(21) { ph_index_scores(P, SM, KIB, SC, ring, blk, G, tid); __syncthreads(); } }
        SEAM(pb + 1);
        if (IN(pb + 2)) { PH_BEGIN
            ph_ssd_scan(STB, CD, gtid, nthr); REP(30) ph_topk(SC, MASKW, ring + wave * 9728, gw, ngw, lane); }
        SEAM(pb + 2);
        if (IN(pb + 3)) { PH_BEGIN
            REP(40) { ph_ssd_out(P, SM, XC, AIN(9) + layer * NH, AIN(10) + layer * NH, STB,
                                 AIN(11) + layer * NH, AIN(12) + (size_t)layer * DI, Y, ring, blk, G, tid); __syncthreads(); }
            REP(41) { ph_attn_dense<0>(P, MASKW, AO, ring, blk, G, tid); __syncthreads(); }
#if PROBE_DOUBLE >= 1000
            { ph_attn_dense<PROBE_DOUBLE - 1000>(P, MASKW, (GAS bf16*)U, ring, blk, G, tid); __syncthreads(); }
#endif
            }
        SEAM(pb + 3);
        if (IN(pb + 4)) {
            { PH_BEGIN
              pg8::Gemm g{Y, (const GAS bf16*)(WL + WL_SSM), M, D, DI}; pg8::StaticOrder S; S.init(M, D, G, blk);
              pg8::EpiGateMul E{MG, D, P + PG, NMAIN}; pg8::gemm_phase<pg8::EpiGateMul, pg8::StaticOrder, false, true>(ring, g, S, E); }
            __syncthreads();
            { PH_BEGIN
              pg8::Gemm g{AO, (const GAS bf16*)(WL + WL_ATT), M, D, D}; pg8::StaticOrder S; S.init(M, D, G, blk);
              pg8::EpiGateAdd E{MG, MGB, D, P + PG + D, NMAIN}; pg8::gemm_phase<pg8::EpiGateAdd, pg8::StaticOrder, false, true>(ring, g, S, E); }
        }
        SEAM(pb + 4);
        if (IN(pb + 5)) { PH_BEGIN
            pg8::Gemm g{MGB, (const GAS bf16*)(WL + WL_MIX), M, D, D}; pg8::StaticOrder S; S.init(M, D, G, blk);
            pg8::EpiBf16<0> E{YMB, D, nullptr, 0, 0, 1.f}; REP(60) { pg8::gemm_phase<pg8::EpiBf16<0>, pg8::StaticOrder, false, true>(ring, g, S, E); __syncthreads(); } }
        SEAM(pb + 5);
        if (IN(pb + 6)) { PH_BEGIN
            ph_resid_norm<false, true, false>(YMB, AIN(2) + (size_t)layer * D, AIN(3) + (size_t)layer * D, nullptr, XB, nullptr, XB, H, gw, ngw, lane); }
        SEAM(pb + 6);
        if (IN(pb + 7)) { PH_BEGIN
            pg8::Gemm g{H, (const GAS bf16*)(WL + WL_UP), M, FF2, D}; pg8::StaticOrder S; S.init(M, FF2, G, blk);
            pg8::EpiBf16<0> E{U, FF2, nullptr, 0, 0, 1.f}; REP(80) { pg8::gemm_phase<pg8::EpiBf16<0>, pg8::StaticOrder, true, true>(ring, g, S, E); __syncthreads(); } }
        SEAM(pb + 7);
        if (IN(pb + 8)) { PH_BEGIN
            REP(90) ph_ffn_act(U, AIN(17) + (size_t)layer * 3 * FF2, AIN(18) + (size_t)layer * FF2, ACT, gtid, nthr); }
        SEAM(pb + 8);
        if (IN(pb + 9)) { PH_BEGIN
            pg8::Gemm g{ACT, (const GAS bf16*)(WL + WL_DN), M, D, FF}; pg8::StaticOrder S; S.init(M, D, G, blk);
            pg8::EpiBf16<0> E{YMB, D, nullptr, 0, 0, 1.f}; REP(100) { pg8::gemm_phase<pg8::EpiBf16<0>, pg8::StaticOrder, false, true>(ring, g, S, E); __syncthreads(); } }
        SEAM(pb + 9);
        if (IN(pb + 10)) { PH_BEGIN
            if (layer + 1 < DEPTH) ph_resid_norm<false, true, false>(YMB, AIN(4) + (size_t)layer * D, AIN(1) + (size_t)(layer + 1) * D, nullptr, XB, nullptr, XB, H, gw, ngw, lane);
            else ph_resid_norm<false, true, true>(YMB, AIN(4) + (size_t)layer * D, nullptr, nullptr, XB, X, nullptr, H, gw, ngw, lane); }
        SEAM(pb + 10);
    }
#undef IN
#undef SEAM
#undef WL
#undef PH_BEGIN
}

extern "C" void kernel_launch(void* const* d_in, const int* in_sizes, int n_in, void* d_out, int out_size, void* d_ws, size_t ws_size, hipStream_t stream) {
    static int grid = 0;
    if (grid == 0) {
        if (n_in != 20 || in_sizes[0] != M * D || out_size != M * D || ws_size < WS_END) { fprintf(stderr, "kernel_launch: unexpected shapes (n_in %d, in0 %d, out %d, ws %zu < %zu)\n", n_in, n_in > 0 ? in_sizes[0] : -1, out_size, ws_size, (size_t)WS_END); grid = -1; return; }
        int dev = 0, cus = 0, per_cu = 0;
        if (hipGetDevice(&dev) != hipSuccess || hipDeviceGetAttribute(&cus, hipDeviceAttributeMultiprocessorCount, dev) != hipSuccess) { grid = -1; return; }
        if (hipFuncSetAttribute((const void*)fwd, hipFuncAttributeMaxDynamicSharedMemorySize, LDS_BYTES) != hipSuccess) { fprintf(stderr, "kernel_launch: hipFuncSetAttribute failed\n"); grid = -1; return; }
        if (hipOccupancyMaxActiveBlocksPerMultiprocessor(&per_cu, (const void*)fwd, NTHR, LDS_BYTES) != hipSuccess || per_cu < 1) fprintf(stderr, "kernel_launch: occupancy query reports %d blocks per CU\n", per_cu);
        (void)hipGetLastError();
        grid = cus;
    }
    if (grid < 0) return;
    if (hipMemsetAsync((char*)d_ws + WS_CTL, 0, CTL_ZERO_BYTES, stream) != hipSuccess) return;
    Args a{};
    for (int i = 0; i < 20; ++i) a.in[i] = (const float*)d_in[i];
    a.out = (float*)d_out; a.ws = (unsigned char*)d_ws;
#if MK_PER_PHASE
    for (int ph = 0; ph < NPHASE; ++ph) { a.ph_lo = ph; a.ph_hi = ph + 1; hipLaunchKernelGGL(fwd, dim3(grid), dim3(NTHR), LDS_BYTES, stream, a); }
#else
    a.ph_lo = 0; a.ph_hi = NPHASE; hipLaunchKernelGGL(fwd, dim3(grid), dim3(NTHR), LDS_BYTES, stream, a);
#endif
}
```

```cpp
#include <hip/hip_runtime.h>
#include <cstdio>
#include <cstdint>
#define MK_PER_PHASE 0
namespace pg8 {
#define PG8_LAS __attribute__((address_space(3)))
#define PG8_GAS __attribute__((address_space(1)))
typedef unsigned short bf16_t;
typedef short bf16x8 __attribute__((ext_vector_type(8)));
typedef float f32x4 __attribute__((ext_vector_type(4)));
typedef unsigned u32x4 __attribute__((ext_vector_type(4)));
constexpr int BM = 256, BK = 64, HALF = 128, HTB = HALF * BK * 2  , STAGE_BYTES = 8 * HTB, NXCD = 8, WGM = 8;

__host__ __device__ __forceinline__ int lds_byte(int r, int c) { const int st = (r >> 4) * 2 + (c >> 5), rr = r & 15, cc = c & 31, ob = rr * 64 + cc * 2; return st * 1024 + (ob ^ (((ob >> 9) & 1) << 5)); }
__host__ __device__ __forceinline__ void stage_rc(int b, int& R, int& C) { const int st = b / 1024, sb = b % 1024, swz = sb ^ (((sb >> 9) & 1) << 5); R = (st >> 1) * 16 + swz / 64; C = (st & 1) * 32 + (swz % 64) / 2; }
__host__ __device__ __forceinline__ int perm32(int rho) { const int n = rho >> 4, i = rho & 15; return 8 * (i >> 2) + 4 * n + (i & 3); }

struct Unit { int pm, pn; };
struct Gemm { const PG8_GAS bf16_t* A; const PG8_GAS bf16_t* Bt; int M, N, K; };

struct StaticOrder {
    int nM, nN, nwg, G, c;
    __host__ __device__ void init(int M, int N, int G_, int c_) { nM = M / BM; nN = N / BM; nwg = nM * nN; G = G_; c = c_; }
    __host__ __device__ bool next(int i, Unit& u) const {
        const long L = (long)i * G + c; if (L >= nwg) return false;
        int wgid = (int)L; { const int q = nwg / NXCD, r = nwg % NXCD, xcd = wgid % NXCD, off = wgid / NXCD; wgid = (xcd < r ? xcd * (q + 1) : r * (q + 1) + (xcd - r) * q) + off; }
        const int nig = WGM * nN, gid = wgid / nig, fm = gid * WGM, gsz = (nM - fm) < WGM ? (nM - fm) : WGM;
        u.pm = fm + ((wgid % nig) % gsz); u.pn = (wgid % nig) / gsz; return true;
    }
    __device__ __forceinline__ void a_ready(const Unit&) const {}
    __device__ __forceinline__ void done(const Unit&) const {}
};

__device__ __forceinline__ unsigned cvt_pk_bf16(float lo, float hi) { unsigned r; asm volatile("v_cvt_pk_bf16_f32 %0, %1, %2" : "=v"(r) : "v"(lo), "v"(hi)); return r; }
typedef float f32x2 __attribute__((ext_vector_type(2)));
__device__ __forceinline__ f32x2 gelu_pk(f32x2 v) {
    const f32x2 av = __builtin_elementwise_abs(v), d = av * 0.2316418882f + 1.0f;
    f32x2 t; t.x = __builtin_amdgcn_rcpf(d.x); t.y = __builtin_amdgcn_rcpf(d.y);
    f32x2 q = t * 0.5307027145f + (-0.7265760135f); q = q * t + 0.7107068705f; q = q * t + (-0.142248368f); q = q * t + 0.127414796f; q = q * t;
    const f32x2 s = (v * v) * (-0.72134752044f);
    f32x2 e; e.x = __builtin_amdgcn_exp2f(s.x); e.y = __builtin_amdgcn_exp2f(s.y);
    const f32x2 m = v * (q * e), r = v - m;
    f32x2 o; o.x = v.x < 0.f ? m.x : r.x; o.y = v.y < 0.f ? m.y : r.y; return o;
}

template <int ACT  > struct EpiBf16 {
    static constexpr bool PERM = true, AFTER_DRAIN = false; static_assert(ACT == 0 || ACT == 1, "EpiBf16: ACT is 0 (none) or 1 (gelu_pk)");
    PG8_GAS bf16_t* O; int ldc; const PG8_GAS float* bias; int split_cols; size_t split_stride; float scale0;
    __device__ __forceinline__ void operator()(const f32x4 (&acc)[2][2][4][2], const Unit& u, int wr, int wc, int fr, int fq) const {
        const int row0 = u.pm * BM + wr * 64 + fr; int colt = u.pn * BM; PG8_GAS bf16_t* base = O;
        float sc = 1.f; if (split_cols) { const int t = colt / split_cols; base += (size_t)t * split_stride; colt -= t * split_cols; if (t == 0) sc = scale0; }
        const int col0 = colt + wc * 32 + 8 * fq, bcol0 = u.pn * BM + wc * 32 + 8 * fq;
        f32x4 bv[2][2];
#pragma unroll
        for (int bj = 0; bj < 2; ++bj)
#pragma unroll
            for (int n = 0; n < 2; ++n) bv[bj][n] = bias ? *(const PG8_GAS f32x4*)(bias + bcol0 + bj * HALF + 4 * n) : (f32x4){0.f, 0.f, 0.f, 0.f};
#pragma unroll
        for (int ai = 0; ai < 2; ++ai)
#pragma unroll
            for (int m = 0; m < 4; ++m) { PG8_GAS bf16_t* rowp = base + (size_t)(row0 + ai * HALF + m * 16) * ldc + col0;
#pragma unroll
                for (int bj = 0; bj < 2; ++bj) { f32x4 v0 = acc[ai][bj][m][0] + bv[bj][0], v1 = acc[ai][bj][m][1] + bv[bj][1];
                    if (ACT == 1) { f32x2 a = gelu_pk((f32x2){v0[0], v0[1]}), b = gelu_pk((f32x2){v0[2], v0[3]}), c = gelu_pk((f32x2){v1[0], v1[1]}), d = gelu_pk((f32x2){v1[2], v1[3]});
                        v0 = (f32x4){a.x, a.y, b.x, b.y}; v1 = (f32x4){c.x, c.y, d.x, d.y}; }
                    v0 = v0 * sc; v1 = v1 * sc; u32x4 w; w.x = cvt_pk_bf16(v0[0], v0[1]); w.y = cvt_pk_bf16(v0[2], v0[3]); w.z = cvt_pk_bf16(v1[0], v1[1]); w.w = cvt_pk_bf16(v1[2], v1[3]);
                    *(PG8_GAS u32x4*)(rowp + bj * HALF) = w; } }
    }
};

struct EpiF32 {
    static constexpr bool PERM = false, AFTER_DRAIN = false;
    PG8_GAS float* C; int ldc;
    __device__ __forceinline__ void operator()(const f32x4 (&acc)[2][2][4][2], const Unit& u, int wr, int wc, int fr, int fq) const {
        const int row0 = u.pm * BM + wr * 64 + fr, col0 = u.pn * BM + wc * 32 + 4 * fq;
#pragma unroll
        for (int ai = 0; ai < 2; ++ai)
#pragma unroll
            for (int m = 0; m < 4; ++m) { PG8_GAS float* rowp = C + (size_t)(row0 + ai * HALF + m * 16) * ldc + col0;
#pragma unroll
                for (int bj = 0; bj < 2; ++bj)
#pragma unroll
                    for (int n = 0; n < 2; ++n) *(PG8_GAS f32x4*)(rowp + bj * HALF + n * 16) = acc[ai][bj][m][n]; }
    }
};
__device__ __forceinline__ float bf_lo(unsigned w) { return __uint_as_float(w << 16); }
__device__ __forceinline__ float bf_hi(unsigned w) { return __uint_as_float(w & 0xffff0000u); }
__device__ __forceinline__ float sigmoidf_(float x) { return __builtin_amdgcn_rcpf(1.0f + __expf(-x)); }
struct EpiIn {
    static constexpr bool PERM = true, AFTER_DRAIN = false;
    PG8_GAS bf16_t* P; int ldp; const PG8_GAS float* bgate; int gate_tile0;
    __device__ __forceinline__ void operator()(const f32x4 (&acc)[2][2][4][2], const Unit& u, int wr, int wc, int fr, int fq) const {
        const int row0 = u.pm * BM + wr * 64 + fr, colt = u.pn * BM + wc * 32 + 8 * fq;
        {
            const bool gate = u.pn >= gate_tile0;
            f32x4 bv[2][2];
#pragma unroll
            for (int bj = 0; bj < 2; ++bj)
#pragma unroll
                for (int n = 0; n < 2; ++n) bv[bj][n] = gate ? *(const PG8_GAS f32x4*)(bgate + (colt - gate_tile0 * BM) + bj * HALF + 4 * n) : (f32x4){0.f, 0.f, 0.f, 0.f};
#pragma unroll
            for (int ai = 0; ai < 2; ++ai)
#pragma unroll
                for (int m = 0; m < 4; ++m) { PG8_GAS bf16_t* rowp = P + (size_t)(row0 + ai * HALF + m * 16) * ldp + colt;
#pragma unroll
                    for (int bj = 0; bj < 2; ++bj) { f32x4 v0 = acc[ai][bj][m][0] + bv[bj][0], v1 = acc[ai][bj][m][1] + bv[bj][1];
                        if (gate) {
#pragma unroll
                            for (int j = 0; j < 4; ++j) { v0[j] = sigmoidf_(v0[j]); v1[j] = sigmoidf_(v1[j]); } }
                        u32x4 w; w.x = cvt_pk_bf16(v0[0], v0[1]); w.y = cvt_pk_bf16(v0[2], v0[3]); w.z = cvt_pk_bf16(v1[0], v1[1]); w.w = cvt_pk_bf16(v1[2], v1[3]);
                        *(PG8_GAS u32x4*)(rowp + bj * HALF) = w; } }
        }
    }
};
struct EpiGateMul {
    static constexpr bool PERM = true, AFTER_DRAIN = false;
    PG8_GAS bf16_t* O; int ldc; const PG8_GAS bf16_t* G; int ldg;
    __device__ __forceinline__ void operator()(const f32x4 (&acc)[2][2][4][2], const Unit& u, int wr, int wc, int fr, int fq) const {
        const int row0 = u.pm * BM + wr * 64 + fr, colt = u.pn * BM + wc * 32 + 8 * fq;
#pragma unroll
        for (int ai = 0; ai < 2; ++ai)
#pragma unroll
            for (int m = 0; m < 4; ++m) { const size_t row = (size_t)(row0 + ai * HALF + m * 16);
#pragma unroll
                for (int bj = 0; bj < 2; ++bj) { const u32x4 g = *(const PG8_GAS u32x4*)(G + row * ldg + colt + bj * HALF);
                    const f32x4 a0 = acc[ai][bj][m][0], a1 = acc[ai][bj][m][1];
                    u32x4 w; w.x = cvt_pk_bf16(a0[0] * bf_lo(g.x), a0[1] * bf_hi(g.x)); w.y = cvt_pk_bf16(a0[2] * bf_lo(g.y), a0[3] * bf_hi(g.y));
                    w.z = cvt_pk_bf16(a1[0] * bf_lo(g.z), a1[1] * bf_hi(g.z)); w.w = cvt_pk_bf16(a1[2] * bf_lo(g.w), a1[3] * bf_hi(g.w));
                    *(PG8_GAS u32x4*)(O + row * ldc + colt + bj * HALF) = w; } }
    }
};
struct EpiGateAdd {
    static constexpr bool PERM = true, AFTER_DRAIN = false;
    PG8_GAS bf16_t* O; int ldc; const PG8_GAS bf16_t* G; int ldg;
    __device__ __forceinline__ void operator()(const f32x4 (&acc)[2][2][4][2], const Unit& u, int wr, int wc, int fr, int fq) const {
        const int row0 = u.pm * BM + wr * 64 + fr, colt = u.pn * BM + wc * 32 + 8 * fq;
#pragma unroll
        for (int ai = 0; ai < 2; ++ai)
#pragma unroll
            for (int m = 0; m < 4; ++m) { const size_t row = (size_t)(row0 + ai * HALF + m * 16);
#pragma unroll
                for (int bj = 0; bj < 2; ++bj) { const u32x4 g = *(const PG8_GAS u32x4*)(G + row * ldg + colt + bj * HALF);
                    PG8_GAS u32x4* op = (PG8_GAS u32x4*)(O + row * ldc + colt + bj * HALF); const u32x4 p = *op;
                    const f32x4 a0 = acc[ai][bj][m][0], a1 = acc[ai][bj][m][1];
                    u32x4 w; w.x = cvt_pk_bf16(bf_lo(p.x) + a0[0] * bf_lo(g.x), bf_hi(p.x) + a0[1] * bf_hi(g.x)); w.y = cvt_pk_bf16(bf_lo(p.y) + a0[2] * bf_lo(g.y), bf_hi(p.y) + a0[3] * bf_hi(g.y));
                    w.z = cvt_pk_bf16(bf_lo(p.z) + a1[0] * bf_lo(g.z), bf_hi(p.z) + a1[1] * bf_hi(g.z)); w.w = cvt_pk_bf16(bf_lo(p.w) + a1[2] * bf_lo(g.w), bf_hi(p.w) + a1[3] * bf_hi(g.w));
                    *op = w; } }
    }
};
template <class Epi, class Sched, bool ALIGN_EPI = false, bool SP2 = false>
__device__ __forceinline__ void gemm_phase(PG8_LAS unsigned char* lds, const Gemm g, const Sched& S, const Epi& E) {
    int tid = threadIdx.x; asm volatile("" : "+v"(tid));
    const int wid = __builtin_amdgcn_readfirstlane(tid >> 6), lane = tid & 63, wr = wid >> 2, wc = wid & 3, fr = lane & 15, fq = lane >> 4;
    const int K = g.K, nt = K / BK;
    unsigned voffA[2], voffB[2];
#pragma unroll
    for (int i = 0; i < 2; ++i) { int R, C; stage_rc(tid * 16 + i * 8192, R, C); const int Rb = Epi::PERM ? ((R & ~31) + perm32(R & 31)) : R;
        voffA[i] = (unsigned)(R * K + C) * 2u; voffB[i] = (unsigned)(Rb * K + C) * 2u; }
    const size_t kstep = (size_t)(BK * 2);
    const size_t hstep = (size_t)HALF * K * 2;
    const size_t tstep = 2 * hstep;
    const unsigned ldsw = (unsigned)wid * 1024u;
    const int aoff = lds_byte(wr * 64 + fr, fq * 8), boff = lds_byte(wc * 32 + fr, fq * 8);
#define PG8_SA(b, h) (((b) * 2 + (h)) * HTB)
#define PG8_SB(b, h) ((4 + (b) * 2 + (h)) * HTB)
#define PG8_STAGE(bufoff, gbase, voff) do { _Pragma("unroll") for (int _i = 0; _i < 2; ++_i) \
        __builtin_amdgcn_global_load_lds((const PG8_GAS unsigned*)((const PG8_GAS char*)(gbase) + (voff)[_i]), (PG8_LAS unsigned*)(lds + (bufoff) + ldsw + _i * 8192), 16, 0, 0); } while (0)
#define PG8_LDA(dst, b, h) do { _Pragma("unroll") for (int m = 0; m < 4; ++m) _Pragma("unroll") for (int k = 0; k < 2; ++k) dst[m][k] = *(const PG8_LAS bf16x8*)(lds + PG8_SA(b, h) + aoff + m * 2048 + k * 1024); } while (0)
#define PG8_LDB(dst, b, h) do { _Pragma("unroll") for (int n = 0; n < 2; ++n) _Pragma("unroll") for (int k = 0; k < 2; ++k) dst[n][k] = *(const PG8_LAS bf16x8*)(lds + PG8_SB(b, h) + boff + n * 2048 + k * 1024); } while (0)
#define PG8_MMA(ai, bj, At, Bt) do { __builtin_amdgcn_s_setprio(1); _Pragma("unroll") for (int m = 0; m < 4; ++m) _Pragma("unroll") for (int n = 0; n < 2; ++n) _Pragma("unroll") for (int k = 0; k < 2; ++k) \
        acc[ai][bj][m][n] = __builtin_amdgcn_mfma_f32_16x16x32_bf16(Bt[n][k], At[m][k], acc[ai][bj][m][n], 0, 0, 0); __builtin_amdgcn_s_setprio(0); } while (0)
#define PG8_WAIT_V(n) asm volatile("s_waitcnt vmcnt(" #n ")" ::: "memory")
#define PG8_WAIT_L(n) asm volatile("s_waitcnt lgkmcnt(" #n ")" ::: "memory")
#define PG8_BAR __builtin_amdgcn_s_barrier()
#define PG8_SCHED __builtin_amdgcn_sched_barrier(0)
    Unit cur, nxt; int ui = 0;
    if (!S.next(0, cur)) return;
    f32x4 acc[2][2][4][2];
#pragma unroll
    for (int a = 0; a < 2; ++a)
#pragma unroll
        for (int b = 0; b < 2; ++b)
#pragma unroll
            for (int m = 0; m < 4; ++m)
#pragma unroll
                for (int n = 0; n < 2; ++n) acc[a][b][m][n] = (f32x4){0.f, 0.f, 0.f, 0.f};
    bf16x8 At[4][2], B0[2][2], B1[2][2];
    const PG8_GAS char* cA = (const PG8_GAS char*)g.A + (size_t)cur.pm * tstep; const PG8_GAS char* cB = (const PG8_GAS char*)g.Bt + (size_t)cur.pn * tstep;
    S.a_ready(cur);
    if constexpr (SP2) {
        PG8_STAGE(PG8_SB(0, 0), cB, voffB); PG8_STAGE(PG8_SB(0, 1), cB + hstep, voffB); PG8_STAGE(PG8_SA(0, 0), cA, voffA); PG8_STAGE(PG8_SA(0, 1), cA + hstep, voffA);
        if (wr == 1) PG8_BAR;
        PG8_WAIT_V(2); PG8_BAR;
        PG8_STAGE(PG8_SB(1, 0), cB + kstep, voffB); PG8_STAGE(PG8_SA(1, 0), cA + kstep, voffA); PG8_STAGE(PG8_SB(1, 1), cB + hstep + kstep, voffB);
        PG8_WAIT_V(6); PG8_BAR;
    } else {
        PG8_STAGE(PG8_SB(0, 0), cB, voffB); PG8_STAGE(PG8_SA(0, 0), cA, voffA); PG8_STAGE(PG8_SB(0, 1), cB + hstep, voffB); PG8_STAGE(PG8_SA(0, 1), cA + hstep, voffA);
        if (wr == 1) PG8_BAR;
        PG8_WAIT_V(4); PG8_BAR;
        PG8_STAGE(PG8_SB(1, 0), cB + kstep, voffB); PG8_STAGE(PG8_SA(1, 0), cA + kstep, voffA); PG8_STAGE(PG8_SB(1, 1), cB + hstep + kstep, voffB);
        PG8_WAIT_V(6); PG8_BAR;
    }
    for (;;) {
        const bool has_next = S.next(ui + 1, nxt);
        const PG8_GAS char* nA = has_next ? (const PG8_GAS char*)g.A + (size_t)nxt.pm * tstep : cA; const PG8_GAS char* nB = has_next ? (const PG8_GAS char*)g.Bt + (size_t)nxt.pn * tstep : cB;
        for (int t = 0; t < nt; t += 2) {
            const bool last = (t == nt - 2);
            const PG8_GAS char* a1 = cA + (size_t)(t + 1) * kstep;
            const PG8_GAS char* a2 = last ? nA : cA + (size_t)(t + 2) * kstep; const PG8_GAS char* b2 = last ? nB : cB + (size_t)(t + 2) * kstep;
            const PG8_GAS char* a3 = a2 + kstep; const PG8_GAS char* b3 = b2 + kstep;
            if (last && has_next) S.a_ready(nxt);
            if constexpr (SP2) {
            PG8_LDB(B0, 0, 0); PG8_LDB(B1, 0, 1); PG8_SCHED; PG8_LDA(At, 0, 0); PG8_STAGE(PG8_SA(1, 1), a1 + hstep, voffA);
            PG8_WAIT_V(8); PG8_WAIT_L(0); PG8_BAR; PG8_MMA(0, 0, At, B0); PG8_MMA(0, 1, At, B1); PG8_BAR; PG8_SCHED;
            PG8_LDA(At, 0, 1); PG8_STAGE(PG8_SB(0, 0), b2, voffB); PG8_STAGE(PG8_SB(0, 1), b2 + hstep, voffB); PG8_STAGE(PG8_SA(0, 0), a2, voffA);
            PG8_WAIT_V(8); PG8_WAIT_L(0); PG8_BAR; PG8_MMA(1, 0, At, B0); PG8_MMA(1, 1, At, B1); PG8_BAR; PG8_SCHED;
            PG8_LDB(B0, 1, 0); PG8_LDB(B1, 1, 1); PG8_SCHED; PG8_LDA(At, 1, 0); PG8_STAGE(PG8_SA(0, 1), a2 + hstep, voffA);
            PG8_WAIT_V(8); PG8_WAIT_L(0); PG8_BAR; PG8_MMA(0, 0, At, B0); PG8_MMA(0, 1, At, B1); PG8_BAR; PG8_SCHED;
            PG8_LDA(At, 1, 1); PG8_STAGE(PG8_SB(1, 0), b3, voffB); PG8_STAGE(PG8_SB(1, 1), b3 + hstep, voffB); PG8_STAGE(PG8_SA(1, 0), a3, voffA);
            PG8_WAIT_V(8); PG8_WAIT_L(0); PG8_BAR; PG8_MMA(1, 0, At, B0); PG8_MMA(1, 1, At, B1); PG8_BAR; PG8_SCHED;
            } else {
            PG8_LDB(B0, 0, 0); PG8_SCHED; PG8_LDA(At, 0, 0); PG8_STAGE(PG8_SA(1, 1), a1 + hstep, voffA);
            PG8_WAIT_L(8); PG8_BAR; PG8_WAIT_L(0); PG8_MMA(0, 0, At, B0); PG8_BAR; PG8_SCHED;
            PG8_LDB(B1, 0, 1); PG8_STAGE(PG8_SB(0, 0), b2, voffB);
            PG8_BAR; PG8_WAIT_L(0); PG8_MMA(0, 1, At, B1); PG8_BAR;
            PG8_LDA(At, 0, 1); PG8_STAGE(PG8_SA(0, 0), a2, voffA);
            PG8_BAR; PG8_WAIT_L(0); PG8_MMA(1, 0, At, B0); PG8_BAR; PG8_SCHED;
            PG8_STAGE(PG8_SB(0, 1), b2 + hstep, voffB);
            PG8_WAIT_V(6); PG8_BAR; PG8_MMA(1, 1, At, B1); PG8_BAR;
            PG8_LDB(B0, 1, 0); PG8_SCHED; PG8_LDA(At, 1, 0); PG8_STAGE(PG8_SA(0, 1), a2 + hstep, voffA);
            PG8_WAIT_L(8); PG8_BAR; PG8_WAIT_L(0); PG8_MMA(0, 0, At, B0); PG8_BAR; PG8_SCHED;
            PG8_LDB(B1, 1, 1); PG8_STAGE(PG8_SB(1, 0), b3, voffB);
            PG8_BAR; PG8_WAIT_L(0); PG8_MMA(0, 1, At, B1); PG8_BAR;
            PG8_LDA(At, 1, 1); PG8_STAGE(PG8_SA(1, 0), a3, voffA);
            PG8_BAR; PG8_WAIT_L(0); PG8_MMA(1, 0, At, B0); PG8_BAR; PG8_SCHED;
            PG8_STAGE(PG8_SB(1, 1), b3 + hstep, voffB);
            PG8_WAIT_V(6); PG8_BAR; PG8_MMA(1, 1, At, B1); PG8_BAR;
            }
        }
        if constexpr (ALIGN_EPI) { if (wr == 0) PG8_BAR; }
        if constexpr (!Epi::AFTER_DRAIN) { E(acc, cur, wr, wc, fr, fq); S.done(cur); }
        if (!has_next) break;
#pragma unroll
        for (int a = 0; a < 2; ++a)
#pragma unroll
            for (int b = 0; b < 2; ++b)
#pragma unroll
                for (int m = 0; m < 4; ++m)
#pragma unroll
                    for (int n = 0; n < 2; ++n) acc[a][b][m][n] = (f32x4){0.f, 0.f, 0.f, 0.f};
        cur = nxt; cA = nA; cB = nB; ++ui;
        if constexpr (ALIGN_EPI) { if (wr == 1) PG8_BAR; }
    }
    PG8_WAIT_V(0);
    if constexpr (!ALIGN_EPI) { if (wr == 0) PG8_BAR; }
    PG8_BAR;
    if constexpr (Epi::AFTER_DRAIN) { E.fused(acc, cur, wr, wc, fr, fq, lds, wid, lane); S.done(cur); }
#undef PG8_SA
#undef PG8_SB
#undef PG8_STAGE
#undef PG8_LDA
#undef PG8_LDB
#undef PG8_MMA
#undef PG8_WAIT_V
#undef PG8_WAIT_L
#undef PG8_BAR
#undef PG8_SCHED
}
}

#ifndef MK_PER_PHASE
#define MK_PER_PHASE 0
#endif
#ifndef PROBE_DOUBLE
#define PROBE_DOUBLE -1
#endif
#define REP(id) for (int rep_ = 0; rep_ < ((PROBE_DOUBLE == (id)) ? 2 : 1); ++rep_)
constexpr int NWAVES = 8, NTHR = 512;
constexpr int BATCH = 2, SEQ = 4096, M = BATCH * SEQ, D = 2048, DEPTH = 4;
constexpr int DI = 4096, NH = 64, HP = 64, NG = 8, HPG = 8, NS = 128, CONVD = 6144;
constexpr int QH = 16, KVH = 4, AD = 128, IH = 16, IDD = 64, TOPK = 256;
constexpr int FF = 4096, FF2 = 8192;
constexpr int NIN = 18576, NMAIN = 18432, NPAD = 18688;
constexpr int PZ = 0, PXBC = 4096, PQ = 10240, PK = 12288, PV = 12800, PQI = 13312, PG = 14336;
constexpr int SMW = 256, SM_DT = 0, SM_KI = 64, SM_WI = 128;
constexpr float EPS = 1e-6f;
constexpr float ATTN_SCALE = 0.08838834764831845f;

constexpr size_t MiB = 1u << 20;
constexpr size_t WS_CTL = 0, CTL_ZERO_BYTES = 1 * MiB;
constexpr size_t WS_W = 2 * MiB;
constexpr size_t WL_IN = 0, WL_SSM = 73 * MiB, WL_ATT = 89 * MiB, WL_MIX = 97 * MiB, WL_UP = 105 * MiB, WL_DN = 137 * MiB, WL_SIZE = 153 * MiB;
constexpr size_t WS_H = WS_W + DEPTH * WL_SIZE;
constexpr size_t WS_P = WS_H + 32 * MiB;
constexpr size_t WS_SM = WS_P + 288 * MiB;
constexpr size_t WS_XC = WS_SM + 8 * MiB;
constexpr size_t WS_DT = WS_XC + 96 * MiB;
constexpr size_t WS_ACS = WS_DT + 2 * MiB;
constexpr size_t WS_ST = WS_ACS + 2 * MiB;
constexpr size_t WS_Y = WS_ST + 256 * MiB;
constexpr size_t WS_SC = WS_Y + 64 * MiB;
constexpr size_t WS_IDX = WS_SC + 128 * MiB;
constexpr size_t WS_CNT = WS_IDX + 8 * MiB;
constexpr size_t WS_AO = WS_CNT + 1 * MiB;
constexpr size_t WS_MG = WS_AO + 32 * MiB;
constexpr size_t WS_MGB = WS_MG + 64 * MiB;
constexpr size_t WS_YM = WS_MGB + 32 * MiB;
constexpr size_t WS_U = WS_YM + 64 * MiB;
constexpr size_t WS_ACT = WS_U + 128 * MiB;
constexpr size_t WS_KIB = WS_ACT + 64 * MiB;
constexpr size_t WS_END = WS_KIB + 1 * MiB;
constexpr int CW_BAR = 4096;

constexpr int RING_BYTES = 139264, LDSCTL_OFF = RING_BYTES, MISC_OFF = LDSCTL_OFF + 320, LDS_BYTES = 147456;

#define LAS __attribute__((address_space(3)))
#define GAS __attribute__((address_space(1)))
typedef unsigned short bf16;
typedef float f32x4 __attribute__((ext_vector_type(4)));
typedef short bf16x8 __attribute__((ext_vector_type(8)));
typedef unsigned u32x4 __attribute__((ext_vector_type(4)));
typedef unsigned u32x2 __attribute__((ext_vector_type(2)));
#define LDS_WAIT() asm volatile("s_waitcnt lgkmcnt(0)" ::: "memory")

__device__ __forceinline__ unsigned f2bf(float f) { unsigned u = __builtin_bit_cast(unsigned, f); return (u + 0x7fffu + ((u >> 16) & 1u)) >> 16; }
__device__ __forceinline__ unsigned pk2(float lo, float hi) { return f2bf(lo) | (f2bf(hi) << 16); }
__device__ __forceinline__ unsigned cvtpk(float lo, float hi) { unsigned r; asm("v_cvt_pk_bf16_f32 %0, %1, %2" : "=v"(r) : "v"(lo), "v"(hi)); return r; }
__device__ __forceinline__ float bflo(unsigned w) { return __uint_as_float(w << 16); }
__device__ __forceinline__ float bfhi(unsigned w) { return __uint_as_float(w & 0xffff0000u); }
__device__ __forceinline__ void unpack8(const u32x4 w, float (&f)[8]) { f[0] = bflo(w.x); f[1] = bfhi(w.x); f[2] = bflo(w.y); f[3] = bfhi(w.y); f[4] = bflo(w.z); f[5] = bfhi(w.z); f[6] = bflo(w.w); f[7] = bfhi(w.w); }
__device__ __forceinline__ u32x4 pack8(const float (&f)[8]) { u32x4 w; w.x = pk2(f[0], f[1]); w.y = pk2(f[2], f[3]); w.z = pk2(f[4], f[5]); w.w = pk2(f[6], f[7]); return w; }
__device__ __forceinline__ float wave_sum(float v) {
#pragma unroll
    for (int o = 1; o < 64; o <<= 1) v += __shfl_xor(v, o);
    return v;
}
__device__ __forceinline__ float wave_max(float v) {
#pragma unroll
    for (int o = 1; o < 64; o <<= 1) v = fmaxf(v, __shfl_xor(v, o));
    return v;
}
__device__ __forceinline__ float siluf_(float x) { return x / (1.0f + __expf(-x)); }
typedef short s16x4 __attribute__((ext_vector_type(4)));
__device__ __forceinline__ s16x4 lds_tr4(const LAS unsigned char* p) { return __builtin_bit_cast(s16x4, __builtin_amdgcn_ds_read_tr16_b64_v4i16((LAS s16x4*)p)); }

#define XB_TMO      128
#define XB_XCNT(j)  (256  + 64 * (j))
#define XB_XSUB(j)  (1280 + 64 * (j))
#define XB_XGEN(j)  (2304 + 64 * (j))
#define XB_TOP      3328
#define XB_TOPGEN   3392
#define XCD_BAR_WORDS 3456
#define XB_SPIN_CAP (1u << 18)

__device__ __forceinline__ unsigned xb_ld(unsigned* p)              { return __hip_atomic_load(p, __ATOMIC_RELAXED, __HIP_MEMORY_SCOPE_AGENT); }
__device__ __forceinline__ unsigned xb_add(unsigned* p, unsigned v) { return __hip_atomic_fetch_add(p, v, __ATOMIC_RELAXED, __HIP_MEMORY_SCOPE_AGENT); }
__device__ __forceinline__ unsigned xb_xcc_id() { return (unsigned)__builtin_amdgcn_s_getreg((3 << 11) | 20) & 0xFu; }
#define XB_SPIN(cond, bar) do { unsigned _sp = 0; while (cond) { __builtin_amdgcn_s_sleep(1); \
    if ((++_sp & 255u) == 0u) { if (xb_ld(&(bar)[XB_TMO])) break; if (_sp > XB_SPIN_CAP) { atomicAdd(&(bar)[XB_TMO], 1u); break; } } } } while (0)

struct XcdBarrier {
    unsigned* bar; unsigned x;
    volatile LAS unsigned* st;
};

__device__ __forceinline__ XcdBarrier xcd_barrier_post(unsigned* bar, volatile LAS unsigned* st) {
    XcdBarrier b; b.bar = bar; b.x = xb_xcc_id(); b.st = st;
    if (threadIdx.x == 0) (void)xb_add(&bar[XB_XCNT(b.x)], 1u);
    return b;
}
__device__ __forceinline__ void xcd_barrier_complete(unsigned* bar, unsigned x, unsigned& nloc, unsigned& nx) {
    const unsigned G = gridDim.x * gridDim.y * gridDim.z;
    unsigned sum, cnt, mine, sp = 0u;
    for (;;) {
        sum = 0u; cnt = 0u; mine = 0u;
#pragma unroll
        for (unsigned j = 0; j < 16; ++j) { const unsigned c = xb_ld(&bar[XB_XCNT(j)]); sum += c; cnt += (c > 0u) ? 1u : 0u; mine = (j == x) ? c : mine; }
        if (sum == G) break;
        __builtin_amdgcn_s_sleep(1);
        if ((++sp & 255u) == 0u) { if (xb_ld(&bar[XB_TMO])) break; if (sp > XB_SPIN_CAP) { atomicAdd(&bar[XB_TMO], 1u); break; } }
    }
    nloc = mine > 0u ? mine : 1u; nx = cnt > 0u ? cnt : 1u;
}

__device__ __forceinline__ void xcd_barrier(const XcdBarrier& b) {
    asm volatile("s_waitcnt vmcnt(0)" ::: "memory");
    __syncthreads();
    if (threadIdx.x == 0) {
        unsigned* bar = b.bar;
        __builtin_amdgcn_s_waitcnt(0);
        unsigned nloc = b.st[0], nx = b.st[1];
        if (nloc == 0u) { xcd_barrier_complete(bar, b.x, nloc, nx); b.st[0] = nloc; b.st[1] = nx; }
        const unsigned old = xb_add(&bar[XB_XSUB(b.x)], 1u);
        const unsigned gen = old / nloc;
        if (old + 1u == (gen + 1u) * nloc) {
            __builtin_amdgcn_fence(__ATOMIC_RELEASE, "agent");
            asm volatile("s_waitcnt vmcnt(0)" ::: "memory");
            const unsigned og = xb_add(&bar[XB_TOP], 1u);
            const unsigned tg = og / nx;
            if (og + 1u == (tg + 1u) * nx) xb_add(&bar[XB_TOPGEN], 1u);
            else XB_SPIN(xb_ld(&bar[XB_TOPGEN]) == tg, bar);
            __builtin_amdgcn_fence(__ATOMIC_ACQUIRE, "agent");
            xb_add(&bar[XB_XGEN(b.x)], 1u);
            asm volatile("s_waitcnt vmcnt(0)" ::: "memory");
        } else {
            XB_SPIN(xb_ld(&bar[XB_XGEN(b.x)]) == gen, bar);
            __builtin_amdgcn_fence(__ATOMIC_ACQUIRE, "agent");
            asm volatile("s_waitcnt vmcnt(0)" ::: "memory");
        }
    }
    __syncthreads();
}


template <bool XF32IN, bool HASY, bool XF32OUT>
__device__ __forceinline__ void ph_resid_norm(const GAS bf16* Yb, const GAS float* gpost, const GAS float* gnext, const GAS float* Xf_in, const GAS bf16* Xb_in, GAS float* Xf_out, GAS bf16* Xb_out, GAS bf16* H,
                                              int gw, int ngw, int lane) {
    for (int m = gw; m < M; m += ngw) {
        float xv[4][8];
#pragma unroll
        for (int j = 0; j < 4; ++j) { const size_t e = (size_t)m * D + 8 * (lane + 64 * j);
            if (XF32IN) { const f32x4 a = *(const GAS f32x4*)(Xf_in + e), c = *(const GAS f32x4*)(Xf_in + e + 4); xv[j][0] = a.x; xv[j][1] = a.y; xv[j][2] = a.z; xv[j][3] = a.w; xv[j][4] = c.x; xv[j][5] = c.y; xv[j][6] = c.z; xv[j][7] = c.w; }
            else unpack8(*(const GAS u32x4*)(Xb_in + e), xv[j]); }
        if (HASY) {
            float yv[4][8]; float ss = 0.f;
#pragma unroll
            for (int j = 0; j < 4; ++j) { unpack8(*(const GAS u32x4*)(Yb + (size_t)m * D + 8 * (lane + 64 * j)), yv[j]);
#pragma unroll
                for (int i = 0; i < 8; ++i) ss += yv[j][i] * yv[j][i]; }
            const float rstd = rsqrtf(wave_sum(ss) * (1.0f / D) + EPS);
#pragma unroll
            for (int j = 0; j < 4; ++j) { const GAS float* gp = gpost + 8 * (lane + 64 * j); const f32x4 g0 = *(const GAS f32x4*)gp, g1 = *(const GAS f32x4*)(gp + 4);
                xv[j][0] += yv[j][0] * rstd * g0.x; xv[j][1] += yv[j][1] * rstd * g0.y; xv[j][2] += yv[j][2] * rstd * g0.z; xv[j][3] += yv[j][3] * rstd * g0.w;
                xv[j][4] += yv[j][4] * rstd * g1.x; xv[j][5] += yv[j][5] * rstd * g1.y; xv[j][6] += yv[j][6] * rstd * g1.z; xv[j][7] += yv[j][7] * rstd * g1.w; }
        }
#pragma unroll
        for (int j = 0; j < 4; ++j) { const size_t e = (size_t)m * D + 8 * (lane + 64 * j);
            if (XF32OUT) { *(GAS f32x4*)(Xf_out + e) = (f32x4){xv[j][0], xv[j][1], xv[j][2], xv[j][3]}; *(GAS f32x4*)(Xf_out + e + 4) = (f32x4){xv[j][4], xv[j][5], xv[j][6], xv[j][7]}; }
            else *(GAS u32x4*)(Xb_out + e) = pack8(xv[j]); }
        if (gnext) {
            float ss = 0.f;
#pragma unroll
            for (int j = 0; j < 4; ++j)
#pragma unroll
                for (int i = 0; i < 8; ++i) ss += xv[j][i] * xv[j][i];
            const float rstd = rsqrtf(wave_sum(ss) * (1.0f / D) + EPS);
#pragma unroll
            for (int j = 0; j < 4; ++j) { const GAS float* gp = gnext + 8 * (lane + 64 * j); const f32x4 g0 = *(const GAS f32x4*)gp, g1 = *(const GAS f32x4*)(gp + 4);
                float h[8] = {xv[j][0] * rstd * g0.x, xv[j][1] * rstd * g0.y, xv[j][2] * rstd * g0.z, xv[j][3] * rstd * g0.w, xv[j][4] * rstd * g1.x, xv[j][5] * rstd * g1.y, xv[j][6] * rstd * g1.z, xv[j][7] * rstd * g1.w};
                *(GAS u32x4*)(H + (size_t)m * D + 8 * (lane + 64 * j)) = pack8(h); }
        }
    }
}

__device__ __forceinline__ void tr_item(const GAS float* W, int ldw, int K, int k0, int nsrc, int ncols, GAS bf16* WT, int ndst, LAS unsigned char* tile, int lane) {
    const int c4 = (lane & 15) * 4, kr = lane >> 4;
    f32x4 v[16];
#pragma unroll
    for (int i = 0; i < 16; ++i) v[i] = (c4 < ncols) ? *(const GAS f32x4*)(W + (size_t)(k0 + 4 * i + kr) * ldw + nsrc + c4) : (f32x4){0.f, 0.f, 0.f, 0.f};
#pragma unroll
    for (int i = 0; i < 16; ++i) { u32x2 w; w.x = cvtpk(v[i].x, v[i].y); w.y = cvtpk(v[i].z, v[i].w); *(LAS u32x2*)(tile + (4 * i + kr) * 160 + (lane & 15) * 8) = w; }
    LDS_WAIT();
    const int g = lane >> 4, c16 = lane & 15;
    const LAS unsigned char* tb = tile + (8 * g + (c16 >> 2)) * 160 + (c16 & 3) * 8;
#pragma unroll
    for (int nt = 0; nt < 4; ++nt)
#pragma unroll
        for (int kh = 0; kh < 2; ++kh) {
            const s16x4 lo = lds_tr4(tb + (32 * kh) * 160 + nt * 32), hi = lds_tr4(tb + (32 * kh + 4) * 160 + nt * 32);
            *(GAS bf16x8*)(WT + (size_t)(ndst + 16 * nt + c16) * K + k0 + 32 * kh + 8 * g) = __builtin_shufflevector(lo, hi, 0, 1, 2, 3, 4, 5, 6, 7); }
    LDS_WAIT();
}
__device__ __forceinline__ void win_map(int dstrow, int& src, int& ncols) {
    ncols = 64;
    if (dstrow < 10240) src = dstrow;
    else if (dstrow < 12288) src = dstrow - 10240 + 10304;
    else if (dstrow < 12800) src = dstrow - 12288 + 12352;
    else if (dstrow < 13312) src = dstrow - 12800 + 12864;
    else if (dstrow < 14336) src = dstrow - 13312 + 13376;
    else if (dstrow < 18432) src = dstrow - 14336 + 14480;
    else if (dstrow < 18496) src = dstrow - 18432 + 10240;
    else if (dstrow < 18560) src = dstrow - 18496 + 14400;
    else if (dstrow == 18560) { src = 14464; ncols = 16; }
    else { src = 0; ncols = 0; }
}
struct WPtrs { const GAS float *w_in, *w_ssm, *w_att, *w_mix, *w_up, *w_dn; };
__device__ __forceinline__ void ph_weights(const WPtrs wp, GAS unsigned char* ws, LAS unsigned char* tile, int gw, int ngw, int lane) {
    constexpr int I_IN = (NPAD / 64) * (D / 64), I_SSM = (D / 64) * (DI / 64), I_ATT = (D / 64) * (D / 64), I_MIX = I_ATT, I_UP = (FF2 / 64) * (D / 64), I_DN = (D / 64) * (FF / 64);
    constexpr int I_L = I_IN + I_SSM + I_ATT + I_MIX + I_UP + I_DN;
    for (int it = gw; it < DEPTH * I_L; it += ngw) {
        const int layer = it / I_L; int r = it % I_L;
        GAS unsigned char* wl = ws + WS_W + (size_t)layer * WL_SIZE;
        if (r < I_IN) { const int nblk = NPAD / 64, kb = r / nblk, nb = r % nblk; int src, nc; win_map(nb * 64, src, nc);
            tr_item(wp.w_in + (size_t)layer * D * NIN, NIN, D, kb * 64, src, nc, (GAS bf16*)(wl + WL_IN), nb * 64, tile, lane); continue; }
        r -= I_IN;
        if (r < I_SSM) { const int nblk = D / 64, kb = r / nblk, nb = r % nblk; tr_item(wp.w_ssm + (size_t)layer * DI * D, D, DI, kb * 64, nb * 64, 64, (GAS bf16*)(wl + WL_SSM), nb * 64, tile, lane); continue; }
        r -= I_SSM;
        if (r < I_ATT) { const int nblk = D / 64, kb = r / nblk, nb = r % nblk; tr_item(wp.w_att + (size_t)layer * D * D, D, D, kb * 64, nb * 64, 64, (GAS bf16*)(wl + WL_ATT), nb * 64, tile, lane); continue; }
        r -= I_ATT;
        if (r < I_MIX) { const int nblk = D / 64, kb = r / nblk, nb = r % nblk; tr_item(wp.w_mix + (size_t)layer * D * D, D, D, kb * 64, nb * 64, 64, (GAS bf16*)(wl + WL_MIX), nb * 64, tile, lane); continue; }
        r -= I_MIX;
        if (r < I_UP) { const int nblk = FF2 / 64, kb = r / nblk, nb = r % nblk; tr_item(wp.w_up + (size_t)layer * D * FF2, FF2, D, kb * 64, nb * 64, 64, (GAS bf16*)(wl + WL_UP), nb * 64, tile, lane); continue; }
        r -= I_UP;
        { const int nblk = D / 64, kb = r / nblk, nb = r % nblk; tr_item(wp.w_dn + (size_t)layer * FF * D, D, FF, kb * 64, nb * 64, 64, (GAS bf16*)(wl + WL_DN), nb * 64, tile, lane); }
    }
}

__device__ __forceinline__ void ph_small_proj(const GAS bf16* H, const GAS bf16* Ws, GAS float* SM, GAS bf16* KIB, LAS unsigned char* lds, int blk, int nblk, int tid) {
    constexpr int HS = 4112;
    const int lane = tid & 63, wave = __builtin_amdgcn_readfirstlane(tid >> 6), g = lane >> 4, c16 = lane & 15;
    for (int rb = blk; rb < M / 32; rb += nblk) {
        __syncthreads();
#pragma unroll
        for (int i = 0; i < 16; ++i) { const int id = tid + 512 * i, r = id >> 8, ch = id & 255;
            *(LAS u32x4*)(lds + r * HS + ch * 16) = *(const GAS u32x4*)(H + (size_t)(rb * 32 + r) * D + ch * 8); }
        __syncthreads();
        f32x4 acc[2] = {(f32x4){0.f, 0.f, 0.f, 0.f}, (f32x4){0.f, 0.f, 0.f, 0.f}}, acc9[2] = {(f32x4){0.f, 0.f, 0.f, 0.f}, (f32x4){0.f, 0.f, 0.f, 0.f}};
        const GAS bf16* wrow = Ws + (size_t)(16 * wave + c16) * D + 8 * g;
        const GAS bf16* w9 = Ws + (size_t)(128 + c16) * D + 256 * wave + 8 * g;
        const LAS unsigned char* hb = lds + c16 * HS + g * 16;
#pragma unroll 8
        for (int ks = 0; ks < 64; ++ks) {
            const bf16x8 wf = *(const GAS bf16x8*)(wrow + 32 * ks);
            const bf16x8 h0 = *(const LAS bf16x8*)(hb + ks * 64), h1 = *(const LAS bf16x8*)(hb + 16 * HS + ks * 64);
            acc[0] = __builtin_amdgcn_mfma_f32_16x16x32_bf16(wf, h0, acc[0], 0, 0, 0); acc[1] = __builtin_amdgcn_mfma_f32_16x16x32_bf16(wf, h1, acc[1], 0, 0, 0);
        }
#pragma unroll
        for (int k8 = 0; k8 < 8; ++k8) { const int ks = 8 * wave + k8;
            const bf16x8 wf = *(const GAS bf16x8*)(w9 + 32 * k8);
            const bf16x8 h0 = *(const LAS bf16x8*)(hb + ks * 64), h1 = *(const LAS bf16x8*)(hb + 16 * HS + ks * 64);
            acc9[0] = __builtin_amdgcn_mfma_f32_16x16x32_bf16(wf, h0, acc9[0], 0, 0, 0); acc9[1] = __builtin_amdgcn_mfma_f32_16x16x32_bf16(wf, h1, acc9[1], 0, 0, 0);
        }
#pragma unroll
        for (int rt = 0; rt < 2; ++rt) { const size_t row = (size_t)(rb * 32 + 16 * rt + c16);
            *(GAS f32x4*)(SM + row * SMW + 16 * wave + 4 * g) = acc[rt];
            if (wave >= 4) { u32x2 w; w.x = cvtpk(acc[rt].x, acc[rt].y); w.y = cvtpk(acc[rt].z, acc[rt].w); *(GAS u32x2*)(KIB + row * IDD + 16 * (wave - 4) + 4 * g) = w; } }
        __syncthreads();
        *(LAS f32x4*)(lds + ((wave * 2 + 0) * 64 + lane) * 16) = acc9[0]; *(LAS f32x4*)(lds + ((wave * 2 + 1) * 64 + lane) * 16) = acc9[1];
        __syncthreads();
        if (wave < 2) { f32x4 s = (f32x4){0.f, 0.f, 0.f, 0.f};
#pragma unroll
            for (int w8 = 0; w8 < 8; ++w8) s += *(const LAS f32x4*)(lds + ((w8 * 2 + wave) * 64 + lane) * 16);
            *(GAS f32x4*)(SM + (size_t)(rb * 32 + 16 * wave + c16) * SMW + 128 + 4 * g) = s; }
    }
}

__device__ __forceinline__ void ph_index_scores(const GAS bf16* P, const GAS float* SM, const GAS bf16* KIB, GAS float* SC, LAS unsigned char* lds, int blk, int nblk, int tid) {
    constexpr int QS = 1040;
    const int lane = tid & 63, wave = __builtin_amdgcn_readfirstlane(tid >> 6);
    for (int u0 = blk; u0 < 256; u0 += nblk) {
#pragma unroll 1
        for (int half = 0; half < 2; ++half) {
            const int b = half, qt = half ? 255 - u0 : u0;
            const int q0 = b * SEQ + qt * 16, nkt = ((qt * 16) / 64 + 1) * 4;
            const int qrow = q0 + (lane & 15), kq = 8 * (lane >> 4);
            __syncthreads();
#pragma unroll
            for (int i = 0; i < 2; ++i) { const int id = tid + 512 * i, q = id >> 6, ch = id & 63;
                *(LAS u32x4*)(lds + q * QS + ch * 16) = *(const GAS u32x4*)(P + (size_t)(q0 + q) * NMAIN + PQI + 8 * IDD + ch * 8); }
            bf16x8 bq[8][2]; float w[IH];
#pragma unroll
            for (int h = 0; h < IH; ++h) {
                if (h < 8) {
#pragma unroll
                    for (int ks = 0; ks < 2; ++ks) bq[h][ks] = *(const GAS bf16x8*)(P + (size_t)qrow * NMAIN + PQI + h * IDD + ks * 32 + kq); }
                w[h] = SM[(size_t)qrow * SMW + SM_WI + h]; }
            __syncthreads();
            const LAS unsigned char* qb = lds + (lane & 15) * QS + kq * 2;
            for (int kt = wave; kt < nkt; kt += NWAVES) {
                const int key0 = kt * 16; const GAS bf16* kp = KIB + (size_t)(b * SEQ + key0 + (lane & 15)) * IDD + kq;
                const bf16x8 a0 = *(const GAS bf16x8*)kp, a1 = *(const GAS bf16x8*)(kp + 32);
                f32x4 sc = (f32x4){0.f, 0.f, 0.f, 0.f};
#pragma unroll
                for (int h = 0; h < IH; ++h) { f32x4 c = (f32x4){0.f, 0.f, 0.f, 0.f};
                    const bf16x8 b0 = h < 8 ? bq[h & 7][0] : *(const LAS bf16x8*)(qb + (h - 8) * 128), b1 = h < 8 ? bq[h & 7][1] : *(const LAS bf16x8*)(qb + (h - 8) * 128 + 64);
                    c = __builtin_amdgcn_mfma_f32_16x16x32_bf16(a0, b0, c, 0, 0, 0); c = __builtin_amdgcn_mfma_f32_16x16x32_bf16(a1, b1, c, 0, 0, 0);
                    sc.x += w[h] * fmaxf(c.x, 0.f); sc.y += w[h] * fmaxf(c.y, 0.f); sc.z += w[h] * fmaxf(c.z, 0.f); sc.w += w[h] * fmaxf(c.w, 0.f); }
                *(GAS f32x4*)(SC + (size_t)qrow * SEQ + key0 + 4 * (lane >> 4)) = sc;
            }
        }
    }
}

__device__ __forceinline__ void topk_bitwise(const GAS float* srow, GAS unsigned long long* mw, int limit, int lane) {
    unsigned u[64];
#pragma unroll
    for (int j = 0; j < 64; ++j) { const int key = j * 64 + lane; unsigned v = 0u;
        if (key < limit) { const unsigned bits = __float_as_uint(srow[key]); v = (bits & 0x80000000u) ? ~bits : (bits | 0x80000000u); }
        u[j] = v; }
    unsigned T = 0u;
#pragma unroll 1
    for (int bit = 31; bit >= 0; --bit) { const unsigned cand = T | (1u << bit); int cnt = 0;
#pragma unroll
        for (int j = 0; j < 64; ++j) cnt += __popcll(__ballot(u[j] >= cand));
        if (cnt >= TOPK) T = cand; }
    int cgt = 0;
#pragma unroll
    for (int j = 0; j < 64; ++j) cgt += __popcll(__ballot(u[j] > T));
    const int need_eq = TOPK - cgt; int eqbase = 0;
    const unsigned long long lt_mask = (1ull << lane) - 1ull;
#pragma unroll
    for (int j = 0; j < 64; ++j) {
        const bool gt = u[j] > T, eq = u[j] == T;
        const unsigned long long eqm = __ballot(eq);
        const bool take = gt || (eq && (eqbase + __popcll(eqm & lt_mask) < need_eq));
        const unsigned long long tm = __ballot(take);
        if (lane == 0 && j * 64 < limit) mw[j] = tm;
        eqbase += __popcll(eqm);
    }
}
__device__ __forceinline__ void ph_topk(const GAS float* SC, GAS unsigned long long* MASKW, LAS unsigned char* wl, int gw, int ngw, int lane) {
    constexpr int CAP = 1024;
    LAS unsigned* hist = (LAS unsigned*)wl;
    LAS unsigned* maskc = (LAS unsigned*)(wl + 1024);
    LAS float* cval = (LAS float*)(wl + 1536);
    LAS unsigned* ckey = (LAS unsigned*)(wl + 1536 + 4 * CAP);
    const unsigned long long lt_mask = (1ull << lane) - 1ull;
    for (int m = gw; m < M; m += ngw) {
        const int t = m & (SEQ - 1), limit = (t / 64 + 1) * 64, nw = limit / 64;
        GAS unsigned long long* mw = MASKW + (size_t)m * 64;
        if (limit <= TOPK) { unsigned ones = 0xffffffffu; asm volatile("" : "+v"(ones)); if (lane < nw) mw[lane] = ((unsigned long long)ones << 32) | ones; continue; }
        const GAS float* srow = SC + (size_t)m * SEQ;
        float s[64]; float smax = -__builtin_inff(), smin = __builtin_inff();
#pragma unroll
        for (int j = 0; j < 64; ++j) { s[j] = (j < nw) ? srow[j * 64 + lane] : 0.f; if (j < nw) { smax = fmaxf(smax, s[j]); smin = fminf(smin, s[j]); } }
        smax = wave_max(smax); smin = -wave_max(-smin);
        const float scale = smax > smin ? 255.0f / (smax - smin) : 0.f;
        asm volatile("" ::: "memory");
        hist[lane] = 0u; hist[lane + 64] = 0u; hist[lane + 128] = 0u; hist[lane + 192] = 0u; maskc[lane] = 0u; maskc[lane + 64] = 0u;
        LDS_WAIT();
#pragma unroll
        for (int j = 0; j < 64; ++j) if (j < nw) { const int b = min(255, (int)((s[j] - smin) * scale)); __hip_atomic_fetch_add(&hist[b], 1u, __ATOMIC_RELAXED, __HIP_MEMORY_SCOPE_WORKGROUP); }
        LDS_WAIT();
        const unsigned c0 = hist[4 * lane], c1 = hist[4 * lane + 1], c2 = hist[4 * lane + 2], c3 = hist[4 * lane + 3];
        unsigned suf = c0 + c1 + c2 + c3;
#pragma unroll
        for (int o = 1; o < 64; o <<= 1) { const unsigned v = __shfl_down(suf, o); if (lane + o < 64) suf += v; }
        const unsigned above = suf - (c0 + c1 + c2 + c3);
        int bstar = -1; unsigned cab = 0u;
        { unsigned cum = above;
          if (cum < TOPK && cum + c3 >= TOPK) { bstar = 4 * lane + 3; cab = cum; } cum += c3;
          if (bstar < 0 && cum < TOPK && cum + c2 >= TOPK) { bstar = 4 * lane + 2; cab = cum; } cum += c2;
          if (bstar < 0 && cum < TOPK && cum + c1 >= TOPK) { bstar = 4 * lane + 1; cab = cum; } cum += c1;
          if (bstar < 0 && cum < TOPK && cum + c0 >= TOPK) { bstar = 4 * lane + 0; cab = cum; } }
        const unsigned long long who = __ballot(bstar >= 0);
        const int src = __builtin_ctzll(who);
        bstar = __shfl(bstar, src); cab = __shfl(cab, src);
        const int need = TOPK - (int)cab;
        const unsigned ncand = hist[bstar];
        if (ncand > (unsigned)CAP) { topk_bitwise(srow, mw, limit, lane); continue; }
        unsigned long long myword = 0ull; int base = 0;
#pragma unroll
        for (int j = 0; j < 64; ++j) if (j < nw) {
            const int b = min(255, (int)((s[j] - smin) * scale));
            const unsigned long long gm = __ballot(b > bstar), em = __ballot(b == bstar);
            if (lane == j) myword = gm;
            if (b == bstar) { const int pos = base + __popcll(em & lt_mask); cval[pos] = s[j]; ckey[pos] = (unsigned)(j * 64 + lane); }
            base += __popcll(em);
        }
        LDS_WAIT();
        for (int i = lane; i < base; i += 64) { const float vi = cval[i]; const unsigned ki = ckey[i]; int rank = 0;
            if (need < base) { for (int q = 0; q < base; ++q) { const float vq = cval[q]; const unsigned kq = ckey[q]; rank += (vq > vi || (vq == vi && kq < ki)) ? 1 : 0; } }
            if (rank < need) __hip_atomic_fetch_or(&maskc[ki >> 5], 1u << (ki & 31), __ATOMIC_RELAXED, __HIP_MEMORY_SCOPE_WORKGROUP); }
        LDS_WAIT();
        if (lane < nw) { const unsigned long long cw_ = ((unsigned long long)maskc[2 * lane + 1] << 32) | maskc[2 * lane]; mw[lane] = myword | cw_; }
        LDS_WAIT(); asm volatile("" ::: "memory");
    }
}

__device__ __forceinline__ float xmax16(float x) { auto r = __builtin_amdgcn_permlane16_swap(__float_as_uint(x), __float_as_uint(x), false, false); return fmaxf(__uint_as_float(r[0]), __uint_as_float(r[1])); }
__device__ __forceinline__ float xmax32(float x) { auto r = __builtin_amdgcn_permlane32_swap(__float_as_uint(x), __float_as_uint(x), false, false); return fmaxf(__uint_as_float(r[0]), __uint_as_float(r[1])); }
__device__ __forceinline__ float xsum16(float x) { auto r = __builtin_amdgcn_permlane16_swap(__float_as_uint(x), __float_as_uint(x), false, false); return __uint_as_float(r[0]) + __uint_as_float(r[1]); }
__device__ __forceinline__ float xsum32(float x) { auto r = __builtin_amdgcn_permlane32_swap(__float_as_uint(x), __float_as_uint(x), false, false); return __uint_as_float(r[0]) + __uint_as_float(r[1]); }
template <int VAR> __device__ __forceinline__ void ph_attn_dense(const GAS bf16* P, const GAS unsigned long long* MASKW, GAS bf16* AO, LAS unsigned char* lds, int blk, int nblk, int tid) {
    constexpr int KS = 272, VS = 288, KBUF = 64 * KS, VBUF = 64 * VS, VOFF = 2 * KBUF, MOFF = VOFF + 2 * VBUF;
    const int lane = tid & 63, wave = __builtin_amdgcn_readfirstlane(tid >> 6), g = lane >> 4, c16 = lane & 15;
    const int hq = wave >> 1, qh = (wave & 1) * 32;
    const float SCL = ATTN_SCALE * 1.4426950408889634f;
    for (int u0 = blk; u0 < 256; u0 += nblk) {
#pragma unroll 1
        for (int half = 0; half < 2; ++half) {
            const int b = (u0 >> 2) & 1, kvh = u0 & 3, cc = u0 >> 3, c = half ? 63 - cc : cc, nt = c + 1;
            const int m0 = b * SEQ + c * 64;
            bf16x8 qf[2][4];
#pragma unroll
            for (int qt = 0; qt < 2; ++qt)
#pragma unroll
                for (int kd = 0; kd < 4; ++kd) qf[qt][kd] = *(const GAS bf16x8*)(P + (size_t)(m0 + qh + 16 * qt + c16) * NMAIN + PQ + (kvh * 4 + hq) * AD + 32 * kd + 8 * g);
            f32x4 O[2][8];
#pragma unroll
            for (int qt = 0; qt < 2; ++qt)
#pragma unroll
                for (int dt = 0; dt < 8; ++dt) O[qt][dt] = (f32x4){0.f, 0.f, 0.f, 0.f};
            float mrun[2] = {-1e30f, -1e30f}, lrun[2] = {0.f, 0.f};
            const GAS bf16* kvbase = P + (size_t)(b * SEQ) * NMAIN + kvh * AD;
            u32x4 kreg[2], vreg[2];
#define ATT_LOAD(t) do { _Pragma("unroll") for (int i = 0; i < 2; ++i) { const int id = tid + 512 * i; const GAS bf16* src = kvbase + (size_t)((t) * 64 + (id >> 4)) * NMAIN + (id & 15) * 8; \
                kreg[i] = *(const GAS u32x4*)(src + PK); vreg[i] = *(const GAS u32x4*)(src + PV); } } while (0)
#define ATT_STORE(buf) do { _Pragma("unroll") for (int i = 0; i < 2; ++i) { const int id = tid + 512 * i; \
                *(LAS u32x4*)(lds + (buf) * KBUF + (id >> 4) * KS + (id & 15) * 16) = kreg[i]; *(LAS u32x4*)(lds + VOFF + (buf) * VBUF + (id >> 4) * VS + (id & 15) * 16) = vreg[i]; } } while (0)
            __syncthreads();
            ATT_LOAD(0); ATT_STORE(0);
#pragma unroll
            for (int i = 0; i < 4; ++i) { const int id = tid + 512 * i; *(LAS u32x4*)(lds + MOFF + id * 16) = *(const GAS u32x4*)((const GAS unsigned char*)(MASKW + (size_t)m0 * 64) + id * 16); }
            const LAS unsigned long long* mrow0 = (const LAS unsigned long long*)(lds + MOFF) + (qh + c16) * 64; const LAS unsigned long long* mrow1 = mrow0 + 16 * 64;
            __syncthreads();
            for (int t = 0; t < nt; ++t) {
                const int buf = (VAR & 1) ? 0 : (t & 1);
                if (!(VAR & 1) && t + 1 < nt) ATT_LOAD(t + 1);
                const LAS unsigned char* kb = lds + buf * KBUF + c16 * KS + g * 16;
                const LAS unsigned char* vb = lds + VOFF + buf * VBUF + (4 * g + (c16 >> 2)) * VS + (c16 & 3) * 8;
                f32x4 S[2][4];
                bf16x8 kf[2][4];
#pragma unroll
                for (int kd = 0; kd < 4; ++kd) kf[0][kd] = *(const LAS bf16x8*)(kb + kd * 64);
#pragma unroll
                for (int kt = 0; kt < 4; ++kt) {
                    if (kt < 3) {
#pragma unroll
                        for (int kd = 0; kd < 4; ++kd) kf[(kt + 1) & 1][kd] = *(const LAS bf16x8*)(kb + (kt + 1) * 16 * KS + kd * 64); }
#pragma unroll
                    for (int qt = 0; qt < 2; ++qt) { f32x4 s = (f32x4){0.f, 0.f, 0.f, 0.f};
#pragma unroll
                        for (int kd = 0; kd < 4; ++kd) { if (!(VAR & 8)) s = __builtin_amdgcn_mfma_f32_16x16x32_bf16(kf[kt & 1][kd], qf[qt][kd], s, 0, 0, 0); else s += __builtin_bit_cast(f32x4, kf[kt & 1][kd]); }
                        S[qt][kt] = s; }
                }
                s16x4 vlo[8][2], vhi[8][2];
#pragma unroll
                for (int dt = 0; dt < 4; ++dt)
#pragma unroll
                    for (int ks = 0; ks < 2; ++ks) { vlo[dt][ks] = lds_tr4(vb + (32 * ks) * VS + dt * 32); vhi[dt][ks] = lds_tr4(vb + (32 * ks + 16) * VS + dt * 32); }
                bf16x8 pf[2][2];
#pragma unroll
                for (int qt = 0; qt < 2; ++qt) {
                    const unsigned long long mw = (qt ? mrow1[t] : mrow0[t]) >> (4 * g);
                    const int mlo = (int)(unsigned)mw, mhi = (int)(unsigned)(mw >> 32);
                    float mx = fmaxf(fmaxf(S[qt][0][0], S[qt][0][1]), fmaxf(S[qt][0][2], S[qt][0][3]));
#pragma unroll
                    for (int kt = 1; kt < 4; ++kt) mx = fmaxf(fmaxf(mx, S[qt][kt][0]), fmaxf(fmaxf(S[qt][kt][1], S[qt][kt][2]), S[qt][kt][3]));
                    mx = xmax16(mx); mx = xmax32(mx);
                    const float mnew = fmaxf(mrun[qt], mx * SCL);
                    const float alpha = __builtin_amdgcn_exp2f(mrun[qt] - mnew);
                    float ps = 0.f;
#pragma unroll
                    for (int kt = 0; kt < 4; ++kt)
#pragma unroll
                        for (int j = 0; j < 4; ++j) { const int sel = __builtin_amdgcn_sbfe(kt < 2 ? mlo : mhi, (kt & 1) * 16 + j, 1);
                            const float p = (VAR & 2) ? S[qt][kt][j] : __uint_as_float(__float_as_uint(__builtin_amdgcn_exp2f(__builtin_fmaf(S[qt][kt][j], SCL, -mnew))) & (unsigned)sel); S[qt][kt][j] = p; ps += p; }
                    ps = xsum16(ps); ps = xsum32(ps);
                    lrun[qt] = lrun[qt] * alpha + ps; mrun[qt] = mnew;
                    if (!__all(alpha == 1.0f)) {
#pragma unroll
                        for (int dt = 0; dt < 8; ++dt) O[qt][dt] *= alpha; }
#pragma unroll
                    for (int ks = 0; ks < 2; ++ks) { u32x4 w; w.x = cvtpk(S[qt][2 * ks][0], S[qt][2 * ks][1]); w.y = cvtpk(S[qt][2 * ks][2], S[qt][2 * ks][3]);
                        w.z = cvtpk(S[qt][2 * ks + 1][0], S[qt][2 * ks + 1][1]); w.w = cvtpk(S[qt][2 * ks + 1][2], S[qt][2 * ks + 1][3]); pf[qt][ks] = __builtin_bit_cast(bf16x8, w); }
                }
#pragma unroll
                for (int dt = 4; dt < 8; ++dt)
#pragma unroll
                    for (int ks = 0; ks < 2; ++ks) { vlo[dt][ks] = lds_tr4(vb + (32 * ks) * VS + dt * 32); vhi[dt][ks] = lds_tr4(vb + (32 * ks + 16) * VS + dt * 32); }
#pragma unroll
                for (int dt = 0; dt < 8; ++dt)
#pragma unroll
                    for (int ks = 0; ks < 2; ++ks) {
                        const bf16x8 vf = __builtin_shufflevector(vlo[dt][ks], vhi[dt][ks], 0, 1, 2, 3, 4, 5, 6, 7);
                        if (!(VAR & 4)) { O[0][dt] = __builtin_amdgcn_mfma_f32_16x16x32_bf16(vf, pf[0][ks], O[0][dt], 0, 0, 0);
                        O[1][dt] = __builtin_amdgcn_mfma_f32_16x16x32_bf16(vf, pf[1][ks], O[1][dt], 0, 0, 0); } else { O[0][dt] += __builtin_bit_cast(f32x4, pf[0][ks]); O[1][dt] += __builtin_bit_cast(f32x4, pf[1][ks]); }
                    }
                if (!(VAR & 1) && t + 1 < nt) ATT_STORE(buf ^ 1);
                __syncthreads();
            }
#undef ATT_LOAD
#undef ATT_STORE
#pragma unroll
            for (int qt = 0; qt < 2; ++qt) { const float r = 1.0f / lrun[qt];
                GAS bf16* op = AO + (size_t)(m0 + qh + 16 * qt + c16) * D + (kvh * 4 + hq) * AD + 4 * g;
#pragma unroll
                for (int dt = 0; dt < 8; ++dt) { const f32x4 o = O[qt][dt] * r; u32x2 w; w.x = pk2(o.x, o.y); w.y = pk2(o.z, o.w); *(GAS u32x2*)(op + 16 * dt) = w; } }
        }
    }
}

__device__ __forceinline__ void stage_conv(const GAS bf16* P, const GAS float* cw, const GAS float* cb, int m0, int tpos0, int ch0, int nch, LAS unsigned char* dst, int stride, int tid) {
    const int cpr = nch >> 3;
    for (int id = tid; id < 64 * cpr; id += NTHR) {
        const int s = id / cpr, k = id - s * cpr, ch = ch0 + 8 * k;
        float acc[8];
        { const f32x4 b0 = *(const GAS f32x4*)(cb + ch), b1 = *(const GAS f32x4*)(cb + ch + 4); acc[0] = b0.x; acc[1] = b0.y; acc[2] = b0.z; acc[3] = b0.w; acc[4] = b1.x; acc[5] = b1.y; acc[6] = b1.z; acc[7] = b1.w; }
#pragma unroll
        for (int i = 0; i < 4; ++i) { if (tpos0 + s - 3 + i >= 0) {
            float x[8]; unpack8(*(const GAS u32x4*)(P + (size_t)(m0 + s - 3 + i) * NMAIN + PXBC + ch), x);
            const f32x4 w0 = *(const GAS f32x4*)(cw + i * CONVD + ch), w1 = *(const GAS f32x4*)(cw + i * CONVD + ch + 4);
            acc[0] += w0.x * x[0]; acc[1] += w0.y * x[1]; acc[2] += w0.z * x[2]; acc[3] += w0.w * x[3]; acc[4] += w1.x * x[4]; acc[5] += w1.y * x[5]; acc[6] += w1.z * x[6]; acc[7] += w1.w * x[7]; } }
#pragma unroll
        for (int j = 0; j < 8; ++j) acc[j] = siluf_(acc[j]);
        *(LAS u32x4*)(dst + s * stride + k * 16) = pack8(acc);
    }
}
__device__ __forceinline__ void wave_dt_acs(const GAS float* SM, const GAS float* dt_bias, const GAS float* a_log, int m0, int head, LAS float* dtw, LAS float* acsw, int lane) {
    const float raw = SM[(size_t)(m0 + lane) * SMW + SM_DT + head] + dt_bias[head];
    const float dt = fmaxf(raw, 0.f) + log1pf(__expf(-fabsf(raw)));
    float x = dt * (-__expf(a_log[head]));
#pragma unroll
    for (int o = 1; o < 64; o <<= 1) { const float v = __shfl_up(x, o); if (lane >= o) x += v; }
    dtw[lane] = dt; acsw[lane] = x;
}
__device__ __forceinline__ bf16x8 tr8(const LAS unsigned char* p, int off_lo, int off_hi) {
    const s16x4 lo = lds_tr4(p + off_lo), hi = lds_tr4(p + off_hi); return __builtin_shufflevector(lo, hi, 0, 1, 2, 3, 4, 5, 6, 7);
}
template <int NOUT> __device__ __forceinline__ void conv_strip(const GAS bf16* src, int tpos_first_raw, const GAS float* cw, const GAS float* cb, u32x4 (&out)[NOUT]) {
    u32x4 raw[NOUT + 3];
#pragma unroll
    for (int i = 0; i < NOUT + 3; ++i) { const int tp = tpos_first_raw + i; raw[i] = *(const GAS u32x4*)(src + (size_t)(tp < 0 ? 3 : i) * NMAIN); if (tp < 0) raw[i] = (u32x4){0u, 0u, 0u, 0u}; }
    f32x4 w[4][2];
#pragma unroll
    for (int t = 0; t < 4; ++t) { w[t][0] = *(const GAS f32x4*)(cw + t * CONVD); w[t][1] = *(const GAS f32x4*)(cw + t * CONVD + 4); }
    const f32x4 b0 = *(const GAS f32x4*)cb, b1 = *(const GAS f32x4*)(cb + 4);
#pragma unroll
    for (int o = 0; o < NOUT; ++o) { f32x4 a0 = b0, a1 = b1;
#pragma unroll
        for (int t = 0; t < 4; ++t) { float x[8]; unpack8(raw[o + t], x); a0 += w[t][0] * (f32x4){x[0], x[1], x[2], x[3]}; a1 += w[t][1] * (f32x4){x[4], x[5], x[6], x[7]}; }
        float f[8] = {a0.x, a0.y, a0.z, a0.w, a1.x, a1.y, a1.z, a1.w};
#pragma unroll
        for (int j = 0; j < 8; ++j) f[j] = f[j] * __builtin_amdgcn_rcpf(1.0f + __expf(-f[j]));
        out[o] = pack8(f); }
}
__device__ __forceinline__ void ph_ssd_states(const GAS bf16* P, const GAS float* SM, const GAS float* cw, const GAS float* cb, const GAS float* dt_bias, const GAS float* a_log, GAS bf16* XC, GAS bf16* ST, GAS float* CD,
                                              LAS unsigned char* lds, int blk, int nblk, int tid) {
    constexpr int RSW = 160, XW = 64 * RSW, RSB = 288, BMB = 64 * RSB, O_BM = 8 * XW, O_DT = O_BM + 2 * BMB, O_ACS = O_DT + 2048;
    const int lane = tid & 63, wave = __builtin_amdgcn_readfirstlane(tid >> 6), gq = lane >> 4, c16 = lane & 15;
    LAS unsigned char* xw = lds + wave * XW;
    LAS float* dtw = (LAS float*)(lds + O_DT) + wave * 64; LAS float* acsw = (LAS float*)(lds + O_ACS) + wave * 64;
    int par = 0;
    for (int item = blk; item < BATCH * 64 * NG; item += nblk, par ^= 1) {
        const int bc = item >> 3, g = item & 7, m0 = bc * 64, tpos0 = (bc & 63) * 64, head = g * HPG + wave;
        LAS unsigned char* bm = lds + O_BM + par * BMB;
        asm volatile("" ::: "memory");
        { const int k16 = lane & 15, r0 = 8 * wave + 2 * gq, chB = DI + g * NS + 8 * k16;
          const GAS bf16* base = P + (size_t)(m0 + r0 - 3) * NMAIN + PXBC + chB;
          u32x4 ob[2], oc[2];
          conv_strip<2>(base, tpos0 + r0 - 3, cw + chB, cb + chB, ob);
          conv_strip<2>(base + NG * NS, tpos0 + r0 - 3, cw + chB + NG * NS, cb + chB + NG * NS, oc);
#pragma unroll
          for (int o = 0; o < 2; ++o) { *(LAS u32x4*)(bm + (r0 + o) * RSB + k16 * 16) = ob[o];
              *(GAS u32x4*)(XC + (size_t)(m0 + r0 + o) * CONVD + chB) = ob[o]; *(GAS u32x4*)(XC + (size_t)(m0 + r0 + o) * CONVD + chB + NG * NS) = oc[o]; } }
        { const int k8 = lane & 7, r0 = 8 * (lane >> 3), ch = head * HP + 8 * k8;
          u32x4 ox[8];
          conv_strip<8>(P + (size_t)(m0 + r0 - 3) * NMAIN + PXBC + ch, tpos0 + r0 - 3, cw + ch, cb + ch, ox);
#pragma unroll
          for (int o = 0; o < 8; ++o) { *(LAS u32x4*)(xw + (r0 + o) * RSW + k8 * 16) = ox[o]; *(GAS u32x4*)(XC + (size_t)(m0 + r0 + o) * CONVD + ch) = ox[o]; } }
        wave_dt_acs(SM, dt_bias, a_log, m0, head, dtw, acsw, lane);
        LDS_WAIT();
        __syncthreads();
        const float aend = acsw[63];
        if (lane == 0) CD[bc * NH + head] = __expf(aend);
        const LAS unsigned char* xb = xw + (4 * gq + (c16 >> 2)) * RSW + (c16 & 3) * 8;
        const LAS unsigned char* bb = bm + (4 * gq + (c16 >> 2)) * RSB + (c16 & 3) * 8;
        bf16x8 xf[4][2];
#pragma unroll
        for (int ks = 0; ks < 2; ++ks) { float w[8];
#pragma unroll
            for (int j = 0; j < 8; ++j) { const int s = 32 * ks + 16 * (j >> 2) + 4 * gq + (j & 3); w[j] = dtw[s] * __expf(aend - acsw[s]); }
#pragma unroll
            for (int pt = 0; pt < 4; ++pt) { const bf16x8 r = tr8(xb + pt * 32, (32 * ks) * RSW, (32 * ks + 16) * RSW); float f[8]; unpack8(__builtin_bit_cast(u32x4, r), f);
#pragma unroll
                for (int j = 0; j < 8; ++j) f[j] *= w[j];
                xf[pt][ks] = __builtin_bit_cast(bf16x8, pack8(f)); } }
        GAS bf16* dst = ST + (((size_t)bc * NH + head) * HP + c16) * NS + 4 * gq;
#pragma unroll 2
        for (int nt = 0; nt < 8; ++nt) {
            const bf16x8 a0 = tr8(bb + nt * 32, 0, 16 * RSB), a1 = tr8(bb + nt * 32, 32 * RSB, 48 * RSB);
#pragma unroll
            for (int pt = 0; pt < 4; ++pt) { f32x4 acc = (f32x4){0.f, 0.f, 0.f, 0.f};
                acc = __builtin_amdgcn_mfma_f32_16x16x32_bf16(a0, xf[pt][0], acc, 0, 0, 0); acc = __builtin_amdgcn_mfma_f32_16x16x32_bf16(a1, xf[pt][1], acc, 0, 0, 0);
                u32x2 o; o.x = pk2(acc.x, acc.y); o.y = pk2(acc.z, acc.w); *(GAS u32x2*)(dst + (size_t)(16 * pt) * NS + 16 * nt) = o; }
        }
        LDS_WAIT(); asm volatile("" ::: "memory");
    }
}
__device__ __forceinline__ void ph_ssd_scan(GAS bf16* ST, const GAS float* CD, int gtid, int nthr) {
    for (int it = gtid; it < BATCH * NH * HP * (NS / 8); it += nthr) {
        const int n8 = it & 15, p = (it >> 4) & 63, head = (it >> 10) & 63, b = it >> 16;
        float h[8];
#pragma unroll
        for (int j = 0; j < 8; ++j) h[j] = 0.f;
#pragma unroll 8
        for (int c = 0; c < 64; ++c) { GAS u32x4* q = (GAS u32x4*)(ST + ((((size_t)(b * 64 + c)) * NH + head) * HP + p) * NS) + n8;
            float v[8]; unpack8(*q, v); *q = pack8(h); const float dec = CD[(b * 64 + c) * NH + head];
#pragma unroll
            for (int j = 0; j < 8; ++j) h[j] = h[j] * dec + v[j]; }
    }
}
__device__ __forceinline__ void ph_ssd_out(const GAS bf16* P, const GAS float* SM, const GAS bf16* XC, const GAS float* dt_bias, const GAS float* a_log, const GAS bf16* ST,
                                           const GAS float* dskip, const GAS float* gnorm, GAS bf16* Y, LAS unsigned char* lds, int blk, int nblk, int tid) {
    constexpr int RSW = 160, XW = 64 * RSW, O_DT = 8 * XW, O_ACS = O_DT + 2048, O_SSQ = O_ACS + 2048;
    const int lane = tid & 63, wave = __builtin_amdgcn_readfirstlane(tid >> 6), gq = lane >> 4, c16 = lane & 15;
    LAS unsigned char* xw = lds + wave * XW;
    LAS float* dtw = (LAS float*)(lds + O_DT) + wave * 64; LAS float* acsw = (LAS float*)(lds + O_ACS) + wave * 64;
    int par = 0;
    for (int item = blk; item < BATCH * 64 * NG; item += nblk, par ^= 1) {
        const int bc = item >> 3, g = item & 7, m0 = bc * 64, head = g * HPG + wave;
        asm volatile("" ::: "memory");
        { u32x4 xr[8];
#pragma unroll
          for (int i = 0; i < 8; ++i) xr[i] = *(const GAS u32x4*)(XC + (size_t)(m0 + (lane >> 3) + 8 * i) * CONVD + head * HP + (lane & 7) * 8);
#pragma unroll
          for (int i = 0; i < 8; ++i) *(LAS u32x4*)(xw + ((lane >> 3) + 8 * i) * RSW + (lane & 7) * 16) = xr[i]; }
        wave_dt_acs(SM, dt_bias, a_log, m0, head, dtw, acsw, lane);
        const GAS bf16* cbase = XC + (size_t)(m0 + c16) * CONVD + DI + NG * NS + g * NS + 8 * gq;
        const GAS bf16* bbase = cbase - NG * NS;
        bf16x8 cf[4][4];
#pragma unroll
        for (int lt = 0; lt < 4; ++lt)
#pragma unroll
            for (int kn = 0; kn < 4; ++kn) cf[lt][kn] = *(const GAS bf16x8*)(cbase + (size_t)(16 * lt) * CONVD + 32 * kn);
        LDS_WAIT(); asm volatile("" ::: "memory");
        float al[4];
#pragma unroll
        for (int lt = 0; lt < 4; ++lt) al[lt] = acsw[16 * lt + c16];
        bf16x8 lf[2][4];
#pragma unroll
        for (int ks = 0; ks < 2; ++ks) {
            f32x4 lt4[2][4];
#pragma unroll
            for (int h2 = 0; h2 < 2; ++h2) { const int st = 2 * ks + h2;
                bf16x8 bfr[4];
#pragma unroll
                for (int kn = 0; kn < 4; ++kn) bfr[kn] = *(const GAS bf16x8*)(bbase + (size_t)(16 * st) * CONVD + 32 * kn);
                float as_[4], ds_[4];
#pragma unroll
                for (int j = 0; j < 4; ++j) { as_[j] = acsw[16 * st + 4 * gq + j]; ds_[j] = dtw[16 * st + 4 * gq + j]; }
#pragma unroll
                for (int lt = 0; lt < 4; ++lt) { f32x4 t4 = (f32x4){0.f, 0.f, 0.f, 0.f};
                    if (lt >= st) {
#pragma unroll
                        for (int kn = 0; kn < 4; ++kn) t4 = __builtin_amdgcn_mfma_f32_16x16x32_bf16(bfr[kn], cf[lt][kn], t4, 0, 0, 0);
#pragma unroll
                        for (int j = 0; j < 4; ++j) { const float e = __expf(fminf(al[lt] - as_[j], 0.f)) * ds_[j]; const bool ok = (lt > st) || (4 * gq + j <= c16); t4[j] = ok ? t4[j] * e : 0.f; } }
                    lt4[h2][lt] = t4; } }
#pragma unroll
            for (int lt = 0; lt < 4; ++lt) { u32x4 w; w.x = pk2(lt4[0][lt][0], lt4[0][lt][1]); w.y = pk2(lt4[0][lt][2], lt4[0][lt][3]); w.z = pk2(lt4[1][lt][0], lt4[1][lt][1]); w.w = pk2(lt4[1][lt][2], lt4[1][lt][3]);
                lf[ks][lt] = __builtin_bit_cast(bf16x8, w); }
        }
        f32x4 acc[4][4];
        const GAS bf16* hsrc = ST + (((size_t)bc * NH + head) * HP + c16) * NS + 8 * gq;
#pragma unroll
        for (int pt = 0; pt < 4; ++pt) { bf16x8 hf[4];
#pragma unroll
            for (int kn = 0; kn < 4; ++kn) hf[kn] = *(const GAS bf16x8*)(hsrc + (size_t)(16 * pt) * NS + 32 * kn);
#pragma unroll
            for (int lt = 0; lt < 4; ++lt) { f32x4 t4 = (f32x4){0.f, 0.f, 0.f, 0.f};
#pragma unroll
                for (int kn = 0; kn < 4; ++kn) t4 = __builtin_amdgcn_mfma_f32_16x16x32_bf16(hf[kn], cf[lt][kn], t4, 0, 0, 0);
                acc[pt][lt] = t4 * __expf(al[lt]); }
            asm volatile("" ::: "memory"); }
        const LAS unsigned char* xb = xw + (4 * gq + (c16 >> 2)) * RSW + (c16 & 3) * 8;
#pragma unroll
        for (int pt = 0; pt < 4; ++pt) {
            const bf16x8 x0 = tr8(xb + pt * 32, 0, 16 * RSW), x1 = tr8(xb + pt * 32, 32 * RSW, 48 * RSW);
#pragma unroll
            for (int lt = 0; lt < 4; ++lt) { acc[pt][lt] = __builtin_amdgcn_mfma_f32_16x16x32_bf16(x0, lf[0][lt], acc[pt][lt], 0, 0, 0);
                if (lt >= 2) acc[pt][lt] = __builtin_amdgcn_mfma_f32_16x16x32_bf16(x1, lf[1][lt], acc[pt][lt], 0, 0, 0); } }
        const float dk = dskip[head]; float ssq[4] = {0.f, 0.f, 0.f, 0.f};
#pragma unroll
        for (int lt = 0; lt < 4; ++lt) { const int l = 16 * lt + c16;
#pragma unroll
            for (int pt = 0; pt < 4; ++pt) { const int p0 = 16 * pt + 4 * gq;
                const u32x2 xv = *(const LAS u32x2*)(xw + l * RSW + p0 * 2); const u32x2 zw = *(const GAS u32x2*)(P + (size_t)(m0 + l) * NMAIN + PZ + head * HP + p0);
                const float xs4[4] = {bflo(xv.x), bfhi(xv.x), bflo(xv.y), bfhi(xv.y)}, z4[4] = {bflo(zw.x), bfhi(zw.x), bflo(zw.y), bfhi(zw.y)};
#pragma unroll
                for (int j = 0; j < 4; ++j) { const float y = (acc[pt][lt][j] + dk * xs4[j]) * z4[j] * __builtin_amdgcn_rcpf(1.0f + __expf(-z4[j])); acc[pt][lt][j] = y; ssq[lt] += y * y; } } }
        LAS float* ssqs = (LAS float*)(lds + O_SSQ) + par * 512;
#pragma unroll
        for (int lt = 0; lt < 4; ++lt) { float v = ssq[lt]; v += __shfl_xor(v, 16); v += __shfl_xor(v, 32); if (gq == 0) ssqs[wave * 64 + 16 * lt + c16] = v; }
        LDS_WAIT();
        __syncthreads();
#pragma unroll
        for (int lt = 0; lt < 4; ++lt) { const int l = 16 * lt + c16; float tot = 0.f;
#pragma unroll
            for (int w8 = 0; w8 < 8; ++w8) tot += ssqs[w8 * 64 + l];
            const float rstd = rsqrtf(tot * (1.0f / (HPG * HP)) + EPS);
#pragma unroll
            for (int pt = 0; pt < 4; ++pt) { const int ch = head * HP + 16 * pt + 4 * gq; const f32x4 gn = *(const GAS f32x4*)(gnorm + ch); const f32x4 o = acc[pt][lt] * rstd * gn;
                u32x2 w; w.x = pk2(o.x, o.y); w.y = pk2(o.z, o.w); *(GAS u32x2*)(Y + (size_t)(m0 + l) * DI + ch) = w; } }
        LDS_WAIT(); asm volatile("" ::: "memory");
    }
}

__device__ __forceinline__ float gelu_tanhf_(float x) { const float u = 0.7978845608028654f * (x + 0.044715f * x * x * x); return x * __builtin_amdgcn_rcpf(1.0f + __expf(-2.0f * u)); }
__device__ __forceinline__ void ph_ffn_act(const GAS bf16* U, const GAS float* cw, const GAS float* cb, GAS bf16* ACT, int gtid, int nthr) {
    constexpr int NCG = FF / 8, R = 8;
    for (int it = gtid; it < (M / R) * NCG; it += nthr) {
        const int c0 = (it % NCG) * 8, m0 = (it / NCG) * R, t0 = m0 & (SEQ - 1);
        f32x4 wg[3][2], wv[3][2];
#pragma unroll
        for (int i = 0; i < 3; ++i) { wg[i][0] = *(const GAS f32x4*)(cw + i * FF2 + c0); wg[i][1] = *(const GAS f32x4*)(cw + i * FF2 + c0 + 4); wv[i][0] = *(const GAS f32x4*)(cw + i * FF2 + FF + c0); wv[i][1] = *(const GAS f32x4*)(cw + i * FF2 + FF + c0 + 4); }
        const f32x4 bg0 = *(const GAS f32x4*)(cb + c0), bg1 = *(const GAS f32x4*)(cb + c0 + 4), bv0 = *(const GAS f32x4*)(cb + FF + c0), bv1 = *(const GAS f32x4*)(cb + FF + c0 + 4);
        u32x4 rg[R + 2], rv[R + 2];
#pragma unroll
        for (int i = 0; i < R + 2; ++i) { const bool ok = (t0 + i - 2) >= 0; const GAS bf16* ur = U + (size_t)(m0 + (ok ? i - 2 : 0)) * FF2 + c0;
            rg[i] = *(const GAS u32x4*)ur; rv[i] = *(const GAS u32x4*)(ur + FF); if (!ok) { rg[i] = (u32x4){0u, 0u, 0u, 0u}; rv[i] = (u32x4){0u, 0u, 0u, 0u}; } }
#pragma unroll
        for (int o = 0; o < R; ++o) { f32x4 g0 = bg0, g1 = bg1, v0 = bv0, v1 = bv1;
#pragma unroll
            for (int i = 0; i < 3; ++i) { float xg[8], xv[8]; unpack8(rg[o + i], xg); unpack8(rv[o + i], xv);
                g0 += wg[i][0] * (f32x4){xg[0], xg[1], xg[2], xg[3]}; g1 += wg[i][1] * (f32x4){xg[4], xg[5], xg[6], xg[7]};
                v0 += wv[i][0] * (f32x4){xv[0], xv[1], xv[2], xv[3]}; v1 += wv[i][1] * (f32x4){xv[4], xv[5], xv[6], xv[7]}; }
            float r[8] = {gelu_tanhf_(g0.x) * v0.x, gelu_tanhf_(g0.y) * v0.y, gelu_tanhf_(g0.z) * v0.z, gelu_tanhf_(g0.w) * v0.w, gelu_tanhf_(g1.x) * v1.x, gelu_tanhf_(g1.y) * v1.y, gelu_tanhf_(g1.z) * v1.z, gelu_tanhf_(g1.w) * v1.w};
            *(GAS u32x4*)(ACT + (size_t)(m0 + o) * FF + c0) = pack8(r); }
    }
}

struct Args { const float* in[20]; float* out; unsigned char* ws; int ph_lo, ph_hi; };
constexpr int NP = 11, NPHASE = 1 + DEPTH * NP;

#define AIN(i) ((const GAS float*)args.in[i])
__global__ void __launch_bounds__(NTHR, 2) fwd(Args args) {
    extern __shared__ __attribute__((aligned(16))) unsigned char lds[];
    const int G = gridDim.x, blk = blockIdx.x;
    volatile LAS unsigned* MISC = (volatile LAS unsigned*)((LAS unsigned char*)lds + MISC_OFF);
    for (int u = threadIdx.x; u < (LDS_BYTES - LDSCTL_OFF) / 4; u += NTHR) ((LAS unsigned*)((LAS unsigned char*)lds + LDSCTL_OFF))[u] = 0u;
    __syncthreads();
    XcdBarrier bar; bar.bar = (unsigned*)(args.ws + WS_CTL) + CW_BAR; bar.x = 0; bar.st = nullptr;
    if (!MK_PER_PHASE) bar = xcd_barrier_post((unsigned*)(args.ws + WS_CTL) + CW_BAR, MISC + 8);
    const int lo = args.ph_lo, hi = args.ph_hi;
#define IN(k) (lo <= (k) && (k) < hi)
#define SEAM(k) do { if (IN(k) && IN((k) + 1)) xcd_barrier(bar); } while (0)
#define PH_BEGIN \
    int tid = threadIdx.x; asm volatile("" : "+v"(tid)); \
    const int lane = tid & 63, wave = __builtin_amdgcn_readfirstlane(tid >> 6); \
    const int gw = blk * NWAVES + wave, ngw = G * NWAVES, gtid = blk * NTHR + tid, nthr = G * NTHR; \
    GAS unsigned char* ws = (GAS unsigned char*)args.ws; asm volatile("" : "+s"(ws)); \
    LAS unsigned char* ring = (LAS unsigned char*)lds; \
    (void)lane; (void)wave; (void)gw; (void)ngw; (void)gtid; (void)nthr; (void)ring; \
    GAS float* X = (GAS float*)args.out; \
    GAS bf16* H = (GAS bf16*)(ws + WS_H); GAS bf16* P = (GAS bf16*)(ws + WS_P); GAS float* SM = (GAS float*)(ws + WS_SM); GAS bf16* XC = (GAS bf16*)(ws + WS_XC); \
    GAS float* CD = (GAS float*)(ws + WS_DT); GAS bf16* STB = (GAS bf16*)(ws + WS_ST); GAS bf16* Y = (GAS bf16*)(ws + WS_Y); \
    GAS float* SC = (GAS float*)(ws + WS_SC); GAS unsigned long long* MASKW = (GAS unsigned long long*)(ws + WS_IDX); GAS bf16* AO = (GAS bf16*)(ws + WS_AO); \
    GAS float* MG = (GAS float*)(ws + WS_MG); GAS bf16* MGB = (GAS bf16*)(ws + WS_MGB); GAS bf16* YMB = (GAS bf16*)(ws + WS_YM); GAS bf16* XB = (GAS bf16*)(ws + WS_YM + 32 * MiB); GAS bf16* U = (GAS bf16*)(ws + WS_U); \
    GAS bf16* ACT = (GAS bf16*)(ws + WS_ACT); GAS bf16* KIB = (GAS bf16*)(ws + WS_KIB); \
    (void)X; (void)H; (void)P; (void)SM; (void)XC; (void)CD; (void)STB; (void)Y; (void)SC; (void)MASKW; (void)AO; (void)MG; (void)MGB; (void)YMB; (void)XB; (void)U; (void)ACT; (void)KIB;

    if (IN(0)) { PH_BEGIN
        WPtrs wp{AIN(5), AIN(13), AIN(14), AIN(15), AIN(16), AIN(19)};
        REP(5) ph_weights(wp, ws, ring + wave * 10240, gw, ngw, lane);
        ph_resid_norm<true, false, false>(nullptr, nullptr, AIN(1), AIN(0), nullptr, nullptr, XB, H, gw, ngw, lane);
    }
    SEAM(0);

#pragma unroll 1
    for (int layer = 0; layer < DEPTH; ++layer) {
        const int pb = 1 + layer * NP;
#define WL (ws + WS_W + (size_t)layer * WL_SIZE)
        if (IN(pb + 0)) { PH_BEGIN
            { pg8::Gemm g{H, (const GAS bf16*)(WL + WL_IN), M, NMAIN, D}; pg8::StaticOrder S; S.init(M, NMAIN, G, blk);
              pg8::EpiIn E{P, NMAIN, AIN(6) + (size_t)layer * 2 * D, PG / 256};
              REP(1) { pg8::gemm_phase<pg8::EpiIn, pg8::StaticOrder, true, true>(ring, g, S, E); __syncthreads(); } }
            REP(2) { ph_small_proj(H, (const GAS bf16*)(WL + WL_IN) + (size_t)NMAIN * D, SM, KIB, ring, blk, G, tid); __syncthreads(); }
        }
        SEAM(pb + 0);
        if (IN(pb + 1)) { PH_BEGIN
            REP(20) { ph_ssd_states(P, SM, AIN(7) + (size_t)layer * 4 * CONVD, AIN(8) + (size_t)layer * CONVD, AIN(9) + layer * NH, AIN(10) + layer * NH, XC, STB, CD, ring, blk, G, tid); __syncthreads(); }
            REP(21) { ph_index_scores(P, SM, KIB, SC, ring, blk, G, tid); __syncthreads(); } }
        SEAM(pb + 1);
        if (IN(pb + 2)) { PH_BEGIN
            ph_ssd_scan(STB, CD, gtid, nthr); REP(30) ph_topk(SC, MASKW, ring + wave * 9728, gw, ngw, lane);
#if PROBE_DOUBLE == 31
            ph_ssd_scan((GAS bf16*)U, CD, gtid, nthr);
#endif
            }
        SEAM(pb + 2);
        if (IN(pb + 3)) { PH_BEGIN
            REP(40) { ph_ssd_out(P, SM, XC, AIN(9) + layer * NH, AIN(10) + layer * NH, STB,
                                 AIN(11) + layer * NH, AIN(12) + (size_t)layer * DI, Y, ring, blk, G, tid); __syncthreads(); }
            REP(41) { ph_attn_dense<0>(P, MASKW, AO, ring, blk, G, tid); __syncthreads(); }
#if PROBE_DOUBLE >= 1000
            { ph_attn_dense<PROBE_DOUBLE - 1000>(P, MASKW, (GAS bf16*)U, ring, blk, G, tid); __syncthreads(); }
#endif
            }
        SEAM(pb + 3);
        if (IN(pb + 4)) {
            { PH_BEGIN
              pg8::Gemm g{Y, (const GAS bf16*)(WL + WL_SSM), M, D, DI}; pg8::StaticOrder S; S.init(M, D, G, blk);
              pg8::EpiGateMul E{MGB, D, P + PG, NMAIN}; pg8::gemm_phase<pg8::EpiGateMul, pg8::StaticOrder, false, true>(ring, g, S, E); }
            __syncthreads();
            { PH_BEGIN
              pg8::Gemm g{AO, (const GAS bf16*)(WL + WL_ATT), M, D, D}; pg8::StaticOrder S; S.init(M, D, G, blk);
              pg8::EpiGateAdd E{MGB, D, P + PG + D, NMAIN}; pg8::gemm_phase<pg8::EpiGateAdd, pg8::StaticOrder, false, true>(ring, g, S, E); }
        }
        SEAM(pb + 4);
        if (IN(pb + 5)) { PH_BEGIN
            pg8::Gemm g{MGB, (const GAS bf16*)(WL + WL_MIX), M, D, D}; pg8::StaticOrder S; S.init(M, D, G, blk);
            pg8::EpiBf16<0> E{YMB, D, nullptr, 0, 0, 1.f}; REP(60) { pg8::gemm_phase<pg8::EpiBf16<0>, pg8::StaticOrder, false, true>(ring, g, S, E); __syncthreads(); } }
        SEAM(pb + 5);
        if (IN(pb + 6)) { PH_BEGIN
            ph_resid_norm<false, true, false>(YMB, AIN(2) + (size_t)layer * D, AIN(3) + (size_t)layer * D, nullptr, XB, nullptr, XB, H, gw, ngw, lane); }
        SEAM(pb + 6);
        if (IN(pb + 7)) { PH_BEGIN
            pg8::Gemm g{H, (const GAS bf16*)(WL + WL_UP), M, FF2, D}; pg8::StaticOrder S; S.init(M, FF2, G, blk);
            pg8::EpiBf16<0> E{U, FF2, nullptr, 0, 0, 1.f}; REP(80) { pg8::gemm_phase<pg8::EpiBf16<0>, pg8::StaticOrder, true, true>(ring, g, S, E); __syncthreads(); } }
        SEAM(pb + 7);
        if (IN(pb + 8)) { PH_BEGIN
            REP(90) ph_ffn_act(U, AIN(17) + (size_t)layer * 3 * FF2, AIN(18) + (size_t)layer * FF2, ACT, gtid, nthr); }
        SEAM(pb + 8);
        if (IN(pb + 9)) { PH_BEGIN
            pg8::Gemm g{ACT, (const GAS bf16*)(WL + WL_DN), M, D, FF}; pg8::StaticOrder S; S.init(M, D, G, blk);
            pg8::EpiBf16<0> E{YMB, D, nullptr, 0, 0, 1.f}; REP(100) { pg8::gemm_phase<pg8::EpiBf16<0>, pg8::StaticOrder, false, true>(ring, g, S, E); __syncthreads(); } }
        SEAM(pb + 9);
        if (IN(pb + 10)) { PH_BEGIN
            if (layer + 1 < DEPTH) ph_resid_norm<false, true, false>(YMB, AIN(4) + (size_t)layer * D, AIN(1) + (size_t)(layer + 1) * D, nullptr, XB, nullptr, XB, H, gw, ngw, lane);
            else ph_resid_norm<false, true, true>(YMB, AIN(4) + (size_t)layer * D, nullptr, nullptr, XB, X, nullptr, H, gw, ngw, lane); }
        SEAM(pb + 10);
    }
#undef IN
#undef SEAM
#undef WL
#undef PH_BEGIN
}

extern "C" void kernel_launch(void* const* d_in, const int* in_sizes, int n_in, void* d_out, int out_size, void* d_ws, size_t ws_size, hipStream_t stream) {
    static int grid = 0;
    if (grid == 0) {
        if (n_in != 20 || in_sizes[0] != M * D || out_size != M * D || ws_size < WS_END) { fprintf(stderr, "kernel_launch: unexpected shapes (n_in %d, in0 %d, out %d, ws %zu < %zu)\n", n_in, n_in > 0 ? in_sizes[0] : -1, out_size, ws_size, (size_t)WS_END); grid = -1; return; }
        int dev = 0, cus = 0, per_cu = 0;
        if (hipGetDevice(&dev) != hipSuccess || hipDeviceGetAttribute(&cus, hipDeviceAttributeMultiprocessorCount, dev) != hipSuccess) { grid = -1; return; }
        if (hipFuncSetAttribute((const void*)fwd, hipFuncAttributeMaxDynamicSharedMemorySize, LDS_BYTES) != hipSuccess) { fprintf(stderr, "kernel_launch: hipFuncSetAttribute failed\n"); grid = -1; return; }
        if (hipOccupancyMaxActiveBlocksPerMultiprocessor(&per_cu, (const void*)fwd, NTHR, LDS_BYTES) != hipSuccess || per_cu < 1) fprintf(stderr, "kernel_launch: occupancy query reports %d blocks per CU\n", per_cu);
        (void)hipGetLastError();
        grid = cus;
    }
    if (grid < 0) return;
    if (hipMemsetAsync((char*)d_ws + WS_CTL, 0, CTL_ZERO_BYTES, stream) != hipSuccess) return;
    Args a{};
    for (int i = 0; i < 20; ++i) a.in[i] = (const float*)d_in[i];
    a.out = (float*)d_out; a.ws = (unsigned char*)d_ws;
#if MK_PER_PHASE
    for (int ph = 0; ph < NPHASE; ++ph) { a.ph_lo = ph; a.ph_hi = ph + 1; hipLaunchKernelGGL(fwd, dim3(grid), dim3(NTHR), LDS_BYTES, stream, a); }
#else
    a.ph_lo = 0; a.ph_hi = NPHASE; hipLaunchKernelGGL(fwd, dim3(grid), dim3(NTHR), LDS_BYTES, stream, a);
#endif
}
```

```cpp
#include <hip/hip_runtime.h>
#include <cstdio>
#include <cstdint>
#define MK_PER_PHASE 0
namespace pg8 {
#define PG8_LAS __attribute__((address_space(3)))
#define PG8_GAS __attribute__((address_space(1)))
typedef unsigned short bf16_t;
typedef short bf16x8 __attribute__((ext_vector_type(8)));
typedef float f32x4 __attribute__((ext_vector_type(4)));
typedef unsigned u32x4 __attribute__((ext_vector_type(4)));
constexpr int BM = 256, BK = 64, HALF = 128, HTB = HALF * BK * 2  , STAGE_BYTES = 8 * HTB, NXCD = 8, WGM = 8;

__host__ __device__ __forceinline__ int lds_byte(int r, int c) { const int st = (r >> 4) * 2 + (c >> 5), rr = r & 15, cc = c & 31, ob = rr * 64 + cc * 2; return st * 1024 + (ob ^ (((ob >> 9) & 1) << 5)); }
__host__ __device__ __forceinline__ void stage_rc(int b, int& R, int& C) { const int st = b / 1024, sb = b % 1024, swz = sb ^ (((sb >> 9) & 1) << 5); R = (st >> 1) * 16 + swz / 64; C = (st & 1) * 32 + (swz % 64) / 2; }
__host__ __device__ __forceinline__ int perm32(int rho) { const int n = rho >> 4, i = rho & 15; return 8 * (i >> 2) + 4 * n + (i & 3); }

struct Unit { int pm, pn; };
struct Gemm { const PG8_GAS bf16_t* A; const PG8_GAS bf16_t* Bt; int M, N, K; int sa, sb; };

struct StaticOrder {
    int nM, nN, nwg, G, c;
    __host__ __device__ void init(int M, int N, int G_, int c_) { nM = M / BM; nN = N / BM; nwg = nM * nN; G = G_; c = c_; }
    __host__ __device__ bool next(int i, Unit& u) const {
        const long L = (long)i * G + c; if (L >= nwg) return false;
        int wgid = (int)L; { const int q = nwg / NXCD, r = nwg % NXCD, xcd = wgid % NXCD, off = wgid / NXCD; wgid = (xcd < r ? xcd * (q + 1) : r * (q + 1) + (xcd - r) * q) + off; }
        const int nig = WGM * nN, gid = wgid / nig, fm = gid * WGM, gsz = (nM - fm) < WGM ? (nM - fm) : WGM;
        u.pm = fm + ((wgid % nig) % gsz); u.pn = (wgid % nig) / gsz; return true;
    }
    __device__ __forceinline__ void a_ready(const Unit&) const {}
    __device__ __forceinline__ void done(const Unit&) const {}
};

__device__ __forceinline__ unsigned cvt_pk_bf16(float lo, float hi) { unsigned r; asm volatile("v_cvt_pk_bf16_f32 %0, %1, %2" : "=v"(r) : "v"(lo), "v"(hi)); return r; }
typedef float f32x2 __attribute__((ext_vector_type(2)));
__device__ __forceinline__ f32x2 gelu_pk(f32x2 v) {
    const f32x2 av = __builtin_elementwise_abs(v), d = av * 0.2316418882f + 1.0f;
    f32x2 t; t.x = __builtin_amdgcn_rcpf(d.x); t.y = __builtin_amdgcn_rcpf(d.y);
    f32x2 q = t * 0.5307027145f + (-0.7265760135f); q = q * t + 0.7107068705f; q = q * t + (-0.142248368f); q = q * t + 0.127414796f; q = q * t;
    const f32x2 s = (v * v) * (-0.72134752044f);
    f32x2 e; e.x = __builtin_amdgcn_exp2f(s.x); e.y = __builtin_amdgcn_exp2f(s.y);
    const f32x2 m = v * (q * e), r = v - m;
    f32x2 o; o.x = v.x < 0.f ? m.x : r.x; o.y = v.y < 0.f ? m.y : r.y; return o;
}

template <int ACT  > struct EpiBf16 {
    static constexpr bool PERM = true, AFTER_DRAIN = false; static_assert(ACT == 0 || ACT == 1, "EpiBf16: ACT is 0 (none) or 1 (gelu_pk)");
    PG8_GAS bf16_t* O; int ldc; const PG8_GAS float* bias; int split_cols; size_t split_stride; float scale0;
    __device__ __forceinline__ void operator()(const f32x4 (&acc)[2][2][4][2], const Unit& u, int wr, int wc, int fr, int fq) const {
        const int row0 = u.pm * BM + wr * 64 + fr; int colt = u.pn * BM; PG8_GAS bf16_t* base = O;
        float sc = 1.f; if (split_cols) { const int t = colt / split_cols; base += (size_t)t * split_stride; colt -= t * split_cols; if (t == 0) sc = scale0; }
        const int col0 = colt + wc * 32 + 8 * fq, bcol0 = u.pn * BM + wc * 32 + 8 * fq;
        f32x4 bv[2][2];
#pragma unroll
        for (int bj = 0; bj < 2; ++bj)
#pragma unroll
            for (int n = 0; n < 2; ++n) bv[bj][n] = bias ? *(const PG8_GAS f32x4*)(bias + bcol0 + bj * HALF + 4 * n) : (f32x4){0.f, 0.f, 0.f, 0.f};
#pragma unroll
        for (int ai = 0; ai < 2; ++ai)
#pragma unroll
            for (int m = 0; m < 4; ++m) { PG8_GAS bf16_t* rowp = base + (size_t)(row0 + ai * HALF + m * 16) * ldc + col0;
#pragma unroll
                for (int bj = 0; bj < 2; ++bj) { f32x4 v0 = acc[ai][bj][m][0] + bv[bj][0], v1 = acc[ai][bj][m][1] + bv[bj][1];
                    if (ACT == 1) { f32x2 a = gelu_pk((f32x2){v0[0], v0[1]}), b = gelu_pk((f32x2){v0[2], v0[3]}), c = gelu_pk((f32x2){v1[0], v1[1]}), d = gelu_pk((f32x2){v1[2], v1[3]});
                        v0 = (f32x4){a.x, a.y, b.x, b.y}; v1 = (f32x4){c.x, c.y, d.x, d.y}; }
                    v0 = v0 * sc; v1 = v1 * sc; u32x4 w; w.x = cvt_pk_bf16(v0[0], v0[1]); w.y = cvt_pk_bf16(v0[2], v0[3]); w.z = cvt_pk_bf16(v1[0], v1[1]); w.w = cvt_pk_bf16(v1[2], v1[3]);
                    *(PG8_GAS u32x4*)(rowp + bj * HALF) = w; } }
    }
};

struct EpiF32 {
    static constexpr bool PERM = false, AFTER_DRAIN = false;
    PG8_GAS float* C; int ldc;
    __device__ __forceinline__ void operator()(const f32x4 (&acc)[2][2][4][2], const Unit& u, int wr, int wc, int fr, int fq) const {
        const int row0 = u.pm * BM + wr * 64 + fr, col0 = u.pn * BM + wc * 32 + 4 * fq;
#pragma unroll
        for (int ai = 0; ai < 2; ++ai)
#pragma unroll
            for (int m = 0; m < 4; ++m) { PG8_GAS float* rowp = C + (size_t)(row0 + ai * HALF + m * 16) * ldc + col0;
#pragma unroll
                for (int bj = 0; bj < 2; ++bj)
#pragma unroll
                    for (int n = 0; n < 2; ++n) *(PG8_GAS f32x4*)(rowp + bj * HALF + n * 16) = acc[ai][bj][m][n]; }
    }
};
__device__ __forceinline__ float bf_lo(unsigned w) { return __uint_as_float(w << 16); }
__device__ __forceinline__ float bf_hi(unsigned w) { return __uint_as_float(w & 0xffff0000u); }
__device__ __forceinline__ float sigmoidf_(float x) { return __builtin_amdgcn_rcpf(1.0f + __expf(-x)); }
struct EpiIn {
    static constexpr bool PERM = true, AFTER_DRAIN = false;
    PG8_GAS bf16_t* P; int ldp; const PG8_GAS float* bgate; int gate_tile0;
    __device__ __forceinline__ void operator()(const f32x4 (&acc)[2][2][4][2], const Unit& u, int wr, int wc, int fr, int fq) const {
        const int row0 = u.pm * BM + wr * 64 + fr, colt = u.pn * BM + wc * 32 + 8 * fq;
        {
            const bool gate = u.pn >= gate_tile0;
            f32x4 bv[2][2];
#pragma unroll
            for (int bj = 0; bj < 2; ++bj)
#pragma unroll
                for (int n = 0; n < 2; ++n) bv[bj][n] = gate ? *(const PG8_GAS f32x4*)(bgate + (colt - gate_tile0 * BM) + bj * HALF + 4 * n) : (f32x4){0.f, 0.f, 0.f, 0.f};
#pragma unroll
            for (int ai = 0; ai < 2; ++ai)
#pragma unroll
                for (int m = 0; m < 4; ++m) { PG8_GAS bf16_t* rowp = P + (size_t)(row0 + ai * HALF + m * 16) * ldp + colt;
#pragma unroll
                    for (int bj = 0; bj < 2; ++bj) { f32x4 v0 = acc[ai][bj][m][0] + bv[bj][0], v1 = acc[ai][bj][m][1] + bv[bj][1];
                        if (gate) {
#pragma unroll
                            for (int j = 0; j < 4; ++j) { v0[j] = sigmoidf_(v0[j]); v1[j] = sigmoidf_(v1[j]); } }
                        u32x4 w; w.x = cvt_pk_bf16(v0[0], v0[1]); w.y = cvt_pk_bf16(v0[2], v0[3]); w.z = cvt_pk_bf16(v1[0], v1[1]); w.w = cvt_pk_bf16(v1[2], v1[3]);
                        *(PG8_GAS u32x4*)(rowp + bj * HALF) = w; } }
        }
    }
};
struct EpiGateMul {
    static constexpr bool PERM = true, AFTER_DRAIN = false;
    PG8_GAS bf16_t* O; int ldc; const PG8_GAS bf16_t* G; int ldg;
    __device__ __forceinline__ void operator()(const f32x4 (&acc)[2][2][4][2], const Unit& u, int wr, int wc, int fr, int fq) const {
        const int row0 = u.pm * BM + wr * 64 + fr, colt = u.pn * BM + wc * 32 + 8 * fq;
#pragma unroll
        for (int ai = 0; ai < 2; ++ai)
#pragma unroll
            for (int m = 0; m < 4; ++m) { const size_t row = (size_t)(row0 + ai * HALF + m * 16);
#pragma unroll
                for (int bj = 0; bj < 2; ++bj) { const u32x4 g = *(const PG8_GAS u32x4*)(G + row * ldg + colt + bj * HALF);
                    const f32x4 a0 = acc[ai][bj][m][0], a1 = acc[ai][bj][m][1];
                    u32x4 w; w.x = cvt_pk_bf16(a0[0] * bf_lo(g.x), a0[1] * bf_hi(g.x)); w.y = cvt_pk_bf16(a0[2] * bf_lo(g.y), a0[3] * bf_hi(g.y));
                    w.z = cvt_pk_bf16(a1[0] * bf_lo(g.z), a1[1] * bf_hi(g.z)); w.w = cvt_pk_bf16(a1[2] * bf_lo(g.w), a1[3] * bf_hi(g.w));
                    *(PG8_GAS u32x4*)(O + row * ldc + colt + bj * HALF) = w; } }
    }
};
struct EpiGateAdd {
    static constexpr bool PERM = true, AFTER_DRAIN = false;
    PG8_GAS bf16_t* O; int ldc; const PG8_GAS bf16_t* G; int ldg; PG8_GAS unsigned char* O8;
    __device__ __forceinline__ void operator()(const f32x4 (&acc)[2][2][4][2], const Unit& u, int wr, int wc, int fr, int fq) const {
        const int row0 = u.pm * BM + wr * 64 + fr, colt = u.pn * BM + wc * 32 + 8 * fq;
#pragma unroll
        for (int ai = 0; ai < 2; ++ai)
#pragma unroll
            for (int m = 0; m < 4; ++m) { const size_t row = (size_t)(row0 + ai * HALF + m * 16);
#pragma unroll
                for (int bj = 0; bj < 2; ++bj) { const u32x4 g = *(const PG8_GAS u32x4*)(G + row * ldg + colt + bj * HALF);
                    PG8_GAS u32x4* op = (PG8_GAS u32x4*)(O + row * ldc + colt + bj * HALF); const u32x4 p = *op;
                    const f32x4 a0 = acc[ai][bj][m][0], a1 = acc[ai][bj][m][1];
                    const float s0 = bf_lo(p.x) + a0[0] * bf_lo(g.x), s1 = bf_hi(p.x) + a0[1] * bf_hi(g.x), s2 = bf_lo(p.y) + a0[2] * bf_lo(g.y), s3 = bf_hi(p.y) + a0[3] * bf_hi(g.y);
                    const float s4 = bf_lo(p.z) + a1[0] * bf_lo(g.z), s5 = bf_hi(p.z) + a1[1] * bf_hi(g.z), s6 = bf_lo(p.w) + a1[2] * bf_lo(g.w), s7 = bf_hi(p.w) + a1[3] * bf_hi(g.w);
                    if (O8) { int lo = 0, hi = 0; lo = __builtin_amdgcn_cvt_pk_fp8_f32(s0, s1, lo, false); lo = __builtin_amdgcn_cvt_pk_fp8_f32(s2, s3, lo, true); hi = __builtin_amdgcn_cvt_pk_fp8_f32(s4, s5, hi, false); hi = __builtin_amdgcn_cvt_pk_fp8_f32(s6, s7, hi, true);
                        typedef unsigned u32x2e __attribute__((ext_vector_type(2))); u32x2e w8; w8.x = (unsigned)lo; w8.y = (unsigned)hi; *(PG8_GAS u32x2e*)(O8 + row * ldc + colt + bj * HALF) = w8; }
                    else { u32x4 w; w.x = cvt_pk_bf16(s0, s1); w.y = cvt_pk_bf16(s2, s3); w.z = cvt_pk_bf16(s4, s5); w.w = cvt_pk_bf16(s6, s7); *op = w; } } }
    }
};
template <class Epi, class Sched, bool ALIGN_EPI = false, bool SP2 = false, bool FP8 = false>
__device__ __forceinline__ void gemm_phase(PG8_LAS unsigned char* lds, const Gemm g, const Sched& S, const Epi& E) {
    int tid = threadIdx.x; asm volatile("" : "+v"(tid));
    const int wid = __builtin_amdgcn_readfirstlane(tid >> 6), lane = tid & 63, wr = wid >> 2, wc = wid & 3, fr = lane & 15, fq = lane >> 4;
    const int K = g.K, nt = K / BK;
    unsigned voffA[2], voffB[2];
#pragma unroll
    for (int i = 0; i < 2; ++i) { int R, C; stage_rc(tid * 16 + i * 8192, R, C); const int Rb = Epi::PERM ? ((R & ~31) + perm32(R & 31)) : R;
        voffA[i] = (unsigned)(R * K + C) * 2u; voffB[i] = (unsigned)(Rb * K + C) * 2u; }
    const size_t kstep = (size_t)(BK * 2);
    const size_t hstep = (size_t)HALF * K * 2;
    const size_t tstep = 2 * hstep;
    const unsigned ldsw = (unsigned)wid * 1024u;
    const int aoff = lds_byte(wr * 64 + fr, fq * 8), boff = lds_byte(wc * 32 + fr, fq * 8);
#define PG8_SA(b, h) (((b) * 2 + (h)) * HTB)
#define PG8_SB(b, h) ((4 + (b) * 2 + (h)) * HTB)
#define PG8_STAGE(bufoff, gbase, voff) do { _Pragma("unroll") for (int _i = 0; _i < 2; ++_i) \
        __builtin_amdgcn_global_load_lds((const PG8_GAS unsigned*)((const PG8_GAS char*)(gbase) + (voff)[_i]), (PG8_LAS unsigned*)(lds + (bufoff) + ldsw + _i * 8192), 16, 0, 0); } while (0)
typedef int pg8_v4i __attribute__((ext_vector_type(4))); typedef int pg8_v8i __attribute__((ext_vector_type(8)));
#define PG8_CAT(x, y) __builtin_shufflevector(__builtin_bit_cast(pg8_v4i, (x)), __builtin_bit_cast(pg8_v4i, (y)), 0, 1, 2, 3, 4, 5, 6, 7)
#define PG8_LDA(dst, b, h) do { if constexpr (FP8) { _Pragma("unroll") for (int m = 0; m < 4; ++m) dst##8[m] = PG8_CAT(*(const PG8_LAS bf16x8*)(lds + PG8_SA(b, h) + aoff + m * 2048), *(const PG8_LAS bf16x8*)(lds + PG8_SA(b, h) + aoff + m * 2048 + 1024)); } \
        else { _Pragma("unroll") for (int m = 0; m < 4; ++m) _Pragma("unroll") for (int k = 0; k < 2; ++k) dst[m][k] = *(const PG8_LAS bf16x8*)(lds + PG8_SA(b, h) + aoff + m * 2048 + k * 1024); } } while (0)
#define PG8_LDB(dst, b, h) do { if constexpr (FP8) { _Pragma("unroll") for (int n = 0; n < 2; ++n) dst##8[n] = PG8_CAT(*(const PG8_LAS bf16x8*)(lds + PG8_SB(b, h) + boff + n * 2048), *(const PG8_LAS bf16x8*)(lds + PG8_SB(b, h) + boff + n * 2048 + 1024)); } \
        else { _Pragma("unroll") for (int n = 0; n < 2; ++n) _Pragma("unroll") for (int k = 0; k < 2; ++k) dst[n][k] = *(const PG8_LAS bf16x8*)(lds + PG8_SB(b, h) + boff + n * 2048 + k * 1024); } } while (0)
#define PG8_MMA(ai, bj, At, Bt) do { __builtin_amdgcn_s_setprio(1); \
        if constexpr (FP8) { _Pragma("unroll") for (int m = 0; m < 4; ++m) _Pragma("unroll") for (int n = 0; n < 2; ++n) \
            asm volatile("v_mfma_scale_f32_16x16x128_f8f6f4 %0, %1, %2, %0, %3, %4 op_sel_hi:[0,0,0]" : "+v"(acc[ai][bj][m][n]) : "v"(Bt##8[n]), "v"(At##8[m]), "v"(sc_b), "v"(sc_a)); } \
        else { _Pragma("unroll") for (int m = 0; m < 4; ++m) _Pragma("unroll") for (int n = 0; n < 2; ++n) _Pragma("unroll") for (int k = 0; k < 2; ++k) \
            acc[ai][bj][m][n] = __builtin_amdgcn_mfma_f32_16x16x32_bf16(Bt[n][k], At[m][k], acc[ai][bj][m][n], 0, 0, 0); } \
        __builtin_amdgcn_s_setprio(0); } while (0)
#define PG8_WAIT_V(n) asm volatile("s_waitcnt vmcnt(" #n ")" ::: "memory")
#define PG8_WAIT_L(n) asm volatile("s_waitcnt lgkmcnt(" #n ")" ::: "memory")
#define PG8_BAR __builtin_amdgcn_s_barrier()
#define PG8_SCHED __builtin_amdgcn_sched_barrier(0)
    Unit cur, nxt; int ui = 0;
    if (!S.next(0, cur)) return;
    f32x4 acc[2][2][4][2];
#pragma unroll
    for (int a = 0; a < 2; ++a)
#pragma unroll
        for (int b = 0; b < 2; ++b)
#pragma unroll
            for (int m = 0; m < 4; ++m)
#pragma unroll
                for (int n = 0; n < 2; ++n) acc[a][b][m][n] = (f32x4){0.f, 0.f, 0.f, 0.f};
    const int sc_a = g.sa, sc_b = g.sb;
    bf16x8 At[4][2], B0[2][2], B1[2][2]; pg8_v8i At8[4], B08[2], B18[2];
    const PG8_GAS char* cA = (const PG8_GAS char*)g.A + (size_t)cur.pm * tstep; const PG8_GAS char* cB = (const PG8_GAS char*)g.Bt + (size_t)cur.pn * tstep;
    S.a_ready(cur);
    if constexpr (SP2) {
        PG8_STAGE(PG8_SB(0, 0), cB, voffB); PG8_STAGE(PG8_SB(0, 1), cB + hstep, voffB); PG8_STAGE(PG8_SA(0, 0), cA, voffA); PG8_STAGE(PG8_SA(0, 1), cA + hstep, voffA);
        if (wr == 1) PG8_BAR;
        PG8_WAIT_V(2); PG8_BAR;
        PG8_STAGE(PG8_SB(1, 0), cB + kstep, voffB); PG8_STAGE(PG8_SA(1, 0), cA + kstep, voffA); PG8_STAGE(PG8_SB(1, 1), cB + hstep + kstep, voffB);
        PG8_WAIT_V(6); PG8_BAR;
    } else {
        PG8_STAGE(PG8_SB(0, 0), cB, voffB); PG8_STAGE(PG8_SA(0, 0), cA, voffA); PG8_STAGE(PG8_SB(0, 1), cB + hstep, voffB); PG8_STAGE(PG8_SA(0, 1), cA + hstep, voffA);
        if (wr == 1) PG8_BAR;
        PG8_WAIT_V(4); PG8_BAR;
        PG8_STAGE(PG8_SB(1, 0), cB + kstep, voffB); PG8_STAGE(PG8_SA(1, 0), cA + kstep, voffA); PG8_STAGE(PG8_SB(1, 1), cB + hstep + kstep, voffB);
        PG8_WAIT_V(6); PG8_BAR;
    }
    for (;;) {
        const bool has_next = S.next(ui + 1, nxt);
        const PG8_GAS char* nA = has_next ? (const PG8_GAS char*)g.A + (size_t)nxt.pm * tstep : cA; const PG8_GAS char* nB = has_next ? (const PG8_GAS char*)g.Bt + (size_t)nxt.pn * tstep : cB;
        for (int t = 0; t < nt; t += 2) {
            const bool last = (t == nt - 2);
            const PG8_GAS char* a1 = cA + (size_t)(t + 1) * kstep;
            const PG8_GAS char* a2 = last ? nA : cA + (size_t)(t + 2) * kstep; const PG8_GAS char* b2 = last ? nB : cB + (size_t)(t + 2) * kstep;
            const PG8_GAS char* a3 = a2 + kstep; const PG8_GAS char* b3 = b2 + kstep;
            if (last && has_next) S.a_ready(nxt);
            if constexpr (SP2) {
            PG8_LDB(B0, 0, 0); PG8_LDB(B1, 0, 1); PG8_SCHED; PG8_LDA(At, 0, 0); PG8_STAGE(PG8_SA(1, 1), a1 + hstep, voffA);
            PG8_WAIT_V(8); PG8_WAIT_L(0); PG8_BAR; PG8_MMA(0, 0, At, B0); PG8_MMA(0, 1, At, B1); PG8_BAR; PG8_SCHED;
            PG8_LDA(At, 0, 1); PG8_STAGE(PG8_SB(0, 0), b2, voffB); PG8_STAGE(PG8_SB(0, 1), b2 + hstep, voffB); PG8_STAGE(PG8_SA(0, 0), a2, voffA);
            PG8_WAIT_V(8); PG8_WAIT_L(0); PG8_BAR; PG8_MMA(1, 0, At, B0); PG8_MMA(1, 1, At, B1); PG8_BAR; PG8_SCHED;
            PG8_LDB(B0, 1, 0); PG8_LDB(B1, 1, 1); PG8_SCHED; PG8_LDA(At, 1, 0); PG8_STAGE(PG8_SA(0, 1), a2 + hstep, voffA);
            PG8_WAIT_V(8); PG8_WAIT_L(0); PG8_BAR; PG8_MMA(0, 0, At, B0); PG8_MMA(0, 1, At, B1); PG8_BAR; PG8_SCHED;
            PG8_LDA(At, 1, 1); PG8_STAGE(PG8_SB(1, 0), b3, voffB); PG8_STAGE(PG8_SB(1, 1), b3 + hstep, voffB); PG8_STAGE(PG8_SA(1, 0), a3, voffA);
            PG8_WAIT_V(8); PG8_WAIT_L(0); PG8_BAR; PG8_MMA(1, 0, At, B0); PG8_MMA(1, 1, At, B1); PG8_BAR; PG8_SCHED;
            } else {
            PG8_LDB(B0, 0, 0); PG8_SCHED; PG8_LDA(At, 0, 0); PG8_STAGE(PG8_SA(1, 1), a1 + hstep, voffA);
            PG8_WAIT_L(8); PG8_BAR; PG8_WAIT_L(0); PG8_MMA(0, 0, At, B0); PG8_BAR; PG8_SCHED;
            PG8_LDB(B1, 0, 1); PG8_STAGE(PG8_SB(0, 0), b2, voffB);
            PG8_BAR; PG8_WAIT_L(0); PG8_MMA(0, 1, At, B1); PG8_BAR;
            PG8_LDA(At, 0, 1); PG8_STAGE(PG8_SA(0, 0), a2, voffA);
            PG8_BAR; PG8_WAIT_L(0); PG8_MMA(1, 0, At, B0); PG8_BAR; PG8_SCHED;
            PG8_STAGE(PG8_SB(0, 1), b2 + hstep, voffB);
            PG8_WAIT_V(6); PG8_BAR; PG8_MMA(1, 1, At, B1); PG8_BAR;
            PG8_LDB(B0, 1, 0); PG8_SCHED; PG8_LDA(At, 1, 0); PG8_STAGE(PG8_SA(0, 1), a2 + hstep, voffA);
            PG8_WAIT_L(8); PG8_BAR; PG8_WAIT_L(0); PG8_MMA(0, 0, At, B0); PG8_BAR; PG8_SCHED;
            PG8_LDB(B1, 1, 1); PG8_STAGE(PG8_SB(1, 0), b3, voffB);
            PG8_BAR; PG8_WAIT_L(0); PG8_MMA(0, 1, At, B1); PG8_BAR;
            PG8_LDA(At, 1, 1); PG8_STAGE(PG8_SA(1, 0), a3, voffA);
            PG8_BAR; PG8_WAIT_L(0); PG8_MMA(1, 0, At, B0); PG8_BAR; PG8_SCHED;
            PG8_STAGE(PG8_SB(1, 1), b3 + hstep, voffB);
            PG8_WAIT_V(6); PG8_BAR; PG8_MMA(1, 1, At, B1); PG8_BAR;
            }
        }
        if constexpr (FP8) asm volatile("s_nop 15\n\ts_nop 15" ::: "memory");
        if constexpr (ALIGN_EPI) { if (wr == 0) PG8_BAR; }
        if constexpr (!Epi::AFTER_DRAIN) { E(acc, cur, wr, wc, fr, fq); S.done(cur); }
        if (!has_next) break;
#pragma unroll
        for (int a = 0; a < 2; ++a)
#pragma unroll
            for (int b = 0; b < 2; ++b)
#pragma unroll
                for (int m = 0; m < 4; ++m)
#pragma unroll
                    for (int n = 0; n < 2; ++n) acc[a][b][m][n] = (f32x4){0.f, 0.f, 0.f, 0.f};
        cur = nxt; cA = nA; cB = nB; ++ui;
        if constexpr (ALIGN_EPI) { if (wr == 1) PG8_BAR; }
    }
    PG8_WAIT_V(0);
    if constexpr (!ALIGN_EPI) { if (wr == 0) PG8_BAR; }
    PG8_BAR;
    if constexpr (Epi::AFTER_DRAIN) { E.fused(acc, cur, wr, wc, fr, fq, lds, wid, lane); S.done(cur); }
#undef PG8_SA
#undef PG8_SB
#undef PG8_STAGE
#undef PG8_LDA
#undef PG8_LDB
#undef PG8_MMA
#undef PG8_WAIT_V
#undef PG8_WAIT_L
#undef PG8_BAR
#undef PG8_SCHED
}
}

#ifndef MK_PER_PHASE
#define MK_PER_PHASE 0
#endif
#ifndef PROBE_DOUBLE
#define PROBE_DOUBLE -1
#endif
#define REP(id) for (int rep_ = 0; rep_ < ((PROBE_DOUBLE == (id)) ? 2 : 1); ++rep_)
constexpr int NWAVES = 8, NTHR = 512;
constexpr int BATCH = 2, SEQ = 4096, M = BATCH * SEQ, D = 2048, DEPTH = 4;
constexpr int DI = 4096, NH = 64, HP = 64, NG = 8, HPG = 8, NS = 128, CONVD = 6144;
constexpr int QH = 16, KVH = 4, AD = 128, IH = 16, IDD = 64, TOPK = 256;
constexpr int FF = 4096, FF2 = 8192;
constexpr int NIN = 18576, NMAIN = 18432, NPAD = 18688;
constexpr int PZ = 0, PXBC = 4096, PQ = 10240, PK = 12288, PV = 12800, PQI = 13312, PG = 14336;
constexpr int SMW = 256, SM_DT = 0, SM_KI = 64, SM_WI = 128;
constexpr float EPS = 1e-6f;
constexpr int F8_DN = DEPTH - 1, F8_UP = DEPTH - 1, F8_MIX = DEPTH - 1, F8_OUT = DEPTH - 1;
constexpr float ATTN_SCALE = 0.08838834764831845f;

constexpr size_t MiB = 1u << 20;
constexpr size_t WS_CTL = 0, CTL_ZERO_BYTES = 1 * MiB;
constexpr size_t WS_W = 2 * MiB;
constexpr size_t WL_IN = 0, WL_SSM = 73 * MiB, WL_ATT = 89 * MiB, WL_MIX = 97 * MiB, WL_UP = 105 * MiB, WL_DN = 137 * MiB, WL_SIZE = 153 * MiB;
constexpr size_t WS_H = WS_W + DEPTH * WL_SIZE;
constexpr size_t WS_P = WS_H + 32 * MiB;
constexpr size_t WS_SM = WS_P + 288 * MiB;
constexpr size_t WS_XC = WS_SM + 8 * MiB;
constexpr size_t WS_DT = WS_XC + 96 * MiB;
constexpr size_t WS_ACS = WS_DT + 2 * MiB;
constexpr size_t WS_ST = WS_ACS + 2 * MiB;
constexpr size_t WS_Y = WS_ST + 256 * MiB;
constexpr size_t WS_SC = WS_Y + 64 * MiB;
constexpr size_t WS_IDX = WS_SC + 128 * MiB;
constexpr size_t WS_CNT = WS_IDX + 8 * MiB;
constexpr size_t WS_AO = WS_CNT + 1 * MiB;
constexpr size_t WS_MG = WS_AO + 32 * MiB;
constexpr size_t WS_MGB = WS_MG + 64 * MiB;
constexpr size_t WS_YM = WS_MGB + 32 * MiB;
constexpr size_t WS_U = WS_YM + 64 * MiB;
constexpr size_t WS_ACT = WS_U + 128 * MiB;
constexpr size_t WS_KIB = WS_ACT + 64 * MiB;
constexpr size_t WS_END = WS_KIB + 1 * MiB;
constexpr int CW_BAR = 4096;

constexpr int RING_BYTES = 139264, LDSCTL_OFF = RING_BYTES, MISC_OFF = LDSCTL_OFF + 320, LDS_BYTES = 147456;

#define LAS __attribute__((address_space(3)))
#define GAS __attribute__((address_space(1)))
typedef unsigned short bf16;
typedef float f32x4 __attribute__((ext_vector_type(4)));
typedef short bf16x8 __attribute__((ext_vector_type(8)));
typedef unsigned u32x4 __attribute__((ext_vector_type(4)));
typedef unsigned u32x2 __attribute__((ext_vector_type(2)));
#define LDS_WAIT() asm volatile("s_waitcnt lgkmcnt(0)" ::: "memory")

__device__ __forceinline__ unsigned f2bf(float f) { unsigned u = __builtin_bit_cast(unsigned, f); return (u + 0x7fffu + ((u >> 16) & 1u)) >> 16; }
__device__ __forceinline__ unsigned pk2(float lo, float hi) { return f2bf(lo) | (f2bf(hi) << 16); }
__device__ __forceinline__ unsigned cvtpk(float lo, float hi) { unsigned r; asm("v_cvt_pk_bf16_f32 %0, %1, %2" : "=v"(r) : "v"(lo), "v"(hi)); return r; }
__device__ __forceinline__ u32x2 pack8_fp8(const float (&f)[8]) { int lo = 0, hi = 0; lo = __builtin_amdgcn_cvt_pk_fp8_f32(f[0], f[1], lo, false); lo = __builtin_amdgcn_cvt_pk_fp8_f32(f[2], f[3], lo, true);
    hi = __builtin_amdgcn_cvt_pk_fp8_f32(f[4], f[5], hi, false); hi = __builtin_amdgcn_cvt_pk_fp8_f32(f[6], f[7], hi, true); u32x2 w; w.x = (unsigned)lo; w.y = (unsigned)hi; return w; }
__device__ __forceinline__ unsigned pack4_fp8(float a, float b, float c, float d) { int w = 0; w = __builtin_amdgcn_cvt_pk_fp8_f32(a, b, w, false); w = __builtin_amdgcn_cvt_pk_fp8_f32(c, d, w, true); return (unsigned)w; }
__device__ __forceinline__ float bflo(unsigned w) { return __uint_as_float(w << 16); }
__device__ __forceinline__ float bfhi(unsigned w) { return __uint_as_float(w & 0xffff0000u); }
__device__ __forceinline__ void unpack8(const u32x4 w, float (&f)[8]) { f[0] = bflo(w.x); f[1] = bfhi(w.x); f[2] = bflo(w.y); f[3] = bfhi(w.y); f[4] = bflo(w.z); f[5] = bfhi(w.z); f[6] = bflo(w.w); f[7] = bfhi(w.w); }
__device__ __forceinline__ u32x4 pack8(const float (&f)[8]) { u32x4 w; w.x = pk2(f[0], f[1]); w.y = pk2(f[2], f[3]); w.z = pk2(f[4], f[5]); w.w = pk2(f[6], f[7]); return w; }
__device__ __forceinline__ float wave_sum(float v) {
#pragma unroll
    for (int o = 1; o < 64; o <<= 1) v += __shfl_xor(v, o);
    return v;
}
__device__ __forceinline__ float wave_max(float v) {
#pragma unroll
    for (int o = 1; o < 64; o <<= 1) v = fmaxf(v, __shfl_xor(v, o));
    return v;
}
__device__ __forceinline__ float siluf_(float x) { return x / (1.0f + __expf(-x)); }
typedef short s16x4 __attribute__((ext_vector_type(4)));
__device__ __forceinline__ s16x4 lds_tr4(const LAS unsigned char* p) { return __builtin_bit_cast(s16x4, __builtin_amdgcn_ds_read_tr16_b64_v4i16((LAS s16x4*)p)); }

#define XB_TMO      128
#define XB_XCNT(j)  (256  + 64 * (j))
#define XB_XSUB(j)  (1280 + 64 * (j))
#define XB_XGEN(j)  (2304 + 64 * (j))
#define XB_TOP      3328
#define XB_TOPGEN   3392
#define XCD_BAR_WORDS 3456
#define XB_SPIN_CAP (1u << 18)

__device__ __forceinline__ unsigned xb_ld(unsigned* p)              { return __hip_atomic_load(p, __ATOMIC_RELAXED, __HIP_MEMORY_SCOPE_AGENT); }
__device__ __forceinline__ unsigned xb_add(unsigned* p, unsigned v) { return __hip_atomic_fetch_add(p, v, __ATOMIC_RELAXED, __HIP_MEMORY_SCOPE_AGENT); }
__device__ __forceinline__ unsigned xb_xcc_id() { return (unsigned)__builtin_amdgcn_s_getreg((3 << 11) | 20) & 0xFu; }
#define XB_SPIN(cond, bar) do { unsigned _sp = 0; while (cond) { __builtin_amdgcn_s_sleep(1); \
    if ((++_sp & 255u) == 0u) { if (xb_ld(&(bar)[XB_TMO])) break; if (_sp > XB_SPIN_CAP) { atomicAdd(&(bar)[XB_TMO], 1u); break; } } } } while (0)

struct XcdBarrier {
    unsigned* bar; unsigned x;
    volatile LAS unsigned* st;
};

__device__ __forceinline__ XcdBarrier xcd_barrier_post(unsigned* bar, volatile LAS unsigned* st) {
    XcdBarrier b; b.bar = bar; b.x = xb_xcc_id(); b.st = st;
    if (threadIdx.x == 0) (void)xb_add(&bar[XB_XCNT(b.x)], 1u);
    return b;
}
__device__ __forceinline__ void xcd_barrier_complete(unsigned* bar, unsigned x, unsigned& nloc, unsigned& nx) {
    const unsigned G = gridDim.x * gridDim.y * gridDim.z;
    unsigned sum, cnt, mine, sp = 0u;
    for (;;) {
        sum = 0u; cnt = 0u; mine = 0u;
#pragma unroll
        for (unsigned j = 0; j < 16; ++j) { const unsigned c = xb_ld(&bar[XB_XCNT(j)]); sum += c; cnt += (c > 0u) ? 1u : 0u; mine = (j == x) ? c : mine; }
        if (sum == G) break;
        __builtin_amdgcn_s_sleep(1);
        if ((++sp & 255u) == 0u) { if (xb_ld(&bar[XB_TMO])) break; if (sp > XB_SPIN_CAP) { atomicAdd(&bar[XB_TMO], 1u); break; } }
    }
    nloc = mine > 0u ? mine : 1u; nx = cnt > 0u ? cnt : 1u;
}

__device__ __forceinline__ void xcd_barrier(const XcdBarrier& b) {
    asm volatile("s_waitcnt vmcnt(0)" ::: "memory");
    __syncthreads();
    if (threadIdx.x == 0) {
        unsigned* bar = b.bar;
        __builtin_amdgcn_s_waitcnt(0);
        unsigned nloc = b.st[0], nx = b.st[1];
        if (nloc == 0u) { xcd_barrier_complete(bar, b.x, nloc, nx); b.st[0] = nloc; b.st[1] = nx; }
        const unsigned old = xb_add(&bar[XB_XSUB(b.x)], 1u);
        const unsigned gen = old / nloc;
        if (old + 1u == (gen + 1u) * nloc) {
            __builtin_amdgcn_fence(__ATOMIC_RELEASE, "agent");
            asm volatile("s_waitcnt vmcnt(0)" ::: "memory");
            const unsigned og = xb_add(&bar[XB_TOP], 1u);
            const unsigned tg = og / nx;
            if (og + 1u == (tg + 1u) * nx) xb_add(&bar[XB_TOPGEN], 1u);
            else XB_SPIN(xb_ld(&bar[XB_TOPGEN]) == tg, bar);
            __builtin_amdgcn_fence(__ATOMIC_ACQUIRE, "agent");
            xb_add(&bar[XB_XGEN(b.x)], 1u);
            asm volatile("s_waitcnt vmcnt(0)" ::: "memory");
        } else {
            XB_SPIN(xb_ld(&bar[XB_XGEN(b.x)]) == gen, bar);
            __builtin_amdgcn_fence(__ATOMIC_ACQUIRE, "agent");
            asm volatile("s_waitcnt vmcnt(0)" ::: "memory");
        }
    }
    __syncthreads();
}


template <bool XF32IN, bool HASY, bool XF32OUT, bool HF8 = false>
__device__ __forceinline__ void ph_resid_norm(const GAS bf16* Yb, const GAS float* gpost, const GAS float* gnext, const GAS float* Xf_in, const GAS bf16* Xb_in, GAS float* Xf_out, GAS bf16* Xb_out, GAS bf16* H,
                                              int gw, int ngw, int lane) {
    for (int m = gw; m < M; m += ngw) {
        float xv[4][8];
#pragma unroll
        for (int j = 0; j < 4; ++j) { const size_t e = (size_t)m * D + 8 * (lane + 64 * j);
            if (XF32IN) { const f32x4 a = *(const GAS f32x4*)(Xf_in + e), c = *(const GAS f32x4*)(Xf_in + e + 4); xv[j][0] = a.x; xv[j][1] = a.y; xv[j][2] = a.z; xv[j][3] = a.w; xv[j][4] = c.x; xv[j][5] = c.y; xv[j][6] = c.z; xv[j][7] = c.w; }
            else unpack8(*(const GAS u32x4*)(Xb_in + e), xv[j]); }
        if (HASY) {
            float yv[4][8]; float ss = 0.f;
#pragma unroll
            for (int j = 0; j < 4; ++j) { unpack8(*(const GAS u32x4*)(Yb + (size_t)m * D + 8 * (lane + 64 * j)), yv[j]);
#pragma unroll
                for (int i = 0; i < 8; ++i) ss += yv[j][i] * yv[j][i]; }
            const float rstd = rsqrtf(wave_sum(ss) * (1.0f / D) + EPS);
#pragma unroll
            for (int j = 0; j < 4; ++j) { const GAS float* gp = gpost + 8 * (lane + 64 * j); const f32x4 g0 = *(const GAS f32x4*)gp, g1 = *(const GAS f32x4*)(gp + 4);
                xv[j][0] += yv[j][0] * rstd * g0.x; xv[j][1] += yv[j][1] * rstd * g0.y; xv[j][2] += yv[j][2] * rstd * g0.z; xv[j][3] += yv[j][3] * rstd * g0.w;
                xv[j][4] += yv[j][4] * rstd * g1.x; xv[j][5] += yv[j][5] * rstd * g1.y; xv[j][6] += yv[j][6] * rstd * g1.z; xv[j][7] += yv[j][7] * rstd * g1.w; }
        }
#pragma unroll
        for (int j = 0; j < 4; ++j) { const size_t e = (size_t)m * D + 8 * (lane + 64 * j);
            if (XF32OUT) { *(GAS f32x4*)(Xf_out + e) = (f32x4){xv[j][0], xv[j][1], xv[j][2], xv[j][3]}; *(GAS f32x4*)(Xf_out + e + 4) = (f32x4){xv[j][4], xv[j][5], xv[j][6], xv[j][7]}; }
            else *(GAS u32x4*)(Xb_out + e) = pack8(xv[j]); }
        if (gnext) {
            float ss = 0.f;
#pragma unroll
            for (int j = 0; j < 4; ++j)
#pragma unroll
                for (int i = 0; i < 8; ++i) ss += xv[j][i] * xv[j][i];
            const float rstd = rsqrtf(wave_sum(ss) * (1.0f / D) + EPS);
#pragma unroll
            for (int j = 0; j < 4; ++j) { const GAS float* gp = gnext + 8 * (lane + 64 * j); const f32x4 g0 = *(const GAS f32x4*)gp, g1 = *(const GAS f32x4*)(gp + 4);
                float h[8] = {xv[j][0] * rstd * g0.x, xv[j][1] * rstd * g0.y, xv[j][2] * rstd * g0.z, xv[j][3] * rstd * g0.w, xv[j][4] * rstd * g1.x, xv[j][5] * rstd * g1.y, xv[j][6] * rstd * g1.z, xv[j][7] * rstd * g1.w};
                if (HF8) *(GAS u32x2*)((GAS unsigned char*)H + (size_t)m * D + 8 * (lane + 64 * j)) = pack8_fp8(h);
                else *(GAS u32x4*)(H + (size_t)m * D + 8 * (lane + 64 * j)) = pack8(h); }
        }
    }
}

__device__ __forceinline__ void tr_item(const GAS float* W, int ldw, int K, int k0, int nsrc, int ncols, GAS bf16* WT, int ndst, LAS unsigned char* tile, int lane) {
    const int c4 = (lane & 15) * 4, kr = lane >> 4;
    f32x4 v[16];
#pragma unroll
    for (int i = 0; i < 16; ++i) v[i] = (c4 < ncols) ? *(const GAS f32x4*)(W + (size_t)(k0 + 4 * i + kr) * ldw + nsrc + c4) : (f32x4){0.f, 0.f, 0.f, 0.f};
#pragma unroll
    for (int i = 0; i < 16; ++i) { u32x2 w; w.x = cvtpk(v[i].x, v[i].y); w.y = cvtpk(v[i].z, v[i].w); *(LAS u32x2*)(tile + (4 * i + kr) * 160 + (lane & 15) * 8) = w; }
    LDS_WAIT();
    const int g = lane >> 4, c16 = lane & 15;
    const LAS unsigned char* tb = tile + (8 * g + (c16 >> 2)) * 160 + (c16 & 3) * 8;
#pragma unroll
    for (int nt = 0; nt < 4; ++nt)
#pragma unroll
        for (int kh = 0; kh < 2; ++kh) {
            const s16x4 lo = lds_tr4(tb + (32 * kh) * 160 + nt * 32), hi = lds_tr4(tb + (32 * kh + 4) * 160 + nt * 32);
            *(GAS bf16x8*)(WT + (size_t)(ndst + 16 * nt + c16) * K + k0 + 32 * kh + 8 * g) = __builtin_shufflevector(lo, hi, 0, 1, 2, 3, 4, 5, 6, 7); }
    LDS_WAIT();
}
__device__ __forceinline__ void tr_item_fp8(const GAS float* W, int ldw, int K, int k0, int nsrc, GAS unsigned char* WT8, int ndst, LAS unsigned char* tile, int lane) {
    const int c4 = (lane & 15) * 4, kr = lane >> 4;
    f32x4 v[16];
#pragma unroll
    for (int i = 0; i < 16; ++i) v[i] = *(const GAS f32x4*)(W + (size_t)(k0 + 4 * i + kr) * ldw + nsrc + c4);
#pragma unroll
    for (int i = 0; i < 16; ++i) { u32x2 w; w.x = cvtpk(v[i].x, v[i].y); w.y = cvtpk(v[i].z, v[i].w); *(LAS u32x2*)(tile + (4 * i + kr) * 160 + (lane & 15) * 8) = w; }
    LDS_WAIT();
    const int g = lane >> 4, c16 = lane & 15;
    const LAS unsigned char* tb = tile + (16 * g + (c16 >> 2)) * 160 + (c16 & 3) * 8;
#pragma unroll
    for (int nt = 0; nt < 4; ++nt) { u32x4 o;
#pragma unroll
        for (int h = 0; h < 2; ++h) { const s16x4 lo = lds_tr4(tb + (8 * h) * 160 + nt * 32), hi = lds_tr4(tb + (8 * h + 4) * 160 + nt * 32);
            float f[8]; unpack8(__builtin_bit_cast(u32x4, __builtin_shufflevector(lo, hi, 0, 1, 2, 3, 4, 5, 6, 7)), f);
#pragma unroll
            for (int j = 0; j < 8; ++j) f[j] *= 64.0f;
            const u32x2 w = pack8_fp8(f); if (h == 0) { o.x = w.x; o.y = w.y; } else { o.z = w.x; o.w = w.y; } }
        *(GAS u32x4*)(WT8 + (size_t)(ndst + 16 * nt + c16) * K + k0 + 16 * g) = o; }
    LDS_WAIT();
}
__device__ __forceinline__ void win_map(int dstrow, int& src, int& ncols) {
    ncols = 64;
    if (dstrow < 10240) src = dstrow;
    else if (dstrow < 12288) src = dstrow - 10240 + 10304;
    else if (dstrow < 12800) src = dstrow - 12288 + 12352;
    else if (dstrow < 13312) src = dstrow - 12800 + 12864;
    else if (dstrow < 14336) src = dstrow - 13312 + 13376;
    else if (dstrow < 18432) src = dstrow - 14336 + 14480;
    else if (dstrow < 18496) src = dstrow - 18432 + 10240;
    else if (dstrow < 18560) src = dstrow - 18496 + 14400;
    else if (dstrow == 18560) { src = 14464; ncols = 16; }
    else { src = 0; ncols = 0; }
}
struct WPtrs { const GAS float *w_in, *w_ssm, *w_att, *w_mix, *w_up, *w_dn; };
__device__ __forceinline__ void ph_weights(const WPtrs wp, GAS unsigned char* ws, LAS unsigned char* tile, int gw, int ngw, int lane) {
    constexpr int I_IN = (NPAD / 64) * (D / 64), I_SSM = (D / 64) * (DI / 64), I_ATT = (D / 64) * (D / 64), I_MIX = I_ATT, I_UP = (FF2 / 64) * (D / 64), I_DN = (D / 64) * (FF / 64);
    constexpr int I_L = I_IN + I_SSM + I_ATT + I_MIX + I_UP + I_DN;
    for (int it = gw; it < DEPTH * I_L; it += ngw) {
        const int layer = it / I_L; int r = it % I_L;
        GAS unsigned char* wl = ws + WS_W + (size_t)layer * WL_SIZE;
        if (r < I_IN) { const int nblk = NPAD / 64, kb = r / nblk, nb = r % nblk; int src, nc; win_map(nb * 64, src, nc);
            tr_item(wp.w_in + (size_t)layer * D * NIN, NIN, D, kb * 64, src, nc, (GAS bf16*)(wl + WL_IN), nb * 64, tile, lane); continue; }
        r -= I_IN;
        if (r < I_SSM) { const int nblk = D / 64, kb = r / nblk, nb = r % nblk; if (layer >= F8_OUT) tr_item_fp8(wp.w_ssm + (size_t)layer * DI * D, D, DI, kb * 64, nb * 64, wl + WL_SSM, nb * 64, tile, lane); else tr_item(wp.w_ssm + (size_t)layer * DI * D, D, DI, kb * 64, nb * 64, 64, (GAS bf16*)(wl + WL_SSM), nb * 64, tile, lane); continue; }
        r -= I_SSM;
        if (r < I_ATT) { const int nblk = D / 64, kb = r / nblk, nb = r % nblk; if (layer >= F8_OUT) tr_item_fp8(wp.w_att + (size_t)layer * D * D, D, D, kb * 64, nb * 64, wl + WL_ATT, nb * 64, tile, lane); else tr_item(wp.w_att + (size_t)layer * D * D, D, D, kb * 64, nb * 64, 64, (GAS bf16*)(wl + WL_ATT), nb * 64, tile, lane); continue; }
        r -= I_ATT;
        if (r < I_MIX) { const int nblk = D / 64, kb = r / nblk, nb = r % nblk; if (layer >= F8_MIX) tr_item_fp8(wp.w_mix + (size_t)layer * D * D, D, D, kb * 64, nb * 64, wl + WL_MIX, nb * 64, tile, lane); else tr_item(wp.w_mix + (size_t)layer * D * D, D, D, kb * 64, nb * 64, 64, (GAS bf16*)(wl + WL_MIX), nb * 64, tile, lane); continue; }
        r -= I_MIX;
        if (r < I_UP) { const int nblk = FF2 / 64, kb = r / nblk, nb = r % nblk;
            if (layer >= F8_UP) tr_item_fp8(wp.w_up + (size_t)layer * D * FF2, FF2, D, kb * 64, nb * 64, wl + WL_UP, nb * 64, tile, lane);
            else tr_item(wp.w_up + (size_t)layer * D * FF2, FF2, D, kb * 64, nb * 64, 64, (GAS bf16*)(wl + WL_UP), nb * 64, tile, lane);
            continue; }
        r -= I_UP;
        { const int nblk = D / 64, kb = r / nblk, nb = r % nblk;
          if (layer >= F8_DN) tr_item_fp8(wp.w_dn + (size_t)layer * FF * D, D, FF, kb * 64, nb * 64, wl + WL_DN, nb * 64, tile, lane);
          else tr_item(wp.w_dn + (size_t)layer * FF * D, D, FF, kb * 64, nb * 64, 64, (GAS bf16*)(wl + WL_DN), nb * 64, tile, lane); }
    }
}

__device__ __forceinline__ void ph_small_proj(const GAS bf16* H, const GAS bf16* Ws, GAS float* SM, GAS bf16* KIB, LAS unsigned char* lds, int blk, int nblk, int tid) {
    constexpr int HS = 4112;
    const int lane = tid & 63, wave = __builtin_amdgcn_readfirstlane(tid >> 6), g = lane >> 4, c16 = lane & 15;
    for (int rb = blk; rb < M / 32; rb += nblk) {
        __syncthreads();
#pragma unroll
        for (int i = 0; i < 16; ++i) { const int id = tid + 512 * i, r = id >> 8, ch = id & 255;
            *(LAS u32x4*)(lds + r * HS + ch * 16) = *(const GAS u32x4*)(H + (size_t)(rb * 32 + r) * D + ch * 8); }
        __syncthreads();
        f32x4 acc[2] = {(f32x4){0.f, 0.f, 0.f, 0.f}, (f32x4){0.f, 0.f, 0.f, 0.f}}, acc9[2] = {(f32x4){0.f, 0.f, 0.f, 0.f}, (f32x4){0.f, 0.f, 0.f, 0.f}};
        const GAS bf16* wrow = Ws + (size_t)(16 * wave + c16) * D + 8 * g;
        const GAS bf16* w9 = Ws + (size_t)(128 + c16) * D + 256 * wave + 8 * g;
        const LAS unsigned char* hb = lds + c16 * HS + g * 16;
#pragma unroll 8
        for (int ks = 0; ks < 64; ++ks) {
            const bf16x8 wf = *(const GAS bf16x8*)(wrow + 32 * ks);
            const bf16x8 h0 = *(const LAS bf16x8*)(hb + ks * 64), h1 = *(const LAS bf16x8*)(hb + 16 * HS + ks * 64);
            acc[0] = __builtin_amdgcn_mfma_f32_16x16x32_bf16(wf, h0, acc[0], 0, 0, 0); acc[1] = __builtin_amdgcn_mfma_f32_16x16x32_bf16(wf, h1, acc[1], 0, 0, 0);
        }
#pragma unroll
        for (int k8 = 0; k8 < 8; ++k8) { const int ks = 8 * wave + k8;
            const bf16x8 wf = *(const GAS bf16x8*)(w9 + 32 * k8);
            const bf16x8 h0 = *(const LAS bf16x8*)(hb + ks * 64), h1 = *(const LAS bf16x8*)(hb + 16 * HS + ks * 64);
            acc9[0] = __builtin_amdgcn_mfma_f32_16x16x32_bf16(wf, h0, acc9[0], 0, 0, 0); acc9[1] = __builtin_amdgcn_mfma_f32_16x16x32_bf16(wf, h1, acc9[1], 0, 0, 0);
        }
#pragma unroll
        for (int rt = 0; rt < 2; ++rt) { const size_t row = (size_t)(rb * 32 + 16 * rt + c16);
            *(GAS f32x4*)(SM + row * SMW + 16 * wave + 4 * g) = acc[rt];
            if (wave >= 4) { u32x2 w; w.x = cvtpk(acc[rt].x, acc[rt].y); w.y = cvtpk(acc[rt].z, acc[rt].w); *(GAS u32x2*)(KIB + row * IDD + 16 * (wave - 4) + 4 * g) = w; } }
        __syncthreads();
        *(LAS f32x4*)(lds + ((wave * 2 + 0) * 64 + lane) * 16) = acc9[0]; *(LAS f32x4*)(lds + ((wave * 2 + 1) * 64 + lane) * 16) = acc9[1];
        __syncthreads();
        if (wave < 2) { f32x4 s = (f32x4){0.f, 0.f, 0.f, 0.f};
#pragma unroll
            for (int w8 = 0; w8 < 8; ++w8) s += *(const LAS f32x4*)(lds + ((w8 * 2 + wave) * 64 + lane) * 16);
            *(GAS f32x4*)(SM + (size_t)(rb * 32 + 16 * wave + c16) * SMW + 128 + 4 * g) = s; }
    }
}

__device__ __forceinline__ void ph_index_scores(const GAS bf16* P, const GAS float* SM, const GAS bf16* KIB, GAS float* SC, LAS unsigned char* lds, int blk, int nblk, int tid) {
    constexpr int QS = 1040;
    const int lane = tid & 63, wave = __builtin_amdgcn_readfirstlane(tid >> 6);
    for (int u0 = blk; u0 < 256; u0 += nblk) {
#pragma unroll 1
        for (int half = 0; half < 2; ++half) {
            const int b = half, qt = half ? 255 - u0 : u0;
            const int q0 = b * SEQ + qt * 16, nkt = ((qt * 16) / 64 + 1) * 4;
            const int qrow = q0 + (lane & 15), kq = 8 * (lane >> 4);
            __syncthreads();
#pragma unroll
            for (int i = 0; i < 2; ++i) { const int id = tid + 512 * i, q = id >> 6, ch = id & 63;
                *(LAS u32x4*)(lds + q * QS + ch * 16) = *(const GAS u32x4*)(P + (size_t)(q0 + q) * NMAIN + PQI + 8 * IDD + ch * 8); }
            bf16x8 bq[8][2]; float w[IH];
#pragma unroll
            for (int h = 0; h < IH; ++h) {
                if (h < 8) {
#pragma unroll
                    for (int ks = 0; ks < 2; ++ks) bq[h][ks] = *(const GAS bf16x8*)(P + (size_t)qrow * NMAIN + PQI + h * IDD + ks * 32 + kq); }
                w[h] = SM[(size_t)qrow * SMW + SM_WI + h]; }
            __syncthreads();
            const LAS unsigned char* qb = lds + (lane & 15) * QS + kq * 2;
            for (int kt = wave; kt < nkt; kt += NWAVES) {
                const int key0 = kt * 16; const GAS bf16* kp = KIB + (size_t)(b * SEQ + key0 + (lane & 15)) * IDD + kq;
                const bf16x8 a0 = *(const GAS bf16x8*)kp, a1 = *(const GAS bf16x8*)(kp + 32);
                f32x4 sc = (f32x4){0.f, 0.f, 0.f, 0.f};
#pragma unroll
                for (int h = 0; h < IH; ++h) { f32x4 c = (f32x4){0.f, 0.f, 0.f, 0.f};
                    const bf16x8 b0 = h < 8 ? bq[h & 7][0] : *(const LAS bf16x8*)(qb + (h - 8) * 128), b1 = h < 8 ? bq[h & 7][1] : *(const LAS bf16x8*)(qb + (h - 8) * 128 + 64);
                    c = __builtin_amdgcn_mfma_f32_16x16x32_bf16(a0, b0, c, 0, 0, 0); c = __builtin_amdgcn_mfma_f32_16x16x32_bf16(a1, b1, c, 0, 0, 0);
                    sc.x += w[h] * fmaxf(c.x, 0.f); sc.y += w[h] * fmaxf(c.y, 0.f); sc.z += w[h] * fmaxf(c.z, 0.f); sc.w += w[h] * fmaxf(c.w, 0.f); }
                *(GAS f32x4*)(SC + (size_t)qrow * SEQ + key0 + 4 * (lane >> 4)) = sc;
            }
        }
    }
}

__device__ __forceinline__ void topk_bitwise(const GAS float* srow, GAS unsigned long long* mw, int limit, int lane) {
    unsigned u[64];
#pragma unroll
    for (int j = 0; j < 64; ++j) { const int key = j * 64 + lane; unsigned v = 0u;
        if (key < limit) { const unsigned bits = __float_as_uint(srow[key]); v = (bits & 0x80000000u) ? ~bits : (bits | 0x80000000u); }
        u[j] = v; }
    unsigned T = 0u;
#pragma unroll 1
    for (int bit = 31; bit >= 0; --bit) { const unsigned cand = T | (1u << bit); int cnt = 0;
#pragma unroll
        for (int j = 0; j < 64; ++j) cnt += __popcll(__ballot(u[j] >= cand));
        if (cnt >= TOPK) T = cand; }
    int cgt = 0;
#pragma unroll
    for (int j = 0; j < 64; ++j) cgt += __popcll(__ballot(u[j] > T));
    const int need_eq = TOPK - cgt; int eqbase = 0;
    const unsigned long long lt_mask = (1ull << lane) - 1ull;
#pragma unroll
    for (int j = 0; j < 64; ++j) {
        const bool gt = u[j] > T, eq = u[j] == T;
        const unsigned long long eqm = __ballot(eq);
        const bool take = gt || (eq && (eqbase + __popcll(eqm & lt_mask) < need_eq));
        const unsigned long long tm = __ballot(take);
        if (lane == 0 && j * 64 < limit) mw[j] = tm;
        eqbase += __popcll(eqm);
    }
}
__device__ __forceinline__ void ph_topk(const GAS float* SC, GAS unsigned long long* MASKW, LAS unsigned char* wl, int gw, int ngw, int lane) {
    constexpr int CAP = 1024;
    LAS unsigned* hist = (LAS unsigned*)wl;
    LAS unsigned* maskc = (LAS unsigned*)(wl + 1024);
    LAS float* cval = (LAS float*)(wl + 1536);
    LAS unsigned* ckey = (LAS unsigned*)(wl + 1536 + 4 * CAP);
    const unsigned long long lt_mask = (1ull << lane) - 1ull;
    for (int m = gw; m < M; m += ngw) {
        const int t = m & (SEQ - 1), limit = (t / 64 + 1) * 64, nw = limit / 64;
        GAS unsigned long long* mw = MASKW + (size_t)m * 64;
        if (limit <= TOPK) { unsigned ones = 0xffffffffu; asm volatile("" : "+v"(ones)); if (lane < nw) mw[lane] = ((unsigned long long)ones << 32) | ones; continue; }
        const GAS float* srow = SC + (size_t)m * SEQ;
        float s[64]; float smax = -__builtin_inff(), smin = __builtin_inff();
#pragma unroll
        for (int j = 0; j < 64; ++j) { s[j] = (j < nw) ? srow[j * 64 + lane] : 0.f; if (j < nw) { smax = fmaxf(smax, s[j]); smin = fminf(smin, s[j]); } }
        smax = wave_max(smax); smin = -wave_max(-smin);
        const float scale = smax > smin ? 255.0f / (smax - smin) : 0.f;
        asm volatile("" ::: "memory");
        hist[lane] = 0u; hist[lane + 64] = 0u; hist[lane + 128] = 0u; hist[lane + 192] = 0u; maskc[lane] = 0u; maskc[lane + 64] = 0u;
        LDS_WAIT();
#pragma unroll
        for (int j = 0; j < 64; ++j) if (j < nw) { const int b = min(255, (int)((s[j] - smin) * scale)); __hip_atomic_fetch_add(&hist[b], 1u, __ATOMIC_RELAXED, __HIP_MEMORY_SCOPE_WORKGROUP); }
        LDS_WAIT();
        const unsigned c0 = hist[4 * lane], c1 = hist[4 * lane + 1], c2 = hist[4 * lane + 2], c3 = hist[4 * lane + 3];
        unsigned suf = c0 + c1 + c2 + c3;
#pragma unroll
        for (int o = 1; o < 64; o <<= 1) { const unsigned v = __shfl_down(suf, o); if (lane + o < 64) suf += v; }
        const unsigned above = suf - (c0 + c1 + c2 + c3);
        int bstar = -1; unsigned cab = 0u;
        { unsigned cum = above;
          if (cum < TOPK && cum + c3 >= TOPK) { bstar = 4 * lane + 3; cab = cum; } cum += c3;
          if (bstar < 0 && cum < TOPK && cum + c2 >= TOPK) { bstar = 4 * lane + 2; cab = cum; } cum += c2;
          if (bstar < 0 && cum < TOPK && cum + c1 >= TOPK) { bstar = 4 * lane + 1; cab = cum; } cum += c1;
          if (bstar < 0 && cum < TOPK && cum + c0 >= TOPK) { bstar = 4 * lane + 0; cab = cum; } }
        const unsigned long long who = __ballot(bstar >= 0);
        const int src = __builtin_ctzll(who);
        bstar = __shfl(bstar, src); cab = __shfl(cab, src);
        const int need = TOPK - (int)cab;
        const unsigned ncand = hist[bstar];
        if (ncand > (unsigned)CAP) { topk_bitwise(srow, mw, limit, lane); continue; }
        unsigned long long myword = 0ull; int base = 0;
#pragma unroll
        for (int j = 0; j < 64; ++j) if (j < nw) {
            const int b = min(255, (int)((s[j] - smin) * scale));
            const unsigned long long gm = __ballot(b > bstar), em = __ballot(b == bstar);
            if (lane == j) myword = gm;
            if (b == bstar) { const int pos = base + __popcll(em & lt_mask); cval[pos] = s[j]; ckey[pos] = (unsigned)(j * 64 + lane); }
            base += __popcll(em);
        }
        LDS_WAIT();
        for (int i = lane; i < base; i += 64) { const float vi = cval[i]; const unsigned ki = ckey[i]; int rank = 0;
            if (need < base) { for (int q = 0; q < base; ++q) { const float vq = cval[q]; const unsigned kq = ckey[q]; rank += (vq > vi || (vq == vi && kq < ki)) ? 1 : 0; } }
            if (rank < need) __hip_atomic_fetch_or(&maskc[ki >> 5], 1u << (ki & 31), __ATOMIC_RELAXED, __HIP_MEMORY_SCOPE_WORKGROUP); }
        LDS_WAIT();
        if (lane < nw) { const unsigned long long cw_ = ((unsigned long long)maskc[2 * lane + 1] << 32) | maskc[2 * lane]; mw[lane] = myword | cw_; }
        LDS_WAIT(); asm volatile("" ::: "memory");
    }
}

__device__ __forceinline__ float xmax16(float x) { auto r = __builtin_amdgcn_permlane16_swap(__float_as_uint(x), __float_as_uint(x), false, false); return fmaxf(__uint_as_float(r[0]), __uint_as_float(r[1])); }
__device__ __forceinline__ float xmax32(float x) { auto r = __builtin_amdgcn_permlane32_swap(__float_as_uint(x), __float_as_uint(x), false, false); return fmaxf(__uint_as_float(r[0]), __uint_as_float(r[1])); }
__device__ __forceinline__ float xsum16(float x) { auto r = __builtin_amdgcn_permlane16_swap(__float_as_uint(x), __float_as_uint(x), false, false); return __uint_as_float(r[0]) + __uint_as_float(r[1]); }
__device__ __forceinline__ float xsum32(float x) { auto r = __builtin_amdgcn_permlane32_swap(__float_as_uint(x), __float_as_uint(x), false, false); return __uint_as_float(r[0]) + __uint_as_float(r[1]); }
template <int VAR> __device__ __forceinline__ void ph_attn_dense(const GAS bf16* P, const GAS unsigned long long* MASKW, GAS bf16* AO, LAS unsigned char* lds, int blk, int nblk, int tid) {
    constexpr int KS = 272, VS = 288, KBUF = 64 * KS, VBUF = 64 * VS, VOFF = 2 * KBUF, MOFF = VOFF + 2 * VBUF;
    const int lane = tid & 63, wave = __builtin_amdgcn_readfirstlane(tid >> 6), g = lane >> 4, c16 = lane & 15;
    const int hq = wave >> 1, qh = (wave & 1) * 32;
    const float SCL = ATTN_SCALE * 1.4426950408889634f;
    for (int u0 = blk; u0 < 256; u0 += nblk) {
#pragma unroll 1
        for (int half = 0; half < 2; ++half) {
            const int b = (u0 >> 2) & 1, kvh = u0 & 3, cc = u0 >> 3, c = half ? 63 - cc : cc, nt = c + 1;
            const int m0 = b * SEQ + c * 64;
            bf16x8 qf[2][4];
#pragma unroll
            for (int qt = 0; qt < 2; ++qt)
#pragma unroll
                for (int kd = 0; kd < 4; ++kd) qf[qt][kd] = *(const GAS bf16x8*)(P + (size_t)(m0 + qh + 16 * qt + c16) * NMAIN + PQ + (kvh * 4 + hq) * AD + 32 * kd + 8 * g);
            f32x4 O[2][8];
#pragma unroll
            for (int qt = 0; qt < 2; ++qt)
#pragma unroll
                for (int dt = 0; dt < 8; ++dt) O[qt][dt] = (f32x4){0.f, 0.f, 0.f, 0.f};
            float mrun[2] = {-1e30f, -1e30f}, lrun[2] = {0.f, 0.f};
            const GAS bf16* kvbase = P + (size_t)(b * SEQ) * NMAIN + kvh * AD;
            u32x4 kreg[2], vreg[2];
#define ATT_LOAD(t) do { _Pragma("unroll") for (int i = 0; i < 2; ++i) { const int id = tid + 512 * i; const GAS bf16* src = kvbase + (size_t)((t) * 64 + (id >> 4)) * NMAIN + (id & 15) * 8; \
                kreg[i] = *(const GAS u32x4*)(src + PK); vreg[i] = *(const GAS u32x4*)(src + PV); } } while (0)
#define ATT_STORE(buf) do { _Pragma("unroll") for (int i = 0; i < 2; ++i) { const int id = tid + 512 * i; \
                *(LAS u32x4*)(lds + (buf) * KBUF + (id >> 4) * KS + (id & 15) * 16) = kreg[i]; *(LAS u32x4*)(lds + VOFF + (buf) * VBUF + (id >> 4) * VS + (id & 15) * 16) = vreg[i]; } } while (0)
            __syncthreads();
            ATT_LOAD(0); ATT_STORE(0);
#pragma unroll
            for (int i = 0; i < 4; ++i) { const int id = tid + 512 * i; *(LAS u32x4*)(lds + MOFF + id * 16) = *(const GAS u32x4*)((const GAS unsigned char*)(MASKW + (size_t)m0 * 64) + id * 16); }
            const LAS unsigned long long* mrow0 = (const LAS unsigned long long*)(lds + MOFF) + (qh + c16) * 64; const LAS unsigned long long* mrow1 = mrow0 + 16 * 64;
            __syncthreads();
            for (int t = 0; t < nt; ++t) {
                const int buf = (VAR & 1) ? 0 : (t & 1);
                if (!(VAR & 1) && t + 1 < nt) ATT_LOAD(t + 1);
                const LAS unsigned char* kb = lds + buf * KBUF + c16 * KS + g * 16;
                const LAS unsigned char* vb = lds + VOFF + buf * VBUF + (4 * g + (c16 >> 2)) * VS + (c16 & 3) * 8;
                f32x4 S[2][4];
                bf16x8 kf[2][4];
#pragma unroll
                for (int kd = 0; kd < 4; ++kd) kf[0][kd] = *(const LAS bf16x8*)(kb + kd * 64);
#pragma unroll
                for (int kt = 0; kt < 4; ++kt) {
                    if (kt < 3) {
#pragma unroll
                        for (int kd = 0; kd < 4; ++kd) kf[(kt + 1) & 1][kd] = *(const LAS bf16x8*)(kb + (kt + 1) * 16 * KS + kd * 64); }
#pragma unroll
                    for (int qt = 0; qt < 2; ++qt) { f32x4 s = (f32x4){0.f, 0.f, 0.f, 0.f};
#pragma unroll
                        for (int kd = 0; kd < 4; ++kd) { if (!(VAR & 8)) s = __builtin_amdgcn_mfma_f32_16x16x32_bf16(kf[kt & 1][kd], qf[qt][kd], s, 0, 0, 0); else s += __builtin_bit_cast(f32x4, kf[kt & 1][kd]); }
                        S[qt][kt] = s; }
                }
                s16x4 vlo[8][2], vhi[8][2];
#pragma unroll
                for (int dt = 0; dt < 4; ++dt)
#pragma unroll
                    for (int ks = 0; ks < 2; ++ks) { vlo[dt][ks] = lds_tr4(vb + (32 * ks) * VS + dt * 32); vhi[dt][ks] = lds_tr4(vb + (32 * ks + 16) * VS + dt * 32); }
                bf16x8 pf[2][2];
#pragma unroll
                for (int qt = 0; qt < 2; ++qt) {
                    const unsigned long long mw = (qt ? mrow1[t] : mrow0[t]) >> (4 * g);
                    const int mlo = (int)(unsigned)mw, mhi = (int)(unsigned)(mw >> 32);
                    float mx = fmaxf(fmaxf(S[qt][0][0], S[qt][0][1]), fmaxf(S[qt][0][2], S[qt][0][3]));
#pragma unroll
                    for (int kt = 1; kt < 4; ++kt) mx = fmaxf(fmaxf(mx, S[qt][kt][0]), fmaxf(fmaxf(S[qt][kt][1], S[qt][kt][2]), S[qt][kt][3]));
                    mx = xmax16(mx); mx = xmax32(mx);
                    const float mnew = fmaxf(mrun[qt], mx * SCL);
                    const float alpha = __builtin_amdgcn_exp2f(mrun[qt] - mnew);
                    float ps = 0.f;
#pragma unroll
                    for (int kt = 0; kt < 4; ++kt)
#pragma unroll
                        for (int j = 0; j < 4; ++j) { const int sel = __builtin_amdgcn_sbfe(kt < 2 ? mlo : mhi, (kt & 1) * 16 + j, 1);
                            const float p = (VAR & 2) ? S[qt][kt][j] : __uint_as_float(__float_as_uint(__builtin_amdgcn_exp2f(__builtin_fmaf(S[qt][kt][j], SCL, -mnew))) & (unsigned)sel); S[qt][kt][j] = p; ps += p; }
                    ps = xsum16(ps); ps = xsum32(ps);
                    lrun[qt] = lrun[qt] * alpha + ps; mrun[qt] = mnew;
                    if (!__all(alpha == 1.0f)) {
#pragma unroll
                        for (int dt = 0; dt < 8; ++dt) O[qt][dt] *= alpha; }
#pragma unroll
                    for (int ks = 0; ks < 2; ++ks) { u32x4 w; w.x = cvtpk(S[qt][2 * ks][0], S[qt][2 * ks][1]); w.y = cvtpk(S[qt][2 * ks][2], S[qt][2 * ks][3]);
                        w.z = cvtpk(S[qt][2 * ks + 1][0], S[qt][2 * ks + 1][1]); w.w = cvtpk(S[qt][2 * ks + 1][2], S[qt][2 * ks + 1][3]); pf[qt][ks] = __builtin_bit_cast(bf16x8, w); }
                }
#pragma unroll
                for (int dt = 4; dt < 8; ++dt)
#pragma unroll
                    for (int ks = 0; ks < 2; ++ks) { vlo[dt][ks] = lds_tr4(vb + (32 * ks) * VS + dt * 32); vhi[dt][ks] = lds_tr4(vb + (32 * ks + 16) * VS + dt * 32); }
#pragma unroll
                for (int dt = 0; dt < 8; ++dt)
#pragma unroll
                    for (int ks = 0; ks < 2; ++ks) {
                        const bf16x8 vf = __builtin_shufflevector(vlo[dt][ks], vhi[dt][ks], 0, 1, 2, 3, 4, 5, 6, 7);
                        if (!(VAR & 4)) { O[0][dt] = __builtin_amdgcn_mfma_f32_16x16x32_bf16(vf, pf[0][ks], O[0][dt], 0, 0, 0);
                        O[1][dt] = __builtin_amdgcn_mfma_f32_16x16x32_bf16(vf, pf[1][ks], O[1][dt], 0, 0, 0); } else { O[0][dt] += __builtin_bit_cast(f32x4, pf[0][ks]); O[1][dt] += __builtin_bit_cast(f32x4, pf[1][ks]); }
                    }
                if (!(VAR & 1) && t + 1 < nt) ATT_STORE(buf ^ 1);
                __syncthreads();
            }
#undef ATT_LOAD
#undef ATT_STORE
#pragma unroll
            for (int qt = 0; qt < 2; ++qt) { const float r = 1.0f / lrun[qt];
                const size_t oi = (size_t)(m0 + qh + 16 * qt + c16) * D + (kvh * 4 + hq) * AD + 4 * g;
#pragma unroll
                for (int dt = 0; dt < 8; ++dt) { const f32x4 o = O[qt][dt] * r;
                    if (VAR & 16) *(GAS unsigned*)((GAS unsigned char*)AO + oi + 16 * dt) = pack4_fp8(o.x, o.y, o.z, o.w);
                    else { u32x2 w; w.x = pk2(o.x, o.y); w.y = pk2(o.z, o.w); *(GAS u32x2*)(AO + oi + 16 * dt) = w; } } }
        }
    }
}

__device__ __forceinline__ void stage_conv(const GAS bf16* P, const GAS float* cw, const GAS float* cb, int m0, int tpos0, int ch0, int nch, LAS unsigned char* dst, int stride, int tid) {
    const int cpr = nch >> 3;
    for (int id = tid; id < 64 * cpr; id += NTHR) {
        const int s = id / cpr, k = id - s * cpr, ch = ch0 + 8 * k;
        float acc[8];
        { const f32x4 b0 = *(const GAS f32x4*)(cb + ch), b1 = *(const GAS f32x4*)(cb + ch + 4); acc[0] = b0.x; acc[1] = b0.y; acc[2] = b0.z; acc[3] = b0.w; acc[4] = b1.x; acc[5] = b1.y; acc[6] = b1.z; acc[7] = b1.w; }
#pragma unroll
        for (int i = 0; i < 4; ++i) { if (tpos0 + s - 3 + i >= 0) {
            float x[8]; unpack8(*(const GAS u32x4*)(P + (size_t)(m0 + s - 3 + i) * NMAIN + PXBC + ch), x);
            const f32x4 w0 = *(const GAS f32x4*)(cw + i * CONVD + ch), w1 = *(const GAS f32x4*)(cw + i * CONVD + ch + 4);
            acc[0] += w0.x * x[0]; acc[1] += w0.y * x[1]; acc[2] += w0.z * x[2]; acc[3] += w0.w * x[3]; acc[4] += w1.x * x[4]; acc[5] += w1.y * x[5]; acc[6] += w1.z * x[6]; acc[7] += w1.w * x[7]; } }
#pragma unroll
        for (int j = 0; j < 8; ++j) acc[j] = siluf_(acc[j]);
        *(LAS u32x4*)(dst + s * stride + k * 16) = pack8(acc);
    }
}
__device__ __forceinline__ void wave_dt_acs(const GAS float* SM, const GAS float* dt_bias, const GAS float* a_log, int m0, int head, LAS float* dtw, LAS float* acsw, int lane) {
    const float raw = SM[(size_t)(m0 + lane) * SMW + SM_DT + head] + dt_bias[head];
    const float dt = fmaxf(raw, 0.f) + log1pf(__expf(-fabsf(raw)));
    float x = dt * (-__expf(a_log[head]));
#pragma unroll
    for (int o = 1; o < 64; o <<= 1) { const float v = __shfl_up(x, o); if (lane >= o) x += v; }
    dtw[lane] = dt; acsw[lane] = x;
}
__device__ __forceinline__ bf16x8 tr8(const LAS unsigned char* p, int off_lo, int off_hi) {
    const s16x4 lo = lds_tr4(p + off_lo), hi = lds_tr4(p + off_hi); return __builtin_shufflevector(lo, hi, 0, 1, 2, 3, 4, 5, 6, 7);
}
template <int NOUT> __device__ __forceinline__ void conv_strip(const GAS bf16* src, int tpos_first_raw, const GAS float* cw, const GAS float* cb, u32x4 (&out)[NOUT]) {
    u32x4 raw[NOUT + 3];
#pragma unroll
    for (int i = 0; i < NOUT + 3; ++i) { const int tp = tpos_first_raw + i; raw[i] = *(const GAS u32x4*)(src + (size_t)(tp < 0 ? 3 : i) * NMAIN); if (tp < 0) raw[i] = (u32x4){0u, 0u, 0u, 0u}; }
    f32x4 w[4][2];
#pragma unroll
    for (int t = 0; t < 4; ++t) { w[t][0] = *(const GAS f32x4*)(cw + t * CONVD); w[t][1] = *(const GAS f32x4*)(cw + t * CONVD + 4); }
    const f32x4 b0 = *(const GAS f32x4*)cb, b1 = *(const GAS f32x4*)(cb + 4);
#pragma unroll
    for (int o = 0; o < NOUT; ++o) { f32x4 a0 = b0, a1 = b1;
#pragma unroll
        for (int t = 0; t < 4; ++t) { float x[8]; unpack8(raw[o + t], x); a0 += w[t][0] * (f32x4){x[0], x[1], x[2], x[3]}; a1 += w[t][1] * (f32x4){x[4], x[5], x[6], x[7]}; }
        float f[8] = {a0.x, a0.y, a0.z, a0.w, a1.x, a1.y, a1.z, a1.w};
#pragma unroll
        for (int j = 0; j < 8; ++j) f[j] = f[j] * __builtin_amdgcn_rcpf(1.0f + __expf(-f[j]));
        out[o] = pack8(f); }
}
__device__ __forceinline__ void ph_ssd_states(const GAS bf16* P, const GAS float* SM, const GAS float* cw, const GAS float* cb, const GAS float* dt_bias, const GAS float* a_log, GAS bf16* XC, GAS bf16* ST, GAS float* CD,
                                              LAS unsigned char* lds, int blk, int nblk, int tid) {
    constexpr int RSW = 160, XW = 64 * RSW, RSB = 288, BMB = 64 * RSB, O_BM = 8 * XW, O_DT = O_BM + 2 * BMB, O_ACS = O_DT + 2048;
    const int lane = tid & 63, wave = __builtin_amdgcn_readfirstlane(tid >> 6), gq = lane >> 4, c16 = lane & 15;
    LAS unsigned char* xw = lds + wave * XW;
    LAS float* dtw = (LAS float*)(lds + O_DT) + wave * 64; LAS float* acsw = (LAS float*)(lds + O_ACS) + wave * 64;
    int par = 0;
    for (int item = blk; item < BATCH * 64 * NG; item += nblk, par ^= 1) {
        const int bc = item >> 3, g = item & 7, m0 = bc * 64, tpos0 = (bc & 63) * 64, head = g * HPG + wave;
        LAS unsigned char* bm = lds + O_BM + par * BMB;
        asm volatile("" ::: "memory");
        { const int k16 = lane & 15, r0 = 8 * wave + 2 * gq, chB = DI + g * NS + 8 * k16;
          const GAS bf16* base = P + (size_t)(m0 + r0 - 3) * NMAIN + PXBC + chB;
          u32x4 ob[2], oc[2];
          conv_strip<2>(base, tpos0 + r0 - 3, cw + chB, cb + chB, ob);
          conv_strip<2>(base + NG * NS, tpos0 + r0 - 3, cw + chB + NG * NS, cb + chB + NG * NS, oc);
#pragma unroll
          for (int o = 0; o < 2; ++o) { *(LAS u32x4*)(bm + (r0 + o) * RSB + k16 * 16) = ob[o];
              *(GAS u32x4*)(XC + (size_t)(m0 + r0 + o) * CONVD + chB) = ob[o]; *(GAS u32x4*)(XC + (size_t)(m0 + r0 + o) * CONVD + chB + NG * NS) = oc[o]; } }
        { const int k8 = lane & 7, r0 = 8 * (lane >> 3), ch = head * HP + 8 * k8;
          u32x4 ox[8];
          conv_strip<8>(P + (size_t)(m0 + r0 - 3) * NMAIN + PXBC + ch, tpos0 + r0 - 3, cw + ch, cb + ch, ox);
#pragma unroll
          for (int o = 0; o < 8; ++o) { *(LAS u32x4*)(xw + (r0 + o) * RSW + k8 * 16) = ox[o]; *(GAS u32x4*)(XC + (size_t)(m0 + r0 + o) * CONVD + ch) = ox[o]; } }
        wave_dt_acs(SM, dt_bias, a_log, m0, head, dtw, acsw, lane);
        LDS_WAIT();
        __syncthreads();
        const float aend = acsw[63];
        if (lane == 0) CD[bc * NH + head] = __expf(aend);
        const LAS unsigned char* xb = xw + (4 * gq + (c16 >> 2)) * RSW + (c16 & 3) * 8;
        const LAS unsigned char* bb = bm + (4 * gq + (c16 >> 2)) * RSB + (c16 & 3) * 8;
        bf16x8 xf[4][2];
#pragma unroll
        for (int ks = 0; ks < 2; ++ks) { float w[8];
#pragma unroll
            for (int j = 0; j < 8; ++j) { const int s = 32 * ks + 16 * (j >> 2) + 4 * gq + (j & 3); w[j] = dtw[s] * __expf(aend - acsw[s]); }
#pragma unroll
            for (int pt = 0; pt < 4; ++pt) { const bf16x8 r = tr8(xb + pt * 32, (32 * ks) * RSW, (32 * ks + 16) * RSW); float f[8]; unpack8(__builtin_bit_cast(u32x4, r), f);
#pragma unroll
                for (int j = 0; j < 8; ++j) f[j] *= w[j];
                xf[pt][ks] = __builtin_bit_cast(bf16x8, pack8(f)); } }
        GAS bf16* dst = ST + (((size_t)bc * NH + head) * HP + c16) * NS + 4 * gq;
#pragma unroll 2
        for (int nt = 0; nt < 8; ++nt) {
            const bf16x8 a0 = tr8(bb + nt * 32, 0, 16 * RSB), a1 = tr8(bb + nt * 32, 32 * RSB, 48 * RSB);
#pragma unroll
            for (int pt = 0; pt < 4; ++pt) { f32x4 acc = (f32x4){0.f, 0.f, 0.f, 0.f};
                acc = __builtin_amdgcn_mfma_f32_16x16x32_bf16(a0, xf[pt][0], acc, 0, 0, 0); acc = __builtin_amdgcn_mfma_f32_16x16x32_bf16(a1, xf[pt][1], acc, 0, 0, 0);
                u32x2 o; o.x = pk2(acc.x, acc.y); o.y = pk2(acc.z, acc.w); *(GAS u32x2*)(dst + (size_t)(16 * pt) * NS + 16 * nt) = o; }
        }
        LDS_WAIT(); asm volatile("" ::: "memory");
    }
}
__device__ __forceinline__ void ph_ssd_scan(GAS bf16* ST, const GAS float* CD, int gtid, int nthr) {
    for (int it = gtid; it < BATCH * NH * HP * (NS / 8); it += nthr) {
        const int n8 = it & 15, p = (it >> 4) & 63, head = (it >> 10) & 63, b = it >> 16;
        float h[8];
#pragma unroll
        for (int j = 0; j < 8; ++j) h[j] = 0.f;
#pragma unroll 8
        for (int c = 0; c < 64; ++c) { GAS u32x4* q = (GAS u32x4*)(ST + ((((size_t)(b * 64 + c)) * NH + head) * HP + p) * NS) + n8;
            float v[8]; unpack8(*q, v); *q = pack8(h); const float dec = CD[(b * 64 + c) * NH + head];
#pragma unroll
            for (int j = 0; j < 8; ++j) h[j] = h[j] * dec + v[j]; }
    }
}
template <bool YF8> __device__ __forceinline__ void ph_ssd_out(const GAS bf16* P, const GAS float* SM, const GAS bf16* XC, const GAS float* dt_bias, const GAS float* a_log, const GAS bf16* ST,
                                           const GAS float* dskip, const GAS float* gnorm, GAS bf16* Y, LAS unsigned char* lds, int blk, int nblk, int tid) {
    constexpr int RSW = 160, XW = 64 * RSW, O_DT = 8 * XW, O_ACS = O_DT + 2048, O_SSQ = O_ACS + 2048;
    const int lane = tid & 63, wave = __builtin_amdgcn_readfirstlane(tid >> 6), gq = lane >> 4, c16 = lane & 15;
    LAS unsigned char* xw = lds + wave * XW;
    LAS float* dtw = (LAS float*)(lds + O_DT) + wave * 64; LAS float* acsw = (LAS float*)(lds + O_ACS) + wave * 64;
    int par = 0;
    for (int item = blk; item < BATCH * 64 * NG; item += nblk, par ^= 1) {
        const int bc = item >> 3, g = item & 7, m0 = bc * 64, head = g * HPG + wave;
        asm volatile("" ::: "memory");
        { u32x4 xr[8];
#pragma unroll
          for (int i = 0; i < 8; ++i) xr[i] = *(const GAS u32x4*)(XC + (size_t)(m0 + (lane >> 3) + 8 * i) * CONVD + head * HP + (lane & 7) * 8);
#pragma unroll
          for (int i = 0; i < 8; ++i) *(LAS u32x4*)(xw + ((lane >> 3) + 8 * i) * RSW + (lane & 7) * 16) = xr[i]; }
        wave_dt_acs(SM, dt_bias, a_log, m0, head, dtw, acsw, lane);
        const GAS bf16* cbase = XC + (size_t)(m0 + c16) * CONVD + DI + NG * NS + g * NS + 8 * gq;
        const GAS bf16* bbase = cbase - NG * NS;
        bf16x8 cf[4][4];
#pragma unroll
        for (int lt = 0; lt < 4; ++lt)
#pragma unroll
            for (int kn = 0; kn < 4; ++kn) cf[lt][kn] = *(const GAS bf16x8*)(cbase + (size_t)(16 * lt) * CONVD + 32 * kn);
        LDS_WAIT(); asm volatile("" ::: "memory");
        float al[4];
#pragma unroll
        for (int lt = 0; lt < 4; ++lt) al[lt] = acsw[16 * lt + c16];
        bf16x8 lf[2][4];
#pragma unroll
        for (int ks = 0; ks < 2; ++ks) {
            f32x4 lt4[2][4];
#pragma unroll
            for (int h2 = 0; h2 < 2; ++h2) { const int st = 2 * ks + h2;
                bf16x8 bfr[4];
#pragma unroll
                for (int kn = 0; kn < 4; ++kn) bfr[kn] = *(const GAS bf16x8*)(bbase + (size_t)(16 * st) * CONVD + 32 * kn);
                float as_[4], ds_[4];
#pragma unroll
                for (int j = 0; j < 4; ++j) { as_[j] = acsw[16 * st + 4 * gq + j]; ds_[j] = dtw[16 * st + 4 * gq + j]; }
#pragma unroll
                for (int lt = 0; lt < 4; ++lt) { f32x4 t4 = (f32x4){0.f, 0.f, 0.f, 0.f};
                    if (lt >= st) {
#pragma unroll
                        for (int kn = 0; kn < 4; ++kn) t4 = __builtin_amdgcn_mfma_f32_16x16x32_bf16(bfr[kn], cf[lt][kn], t4, 0, 0, 0);
#pragma unroll
                        for (int j = 0; j < 4; ++j) { const float e = __expf(fminf(al[lt] - as_[j], 0.f)) * ds_[j]; const bool ok = (lt > st) || (4 * gq + j <= c16); t4[j] = ok ? t4[j] * e : 0.f; } }
                    lt4[h2][lt] = t4; } }
#pragma unroll
            for (int lt = 0; lt < 4; ++lt) { u32x4 w; w.x = pk2(lt4[0][lt][0], lt4[0][lt][1]); w.y = pk2(lt4[0][lt][2], lt4[0][lt][3]); w.z = pk2(lt4[1][lt][0], lt4[1][lt][1]); w.w = pk2(lt4[1][lt][2], lt4[1][lt][3]);
                lf[ks][lt] = __builtin_bit_cast(bf16x8, w); }
        }
        f32x4 acc[4][4];
        const GAS bf16* hsrc = ST + (((size_t)bc * NH + head) * HP + c16) * NS + 8 * gq;
#pragma unroll
        for (int pt = 0; pt < 4; ++pt) { bf16x8 hf[4];
#pragma unroll
            for (int kn = 0; kn < 4; ++kn) hf[kn] = *(const GAS bf16x8*)(hsrc + (size_t)(16 * pt) * NS + 32 * kn);
#pragma unroll
            for (int lt = 0; lt < 4; ++lt) { f32x4 t4 = (f32x4){0.f, 0.f, 0.f, 0.f};
#pragma unroll
                for (int kn = 0; kn < 4; ++kn) t4 = __builtin_amdgcn_mfma_f32_16x16x32_bf16(hf[kn], cf[lt][kn], t4, 0, 0, 0);
                acc[pt][lt] = t4 * __expf(al[lt]); }
            asm volatile("" ::: "memory"); }
        const LAS unsigned char* xb = xw + (4 * gq + (c16 >> 2)) * RSW + (c16 & 3) * 8;
#pragma unroll
        for (int pt = 0; pt < 4; ++pt) {
            const bf16x8 x0 = tr8(xb + pt * 32, 0, 16 * RSW), x1 = tr8(xb + pt * 32, 32 * RSW, 48 * RSW);
#pragma unroll
            for (int lt = 0; lt < 4; ++lt) { acc[pt][lt] = __builtin_amdgcn_mfma_f32_16x16x32_bf16(x0, lf[0][lt], acc[pt][lt], 0, 0, 0);
                if (lt >= 2) acc[pt][lt] = __builtin_amdgcn_mfma_f32_16x16x32_bf16(x1, lf[1][lt], acc[pt][lt], 0, 0, 0); } }
        const float dk = dskip[head]; float ssq[4] = {0.f, 0.f, 0.f, 0.f};
#pragma unroll
        for (int lt = 0; lt < 4; ++lt) { const int l = 16 * lt + c16;
#pragma unroll
            for (int pt = 0; pt < 4; ++pt) { const int p0 = 16 * pt + 4 * gq;
                const u32x2 xv = *(const LAS u32x2*)(xw + l * RSW + p0 * 2); const u32x2 zw = *(const GAS u32x2*)(P + (size_t)(m0 + l) * NMAIN + PZ + head * HP + p0);
                const float xs4[4] = {bflo(xv.x), bfhi(xv.x), bflo(xv.y), bfhi(xv.y)}, z4[4] = {bflo(zw.x), bfhi(zw.x), bflo(zw.y), bfhi(zw.y)};
#pragma unroll
                for (int j = 0; j < 4; ++j) { const float y = (acc[pt][lt][j] + dk * xs4[j]) * z4[j] * __builtin_amdgcn_rcpf(1.0f + __expf(-z4[j])); acc[pt][lt][j] = y; ssq[lt] += y * y; } } }
        LAS float* ssqs = (LAS float*)(lds + O_SSQ) + par * 512;
#pragma unroll
        for (int lt = 0; lt < 4; ++lt) { float v = ssq[lt]; v += __shfl_xor(v, 16); v += __shfl_xor(v, 32); if (gq == 0) ssqs[wave * 64 + 16 * lt + c16] = v; }
        LDS_WAIT();
        __syncthreads();
#pragma unroll
        for (int lt = 0; lt < 4; ++lt) { const int l = 16 * lt + c16; float tot = 0.f;
#pragma unroll
            for (int w8 = 0; w8 < 8; ++w8) tot += ssqs[w8 * 64 + l];
            const float rstd = rsqrtf(tot * (1.0f / (HPG * HP)) + EPS);
#pragma unroll
            for (int pt = 0; pt < 4; ++pt) { const int ch = head * HP + 16 * pt + 4 * gq; const f32x4 gn = *(const GAS f32x4*)(gnorm + ch); const f32x4 o = acc[pt][lt] * rstd * gn;
                if (YF8) *(GAS unsigned*)((GAS unsigned char*)Y + (size_t)(m0 + l) * DI + ch) = pack4_fp8(o.x, o.y, o.z, o.w);
                else { u32x2 w; w.x = pk2(o.x, o.y); w.y = pk2(o.z, o.w); *(GAS u32x2*)(Y + (size_t)(m0 + l) * DI + ch) = w; } } }
        LDS_WAIT(); asm volatile("" ::: "memory");
    }
}

__device__ __forceinline__ float gelu_tanhf_(float x) { const float u = 0.7978845608028654f * (x + 0.044715f * x * x * x); return x * __builtin_amdgcn_rcpf(1.0f + __expf(-2.0f * u)); }
template <bool F8> __device__ __forceinline__ void ph_ffn_act(const GAS bf16* U, const GAS float* cw, const GAS float* cb, GAS bf16* ACT, int gtid, int nthr) {
    constexpr int NCG = FF / 8, R = 8;
    for (int it = gtid; it < (M / R) * NCG; it += nthr) {
        const int c0 = (it % NCG) * 8, m0 = (it / NCG) * R, t0 = m0 & (SEQ - 1);
        f32x4 wg[3][2], wv[3][2];
#pragma unroll
        for (int i = 0; i < 3; ++i) { wg[i][0] = *(const GAS f32x4*)(cw + i * FF2 + c0); wg[i][1] = *(const GAS f32x4*)(cw + i * FF2 + c0 + 4); wv[i][0] = *(const GAS f32x4*)(cw + i * FF2 + FF + c0); wv[i][1] = *(const GAS f32x4*)(cw + i * FF2 + FF + c0 + 4); }
        const f32x4 bg0 = *(const GAS f32x4*)(cb + c0), bg1 = *(const GAS f32x4*)(cb + c0 + 4), bv0 = *(const GAS f32x4*)(cb + FF + c0), bv1 = *(const GAS f32x4*)(cb + FF + c0 + 4);
        u32x4 rg[R + 2], rv[R + 2];
#pragma unroll
        for (int i = 0; i < R + 2; ++i) { const bool ok = (t0 + i - 2) >= 0; const GAS bf16* ur = U + (size_t)(m0 + (ok ? i - 2 : 0)) * FF2 + c0;
            rg[i] = *(const GAS u32x4*)ur; rv[i] = *(const GAS u32x4*)(ur + FF); if (!ok) { rg[i] = (u32x4){0u, 0u, 0u, 0u}; rv[i] = (u32x4){0u, 0u, 0u, 0u}; } }
#pragma unroll
        for (int o = 0; o < R; ++o) { f32x4 g0 = bg0, g1 = bg1, v0 = bv0, v1 = bv1;
#pragma unroll
            for (int i = 0; i < 3; ++i) { float xg[8], xv[8]; unpack8(rg[o + i], xg); unpack8(rv[o + i], xv);
                g0 += wg[i][0] * (f32x4){xg[0], xg[1], xg[2], xg[3]}; g1 += wg[i][1] * (f32x4){xg[4], xg[5], xg[6], xg[7]};
                v0 += wv[i][0] * (f32x4){xv[0], xv[1], xv[2], xv[3]}; v1 += wv[i][1] * (f32x4){xv[4], xv[5], xv[6], xv[7]}; }
            float r[8] = {gelu_tanhf_(g0.x) * v0.x, gelu_tanhf_(g0.y) * v0.y, gelu_tanhf_(g0.z) * v0.z, gelu_tanhf_(g0.w) * v0.w, gelu_tanhf_(g1.x) * v1.x, gelu_tanhf_(g1.y) * v1.y, gelu_tanhf_(g1.z) * v1.z, gelu_tanhf_(g1.w) * v1.w};
            if (F8) *(GAS u32x2*)((GAS unsigned char*)ACT + (size_t)(m0 + o) * FF + c0) = pack8_fp8(r);
            else *(GAS u32x4*)(ACT + (size_t)(m0 + o) * FF + c0) = pack8(r); }
    }
}

struct Args { const float* in[20]; float* out; unsigned char* ws; int ph_lo, ph_hi; };
constexpr int NP = 11, NPHASE = 1 + DEPTH * NP;

#define AIN(i) ((const GAS float*)args.in[i])
__global__ void __launch_bounds__(NTHR, 2) fwd(Args args) {
    extern __shared__ __attribute__((aligned(16))) unsigned char lds[];
    const int G = gridDim.x, blk = blockIdx.x;
    volatile LAS unsigned* MISC = (volatile LAS unsigned*)((LAS unsigned char*)lds + MISC_OFF);
    for (int u = threadIdx.x; u < (LDS_BYTES - LDSCTL_OFF) / 4; u += NTHR) ((LAS unsigned*)((LAS unsigned char*)lds + LDSCTL_OFF))[u] = 0u;
    __syncthreads();
    XcdBarrier bar; bar.bar = (unsigned*)(args.ws + WS_CTL) + CW_BAR; bar.x = 0; bar.st = nullptr;
    if (!MK_PER_PHASE) bar = xcd_barrier_post((unsigned*)(args.ws + WS_CTL) + CW_BAR, MISC + 8);
    const int lo = args.ph_lo, hi = args.ph_hi;
#define IN(k) (lo <= (k) && (k) < hi)
#define SEAM(k) do { if (IN(k) && IN((k) + 1)) xcd_barrier(bar); } while (0)
#define PH_BEGIN \
    int tid = threadIdx.x; asm volatile("" : "+v"(tid)); \
    const int lane = tid & 63, wave = __builtin_amdgcn_readfirstlane(tid >> 6); \
    const int gw = blk * NWAVES + wave, ngw = G * NWAVES, gtid = blk * NTHR + tid, nthr = G * NTHR; \
    GAS unsigned char* ws = (GAS unsigned char*)args.ws; asm volatile("" : "+s"(ws)); \
    LAS unsigned char* ring = (LAS unsigned char*)lds; \
    (void)lane; (void)wave; (void)gw; (void)ngw; (void)gtid; (void)nthr; (void)ring; \
    GAS float* X = (GAS float*)args.out; \
    GAS bf16* H = (GAS bf16*)(ws + WS_H); GAS bf16* P = (GAS bf16*)(ws + WS_P); GAS float* SM = (GAS float*)(ws + WS_SM); GAS bf16* XC = (GAS bf16*)(ws + WS_XC); \
    GAS float* CD = (GAS float*)(ws + WS_DT); GAS bf16* STB = (GAS bf16*)(ws + WS_ST); GAS bf16* Y = (GAS bf16*)(ws + WS_Y); \
    GAS float* SC = (GAS float*)(ws + WS_SC); GAS unsigned long long* MASKW = (GAS unsigned long long*)(ws + WS_IDX); GAS bf16* AO = (GAS bf16*)(ws + WS_AO); \
    GAS float* MG = (GAS float*)(ws + WS_MG); GAS bf16* MGB = (GAS bf16*)(ws + WS_MGB); GAS bf16* YMB = (GAS bf16*)(ws + WS_YM); GAS bf16* XB = (GAS bf16*)(ws + WS_YM + 32 * MiB); GAS bf16* U = (GAS bf16*)(ws + WS_U); \
    GAS bf16* ACT = (GAS bf16*)(ws + WS_ACT); GAS bf16* KIB = (GAS bf16*)(ws + WS_KIB); \
    (void)X; (void)H; (void)P; (void)SM; (void)XC; (void)CD; (void)STB; (void)Y; (void)SC; (void)MASKW; (void)AO; (void)MG; (void)MGB; (void)YMB; (void)XB; (void)U; (void)ACT; (void)KIB;

    if (IN(0)) { PH_BEGIN
        WPtrs wp{AIN(5), AIN(13), AIN(14), AIN(15), AIN(16), AIN(19)};
        REP(5) ph_weights(wp, ws, ring + wave * 10240, gw, ngw, lane);
        ph_resid_norm<true, false, false>(nullptr, nullptr, AIN(1), AIN(0), nullptr, nullptr, XB, H, gw, ngw, lane);
    }
    SEAM(0);

#pragma unroll 1
    for (int layer = 0; layer < DEPTH; ++layer) {
        const int pb = 1 + layer * NP;
#define WL (ws + WS_W + (size_t)layer * WL_SIZE)
        if (IN(pb + 0)) { PH_BEGIN
            { pg8::Gemm g{H, (const GAS bf16*)(WL + WL_IN), M, NMAIN, D}; pg8::StaticOrder S; S.init(M, NMAIN, G, blk);
              pg8::EpiIn E{P, NMAIN, AIN(6) + (size_t)layer * 2 * D, PG / 256};
              REP(1) { pg8::gemm_phase<pg8::EpiIn, pg8::StaticOrder, true, true>(ring, g, S, E); __syncthreads(); } }
            REP(2) { ph_small_proj(H, (const GAS bf16*)(WL + WL_IN) + (size_t)NMAIN * D, SM, KIB, ring, blk, G, tid); __syncthreads(); }
        }
        SEAM(pb + 0);
        if (IN(pb + 1)) { PH_BEGIN
            REP(20) { ph_ssd_states(P, SM, AIN(7) + (size_t)layer * 4 * CONVD, AIN(8) + (size_t)layer * CONVD, AIN(9) + layer * NH, AIN(10) + layer * NH, XC, STB, CD, ring, blk, G, tid); __syncthreads(); }
            REP(21) { ph_index_scores(P, SM, KIB, SC, ring, blk, G, tid); __syncthreads(); } }
        SEAM(pb + 1);
        if (IN(pb + 2)) { PH_BEGIN
            ph_ssd_scan(STB, CD, gtid, nthr); REP(30) ph_topk(SC, MASKW, ring + wave * 9728, gw, ngw, lane);
#if PROBE_DOUBLE == 31
            ph_ssd_scan((GAS bf16*)U, CD, gtid, nthr);
#endif
            }
        SEAM(pb + 2);
        if (IN(pb + 3)) { PH_BEGIN
            if (layer >= F8_OUT) { ph_ssd_out<true>(P, SM, XC, AIN(9) + layer * NH, AIN(10) + layer * NH, STB, AIN(11) + layer * NH, AIN(12) + (size_t)layer * DI, Y, ring, blk, G, tid); __syncthreads();
                ph_attn_dense<16>(P, MASKW, AO, ring, blk, G, tid); __syncthreads(); }
            else { REP(40) { ph_ssd_out<false>(P, SM, XC, AIN(9) + layer * NH, AIN(10) + layer * NH, STB, AIN(11) + layer * NH, AIN(12) + (size_t)layer * DI, Y, ring, blk, G, tid); __syncthreads(); }
                REP(41) { ph_attn_dense<0>(P, MASKW, AO, ring, blk, G, tid); __syncthreads(); } }
            }
        SEAM(pb + 3);
        if (IN(pb + 4)) {
            { PH_BEGIN
              pg8::StaticOrder S; S.init(M, D, G, blk); pg8::EpiGateMul E{MGB, D, P + PG, NMAIN};
              if (layer >= F8_OUT) { pg8::Gemm g{Y, (const GAS bf16*)(WL + WL_SSM), M, D, DI / 2, 0x7f7f7f7f, 0x79797979}; pg8::gemm_phase<pg8::EpiGateMul, pg8::StaticOrder, false, true, true>(ring, g, S, E); }
              else { pg8::Gemm g{Y, (const GAS bf16*)(WL + WL_SSM), M, D, DI}; pg8::gemm_phase<pg8::EpiGateMul, pg8::StaticOrder, false, true>(ring, g, S, E); } }
            __syncthreads();
            { PH_BEGIN
              pg8::StaticOrder S; S.init(M, D, G, blk); pg8::EpiGateAdd E{MGB, D, P + PG + D, NMAIN, layer >= F8_MIX ? (GAS unsigned char*)MG : nullptr};
              if (layer >= F8_OUT) { pg8::Gemm g{AO, (const GAS bf16*)(WL + WL_ATT), M, D, D / 2, 0x7f7f7f7f, 0x79797979}; pg8::gemm_phase<pg8::EpiGateAdd, pg8::StaticOrder, false, true, true>(ring, g, S, E); }
              else { pg8::Gemm g{AO, (const GAS bf16*)(WL + WL_ATT), M, D, D}; pg8::gemm_phase<pg8::EpiGateAdd, pg8::StaticOrder, false, true>(ring, g, S, E); } }
        }
        SEAM(pb + 4);
        if (IN(pb + 5)) { PH_BEGIN
            pg8::StaticOrder S; S.init(M, D, G, blk); pg8::EpiBf16<0> E{YMB, D, nullptr, 0, 0, 1.f};
            if (layer >= F8_MIX) { pg8::Gemm g{(const GAS bf16*)MG, (const GAS bf16*)(WL + WL_MIX), M, D, D / 2, 0x7f7f7f7f, 0x79797979}; pg8::gemm_phase<pg8::EpiBf16<0>, pg8::StaticOrder, false, true, true>(ring, g, S, E); }
            else { pg8::Gemm g{MGB, (const GAS bf16*)(WL + WL_MIX), M, D, D}; REP(60) { pg8::gemm_phase<pg8::EpiBf16<0>, pg8::StaticOrder, false, true>(ring, g, S, E); __syncthreads(); } } }
        SEAM(pb + 5);
        if (IN(pb + 6)) { PH_BEGIN
            if (layer >= F8_UP) ph_resid_norm<false, true, false, true>(YMB, AIN(2) + (size_t)layer * D, AIN(3) + (size_t)layer * D, nullptr, XB, nullptr, XB, H, gw, ngw, lane);
            else ph_resid_norm<false, true, false>(YMB, AIN(2) + (size_t)layer * D, AIN(3) + (size_t)layer * D, nullptr, XB, nullptr, XB, H, gw, ngw, lane); }
        SEAM(pb + 6);
        if (IN(pb + 7)) { PH_BEGIN
            pg8::StaticOrder S; S.init(M, FF2, G, blk); pg8::EpiBf16<0> E{U, FF2, nullptr, 0, 0, 1.f};
            if (layer >= F8_UP) { pg8::Gemm g{H, (const GAS bf16*)(WL + WL_UP), M, FF2, D / 2, 0x7f7f7f7f, 0x79797979}; pg8::gemm_phase<pg8::EpiBf16<0>, pg8::StaticOrder, true, true, true>(ring, g, S, E); }
            else { pg8::Gemm g{H, (const GAS bf16*)(WL + WL_UP), M, FF2, D}; REP(80) { pg8::gemm_phase<pg8::EpiBf16<0>, pg8::StaticOrder, true, true>(ring, g, S, E); __syncthreads(); } } }
        SEAM(pb + 7);
        if (IN(pb + 8)) { PH_BEGIN
            if (layer >= F8_DN) ph_ffn_act<true>(U, AIN(17) + (size_t)layer * 3 * FF2, AIN(18) + (size_t)layer * FF2, ACT, gtid, nthr);
            else REP(90) ph_ffn_act<false>(U, AIN(17) + (size_t)layer * 3 * FF2, AIN(18) + (size_t)layer * FF2, ACT, gtid, nthr); }
        SEAM(pb + 8);
        if (IN(pb + 9)) { PH_BEGIN
            pg8::StaticOrder S; S.init(M, D, G, blk); pg8::EpiBf16<0> E{YMB, D, nullptr, 0, 0, 1.f};
            if (layer >= F8_DN) { pg8::Gemm g{ACT, (const GAS bf16*)(WL + WL_DN), M, D, FF / 2, 0x7f7f7f7f, 0x79797979}; pg8::gemm_phase<pg8::EpiBf16<0>, pg8::StaticOrder, false, true, true>(ring, g, S, E); }
            else { pg8::Gemm g{ACT, (const GAS bf16*)(WL + WL_DN), M, D, FF}; REP(100) { pg8::gemm_phase<pg8::EpiBf16<0>, pg8::StaticOrder, false, true>(ring, g, S, E); __syncthreads(); } } }
        SEAM(pb + 9);
        if (IN(pb + 10)) { PH_BEGIN
            if (layer + 1 < DEPTH) ph_resid_norm<false, true, false>(YMB, AIN(4) + (size_t)layer * D, AIN(1) + (size_t)(layer + 1) * D, nullptr, XB, nullptr, XB, H, gw, ngw, lane);
            else ph_resid_norm<false, true, true>(YMB, AIN(4) + (size_t)layer * D, nullptr, nullptr, XB, X, nullptr, H, gw, ngw, lane); }
        SEAM(pb + 10);
    }
#undef IN
#undef SEAM
#undef WL
#undef PH_BEGIN
}

extern "C" void kernel_launch(void* const* d_in, const int* in_sizes, int n_in, void* d_out, int out_size, void* d_ws, size_t ws_size, hipStream_t stream) {
    static int grid = 0;
    if (grid == 0) {
        if (n_in != 20 || in_sizes[0] != M * D || out_size != M * D || ws_size < WS_END) { fprintf(stderr, "kernel_launch: unexpected shapes (n_in %d, in0 %d, out %d, ws %zu < %zu)\n", n_in, n_in > 0 ? in_sizes[0] : -1, out_size, ws_size, (size_t)WS_END); grid = -1; return; }
        int dev = 0, cus = 0, per_cu = 0;
        if (hipGetDevice(&dev) != hipSuccess || hipDeviceGetAttribute(&cus, hipDeviceAttributeMultiprocessorCount, dev) != hipSuccess) { grid = -1; return; }
        if (hipFuncSetAttribute((const void*)fwd, hipFuncAttributeMaxDynamicSharedMemorySize, LDS_BYTES) != hipSuccess) { fprintf(stderr, "kernel_launch: hipFuncSetAttribute failed\n"); grid = -1; return; }
        if (hipOccupancyMaxActiveBlocksPerMultiprocessor(&per_cu, (const void*)fwd, NTHR, LDS_BYTES) != hipSuccess || per_cu < 1) fprintf(stderr, "kernel_launch: occupancy query reports %d blocks per CU\n", per_cu);
        (void)hipGetLastError();
        grid = cus;
    }
    if (grid < 0) return;
    if (hipMemsetAsync((char*)d_ws + WS_CTL, 0, CTL_ZERO_BYTES, stream) != hipSuccess) return;
    Args a{};
    for (int i = 0; i < 20; ++i) a.in[i] = (const float*)d_in[i];
    a.out = (float*)d_out; a.ws = (unsigned char*)d_ws;
#if MK_PER_PHASE
    for (int ph = 0; ph < NPHASE; ++ph) { a.ph_lo = ph; a.ph_hi = ph + 1; hipLaunchKernelGGL(fwd, dim3(grid), dim3(NTHR), LDS_BYTES, stream, a); }
#else
    a.ph_lo = 0; a.ph_hi = NPHASE; hipLaunchKernelGGL(fwd, dim3(grid), dim3(NTHR), LDS_BYTES, stream, a);
#endif
}
```

```cpp
#include <hip/hip_runtime.h>
#include <cstdio>
#include <cstdint>
#define MK_PER_PHASE 0
namespace pg8 {
#define PG8_LAS __attribute__((address_space(3)))
#define PG8_GAS __attribute__((address_space(1)))
typedef unsigned short bf16_t;
typedef short bf16x8 __attribute__((ext_vector_type(8)));
typedef float f32x4 __attribute__((ext_vector_type(4)));
typedef unsigned u32x4 __attribute__((ext_vector_type(4)));
constexpr int BM = 256, BK = 64, HALF = 128, HTB = HALF * BK * 2  , STAGE_BYTES = 8 * HTB, NXCD = 8, WGM = 8;

__host__ __device__ __forceinline__ int lds_byte(int r, int c) { const int st = (r >> 4) * 2 + (c >> 5), rr = r & 15, cc = c & 31, ob = rr * 64 + cc * 2; return st * 1024 + (ob ^ (((ob >> 9) & 1) << 5)); }
__host__ __device__ __forceinline__ void stage_rc(int b, int& R, int& C) { const int st = b / 1024, sb = b % 1024, swz = sb ^ (((sb >> 9) & 1) << 5); R = (st >> 1) * 16 + swz / 64; C = (st & 1) * 32 + (swz % 64) / 2; }
__host__ __device__ __forceinline__ int perm32(int rho) { const int n = rho >> 4, i = rho & 15; return 8 * (i >> 2) + 4 * n + (i & 3); }

struct Unit { int pm, pn; };
struct Gemm { const PG8_GAS bf16_t* A; const PG8_GAS bf16_t* Bt; int M, N, K; int sa, sb; };

struct StaticOrder {
    int nM, nN, nwg, G, c;
    __host__ __device__ void init(int M, int N, int G_, int c_) { nM = M / BM; nN = N / BM; nwg = nM * nN; G = G_; c = c_; }
    __host__ __device__ bool next(int i, Unit& u) const {
        const long L = (long)i * G + c; if (L >= nwg) return false;
        int wgid = (int)L; { const int q = nwg / NXCD, r = nwg % NXCD, xcd = wgid % NXCD, off = wgid / NXCD; wgid = (xcd < r ? xcd * (q + 1) : r * (q + 1) + (xcd - r) * q) + off; }
        const int nig = WGM * nN, gid = wgid / nig, fm = gid * WGM, gsz = (nM - fm) < WGM ? (nM - fm) : WGM;
        u.pm = fm + ((wgid % nig) % gsz); u.pn = (wgid % nig) / gsz; return true;
    }
    __device__ __forceinline__ void a_ready(const Unit&) const {}
    __device__ __forceinline__ void done(const Unit&) const {}
};

__device__ __forceinline__ unsigned cvt_pk_bf16(float lo, float hi) { unsigned r; asm volatile("v_cvt_pk_bf16_f32 %0, %1, %2" : "=v"(r) : "v"(lo), "v"(hi)); return r; }
typedef float f32x2 __attribute__((ext_vector_type(2)));
__device__ __forceinline__ f32x2 gelu_pk(f32x2 v) {
    const f32x2 av = __builtin_elementwise_abs(v), d = av * 0.2316418882f + 1.0f;
    f32x2 t; t.x = __builtin_amdgcn_rcpf(d.x); t.y = __builtin_amdgcn_rcpf(d.y);
    f32x2 q = t * 0.5307027145f + (-0.7265760135f); q = q * t + 0.7107068705f; q = q * t + (-0.142248368f); q = q * t + 0.127414796f; q = q * t;
    const f32x2 s = (v * v) * (-0.72134752044f);
    f32x2 e; e.x = __builtin_amdgcn_exp2f(s.x); e.y = __builtin_amdgcn_exp2f(s.y);
    const f32x2 m = v * (q * e), r = v - m;
    f32x2 o; o.x = v.x < 0.f ? m.x : r.x; o.y = v.y < 0.f ? m.y : r.y; return o;
}

template <int ACT  > struct EpiBf16 {
    static constexpr bool PERM = true, AFTER_DRAIN = false; static_assert(ACT == 0 || ACT == 1, "EpiBf16: ACT is 0 (none) or 1 (gelu_pk)");
    PG8_GAS bf16_t* O; int ldc; const PG8_GAS float* bias; int split_cols; size_t split_stride; float scale0;
    __device__ __forceinline__ void operator()(const f32x4 (&acc)[2][2][4][2], const Unit& u, int wr, int wc, int fr, int fq) const {
        const int row0 = u.pm * BM + wr * 64 + fr; int colt = u.pn * BM; PG8_GAS bf16_t* base = O;
        float sc = 1.f; if (split_cols) { const int t = colt / split_cols; base += (size_t)t * split_stride; colt -= t * split_cols; if (t == 0) sc = scale0; }
        const int col0 = colt + wc * 32 + 8 * fq, bcol0 = u.pn * BM + wc * 32 + 8 * fq;
        f32x4 bv[2][2];
#pragma unroll
        for (int bj = 0; bj < 2; ++bj)
#pragma unroll
            for (int n = 0; n < 2; ++n) bv[bj][n] = bias ? *(const PG8_GAS f32x4*)(bias + bcol0 + bj * HALF + 4 * n) : (f32x4){0.f, 0.f, 0.f, 0.f};
#pragma unroll
        for (int ai = 0; ai < 2; ++ai)
#pragma unroll
            for (int m = 0; m < 4; ++m) { PG8_GAS bf16_t* rowp = base + (size_t)(row0 + ai * HALF + m * 16) * ldc + col0;
#pragma unroll
                for (int bj = 0; bj < 2; ++bj) { f32x4 v0 = acc[ai][bj][m][0] + bv[bj][0], v1 = acc[ai][bj][m][1] + bv[bj][1];
                    if (ACT == 1) { f32x2 a = gelu_pk((f32x2){v0[0], v0[1]}), b = gelu_pk((f32x2){v0[2], v0[3]}), c = gelu_pk((f32x2){v1[0], v1[1]}), d = gelu_pk((f32x2){v1[2], v1[3]});
                        v0 = (f32x4){a.x, a.y, b.x, b.y}; v1 = (f32x4){c.x, c.y, d.x, d.y}; }
                    v0 = v0 * sc; v1 = v1 * sc; u32x4 w; w.x = cvt_pk_bf16(v0[0], v0[1]); w.y = cvt_pk_bf16(v0[2], v0[3]); w.z = cvt_pk_bf16(v1[0], v1[1]); w.w = cvt_pk_bf16(v1[2], v1[3]);
                    *(PG8_GAS u32x4*)(rowp + bj * HALF) = w; } }
    }
};

struct EpiF32 {
    static constexpr bool PERM = false, AFTER_DRAIN = false;
    PG8_GAS float* C; int ldc;
    __device__ __forceinline__ void operator()(const f32x4 (&acc)[2][2][4][2], const Unit& u, int wr, int wc, int fr, int fq) const {
        const int row0 = u.pm * BM + wr * 64 + fr, col0 = u.pn * BM + wc * 32 + 4 * fq;
#pragma unroll
        for (int ai = 0; ai < 2; ++ai)
#pragma unroll
            for (int m = 0; m < 4; ++m) { PG8_GAS float* rowp = C + (size_t)(row0 + ai * HALF + m * 16) * ldc + col0;
#pragma unroll
                for (int bj = 0; bj < 2; ++bj)
#pragma unroll
                    for (int n = 0; n < 2; ++n) *(PG8_GAS f32x4*)(rowp + bj * HALF + n * 16) = acc[ai][bj][m][n]; }
    }
};
__device__ __forceinline__ float bf_lo(unsigned w) { return __uint_as_float(w << 16); }
__device__ __forceinline__ float bf_hi(unsigned w) { return __uint_as_float(w & 0xffff0000u); }
__device__ __forceinline__ float sigmoidf_(float x) { return __builtin_amdgcn_rcpf(1.0f + __expf(-x)); }
struct EpiIn {
    static constexpr bool PERM = true, AFTER_DRAIN = false;
    PG8_GAS bf16_t* P; int ldp; const PG8_GAS float* bgate; int gate_tile0, tile0;
    __device__ __forceinline__ void operator()(const f32x4 (&acc)[2][2][4][2], const Unit& u, int wr, int wc, int fr, int fq) const {
        const int pn = u.pn + tile0, row0 = u.pm * BM + wr * 64 + fr, colt = pn * BM + wc * 32 + 8 * fq;
        {
            const bool gate = pn >= gate_tile0 && pn < gate_tile0 + 16;
            f32x4 bv[2][2];
#pragma unroll
            for (int bj = 0; bj < 2; ++bj)
#pragma unroll
                for (int n = 0; n < 2; ++n) bv[bj][n] = gate ? *(const PG8_GAS f32x4*)(bgate + (colt - gate_tile0 * BM) + bj * HALF + 4 * n) : (f32x4){0.f, 0.f, 0.f, 0.f};
#pragma unroll
            for (int ai = 0; ai < 2; ++ai)
#pragma unroll
                for (int m = 0; m < 4; ++m) { PG8_GAS bf16_t* rowp = P + (size_t)(row0 + ai * HALF + m * 16) * ldp + colt;
#pragma unroll
                    for (int bj = 0; bj < 2; ++bj) { f32x4 v0 = acc[ai][bj][m][0] + bv[bj][0], v1 = acc[ai][bj][m][1] + bv[bj][1];
                        if (gate) {
#pragma unroll
                            for (int j = 0; j < 4; ++j) { v0[j] = sigmoidf_(v0[j]); v1[j] = sigmoidf_(v1[j]); } }
                        u32x4 w; w.x = cvt_pk_bf16(v0[0], v0[1]); w.y = cvt_pk_bf16(v0[2], v0[3]); w.z = cvt_pk_bf16(v1[0], v1[1]); w.w = cvt_pk_bf16(v1[2], v1[3]);
                        *(PG8_GAS u32x4*)(rowp + bj * HALF) = w; } }
        }
    }
};
struct EpiGateMul {
    static constexpr bool PERM = true, AFTER_DRAIN = false;
    PG8_GAS bf16_t* O; int ldc; const PG8_GAS bf16_t* G; int ldg;
    __device__ __forceinline__ void operator()(const f32x4 (&acc)[2][2][4][2], const Unit& u, int wr, int wc, int fr, int fq) const {
        const int row0 = u.pm * BM + wr * 64 + fr, colt = u.pn * BM + wc * 32 + 8 * fq;
#pragma unroll
        for (int ai = 0; ai < 2; ++ai)
#pragma unroll
            for (int m = 0; m < 4; ++m) { const size_t row = (size_t)(row0 + ai * HALF + m * 16);
#pragma unroll
                for (int bj = 0; bj < 2; ++bj) { const u32x4 g = *(const PG8_GAS u32x4*)(G + row * ldg + colt + bj * HALF);
                    const f32x4 a0 = acc[ai][bj][m][0], a1 = acc[ai][bj][m][1];
                    u32x4 w; w.x = cvt_pk_bf16(a0[0] * bf_lo(g.x), a0[1] * bf_hi(g.x)); w.y = cvt_pk_bf16(a0[2] * bf_lo(g.y), a0[3] * bf_hi(g.y));
                    w.z = cvt_pk_bf16(a1[0] * bf_lo(g.z), a1[1] * bf_hi(g.z)); w.w = cvt_pk_bf16(a1[2] * bf_lo(g.w), a1[3] * bf_hi(g.w));
                    *(PG8_GAS u32x4*)(O + row * ldc + colt + bj * HALF) = w; } }
    }
};
struct EpiGateAdd {
    static constexpr bool PERM = true, AFTER_DRAIN = false;
    PG8_GAS bf16_t* O; int ldc; const PG8_GAS bf16_t* G; int ldg; PG8_GAS unsigned char* O8;
    __device__ __forceinline__ void operator()(const f32x4 (&acc)[2][2][4][2], const Unit& u, int wr, int wc, int fr, int fq) const {
        const int row0 = u.pm * BM + wr * 64 + fr, colt = u.pn * BM + wc * 32 + 8 * fq;
#pragma unroll
        for (int ai = 0; ai < 2; ++ai)
#pragma unroll
            for (int m = 0; m < 4; ++m) { const size_t row = (size_t)(row0 + ai * HALF + m * 16);
#pragma unroll
                for (int bj = 0; bj < 2; ++bj) { const u32x4 g = *(const PG8_GAS u32x4*)(G + row * ldg + colt + bj * HALF);
                    PG8_GAS u32x4* op = (PG8_GAS u32x4*)(O + row * ldc + colt + bj * HALF); const u32x4 p = *op;
                    const f32x4 a0 = acc[ai][bj][m][0], a1 = acc[ai][bj][m][1];
                    const float s0 = bf_lo(p.x) + a0[0] * bf_lo(g.x), s1 = bf_hi(p.x) + a0[1] * bf_hi(g.x), s2 = bf_lo(p.y) + a0[2] * bf_lo(g.y), s3 = bf_hi(p.y) + a0[3] * bf_hi(g.y);
                    const float s4 = bf_lo(p.z) + a1[0] * bf_lo(g.z), s5 = bf_hi(p.z) + a1[1] * bf_hi(g.z), s6 = bf_lo(p.w) + a1[2] * bf_lo(g.w), s7 = bf_hi(p.w) + a1[3] * bf_hi(g.w);
                    if (O8) { int lo = 0, hi = 0; lo = __builtin_amdgcn_cvt_pk_fp8_f32(s0, s1, lo, false); lo = __builtin_amdgcn_cvt_pk_fp8_f32(s2, s3, lo, true); hi = __builtin_amdgcn_cvt_pk_fp8_f32(s4, s5, hi, false); hi = __builtin_amdgcn_cvt_pk_fp8_f32(s6, s7, hi, true);
                        typedef unsigned u32x2e __attribute__((ext_vector_type(2))); u32x2e w8; w8.x = (unsigned)lo; w8.y = (unsigned)hi; *(PG8_GAS u32x2e*)(O8 + row * ldc + colt + bj * HALF) = w8; }
                    else { u32x4 w; w.x = cvt_pk_bf16(s0, s1); w.y = cvt_pk_bf16(s2, s3); w.z = cvt_pk_bf16(s4, s5); w.w = cvt_pk_bf16(s6, s7); *op = w; } } }
    }
};
template <class Epi, class Sched, bool ALIGN_EPI = false, bool SP2 = false, bool FP8 = false>
__device__ __forceinline__ void gemm_phase(PG8_LAS unsigned char* lds, const Gemm g, const Sched& S, const Epi& E) {
    int tid = threadIdx.x; asm volatile("" : "+v"(tid));
    const int wid = __builtin_amdgcn_readfirstlane(tid >> 6), lane = tid & 63, wr = wid >> 2, wc = wid & 3, fr = lane & 15, fq = lane >> 4;
    const int K = g.K, nt = K / BK;
    unsigned voffA[2], voffB[2];
#pragma unroll
    for (int i = 0; i < 2; ++i) { int R, C; stage_rc(tid * 16 + i * 8192, R, C); const int Rb = Epi::PERM ? ((R & ~31) + perm32(R & 31)) : R;
        voffA[i] = (unsigned)(R * K + C) * 2u; voffB[i] = (unsigned)(Rb * K + C) * 2u; }
    const size_t kstep = (size_t)(BK * 2);
    const size_t hstep = (size_t)HALF * K * 2;
    const size_t tstep = 2 * hstep;
    const unsigned ldsw = (unsigned)wid * 1024u;
    const int aoff = lds_byte(wr * 64 + fr, fq * 8), boff = lds_byte(wc * 32 + fr, fq * 8);
#define PG8_SA(b, h) (((b) * 2 + (h)) * HTB)
#define PG8_SB(b, h) ((4 + (b) * 2 + (h)) * HTB)
#define PG8_STAGE(bufoff, gbase, voff) do { _Pragma("unroll") for (int _i = 0; _i < 2; ++_i) \
        __builtin_amdgcn_global_load_lds((const PG8_GAS unsigned*)((const PG8_GAS char*)(gbase) + (voff)[_i]), (PG8_LAS unsigned*)(lds + (bufoff) + ldsw + _i * 8192), 16, 0, 0); } while (0)
typedef int pg8_v4i __attribute__((ext_vector_type(4))); typedef int pg8_v8i __attribute__((ext_vector_type(8)));
#define PG8_CAT(x, y) __builtin_shufflevector(__builtin_bit_cast(pg8_v4i, (x)), __builtin_bit_cast(pg8_v4i, (y)), 0, 1, 2, 3, 4, 5, 6, 7)
#define PG8_LDA(dst, b, h) do { if constexpr (FP8) { _Pragma("unroll") for (int m = 0; m < 4; ++m) dst##8[m] = PG8_CAT(*(const PG8_LAS bf16x8*)(lds + PG8_SA(b, h) + aoff + m * 2048), *(const PG8_LAS bf16x8*)(lds + PG8_SA(b, h) + aoff + m * 2048 + 1024)); } \
        else { _Pragma("unroll") for (int m = 0; m < 4; ++m) _Pragma("unroll") for (int k = 0; k < 2; ++k) dst[m][k] = *(const PG8_LAS bf16x8*)(lds + PG8_SA(b, h) + aoff + m * 2048 + k * 1024); } } while (0)
#define PG8_LDB(dst, b, h) do { if constexpr (FP8) { _Pragma("unroll") for (int n = 0; n < 2; ++n) dst##8[n] = PG8_CAT(*(const PG8_LAS bf16x8*)(lds + PG8_SB(b, h) + boff + n * 2048), *(const PG8_LAS bf16x8*)(lds + PG8_SB(b, h) + boff + n * 2048 + 1024)); } \
        else { _Pragma("unroll") for (int n = 0; n < 2; ++n) _Pragma("unroll") for (int k = 0; k < 2; ++k) dst[n][k] = *(const PG8_LAS bf16x8*)(lds + PG8_SB(b, h) + boff + n * 2048 + k * 1024); } } while (0)
#define PG8_MMA(ai, bj, At, Bt) do { __builtin_amdgcn_s_setprio(1); \
        if constexpr (FP8) { _Pragma("unroll") for (int m = 0; m < 4; ++m) _Pragma("unroll") for (int n = 0; n < 2; ++n) \
            asm volatile("v_mfma_scale_f32_16x16x128_f8f6f4 %0, %1, %2, %0, %3, %4 op_sel_hi:[0,0,0]" : "+v"(acc[ai][bj][m][n]) : "v"(Bt##8[n]), "v"(At##8[m]), "v"(sc_b), "v"(sc_a)); } \
        else { _Pragma("unroll") for (int m = 0; m < 4; ++m) _Pragma("unroll") for (int n = 0; n < 2; ++n) _Pragma("unroll") for (int k = 0; k < 2; ++k) \
            acc[ai][bj][m][n] = __builtin_amdgcn_mfma_f32_16x16x32_bf16(Bt[n][k], At[m][k], acc[ai][bj][m][n], 0, 0, 0); } \
        __builtin_amdgcn_s_setprio(0); } while (0)
#define PG8_WAIT_V(n) asm volatile("s_waitcnt vmcnt(" #n ")" ::: "memory")
#define PG8_WAIT_L(n) asm volatile("s_waitcnt lgkmcnt(" #n ")" ::: "memory")
#define PG8_BAR __builtin_amdgcn_s_barrier()
#define PG8_SCHED __builtin_amdgcn_sched_barrier(0)
    Unit cur, nxt; int ui = 0;
    if (!S.next(0, cur)) return;
    f32x4 acc[2][2][4][2];
#pragma unroll
    for (int a = 0; a < 2; ++a)
#pragma unroll
        for (int b = 0; b < 2; ++b)
#pragma unroll
            for (int m = 0; m < 4; ++m)
#pragma unroll
                for (int n = 0; n < 2; ++n) acc[a][b][m][n] = (f32x4){0.f, 0.f, 0.f, 0.f};
    const int sc_a = g.sa, sc_b = g.sb;
    bf16x8 At[4][2], B0[2][2], B1[2][2]; pg8_v8i At8[4], B08[2], B18[2];
    const PG8_GAS char* cA = (const PG8_GAS char*)g.A + (size_t)cur.pm * tstep; const PG8_GAS char* cB = (const PG8_GAS char*)g.Bt + (size_t)cur.pn * tstep;
    S.a_ready(cur);
    if constexpr (SP2) {
        PG8_STAGE(PG8_SB(0, 0), cB, voffB); PG8_STAGE(PG8_SB(0, 1), cB + hstep, voffB); PG8_STAGE(PG8_SA(0, 0), cA, voffA); PG8_STAGE(PG8_SA(0, 1), cA + hstep, voffA);
        if (wr == 1) PG8_BAR;
        PG8_WAIT_V(2); PG8_BAR;
        PG8_STAGE(PG8_SB(1, 0), cB + kstep, voffB); PG8_STAGE(PG8_SA(1, 0), cA + kstep, voffA); PG8_STAGE(PG8_SB(1, 1), cB + hstep + kstep, voffB);
        PG8_WAIT_V(6); PG8_BAR;
    } else {
        PG8_STAGE(PG8_SB(0, 0), cB, voffB); PG8_STAGE(PG8_SA(0, 0), cA, voffA); PG8_STAGE(PG8_SB(0, 1), cB + hstep, voffB); PG8_STAGE(PG8_SA(0, 1), cA + hstep, voffA);
        if (wr == 1) PG8_BAR;
        PG8_WAIT_V(4); PG8_BAR;
        PG8_STAGE(PG8_SB(1, 0), cB + kstep, voffB); PG8_STAGE(PG8_SA(1, 0), cA + kstep, voffA); PG8_STAGE(PG8_SB(1, 1), cB + hstep + kstep, voffB);
        PG8_WAIT_V(6); PG8_BAR;
    }
    for (;;) {
        const bool has_next = S.next(ui + 1, nxt);
        const PG8_GAS char* nA = has_next ? (const PG8_GAS char*)g.A + (size_t)nxt.pm * tstep : cA; const PG8_GAS char* nB = has_next ? (const PG8_GAS char*)g.Bt + (size_t)nxt.pn * tstep : cB;
        for (int t = 0; t < nt; t += 2) {
            const bool last = (t == nt - 2);
            const PG8_GAS char* a1 = cA + (size_t)(t + 1) * kstep;
            const PG8_GAS char* a2 = last ? nA : cA + (size_t)(t + 2) * kstep; const PG8_GAS char* b2 = last ? nB : cB + (size_t)(t + 2) * kstep;
            const PG8_GAS char* a3 = a2 + kstep; const PG8_GAS char* b3 = b2 + kstep;
            if (last && has_next) S.a_ready(nxt);
            if constexpr (SP2) {
            PG8_LDB(B0, 0, 0); PG8_LDB(B1, 0, 1); PG8_SCHED; PG8_LDA(At, 0, 0); PG8_STAGE(PG8_SA(1, 1), a1 + hstep, voffA);
            PG8_WAIT_V(8); PG8_WAIT_L(0); PG8_BAR; PG8_MMA(0, 0, At, B0); PG8_MMA(0, 1, At, B1); PG8_BAR; PG8_SCHED;
            PG8_LDA(At, 0, 1); PG8_STAGE(PG8_SB(0, 0), b2, voffB); PG8_STAGE(PG8_SB(0, 1), b2 + hstep, voffB); PG8_STAGE(PG8_SA(0, 0), a2, voffA);
            PG8_WAIT_V(8); PG8_WAIT_L(0); PG8_BAR; PG8_MMA(1, 0, At, B0); PG8_MMA(1, 1, At, B1); PG8_BAR; PG8_SCHED;
            PG8_LDB(B0, 1, 0); PG8_LDB(B1, 1, 1); PG8_SCHED; PG8_LDA(At, 1, 0); PG8_STAGE(PG8_SA(0, 1), a2 + hstep, voffA);
            PG8_WAIT_V(8); PG8_WAIT_L(0); PG8_BAR; PG8_MMA(0, 0, At, B0); PG8_MMA(0, 1, At, B1); PG8_BAR; PG8_SCHED;
            PG8_LDA(At, 1, 1); PG8_STAGE(PG8_SB(1, 0), b3, voffB); PG8_STAGE(PG8_SB(1, 1), b3 + hstep, voffB); PG8_STAGE(PG8_SA(1, 0), a3, voffA);
            PG8_WAIT_V(8); PG8_WAIT_L(0); PG8_BAR; PG8_MMA(1, 0, At, B0); PG8_MMA(1, 1, At, B1); PG8_BAR; PG8_SCHED;
            } else {
            PG8_LDB(B0, 0, 0); PG8_SCHED; PG8_LDA(At, 0, 0); PG8_STAGE(PG8_SA(1, 1), a1 + hstep, voffA);
            PG8_WAIT_L(8); PG8_BAR; PG8_WAIT_L(0); PG8_MMA(0, 0, At, B0); PG8_BAR; PG8_SCHED;
            PG8_LDB(B1, 0, 1); PG8_STAGE(PG8_SB(0, 0), b2, voffB);
            PG8_BAR; PG8_WAIT_L(0); PG8_MMA(0, 1, At, B1); PG8_BAR;
            PG8_LDA(At, 0, 1); PG8_STAGE(PG8_SA(0, 0), a2, voffA);
            PG8_BAR; PG8_WAIT_L(0); PG8_MMA(1, 0, At, B0); PG8_BAR; PG8_SCHED;
            PG8_STAGE(PG8_SB(0, 1), b2 + hstep, voffB);
            PG8_WAIT_V(6); PG8_BAR; PG8_MMA(1, 1, At, B1); PG8_BAR;
            PG8_LDB(B0, 1, 0); PG8_SCHED; PG8_LDA(At, 1, 0); PG8_STAGE(PG8_SA(0, 1), a2 + hstep, voffA);
            PG8_WAIT_L(8); PG8_BAR; PG8_WAIT_L(0); PG8_MMA(0, 0, At, B0); PG8_BAR; PG8_SCHED;
            PG8_LDB(B1, 1, 1); PG8_STAGE(PG8_SB(1, 0), b3, voffB);
            PG8_BAR; PG8_WAIT_L(0); PG8_MMA(0, 1, At, B1); PG8_BAR;
            PG8_LDA(At, 1, 1); PG8_STAGE(PG8_SA(1, 0), a3, voffA);
            PG8_BAR; PG8_WAIT_L(0); PG8_MMA(1, 0, At, B0); PG8_BAR; PG8_SCHED;
            PG8_STAGE(PG8_SB(1, 1), b3 + hstep, voffB);
            PG8_WAIT_V(6); PG8_BAR; PG8_MMA(1, 1, At, B1); PG8_BAR;
            }
        }
        if constexpr (FP8) asm volatile("s_nop 15\n\ts_nop 15" ::: "memory");
        if constexpr (ALIGN_EPI) { if (wr == 0) PG8_BAR; }
        if constexpr (!Epi::AFTER_DRAIN) { E(acc, cur, wr, wc, fr, fq); S.done(cur); }
        if (!has_next) break;
#pragma unroll
        for (int a = 0; a < 2; ++a)
#pragma unroll
            for (int b = 0; b < 2; ++b)
#pragma unroll
                for (int m = 0; m < 4; ++m)
#pragma unroll
                    for (int n = 0; n < 2; ++n) acc[a][b][m][n] = (f32x4){0.f, 0.f, 0.f, 0.f};
        cur = nxt; cA = nA; cB = nB; ++ui;
        if constexpr (ALIGN_EPI) { if (wr == 1) PG8_BAR; }
    }
    PG8_WAIT_V(0);
    if constexpr (!ALIGN_EPI) { if (wr == 0) PG8_BAR; }
    PG8_BAR;
    if constexpr (Epi::AFTER_DRAIN) { E.fused(acc, cur, wr, wc, fr, fq, lds, wid, lane); S.done(cur); }
#undef PG8_SA
#undef PG8_SB
#undef PG8_STAGE
#undef PG8_LDA
#undef PG8_LDB
#undef PG8_MMA
#undef PG8_WAIT_V
#undef PG8_WAIT_L
#undef PG8_BAR
#undef PG8_SCHED
}
}

#ifndef MK_PER_PHASE
#define MK_PER_PHASE 0
#endif
#ifndef PROBE_DOUBLE
#define PROBE_DOUBLE -1
#endif
#define REP(id) for (int rep_ = 0; rep_ < ((PROBE_DOUBLE == (id)) ? 2 : 1); ++rep_)
constexpr int NWAVES = 8, NTHR = 512;
constexpr int BATCH = 2, SEQ = 4096, M = BATCH * SEQ, D = 2048, DEPTH = 4;
constexpr int DI = 4096, NH = 64, HP = 64, NG = 8, HPG = 8, NS = 128, CONVD = 6144;
constexpr int QH = 16, KVH = 4, AD = 128, IH = 16, IDD = 64, TOPK = 256;
constexpr int FF = 4096, FF2 = 8192;
constexpr int NIN = 18576, NMAIN = 18432, NPAD = 18688;
constexpr int PZ = 0, PXBC = 4096, PQ = 10240, PK = 12288, PV = 12800, PG = 13312, PQI = 17408;
constexpr int SMW = 256, SM_DT = 0, SM_KI = 64, SM_WI = 128;
constexpr float EPS = 1e-6f;
constexpr int F8_DN = DEPTH - 1, F8_UP = DEPTH - 1, F8_MIX = DEPTH - 1, F8_OUT = DEPTH - 1, F8_IN = DEPTH - 1;
constexpr float ATTN_SCALE = 0.08838834764831845f;

constexpr size_t MiB = 1u << 20;
constexpr size_t WS_CTL = 0, CTL_ZERO_BYTES = 1 * MiB;
constexpr size_t WS_W = 2 * MiB;
constexpr size_t WL_IN = 0, WL_SSM = 73 * MiB, WL_ATT = 89 * MiB, WL_MIX = 97 * MiB, WL_UP = 105 * MiB, WL_DN = 137 * MiB, WL_SIZE = 153 * MiB;
constexpr size_t WS_H = WS_W + DEPTH * WL_SIZE;
constexpr size_t WS_P = WS_H + 32 * MiB;
constexpr size_t WS_SM = WS_P + 288 * MiB;
constexpr size_t WS_XC = WS_SM + 8 * MiB;
constexpr size_t WS_DT = WS_XC + 96 * MiB;
constexpr size_t WS_ACS = WS_DT + 2 * MiB;
constexpr size_t WS_ST = WS_ACS + 2 * MiB;
constexpr size_t WS_Y = WS_ST + 256 * MiB;
constexpr size_t WS_SC = WS_Y + 64 * MiB;
constexpr size_t WS_IDX = WS_SC + 128 * MiB;
constexpr size_t WS_CNT = WS_IDX + 8 * MiB;
constexpr size_t WS_AO = WS_CNT + 1 * MiB;
constexpr size_t WS_MG = WS_AO + 32 * MiB;
constexpr size_t WS_MGB = WS_MG + 64 * MiB;
constexpr size_t WS_YM = WS_MGB + 32 * MiB;
constexpr size_t WS_U = WS_YM + 64 * MiB;
constexpr size_t WS_ACT = WS_U + 128 * MiB;
constexpr size_t WS_KIB = WS_ACT + 64 * MiB;
constexpr size_t WS_END = WS_KIB + 1 * MiB;
constexpr int CW_BAR = 4096;

constexpr int RING_BYTES = 139264, LDSCTL_OFF = RING_BYTES, MISC_OFF = LDSCTL_OFF + 320, LDS_BYTES = 147456;

#define LAS __attribute__((address_space(3)))
#define GAS __attribute__((address_space(1)))
typedef unsigned short bf16;
typedef float f32x4 __attribute__((ext_vector_type(4)));
typedef short bf16x8 __attribute__((ext_vector_type(8)));
typedef unsigned u32x4 __attribute__((ext_vector_type(4)));
typedef unsigned u32x2 __attribute__((ext_vector_type(2)));
#define LDS_WAIT() asm volatile("s_waitcnt lgkmcnt(0)" ::: "memory")

__device__ __forceinline__ unsigned f2bf(float f) { unsigned u = __builtin_bit_cast(unsigned, f); return (u + 0x7fffu + ((u >> 16) & 1u)) >> 16; }
__device__ __forceinline__ unsigned pk2(float lo, float hi) { return f2bf(lo) | (f2bf(hi) << 16); }
__device__ __forceinline__ unsigned cvtpk(float lo, float hi) { unsigned r; asm("v_cvt_pk_bf16_f32 %0, %1, %2" : "=v"(r) : "v"(lo), "v"(hi)); return r; }
__device__ __forceinline__ u32x2 pack8_fp8(const float (&f)[8]) { int lo = 0, hi = 0; lo = __builtin_amdgcn_cvt_pk_fp8_f32(f[0], f[1], lo, false); lo = __builtin_amdgcn_cvt_pk_fp8_f32(f[2], f[3], lo, true);
    hi = __builtin_amdgcn_cvt_pk_fp8_f32(f[4], f[5], hi, false); hi = __builtin_amdgcn_cvt_pk_fp8_f32(f[6], f[7], hi, true); u32x2 w; w.x = (unsigned)lo; w.y = (unsigned)hi; return w; }
__device__ __forceinline__ unsigned pack4_fp8(float a, float b, float c, float d) { int w = 0; w = __builtin_amdgcn_cvt_pk_fp8_f32(a, b, w, false); w = __builtin_amdgcn_cvt_pk_fp8_f32(c, d, w, true); return (unsigned)w; }
__device__ __forceinline__ float bflo(unsigned w) { return __uint_as_float(w << 16); }
__device__ __forceinline__ float bfhi(unsigned w) { return __uint_as_float(w & 0xffff0000u); }
__device__ __forceinline__ void unpack8(const u32x4 w, float (&f)[8]) { f[0] = bflo(w.x); f[1] = bfhi(w.x); f[2] = bflo(w.y); f[3] = bfhi(w.y); f[4] = bflo(w.z); f[5] = bfhi(w.z); f[6] = bflo(w.w); f[7] = bfhi(w.w); }
__device__ __forceinline__ u32x4 pack8(const float (&f)[8]) { u32x4 w; w.x = pk2(f[0], f[1]); w.y = pk2(f[2], f[3]); w.z = pk2(f[4], f[5]); w.w = pk2(f[6], f[7]); return w; }
__device__ __forceinline__ float wave_sum(float v) {
#pragma unroll
    for (int o = 1; o < 64; o <<= 1) v += __shfl_xor(v, o);
    return v;
}
__device__ __forceinline__ float wave_max(float v) {
#pragma unroll
    for (int o = 1; o < 64; o <<= 1) v = fmaxf(v, __shfl_xor(v, o));
    return v;
}
__device__ __forceinline__ float siluf_(float x) { return x / (1.0f + __expf(-x)); }
typedef short s16x4 __attribute__((ext_vector_type(4)));
__device__ __forceinline__ s16x4 lds_tr4(const LAS unsigned char* p) { return __builtin_bit_cast(s16x4, __builtin_amdgcn_ds_read_tr16_b64_v4i16((LAS s16x4*)p)); }

#define XB_TMO      128
#define XB_XCNT(j)  (256  + 64 * (j))
#define XB_XSUB(j)  (1280 + 64 * (j))
#define XB_XGEN(j)  (2304 + 64 * (j))
#define XB_TOP      3328
#define XB_TOPGEN   3392
#define XCD_BAR_WORDS 3456
#define XB_SPIN_CAP (1u << 18)

__device__ __forceinline__ unsigned xb_ld(unsigned* p)              { return __hip_atomic_load(p, __ATOMIC_RELAXED, __HIP_MEMORY_SCOPE_AGENT); }
__device__ __forceinline__ unsigned xb_add(unsigned* p, unsigned v) { return __hip_atomic_fetch_add(p, v, __ATOMIC_RELAXED, __HIP_MEMORY_SCOPE_AGENT); }
__device__ __forceinline__ unsigned xb_xcc_id() { return (unsigned)__builtin_amdgcn_s_getreg((3 << 11) | 20) & 0xFu; }
#define XB_SPIN(cond, bar) do { unsigned _sp = 0; while (cond) { __builtin_amdgcn_s_sleep(1); \
    if ((++_sp & 255u) == 0u) { if (xb_ld(&(bar)[XB_TMO])) break; if (_sp > XB_SPIN_CAP) { atomicAdd(&(bar)[XB_TMO], 1u); break; } } } } while (0)

struct XcdBarrier {
    unsigned* bar; unsigned x;
    volatile LAS unsigned* st;
};

__device__ __forceinline__ XcdBarrier xcd_barrier_post(unsigned* bar, volatile LAS unsigned* st) {
    XcdBarrier b; b.bar = bar; b.x = xb_xcc_id(); b.st = st;
    if (threadIdx.x == 0) (void)xb_add(&bar[XB_XCNT(b.x)], 1u);
    return b;
}
__device__ __forceinline__ void xcd_barrier_complete(unsigned* bar, unsigned x, unsigned& nloc, unsigned& nx) {
    const unsigned G = gridDim.x * gridDim.y * gridDim.z;
    unsigned sum, cnt, mine, sp = 0u;
    for (;;) {
        sum = 0u; cnt = 0u; mine = 0u;
#pragma unroll
        for (unsigned j = 0; j < 16; ++j) { const unsigned c = xb_ld(&bar[XB_XCNT(j)]); sum += c; cnt += (c > 0u) ? 1u : 0u; mine = (j == x) ? c : mine; }
        if (sum == G) break;
        __builtin_amdgcn_s_sleep(1);
        if ((++sp & 255u) == 0u) { if (xb_ld(&bar[XB_TMO])) break; if (sp > XB_SPIN_CAP) { atomicAdd(&bar[XB_TMO], 1u); break; } }
    }
    nloc = mine > 0u ? mine : 1u; nx = cnt > 0u ? cnt : 1u;
}

__device__ __forceinline__ void xcd_barrier(const XcdBarrier& b) {
    asm volatile("s_waitcnt vmcnt(0)" ::: "memory");
    __syncthreads();
    if (threadIdx.x == 0) {
        unsigned* bar = b.bar;
        __builtin_amdgcn_s_waitcnt(0);
        unsigned nloc = b.st[0], nx = b.st[1];
        if (nloc == 0u) { xcd_barrier_complete(bar, b.x, nloc, nx); b.st[0] = nloc; b.st[1] = nx; }
        const unsigned old = xb_add(&bar[XB_XSUB(b.x)], 1u);
        const unsigned gen = old / nloc;
        if (old + 1u == (gen + 1u) * nloc) {
            __builtin_amdgcn_fence(__ATOMIC_RELEASE, "agent");
            asm volatile("s_waitcnt vmcnt(0)" ::: "memory");
            const unsigned og = xb_add(&bar[XB_TOP], 1u);
            const unsigned tg = og / nx;
            if (og + 1u == (tg + 1u) * nx) xb_add(&bar[XB_TOPGEN], 1u);
            else XB_SPIN(xb_ld(&bar[XB_TOPGEN]) == tg, bar);
            __builtin_amdgcn_fence(__ATOMIC_ACQUIRE, "agent");
            xb_add(&bar[XB_XGEN(b.x)], 1u);
            asm volatile("s_waitcnt vmcnt(0)" ::: "memory");
        } else {
            XB_SPIN(xb_ld(&bar[XB_XGEN(b.x)]) == gen, bar);
            __builtin_amdgcn_fence(__ATOMIC_ACQUIRE, "agent");
            asm volatile("s_waitcnt vmcnt(0)" ::: "memory");
        }
    }
    __syncthreads();
}


template <bool XF32IN, bool HASY, bool XF32OUT, bool HF8 = false>
__device__ __forceinline__ void ph_resid_norm(const GAS bf16* Yb, const GAS float* gpost, const GAS float* gnext, const GAS float* Xf_in, const GAS bf16* Xb_in, GAS float* Xf_out, GAS bf16* Xb_out, GAS bf16* H, GAS unsigned char* H8,
                                              int gw, int ngw, int lane) {
    for (int m = gw; m < M; m += ngw) {
        float xv[4][8];
#pragma unroll
        for (int j = 0; j < 4; ++j) { const size_t e = (size_t)m * D + 8 * (lane + 64 * j);
            if (XF32IN) { const f32x4 a = *(const GAS f32x4*)(Xf_in + e), c = *(const GAS f32x4*)(Xf_in + e + 4); xv[j][0] = a.x; xv[j][1] = a.y; xv[j][2] = a.z; xv[j][3] = a.w; xv[j][4] = c.x; xv[j][5] = c.y; xv[j][6] = c.z; xv[j][7] = c.w; }
            else unpack8(*(const GAS u32x4*)(Xb_in + e), xv[j]); }
        if (HASY) {
            float yv[4][8]; float ss = 0.f;
#pragma unroll
            for (int j = 0; j < 4; ++j) { unpack8(*(const GAS u32x4*)(Yb + (size_t)m * D + 8 * (lane + 64 * j)), yv[j]);
#pragma unroll
                for (int i = 0; i < 8; ++i) ss += yv[j][i] * yv[j][i]; }
            const float rstd = rsqrtf(wave_sum(ss) * (1.0f / D) + EPS);
#pragma unroll
            for (int j = 0; j < 4; ++j) { const GAS float* gp = gpost + 8 * (lane + 64 * j); const f32x4 g0 = *(const GAS f32x4*)gp, g1 = *(const GAS f32x4*)(gp + 4);
                xv[j][0] += yv[j][0] * rstd * g0.x; xv[j][1] += yv[j][1] * rstd * g0.y; xv[j][2] += yv[j][2] * rstd * g0.z; xv[j][3] += yv[j][3] * rstd * g0.w;
                xv[j][4] += yv[j][4] * rstd * g1.x; xv[j][5] += yv[j][5] * rstd * g1.y; xv[j][6] += yv[j][6] * rstd * g1.z; xv[j][7] += yv[j][7] * rstd * g1.w; }
        }
#pragma unroll
        for (int j = 0; j < 4; ++j) { const size_t e = (size_t)m * D + 8 * (lane + 64 * j);
            if (XF32OUT) { *(GAS f32x4*)(Xf_out + e) = (f32x4){xv[j][0], xv[j][1], xv[j][2], xv[j][3]}; *(GAS f32x4*)(Xf_out + e + 4) = (f32x4){xv[j][4], xv[j][5], xv[j][6], xv[j][7]}; }
            else *(GAS u32x4*)(Xb_out + e) = pack8(xv[j]); }
        if (gnext) {
            float ss = 0.f;
#pragma unroll
            for (int j = 0; j < 4; ++j)
#pragma unroll
                for (int i = 0; i < 8; ++i) ss += xv[j][i] * xv[j][i];
            const float rstd = rsqrtf(wave_sum(ss) * (1.0f / D) + EPS);
#pragma unroll
            for (int j = 0; j < 4; ++j) { const GAS float* gp = gnext + 8 * (lane + 64 * j); const f32x4 g0 = *(const GAS f32x4*)gp, g1 = *(const GAS f32x4*)(gp + 4);
                float h[8] = {xv[j][0] * rstd * g0.x, xv[j][1] * rstd * g0.y, xv[j][2] * rstd * g0.z, xv[j][3] * rstd * g0.w, xv[j][4] * rstd * g1.x, xv[j][5] * rstd * g1.y, xv[j][6] * rstd * g1.z, xv[j][7] * rstd * g1.w};
                if (HF8) *(GAS u32x2*)((GAS unsigned char*)H + (size_t)m * D + 8 * (lane + 64 * j)) = pack8_fp8(h);
                else *(GAS u32x4*)(H + (size_t)m * D + 8 * (lane + 64 * j)) = pack8(h);
                if (H8) *(GAS u32x2*)(H8 + (size_t)m * D + 8 * (lane + 64 * j)) = pack8_fp8(h); }
        }
    }
}

__device__ __forceinline__ void tr_item(const GAS float* W, int ldw, int K, int k0, int nsrc, int ncols, GAS bf16* WT, int ndst, LAS unsigned char* tile, int lane) {
    const int c4 = (lane & 15) * 4, kr = lane >> 4;
    f32x4 v[16];
#pragma unroll
    for (int i = 0; i < 16; ++i) v[i] = (c4 < ncols) ? *(const GAS f32x4*)(W + (size_t)(k0 + 4 * i + kr) * ldw + nsrc + c4) : (f32x4){0.f, 0.f, 0.f, 0.f};
#pragma unroll
    for (int i = 0; i < 16; ++i) { u32x2 w; w.x = cvtpk(v[i].x, v[i].y); w.y = cvtpk(v[i].z, v[i].w); *(LAS u32x2*)(tile + (4 * i + kr) * 160 + (lane & 15) * 8) = w; }
    LDS_WAIT();
    const int g = lane >> 4, c16 = lane & 15;
    const LAS unsigned char* tb = tile + (8 * g + (c16 >> 2)) * 160 + (c16 & 3) * 8;
#pragma unroll
    for (int nt = 0; nt < 4; ++nt)
#pragma unroll
        for (int kh = 0; kh < 2; ++kh) {
            const s16x4 lo = lds_tr4(tb + (32 * kh) * 160 + nt * 32), hi = lds_tr4(tb + (32 * kh + 4) * 160 + nt * 32);
            *(GAS bf16x8*)(WT + (size_t)(ndst + 16 * nt + c16) * K + k0 + 32 * kh + 8 * g) = __builtin_shufflevector(lo, hi, 0, 1, 2, 3, 4, 5, 6, 7); }
    LDS_WAIT();
}
__device__ __forceinline__ void tr_item_fp8(const GAS float* W, int ldw, int K, int k0, int nsrc, GAS unsigned char* WT8, int ndst, LAS unsigned char* tile, int lane) {
    const int c4 = (lane & 15) * 4, kr = lane >> 4;
    f32x4 v[16];
#pragma unroll
    for (int i = 0; i < 16; ++i) v[i] = *(const GAS f32x4*)(W + (size_t)(k0 + 4 * i + kr) * ldw + nsrc + c4);
#pragma unroll
    for (int i = 0; i < 16; ++i) { u32x2 w; w.x = cvtpk(v[i].x, v[i].y); w.y = cvtpk(v[i].z, v[i].w); *(LAS u32x2*)(tile + (4 * i + kr) * 160 + (lane & 15) * 8) = w; }
    LDS_WAIT();
    const int g = lane >> 4, c16 = lane & 15;
    const LAS unsigned char* tb = tile + (16 * g + (c16 >> 2)) * 160 + (c16 & 3) * 8;
#pragma unroll
    for (int nt = 0; nt < 4; ++nt) { u32x4 o;
#pragma unroll
        for (int h = 0; h < 2; ++h) { const s16x4 lo = lds_tr4(tb + (8 * h) * 160 + nt * 32), hi = lds_tr4(tb + (8 * h + 4) * 160 + nt * 32);
            float f[8]; unpack8(__builtin_bit_cast(u32x4, __builtin_shufflevector(lo, hi, 0, 1, 2, 3, 4, 5, 6, 7)), f);
#pragma unroll
            for (int j = 0; j < 8; ++j) f[j] *= 64.0f;
            const u32x2 w = pack8_fp8(f); if (h == 0) { o.x = w.x; o.y = w.y; } else { o.z = w.x; o.w = w.y; } }
        *(GAS u32x4*)(WT8 + (size_t)(ndst + 16 * nt + c16) * K + k0 + 16 * g) = o; }
    LDS_WAIT();
}
__device__ __forceinline__ void win_map(int dstrow, int& src, int& ncols) {
    ncols = 64;
    if (dstrow < 10240) src = dstrow;
    else if (dstrow < 12288) src = dstrow - 10240 + 10304;
    else if (dstrow < 12800) src = dstrow - 12288 + 12352;
    else if (dstrow < 13312) src = dstrow - 12800 + 12864;
    else if (dstrow < 17408) src = dstrow - 13312 + 14480;
    else if (dstrow < 18432) src = dstrow - 17408 + 13376;
    else if (dstrow < 18496) src = dstrow - 18432 + 10240;
    else if (dstrow < 18560) src = dstrow - 18496 + 14400;
    else if (dstrow == 18560) { src = 14464; ncols = 16; }
    else { src = 0; ncols = 0; }
}
struct WPtrs { const GAS float *w_in, *w_ssm, *w_att, *w_mix, *w_up, *w_dn; };
__device__ __forceinline__ void ph_weights(const WPtrs wp, GAS unsigned char* ws, LAS unsigned char* tile, int gw, int ngw, int lane) {
    constexpr int I_IN = (NPAD / 64) * (D / 64), I_SSM = (D / 64) * (DI / 64), I_ATT = (D / 64) * (D / 64), I_MIX = I_ATT, I_UP = (FF2 / 64) * (D / 64), I_DN = (D / 64) * (FF / 64);
    constexpr int I_L = I_IN + I_SSM + I_ATT + I_MIX + I_UP + I_DN;
    for (int it = gw; it < DEPTH * I_L; it += ngw) {
        const int layer = it / I_L; int r = it % I_L;
        GAS unsigned char* wl = ws + WS_W + (size_t)layer * WL_SIZE;
        if (r < I_IN) { const int nblk = NPAD / 64, kb = r / nblk, nb = r % nblk; int src, nc; win_map(nb * 64, src, nc);
            if (layer >= F8_IN && nb * 64 < PQI) tr_item_fp8(wp.w_in + (size_t)layer * D * NIN, NIN, D, kb * 64, src, wl + WL_IN, nb * 64, tile, lane);
            else tr_item(wp.w_in + (size_t)layer * D * NIN, NIN, D, kb * 64, src, nc, (GAS bf16*)(wl + WL_IN), nb * 64, tile, lane);
            continue; }
        r -= I_IN;
        if (r < I_SSM) { const int nblk = D / 64, kb = r / nblk, nb = r % nblk; if (layer >= F8_OUT) tr_item_fp8(wp.w_ssm + (size_t)layer * DI * D, D, DI, kb * 64, nb * 64, wl + WL_SSM, nb * 64, tile, lane); else tr_item(wp.w_ssm + (size_t)layer * DI * D, D, DI, kb * 64, nb * 64, 64, (GAS bf16*)(wl + WL_SSM), nb * 64, tile, lane); continue; }
        r -= I_SSM;
        if (r < I_ATT) { const int nblk = D / 64, kb = r / nblk, nb = r % nblk; if (layer >= F8_OUT) tr_item_fp8(wp.w_att + (size_t)layer * D * D, D, D, kb * 64, nb * 64, wl + WL_ATT, nb * 64, tile, lane); else tr_item(wp.w_att + (size_t)layer * D * D, D, D, kb * 64, nb * 64, 64, (GAS bf16*)(wl + WL_ATT), nb * 64, tile, lane); continue; }
        r -= I_ATT;
        if (r < I_MIX) { const int nblk = D / 64, kb = r / nblk, nb = r % nblk; if (layer >= F8_MIX) tr_item_fp8(wp.w_mix + (size_t)layer * D * D, D, D, kb * 64, nb * 64, wl + WL_MIX, nb * 64, tile, lane); else tr_item(wp.w_mix + (size_t)layer * D * D, D, D, kb * 64, nb * 64, 64, (GAS bf16*)(wl + WL_MIX), nb * 64, tile, lane); continue; }
        r -= I_MIX;
        if (r < I_UP) { const int nblk = FF2 / 64, kb = r / nblk, nb = r % nblk;
            if (layer >= F8_UP) tr_item_fp8(wp.w_up + (size_t)layer * D * FF2, FF2, D, kb * 64, nb * 64, wl + WL_UP, nb * 64, tile, lane);
            else tr_item(wp.w_up + (size_t)layer * D * FF2, FF2, D, kb * 64, nb * 64, 64, (GAS bf16*)(wl + WL_UP), nb * 64, tile, lane);
            continue; }
        r -= I_UP;
        { const int nblk = D / 64, kb = r / nblk, nb = r % nblk;
          if (layer >= F8_DN) tr_item_fp8(wp.w_dn + (size_t)layer * FF * D, D, FF, kb * 64, nb * 64, wl + WL_DN, nb * 64, tile, lane);
          else tr_item(wp.w_dn + (size_t)layer * FF * D, D, FF, kb * 64, nb * 64, 64, (GAS bf16*)(wl + WL_DN), nb * 64, tile, lane); }
    }
}

__device__ __forceinline__ void ph_small_proj(const GAS bf16* H, const GAS bf16* Ws, GAS float* SM, GAS bf16* KIB, LAS unsigned char* lds, int blk, int nblk, int tid) {
    constexpr int HS = 4112;
    const int lane = tid & 63, wave = __builtin_amdgcn_readfirstlane(tid >> 6), g = lane >> 4, c16 = lane & 15;
    for (int rb = blk; rb < M / 32; rb += nblk) {
        __syncthreads();
#pragma unroll
        for (int i = 0; i < 16; ++i) { const int id = tid + 512 * i, r = id >> 8, ch = id & 255;
            *(LAS u32x4*)(lds + r * HS + ch * 16) = *(const GAS u32x4*)(H + (size_t)(rb * 32 + r) * D + ch * 8); }
        __syncthreads();
        f32x4 acc[2] = {(f32x4){0.f, 0.f, 0.f, 0.f}, (f32x4){0.f, 0.f, 0.f, 0.f}}, acc9[2] = {(f32x4){0.f, 0.f, 0.f, 0.f}, (f32x4){0.f, 0.f, 0.f, 0.f}};
        const GAS bf16* wrow = Ws + (size_t)(16 * wave + c16) * D + 8 * g;
        const GAS bf16* w9 = Ws + (size_t)(128 + c16) * D + 256 * wave + 8 * g;
        const LAS unsigned char* hb = lds + c16 * HS + g * 16;
#pragma unroll 8
        for (int ks = 0; ks < 64; ++ks) {
            const bf16x8 wf = *(const GAS bf16x8*)(wrow + 32 * ks);
            const bf16x8 h0 = *(const LAS bf16x8*)(hb + ks * 64), h1 = *(const LAS bf16x8*)(hb + 16 * HS + ks * 64);
            acc[0] = __builtin_amdgcn_mfma_f32_16x16x32_bf16(wf, h0, acc[0], 0, 0, 0); acc[1] = __builtin_amdgcn_mfma_f32_16x16x32_bf16(wf, h1, acc[1], 0, 0, 0);
        }
#pragma unroll
        for (int k8 = 0; k8 < 8; ++k8) { const int ks = 8 * wave + k8;
            const bf16x8 wf = *(const GAS bf16x8*)(w9 + 32 * k8);
            const bf16x8 h0 = *(const LAS bf16x8*)(hb + ks * 64), h1 = *(const LAS bf16x8*)(hb + 16 * HS + ks * 64);
            acc9[0] = __builtin_amdgcn_mfma_f32_16x16x32_bf16(wf, h0, acc9[0], 0, 0, 0); acc9[1] = __builtin_amdgcn_mfma_f32_16x16x32_bf16(wf, h1, acc9[1], 0, 0, 0);
        }
#pragma unroll
        for (int rt = 0; rt < 2; ++rt) { const size_t row = (size_t)(rb * 32 + 16 * rt + c16);
            *(GAS f32x4*)(SM + row * SMW + 16 * wave + 4 * g) = acc[rt];
            if (wave >= 4) { u32x2 w; w.x = cvtpk(acc[rt].x, acc[rt].y); w.y = cvtpk(acc[rt].z, acc[rt].w); *(GAS u32x2*)(KIB + row * IDD + 16 * (wave - 4) + 4 * g) = w; } }
        __syncthreads();
        *(LAS f32x4*)(lds + ((wave * 2 + 0) * 64 + lane) * 16) = acc9[0]; *(LAS f32x4*)(lds + ((wave * 2 + 1) * 64 + lane) * 16) = acc9[1];
        __syncthreads();
        if (wave < 2) { f32x4 s = (f32x4){0.f, 0.f, 0.f, 0.f};
#pragma unroll
            for (int w8 = 0; w8 < 8; ++w8) s += *(const LAS f32x4*)(lds + ((w8 * 2 + wave) * 64 + lane) * 16);
            *(GAS f32x4*)(SM + (size_t)(rb * 32 + 16 * wave + c16) * SMW + 128 + 4 * g) = s; }
    }
}

__device__ __forceinline__ void ph_index_scores(const GAS bf16* P, const GAS float* SM, const GAS bf16* KIB, GAS float* SC, LAS unsigned char* lds, int blk, int nblk, int tid) {
    constexpr int QS = 1040;
    const int lane = tid & 63, wave = __builtin_amdgcn_readfirstlane(tid >> 6);
    for (int u0 = blk; u0 < 256; u0 += nblk) {
#pragma unroll 1
        for (int half = 0; half < 2; ++half) {
            const int b = half, qt = half ? 255 - u0 : u0;
            const int q0 = b * SEQ + qt * 16, nkt = ((qt * 16) / 64 + 1) * 4;
            const int qrow = q0 + (lane & 15), kq = 8 * (lane >> 4);
            __syncthreads();
#pragma unroll
            for (int i = 0; i < 2; ++i) { const int id = tid + 512 * i, q = id >> 6, ch = id & 63;
                *(LAS u32x4*)(lds + q * QS + ch * 16) = *(const GAS u32x4*)(P + (size_t)(q0 + q) * NMAIN + PQI + 8 * IDD + ch * 8); }
            bf16x8 bq[8][2]; float w[IH];
#pragma unroll
            for (int h = 0; h < IH; ++h) {
                if (h < 8) {
#pragma unroll
                    for (int ks = 0; ks < 2; ++ks) bq[h][ks] = *(const GAS bf16x8*)(P + (size_t)qrow * NMAIN + PQI + h * IDD + ks * 32 + kq); }
                w[h] = SM[(size_t)qrow * SMW + SM_WI + h]; }
            __syncthreads();
            const LAS unsigned char* qb = lds + (lane & 15) * QS + kq * 2;
            for (int kt = wave; kt < nkt; kt += NWAVES) {
                const int key0 = kt * 16; const GAS bf16* kp = KIB + (size_t)(b * SEQ + key0 + (lane & 15)) * IDD + kq;
                const bf16x8 a0 = *(const GAS bf16x8*)kp, a1 = *(const GAS bf16x8*)(kp + 32);
                f32x4 sc = (f32x4){0.f, 0.f, 0.f, 0.f};
#pragma unroll
                for (int h = 0; h < IH; ++h) { f32x4 c = (f32x4){0.f, 0.f, 0.f, 0.f};
                    const bf16x8 b0 = h < 8 ? bq[h & 7][0] : *(const LAS bf16x8*)(qb + (h - 8) * 128), b1 = h < 8 ? bq[h & 7][1] : *(const LAS bf16x8*)(qb + (h - 8) * 128 + 64);
                    c = __builtin_amdgcn_mfma_f32_16x16x32_bf16(a0, b0, c, 0, 0, 0); c = __builtin_amdgcn_mfma_f32_16x16x32_bf16(a1, b1, c, 0, 0, 0);
                    sc.x += w[h] * fmaxf(c.x, 0.f); sc.y += w[h] * fmaxf(c.y, 0.f); sc.z += w[h] * fmaxf(c.z, 0.f); sc.w += w[h] * fmaxf(c.w, 0.f); }
                *(GAS f32x4*)(SC + (size_t)qrow * SEQ + key0 + 4 * (lane >> 4)) = sc;
            }
        }
    }
}

__device__ __forceinline__ void topk_bitwise(const GAS float* srow, GAS unsigned long long* mw, int limit, int lane) {
    unsigned u[64];
#pragma unroll
    for (int j = 0; j < 64; ++j) { const int key = j * 64 + lane; unsigned v = 0u;
        if (key < limit) { const unsigned bits = __float_as_uint(srow[key]); v = (bits & 0x80000000u) ? ~bits : (bits | 0x80000000u); }
        u[j] = v; }
    unsigned T = 0u;
#pragma unroll 1
    for (int bit = 31; bit >= 0; --bit) { const unsigned cand = T | (1u << bit); int cnt = 0;
#pragma unroll
        for (int j = 0; j < 64; ++j) cnt += __popcll(__ballot(u[j] >= cand));
        if (cnt >= TOPK) T = cand; }
    int cgt = 0;
#pragma unroll
    for (int j = 0; j < 64; ++j) cgt += __popcll(__ballot(u[j] > T));
    const int need_eq = TOPK - cgt; int eqbase = 0;
    const unsigned long long lt_mask = (1ull << lane) - 1ull;
#pragma unroll
    for (int j = 0; j < 64; ++j) {
        const bool gt = u[j] > T, eq = u[j] == T;
        const unsigned long long eqm = __ballot(eq);
        const bool take = gt || (eq && (eqbase + __popcll(eqm & lt_mask) < need_eq));
        const unsigned long long tm = __ballot(take);
        if (lane == 0 && j * 64 < limit) mw[j] = tm;
        eqbase += __popcll(eqm);
    }
}
__device__ __forceinline__ void ph_topk(const GAS float* SC, GAS unsigned long long* MASKW, LAS unsigned char* wl, int gw, int ngw, int lane) {
    constexpr int CAP = 1024;
    LAS unsigned* hist = (LAS unsigned*)wl;
    LAS unsigned* maskc = (LAS unsigned*)(wl + 1024);
    LAS float* cval = (LAS float*)(wl + 1536);
    LAS unsigned* ckey = (LAS unsigned*)(wl + 1536 + 4 * CAP);
    const unsigned long long lt_mask = (1ull << lane) - 1ull;
    for (int m = gw; m < M; m += ngw) {
        const int t = m & (SEQ - 1), limit = (t / 64 + 1) * 64, nw = limit / 64;
        GAS unsigned long long* mw = MASKW + (size_t)m * 64;
        if (limit <= TOPK) { unsigned ones = 0xffffffffu; asm volatile("" : "+v"(ones)); if (lane < nw) mw[lane] = ((unsigned long long)ones << 32) | ones; continue; }
        const GAS float* srow = SC + (size_t)m * SEQ;
        float s[64]; float smax = -__builtin_inff(), smin = __builtin_inff();
#pragma unroll
        for (int j = 0; j < 64; ++j) { s[j] = (j < nw) ? srow[j * 64 + lane] : 0.f; if (j < nw) { smax = fmaxf(smax, s[j]); smin = fminf(smin, s[j]); } }
        smax = wave_max(smax); smin = -wave_max(-smin);
        const float scale = smax > smin ? 255.0f / (smax - smin) : 0.f;
        asm volatile("" ::: "memory");
        hist[lane] = 0u; hist[lane + 64] = 0u; hist[lane + 128] = 0u; hist[lane + 192] = 0u; maskc[lane] = 0u; maskc[lane + 64] = 0u;
        LDS_WAIT();
#pragma unroll
        for (int j = 0; j < 64; ++j) if (j < nw) { const int b = min(255, (int)((s[j] - smin) * scale)); __hip_atomic_fetch_add(&hist[b], 1u, __ATOMIC_RELAXED, __HIP_MEMORY_SCOPE_WORKGROUP); }
        LDS_WAIT();
        const unsigned c0 = hist[4 * lane], c1 = hist[4 * lane + 1], c2 = hist[4 * lane + 2], c3 = hist[4 * lane + 3];
        unsigned suf = c0 + c1 + c2 + c3;
#pragma unroll
        for (int o = 1; o < 64; o <<= 1) { const unsigned v = __shfl_down(suf, o); if (lane + o < 64) suf += v; }
        const unsigned above = suf - (c0 + c1 + c2 + c3);
        int bstar = -1; unsigned cab = 0u;
        { unsigned cum = above;
          if (cum < TOPK && cum + c3 >= TOPK) { bstar = 4 * lane + 3; cab = cum; } cum += c3;
          if (bstar < 0 && cum < TOPK && cum + c2 >= TOPK) { bstar = 4 * lane + 2; cab = cum; } cum += c2;
          if (bstar < 0 && cum < TOPK && cum + c1 >= TOPK) { bstar = 4 * lane + 1; cab = cum; } cum += c1;
          if (bstar < 0 && cum < TOPK && cum + c0 >= TOPK) { bstar = 4 * lane + 0; cab = cum; } }
        const unsigned long long who = __ballot(bstar >= 0);
        const int src = __builtin_ctzll(who);
        bstar = __shfl(bstar, src); cab = __shfl(cab, src);
        const int need = TOPK - (int)cab;
        const unsigned ncand = hist[bstar];
        if (ncand > (unsigned)CAP) { topk_bitwise(srow, mw, limit, lane); continue; }
        unsigned long long myword = 0ull; int base = 0;
#pragma unroll
        for (int j = 0; j < 64; ++j) if (j < nw) {
            const int b = min(255, (int)((s[j] - smin) * scale));
            const unsigned long long gm = __ballot(b > bstar), em = __ballot(b == bstar);
            if (lane == j) myword = gm;
            if (b == bstar) { const int pos = base + __popcll(em & lt_mask); cval[pos] = s[j]; ckey[pos] = (unsigned)(j * 64 + lane); }
            base += __popcll(em);
        }
        LDS_WAIT();
        for (int i = lane; i < base; i += 64) { const float vi = cval[i]; const unsigned ki = ckey[i]; int rank = 0;
            if (need < base) { for (int q = 0; q < base; ++q) { const float vq = cval[q]; const unsigned kq = ckey[q]; rank += (vq > vi || (vq == vi && kq < ki)) ? 1 : 0; } }
            if (rank < need) __hip_atomic_fetch_or(&maskc[ki >> 5], 1u << (ki & 31), __ATOMIC_RELAXED, __HIP_MEMORY_SCOPE_WORKGROUP); }
        LDS_WAIT();
        if (lane < nw) { const unsigned long long cw_ = ((unsigned long long)maskc[2 * lane + 1] << 32) | maskc[2 * lane]; mw[lane] = myword | cw_; }
        LDS_WAIT(); asm volatile("" ::: "memory");
    }
}

__device__ __forceinline__ float xmax16(float x) { auto r = __builtin_amdgcn_permlane16_swap(__float_as_uint(x), __float_as_uint(x), false, false); return fmaxf(__uint_as_float(r[0]), __uint_as_float(r[1])); }
__device__ __forceinline__ float xmax32(float x) { auto r = __builtin_amdgcn_permlane32_swap(__float_as_uint(x), __float_as_uint(x), false, false); return fmaxf(__uint_as_float(r[0]), __uint_as_float(r[1])); }
__device__ __forceinline__ float xsum16(float x) { auto r = __builtin_amdgcn_permlane16_swap(__float_as_uint(x), __float_as_uint(x), false, false); return __uint_as_float(r[0]) + __uint_as_float(r[1]); }
__device__ __forceinline__ float xsum32(float x) { auto r = __builtin_amdgcn_permlane32_swap(__float_as_uint(x), __float_as_uint(x), false, false); return __uint_as_float(r[0]) + __uint_as_float(r[1]); }
template <int VAR> __device__ __forceinline__ void ph_attn_dense(const GAS bf16* P, const GAS unsigned long long* MASKW, GAS bf16* AO, LAS unsigned char* lds, int blk, int nblk, int tid) {
    constexpr int KS = 272, VS = 288, KBUF = 64 * KS, VBUF = 64 * VS, VOFF = 2 * KBUF, MOFF = VOFF + 2 * VBUF;
    const int lane = tid & 63, wave = __builtin_amdgcn_readfirstlane(tid >> 6), g = lane >> 4, c16 = lane & 15;
    const int hq = wave >> 1, qh = (wave & 1) * 32;
    const float SCL = ATTN_SCALE * 1.4426950408889634f;
    for (int u0 = blk; u0 < 256; u0 += nblk) {
#pragma unroll 1
        for (int half = 0; half < 2; ++half) {
            const int b = (u0 >> 2) & 1, kvh = u0 & 3, cc = u0 >> 3, c = half ? 63 - cc : cc, nt = c + 1;
            const int m0 = b * SEQ + c * 64;
            bf16x8 qf[2][4];
#pragma unroll
            for (int qt = 0; qt < 2; ++qt)
#pragma unroll
                for (int kd = 0; kd < 4; ++kd) qf[qt][kd] = *(const GAS bf16x8*)(P + (size_t)(m0 + qh + 16 * qt + c16) * NMAIN + PQ + (kvh * 4 + hq) * AD + 32 * kd + 8 * g);
            f32x4 O[2][8];
#pragma unroll
            for (int qt = 0; qt < 2; ++qt)
#pragma unroll
                for (int dt = 0; dt < 8; ++dt) O[qt][dt] = (f32x4){0.f, 0.f, 0.f, 0.f};
            float mrun[2] = {-1e30f, -1e30f}, lrun[2] = {0.f, 0.f};
            const GAS bf16* kvbase = P + (size_t)(b * SEQ) * NMAIN + kvh * AD;
            u32x4 kreg[2], vreg[2];
#define ATT_LOAD(t) do { _Pragma("unroll") for (int i = 0; i < 2; ++i) { const int id = tid + 512 * i; const GAS bf16* src = kvbase + (size_t)((t) * 64 + (id >> 4)) * NMAIN + (id & 15) * 8; \
                kreg[i] = *(const GAS u32x4*)(src + PK); vreg[i] = *(const GAS u32x4*)(src + PV); } } while (0)
#define ATT_STORE(buf) do { _Pragma("unroll") for (int i = 0; i < 2; ++i) { const int id = tid + 512 * i; \
                *(LAS u32x4*)(lds + (buf) * KBUF + (id >> 4) * KS + (id & 15) * 16) = kreg[i]; *(LAS u32x4*)(lds + VOFF + (buf) * VBUF + (id >> 4) * VS + (id & 15) * 16) = vreg[i]; } } while (0)
            __syncthreads();
            ATT_LOAD(0); ATT_STORE(0);
#pragma unroll
            for (int i = 0; i < 4; ++i) { const int id = tid + 512 * i; *(LAS u32x4*)(lds + MOFF + id * 16) = *(const GAS u32x4*)((const GAS unsigned char*)(MASKW + (size_t)m0 * 64) + id * 16); }
            const LAS unsigned long long* mrow0 = (const LAS unsigned long long*)(lds + MOFF) + (qh + c16) * 64; const LAS unsigned long long* mrow1 = mrow0 + 16 * 64;
            __syncthreads();
            for (int t = 0; t < nt; ++t) {
                const int buf = (VAR & 1) ? 0 : (t & 1);
                if (!(VAR & 1) && t + 1 < nt) ATT_LOAD(t + 1);
                const LAS unsigned char* kb = lds + buf * KBUF + c16 * KS + g * 16;
                const LAS unsigned char* vb = lds + VOFF + buf * VBUF + (4 * g + (c16 >> 2)) * VS + (c16 & 3) * 8;
                f32x4 S[2][4];
                bf16x8 kf[2][4];
#pragma unroll
                for (int kd = 0; kd < 4; ++kd) kf[0][kd] = *(const LAS bf16x8*)(kb + kd * 64);
#pragma unroll
                for (int kt = 0; kt < 4; ++kt) {
                    if (kt < 3) {
#pragma unroll
                        for (int kd = 0; kd < 4; ++kd) kf[(kt + 1) & 1][kd] = *(const LAS bf16x8*)(kb + (kt + 1) * 16 * KS + kd * 64); }
#pragma unroll
                    for (int qt = 0; qt < 2; ++qt) { f32x4 s = (f32x4){0.f, 0.f, 0.f, 0.f};
#pragma unroll
                        for (int kd = 0; kd < 4; ++kd) { if (!(VAR & 8)) s = __builtin_amdgcn_mfma_f32_16x16x32_bf16(kf[kt & 1][kd], qf[qt][kd], s, 0, 0, 0); else s += __builtin_bit_cast(f32x4, kf[kt & 1][kd]); }
                        S[qt][kt] = s; }
                }
                s16x4 vlo[8][2], vhi[8][2];
#pragma unroll
                for (int dt = 0; dt < 4; ++dt)
#pragma unroll
                    for (int ks = 0; ks < 2; ++ks) { vlo[dt][ks] = lds_tr4(vb + (32 * ks) * VS + dt * 32); vhi[dt][ks] = lds_tr4(vb + (32 * ks + 16) * VS + dt * 32); }
                bf16x8 pf[2][2];
#pragma unroll
                for (int qt = 0; qt < 2; ++qt) {
                    const unsigned long long mw = (qt ? mrow1[t] : mrow0[t]) >> (4 * g);
                    const int mlo = (int)(unsigned)mw, mhi = (int)(unsigned)(mw >> 32);
                    float mx = fmaxf(fmaxf(S[qt][0][0], S[qt][0][1]), fmaxf(S[qt][0][2], S[qt][0][3]));
#pragma unroll
                    for (int kt = 1; kt < 4; ++kt) mx = fmaxf(fmaxf(mx, S[qt][kt][0]), fmaxf(fmaxf(S[qt][kt][1], S[qt][kt][2]), S[qt][kt][3]));
                    mx = xmax16(mx); mx = xmax32(mx);
                    const float mnew = fmaxf(mrun[qt], mx * SCL);
                    const float alpha = __builtin_amdgcn_exp2f(mrun[qt] - mnew);
                    float ps = 0.f;
#pragma unroll
                    for (int kt = 0; kt < 4; ++kt)
#pragma unroll
                        for (int j = 0; j < 4; ++j) { const int sel = __builtin_amdgcn_sbfe(kt < 2 ? mlo : mhi, (kt & 1) * 16 + j, 1);
                            const float p = (VAR & 2) ? S[qt][kt][j] : __uint_as_float(__float_as_uint(__builtin_amdgcn_exp2f(__builtin_fmaf(S[qt][kt][j], SCL, -mnew))) & (unsigned)sel); S[qt][kt][j] = p; ps += p; }
                    ps = xsum16(ps); ps = xsum32(ps);
                    lrun[qt] = lrun[qt] * alpha + ps; mrun[qt] = mnew;
                    if (!__all(alpha == 1.0f)) {
#pragma unroll
                        for (int dt = 0; dt < 8; ++dt) O[qt][dt] *= alpha; }
#pragma unroll
                    for (int ks = 0; ks < 2; ++ks) { u32x4 w; w.x = cvtpk(S[qt][2 * ks][0], S[qt][2 * ks][1]); w.y = cvtpk(S[qt][2 * ks][2], S[qt][2 * ks][3]);
                        w.z = cvtpk(S[qt][2 * ks + 1][0], S[qt][2 * ks + 1][1]); w.w = cvtpk(S[qt][2 * ks + 1][2], S[qt][2 * ks + 1][3]); pf[qt][ks] = __builtin_bit_cast(bf16x8, w); }
                }
#pragma unroll
                for (int dt = 4; dt < 8; ++dt)
#pragma unroll
                    for (int ks = 0; ks < 2; ++ks) { vlo[dt][ks] = lds_tr4(vb + (32 * ks) * VS + dt * 32); vhi[dt][ks] = lds_tr4(vb + (32 * ks + 16) * VS + dt * 32); }
#pragma unroll
                for (int dt = 0; dt < 8; ++dt)
#pragma unroll
                    for (int ks = 0; ks < 2; ++ks) {
                        const bf16x8 vf = __builtin_shufflevector(vlo[dt][ks], vhi[dt][ks], 0, 1, 2, 3, 4, 5, 6, 7);
                        if (!(VAR & 4)) { O[0][dt] = __builtin_amdgcn_mfma_f32_16x16x32_bf16(vf, pf[0][ks], O[0][dt], 0, 0, 0);
                        O[1][dt] = __builtin_amdgcn_mfma_f32_16x16x32_bf16(vf, pf[1][ks], O[1][dt], 0, 0, 0); } else { O[0][dt] += __builtin_bit_cast(f32x4, pf[0][ks]); O[1][dt] += __builtin_bit_cast(f32x4, pf[1][ks]); }
                    }
                if (!(VAR & 1) && t + 1 < nt) ATT_STORE(buf ^ 1);
                __syncthreads();
            }
#undef ATT_LOAD
#undef ATT_STORE
#pragma unroll
            for (int qt = 0; qt < 2; ++qt) { const float r = 1.0f / lrun[qt];
                const size_t oi = (size_t)(m0 + qh + 16 * qt + c16) * D + (kvh * 4 + hq) * AD + 4 * g;
#pragma unroll
                for (int dt = 0; dt < 8; ++dt) { const f32x4 o = O[qt][dt] * r;
                    if (VAR & 16) *(GAS unsigned*)((GAS unsigned char*)AO + oi + 16 * dt) = pack4_fp8(o.x, o.y, o.z, o.w);
                    else { u32x2 w; w.x = pk2(o.x, o.y); w.y = pk2(o.z, o.w); *(GAS u32x2*)(AO + oi + 16 * dt) = w; } } }
        }
    }
}

__device__ __forceinline__ void stage_conv(const GAS bf16* P, const GAS float* cw, const GAS float* cb, int m0, int tpos0, int ch0, int nch, LAS unsigned char* dst, int stride, int tid) {
    const int cpr = nch >> 3;
    for (int id = tid; id < 64 * cpr; id += NTHR) {
        const int s = id / cpr, k = id - s * cpr, ch = ch0 + 8 * k;
        float acc[8];
        { const f32x4 b0 = *(const GAS f32x4*)(cb + ch), b1 = *(const GAS f32x4*)(cb + ch + 4); acc[0] = b0.x; acc[1] = b0.y; acc[2] = b0.z; acc[3] = b0.w; acc[4] = b1.x; acc[5] = b1.y; acc[6] = b1.z; acc[7] = b1.w; }
#pragma unroll
        for (int i = 0; i < 4; ++i) { if (tpos0 + s - 3 + i >= 0) {
            float x[8]; unpack8(*(const GAS u32x4*)(P + (size_t)(m0 + s - 3 + i) * NMAIN + PXBC + ch), x);
            const f32x4 w0 = *(const GAS f32x4*)(cw + i * CONVD + ch), w1 = *(const GAS f32x4*)(cw + i * CONVD + ch + 4);
            acc[0] += w0.x * x[0]; acc[1] += w0.y * x[1]; acc[2] += w0.z * x[2]; acc[3] += w0.w * x[3]; acc[4] += w1.x * x[4]; acc[5] += w1.y * x[5]; acc[6] += w1.z * x[6]; acc[7] += w1.w * x[7]; } }
#pragma unroll
        for (int j = 0; j < 8; ++j) acc[j] = siluf_(acc[j]);
        *(LAS u32x4*)(dst + s * stride + k * 16) = pack8(acc);
    }
}
__device__ __forceinline__ void wave_dt_acs(const GAS float* SM, const GAS float* dt_bias, const GAS float* a_log, int m0, int head, LAS float* dtw, LAS float* acsw, int lane) {
    const float raw = SM[(size_t)(m0 + lane) * SMW + SM_DT + head] + dt_bias[head];
    const float dt = fmaxf(raw, 0.f) + log1pf(__expf(-fabsf(raw)));
    float x = dt * (-__expf(a_log[head]));
#pragma unroll
    for (int o = 1; o < 64; o <<= 1) { const float v = __shfl_up(x, o); if (lane >= o) x += v; }
    dtw[lane] = dt; acsw[lane] = x;
}
__device__ __forceinline__ bf16x8 tr8(const LAS unsigned char* p, int off_lo, int off_hi) {
    const s16x4 lo = lds_tr4(p + off_lo), hi = lds_tr4(p + off_hi); return __builtin_shufflevector(lo, hi, 0, 1, 2, 3, 4, 5, 6, 7);
}
template <int NOUT> __device__ __forceinline__ void conv_strip(const GAS bf16* src, int tpos_first_raw, const GAS float* cw, const GAS float* cb, u32x4 (&out)[NOUT]) {
    u32x4 raw[NOUT + 3];
#pragma unroll
    for (int i = 0; i < NOUT + 3; ++i) { const int tp = tpos_first_raw + i; raw[i] = *(const GAS u32x4*)(src + (size_t)(tp < 0 ? 3 : i) * NMAIN); if (tp < 0) raw[i] = (u32x4){0u, 0u, 0u, 0u}; }
    f32x4 w[4][2];
#pragma unroll
    for (int t = 0; t < 4; ++t) { w[t][0] = *(const GAS f32x4*)(cw + t * CONVD); w[t][1] = *(const GAS f32x4*)(cw + t * CONVD + 4); }
    const f32x4 b0 = *(const GAS f32x4*)cb, b1 = *(const GAS f32x4*)(cb + 4);
#pragma unroll
    for (int o = 0; o < NOUT; ++o) { f32x4 a0 = b0, a1 = b1;
#pragma unroll
        for (int t = 0; t < 4; ++t) { float x[8]; unpack8(raw[o + t], x); a0 += w[t][0] * (f32x4){x[0], x[1], x[2], x[3]}; a1 += w[t][1] * (f32x4){x[4], x[5], x[6], x[7]}; }
        float f[8] = {a0.x, a0.y, a0.z, a0.w, a1.x, a1.y, a1.z, a1.w};
#pragma unroll
        for (int j = 0; j < 8; ++j) f[j] = f[j] * __builtin_amdgcn_rcpf(1.0f + __expf(-f[j]));
        out[o] = pack8(f); }
}
__device__ __forceinline__ void ph_ssd_states(const GAS bf16* P, const GAS float* SM, const GAS float* cw, const GAS float* cb, const GAS float* dt_bias, const GAS float* a_log, GAS bf16* XC, GAS bf16* ST, GAS float* CD,
                                              LAS unsigned char* lds, int blk, int nblk, int tid) {
    constexpr int RSW = 160, XW = 64 * RSW, RSB = 288, BMB = 64 * RSB, O_BM = 8 * XW, O_DT = O_BM + 2 * BMB, O_ACS = O_DT + 2048;
    const int lane = tid & 63, wave = __builtin_amdgcn_readfirstlane(tid >> 6), gq = lane >> 4, c16 = lane & 15;
    LAS unsigned char* xw = lds + wave * XW;
    LAS float* dtw = (LAS float*)(lds + O_DT) + wave * 64; LAS float* acsw = (LAS float*)(lds + O_ACS) + wave * 64;
    int par = 0;
    for (int item = blk; item < BATCH * 64 * NG; item += nblk, par ^= 1) {
        const int bc = item >> 3, g = item & 7, m0 = bc * 64, tpos0 = (bc & 63) * 64, head = g * HPG + wave;
        LAS unsigned char* bm = lds + O_BM + par * BMB;
        asm volatile("" ::: "memory");
        { const int k16 = lane & 15, r0 = 8 * wave + 2 * gq, chB = DI + g * NS + 8 * k16;
          const GAS bf16* base = P + (size_t)(m0 + r0 - 3) * NMAIN + PXBC + chB;
          u32x4 ob[2], oc[2];
          conv_strip<2>(base, tpos0 + r0 - 3, cw + chB, cb + chB, ob);
          conv_strip<2>(base + NG * NS, tpos0 + r0 - 3, cw + chB + NG * NS, cb + chB + NG * NS, oc);
#pragma unroll
          for (int o = 0; o < 2; ++o) { *(LAS u32x4*)(bm + (r0 + o) * RSB + k16 * 16) = ob[o];
              *(GAS u32x4*)(XC + (size_t)(m0 + r0 + o) * CONVD + chB) = ob[o]; *(GAS u32x4*)(XC + (size_t)(m0 + r0 + o) * CONVD + chB + NG * NS) = oc[o]; } }
        { const int k8 = lane & 7, r0 = 8 * (lane >> 3), ch = head * HP + 8 * k8;
          u32x4 ox[8];
          conv_strip<8>(P + (size_t)(m0 + r0 - 3) * NMAIN + PXBC + ch, tpos0 + r0 - 3, cw + ch, cb + ch, ox);
#pragma unroll
          for (int o = 0; o < 8; ++o) { *(LAS u32x4*)(xw + (r0 + o) * RSW + k8 * 16) = ox[o]; *(GAS u32x4*)(XC + (size_t)(m0 + r0 + o) * CONVD + ch) = ox[o]; } }
        wave_dt_acs(SM, dt_bias, a_log, m0, head, dtw, acsw, lane);
        LDS_WAIT();
        __syncthreads();
        const float aend = acsw[63];
        if (lane == 0) CD[bc * NH + head] = __expf(aend);
        const LAS unsigned char* xb = xw + (4 * gq + (c16 >> 2)) * RSW + (c16 & 3) * 8;
        const LAS unsigned char* bb = bm + (4 * gq + (c16 >> 2)) * RSB + (c16 & 3) * 8;
        bf16x8 xf[4][2];
#pragma unroll
        for (int ks = 0; ks < 2; ++ks) { float w[8];
#pragma unroll
            for (int j = 0; j < 8; ++j) { const int s = 32 * ks + 16 * (j >> 2) + 4 * gq + (j & 3); w[j] = dtw[s] * __expf(aend - acsw[s]); }
#pragma unroll
            for (int pt = 0; pt < 4; ++pt) { const bf16x8 r = tr8(xb + pt * 32, (32 * ks) * RSW, (32 * ks + 16) * RSW); float f[8]; unpack8(__builtin_bit_cast(u32x4, r), f);
#pragma unroll
                for (int j = 0; j < 8; ++j) f[j] *= w[j];
                xf[pt][ks] = __builtin_bit_cast(bf16x8, pack8(f)); } }
        GAS bf16* dst = ST + (((size_t)bc * NH + head) * HP + c16) * NS + 4 * gq;
#pragma unroll 2
        for (int nt = 0; nt < 8; ++nt) {
            const bf16x8 a0 = tr8(bb + nt * 32, 0, 16 * RSB), a1 = tr8(bb + nt * 32, 32 * RSB, 48 * RSB);
#pragma unroll
            for (int pt = 0; pt < 4; ++pt) { f32x4 acc = (f32x4){0.f, 0.f, 0.f, 0.f};
                acc = __builtin_amdgcn_mfma_f32_16x16x32_bf16(a0, xf[pt][0], acc, 0, 0, 0); acc = __builtin_amdgcn_mfma_f32_16x16x32_bf16(a1, xf[pt][1], acc, 0, 0, 0);
                u32x2 o; o.x = pk2(acc.x, acc.y); o.y = pk2(acc.z, acc.w); *(GAS u32x2*)(dst + (size_t)(16 * pt) * NS + 16 * nt) = o; }
        }
        LDS_WAIT(); asm volatile("" ::: "memory");
    }
}
__device__ __forceinline__ void ph_ssd_scan(GAS bf16* ST, const GAS float* CD, int gtid, int nthr) {
    for (int it = gtid; it < BATCH * NH * HP * (NS / 8); it += nthr) {
        const int n8 = it & 15, p = (it >> 4) & 63, head = (it >> 10) & 63, b = it >> 16;
        float h[8];
#pragma unroll
        for (int j = 0; j < 8; ++j) h[j] = 0.f;
#pragma unroll 8
        for (int c = 0; c < 64; ++c) { GAS u32x4* q = (GAS u32x4*)(ST + ((((size_t)(b * 64 + c)) * NH + head) * HP + p) * NS) + n8;
            float v[8]; unpack8(*q, v); *q = pack8(h); const float dec = CD[(b * 64 + c) * NH + head];
#pragma unroll
            for (int j = 0; j < 8; ++j) h[j] = h[j] * dec + v[j]; }
    }
}
template <bool YF8> __device__ __forceinline__ void ph_ssd_out(const GAS bf16* P, const GAS float* SM, const GAS bf16* XC, const GAS float* dt_bias, const GAS float* a_log, const GAS bf16* ST,
                                           const GAS float* dskip, const GAS float* gnorm, GAS bf16* Y, LAS unsigned char* lds, int blk, int nblk, int tid) {
    constexpr int RSW = 160, XW = 64 * RSW, O_DT = 8 * XW, O_ACS = O_DT + 2048, O_SSQ = O_ACS + 2048;
    const int lane = tid & 63, wave = __builtin_amdgcn_readfirstlane(tid >> 6), gq = lane >> 4, c16 = lane & 15;
    LAS unsigned char* xw = lds + wave * XW;
    LAS float* dtw = (LAS float*)(lds + O_DT) + wave * 64; LAS float* acsw = (LAS float*)(lds + O_ACS) + wave * 64;
    int par = 0;
    for (int item = blk; item < BATCH * 64 * NG; item += nblk, par ^= 1) {
        const int bc = item >> 3, g = item & 7, m0 = bc * 64, head = g * HPG + wave;
        asm volatile("" ::: "memory");
        { u32x4 xr[8];
#pragma unroll
          for (int i = 0; i < 8; ++i) xr[i] = *(const GAS u32x4*)(XC + (size_t)(m0 + (lane >> 3) + 8 * i) * CONVD + head * HP + (lane & 7) * 8);
#pragma unroll
          for (int i = 0; i < 8; ++i) *(LAS u32x4*)(xw + ((lane >> 3) + 8 * i) * RSW + (lane & 7) * 16) = xr[i]; }
        wave_dt_acs(SM, dt_bias, a_log, m0, head, dtw, acsw, lane);
        const GAS bf16* cbase = XC + (size_t)(m0 + c16) * CONVD + DI + NG * NS + g * NS + 8 * gq;
        const GAS bf16* bbase = cbase - NG * NS;
        bf16x8 cf[4][4];
#pragma unroll
        for (int lt = 0; lt < 4; ++lt)
#pragma unroll
            for (int kn = 0; kn < 4; ++kn) cf[lt][kn] = *(const GAS bf16x8*)(cbase + (size_t)(16 * lt) * CONVD + 32 * kn);
        LDS_WAIT(); asm volatile("" ::: "memory");
        float al[4];
#pragma unroll
        for (int lt = 0; lt < 4; ++lt) al[lt] = acsw[16 * lt + c16];
        bf16x8 lf[2][4];
#pragma unroll
        for (int ks = 0; ks < 2; ++ks) {
            f32x4 lt4[2][4];
#pragma unroll
            for (int h2 = 0; h2 < 2; ++h2) { const int st = 2 * ks + h2;
                bf16x8 bfr[4];
#pragma unroll
                for (int kn = 0; kn < 4; ++kn) bfr[kn] = *(const GAS bf16x8*)(bbase + (size_t)(16 * st) * CONVD + 32 * kn);
                float as_[4], ds_[4];
#pragma unroll
                for (int j = 0; j < 4; ++j) { as_[j] = acsw[16 * st + 4 * gq + j]; ds_[j] = dtw[16 * st + 4 * gq + j]; }
#pragma unroll
                for (int lt = 0; lt < 4; ++lt) { f32x4 t4 = (f32x4){0.f, 0.f, 0.f, 0.f};
                    if (lt >= st) {
#pragma unroll
                        for (int kn = 0; kn < 4; ++kn) t4 = __builtin_amdgcn_mfma_f32_16x16x32_bf16(bfr[kn], cf[lt][kn], t4, 0, 0, 0);
#pragma unroll
                        for (int j = 0; j < 4; ++j) { const float e = __expf(fminf(al[lt] - as_[j], 0.f)) * ds_[j]; const bool ok = (lt > st) || (4 * gq + j <= c16); t4[j] = ok ? t4[j] * e : 0.f; } }
                    lt4[h2][lt] = t4; } }
#pragma unroll
            for (int lt = 0; lt < 4; ++lt) { u32x4 w; w.x = pk2(lt4[0][lt][0], lt4[0][lt][1]); w.y = pk2(lt4[0][lt][2], lt4[0][lt][3]); w.z = pk2(lt4[1][lt][0], lt4[1][lt][1]); w.w = pk2(lt4[1][lt][2], lt4[1][lt][3]);
                lf[ks][lt] = __builtin_bit_cast(bf16x8, w); }
        }
        f32x4 acc[4][4];
        const GAS bf16* hsrc = ST + (((size_t)bc * NH + head) * HP + c16) * NS + 8 * gq;
#pragma unroll
        for (int pt = 0; pt < 4; ++pt) { bf16x8 hf[4];
#pragma unroll
            for (int kn = 0; kn < 4; ++kn) hf[kn] = *(const GAS bf16x8*)(hsrc + (size_t)(16 * pt) * NS + 32 * kn);
#pragma unroll
            for (int lt = 0; lt < 4; ++lt) { f32x4 t4 = (f32x4){0.f, 0.f, 0.f, 0.f};
#pragma unroll
                for (int kn = 0; kn < 4; ++kn) t4 = __builtin_amdgcn_mfma_f32_16x16x32_bf16(hf[kn], cf[lt][kn], t4, 0, 0, 0);
                acc[pt][lt] = t4 * __expf(al[lt]); }
            asm volatile("" ::: "memory"); }
        const LAS unsigned char* xb = xw + (4 * gq + (c16 >> 2)) * RSW + (c16 & 3) * 8;
#pragma unroll
        for (int pt = 0; pt < 4; ++pt) {
            const bf16x8 x0 = tr8(xb + pt * 32, 0, 16 * RSW), x1 = tr8(xb + pt * 32, 32 * RSW, 48 * RSW);
#pragma unroll
            for (int lt = 0; lt < 4; ++lt) { acc[pt][lt] = __builtin_amdgcn_mfma_f32_16x16x32_bf16(x0, lf[0][lt], acc[pt][lt], 0, 0, 0);
                if (lt >= 2) acc[pt][lt] = __builtin_amdgcn_mfma_f32_16x16x32_bf16(x1, lf[1][lt], acc[pt][lt], 0, 0, 0); } }
        const float dk = dskip[head]; float ssq[4] = {0.f, 0.f, 0.f, 0.f};
#pragma unroll
        for (int lt = 0; lt < 4; ++lt) { const int l = 16 * lt + c16;
#pragma unroll
            for (int pt = 0; pt < 4; ++pt) { const int p0 = 16 * pt + 4 * gq;
                const u32x2 xv = *(const LAS u32x2*)(xw + l * RSW + p0 * 2); const u32x2 zw = *(const GAS u32x2*)(P + (size_t)(m0 + l) * NMAIN + PZ + head * HP + p0);
                const float xs4[4] = {bflo(xv.x), bfhi(xv.x), bflo(xv.y), bfhi(xv.y)}, z4[4] = {bflo(zw.x), bfhi(zw.x), bflo(zw.y), bfhi(zw.y)};
#pragma unroll
                for (int j = 0; j < 4; ++j) { const float y = (acc[pt][lt][j] + dk * xs4[j]) * z4[j] * __builtin_amdgcn_rcpf(1.0f + __expf(-z4[j])); acc[pt][lt][j] = y; ssq[lt] += y * y; } } }
        LAS float* ssqs = (LAS float*)(lds + O_SSQ) + par * 512;
#pragma unroll
        for (int lt = 0; lt < 4; ++lt) { float v = ssq[lt]; v += __shfl_xor(v, 16); v += __shfl_xor(v, 32); if (gq == 0) ssqs[wave * 64 + 16 * lt + c16] = v; }
        LDS_WAIT();
        __syncthreads();
#pragma unroll
        for (int lt = 0; lt < 4; ++lt) { const int l = 16 * lt + c16; float tot = 0.f;
#pragma unroll
            for (int w8 = 0; w8 < 8; ++w8) tot += ssqs[w8 * 64 + l];
            const float rstd = rsqrtf(tot * (1.0f / (HPG * HP)) + EPS);
#pragma unroll
            for (int pt = 0; pt < 4; ++pt) { const int ch = head * HP + 16 * pt + 4 * gq; const f32x4 gn = *(const GAS f32x4*)(gnorm + ch); const f32x4 o = acc[pt][lt] * rstd * gn;
                if (YF8) *(GAS unsigned*)((GAS unsigned char*)Y + (size_t)(m0 + l) * DI + ch) = pack4_fp8(o.x, o.y, o.z, o.w);
                else { u32x2 w; w.x = pk2(o.x, o.y); w.y = pk2(o.z, o.w); *(GAS u32x2*)(Y + (size_t)(m0 + l) * DI + ch) = w; } } }
        LDS_WAIT(); asm volatile("" ::: "memory");
    }
}

__device__ __forceinline__ float gelu_tanhf_(float x) { const float u = 0.7978845608028654f * (x + 0.044715f * x * x * x); return x * __builtin_amdgcn_rcpf(1.0f + __expf(-2.0f * u)); }
template <bool F8> __device__ __forceinline__ void ph_ffn_act(const GAS bf16* U, const GAS float* cw, const GAS float* cb, GAS bf16* ACT, int gtid, int nthr) {
    constexpr int NCG = FF / 8, R = 8;
    for (int it = gtid; it < (M / R) * NCG; it += nthr) {
        const int c0 = (it % NCG) * 8, m0 = (it / NCG) * R, t0 = m0 & (SEQ - 1);
        f32x4 wg[3][2], wv[3][2];
#pragma unroll
        for (int i = 0; i < 3; ++i) { wg[i][0] = *(const GAS f32x4*)(cw + i * FF2 + c0); wg[i][1] = *(const GAS f32x4*)(cw + i * FF2 + c0 + 4); wv[i][0] = *(const GAS f32x4*)(cw + i * FF2 + FF + c0); wv[i][1] = *(const GAS f32x4*)(cw + i * FF2 + FF + c0 + 4); }
        const f32x4 bg0 = *(const GAS f32x4*)(cb + c0), bg1 = *(const GAS f32x4*)(cb + c0 + 4), bv0 = *(const GAS f32x4*)(cb + FF + c0), bv1 = *(const GAS f32x4*)(cb + FF + c0 + 4);
        u32x4 rg[R + 2], rv[R + 2];
#pragma unroll
        for (int i = 0; i < R + 2; ++i) { const bool ok = (t0 + i - 2) >= 0; const GAS bf16* ur = U + (size_t)(m0 + (ok ? i - 2 : 0)) * FF2 + c0;
            rg[i] = *(const GAS u32x4*)ur; rv[i] = *(const GAS u32x4*)(ur + FF); if (!ok) { rg[i] = (u32x4){0u, 0u, 0u, 0u}; rv[i] = (u32x4){0u, 0u, 0u, 0u}; } }
#pragma unroll
        for (int o = 0; o < R; ++o) { f32x4 g0 = bg0, g1 = bg1, v0 = bv0, v1 = bv1;
#pragma unroll
            for (int i = 0; i < 3; ++i) { float xg[8], xv[8]; unpack8(rg[o + i], xg); unpack8(rv[o + i], xv);
                g0 += wg[i][0] * (f32x4){xg[0], xg[1], xg[2], xg[3]}; g1 += wg[i][1] * (f32x4){xg[4], xg[5], xg[6], xg[7]};
                v0 += wv[i][0] * (f32x4){xv[0], xv[1], xv[2], xv[3]}; v1 += wv[i][1] * (f32x4){xv[4], xv[5], xv[6], xv[7]}; }
            float r[8] = {gelu_tanhf_(g0.x) * v0.x, gelu_tanhf_(g0.y) * v0.y, gelu_tanhf_(g0.z) * v0.z, gelu_tanhf_(g0.w) * v0.w, gelu_tanhf_(g1.x) * v1.x, gelu_tanhf_(g1.y) * v1.y, gelu_tanhf_(g1.z) * v1.z, gelu_tanhf_(g1.w) * v1.w};
            if (F8) *(GAS u32x2*)((GAS unsigned char*)ACT + (size_t)(m0 + o) * FF + c0) = pack8_fp8(r);
            else *(GAS u32x4*)(ACT + (size_t)(m0 + o) * FF + c0) = pack8(r); }
    }
}

struct Args { const float* in[20]; float* out; unsigned char* ws; int ph_lo, ph_hi; };
constexpr int NP = 11, NPHASE = 1 + DEPTH * NP;

#define AIN(i) ((const GAS float*)args.in[i])
__global__ void __launch_bounds__(NTHR, 2) fwd(Args args) {
    extern __shared__ __attribute__((aligned(16))) unsigned char lds[];
    const int G = gridDim.x, blk = blockIdx.x;
    volatile LAS unsigned* MISC = (volatile LAS unsigned*)((LAS unsigned char*)lds + MISC_OFF);
    for (int u = threadIdx.x; u < (LDS_BYTES - LDSCTL_OFF) / 4; u += NTHR) ((LAS unsigned*)((LAS unsigned char*)lds + LDSCTL_OFF))[u] = 0u;
    __syncthreads();
    XcdBarrier bar; bar.bar = (unsigned*)(args.ws + WS_CTL) + CW_BAR; bar.x = 0; bar.st = nullptr;
    if (!MK_PER_PHASE) bar = xcd_barrier_post((unsigned*)(args.ws + WS_CTL) + CW_BAR, MISC + 8);
    const int lo = args.ph_lo, hi = args.ph_hi;
#define IN(k) (lo <= (k) && (k) < hi)
#define SEAM(k) do { if (IN(k) && IN((k) + 1)) xcd_barrier(bar); } while (0)
#define PH_BEGIN \
    int tid = threadIdx.x; asm volatile("" : "+v"(tid)); \
    const int lane = tid & 63, wave = __builtin_amdgcn_readfirstlane(tid >> 6); \
    const int gw = blk * NWAVES + wave, ngw = G * NWAVES, gtid = blk * NTHR + tid, nthr = G * NTHR; \
    GAS unsigned char* ws = (GAS unsigned char*)args.ws; asm volatile("" : "+s"(ws)); \
    LAS unsigned char* ring = (LAS unsigned char*)lds; \
    (void)lane; (void)wave; (void)gw; (void)ngw; (void)gtid; (void)nthr; (void)ring; \
    GAS float* X = (GAS float*)args.out; \
    GAS bf16* H = (GAS bf16*)(ws + WS_H); GAS bf16* P = (GAS bf16*)(ws + WS_P); GAS float* SM = (GAS float*)(ws + WS_SM); GAS bf16* XC = (GAS bf16*)(ws + WS_XC); \
    GAS float* CD = (GAS float*)(ws + WS_DT); GAS bf16* STB = (GAS bf16*)(ws + WS_ST); GAS bf16* Y = (GAS bf16*)(ws + WS_Y); \
    GAS float* SC = (GAS float*)(ws + WS_SC); GAS unsigned long long* MASKW = (GAS unsigned long long*)(ws + WS_IDX); GAS bf16* AO = (GAS bf16*)(ws + WS_AO); \
    GAS float* MG = (GAS float*)(ws + WS_MG); GAS unsigned char* H8 = ws + WS_MG + 32 * MiB; GAS bf16* MGB = (GAS bf16*)(ws + WS_MGB); GAS bf16* YMB = (GAS bf16*)(ws + WS_YM); GAS bf16* XB = (GAS bf16*)(ws + WS_YM + 32 * MiB); GAS bf16* U = (GAS bf16*)(ws + WS_U); \
    GAS bf16* ACT = (GAS bf16*)(ws + WS_ACT); GAS bf16* KIB = (GAS bf16*)(ws + WS_KIB); \
    (void)X; (void)H; (void)P; (void)SM; (void)XC; (void)CD; (void)STB; (void)Y; (void)SC; (void)MASKW; (void)AO; (void)MG; (void)H8; (void)MGB; (void)YMB; (void)XB; (void)U; (void)ACT; (void)KIB;

    if (IN(0)) { PH_BEGIN
        WPtrs wp{AIN(5), AIN(13), AIN(14), AIN(15), AIN(16), AIN(19)};
        REP(5) ph_weights(wp, ws, ring + wave * 10240, gw, ngw, lane);
        ph_resid_norm<true, false, false>(nullptr, nullptr, AIN(1), AIN(0), nullptr, nullptr, XB, H, F8_IN == 0 ? H8 : nullptr, gw, ngw, lane);
    }
    SEAM(0);

#pragma unroll 1
    for (int layer = 0; layer < DEPTH; ++layer) {
        const int pb = 1 + layer * NP;
#define WL (ws + WS_W + (size_t)layer * WL_SIZE)
        if (IN(pb + 0)) { PH_BEGIN
            if (layer >= F8_IN) {
                { pg8::Gemm g{(const GAS bf16*)H8, (const GAS bf16*)(WL + WL_IN), M, PQI, D / 2, 0x7f7f7f7f, 0x79797979}; pg8::StaticOrder S; S.init(M, PQI, G, blk);
                  pg8::EpiIn E{P, NMAIN, AIN(6) + (size_t)layer * 2 * D, PG / 256, 0};
                  pg8::gemm_phase<pg8::EpiIn, pg8::StaticOrder, true, true, true>(ring, g, S, E); }
                __syncthreads();
                { pg8::Gemm g{H, (const GAS bf16*)(WL + WL_IN) + (size_t)PQI * D, M, NMAIN - PQI, D}; pg8::StaticOrder S; S.init(M, NMAIN - PQI, G, (blk + G / 2) % G);
                  pg8::EpiIn E{P, NMAIN, AIN(6) + (size_t)layer * 2 * D, PG / 256, PQI / 256};
                  pg8::gemm_phase<pg8::EpiIn, pg8::StaticOrder, true, true>(ring, g, S, E); }
                __syncthreads();
            } else
            { pg8::Gemm g{H, (const GAS bf16*)(WL + WL_IN), M, NMAIN, D}; pg8::StaticOrder S; S.init(M, NMAIN, G, blk);
              pg8::EpiIn E{P, NMAIN, AIN(6) + (size_t)layer * 2 * D, PG / 256, 0};
              REP(1) { pg8::gemm_phase<pg8::EpiIn, pg8::StaticOrder, true, true>(ring, g, S, E); __syncthreads(); } }
            REP(2) { ph_small_proj(H, (const GAS bf16*)(WL + WL_IN) + (size_t)NMAIN * D, SM, KIB, ring, blk, G, tid); __syncthreads(); }
        }
        SEAM(pb + 0);
        if (IN(pb + 1)) { PH_BEGIN
            REP(20) { ph_ssd_states(P, SM, AIN(7) + (size_t)layer * 4 * CONVD, AIN(8) + (size_t)layer * CONVD, AIN(9) + layer * NH, AIN(10) + layer * NH, XC, STB, CD, ring, blk, G, tid); __syncthreads(); }
            REP(21) { ph_index_scores(P, SM, KIB, SC, ring, blk, G, tid); __syncthreads(); } }
        SEAM(pb + 1);
        if (IN(pb + 2)) { PH_BEGIN
            ph_ssd_scan(STB, CD, gtid, nthr); REP(30) ph_topk(SC, MASKW, ring + wave * 9728, gw, ngw, lane);
#if PROBE_DOUBLE == 31
            ph_ssd_scan((GAS bf16*)U, CD, gtid, nthr);
#endif
            }
        SEAM(pb + 2);
        if (IN(pb + 3)) { PH_BEGIN
            if (layer >= F8_OUT) { ph_ssd_out<true>(P, SM, XC, AIN(9) + layer * NH, AIN(10) + layer * NH, STB, AIN(11) + layer * NH, AIN(12) + (size_t)layer * DI, Y, ring, blk, G, tid); __syncthreads();
                ph_attn_dense<16>(P, MASKW, AO, ring, blk, G, tid); __syncthreads(); }
            else { REP(40) { ph_ssd_out<false>(P, SM, XC, AIN(9) + layer * NH, AIN(10) + layer * NH, STB, AIN(11) + layer * NH, AIN(12) + (size_t)layer * DI, Y, ring, blk, G, tid); __syncthreads(); }
                REP(41) { ph_attn_dense<0>(P, MASKW, AO, ring, blk, G, tid); __syncthreads(); } }
            }
        SEAM(pb + 3);
        if (IN(pb + 4)) {
            { PH_BEGIN
              pg8::StaticOrder S; S.init(M, D, G, blk); pg8::EpiGateMul E{MGB, D, P + PG, NMAIN};
              if (layer >= F8_OUT) { pg8::Gemm g{Y, (const GAS bf16*)(WL + WL_SSM), M, D, DI / 2, 0x7f7f7f7f, 0x79797979}; pg8::gemm_phase<pg8::EpiGateMul, pg8::StaticOrder, false, true, true>(ring, g, S, E); }
              else { pg8::Gemm g{Y, (const GAS bf16*)(WL + WL_SSM), M, D, DI}; pg8::gemm_phase<pg8::EpiGateMul, pg8::StaticOrder, false, true>(ring, g, S, E); } }
            __syncthreads();
            { PH_BEGIN
              pg8::StaticOrder S; S.init(M, D, G, blk); pg8::EpiGateAdd E{MGB, D, P + PG + D, NMAIN, layer >= F8_MIX ? (GAS unsigned char*)MG : nullptr};
              if (layer >= F8_OUT) { pg8::Gemm g{AO, (const GAS bf16*)(WL + WL_ATT), M, D, D / 2, 0x7f7f7f7f, 0x79797979}; pg8::gemm_phase<pg8::EpiGateAdd, pg8::StaticOrder, false, true, true>(ring, g, S, E); }
              else { pg8::Gemm g{AO, (const GAS bf16*)(WL + WL_ATT), M, D, D}; pg8::gemm_phase<pg8::EpiGateAdd, pg8::StaticOrder, false, true>(ring, g, S, E); } }
        }
        SEAM(pb + 4);
        if (IN(pb + 5)) { PH_BEGIN
            pg8::StaticOrder S; S.init(M, D, G, blk); pg8::EpiBf16<0> E{YMB, D, nullptr, 0, 0, 1.f};
            if (layer >= F8_MIX) { pg8::Gemm g{(const GAS bf16*)MG, (const GAS bf16*)(WL + WL_MIX), M, D, D / 2, 0x7f7f7f7f, 0x79797979}; pg8::gemm_phase<pg8::EpiBf16<0>, pg8::StaticOrder, false, true, true>(ring, g, S, E); }
            else { pg8::Gemm g{MGB, (const GAS bf16*)(WL + WL_MIX), M, D, D}; REP(60) { pg8::gemm_phase<pg8::EpiBf16<0>, pg8::StaticOrder, false, true>(ring, g, S, E); __syncthreads(); } } }
        SEAM(pb + 5);
        if (IN(pb + 6)) { PH_BEGIN
            if (layer >= F8_UP) ph_resid_norm<false, true, false, true>(YMB, AIN(2) + (size_t)layer * D, AIN(3) + (size_t)layer * D, nullptr, XB, nullptr, XB, H, nullptr, gw, ngw, lane);
            else ph_resid_norm<false, true, false>(YMB, AIN(2) + (size_t)layer * D, AIN(3) + (size_t)layer * D, nullptr, XB, nullptr, XB, H, nullptr, gw, ngw, lane); }
        SEAM(pb + 6);
        if (IN(pb + 7)) { PH_BEGIN
            pg8::StaticOrder S; S.init(M, FF2, G, blk); pg8::EpiBf16<0> E{U, FF2, nullptr, 0, 0, 1.f};
            if (layer >= F8_UP) { pg8::Gemm g{H, (const GAS bf16*)(WL + WL_UP), M, FF2, D / 2, 0x7f7f7f7f, 0x79797979}; pg8::gemm_phase<pg8::EpiBf16<0>, pg8::StaticOrder, true, true, true>(ring, g, S, E); }
            else { pg8::Gemm g{H, (const GAS bf16*)(WL + WL_UP), M, FF2, D}; REP(80) { pg8::gemm_phase<pg8::EpiBf16<0>, pg8::StaticOrder, true, true>(ring, g, S, E); __syncthreads(); } } }
        SEAM(pb + 7);
        if (IN(pb + 8)) { PH_BEGIN
            if (layer >= F8_DN) ph_ffn_act<true>(U, AIN(17) + (size_t)layer * 3 * FF2, AIN(18) + (size_t)layer * FF2, ACT, gtid, nthr);
            else REP(90) ph_ffn_act<false>(U, AIN(17) + (size_t)layer * 3 * FF2, AIN(18) + (size_t)layer * FF2, ACT, gtid, nthr); }
        SEAM(pb + 8);
        if (IN(pb + 9)) { PH_BEGIN
            pg8::StaticOrder S; S.init(M, D, G, blk); pg8::EpiBf16<0> E{YMB, D, nullptr, 0, 0, 1.f};
            if (layer >= F8_DN) { pg8::Gemm g{ACT, (const GAS bf16*)(WL + WL_DN), M, D, FF / 2, 0x7f7f7f7f, 0x79797979}; pg8::gemm_phase<pg8::EpiBf16<0>, pg8::StaticOrder, false, true, true>(ring, g, S, E); }
            else { pg8::Gemm g{ACT, (const GAS bf16*)(WL + WL_DN), M, D, FF}; REP(100) { pg8::gemm_phase<pg8::EpiBf16<0>, pg8::StaticOrder, false, true>(ring, g, S, E); __syncthreads(); } } }
        SEAM(pb + 9);
        if (IN(pb + 10)) { PH_BEGIN
            if (layer + 1 < DEPTH) ph_resid_norm<false, true, false>(YMB, AIN(4) + (size_t)layer * D, AIN(1) + (size_t)(layer + 1) * D, nullptr, XB, nullptr, XB, H, layer + 1 >= F8_IN ? H8 : nullptr, gw, ngw, lane);
            else ph_resid_norm<false, true, true>(YMB, AIN(4) + (size_t)layer * D, nullptr, nullptr, XB, X, nullptr, H, nullptr, gw, ngw, lane); }
        SEAM(pb + 10);
    }
#undef IN
#undef SEAM
#undef WL
#undef PH_BEGIN
}

extern "C" void kernel_launch(void* const* d_in, const int* in_sizes, int n_in, void* d_out, int out_size, void* d_ws, size_t ws_size, hipStream_t stream) {
    static int grid = 0;
    if (grid == 0) {
        if (n_in != 20 || in_sizes[0] != M * D || out_size != M * D || ws_size < WS_END) { fprintf(stderr, "kernel_launch: unexpected shapes (n_in %d, in0 %d, out %d, ws %zu < %zu)\n", n_in, n_in > 0 ? in_sizes[0] : -1, out_size, ws_size, (size_t)WS_END); grid = -1; return; }
        int dev = 0, cus = 0, per_cu = 0;
        if (hipGetDevice(&dev) != hipSuccess || hipDeviceGetAttribute(&cus, hipDeviceAttributeMultiprocessorCount, dev) != hipSuccess) { grid = -1; return; }
        if (hipFuncSetAttribute((const void*)fwd, hipFuncAttributeMaxDynamicSharedMemorySize, LDS_BYTES) != hipSuccess) { fprintf(stderr, "kernel_launch: hipFuncSetAttribute failed\n"); grid = -1; return; }
        if (hipOccupancyMaxActiveBlocksPerMultiprocessor(&per_cu, (const void*)fwd, NTHR, LDS_BYTES) != hipSuccess || per_cu < 1) fprintf(stderr, "kernel_launch: occupancy query reports %d blocks per CU\n", per_cu);
        (void)hipGetLastError();
        grid = cus;
    }
    if (grid < 0) return;
    if (hipMemsetAsync((char*)d_ws + WS_CTL, 0, CTL_ZERO_BYTES, stream) != hipSuccess) return;
    Args a{};
    for (int i = 0; i < 20; ++i) a.in[i] = (const float*)d_in[i];
    a.out = (float*)d_out; a.ws = (unsigned char*)d_ws;
#if MK_PER_PHASE
    for (int ph = 0; ph < NPHASE; ++ph) { a.ph_lo = ph; a.ph_hi = ph + 1; hipLaunchKernelGGL(fwd, dim3(grid), dim3(NTHR), LDS_BYTES, stream, a); }
#else
    a.ph_lo = 0; a.ph_hi = NPHASE; hipLaunchKernelGGL(fwd, dim3(grid), dim3(NTHR), LDS_BYTES, stream, a);
#endif
}
```

```cpp
#include <hip/hip_runtime.h>
#include <cstdio>
#include <cstdint>
#define MK_PER_PHASE 0
namespace pg8 {
#define PG8_LAS __attribute__((address_space(3)))
#define PG8_GAS __attribute__((address_space(1)))
typedef unsigned short bf16_t;
typedef short bf16x8 __attribute__((ext_vector_type(8)));
typedef float f32x4 __attribute__((ext_vector_type(4)));
typedef unsigned u32x4 __attribute__((ext_vector_type(4)));
constexpr int BM = 256, BK = 64, HALF = 128, HTB = HALF * BK * 2  , STAGE_BYTES = 8 * HTB, NXCD = 8, WGM = 8;

__host__ __device__ __forceinline__ int lds_byte(int r, int c) { const int st = (r >> 4) * 2 + (c >> 5), rr = r & 15, cc = c & 31, ob = rr * 64 + cc * 2; return st * 1024 + (ob ^ (((ob >> 9) & 1) << 5)); }
__host__ __device__ __forceinline__ void stage_rc(int b, int& R, int& C) { const int st = b / 1024, sb = b % 1024, swz = sb ^ (((sb >> 9) & 1) << 5); R = (st >> 1) * 16 + swz / 64; C = (st & 1) * 32 + (swz % 64) / 2; }
__host__ __device__ __forceinline__ int perm32(int rho) { const int n = rho >> 4, i = rho & 15; return 8 * (i >> 2) + 4 * n + (i & 3); }

struct Unit { int pm, pn; };
struct Gemm { const PG8_GAS bf16_t* A; const PG8_GAS bf16_t* Bt; int M, N, K; int sa, sb; };

struct StaticOrder {
    int nM, nN, nwg, G, c;
    __host__ __device__ void init(int M, int N, int G_, int c_) { nM = M / BM; nN = N / BM; nwg = nM * nN; G = G_; c = c_; }
    __host__ __device__ bool next(int i, Unit& u) const {
        const long L = (long)i * G + c; if (L >= nwg) return false;
        int wgid = (int)L; { const int q = nwg / NXCD, r = nwg % NXCD, xcd = wgid % NXCD, off = wgid / NXCD; wgid = (xcd < r ? xcd * (q + 1) : r * (q + 1) + (xcd - r) * q) + off; }
        const int nig = WGM * nN, gid = wgid / nig, fm = gid * WGM, gsz = (nM - fm) < WGM ? (nM - fm) : WGM;
        u.pm = fm + ((wgid % nig) % gsz); u.pn = (wgid % nig) / gsz; return true;
    }
    __device__ __forceinline__ void a_ready(const Unit&) const {}
    __device__ __forceinline__ void done(const Unit&) const {}
};

__device__ __forceinline__ unsigned cvt_pk_bf16(float lo, float hi) { unsigned r; asm volatile("v_cvt_pk_bf16_f32 %0, %1, %2" : "=v"(r) : "v"(lo), "v"(hi)); return r; }
typedef float f32x2 __attribute__((ext_vector_type(2)));
__device__ __forceinline__ f32x2 gelu_pk(f32x2 v) {
    const f32x2 av = __builtin_elementwise_abs(v), d = av * 0.2316418882f + 1.0f;
    f32x2 t; t.x = __builtin_amdgcn_rcpf(d.x); t.y = __builtin_amdgcn_rcpf(d.y);
    f32x2 q = t * 0.5307027145f + (-0.7265760135f); q = q * t + 0.7107068705f; q = q * t + (-0.142248368f); q = q * t + 0.127414796f; q = q * t;
    const f32x2 s = (v * v) * (-0.72134752044f);
    f32x2 e; e.x = __builtin_amdgcn_exp2f(s.x); e.y = __builtin_amdgcn_exp2f(s.y);
    const f32x2 m = v * (q * e), r = v - m;
    f32x2 o; o.x = v.x < 0.f ? m.x : r.x; o.y = v.y < 0.f ? m.y : r.y; return o;
}

template <int ACT  > struct EpiBf16 {
    static constexpr bool PERM = true, AFTER_DRAIN = false; static_assert(ACT == 0 || ACT == 1, "EpiBf16: ACT is 0 (none) or 1 (gelu_pk)");
    PG8_GAS bf16_t* O; int ldc; const PG8_GAS float* bias; int split_cols; size_t split_stride; float scale0;
    __device__ __forceinline__ void operator()(const f32x4 (&acc)[2][2][4][2], const Unit& u, int wr, int wc, int fr, int fq) const {
        const int row0 = u.pm * BM + wr * 64 + fr; int colt = u.pn * BM; PG8_GAS bf16_t* base = O;
        float sc = 1.f; if (split_cols) { const int t = colt / split_cols; base += (size_t)t * split_stride; colt -= t * split_cols; if (t == 0) sc = scale0; }
        const int col0 = colt + wc * 32 + 8 * fq, bcol0 = u.pn * BM + wc * 32 + 8 * fq;
        f32x4 bv[2][2];
#pragma unroll
        for (int bj = 0; bj < 2; ++bj)
#pragma unroll
            for (int n = 0; n < 2; ++n) bv[bj][n] = bias ? *(const PG8_GAS f32x4*)(bias + bcol0 + bj * HALF + 4 * n) : (f32x4){0.f, 0.f, 0.f, 0.f};
#pragma unroll
        for (int ai = 0; ai < 2; ++ai)
#pragma unroll
            for (int m = 0; m < 4; ++m) { PG8_GAS bf16_t* rowp = base + (size_t)(row0 + ai * HALF + m * 16) * ldc + col0;
#pragma unroll
                for (int bj = 0; bj < 2; ++bj) { f32x4 v0 = acc[ai][bj][m][0] + bv[bj][0], v1 = acc[ai][bj][m][1] + bv[bj][1];
                    if (ACT == 1) { f32x2 a = gelu_pk((f32x2){v0[0], v0[1]}), b = gelu_pk((f32x2){v0[2], v0[3]}), c = gelu_pk((f32x2){v1[0], v1[1]}), d = gelu_pk((f32x2){v1[2], v1[3]});
                        v0 = (f32x4){a.x, a.y, b.x, b.y}; v1 = (f32x4){c.x, c.y, d.x, d.y}; }
                    v0 = v0 * sc; v1 = v1 * sc; u32x4 w; w.x = cvt_pk_bf16(v0[0], v0[1]); w.y = cvt_pk_bf16(v0[2], v0[3]); w.z = cvt_pk_bf16(v1[0], v1[1]); w.w = cvt_pk_bf16(v1[2], v1[3]);
                    *(PG8_GAS u32x4*)(rowp + bj * HALF) = w; } }
    }
};

struct EpiF32 {
    static constexpr bool PERM = false, AFTER_DRAIN = false;
    PG8_GAS float* C; int ldc;
    __device__ __forceinline__ void operator()(const f32x4 (&acc)[2][2][4][2], const Unit& u, int wr, int wc, int fr, int fq) const {
        const int row0 = u.pm * BM + wr * 64 + fr, col0 = u.pn * BM + wc * 32 + 4 * fq;
#pragma unroll
        for (int ai = 0; ai < 2; ++ai)
#pragma unroll
            for (int m = 0; m < 4; ++m) { PG8_GAS float* rowp = C + (size_t)(row0 + ai * HALF + m * 16) * ldc + col0;
#pragma unroll
                for (int bj = 0; bj < 2; ++bj)
#pragma unroll
                    for (int n = 0; n < 2; ++n) *(PG8_GAS f32x4*)(rowp + bj * HALF + n * 16) = acc[ai][bj][m][n]; }
    }
};
__device__ __forceinline__ float bf_lo(unsigned w) { return __uint_as_float(w << 16); }
__device__ __forceinline__ float bf_hi(unsigned w) { return __uint_as_float(w & 0xffff0000u); }
__device__ __forceinline__ float sigmoidf_(float x) { return __builtin_amdgcn_rcpf(1.0f + __expf(-x)); }
struct EpiIn {
    static constexpr bool PERM = true, AFTER_DRAIN = false;
    PG8_GAS bf16_t* P; int ldp; const PG8_GAS float* bgate; int gate_tile0, tile0;
    __device__ __forceinline__ void operator()(const f32x4 (&acc)[2][2][4][2], const Unit& u, int wr, int wc, int fr, int fq) const {
        const int pn = u.pn + tile0, row0 = u.pm * BM + wr * 64 + fr, colt = pn * BM + wc * 32 + 8 * fq;
        {
            const bool gate = pn >= gate_tile0 && pn < gate_tile0 + 16;
            f32x4 bv[2][2];
#pragma unroll
            for (int bj = 0; bj < 2; ++bj)
#pragma unroll
                for (int n = 0; n < 2; ++n) bv[bj][n] = gate ? *(const PG8_GAS f32x4*)(bgate + (colt - gate_tile0 * BM) + bj * HALF + 4 * n) : (f32x4){0.f, 0.f, 0.f, 0.f};
#pragma unroll
            for (int ai = 0; ai < 2; ++ai)
#pragma unroll
                for (int m = 0; m < 4; ++m) { PG8_GAS bf16_t* rowp = P + (size_t)(row0 + ai * HALF + m * 16) * ldp + colt;
#pragma unroll
                    for (int bj = 0; bj < 2; ++bj) { f32x4 v0 = acc[ai][bj][m][0] + bv[bj][0], v1 = acc[ai][bj][m][1] + bv[bj][1];
                        if (gate) {
#pragma unroll
                            for (int j = 0; j < 4; ++j) { v0[j] = sigmoidf_(v0[j]); v1[j] = sigmoidf_(v1[j]); } }
                        u32x4 w; w.x = cvt_pk_bf16(v0[0], v0[1]); w.y = cvt_pk_bf16(v0[2], v0[3]); w.z = cvt_pk_bf16(v1[0], v1[1]); w.w = cvt_pk_bf16(v1[2], v1[3]);
                        *(PG8_GAS u32x4*)(rowp + bj * HALF) = w; } }
        }
    }
};
struct EpiGateMul {
    static constexpr bool PERM = true, AFTER_DRAIN = false;
    PG8_GAS bf16_t* O; int ldc; const PG8_GAS bf16_t* G; int ldg;
    __device__ __forceinline__ void operator()(const f32x4 (&acc)[2][2][4][2], const Unit& u, int wr, int wc, int fr, int fq) const {
        const int row0 = u.pm * BM + wr * 64 + fr, colt = u.pn * BM + wc * 32 + 8 * fq;
#pragma unroll
        for (int ai = 0; ai < 2; ++ai)
#pragma unroll
            for (int m = 0; m < 4; ++m) { const size_t row = (size_t)(row0 + ai * HALF + m * 16);
#pragma unroll
                for (int bj = 0; bj < 2; ++bj) { const u32x4 g = *(const PG8_GAS u32x4*)(G + row * ldg + colt + bj * HALF);
                    const f32x4 a0 = acc[ai][bj][m][0], a1 = acc[ai][bj][m][1];
                    u32x4 w; w.x = cvt_pk_bf16(a0[0] * bf_lo(g.x), a0[1] * bf_hi(g.x)); w.y = cvt_pk_bf16(a0[2] * bf_lo(g.y), a0[3] * bf_hi(g.y));
                    w.z = cvt_pk_bf16(a1[0] * bf_lo(g.z), a1[1] * bf_hi(g.z)); w.w = cvt_pk_bf16(a1[2] * bf_lo(g.w), a1[3] * bf_hi(g.w));
                    *(PG8_GAS u32x4*)(O + row * ldc + colt + bj * HALF) = w; } }
    }
};
struct EpiGateAdd {
    static constexpr bool PERM = true, AFTER_DRAIN = false;
    PG8_GAS bf16_t* O; int ldc; const PG8_GAS bf16_t* G; int ldg; PG8_GAS unsigned char* O8;
    __device__ __forceinline__ void operator()(const f32x4 (&acc)[2][2][4][2], const Unit& u, int wr, int wc, int fr, int fq) const {
        const int row0 = u.pm * BM + wr * 64 + fr, colt = u.pn * BM + wc * 32 + 8 * fq;
#pragma unroll
        for (int ai = 0; ai < 2; ++ai)
#pragma unroll
            for (int m = 0; m < 4; ++m) { const size_t row = (size_t)(row0 + ai * HALF + m * 16);
#pragma unroll
                for (int bj = 0; bj < 2; ++bj) { const u32x4 g = *(const PG8_GAS u32x4*)(G + row * ldg + colt + bj * HALF);
                    PG8_GAS u32x4* op = (PG8_GAS u32x4*)(O + row * ldc + colt + bj * HALF); const u32x4 p = *op;
                    const f32x4 a0 = acc[ai][bj][m][0], a1 = acc[ai][bj][m][1];
                    const float s0 = bf_lo(p.x) + a0[0] * bf_lo(g.x), s1 = bf_hi(p.x) + a0[1] * bf_hi(g.x), s2 = bf_lo(p.y) + a0[2] * bf_lo(g.y), s3 = bf_hi(p.y) + a0[3] * bf_hi(g.y);
                    const float s4 = bf_lo(p.z) + a1[0] * bf_lo(g.z), s5 = bf_hi(p.z) + a1[1] * bf_hi(g.z), s6 = bf_lo(p.w) + a1[2] * bf_lo(g.w), s7 = bf_hi(p.w) + a1[3] * bf_hi(g.w);
                    if (O8) { int lo = 0, hi = 0; lo = __builtin_amdgcn_cvt_pk_fp8_f32(s0, s1, lo, false); lo = __builtin_amdgcn_cvt_pk_fp8_f32(s2, s3, lo, true); hi = __builtin_amdgcn_cvt_pk_fp8_f32(s4, s5, hi, false); hi = __builtin_amdgcn_cvt_pk_fp8_f32(s6, s7, hi, true);
                        typedef unsigned u32x2e __attribute__((ext_vector_type(2))); u32x2e w8; w8.x = (unsigned)lo; w8.y = (unsigned)hi; *(PG8_GAS u32x2e*)(O8 + row * ldc + colt + bj * HALF) = w8; }
                    else { u32x4 w; w.x = cvt_pk_bf16(s0, s1); w.y = cvt_pk_bf16(s2, s3); w.z = cvt_pk_bf16(s4, s5); w.w = cvt_pk_bf16(s6, s7); *op = w; } } }
    }
};
template <class Epi, class Sched, bool ALIGN_EPI = false, bool SP2 = false, bool FP8 = false>
__device__ __forceinline__ void gemm_phase(PG8_LAS unsigned char* lds, const Gemm g, const Sched& S, const Epi& E) {
    int tid = threadIdx.x; asm volatile("" : "+v"(tid));
    const int wid = __builtin_amdgcn_readfirstlane(tid >> 6), lane = tid & 63, wr = wid >> 2, wc = wid & 3, fr = lane & 15, fq = lane >> 4;
    const int K = g.K, nt = K / BK;
    unsigned voffA[2], voffB[2];
#pragma unroll
    for (int i = 0; i < 2; ++i) { int R, C; stage_rc(tid * 16 + i * 8192, R, C); const int Rb = Epi::PERM ? ((R & ~31) + perm32(R & 31)) : R;
        voffA[i] = (unsigned)(R * K + C) * 2u; voffB[i] = (unsigned)(Rb * K + C) * 2u; }
    const size_t kstep = (size_t)(BK * 2);
    const size_t hstep = (size_t)HALF * K * 2;
    const size_t tstep = 2 * hstep;
    const unsigned ldsw = (unsigned)wid * 1024u;
    const int aoff = lds_byte(wr * 64 + fr, fq * 8), boff = lds_byte(wc * 32 + fr, fq * 8);
#define PG8_SA(b, h) (((b) * 2 + (h)) * HTB)
#define PG8_SB(b, h) ((4 + (b) * 2 + (h)) * HTB)
#define PG8_STAGE(bufoff, gbase, voff) do { _Pragma("unroll") for (int _i = 0; _i < 2; ++_i) \
        __builtin_amdgcn_global_load_lds((const PG8_GAS unsigned*)((const PG8_GAS char*)(gbase) + (voff)[_i]), (PG8_LAS unsigned*)(lds + (bufoff) + ldsw + _i * 8192), 16, 0, 0); } while (0)
typedef int pg8_v4i __attribute__((ext_vector_type(4))); typedef int pg8_v8i __attribute__((ext_vector_type(8)));
#define PG8_CAT(x, y) __builtin_shufflevector(__builtin_bit_cast(pg8_v4i, (x)), __builtin_bit_cast(pg8_v4i, (y)), 0, 1, 2, 3, 4, 5, 6, 7)
#define PG8_LDA(dst, b, h) do { if constexpr (FP8) { _Pragma("unroll") for (int m = 0; m < 4; ++m) dst##8[m] = PG8_CAT(*(const PG8_LAS bf16x8*)(lds + PG8_SA(b, h) + aoff + m * 2048), *(const PG8_LAS bf16x8*)(lds + PG8_SA(b, h) + aoff + m * 2048 + 1024)); } \
        else { _Pragma("unroll") for (int m = 0; m < 4; ++m) _Pragma("unroll") for (int k = 0; k < 2; ++k) dst[m][k] = *(const PG8_LAS bf16x8*)(lds + PG8_SA(b, h) + aoff + m * 2048 + k * 1024); } } while (0)
#define PG8_LDB(dst, b, h) do { if constexpr (FP8) { _Pragma("unroll") for (int n = 0; n < 2; ++n) dst##8[n] = PG8_CAT(*(const PG8_LAS bf16x8*)(lds + PG8_SB(b, h) + boff + n * 2048), *(const PG8_LAS bf16x8*)(lds + PG8_SB(b, h) + boff + n * 2048 + 1024)); } \
        else { _Pragma("unroll") for (int n = 0; n < 2; ++n) _Pragma("unroll") for (int k = 0; k < 2; ++k) dst[n][k] = *(const PG8_LAS bf16x8*)(lds + PG8_SB(b, h) + boff + n * 2048 + k * 1024); } } while (0)
#define PG8_MMA(ai, bj, At, Bt) do { __builtin_amdgcn_s_setprio(1); \
        if constexpr (FP8) { _Pragma("unroll") for (int m = 0; m < 4; ++m) _Pragma("unroll") for (int n = 0; n < 2; ++n) \
            asm volatile("v_mfma_scale_f32_16x16x128_f8f6f4 %0, %1, %2, %0, %3, %4 op_sel_hi:[0,0,0]" : "+v"(acc[ai][bj][m][n]) : "v"(Bt##8[n]), "v"(At##8[m]), "v"(sc_b), "v"(sc_a)); } \
        else { _Pragma("unroll") for (int m = 0; m < 4; ++m) _Pragma("unroll") for (int n = 0; n < 2; ++n) _Pragma("unroll") for (int k = 0; k < 2; ++k) \
            acc[ai][bj][m][n] = __builtin_amdgcn_mfma_f32_16x16x32_bf16(Bt[n][k], At[m][k], acc[ai][bj][m][n], 0, 0, 0); } \
        __builtin_amdgcn_s_setprio(0); } while (0)
#define PG8_WAIT_V(n) asm volatile("s_waitcnt vmcnt(" #n ")" ::: "memory")
#define PG8_WAIT_L(n) asm volatile("s_waitcnt lgkmcnt(" #n ")" ::: "memory")
#define PG8_BAR __builtin_amdgcn_s_barrier()
#define PG8_SCHED __builtin_amdgcn_sched_barrier(0)
    Unit cur, nxt; int ui = 0;
    if (!S.next(0, cur)) return;
    f32x4 acc[2][2][4][2];
#pragma unroll
    for (int a = 0; a < 2; ++a)
#pragma unroll
        for (int b = 0; b < 2; ++b)
#pragma unroll
            for (int m = 0; m < 4; ++m)
#pragma unroll
                for (int n = 0; n < 2; ++n) acc[a][b][m][n] = (f32x4){0.f, 0.f, 0.f, 0.f};
    const int sc_a = g.sa, sc_b = g.sb;
    bf16x8 At[4][2], B0[2][2], B1[2][2]; pg8_v8i At8[4], B08[2], B18[2];
    const PG8_GAS char* cA = (const PG8_GAS char*)g.A + (size_t)cur.pm * tstep; const PG8_GAS char* cB = (const PG8_GAS char*)g.Bt + (size_t)cur.pn * tstep;
    S.a_ready(cur);
    if constexpr (SP2) {
        PG8_STAGE(PG8_SB(0, 0), cB, voffB); PG8_STAGE(PG8_SB(0, 1), cB + hstep, voffB); PG8_STAGE(PG8_SA(0, 0), cA, voffA); PG8_STAGE(PG8_SA(0, 1), cA + hstep, voffA);
        if (wr == 1) PG8_BAR;
        PG8_WAIT_V(2); PG8_BAR;
        PG8_STAGE(PG8_SB(1, 0), cB + kstep, voffB); PG8_STAGE(PG8_SA(1, 0), cA + kstep, voffA); PG8_STAGE(PG8_SB(1, 1), cB + hstep + kstep, voffB);
        PG8_WAIT_V(6); PG8_BAR;
    } else {
        PG8_STAGE(PG8_SB(0, 0), cB, voffB); PG8_STAGE(PG8_SA(0, 0), cA, voffA); PG8_STAGE(PG8_SB(0, 1), cB + hstep, voffB); PG8_STAGE(PG8_SA(0, 1), cA + hstep, voffA);
        if (wr == 1) PG8_BAR;
        PG8_WAIT_V(4); PG8_BAR;
        PG8_STAGE(PG8_SB(1, 0), cB + kstep, voffB); PG8_STAGE(PG8_SA(1, 0), cA + kstep, voffA); PG8_STAGE(PG8_SB(1, 1), cB + hstep + kstep, voffB);
        PG8_WAIT_V(6); PG8_BAR;
    }
    for (;;) {
        const bool has_next = S.next(ui + 1, nxt);
        const PG8_GAS char* nA = has_next ? (const PG8_GAS char*)g.A + (size_t)nxt.pm * tstep : cA; const PG8_GAS char* nB = has_next ? (const PG8_GAS char*)g.Bt + (size_t)nxt.pn * tstep : cB;
        for (int t = 0; t < nt; t += 2) {
            const bool last = (t == nt - 2);
            const PG8_GAS char* a1 = cA + (size_t)(t + 1) * kstep;
            const PG8_GAS char* a2 = last ? nA : cA + (size_t)(t + 2) * kstep; const PG8_GAS char* b2 = last ? nB : cB + (size_t)(t + 2) * kstep;
            const PG8_GAS char* a3 = a2 + kstep; const PG8_GAS char* b3 = b2 + kstep;
            if (last && has_next) S.a_ready(nxt);
            if constexpr (SP2) {
            PG8_LDB(B0, 0, 0); PG8_LDB(B1, 0, 1); PG8_SCHED; PG8_LDA(At, 0, 0); PG8_STAGE(PG8_SA(1, 1), a1 + hstep, voffA);
            PG8_WAIT_V(8); PG8_WAIT_L(0); PG8_BAR; PG8_MMA(0, 0, At, B0); PG8_MMA(0, 1, At, B1); PG8_BAR; PG8_SCHED;
            PG8_LDA(At, 0, 1); PG8_STAGE(PG8_SB(0, 0), b2, voffB); PG8_STAGE(PG8_SB(0, 1), b2 + hstep, voffB); PG8_STAGE(PG8_SA(0, 0), a2, voffA);
            PG8_WAIT_V(8); PG8_WAIT_L(0); PG8_BAR; PG8_MMA(1, 0, At, B0); PG8_MMA(1, 1, At, B1); PG8_BAR; PG8_SCHED;
            PG8_LDB(B0, 1, 0); PG8_LDB(B1, 1, 1); PG8_SCHED; PG8_LDA(At, 1, 0); PG8_STAGE(PG8_SA(0, 1), a2 + hstep, voffA);
            PG8_WAIT_V(8); PG8_WAIT_L(0); PG8_BAR; PG8_MMA(0, 0, At, B0); PG8_MMA(0, 1, At, B1); PG8_BAR; PG8_SCHED;
            PG8_LDA(At, 1, 1); PG8_STAGE(PG8_SB(1, 0), b3, voffB); PG8_STAGE(PG8_SB(1, 1), b3 + hstep, voffB); PG8_STAGE(PG8_SA(1, 0), a3, voffA);
            PG8_WAIT_V(8); PG8_WAIT_L(0); PG8_BAR; PG8_MMA(1, 0, At, B0); PG8_MMA(1, 1, At, B1); PG8_BAR; PG8_SCHED;
            } else {
            PG8_LDB(B0, 0, 0); PG8_SCHED; PG8_LDA(At, 0, 0); PG8_STAGE(PG8_SA(1, 1), a1 + hstep, voffA);
            PG8_WAIT_L(8); PG8_BAR; PG8_WAIT_L(0); PG8_MMA(0, 0, At, B0); PG8_BAR; PG8_SCHED;
            PG8_LDB(B1, 0, 1); PG8_STAGE(PG8_SB(0, 0), b2, voffB);
            PG8_BAR; PG8_WAIT_L(0); PG8_MMA(0, 1, At, B1); PG8_BAR;
            PG8_LDA(At, 0, 1); PG8_STAGE(PG8_SA(0, 0), a2, voffA);
            PG8_BAR; PG8_WAIT_L(0); PG8_MMA(1, 0, At, B0); PG8_BAR; PG8_SCHED;
            PG8_STAGE(PG8_SB(0, 1), b2 + hstep, voffB);
            PG8_WAIT_V(6); PG8_BAR; PG8_MMA(1, 1, At, B1); PG8_BAR;
            PG8_LDB(B0, 1, 0); PG8_SCHED; PG8_LDA(At, 1, 0); PG8_STAGE(PG8_SA(0, 1), a2 + hstep, voffA);
            PG8_WAIT_L(8); PG8_BAR; PG8_WAIT_L(0); PG8_MMA(0, 0, At, B0); PG8_BAR; PG8_SCHED;
            PG8_LDB(B1, 1, 1); PG8_STAGE(PG8_SB(1, 0), b3, voffB);
            PG8_BAR; PG8_WAIT_L(0); PG8_MMA(0, 1, At, B1); PG8_BAR;
            PG8_LDA(At, 1, 1); PG8_STAGE(PG8_SA(1, 0), a3, voffA);
            PG8_BAR; PG8_WAIT_L(0); PG8_MMA(1, 0, At, B0); PG8_BAR; PG8_SCHED;
            PG8_STAGE(PG8_SB(1, 1), b3 + hstep, voffB);
            PG8_WAIT_V(6); PG8_BAR; PG8_MMA(1, 1, At, B1); PG8_BAR;
            }
        }
        if constexpr (FP8) asm volatile("s_nop 15\n\ts_nop 15" ::: "memory");
        if constexpr (ALIGN_EPI) { if (wr == 0) PG8_BAR; }
        if constexpr (!Epi::AFTER_DRAIN) { E(acc, cur, wr, wc, fr, fq); S.done(cur); }
        if (!has_next) break;
#pragma unroll
        for (int a = 0; a < 2; ++a)
#pragma unroll
            for (int b = 0; b < 2; ++b)
#pragma unroll
                for (int m = 0; m < 4; ++m)
#pragma unroll
                    for (int n = 0; n < 2; ++n) acc[a][b][m][n] = (f32x4){0.f, 0.f, 0.f, 0.f};
        cur = nxt; cA = nA; cB = nB; ++ui;
        if constexpr (ALIGN_EPI) { if (wr == 1) PG8_BAR; }
    }
    PG8_WAIT_V(0);
    if constexpr (!ALIGN_EPI) { if (wr == 0) PG8_BAR; }
    PG8_BAR;
    if constexpr (Epi::AFTER_DRAIN) { E.fused(acc, cur, wr, wc, fr, fq, lds, wid, lane); S.done(cur); }
#undef PG8_SA
#undef PG8_SB
#undef PG8_STAGE
#undef PG8_LDA
#undef PG8_LDB
#undef PG8_MMA
#undef PG8_WAIT_V
#undef PG8_WAIT_L
#undef PG8_BAR
#undef PG8_SCHED
}
}

#ifndef MK_PER_PHASE
#define MK_PER_PHASE 0
#endif
#ifndef PROBE_DOUBLE
#define PROBE_DOUBLE -1
#endif
#define REP(id) for (int rep_ = 0; rep_ < ((PROBE_DOUBLE == (id)) ? 2 : 1); ++rep_)
constexpr int NWAVES = 8, NTHR = 512;
constexpr int BATCH = 2, SEQ = 4096, M = BATCH * SEQ, D = 2048, DEPTH = 4;
constexpr int DI = 4096, NH = 64, HP = 64, NG = 8, HPG = 8, NS = 128, CONVD = 6144;
constexpr int QH = 16, KVH = 4, AD = 128, IH = 16, IDD = 64, TOPK = 256;
constexpr int FF = 4096, FF2 = 8192;
constexpr int NIN = 18576, NMAIN = 18432, NPAD = 18688;
constexpr int PZ = 0, PXBC = 4096, PQ = 10240, PK = 12288, PV = 12800, PG = 13312, PQI = 17408;
constexpr int SMW = 256, SM_DT = 0, SM_KI = 64, SM_WI = 128;
constexpr float EPS = 1e-6f;
constexpr int F8_DN = DEPTH - 2, F8_UP = DEPTH - 2, F8_MIX = DEPTH - 1, F8_OUT = DEPTH - 1, F8_IN = DEPTH - 1;
constexpr float ATTN_SCALE = 0.08838834764831845f;

constexpr size_t MiB = 1u << 20;
constexpr size_t WS_CTL = 0, CTL_ZERO_BYTES = 1 * MiB;
constexpr size_t WS_W = 2 * MiB;
constexpr size_t WL_IN = 0, WL_SSM = 73 * MiB, WL_ATT = 89 * MiB, WL_MIX = 97 * MiB, WL_UP = 105 * MiB, WL_DN = 137 * MiB, WL_SIZE = 153 * MiB;
constexpr size_t WS_H = WS_W + DEPTH * WL_SIZE;
constexpr size_t WS_P = WS_H + 32 * MiB;
constexpr size_t WS_SM = WS_P + 288 * MiB;
constexpr size_t WS_XC = WS_SM + 8 * MiB;
constexpr size_t WS_DT = WS_XC + 96 * MiB;
constexpr size_t WS_ACS = WS_DT + 2 * MiB;
constexpr size_t WS_ST = WS_ACS + 2 * MiB;
constexpr size_t WS_Y = WS_ST + 256 * MiB;
constexpr size_t WS_SC = WS_Y + 64 * MiB;
constexpr size_t WS_IDX = WS_SC + 128 * MiB;
constexpr size_t WS_CNT = WS_IDX + 8 * MiB;
constexpr size_t WS_AO = WS_CNT + 1 * MiB;
constexpr size_t WS_MG = WS_AO + 32 * MiB;
constexpr size_t WS_MGB = WS_MG + 64 * MiB;
constexpr size_t WS_YM = WS_MGB + 32 * MiB;
constexpr size_t WS_U = WS_YM + 64 * MiB;
constexpr size_t WS_ACT = WS_U + 128 * MiB;
constexpr size_t WS_KIB = WS_ACT + 64 * MiB;
constexpr size_t WS_END = WS_KIB + 1 * MiB;
constexpr int CW_BAR = 4096;

constexpr int RING_BYTES = 139264, LDSCTL_OFF = RING_BYTES, MISC_OFF = LDSCTL_OFF + 320, LDS_BYTES = 147456;

#define LAS __attribute__((address_space(3)))
#define GAS __attribute__((address_space(1)))
typedef unsigned short bf16;
typedef float f32x4 __attribute__((ext_vector_type(4)));
typedef short bf16x8 __attribute__((ext_vector_type(8)));
typedef unsigned u32x4 __attribute__((ext_vector_type(4)));
typedef unsigned u32x2 __attribute__((ext_vector_type(2)));
#define LDS_WAIT() asm volatile("s_waitcnt lgkmcnt(0)" ::: "memory")

__device__ __forceinline__ unsigned f2bf(float f) { unsigned u = __builtin_bit_cast(unsigned, f); return (u + 0x7fffu + ((u >> 16) & 1u)) >> 16; }
__device__ __forceinline__ unsigned pk2(float lo, float hi) { return f2bf(lo) | (f2bf(hi) << 16); }
__device__ __forceinline__ unsigned cvtpk(float lo, float hi) { unsigned r; asm("v_cvt_pk_bf16_f32 %0, %1, %2" : "=v"(r) : "v"(lo), "v"(hi)); return r; }
__device__ __forceinline__ u32x2 pack8_fp8(const float (&f)[8]) { int lo = 0, hi = 0; lo = __builtin_amdgcn_cvt_pk_fp8_f32(f[0], f[1], lo, false); lo = __builtin_amdgcn_cvt_pk_fp8_f32(f[2], f[3], lo, true);
    hi = __builtin_amdgcn_cvt_pk_fp8_f32(f[4], f[5], hi, false); hi = __builtin_amdgcn_cvt_pk_fp8_f32(f[6], f[7], hi, true); u32x2 w; w.x = (unsigned)lo; w.y = (unsigned)hi; return w; }
__device__ __forceinline__ unsigned pack4_fp8(float a, float b, float c, float d) { int w = 0; w = __builtin_amdgcn_cvt_pk_fp8_f32(a, b, w, false); w = __builtin_amdgcn_cvt_pk_fp8_f32(c, d, w, true); return (unsigned)w; }
__device__ __forceinline__ float bflo(unsigned w) { return __uint_as_float(w << 16); }
__device__ __forceinline__ float bfhi(unsigned w) { return __uint_as_float(w & 0xffff0000u); }
__device__ __forceinline__ void unpack8(const u32x4 w, float (&f)[8]) { f[0] = bflo(w.x); f[1] = bfhi(w.x); f[2] = bflo(w.y); f[3] = bfhi(w.y); f[4] = bflo(w.z); f[5] = bfhi(w.z); f[6] = bflo(w.w); f[7] = bfhi(w.w); }
__device__ __forceinline__ u32x4 pack8(const float (&f)[8]) { u32x4 w; w.x = pk2(f[0], f[1]); w.y = pk2(f[2], f[3]); w.z = pk2(f[4], f[5]); w.w = pk2(f[6], f[7]); return w; }
__device__ __forceinline__ float wave_sum(float v) {
#pragma unroll
    for (int o = 1; o < 64; o <<= 1) v += __shfl_xor(v, o);
    return v;
}
__device__ __forceinline__ float wave_max(float v) {
#pragma unroll
    for (int o = 1; o < 64; o <<= 1) v = fmaxf(v, __shfl_xor(v, o));
    return v;
}
__device__ __forceinline__ float siluf_(float x) { return x / (1.0f + __expf(-x)); }
typedef short s16x4 __attribute__((ext_vector_type(4)));
__device__ __forceinline__ s16x4 lds_tr4(const LAS unsigned char* p) { return __builtin_bit_cast(s16x4, __builtin_amdgcn_ds_read_tr16_b64_v4i16((LAS s16x4*)p)); }

#define XB_TMO      128
#define XB_XCNT(j)  (256  + 64 * (j))
#define XB_XSUB(j)  (1280 + 64 * (j))
#define XB_XGEN(j)  (2304 + 64 * (j))
#define XB_TOP      3328
#define XB_TOPGEN   3392
#define XCD_BAR_WORDS 3456
#define XB_SPIN_CAP (1u << 18)

__device__ __forceinline__ unsigned xb_ld(unsigned* p)              { return __hip_atomic_load(p, __ATOMIC_RELAXED, __HIP_MEMORY_SCOPE_AGENT); }
__device__ __forceinline__ unsigned xb_add(unsigned* p, unsigned v) { return __hip_atomic_fetch_add(p, v, __ATOMIC_RELAXED, __HIP_MEMORY_SCOPE_AGENT); }
__device__ __forceinline__ unsigned xb_xcc_id() { return (unsigned)__builtin_amdgcn_s_getreg((3 << 11) | 20) & 0xFu; }
#define XB_SPIN(cond, bar) do { unsigned _sp = 0; while (cond) { __builtin_amdgcn_s_sleep(1); \
    if ((++_sp & 255u) == 0u) { if (xb_ld(&(bar)[XB_TMO])) break; if (_sp > XB_SPIN_CAP) { atomicAdd(&(bar)[XB_TMO], 1u); break; } } } } while (0)

struct XcdBarrier {
    unsigned* bar; unsigned x;
    volatile LAS unsigned* st;
};

__device__ __forceinline__ XcdBarrier xcd_barrier_post(unsigned* bar, volatile LAS unsigned* st) {
    XcdBarrier b; b.bar = bar; b.x = xb_xcc_id(); b.st = st;
    if (threadIdx.x == 0) (void)xb_add(&bar[XB_XCNT(b.x)], 1u);
    return b;
}
__device__ __forceinline__ void xcd_barrier_complete(unsigned* bar, unsigned x, unsigned& nloc, unsigned& nx) {
    const unsigned G = gridDim.x * gridDim.y * gridDim.z;
    unsigned sum, cnt, mine, sp = 0u;
    for (;;) {
        sum = 0u; cnt = 0u; mine = 0u;
#pragma unroll
        for (unsigned j = 0; j < 16; ++j) { const unsigned c = xb_ld(&bar[XB_XCNT(j)]); sum += c; cnt += (c > 0u) ? 1u : 0u; mine = (j == x) ? c : mine; }
        if (sum == G) break;
        __builtin_amdgcn_s_sleep(1);
        if ((++sp & 255u) == 0u) { if (xb_ld(&bar[XB_TMO])) break; if (sp > XB_SPIN_CAP) { atomicAdd(&bar[XB_TMO], 1u); break; } }
    }
    nloc = mine > 0u ? mine : 1u; nx = cnt > 0u ? cnt : 1u;
}

__device__ __forceinline__ void xcd_barrier(const XcdBarrier& b) {
    asm volatile("s_waitcnt vmcnt(0)" ::: "memory");
    __syncthreads();
    if (threadIdx.x == 0) {
        unsigned* bar = b.bar;
        __builtin_amdgcn_s_waitcnt(0);
        unsigned nloc = b.st[0], nx = b.st[1];
        if (nloc == 0u) { xcd_barrier_complete(bar, b.x, nloc, nx); b.st[0] = nloc; b.st[1] = nx; }
        const unsigned old = xb_add(&bar[XB_XSUB(b.x)], 1u);
        const unsigned gen = old / nloc;
        if (old + 1u == (gen + 1u) * nloc) {
            __builtin_amdgcn_fence(__ATOMIC_RELEASE, "agent");
            asm volatile("s_waitcnt vmcnt(0)" ::: "memory");
            const unsigned og = xb_add(&bar[XB_TOP], 1u);
            const unsigned tg = og / nx;
            if (og + 1u == (tg + 1u) * nx) xb_add(&bar[XB_TOPGEN], 1u);
            else XB_SPIN(xb_ld(&bar[XB_TOPGEN]) == tg, bar);
            __builtin_amdgcn_fence(__ATOMIC_ACQUIRE, "agent");
            xb_add(&bar[XB_XGEN(b.x)], 1u);
            asm volatile("s_waitcnt vmcnt(0)" ::: "memory");
        } else {
            XB_SPIN(xb_ld(&bar[XB_XGEN(b.x)]) == gen, bar);
            __builtin_amdgcn_fence(__ATOMIC_ACQUIRE, "agent");
            asm volatile("s_waitcnt vmcnt(0)" ::: "memory");
        }
    }
    __syncthreads();
}


template <bool XF32IN, bool HASY, bool XF32OUT, bool HF8 = false>
__device__ __forceinline__ void ph_resid_norm(const GAS bf16* Yb, const GAS float* gpost, const GAS float* gnext, const GAS float* Xf_in, const GAS bf16* Xb_in, GAS float* Xf_out, GAS bf16* Xb_out, GAS bf16* H, GAS unsigned char* H8,
                                              int gw, int ngw, int lane) {
    for (int m = gw; m < M; m += ngw) {
        float xv[4][8];
#pragma unroll
        for (int j = 0; j < 4; ++j) { const size_t e = (size_t)m * D + 8 * (lane + 64 * j);
            if (XF32IN) { const f32x4 a = *(const GAS f32x4*)(Xf_in + e), c = *(const GAS f32x4*)(Xf_in + e + 4); xv[j][0] = a.x; xv[j][1] = a.y; xv[j][2] = a.z; xv[j][3] = a.w; xv[j][4] = c.x; xv[j][5] = c.y; xv[j][6] = c.z; xv[j][7] = c.w; }
            else unpack8(*(const GAS u32x4*)(Xb_in + e), xv[j]); }
        if (HASY) {
            float yv[4][8]; float ss = 0.f;
#pragma unroll
            for (int j = 0; j < 4; ++j) { unpack8(*(const GAS u32x4*)(Yb + (size_t)m * D + 8 * (lane + 64 * j)), yv[j]);
#pragma unroll
                for (int i = 0; i < 8; ++i) ss += yv[j][i] * yv[j][i]; }
            const float rstd = rsqrtf(wave_sum(ss) * (1.0f / D) + EPS);
#pragma unroll
            for (int j = 0; j < 4; ++j) { const GAS float* gp = gpost + 8 * (lane + 64 * j); const f32x4 g0 = *(const GAS f32x4*)gp, g1 = *(const GAS f32x4*)(gp + 4);
                xv[j][0] += yv[j][0] * rstd * g0.x; xv[j][1] += yv[j][1] * rstd * g0.y; xv[j][2] += yv[j][2] * rstd * g0.z; xv[j][3] += yv[j][3] * rstd * g0.w;
                xv[j][4] += yv[j][4] * rstd * g1.x; xv[j][5] += yv[j][5] * rstd * g1.y; xv[j][6] += yv[j][6] * rstd * g1.z; xv[j][7] += yv[j][7] * rstd * g1.w; }
        }
#pragma unroll
        for (int j = 0; j < 4; ++j) { const size_t e = (size_t)m * D + 8 * (lane + 64 * j);
            if (XF32OUT) { *(GAS f32x4*)(Xf_out + e) = (f32x4){xv[j][0], xv[j][1], xv[j][2], xv[j][3]}; *(GAS f32x4*)(Xf_out + e + 4) = (f32x4){xv[j][4], xv[j][5], xv[j][6], xv[j][7]}; }
            else *(GAS u32x4*)(Xb_out + e) = pack8(xv[j]); }
        if (gnext) {
            float ss = 0.f;
#pragma unroll
            for (int j = 0; j < 4; ++j)
#pragma unroll
                for (int i = 0; i < 8; ++i) ss += xv[j][i] * xv[j][i];
            const float rstd = rsqrtf(wave_sum(ss) * (1.0f / D) + EPS);
#pragma unroll
            for (int j = 0; j < 4; ++j) { const GAS float* gp = gnext + 8 * (lane + 64 * j); const f32x4 g0 = *(const GAS f32x4*)gp, g1 = *(const GAS f32x4*)(gp + 4);
                float h[8] = {xv[j][0] * rstd * g0.x, xv[j][1] * rstd * g0.y, xv[j][2] * rstd * g0.z, xv[j][3] * rstd * g0.w, xv[j][4] * rstd * g1.x, xv[j][5] * rstd * g1.y, xv[j][6] * rstd * g1.z, xv[j][7] * rstd * g1.w};
                if (HF8) *(GAS u32x2*)((GAS unsigned char*)H + (size_t)m * D + 8 * (lane + 64 * j)) = pack8_fp8(h);
                else *(GAS u32x4*)(H + (size_t)m * D + 8 * (lane + 64 * j)) = pack8(h);
                if (H8) *(GAS u32x2*)(H8 + (size_t)m * D + 8 * (lane + 64 * j)) = pack8_fp8(h); }
        }
    }
}

__device__ __forceinline__ void tr_item(const GAS float* W, int ldw, int K, int k0, int nsrc, int ncols, GAS bf16* WT, int ndst, LAS unsigned char* tile, int lane) {
    const int c4 = (lane & 15) * 4, kr = lane >> 4;
    f32x4 v[16];
#pragma unroll
    for (int i = 0; i < 16; ++i) v[i] = (c4 < ncols) ? *(const GAS f32x4*)(W + (size_t)(k0 + 4 * i + kr) * ldw + nsrc + c4) : (f32x4){0.f, 0.f, 0.f, 0.f};
#pragma unroll
    for (int i = 0; i < 16; ++i) { u32x2 w; w.x = cvtpk(v[i].x, v[i].y); w.y = cvtpk(v[i].z, v[i].w); *(LAS u32x2*)(tile + (4 * i + kr) * 160 + (lane & 15) * 8) = w; }
    LDS_WAIT();
    const int g = lane >> 4, c16 = lane & 15;
    const LAS unsigned char* tb = tile + (8 * g + (c16 >> 2)) * 160 + (c16 & 3) * 8;
#pragma unroll
    for (int nt = 0; nt < 4; ++nt)
#pragma unroll
        for (int kh = 0; kh < 2; ++kh) {
            const s16x4 lo = lds_tr4(tb + (32 * kh) * 160 + nt * 32), hi = lds_tr4(tb + (32 * kh + 4) * 160 + nt * 32);
            *(GAS bf16x8*)(WT + (size_t)(ndst + 16 * nt + c16) * K + k0 + 32 * kh + 8 * g) = __builtin_shufflevector(lo, hi, 0, 1, 2, 3, 4, 5, 6, 7); }
    LDS_WAIT();
}
__device__ __forceinline__ void tr_item_fp8(const GAS float* W, int ldw, int K, int k0, int nsrc, GAS unsigned char* WT8, int ndst, LAS unsigned char* tile, int lane) {
    const int c4 = (lane & 15) * 4, kr = lane >> 4;
    f32x4 v[16];
#pragma unroll
    for (int i = 0; i < 16; ++i) v[i] = *(const GAS f32x4*)(W + (size_t)(k0 + 4 * i + kr) * ldw + nsrc + c4);
#pragma unroll
    for (int i = 0; i < 16; ++i) { u32x2 w; w.x = cvtpk(v[i].x, v[i].y); w.y = cvtpk(v[i].z, v[i].w); *(LAS u32x2*)(tile + (4 * i + kr) * 160 + (lane & 15) * 8) = w; }
    LDS_WAIT();
    const int g = lane >> 4, c16 = lane & 15;
    const LAS unsigned char* tb = tile + (16 * g + (c16 >> 2)) * 160 + (c16 & 3) * 8;
#pragma unroll
    for (int nt = 0; nt < 4; ++nt) { u32x4 o;
#pragma unroll
        for (int h = 0; h < 2; ++h) { const s16x4 lo = lds_tr4(tb + (8 * h) * 160 + nt * 32), hi = lds_tr4(tb + (8 * h + 4) * 160 + nt * 32);
            float f[8]; unpack8(__builtin_bit_cast(u32x4, __builtin_shufflevector(lo, hi, 0, 1, 2, 3, 4, 5, 6, 7)), f);
#pragma unroll
            for (int j = 0; j < 8; ++j) f[j] *= 64.0f;
            const u32x2 w = pack8_fp8(f); if (h == 0) { o.x = w.x; o.y = w.y; } else { o.z = w.x; o.w = w.y; } }
        *(GAS u32x4*)(WT8 + (size_t)(ndst + 16 * nt + c16) * K + k0 + 16 * g) = o; }
    LDS_WAIT();
}
__device__ __forceinline__ void win_map(int dstrow, int& src, int& ncols) {
    ncols = 64;
    if (dstrow < 10240) src = dstrow;
    else if (dstrow < 12288) src = dstrow - 10240 + 10304;
    else if (dstrow < 12800) src = dstrow - 12288 + 12352;
    else if (dstrow < 13312) src = dstrow - 12800 + 12864;
    else if (dstrow < 17408) src = dstrow - 13312 + 14480;
    else if (dstrow < 18432) src = dstrow - 17408 + 13376;
    else if (dstrow < 18496) src = dstrow - 18432 + 10240;
    else if (dstrow < 18560) src = dstrow - 18496 + 14400;
    else if (dstrow == 18560) { src = 14464; ncols = 16; }
    else { src = 0; ncols = 0; }
}
struct WPtrs { const GAS float *w_in, *w_ssm, *w_att, *w_mix, *w_up, *w_dn; };
__device__ __forceinline__ void ph_weights(const WPtrs wp, GAS unsigned char* ws, LAS unsigned char* tile, int gw, int ngw, int lane) {
    constexpr int I_IN = (NPAD / 64) * (D / 64), I_SSM = (D / 64) * (DI / 64), I_ATT = (D / 64) * (D / 64), I_MIX = I_ATT, I_UP = (FF2 / 64) * (D / 64), I_DN = (D / 64) * (FF / 64);
    constexpr int I_L = I_IN + I_SSM + I_ATT + I_MIX + I_UP + I_DN;
    for (int it = gw; it < DEPTH * I_L; it += ngw) {
        const int layer = it / I_L; int r = it % I_L;
        GAS unsigned char* wl = ws + WS_W + (size_t)layer * WL_SIZE;
        if (r < I_IN) { const int nblk = NPAD / 64, kb = r / nblk, nb = r % nblk; int src, nc; win_map(nb * 64, src, nc);
            if (layer >= F8_IN && nb * 64 < PQI) tr_item_fp8(wp.w_in + (size_t)layer * D * NIN, NIN, D, kb * 64, src, wl + WL_IN, nb * 64, tile, lane);
            else tr_item(wp.w_in + (size_t)layer * D * NIN, NIN, D, kb * 64, src, nc, (GAS bf16*)(wl + WL_IN), nb * 64, tile, lane);
            continue; }
        r -= I_IN;
        if (r < I_SSM) { const int nblk = D / 64, kb = r / nblk, nb = r % nblk; if (layer >= F8_OUT) tr_item_fp8(wp.w_ssm + (size_t)layer * DI * D, D, DI, kb * 64, nb * 64, wl + WL_SSM, nb * 64, tile, lane); else tr_item(wp.w_ssm + (size_t)layer * DI * D, D, DI, kb * 64, nb * 64, 64, (GAS bf16*)(wl + WL_SSM), nb * 64, tile, lane); continue; }
        r -= I_SSM;
        if (r < I_ATT) { const int nblk = D / 64, kb = r / nblk, nb = r % nblk; if (layer >= F8_OUT) tr_item_fp8(wp.w_att + (size_t)layer * D * D, D, D, kb * 64, nb * 64, wl + WL_ATT, nb * 64, tile, lane); else tr_item(wp.w_att + (size_t)layer * D * D, D, D, kb * 64, nb * 64, 64, (GAS bf16*)(wl + WL_ATT), nb * 64, tile, lane); continue; }
        r -= I_ATT;
        if (r < I_MIX) { const int nblk = D / 64, kb = r / nblk, nb = r % nblk; if (layer >= F8_MIX) tr_item_fp8(wp.w_mix + (size_t)layer * D * D, D, D, kb * 64, nb * 64, wl + WL_MIX, nb * 64, tile, lane); else tr_item(wp.w_mix + (size_t)layer * D * D, D, D, kb * 64, nb * 64, 64, (GAS bf16*)(wl + WL_MIX), nb * 64, tile, lane); continue; }
        r -= I_MIX;
        if (r < I_UP) { const int nblk = FF2 / 64, kb = r / nblk, nb = r % nblk;
            if (layer >= F8_UP) tr_item_fp8(wp.w_up + (size_t)layer * D * FF2, FF2, D, kb * 64, nb * 64, wl + WL_UP, nb * 64, tile, lane);
            else tr_item(wp.w_up + (size_t)layer * D * FF2, FF2, D, kb * 64, nb * 64, 64, (GAS bf16*)(wl + WL_UP), nb * 64, tile, lane);
            continue; }
        r -= I_UP;
        { const int nblk = D / 64, kb = r / nblk, nb = r % nblk;
          if (layer >= F8_DN) tr_item_fp8(wp.w_dn + (size_t)layer * FF * D, D, FF, kb * 64, nb * 64, wl + WL_DN, nb * 64, tile, lane);
          else tr_item(wp.w_dn + (size_t)layer * FF * D, D, FF, kb * 64, nb * 64, 64, (GAS bf16*)(wl + WL_DN), nb * 64, tile, lane); }
    }
}

__device__ __forceinline__ void ph_small_proj(const GAS bf16* H, const GAS bf16* Ws, GAS float* SM, GAS bf16* KIB, LAS unsigned char* lds, int blk, int nblk, int tid) {
    constexpr int HS = 4112;
    const int lane = tid & 63, wave = __builtin_amdgcn_readfirstlane(tid >> 6), g = lane >> 4, c16 = lane & 15;
    for (int rb = blk; rb < M / 32; rb += nblk) {
        __syncthreads();
#pragma unroll
        for (int i = 0; i < 16; ++i) { const int id = tid + 512 * i, r = id >> 8, ch = id & 255;
            *(LAS u32x4*)(lds + r * HS + ch * 16) = *(const GAS u32x4*)(H + (size_t)(rb * 32 + r) * D + ch * 8); }
        __syncthreads();
        f32x4 acc[2] = {(f32x4){0.f, 0.f, 0.f, 0.f}, (f32x4){0.f, 0.f, 0.f, 0.f}}, acc9[2] = {(f32x4){0.f, 0.f, 0.f, 0.f}, (f32x4){0.f, 0.f, 0.f, 0.f}};
        const GAS bf16* wrow = Ws + (size_t)(16 * wave + c16) * D + 8 * g;
        const GAS bf16* w9 = Ws + (size_t)(128 + c16) * D + 256 * wave + 8 * g;
        const LAS unsigned char* hb = lds + c16 * HS + g * 16;
#pragma unroll 8
        for (int ks = 0; ks < 64; ++ks) {
            const bf16x8 wf = *(const GAS bf16x8*)(wrow + 32 * ks);
            const bf16x8 h0 = *(const LAS bf16x8*)(hb + ks * 64), h1 = *(const LAS bf16x8*)(hb + 16 * HS + ks * 64);
            acc[0] = __builtin_amdgcn_mfma_f32_16x16x32_bf16(wf, h0, acc[0], 0, 0, 0); acc[1] = __builtin_amdgcn_mfma_f32_16x16x32_bf16(wf, h1, acc[1], 0, 0, 0);
        }
#pragma unroll
        for (int k8 = 0; k8 < 8; ++k8) { const int ks = 8 * wave + k8;
            const bf16x8 wf = *(const GAS bf16x8*)(w9 + 32 * k8);
            const bf16x8 h0 = *(const LAS bf16x8*)(hb + ks * 64), h1 = *(const LAS bf16x8*)(hb + 16 * HS + ks * 64);
            acc9[0] = __builtin_amdgcn_mfma_f32_16x16x32_bf16(wf, h0, acc9[0], 0, 0, 0); acc9[1] = __builtin_amdgcn_mfma_f32_16x16x32_bf16(wf, h1, acc9[1], 0, 0, 0);
        }
#pragma unroll
        for (int rt = 0; rt < 2; ++rt) { const size_t row = (size_t)(rb * 32 + 16 * rt + c16);
            *(GAS f32x4*)(SM + row * SMW + 16 * wave + 4 * g) = acc[rt];
            if (wave >= 4) { u32x2 w; w.x = cvtpk(acc[rt].x, acc[rt].y); w.y = cvtpk(acc[rt].z, acc[rt].w); *(GAS u32x2*)(KIB + row * IDD + 16 * (wave - 4) + 4 * g) = w; } }
        __syncthreads();
        *(LAS f32x4*)(lds + ((wave * 2 + 0) * 64 + lane) * 16) = acc9[0]; *(LAS f32x4*)(lds + ((wave * 2 + 1) * 64 + lane) * 16) = acc9[1];
        __syncthreads();
        if (wave < 2) { f32x4 s = (f32x4){0.f, 0.f, 0.f, 0.f};
#pragma unroll
            for (int w8 = 0; w8 < 8; ++w8) s += *(const LAS f32x4*)(lds + ((w8 * 2 + wave) * 64 + lane) * 16);
            *(GAS f32x4*)(SM + (size_t)(rb * 32 + 16 * wave + c16) * SMW + 128 + 4 * g) = s; }
    }
}

__device__ __forceinline__ void ph_index_scores(const GAS bf16* P, const GAS float* SM, const GAS bf16* KIB, GAS float* SC, LAS unsigned char* lds, int blk, int nblk, int tid) {
    constexpr int QS = 1040;
    const int lane = tid & 63, wave = __builtin_amdgcn_readfirstlane(tid >> 6);
    for (int u0 = blk; u0 < 256; u0 += nblk) {
#pragma unroll 1
        for (int half = 0; half < 2; ++half) {
            const int b = half, qt = half ? 255 - u0 : u0;
            const int q0 = b * SEQ + qt * 16, nkt = ((qt * 16) / 64 + 1) * 4;
            const int qrow = q0 + (lane & 15), kq = 8 * (lane >> 4);
            __syncthreads();
#pragma unroll
            for (int i = 0; i < 2; ++i) { const int id = tid + 512 * i, q = id >> 6, ch = id & 63;
                *(LAS u32x4*)(lds + q * QS + ch * 16) = *(const GAS u32x4*)(P + (size_t)(q0 + q) * NMAIN + PQI + 8 * IDD + ch * 8); }
            bf16x8 bq[8][2]; float w[IH];
#pragma unroll
            for (int h = 0; h < IH; ++h) {
                if (h < 8) {
#pragma unroll
                    for (int ks = 0; ks < 2; ++ks) bq[h][ks] = *(const GAS bf16x8*)(P + (size_t)qrow * NMAIN + PQI + h * IDD + ks * 32 + kq); }
                w[h] = SM[(size_t)qrow * SMW + SM_WI + h]; }
            __syncthreads();
            const LAS unsigned char* qb = lds + (lane & 15) * QS + kq * 2;
            for (int kt = wave; kt < nkt; kt += NWAVES) {
                const int key0 = kt * 16; const GAS bf16* kp = KIB + (size_t)(b * SEQ + key0 + (lane & 15)) * IDD + kq;
                const bf16x8 a0 = *(const GAS bf16x8*)kp, a1 = *(const GAS bf16x8*)(kp + 32);
                f32x4 sc = (f32x4){0.f, 0.f, 0.f, 0.f};
#pragma unroll
                for (int h = 0; h < IH; ++h) { f32x4 c = (f32x4){0.f, 0.f, 0.f, 0.f};
                    const bf16x8 b0 = h < 8 ? bq[h & 7][0] : *(const LAS bf16x8*)(qb + (h - 8) * 128), b1 = h < 8 ? bq[h & 7][1] : *(const LAS bf16x8*)(qb + (h - 8) * 128 + 64);
                    c = __builtin_amdgcn_mfma_f32_16x16x32_bf16(a0, b0, c, 0, 0, 0); c = __builtin_amdgcn_mfma_f32_16x16x32_bf16(a1, b1, c, 0, 0, 0);
                    sc.x += w[h] * fmaxf(c.x, 0.f); sc.y += w[h] * fmaxf(c.y, 0.f); sc.z += w[h] * fmaxf(c.z, 0.f); sc.w += w[h] * fmaxf(c.w, 0.f); }
                *(GAS f32x4*)(SC + (size_t)qrow * SEQ + key0 + 4 * (lane >> 4)) = sc;
            }
        }
    }
}

__device__ __forceinline__ void topk_bitwise(const GAS float* srow, GAS unsigned long long* mw, int limit, int lane) {
    unsigned u[64];
#pragma unroll
    for (int j = 0; j < 64; ++j) { const int key = j * 64 + lane; unsigned v = 0u;
        if (key < limit) { const unsigned bits = __float_as_uint(srow[key]); v = (bits & 0x80000000u) ? ~bits : (bits | 0x80000000u); }
        u[j] = v; }
    unsigned T = 0u;
#pragma unroll 1
    for (int bit = 31; bit >= 0; --bit) { const unsigned cand = T | (1u << bit); int cnt = 0;
#pragma unroll
        for (int j = 0; j < 64; ++j) cnt += __popcll(__ballot(u[j] >= cand));
        if (cnt >= TOPK) T = cand; }
    int cgt = 0;
#pragma unroll
    for (int j = 0; j < 64; ++j) cgt += __popcll(__ballot(u[j] > T));
    const int need_eq = TOPK - cgt; int eqbase = 0;
    const unsigned long long lt_mask = (1ull << lane) - 1ull;
#pragma unroll
    for (int j = 0; j < 64; ++j) {
        const bool gt = u[j] > T, eq = u[j] == T;
        const unsigned long long eqm = __ballot(eq);
        const bool take = gt || (eq && (eqbase + __popcll(eqm & lt_mask) < need_eq));
        const unsigned long long tm = __ballot(take);
        if (lane == 0 && j * 64 < limit) mw[j] = tm;
        eqbase += __popcll(eqm);
    }
}
__device__ __forceinline__ void ph_topk(const GAS float* SC, GAS unsigned long long* MASKW, LAS unsigned char* wl, int gw, int ngw, int lane) {
    constexpr int CAP = 1024;
    LAS unsigned* hist = (LAS unsigned*)wl;
    LAS unsigned* maskc = (LAS unsigned*)(wl + 1024);
    LAS float* cval = (LAS float*)(wl + 1536);
    LAS unsigned* ckey = (LAS unsigned*)(wl + 1536 + 4 * CAP);
    const unsigned long long lt_mask = (1ull << lane) - 1ull;
    for (int q = gw; q < M; q += ngw) {
        int m = q;
        if (ngw * 4 == M) { const int j = q / ngw; m = (j & 1) * SEQ + ((j & 2) ? SEQ - 1 - gw : gw); }
        const int t = m & (SEQ - 1), limit = (t / 64 + 1) * 64, nw = limit / 64;
        GAS unsigned long long* mw = MASKW + (size_t)m * 64;
        if (limit <= TOPK) { unsigned ones = 0xffffffffu; asm volatile("" : "+v"(ones)); if (lane < nw) mw[lane] = ((unsigned long long)ones << 32) | ones; continue; }
        const GAS float* srow = SC + (size_t)m * SEQ;
        float s[64]; float smax = -__builtin_inff(), smin = __builtin_inff();
#pragma unroll
        for (int j = 0; j < 64; ++j) { s[j] = (j < nw) ? srow[j * 64 + lane] : 0.f; if (j < nw) { smax = fmaxf(smax, s[j]); smin = fminf(smin, s[j]); } }
        smax = wave_max(smax); smin = -wave_max(-smin);
        const float scale = smax > smin ? 255.0f / (smax - smin) : 0.f;
        asm volatile("" ::: "memory");
        hist[lane] = 0u; hist[lane + 64] = 0u; hist[lane + 128] = 0u; hist[lane + 192] = 0u; maskc[lane] = 0u; maskc[lane + 64] = 0u;
        LDS_WAIT();
#pragma unroll
        for (int j = 0; j < 64; ++j) if (j < nw) { const int b = min(255, (int)((s[j] - smin) * scale)); __hip_atomic_fetch_add(&hist[b], 1u, __ATOMIC_RELAXED, __HIP_MEMORY_SCOPE_WORKGROUP); }
        LDS_WAIT();
        const unsigned c0 = hist[4 * lane], c1 = hist[4 * lane + 1], c2 = hist[4 * lane + 2], c3 = hist[4 * lane + 3];
        unsigned suf = c0 + c1 + c2 + c3;
#pragma unroll
        for (int o = 1; o < 64; o <<= 1) { const unsigned v = __shfl_down(suf, o); if (lane + o < 64) suf += v; }
        const unsigned above = suf - (c0 + c1 + c2 + c3);
        int bstar = -1; unsigned cab = 0u;
        { unsigned cum = above;
          if (cum < TOPK && cum + c3 >= TOPK) { bstar = 4 * lane + 3; cab = cum; } cum += c3;
          if (bstar < 0 && cum < TOPK && cum + c2 >= TOPK) { bstar = 4 * lane + 2; cab = cum; } cum += c2;
          if (bstar < 0 && cum < TOPK && cum + c1 >= TOPK) { bstar = 4 * lane + 1; cab = cum; } cum += c1;
          if (bstar < 0 && cum < TOPK && cum + c0 >= TOPK) { bstar = 4 * lane + 0; cab = cum; } }
        const unsigned long long who = __ballot(bstar >= 0);
        const int src = __builtin_ctzll(who);
        bstar = __shfl(bstar, src); cab = __shfl(cab, src);
        const int need = TOPK - (int)cab;
        const unsigned ncand = hist[bstar];
        if (ncand > (unsigned)CAP) { topk_bitwise(srow, mw, limit, lane); continue; }
        unsigned long long myword = 0ull; int base = 0;
#pragma unroll
        for (int j = 0; j < 64; ++j) if (j < nw) {
            const int b = min(255, (int)((s[j] - smin) * scale));
            const unsigned long long gm = __ballot(b > bstar), em = __ballot(b == bstar);
            if (lane == j) myword = gm;
            if (b == bstar) { const int pos = base + __popcll(em & lt_mask); cval[pos] = s[j]; ckey[pos] = (unsigned)(j * 64 + lane); }
            base += __popcll(em);
        }
        LDS_WAIT();
        for (int i = lane; i < base; i += 64) { const float vi = cval[i]; const unsigned ki = ckey[i]; int rank = 0;
            if (need < base) { for (int q = 0; q < base; ++q) { const float vq = cval[q]; const unsigned kq = ckey[q]; rank += (vq > vi || (vq == vi && kq < ki)) ? 1 : 0; } }
            if (rank < need) __hip_atomic_fetch_or(&maskc[ki >> 5], 1u << (ki & 31), __ATOMIC_RELAXED, __HIP_MEMORY_SCOPE_WORKGROUP); }
        LDS_WAIT();
        if (lane < nw) { const unsigned long long cw_ = ((unsigned long long)maskc[2 * lane + 1] << 32) | maskc[2 * lane]; mw[lane] = myword | cw_; }
        LDS_WAIT(); asm volatile("" ::: "memory");
    }
}

__device__ __forceinline__ float xmax16(float x) { auto r = __builtin_amdgcn_permlane16_swap(__float_as_uint(x), __float_as_uint(x), false, false); return fmaxf(__uint_as_float(r[0]), __uint_as_float(r[1])); }
__device__ __forceinline__ float xmax32(float x) { auto r = __builtin_amdgcn_permlane32_swap(__float_as_uint(x), __float_as_uint(x), false, false); return fmaxf(__uint_as_float(r[0]), __uint_as_float(r[1])); }
__device__ __forceinline__ float xsum16(float x) { auto r = __builtin_amdgcn_permlane16_swap(__float_as_uint(x), __float_as_uint(x), false, false); return __uint_as_float(r[0]) + __uint_as_float(r[1]); }
__device__ __forceinline__ float xsum32(float x) { auto r = __builtin_amdgcn_permlane32_swap(__float_as_uint(x), __float_as_uint(x), false, false); return __uint_as_float(r[0]) + __uint_as_float(r[1]); }
template <int VAR> __device__ __forceinline__ void ph_attn_dense(const GAS bf16* P, const GAS unsigned long long* MASKW, GAS bf16* AO, LAS unsigned char* lds, int blk, int nblk, int tid) {
    constexpr int KS = 272, VS = 288, KBUF = 64 * KS, VBUF = 64 * VS, VOFF = 2 * KBUF, MOFF = VOFF + 2 * VBUF;
    const int lane = tid & 63, wave = __builtin_amdgcn_readfirstlane(tid >> 6), g = lane >> 4, c16 = lane & 15;
    const int hq = wave >> 1, qh = (wave & 1) * 32;
    const float SCL = ATTN_SCALE * 1.4426950408889634f;
    for (int u0 = blk; u0 < 256; u0 += nblk) {
#pragma unroll 1
        for (int half = 0; half < 2; ++half) {
            const int b = (u0 >> 2) & 1, kvh = u0 & 3, cc = u0 >> 3, c = half ? 63 - cc : cc, nt = c + 1;
            const int m0 = b * SEQ + c * 64;
            bf16x8 qf[2][4];
#pragma unroll
            for (int qt = 0; qt < 2; ++qt)
#pragma unroll
                for (int kd = 0; kd < 4; ++kd) qf[qt][kd] = *(const GAS bf16x8*)(P + (size_t)(m0 + qh + 16 * qt + c16) * NMAIN + PQ + (kvh * 4 + hq) * AD + 32 * kd + 8 * g);
            f32x4 O[2][8];
#pragma unroll
            for (int qt = 0; qt < 2; ++qt)
#pragma unroll
                for (int dt = 0; dt < 8; ++dt) O[qt][dt] = (f32x4){0.f, 0.f, 0.f, 0.f};
            float mrun[2] = {-1e30f, -1e30f}, lrun[2] = {0.f, 0.f};
            const GAS bf16* kvbase = P + (size_t)(b * SEQ) * NMAIN + kvh * AD;
            u32x4 kreg[2], vreg[2];
#define ATT_LOAD(t) do { _Pragma("unroll") for (int i = 0; i < 2; ++i) { const int id = tid + 512 * i; const GAS bf16* src = kvbase + (size_t)((t) * 64 + (id >> 4)) * NMAIN + (id & 15) * 8; \
                kreg[i] = *(const GAS u32x4*)(src + PK); vreg[i] = *(const GAS u32x4*)(src + PV); } } while (0)
#define ATT_STORE(buf) do { _Pragma("unroll") for (int i = 0; i < 2; ++i) { const int id = tid + 512 * i; \
                *(LAS u32x4*)(lds + (buf) * KBUF + (id >> 4) * KS + (id & 15) * 16) = kreg[i]; *(LAS u32x4*)(lds + VOFF + (buf) * VBUF + (id >> 4) * VS + (id & 15) * 16) = vreg[i]; } } while (0)
            __syncthreads();
            ATT_LOAD(0); ATT_STORE(0);
#pragma unroll
            for (int i = 0; i < 4; ++i) { const int id = tid + 512 * i; *(LAS u32x4*)(lds + MOFF + id * 16) = *(const GAS u32x4*)((const GAS unsigned char*)(MASKW + (size_t)m0 * 64) + id * 16); }
            const LAS unsigned long long* mrow0 = (const LAS unsigned long long*)(lds + MOFF) + (qh + c16) * 64; const LAS unsigned long long* mrow1 = mrow0 + 16 * 64;
            __syncthreads();
            for (int t = 0; t < nt; ++t) {
                const int buf = (VAR & 1) ? 0 : (t & 1);
                if (!(VAR & 1) && t + 1 < nt) ATT_LOAD(t + 1);
                const LAS unsigned char* kb = lds + buf * KBUF + c16 * KS + g * 16;
                const LAS unsigned char* vb = lds + VOFF + buf * VBUF + (4 * g + (c16 >> 2)) * VS + (c16 & 3) * 8;
                f32x4 S[2][4];
                bf16x8 kf[2][4];
#pragma unroll
                for (int kd = 0; kd < 4; ++kd) kf[0][kd] = *(const LAS bf16x8*)(kb + kd * 64);
#pragma unroll
                for (int kt = 0; kt < 4; ++kt) {
                    if (kt < 3) {
#pragma unroll
                        for (int kd = 0; kd < 4; ++kd) kf[(kt + 1) & 1][kd] = *(const LAS bf16x8*)(kb + (kt + 1) * 16 * KS + kd * 64); }
#pragma unroll
                    for (int qt = 0; qt < 2; ++qt) { f32x4 s = (f32x4){0.f, 0.f, 0.f, 0.f};
#pragma unroll
                        for (int kd = 0; kd < 4; ++kd) { if (!(VAR & 8)) s = __builtin_amdgcn_mfma_f32_16x16x32_bf16(kf[kt & 1][kd], qf[qt][kd], s, 0, 0, 0); else s += __builtin_bit_cast(f32x4, kf[kt & 1][kd]); }
                        S[qt][kt] = s; }
                }
                s16x4 vlo[8][2], vhi[8][2];
#pragma unroll
                for (int dt = 0; dt < 4; ++dt)
#pragma unroll
                    for (int ks = 0; ks < 2; ++ks) { vlo[dt][ks] = lds_tr4(vb + (32 * ks) * VS + dt * 32); vhi[dt][ks] = lds_tr4(vb + (32 * ks + 16) * VS + dt * 32); }
                bf16x8 pf[2][2];
#pragma unroll
                for (int qt = 0; qt < 2; ++qt) {
                    const unsigned long long mw = (qt ? mrow1[t] : mrow0[t]) >> (4 * g);
                    const int mlo = (int)(unsigned)mw, mhi = (int)(unsigned)(mw >> 32);
                    float mx = fmaxf(fmaxf(S[qt][0][0], S[qt][0][1]), fmaxf(S[qt][0][2], S[qt][0][3]));
#pragma unroll
                    for (int kt = 1; kt < 4; ++kt) mx = fmaxf(fmaxf(mx, S[qt][kt][0]), fmaxf(fmaxf(S[qt][kt][1], S[qt][kt][2]), S[qt][kt][3]));
                    mx = xmax16(mx); mx = xmax32(mx);
                    const float mnew = fmaxf(mrun[qt], mx * SCL);
                    const float alpha = __builtin_amdgcn_exp2f(mrun[qt] - mnew);
                    float ps = 0.f;
#pragma unroll
                    for (int kt = 0; kt < 4; ++kt)
#pragma unroll
                        for (int j = 0; j < 4; ++j) { const int sel = __builtin_amdgcn_sbfe(kt < 2 ? mlo : mhi, (kt & 1) * 16 + j, 1);
                            const float p = (VAR & 2) ? S[qt][kt][j] : __uint_as_float(__float_as_uint(__builtin_amdgcn_exp2f(__builtin_fmaf(S[qt][kt][j], SCL, -mnew))) & (unsigned)sel); S[qt][kt][j] = p; ps += p; }
                    ps = xsum16(ps); ps = xsum32(ps);
                    lrun[qt] = lrun[qt] * alpha + ps; mrun[qt] = mnew;
                    if (!__all(alpha == 1.0f)) {
#pragma unroll
                        for (int dt = 0; dt < 8; ++dt) O[qt][dt] *= alpha; }
#pragma unroll
                    for (int ks = 0; ks < 2; ++ks) { u32x4 w; w.x = cvtpk(S[qt][2 * ks][0], S[qt][2 * ks][1]); w.y = cvtpk(S[qt][2 * ks][2], S[qt][2 * ks][3]);
                        w.z = cvtpk(S[qt][2 * ks + 1][0], S[qt][2 * ks + 1][1]); w.w = cvtpk(S[qt][2 * ks + 1][2], S[qt][2 * ks + 1][3]); pf[qt][ks] = __builtin_bit_cast(bf16x8, w); }
                }
#pragma unroll
                for (int dt = 4; dt < 8; ++dt)
#pragma unroll
                    for (int ks = 0; ks < 2; ++ks) { vlo[dt][ks] = lds_tr4(vb + (32 * ks) * VS + dt * 32); vhi[dt][ks] = lds_tr4(vb + (32 * ks + 16) * VS + dt * 32); }
#pragma unroll
                for (int dt = 0; dt < 8; ++dt)
#pragma unroll
                    for (int ks = 0; ks < 2; ++ks) {
                        const bf16x8 vf = __builtin_shufflevector(vlo[dt][ks], vhi[dt][ks], 0, 1, 2, 3, 4, 5, 6, 7);
                        if (!(VAR & 4)) { O[0][dt] = __builtin_amdgcn_mfma_f32_16x16x32_bf16(vf, pf[0][ks], O[0][dt], 0, 0, 0);
                        O[1][dt] = __builtin_amdgcn_mfma_f32_16x16x32_bf16(vf, pf[1][ks], O[1][dt], 0, 0, 0); } else { O[0][dt] += __builtin_bit_cast(f32x4, pf[0][ks]); O[1][dt] += __builtin_bit_cast(f32x4, pf[1][ks]); }
                    }
                if (!(VAR & 1) && t + 1 < nt) ATT_STORE(buf ^ 1);
                __syncthreads();
            }
#undef ATT_LOAD
#undef ATT_STORE
#pragma unroll
            for (int qt = 0; qt < 2; ++qt) { const float r = 1.0f / lrun[qt];
                const size_t oi = (size_t)(m0 + qh + 16 * qt + c16) * D + (kvh * 4 + hq) * AD + 4 * g;
#pragma unroll
                for (int dt = 0; dt < 8; ++dt) { const f32x4 o = O[qt][dt] * r;
                    if (VAR & 16) *(GAS unsigned*)((GAS unsigned char*)AO + oi + 16 * dt) = pack4_fp8(o.x, o.y, o.z, o.w);
                    else { u32x2 w; w.x = pk2(o.x, o.y); w.y = pk2(o.z, o.w); *(GAS u32x2*)(AO + oi + 16 * dt) = w; } } }
        }
    }
}

__device__ __forceinline__ void stage_conv(const GAS bf16* P, const GAS float* cw, const GAS float* cb, int m0, int tpos0, int ch0, int nch, LAS unsigned char* dst, int stride, int tid) {
    const int cpr = nch >> 3;
    for (int id = tid; id < 64 * cpr; id += NTHR) {
        const int s = id / cpr, k = id - s * cpr, ch = ch0 + 8 * k;
        float acc[8];
        { const f32x4 b0 = *(const GAS f32x4*)(cb + ch), b1 = *(const GAS f32x4*)(cb + ch + 4); acc[0] = b0.x; acc[1] = b0.y; acc[2] = b0.z; acc[3] = b0.w; acc[4] = b1.x; acc[5] = b1.y; acc[6] = b1.z; acc[7] = b1.w; }
#pragma unroll
        for (int i = 0; i < 4; ++i) { if (tpos0 + s - 3 + i >= 0) {
            float x[8]; unpack8(*(const GAS u32x4*)(P + (size_t)(m0 + s - 3 + i) * NMAIN + PXBC + ch), x);
            const f32x4 w0 = *(const GAS f32x4*)(cw + i * CONVD + ch), w1 = *(const GAS f32x4*)(cw + i * CONVD + ch + 4);
            acc[0] += w0.x * x[0]; acc[1] += w0.y * x[1]; acc[2] += w0.z * x[2]; acc[3] += w0.w * x[3]; acc[4] += w1.x * x[4]; acc[5] += w1.y * x[5]; acc[6] += w1.z * x[6]; acc[7] += w1.w * x[7]; } }
#pragma unroll
        for (int j = 0; j < 8; ++j) acc[j] = siluf_(acc[j]);
        *(LAS u32x4*)(dst + s * stride + k * 16) = pack8(acc);
    }
}
__device__ __forceinline__ void wave_dt_acs(const GAS float* SM, const GAS float* dt_bias, const GAS float* a_log, int m0, int head, LAS float* dtw, LAS float* acsw, int lane) {
    const float raw = SM[(size_t)(m0 + lane) * SMW + SM_DT + head] + dt_bias[head];
    const float dt = fmaxf(raw, 0.f) + log1pf(__expf(-fabsf(raw)));
    float x = dt * (-__expf(a_log[head]));
#pragma unroll
    for (int o = 1; o < 64; o <<= 1) { const float v = __shfl_up(x, o); if (lane >= o) x += v; }
    dtw[lane] = dt; acsw[lane] = x;
}
__device__ __forceinline__ bf16x8 tr8(const LAS unsigned char* p, int off_lo, int off_hi) {
    const s16x4 lo = lds_tr4(p + off_lo), hi = lds_tr4(p + off_hi); return __builtin_shufflevector(lo, hi, 0, 1, 2, 3, 4, 5, 6, 7);
}
template <int NOUT> __device__ __forceinline__ void conv_strip(const GAS bf16* src, int tpos_first_raw, const GAS float* cw, const GAS float* cb, u32x4 (&out)[NOUT]) {
    u32x4 raw[NOUT + 3];
#pragma unroll
    for (int i = 0; i < NOUT + 3; ++i) { const int tp = tpos_first_raw + i; raw[i] = *(const GAS u32x4*)(src + (size_t)(tp < 0 ? 3 : i) * NMAIN); if (tp < 0) raw[i] = (u32x4){0u, 0u, 0u, 0u}; }
    f32x4 w[4][2];
#pragma unroll
    for (int t = 0; t < 4; ++t) { w[t][0] = *(const GAS f32x4*)(cw + t * CONVD); w[t][1] = *(const GAS f32x4*)(cw + t * CONVD + 4); }
    const f32x4 b0 = *(const GAS f32x4*)cb, b1 = *(const GAS f32x4*)(cb + 4);
#pragma unroll
    for (int o = 0; o < NOUT; ++o) { f32x4 a0 = b0, a1 = b1;
#pragma unroll
        for (int t = 0; t < 4; ++t) { float x[8]; unpack8(raw[o + t], x); a0 += w[t][0] * (f32x4){x[0], x[1], x[2], x[3]}; a1 += w[t][1] * (f32x4){x[4], x[5], x[6], x[7]}; }
        float f[8] = {a0.x, a0.y, a0.z, a0.w, a1.x, a1.y, a1.z, a1.w};
#pragma unroll
        for (int j = 0; j < 8; ++j) f[j] = f[j] * __builtin_amdgcn_rcpf(1.0f + __expf(-f[j]));
        out[o] = pack8(f); }
}
__device__ __forceinline__ void ph_ssd_states(const GAS bf16* P, const GAS float* SM, const GAS float* cw, const GAS float* cb, const GAS float* dt_bias, const GAS float* a_log, GAS bf16* XC, GAS bf16* ST, GAS float* CD,
                                              LAS unsigned char* lds, int blk, int nblk, int tid) {
    constexpr int RSW = 160, XW = 64 * RSW, RSB = 288, BMB = 64 * RSB, O_BM = 8 * XW, O_DT = O_BM + 2 * BMB, O_ACS = O_DT + 2048;
    const int lane = tid & 63, wave = __builtin_amdgcn_readfirstlane(tid >> 6), gq = lane >> 4, c16 = lane & 15;
    LAS unsigned char* xw = lds + wave * XW;
    LAS float* dtw = (LAS float*)(lds + O_DT) + wave * 64; LAS float* acsw = (LAS float*)(lds + O_ACS) + wave * 64;
    int par = 0;
    for (int item = blk; item < BATCH * 64 * NG; item += nblk, par ^= 1) {
        const int bc = item >> 3, g = item & 7, m0 = bc * 64, tpos0 = (bc & 63) * 64, head = g * HPG + wave;
        LAS unsigned char* bm = lds + O_BM + par * BMB;
        asm volatile("" ::: "memory");
        { const int k16 = lane & 15, r0 = 8 * wave + 2 * gq, chB = DI + g * NS + 8 * k16;
          const GAS bf16* base = P + (size_t)(m0 + r0 - 3) * NMAIN + PXBC + chB;
          u32x4 ob[2], oc[2];
          conv_strip<2>(base, tpos0 + r0 - 3, cw + chB, cb + chB, ob);
          conv_strip<2>(base + NG * NS, tpos0 + r0 - 3, cw + chB + NG * NS, cb + chB + NG * NS, oc);
#pragma unroll
          for (int o = 0; o < 2; ++o) { *(LAS u32x4*)(bm + (r0 + o) * RSB + k16 * 16) = ob[o];
              *(GAS u32x4*)(XC + (size_t)(m0 + r0 + o) * CONVD + chB) = ob[o]; *(GAS u32x4*)(XC + (size_t)(m0 + r0 + o) * CONVD + chB + NG * NS) = oc[o]; } }
        { const int k8 = lane & 7, r0 = 8 * (lane >> 3), ch = head * HP + 8 * k8;
          u32x4 ox[8];
          conv_strip<8>(P + (size_t)(m0 + r0 - 3) * NMAIN + PXBC + ch, tpos0 + r0 - 3, cw + ch, cb + ch, ox);
#pragma unroll
          for (int o = 0; o < 8; ++o) { *(LAS u32x4*)(xw + (r0 + o) * RSW + k8 * 16) = ox[o]; *(GAS u32x4*)(XC + (size_t)(m0 + r0 + o) * CONVD + ch) = ox[o]; } }
        wave_dt_acs(SM, dt_bias, a_log, m0, head, dtw, acsw, lane);
        LDS_WAIT();
        __syncthreads();
        const float aend = acsw[63];
        if (lane == 0) CD[bc * NH + head] = __expf(aend);
        const LAS unsigned char* xb = xw + (4 * gq + (c16 >> 2)) * RSW + (c16 & 3) * 8;
        const LAS unsigned char* bb = bm + (4 * gq + (c16 >> 2)) * RSB + (c16 & 3) * 8;
        bf16x8 xf[4][2];
#pragma unroll
        for (int ks = 0; ks < 2; ++ks) { float w[8];
#pragma unroll
            for (int j = 0; j < 8; ++j) { const int s = 32 * ks + 16 * (j >> 2) + 4 * gq + (j & 3); w[j] = dtw[s] * __expf(aend - acsw[s]); }
#pragma unroll
            for (int pt = 0; pt < 4; ++pt) { const bf16x8 r = tr8(xb + pt * 32, (32 * ks) * RSW, (32 * ks + 16) * RSW); float f[8]; unpack8(__builtin_bit_cast(u32x4, r), f);
#pragma unroll
                for (int j = 0; j < 8; ++j) f[j] *= w[j];
                xf[pt][ks] = __builtin_bit_cast(bf16x8, pack8(f)); } }
        GAS bf16* dst = ST + (((size_t)bc * NH + head) * HP + c16) * NS + 4 * gq;
#pragma unroll 2
        for (int nt = 0; nt < 8; ++nt) {
            const bf16x8 a0 = tr8(bb + nt * 32, 0, 16 * RSB), a1 = tr8(bb + nt * 32, 32 * RSB, 48 * RSB);
#pragma unroll
            for (int pt = 0; pt < 4; ++pt) { f32x4 acc = (f32x4){0.f, 0.f, 0.f, 0.f};
                acc = __builtin_amdgcn_mfma_f32_16x16x32_bf16(a0, xf[pt][0], acc, 0, 0, 0); acc = __builtin_amdgcn_mfma_f32_16x16x32_bf16(a1, xf[pt][1], acc, 0, 0, 0);
                u32x2 o; o.x = pk2(acc.x, acc.y); o.y = pk2(acc.z, acc.w); *(GAS u32x2*)(dst + (size_t)(16 * pt) * NS + 16 * nt) = o; }
        }
        LDS_WAIT(); asm volatile("" ::: "memory");
    }
}
__device__ __forceinline__ void ph_ssd_scan(GAS bf16* ST, const GAS float* CD, int gtid, int nthr) {
    for (int it = gtid; it < BATCH * NH * HP * (NS / 8); it += nthr) {
        const int n8 = it & 15, p = (it >> 4) & 63, head = (it >> 10) & 63, b = it >> 16;
        float h[8];
#pragma unroll
        for (int j = 0; j < 8; ++j) h[j] = 0.f;
#pragma unroll 8
        for (int c = 0; c < 64; ++c) { GAS u32x4* q = (GAS u32x4*)(ST + ((((size_t)(b * 64 + c)) * NH + head) * HP + p) * NS) + n8;
            float v[8]; unpack8(*q, v); *q = pack8(h); const float dec = CD[(b * 64 + c) * NH + head];
#pragma unroll
            for (int j = 0; j < 8; ++j) h[j] = h[j] * dec + v[j]; }
    }
}
template <bool YF8> __device__ __forceinline__ void ph_ssd_out(const GAS bf16* P, const GAS float* SM, const GAS bf16* XC, const GAS float* dt_bias, const GAS float* a_log, const GAS bf16* ST,
                                           const GAS float* dskip, const GAS float* gnorm, GAS bf16* Y, LAS unsigned char* lds, int blk, int nblk, int tid) {
    constexpr int RSW = 160, XW = 64 * RSW, O_DT = 8 * XW, O_ACS = O_DT + 2048, O_SSQ = O_ACS + 2048;
    const int lane = tid & 63, wave = __builtin_amdgcn_readfirstlane(tid >> 6), gq = lane >> 4, c16 = lane & 15;
    LAS unsigned char* xw = lds + wave * XW;
    LAS float* dtw = (LAS float*)(lds + O_DT) + wave * 64; LAS float* acsw = (LAS float*)(lds + O_ACS) + wave * 64;
    int par = 0;
    for (int item = blk; item < BATCH * 64 * NG; item += nblk, par ^= 1) {
        const int bc = item >> 3, g = item & 7, m0 = bc * 64, head = g * HPG + wave;
        asm volatile("" ::: "memory");
        { u32x4 xr[8];
#pragma unroll
          for (int i = 0; i < 8; ++i) xr[i] = *(const GAS u32x4*)(XC + (size_t)(m0 + (lane >> 3) + 8 * i) * CONVD + head * HP + (lane & 7) * 8);
#pragma unroll
          for (int i = 0; i < 8; ++i) *(LAS u32x4*)(xw + ((lane >> 3) + 8 * i) * RSW + (lane & 7) * 16) = xr[i]; }
        wave_dt_acs(SM, dt_bias, a_log, m0, head, dtw, acsw, lane);
        const GAS bf16* cbase = XC + (size_t)(m0 + c16) * CONVD + DI + NG * NS + g * NS + 8 * gq;
        const GAS bf16* bbase = cbase - NG * NS;
        bf16x8 cf[4][4];
#pragma unroll
        for (int lt = 0; lt < 4; ++lt)
#pragma unroll
            for (int kn = 0; kn < 4; ++kn) cf[lt][kn] = *(const GAS bf16x8*)(cbase + (size_t)(16 * lt) * CONVD + 32 * kn);
        LDS_WAIT(); asm volatile("" ::: "memory");
        float al[4];
#pragma unroll
        for (int lt = 0; lt < 4; ++lt) al[lt] = acsw[16 * lt + c16];
        bf16x8 lf[2][4];
#pragma unroll
        for (int ks = 0; ks < 2; ++ks) {
            f32x4 lt4[2][4];
#pragma unroll
            for (int h2 = 0; h2 < 2; ++h2) { const int st = 2 * ks + h2;
                bf16x8 bfr[4];
#pragma unroll
                for (int kn = 0; kn < 4; ++kn) bfr[kn] = *(const GAS bf16x8*)(bbase + (size_t)(16 * st) * CONVD + 32 * kn);
                float as_[4], ds_[4];
#pragma unroll
                for (int j = 0; j < 4; ++j) { as_[j] = acsw[16 * st + 4 * gq + j]; ds_[j] = dtw[16 * st + 4 * gq + j]; }
#pragma unroll
                for (int lt = 0; lt < 4; ++lt) { f32x4 t4 = (f32x4){0.f, 0.f, 0.f, 0.f};
                    if (lt >= st) {
#pragma unroll
                        for (int kn = 0; kn < 4; ++kn) t4 = __builtin_amdgcn_mfma_f32_16x16x32_bf16(bfr[kn], cf[lt][kn], t4, 0, 0, 0);
#pragma unroll
                        for (int j = 0; j < 4; ++j) { const float e = __expf(fminf(al[lt] - as_[j], 0.f)) * ds_[j]; const bool ok = (lt > st) || (4 * gq + j <= c16); t4[j] = ok ? t4[j] * e : 0.f; } }
                    lt4[h2][lt] = t4; } }
#pragma unroll
            for (int lt = 0; lt < 4; ++lt) { u32x4 w; w.x = pk2(lt4[0][lt][0], lt4[0][lt][1]); w.y = pk2(lt4[0][lt][2], lt4[0][lt][3]); w.z = pk2(lt4[1][lt][0], lt4[1][lt][1]); w.w = pk2(lt4[1][lt][2], lt4[1][lt][3]);
                lf[ks][lt] = __builtin_bit_cast(bf16x8, w); }
        }
        f32x4 acc[4][4];
        const GAS bf16* hsrc = ST + (((size_t)bc * NH + head) * HP + c16) * NS + 8 * gq;
#pragma unroll
        for (int pt = 0; pt < 4; ++pt) { bf16x8 hf[4];
#pragma unroll
            for (int kn = 0; kn < 4; ++kn) hf[kn] = *(const GAS bf16x8*)(hsrc + (size_t)(16 * pt) * NS + 32 * kn);
#pragma unroll
            for (int lt = 0; lt < 4; ++lt) { f32x4 t4 = (f32x4){0.f, 0.f, 0.f, 0.f};
#pragma unroll
                for (int kn = 0; kn < 4; ++kn) t4 = __builtin_amdgcn_mfma_f32_16x16x32_bf16(hf[kn], cf[lt][kn], t4, 0, 0, 0);
                acc[pt][lt] = t4 * __expf(al[lt]); }
            asm volatile("" ::: "memory"); }
        const LAS unsigned char* xb = xw + (4 * gq + (c16 >> 2)) * RSW + (c16 & 3) * 8;
#pragma unroll
        for (int pt = 0; pt < 4; ++pt) {
            const bf16x8 x0 = tr8(xb + pt * 32, 0, 16 * RSW), x1 = tr8(xb + pt * 32, 32 * RSW, 48 * RSW);
#pragma unroll
            for (int lt = 0; lt < 4; ++lt) { acc[pt][lt] = __builtin_amdgcn_mfma_f32_16x16x32_bf16(x0, lf[0][lt], acc[pt][lt], 0, 0, 0);
                if (lt >= 2) acc[pt][lt] = __builtin_amdgcn_mfma_f32_16x16x32_bf16(x1, lf[1][lt], acc[pt][lt], 0, 0, 0); } }
        const float dk = dskip[head]; float ssq[4] = {0.f, 0.f, 0.f, 0.f};
#pragma unroll
        for (int lt = 0; lt < 4; ++lt) { const int l = 16 * lt + c16;
#pragma unroll
            for (int pt = 0; pt < 4; ++pt) { const int p0 = 16 * pt + 4 * gq;
                const u32x2 xv = *(const LAS u32x2*)(xw + l * RSW + p0 * 2); const u32x2 zw = *(const GAS u32x2*)(P + (size_t)(m0 + l) * NMAIN + PZ + head * HP + p0);
                const float xs4[4] = {bflo(xv.x), bfhi(xv.x), bflo(xv.y), bfhi(xv.y)}, z4[4] = {bflo(zw.x), bfhi(zw.x), bflo(zw.y), bfhi(zw.y)};
#pragma unroll
                for (int j = 0; j < 4; ++j) { const float y = (acc[pt][lt][j] + dk * xs4[j]) * z4[j] * __builtin_amdgcn_rcpf(1.0f + __expf(-z4[j])); acc[pt][lt][j] = y; ssq[lt] += y * y; } } }
        LAS float* ssqs = (LAS float*)(lds + O_SSQ) + par * 512;
#pragma unroll
        for (int lt = 0; lt < 4; ++lt) { float v = ssq[lt]; v += __shfl_xor(v, 16); v += __shfl_xor(v, 32); if (gq == 0) ssqs[wave * 64 + 16 * lt + c16] = v; }
        LDS_WAIT();
        __syncthreads();
#pragma unroll
        for (int lt = 0; lt < 4; ++lt) { const int l = 16 * lt + c16; float tot = 0.f;
#pragma unroll
            for (int w8 = 0; w8 < 8; ++w8) tot += ssqs[w8 * 64 + l];
            const float rstd = rsqrtf(tot * (1.0f / (HPG * HP)) + EPS);
#pragma unroll
            for (int pt = 0; pt < 4; ++pt) { const int ch = head * HP + 16 * pt + 4 * gq; const f32x4 gn = *(const GAS f32x4*)(gnorm + ch); const f32x4 o = acc[pt][lt] * rstd * gn;
                if (YF8) *(GAS unsigned*)((GAS unsigned char*)Y + (size_t)(m0 + l) * DI + ch) = pack4_fp8(o.x, o.y, o.z, o.w);
                else { u32x2 w; w.x = pk2(o.x, o.y); w.y = pk2(o.z, o.w); *(GAS u32x2*)(Y + (size_t)(m0 + l) * DI + ch) = w; } } }
        LDS_WAIT(); asm volatile("" ::: "memory");
    }
}

__device__ __forceinline__ float gelu_tanhf_(float x) { const float u = 0.7978845608028654f * (x + 0.044715f * x * x * x); return x * __builtin_amdgcn_rcpf(1.0f + __expf(-2.0f * u)); }
template <bool F8> __device__ __forceinline__ void ph_ffn_act(const GAS bf16* U, const GAS float* cw, const GAS float* cb, GAS bf16* ACT, int gtid, int nthr) {
    constexpr int NCG = FF / 8, R = 8;
    for (int it = gtid; it < (M / R) * NCG; it += nthr) {
        const int c0 = (it % NCG) * 8, m0 = (it / NCG) * R, t0 = m0 & (SEQ - 1);
        f32x4 wg[3][2], wv[3][2];
#pragma unroll
        for (int i = 0; i < 3; ++i) { wg[i][0] = *(const GAS f32x4*)(cw + i * FF2 + c0); wg[i][1] = *(const GAS f32x4*)(cw + i * FF2 + c0 + 4); wv[i][0] = *(const GAS f32x4*)(cw + i * FF2 + FF + c0); wv[i][1] = *(const GAS f32x4*)(cw + i * FF2 + FF + c0 + 4); }
        const f32x4 bg0 = *(const GAS f32x4*)(cb + c0), bg1 = *(const GAS f32x4*)(cb + c0 + 4), bv0 = *(const GAS f32x4*)(cb + FF + c0), bv1 = *(const GAS f32x4*)(cb + FF + c0 + 4);
        u32x4 rg[R + 2], rv[R + 2];
#pragma unroll
        for (int i = 0; i < R + 2; ++i) { const bool ok = (t0 + i - 2) >= 0; const GAS bf16* ur = U + (size_t)(m0 + (ok ? i - 2 : 0)) * FF2 + c0;
            rg[i] = *(const GAS u32x4*)ur; rv[i] = *(const GAS u32x4*)(ur + FF); if (!ok) { rg[i] = (u32x4){0u, 0u, 0u, 0u}; rv[i] = (u32x4){0u, 0u, 0u, 0u}; } }
#pragma unroll
        for (int o = 0; o < R; ++o) { f32x4 g0 = bg0, g1 = bg1, v0 = bv0, v1 = bv1;
#pragma unroll
            for (int i = 0; i < 3; ++i) { float xg[8], xv[8]; unpack8(rg[o + i], xg); unpack8(rv[o + i], xv);
                g0 += wg[i][0] * (f32x4){xg[0], xg[1], xg[2], xg[3]}; g1 += wg[i][1] * (f32x4){xg[4], xg[5], xg[6], xg[7]};
                v0 += wv[i][0] * (f32x4){xv[0], xv[1], xv[2], xv[3]}; v1 += wv[i][1] * (f32x4){xv[4], xv[5], xv[6], xv[7]}; }
            float r[8] = {gelu_tanhf_(g0.x) * v0.x, gelu_tanhf_(g0.y) * v0.y, gelu_tanhf_(g0.z) * v0.z, gelu_tanhf_(g0.w) * v0.w, gelu_tanhf_(g1.x) * v1.x, gelu_tanhf_(g1.y) * v1.y, gelu_tanhf_(g1.z) * v1.z, gelu_tanhf_(g1.w) * v1.w};
            if (F8) *(GAS u32x2*)((GAS unsigned char*)ACT + (size_t)(m0 + o) * FF + c0) = pack8_fp8(r);
            else *(GAS u32x4*)(ACT + (size_t)(m0 + o) * FF + c0) = pack8(r); }
    }
}

struct Args { const float* in[20]; float* out; unsigned char* ws; int ph_lo, ph_hi; };
constexpr int NP = 11, NPHASE = 1 + DEPTH * NP;

#define AIN(i) ((const GAS float*)args.in[i])
__global__ void __launch_bounds__(NTHR, 2) fwd(Args args) {
    extern __shared__ __attribute__((aligned(16))) unsigned char lds[];
    const int G = gridDim.x, blk = blockIdx.x;
    volatile LAS unsigned* MISC = (volatile LAS unsigned*)((LAS unsigned char*)lds + MISC_OFF);
    for (int u = threadIdx.x; u < (LDS_BYTES - LDSCTL_OFF) / 4; u += NTHR) ((LAS unsigned*)((LAS unsigned char*)lds + LDSCTL_OFF))[u] = 0u;
    __syncthreads();
    XcdBarrier bar; bar.bar = (unsigned*)(args.ws + WS_CTL) + CW_BAR; bar.x = 0; bar.st = nullptr;
    if (!MK_PER_PHASE) bar = xcd_barrier_post((unsigned*)(args.ws + WS_CTL) + CW_BAR, MISC + 8);
    const int lo = args.ph_lo, hi = args.ph_hi;
#define IN(k) (lo <= (k) && (k) < hi)
#define SEAM(k) do { if (IN(k) && IN((k) + 1)) xcd_barrier(bar); } while (0)
#define PH_BEGIN \
    int tid = threadIdx.x; asm volatile("" : "+v"(tid)); \
    const int lane = tid & 63, wave = __builtin_amdgcn_readfirstlane(tid >> 6); \
    const int gw = blk * NWAVES + wave, ngw = G * NWAVES, gtid = blk * NTHR + tid, nthr = G * NTHR; \
    GAS unsigned char* ws = (GAS unsigned char*)args.ws; asm volatile("" : "+s"(ws)); \
    LAS unsigned char* ring = (LAS unsigned char*)lds; \
    (void)lane; (void)wave; (void)gw; (void)ngw; (void)gtid; (void)nthr; (void)ring; \
    GAS float* X = (GAS float*)args.out; \
    GAS bf16* H = (GAS bf16*)(ws + WS_H); GAS bf16* P = (GAS bf16*)(ws + WS_P); GAS float* SM = (GAS float*)(ws + WS_SM); GAS bf16* XC = (GAS bf16*)(ws + WS_XC); \
    GAS float* CD = (GAS float*)(ws + WS_DT); GAS bf16* STB = (GAS bf16*)(ws + WS_ST); GAS bf16* Y = (GAS bf16*)(ws + WS_Y); \
    GAS float* SC = (GAS float*)(ws + WS_SC); GAS unsigned long long* MASKW = (GAS unsigned long long*)(ws + WS_IDX); GAS bf16* AO = (GAS bf16*)(ws + WS_AO); \
    GAS float* MG = (GAS float*)(ws + WS_MG); GAS unsigned char* H8 = ws + WS_MG + 32 * MiB; GAS bf16* MGB = (GAS bf16*)(ws + WS_MGB); GAS bf16* YMB = (GAS bf16*)(ws + WS_YM); GAS bf16* XB = (GAS bf16*)(ws + WS_YM + 32 * MiB); GAS bf16* U = (GAS bf16*)(ws + WS_U); \
    GAS bf16* ACT = (GAS bf16*)(ws + WS_ACT); GAS bf16* KIB = (GAS bf16*)(ws + WS_KIB); \
    (void)X; (void)H; (void)P; (void)SM; (void)XC; (void)CD; (void)STB; (void)Y; (void)SC; (void)MASKW; (void)AO; (void)MG; (void)H8; (void)MGB; (void)YMB; (void)XB; (void)U; (void)ACT; (void)KIB;

    if (IN(0)) { PH_BEGIN
        WPtrs wp{AIN(5), AIN(13), AIN(14), AIN(15), AIN(16), AIN(19)};
        REP(5) ph_weights(wp, ws, ring + wave * 10240, gw, ngw, lane);
        ph_resid_norm<true, false, false>(nullptr, nullptr, AIN(1), AIN(0), nullptr, nullptr, XB, H, F8_IN == 0 ? H8 : nullptr, gw, ngw, lane);
    }
    SEAM(0);

#pragma unroll 1
    for (int layer = 0; layer < DEPTH; ++layer) {
        const int pb = 1 + layer * NP;
#define WL (ws + WS_W + (size_t)layer * WL_SIZE)
        if (IN(pb + 0)) { PH_BEGIN
            if (layer >= F8_IN) {
                { pg8::Gemm g{(const GAS bf16*)H8, (const GAS bf16*)(WL + WL_IN), M, PQI, D / 2, 0x7f7f7f7f, 0x79797979}; pg8::StaticOrder S; S.init(M, PQI, G, blk);
                  pg8::EpiIn E{P, NMAIN, AIN(6) + (size_t)layer * 2 * D, PG / 256, 0};
                  pg8::gemm_phase<pg8::EpiIn, pg8::StaticOrder, true, true, true>(ring, g, S, E); }
                __syncthreads();
                { pg8::Gemm g{H, (const GAS bf16*)(WL + WL_IN) + (size_t)PQI * D, M, NMAIN - PQI, D}; pg8::StaticOrder S; S.init(M, NMAIN - PQI, G, (blk + G / 2) % G);
                  pg8::EpiIn E{P, NMAIN, AIN(6) + (size_t)layer * 2 * D, PG / 256, PQI / 256};
                  pg8::gemm_phase<pg8::EpiIn, pg8::StaticOrder, true, true>(ring, g, S, E); }
                __syncthreads();
            } else
            { pg8::Gemm g{H, (const GAS bf16*)(WL + WL_IN), M, NMAIN, D}; pg8::StaticOrder S; S.init(M, NMAIN, G, blk);
              pg8::EpiIn E{P, NMAIN, AIN(6) + (size_t)layer * 2 * D, PG / 256, 0};
              REP(1) { pg8::gemm_phase<pg8::EpiIn, pg8::StaticOrder, true, true>(ring, g, S, E); __syncthreads(); } }
            REP(2) { ph_small_proj(H, (const GAS bf16*)(WL + WL_IN) + (size_t)NMAIN * D, SM, KIB, ring, blk, G, tid); __syncthreads(); }
        }
        SEAM(pb + 0);
        if (IN(pb + 1)) { PH_BEGIN
            REP(20) { ph_ssd_states(P, SM, AIN(7) + (size_t)layer * 4 * CONVD, AIN(8) + (size_t)layer * CONVD, AIN(9) + layer * NH, AIN(10) + layer * NH, XC, STB, CD, ring, blk, G, tid); __syncthreads(); }
            REP(21) { ph_index_scores(P, SM, KIB, SC, ring, blk, G, tid); __syncthreads(); } }
        SEAM(pb + 1);
        if (IN(pb + 2)) { PH_BEGIN
            ph_ssd_scan(STB, CD, gtid, nthr); REP(30) ph_topk(SC, MASKW, ring + wave * 9728, gw, ngw, lane);
#if PROBE_DOUBLE == 31
            ph_ssd_scan((GAS bf16*)U, CD, gtid, nthr);
#endif
            }
        SEAM(pb + 2);
        if (IN(pb + 3)) { PH_BEGIN
            if (layer >= F8_OUT) { ph_ssd_out<true>(P, SM, XC, AIN(9) + layer * NH, AIN(10) + layer * NH, STB, AIN(11) + layer * NH, AIN(12) + (size_t)layer * DI, Y, ring, blk, G, tid); __syncthreads();
                ph_attn_dense<16>(P, MASKW, AO, ring, blk, G, tid); __syncthreads(); }
            else { REP(40) { ph_ssd_out<false>(P, SM, XC, AIN(9) + layer * NH, AIN(10) + layer * NH, STB, AIN(11) + layer * NH, AIN(12) + (size_t)layer * DI, Y, ring, blk, G, tid); __syncthreads(); }
                REP(41) { ph_attn_dense<0>(P, MASKW, AO, ring, blk, G, tid); __syncthreads(); } }
            }
        SEAM(pb + 3);
        if (IN(pb + 4)) {
            { PH_BEGIN
              pg8::StaticOrder S; S.init(M, D, G, blk); pg8::EpiGateMul E{MGB, D, P + PG, NMAIN};
              if (layer >= F8_OUT) { pg8::Gemm g{Y, (const GAS bf16*)(WL + WL_SSM), M, D, DI / 2, 0x7f7f7f7f, 0x79797979}; pg8::gemm_phase<pg8::EpiGateMul, pg8::StaticOrder, false, true, true>(ring, g, S, E); }
              else { pg8::Gemm g{Y, (const GAS bf16*)(WL + WL_SSM), M, D, DI}; pg8::gemm_phase<pg8::EpiGateMul, pg8::StaticOrder, false, true>(ring, g, S, E); } }
            __syncthreads();
            { PH_BEGIN
              pg8::StaticOrder S; S.init(M, D, G, blk); pg8::EpiGateAdd E{MGB, D, P + PG + D, NMAIN, layer >= F8_MIX ? (GAS unsigned char*)MG : nullptr};
              if (layer >= F8_OUT) { pg8::Gemm g{AO, (const GAS bf16*)(WL + WL_ATT), M, D, D / 2, 0x7f7f7f7f, 0x79797979}; pg8::gemm_phase<pg8::EpiGateAdd, pg8::StaticOrder, false, true, true>(ring, g, S, E); }
              else { pg8::Gemm g{AO, (const GAS bf16*)(WL + WL_ATT), M, D, D}; pg8::gemm_phase<pg8::EpiGateAdd, pg8::StaticOrder, false, true>(ring, g, S, E); } }
        }
        SEAM(pb + 4);
        if (IN(pb + 5)) { PH_BEGIN
            pg8::StaticOrder S; S.init(M, D, G, blk); pg8::EpiBf16<0> E{YMB, D, nullptr, 0, 0, 1.f};
            if (layer >= F8_MIX) { pg8::Gemm g{(const GAS bf16*)MG, (const GAS bf16*)(WL + WL_MIX), M, D, D / 2, 0x7f7f7f7f, 0x79797979}; pg8::gemm_phase<pg8::EpiBf16<0>, pg8::StaticOrder, false, true, true>(ring, g, S, E); }
            else { pg8::Gemm g{MGB, (const GAS bf16*)(WL + WL_MIX), M, D, D}; REP(60) { pg8::gemm_phase<pg8::EpiBf16<0>, pg8::StaticOrder, false, true>(ring, g, S, E); __syncthreads(); } } }
        SEAM(pb + 5);
        if (IN(pb + 6)) { PH_BEGIN
            if (layer >= F8_UP) ph_resid_norm<false, true, false, true>(YMB, AIN(2) + (size_t)layer * D, AIN(3) + (size_t)layer * D, nullptr, XB, nullptr, XB, H, nullptr, gw, ngw, lane);
            else ph_resid_norm<false, true, false>(YMB, AIN(2) + (size_t)layer * D, AIN(3) + (size_t)layer * D, nullptr, XB, nullptr, XB, H, nullptr, gw, ngw, lane); }
        SEAM(pb + 6);
        if (IN(pb + 7)) { PH_BEGIN
            pg8::StaticOrder S; S.init(M, FF2, G, blk); pg8::EpiBf16<0> E{U, FF2, nullptr, 0, 0, 1.f};
            if (layer >= F8_UP) { pg8::Gemm g{H, (const GAS bf16*)(WL + WL_UP), M, FF2, D / 2, 0x7f7f7f7f, 0x79797979}; pg8::gemm_phase<pg8::EpiBf16<0>, pg8::StaticOrder, true, true, true>(ring, g, S, E); }
            else { pg8::Gemm g{H, (const GAS bf16*)(WL + WL_UP), M, FF2, D}; REP(80) { pg8::gemm_phase<pg8::EpiBf16<0>, pg8::StaticOrder, true, true>(ring, g, S, E); __syncthreads(); } } }
        SEAM(pb + 7);
        if (IN(pb + 8)) { PH_BEGIN
            if (layer >= F8_DN) ph_ffn_act<true>(U, AIN(17) + (size_t)layer * 3 * FF2, AIN(18) + (size_t)layer * FF2, ACT, gtid, nthr);
            else REP(90) ph_ffn_act<false>(U, AIN(17) + (size_t)layer * 3 * FF2, AIN(18) + (size_t)layer * FF2, ACT, gtid, nthr); }
        SEAM(pb + 8);
        if (IN(pb + 9)) { PH_BEGIN
            pg8::StaticOrder S; S.init(M, D, G, blk); pg8::EpiBf16<0> E{YMB, D, nullptr, 0, 0, 1.f};
            if (layer >= F8_DN) { pg8::Gemm g{ACT, (const GAS bf16*)(WL + WL_DN), M, D, FF / 2, 0x7f7f7f7f, 0x79797979}; pg8::gemm_phase<pg8::EpiBf16<0>, pg8::StaticOrder, false, true, true>(ring, g, S, E); }
            else { pg8::Gemm g{ACT, (const GAS bf16*)(WL + WL_DN), M, D, FF}; REP(100) { pg8::gemm_phase<pg8::EpiBf16<0>, pg8::StaticOrder, false, true>(ring, g, S, E); __syncthreads(); } } }
        SEAM(pb + 9);
        if (IN(pb + 10)) { PH_BEGIN
            if (layer + 1 < DEPTH) ph_resid_norm<false, true, false>(YMB, AIN(4) + (size_t)layer * D, AIN(1) + (size_t)(layer + 1) * D, nullptr, XB, nullptr, XB, H, layer + 1 >= F8_IN ? H8 : nullptr, gw, ngw, lane);
            else ph_resid_norm<false, true, true>(YMB, AIN(4) + (size_t)layer * D, nullptr, nullptr, XB, X, nullptr, H, nullptr, gw, ngw, lane); }
        SEAM(pb + 10);
    }
#undef IN
#undef SEAM
#undef WL
#undef PH_BEGIN
}

extern "C" void kernel_launch(void* const* d_in, const int* in_sizes, int n_in, void* d_out, int out_size, void* d_ws, size_t ws_size, hipStream_t stream) {
    static int grid = 0;
    if (grid == 0) {
        if (n_in != 20 || in_sizes[0] != M * D || out_size != M * D || ws_size < WS_END) { fprintf(stderr, "kernel_launch: unexpected shapes (n_in %d, in0 %d, out %d, ws %zu < %zu)\n", n_in, n_in > 0 ? in_sizes[0] : -1, out_size, ws_size, (size_t)WS_END); grid = -1; return; }
        int dev = 0, cus = 0, per_cu = 0;
        if (hipGetDevice(&dev) != hipSuccess || hipDeviceGetAttribute(&cus, hipDeviceAttributeMultiprocessorCount, dev) != hipSuccess) { grid = -1; return; }
        if (hipFuncSetAttribute((const void*)fwd, hipFuncAttributeMaxDynamicSharedMemorySize, LDS_BYTES) != hipSuccess) { fprintf(stderr, "kernel_launch: hipFuncSetAttribute failed\n"); grid = -1; return; }
        if (hipOccupancyMaxActiveBlocksPerMultiprocessor(&per_cu, (const void*)fwd, NTHR, LDS_BYTES) != hipSuccess || per_cu < 1) fprintf(stderr, "kernel_launch: occupancy query reports %d blocks per CU\n", per_cu);
        (void)hipGetLastError();
        grid = cus;
    }
    if (grid < 0) return;
    if (hipMemsetAsync((char*)d_ws + WS_CTL, 0, CTL_ZERO_BYTES, stream) != hipSuccess) return;
    Args a{};
    for (int i = 0; i < 20; ++i) a.in[i] = (const float*)d_in[i];
    a.out = (float*)d_out; a.ws = (unsigned char*)d_ws;
#if MK_PER_PHASE
    for (int ph = 0; ph < NPHASE; ++ph) { a.ph_lo = ph; a.ph_hi = ph + 1; hipLaunchKernelGGL(fwd, dim3(grid), dim3(NTHR), LDS_BYTES, stream, a); }
#else
    a.ph_lo = 0; a.ph_hi = NPHASE; hipLaunchKernelGGL(fwd, dim3(grid), dim3(NTHR), LDS_BYTES, stream, a);
#endif
}
```

```cpp
#include <hip/hip_runtime.h>
#include <cstdio>
#include <cstdint>
#define MK_PER_PHASE 0
namespace pg8 {
#define PG8_LAS __attribute__((address_space(3)))
#define PG8_GAS __attribute__((address_space(1)))
typedef unsigned short bf16_t;
typedef short bf16x8 __attribute__((ext_vector_type(8)));
typedef float f32x4 __attribute__((ext_vector_type(4)));
typedef unsigned u32x4 __attribute__((ext_vector_type(4)));
constexpr int BM = 256, BK = 64, HALF = 128, HTB = HALF * BK * 2  , STAGE_BYTES = 8 * HTB, NXCD = 8, WGM = 8;

__host__ __device__ __forceinline__ int lds_byte(int r, int c) { const int st = (r >> 4) * 2 + (c >> 5), rr = r & 15, cc = c & 31, ob = rr * 64 + cc * 2; return st * 1024 + (ob ^ (((ob >> 9) & 1) << 5)); }
__host__ __device__ __forceinline__ void stage_rc(int b, int& R, int& C) { const int st = b / 1024, sb = b % 1024, swz = sb ^ (((sb >> 9) & 1) << 5); R = (st >> 1) * 16 + swz / 64; C = (st & 1) * 32 + (swz % 64) / 2; }
__host__ __device__ __forceinline__ int perm32(int rho) { const int n = rho >> 4, i = rho & 15; return 8 * (i >> 2) + 4 * n + (i & 3); }

struct Unit { int pm, pn; };
struct Gemm { const PG8_GAS bf16_t* A; const PG8_GAS bf16_t* Bt; int M, N, K; int sa, sb; };

struct StaticOrder {
    int nM, nN, nwg, G, c;
    __host__ __device__ void init(int M, int N, int G_, int c_) { nM = M / BM; nN = N / BM; nwg = nM * nN; G = G_; c = c_; }
    __host__ __device__ bool next(int i, Unit& u) const {
        const long L = (long)i * G + c; if (L >= nwg) return false;
        int wgid = (int)L; { const int q = nwg / NXCD, r = nwg % NXCD, xcd = wgid % NXCD, off = wgid / NXCD; wgid = (xcd < r ? xcd * (q + 1) : r * (q + 1) + (xcd - r) * q) + off; }
        const int nig = WGM * nN, gid = wgid / nig, fm = gid * WGM, gsz = (nM - fm) < WGM ? (nM - fm) : WGM;
        u.pm = fm + ((wgid % nig) % gsz); u.pn = (wgid % nig) / gsz; return true;
    }
    __device__ __forceinline__ void a_ready(const Unit&) const {}
    __device__ __forceinline__ void done(const Unit&) const {}
};

__device__ __forceinline__ unsigned cvt_pk_bf16(float lo, float hi) { unsigned r; asm volatile("v_cvt_pk_bf16_f32 %0, %1, %2" : "=v"(r) : "v"(lo), "v"(hi)); return r; }
typedef float f32x2 __attribute__((ext_vector_type(2)));
__device__ __forceinline__ f32x2 gelu_pk(f32x2 v) {
    const f32x2 av = __builtin_elementwise_abs(v), d = av * 0.2316418882f + 1.0f;
    f32x2 t; t.x = __builtin_amdgcn_rcpf(d.x); t.y = __builtin_amdgcn_rcpf(d.y);
    f32x2 q = t * 0.5307027145f + (-0.7265760135f); q = q * t + 0.7107068705f; q = q * t + (-0.142248368f); q = q * t + 0.127414796f; q = q * t;
    const f32x2 s = (v * v) * (-0.72134752044f);
    f32x2 e; e.x = __builtin_amdgcn_exp2f(s.x); e.y = __builtin_amdgcn_exp2f(s.y);
    const f32x2 m = v * (q * e), r = v - m;
    f32x2 o; o.x = v.x < 0.f ? m.x : r.x; o.y = v.y < 0.f ? m.y : r.y; return o;
}

template <int ACT  > struct EpiBf16 {
    static constexpr bool PERM = true, AFTER_DRAIN = false; static_assert(ACT == 0 || ACT == 1, "EpiBf16: ACT is 0 (none) or 1 (gelu_pk)");
    PG8_GAS bf16_t* O; int ldc; const PG8_GAS float* bias; int split_cols; size_t split_stride; float scale0;
    __device__ __forceinline__ void operator()(const f32x4 (&acc)[2][2][4][2], const Unit& u, int wr, int wc, int fr, int fq) const {
        const int row0 = u.pm * BM + wr * 64 + fr; int colt = u.pn * BM; PG8_GAS bf16_t* base = O;
        float sc = 1.f; if (split_cols) { const int t = colt / split_cols; base += (size_t)t * split_stride; colt -= t * split_cols; if (t == 0) sc = scale0; }
        const int col0 = colt + wc * 32 + 8 * fq, bcol0 = u.pn * BM + wc * 32 + 8 * fq;
        f32x4 bv[2][2];
#pragma unroll
        for (int bj = 0; bj < 2; ++bj)
#pragma unroll
            for (int n = 0; n < 2; ++n) bv[bj][n] = bias ? *(const PG8_GAS f32x4*)(bias + bcol0 + bj * HALF + 4 * n) : (f32x4){0.f, 0.f, 0.f, 0.f};
#pragma unroll
        for (int ai = 0; ai < 2; ++ai)
#pragma unroll
            for (int m = 0; m < 4; ++m) { PG8_GAS bf16_t* rowp = base + (size_t)(row0 + ai * HALF + m * 16) * ldc + col0;
#pragma unroll
                for (int bj = 0; bj < 2; ++bj) { f32x4 v0 = acc[ai][bj][m][0] + bv[bj][0], v1 = acc[ai][bj][m][1] + bv[bj][1];
                    if (ACT == 1) { f32x2 a = gelu_pk((f32x2){v0[0], v0[1]}), b = gelu_pk((f32x2){v0[2], v0[3]}), c = gelu_pk((f32x2){v1[0], v1[1]}), d = gelu_pk((f32x2){v1[2], v1[3]});
                        v0 = (f32x4){a.x, a.y, b.x, b.y}; v1 = (f32x4){c.x, c.y, d.x, d.y}; }
                    v0 = v0 * sc; v1 = v1 * sc; u32x4 w; w.x = cvt_pk_bf16(v0[0], v0[1]); w.y = cvt_pk_bf16(v0[2], v0[3]); w.z = cvt_pk_bf16(v1[0], v1[1]); w.w = cvt_pk_bf16(v1[2], v1[3]);
                    *(PG8_GAS u32x4*)(rowp + bj * HALF) = w; } }
    }
};

struct EpiF32 {
    static constexpr bool PERM = false, AFTER_DRAIN = false;
    PG8_GAS float* C; int ldc;
    __device__ __forceinline__ void operator()(const f32x4 (&acc)[2][2][4][2], const Unit& u, int wr, int wc, int fr, int fq) const {
        const int row0 = u.pm * BM + wr * 64 + fr, col0 = u.pn * BM + wc * 32 + 4 * fq;
#pragma unroll
        for (int ai = 0; ai < 2; ++ai)
#pragma unroll
            for (int m = 0; m < 4; ++m) { PG8_GAS float* rowp = C + (size_t)(row0 + ai * HALF + m * 16) * ldc + col0;
#pragma unroll
                for (int bj = 0; bj < 2; ++bj)
#pragma unroll
                    for (int n = 0; n < 2; ++n) *(PG8_GAS f32x4*)(rowp + bj * HALF + n * 16) = acc[ai][bj][m][n]; }
    }
};
__device__ __forceinline__ float bf_lo(unsigned w) { return __uint_as_float(w << 16); }
__device__ __forceinline__ float bf_hi(unsigned w) { return __uint_as_float(w & 0xffff0000u); }
__device__ __forceinline__ float sigmoidf_(float x) { return __builtin_amdgcn_rcpf(1.0f + __expf(-x)); }
struct EpiIn {
    static constexpr bool PERM = true, AFTER_DRAIN = false;
    PG8_GAS bf16_t* P; int ldp; const PG8_GAS float* bgate; int gate_tile0, tile0;
    __device__ __forceinline__ void operator()(const f32x4 (&acc)[2][2][4][2], const Unit& u, int wr, int wc, int fr, int fq) const {
        const int pn = u.pn + tile0, row0 = u.pm * BM + wr * 64 + fr, colt = pn * BM + wc * 32 + 8 * fq;
        {
            const bool gate = pn >= gate_tile0 && pn < gate_tile0 + 16;
            f32x4 bv[2][2];
#pragma unroll
            for (int bj = 0; bj < 2; ++bj)
#pragma unroll
                for (int n = 0; n < 2; ++n) bv[bj][n] = gate ? *(const PG8_GAS f32x4*)(bgate + (colt - gate_tile0 * BM) + bj * HALF + 4 * n) : (f32x4){0.f, 0.f, 0.f, 0.f};
#pragma unroll
            for (int ai = 0; ai < 2; ++ai)
#pragma unroll
                for (int m = 0; m < 4; ++m) { PG8_GAS bf16_t* rowp = P + (size_t)(row0 + ai * HALF + m * 16) * ldp + colt;
#pragma unroll
                    for (int bj = 0; bj < 2; ++bj) { f32x4 v0 = acc[ai][bj][m][0] + bv[bj][0], v1 = acc[ai][bj][m][1] + bv[bj][1];
                        if (gate) {
#pragma unroll
                            for (int j = 0; j < 4; ++j) { v0[j] = sigmoidf_(v0[j]); v1[j] = sigmoidf_(v1[j]); } }
                        u32x4 w; w.x = cvt_pk_bf16(v0[0], v0[1]); w.y = cvt_pk_bf16(v0[2], v0[3]); w.z = cvt_pk_bf16(v1[0], v1[1]); w.w = cvt_pk_bf16(v1[2], v1[3]);
                        *(PG8_GAS u32x4*)(rowp + bj * HALF) = w; } }
        }
    }
};
struct EpiGateMul {
    static constexpr bool PERM = true, AFTER_DRAIN = false;
    PG8_GAS bf16_t* O; int ldc; const PG8_GAS bf16_t* G; int ldg;
    __device__ __forceinline__ void operator()(const f32x4 (&acc)[2][2][4][2], const Unit& u, int wr, int wc, int fr, int fq) const {
        const int row0 = u.pm * BM + wr * 64 + fr, colt = u.pn * BM + wc * 32 + 8 * fq;
#pragma unroll
        for (int ai = 0; ai < 2; ++ai)
#pragma unroll
            for (int m = 0; m < 4; ++m) { const size_t row = (size_t)(row0 + ai * HALF + m * 16);
#pragma unroll
                for (int bj = 0; bj < 2; ++bj) { const u32x4 g = *(const PG8_GAS u32x4*)(G + row * ldg + colt + bj * HALF);
                    const f32x4 a0 = acc[ai][bj][m][0], a1 = acc[ai][bj][m][1];
                    u32x4 w; w.x = cvt_pk_bf16(a0[0] * bf_lo(g.x), a0[1] * bf_hi(g.x)); w.y = cvt_pk_bf16(a0[2] * bf_lo(g.y), a0[3] * bf_hi(g.y));
                    w.z = cvt_pk_bf16(a1[0] * bf_lo(g.z), a1[1] * bf_hi(g.z)); w.w = cvt_pk_bf16(a1[2] * bf_lo(g.w), a1[3] * bf_hi(g.w));
                    *(PG8_GAS u32x4*)(O + row * ldc + colt + bj * HALF) = w; } }
    }
};
struct EpiGateAdd {
    static constexpr bool PERM = true, AFTER_DRAIN = false;
    PG8_GAS bf16_t* O; int ldc; const PG8_GAS bf16_t* G; int ldg; PG8_GAS unsigned char* O8;
    __device__ __forceinline__ void operator()(const f32x4 (&acc)[2][2][4][2], const Unit& u, int wr, int wc, int fr, int fq) const {
        const int row0 = u.pm * BM + wr * 64 + fr, colt = u.pn * BM + wc * 32 + 8 * fq;
#pragma unroll
        for (int ai = 0; ai < 2; ++ai)
#pragma unroll
            for (int m = 0; m < 4; ++m) { const size_t row = (size_t)(row0 + ai * HALF + m * 16);
#pragma unroll
                for (int bj = 0; bj < 2; ++bj) { const u32x4 g = *(const PG8_GAS u32x4*)(G + row * ldg + colt + bj * HALF);
                    PG8_GAS u32x4* op = (PG8_GAS u32x4*)(O + row * ldc + colt + bj * HALF); const u32x4 p = *op;
                    const f32x4 a0 = acc[ai][bj][m][0], a1 = acc[ai][bj][m][1];
                    const float s0 = bf_lo(p.x) + a0[0] * bf_lo(g.x), s1 = bf_hi(p.x) + a0[1] * bf_hi(g.x), s2 = bf_lo(p.y) + a0[2] * bf_lo(g.y), s3 = bf_hi(p.y) + a0[3] * bf_hi(g.y);
                    const float s4 = bf_lo(p.z) + a1[0] * bf_lo(g.z), s5 = bf_hi(p.z) + a1[1] * bf_hi(g.z), s6 = bf_lo(p.w) + a1[2] * bf_lo(g.w), s7 = bf_hi(p.w) + a1[3] * bf_hi(g.w);
                    if (O8) { int lo = 0, hi = 0; lo = __builtin_amdgcn_cvt_pk_fp8_f32(s0, s1, lo, false); lo = __builtin_amdgcn_cvt_pk_fp8_f32(s2, s3, lo, true); hi = __builtin_amdgcn_cvt_pk_fp8_f32(s4, s5, hi, false); hi = __builtin_amdgcn_cvt_pk_fp8_f32(s6, s7, hi, true);
                        typedef unsigned u32x2e __attribute__((ext_vector_type(2))); u32x2e w8; w8.x = (unsigned)lo; w8.y = (unsigned)hi; *(PG8_GAS u32x2e*)(O8 + row * ldc + colt + bj * HALF) = w8; }
                    else { u32x4 w; w.x = cvt_pk_bf16(s0, s1); w.y = cvt_pk_bf16(s2, s3); w.z = cvt_pk_bf16(s4, s5); w.w = cvt_pk_bf16(s6, s7); *op = w; } } }
    }
};
template <class Epi, class Sched, bool ALIGN_EPI = false, bool SP2 = false, bool FP8 = false>
__device__ __forceinline__ void gemm_phase(PG8_LAS unsigned char* lds, const Gemm g, const Sched& S, const Epi& E) {
    int tid = threadIdx.x; asm volatile("" : "+v"(tid));
    const int wid = __builtin_amdgcn_readfirstlane(tid >> 6), lane = tid & 63, wr = wid >> 2, wc = wid & 3, fr = lane & 15, fq = lane >> 4;
    const int K = g.K, nt = K / BK;
    unsigned voffA[2], voffB[2];
#pragma unroll
    for (int i = 0; i < 2; ++i) { int R, C; stage_rc(tid * 16 + i * 8192, R, C); const int Rb = Epi::PERM ? ((R & ~31) + perm32(R & 31)) : R;
        voffA[i] = (unsigned)(R * K + C) * 2u; voffB[i] = (unsigned)(Rb * K + C) * 2u; }
    const size_t kstep = (size_t)(BK * 2);
    const size_t hstep = (size_t)HALF * K * 2;
    const size_t tstep = 2 * hstep;
    const unsigned ldsw = (unsigned)wid * 1024u;
    const int aoff = lds_byte(wr * 64 + fr, fq * 8), boff = lds_byte(wc * 32 + fr, fq * 8);
#define PG8_SA(b, h) (((b) * 2 + (h)) * HTB)
#define PG8_SB(b, h) ((4 + (b) * 2 + (h)) * HTB)
#define PG8_STAGE(bufoff, gbase, voff) do { _Pragma("unroll") for (int _i = 0; _i < 2; ++_i) \
        __builtin_amdgcn_global_load_lds((const PG8_GAS unsigned*)((const PG8_GAS char*)(gbase) + (voff)[_i]), (PG8_LAS unsigned*)(lds + (bufoff) + ldsw + _i * 8192), 16, 0, 0); } while (0)
typedef int pg8_v4i __attribute__((ext_vector_type(4))); typedef int pg8_v8i __attribute__((ext_vector_type(8)));
#define PG8_CAT(x, y) __builtin_shufflevector(__builtin_bit_cast(pg8_v4i, (x)), __builtin_bit_cast(pg8_v4i, (y)), 0, 1, 2, 3, 4, 5, 6, 7)
#define PG8_LDA(dst, b, h) do { if constexpr (FP8) { _Pragma("unroll") for (int m = 0; m < 4; ++m) dst##8[m] = PG8_CAT(*(const PG8_LAS bf16x8*)(lds + PG8_SA(b, h) + aoff + m * 2048), *(const PG8_LAS bf16x8*)(lds + PG8_SA(b, h) + aoff + m * 2048 + 1024)); } \
        else { _Pragma("unroll") for (int m = 0; m < 4; ++m) _Pragma("unroll") for (int k = 0; k < 2; ++k) dst[m][k] = *(const PG8_LAS bf16x8*)(lds + PG8_SA(b, h) + aoff + m * 2048 + k * 1024); } } while (0)
#define PG8_LDB(dst, b, h) do { if constexpr (FP8) { _Pragma("unroll") for (int n = 0; n < 2; ++n) dst##8[n] = PG8_CAT(*(const PG8_LAS bf16x8*)(lds + PG8_SB(b, h) + boff + n * 2048), *(const PG8_LAS bf16x8*)(lds + PG8_SB(b, h) + boff + n * 2048 + 1024)); } \
        else { _Pragma("unroll") for (int n = 0; n < 2; ++n) _Pragma("unroll") for (int k = 0; k < 2; ++k) dst[n][k] = *(const PG8_LAS bf16x8*)(lds + PG8_SB(b, h) + boff + n * 2048 + k * 1024); } } while (0)
#define PG8_MMA(ai, bj, At, Bt) do { __builtin_amdgcn_s_setprio(1); \
        if constexpr (FP8) { _Pragma("unroll") for (int m = 0; m < 4; ++m) _Pragma("unroll") for (int n = 0; n < 2; ++n) \
            asm volatile("v_mfma_scale_f32_16x16x128_f8f6f4 %0, %1, %2, %0, %3, %4 op_sel_hi:[0,0,0]" : "+v"(acc[ai][bj][m][n]) : "v"(Bt##8[n]), "v"(At##8[m]), "v"(sc_b), "v"(sc_a)); } \
        else { _Pragma("unroll") for (int m = 0; m < 4; ++m) _Pragma("unroll") for (int n = 0; n < 2; ++n) _Pragma("unroll") for (int k = 0; k < 2; ++k) \
            acc[ai][bj][m][n] = __builtin_amdgcn_mfma_f32_16x16x32_bf16(Bt[n][k], At[m][k], acc[ai][bj][m][n], 0, 0, 0); } \
        __builtin_amdgcn_s_setprio(0); } while (0)
#define PG8_WAIT_V(n) asm volatile("s_waitcnt vmcnt(" #n ")" ::: "memory")
#define PG8_WAIT_L(n) asm volatile("s_waitcnt lgkmcnt(" #n ")" ::: "memory")
#define PG8_BAR __builtin_amdgcn_s_barrier()
#define PG8_SCHED __builtin_amdgcn_sched_barrier(0)
    Unit cur, nxt; int ui = 0;
    if (!S.next(0, cur)) return;
    f32x4 acc[2][2][4][2];
#pragma unroll
    for (int a = 0; a < 2; ++a)
#pragma unroll
        for (int b = 0; b < 2; ++b)
#pragma unroll
            for (int m = 0; m < 4; ++m)
#pragma unroll
                for (int n = 0; n < 2; ++n) acc[a][b][m][n] = (f32x4){0.f, 0.f, 0.f, 0.f};
    const int sc_a = g.sa, sc_b = g.sb;
    bf16x8 At[4][2], B0[2][2], B1[2][2]; pg8_v8i At8[4], B08[2], B18[2];
    const PG8_GAS char* cA = (const PG8_GAS char*)g.A + (size_t)cur.pm * tstep; const PG8_GAS char* cB = (const PG8_GAS char*)g.Bt + (size_t)cur.pn * tstep;
    S.a_ready(cur);
    if constexpr (SP2) {
        PG8_STAGE(PG8_SB(0, 0), cB, voffB); PG8_STAGE(PG8_SB(0, 1), cB + hstep, voffB); PG8_STAGE(PG8_SA(0, 0), cA, voffA); PG8_STAGE(PG8_SA(0, 1), cA + hstep, voffA);
        if (wr == 1) PG8_BAR;
        PG8_WAIT_V(2); PG8_BAR;
        PG8_STAGE(PG8_SB(1, 0), cB + kstep, voffB); PG8_STAGE(PG8_SA(1, 0), cA + kstep, voffA); PG8_STAGE(PG8_SB(1, 1), cB + hstep + kstep, voffB);
        PG8_WAIT_V(6); PG8_BAR;
    } else {
        PG8_STAGE(PG8_SB(0, 0), cB, voffB); PG8_STAGE(PG8_SA(0, 0), cA, voffA); PG8_STAGE(PG8_SB(0, 1), cB + hstep, voffB); PG8_STAGE(PG8_SA(0, 1), cA + hstep, voffA);
        if (wr == 1) PG8_BAR;
        PG8_WAIT_V(4); PG8_BAR;
        PG8_STAGE(PG8_SB(1, 0), cB + kstep, voffB); PG8_STAGE(PG8_SA(1, 0), cA + kstep, voffA); PG8_STAGE(PG8_SB(1, 1), cB + hstep + kstep, voffB);
        PG8_WAIT_V(6); PG8_BAR;
    }
    for (;;) {
        const bool has_next = S.next(ui + 1, nxt);
        const PG8_GAS char* nA = has_next ? (const PG8_GAS char*)g.A + (size_t)nxt.pm * tstep : cA; const PG8_GAS char* nB = has_next ? (const PG8_GAS char*)g.Bt + (size_t)nxt.pn * tstep : cB;
        for (int t = 0; t < nt; t += 2) {
            const bool last = (t == nt - 2);
            const PG8_GAS char* a1 = cA + (size_t)(t + 1) * kstep;
            const PG8_GAS char* a2 = last ? nA : cA + (size_t)(t + 2) * kstep; const PG8_GAS char* b2 = last ? nB : cB + (size_t)(t + 2) * kstep;
            const PG8_GAS char* a3 = a2 + kstep; const PG8_GAS char* b3 = b2 + kstep;
            if (last && has_next) S.a_ready(nxt);
            if constexpr (SP2) {
            PG8_LDB(B0, 0, 0); PG8_LDB(B1, 0, 1); PG8_SCHED; PG8_LDA(At, 0, 0); PG8_STAGE(PG8_SA(1, 1), a1 + hstep, voffA);
            PG8_WAIT_V(8); PG8_WAIT_L(0); PG8_BAR; PG8_MMA(0, 0, At, B0); PG8_MMA(0, 1, At, B1); PG8_BAR; PG8_SCHED;
            PG8_LDA(At, 0, 1); PG8_STAGE(PG8_SB(0, 0), b2, voffB); PG8_STAGE(PG8_SB(0, 1), b2 + hstep, voffB); PG8_STAGE(PG8_SA(0, 0), a2, voffA);
            PG8_WAIT_V(8); PG8_WAIT_L(0); PG8_BAR; PG8_MMA(1, 0, At, B0); PG8_MMA(1, 1, At, B1); PG8_BAR; PG8_SCHED;
            PG8_LDB(B0, 1, 0); PG8_LDB(B1, 1, 1); PG8_SCHED; PG8_LDA(At, 1, 0); PG8_STAGE(PG8_SA(0, 1), a2 + hstep, voffA);
            PG8_WAIT_V(8); PG8_WAIT_L(0); PG8_BAR; PG8_MMA(0, 0, At, B0); PG8_MMA(0, 1, At, B1); PG8_BAR; PG8_SCHED;
            PG8_LDA(At, 1, 1); PG8_STAGE(PG8_SB(1, 0), b3, voffB); PG8_STAGE(PG8_SB(1, 1), b3 + hstep, voffB); PG8_STAGE(PG8_SA(1, 0), a3, voffA);
            PG8_WAIT_V(8); PG8_WAIT_L(0); PG8_BAR; PG8_MMA(1, 0, At, B0); PG8_MMA(1, 1, At, B1); PG8_BAR; PG8_SCHED;
            } else {
            PG8_LDB(B0, 0, 0); PG8_SCHED; PG8_LDA(At, 0, 0); PG8_STAGE(PG8_SA(1, 1), a1 + hstep, voffA);
            PG8_WAIT_L(8); PG8_BAR; PG8_WAIT_L(0); PG8_MMA(0, 0, At, B0); PG8_BAR; PG8_SCHED;
            PG8_LDB(B1, 0, 1); PG8_STAGE(PG8_SB(0, 0), b2, voffB);
            PG8_BAR; PG8_WAIT_L(0); PG8_MMA(0, 1, At, B1); PG8_BAR;
            PG8_LDA(At, 0, 1); PG8_STAGE(PG8_SA(0, 0), a2, voffA);
            PG8_BAR; PG8_WAIT_L(0); PG8_MMA(1, 0, At, B0); PG8_BAR; PG8_SCHED;
            PG8_STAGE(PG8_SB(0, 1), b2 + hstep, voffB);
            PG8_WAIT_V(6); PG8_BAR; PG8_MMA(1, 1, At, B1); PG8_BAR;
            PG8_LDB(B0, 1, 0); PG8_SCHED; PG8_LDA(At, 1, 0); PG8_STAGE(PG8_SA(0, 1), a2 + hstep, voffA);
            PG8_WAIT_L(8); PG8_BAR; PG8_WAIT_L(0); PG8_MMA(0, 0, At, B0); PG8_BAR; PG8_SCHED;
            PG8_LDB(B1, 1, 1); PG8_STAGE(PG8_SB(1, 0), b3, voffB);
            PG8_BAR; PG8_WAIT_L(0); PG8_MMA(0, 1, At, B1); PG8_BAR;
            PG8_LDA(At, 1, 1); PG8_STAGE(PG8_SA(1, 0), a3, voffA);
            PG8_BAR; PG8_WAIT_L(0); PG8_MMA(1, 0, At, B0); PG8_BAR; PG8_SCHED;
            PG8_STAGE(PG8_SB(1, 1), b3 + hstep, voffB);
            PG8_WAIT_V(6); PG8_BAR; PG8_MMA(1, 1, At, B1); PG8_BAR;
            }
        }
        if constexpr (FP8) asm volatile("s_nop 15\n\ts_nop 15" ::: "memory");
        if constexpr (ALIGN_EPI) { if (wr == 0) PG8_BAR; }
        if constexpr (!Epi::AFTER_DRAIN) { E(acc, cur, wr, wc, fr, fq); S.done(cur); }
        if (!has_next) break;
#pragma unroll
        for (int a = 0; a < 2; ++a)
#pragma unroll
            for (int b = 0; b < 2; ++b)
#pragma unroll
                for (int m = 0; m < 4; ++m)
#pragma unroll
                    for (int n = 0; n < 2; ++n) acc[a][b][m][n] = (f32x4){0.f, 0.f, 0.f, 0.f};
        cur = nxt; cA = nA; cB = nB; ++ui;
        if constexpr (ALIGN_EPI) { if (wr == 1) PG8_BAR; }
    }
    PG8_WAIT_V(0);
    if constexpr (!ALIGN_EPI) { if (wr == 0) PG8_BAR; }
    PG8_BAR;
    if constexpr (Epi::AFTER_DRAIN) { E.fused(acc, cur, wr, wc, fr, fq, lds, wid, lane); S.done(cur); }
#undef PG8_SA
#undef PG8_SB
#undef PG8_STAGE
#undef PG8_LDA
#undef PG8_LDB
#undef PG8_MMA
#undef PG8_WAIT_V
#undef PG8_WAIT_L
#undef PG8_BAR
#undef PG8_SCHED
}
}

#ifndef MK_PER_PHASE
#define MK_PER_PHASE 0
#endif
#ifndef PROBE_DOUBLE
#define PROBE_DOUBLE -1
#endif
#define REP(id) for (int rep_ = 0; rep_ < ((PROBE_DOUBLE == (id)) ? 2 : 1); ++rep_)
constexpr int NWAVES = 8, NTHR = 512;
constexpr int BATCH = 2, SEQ = 4096, M = BATCH * SEQ, D = 2048, DEPTH = 4;
constexpr int DI = 4096, NH = 64, HP = 64, NG = 8, HPG = 8, NS = 128, CONVD = 6144;
constexpr int QH = 16, KVH = 4, AD = 128, IH = 16, IDD = 64, TOPK = 256;
constexpr int FF = 4096, FF2 = 8192;
constexpr int NIN = 18576, NMAIN = 18432, NPAD = 18688;
constexpr int PZ = 0, PXBC = 4096, PQ = 10240, PK = 12288, PV = 12800, PG = 13312, PQI = 17408;
constexpr int SMW = 256, SM_DT = 0, SM_KI = 64, SM_WI = 128;
constexpr float EPS = 1e-6f;
constexpr int F8_DN = DEPTH - 2, F8_UP = DEPTH - 2, F8_MIX = DEPTH - 1, F8_OUT = DEPTH - 1, F8_IN = DEPTH - 1;
constexpr float ATTN_SCALE = 0.08838834764831845f;

constexpr size_t MiB = 1u << 20;
constexpr size_t WS_CTL = 0, CTL_ZERO_BYTES = 1 * MiB;
constexpr size_t WS_W = 2 * MiB;
constexpr size_t WL_IN = 0, WL_SSM = 73 * MiB, WL_ATT = 89 * MiB, WL_MIX = 97 * MiB, WL_UP = 105 * MiB, WL_DN = 137 * MiB, WL_SIZE = 153 * MiB;
constexpr size_t WS_H = WS_W + DEPTH * WL_SIZE;
constexpr size_t WS_P = WS_H + 32 * MiB;
constexpr size_t WS_SM = WS_P + 288 * MiB;
constexpr size_t WS_XC = WS_SM + 8 * MiB;
constexpr size_t WS_DT = WS_XC + 96 * MiB;
constexpr size_t WS_ACS = WS_DT + 2 * MiB;
constexpr size_t WS_ST = WS_ACS + 2 * MiB;
constexpr size_t WS_Y = WS_ST + 256 * MiB;
constexpr size_t WS_SC = WS_Y + 64 * MiB;
constexpr size_t WS_IDX = WS_SC + 128 * MiB;
constexpr size_t WS_CNT = WS_IDX + 8 * MiB;
constexpr size_t WS_AO = WS_CNT + 1 * MiB;
constexpr size_t WS_MG = WS_AO + 32 * MiB;
constexpr size_t WS_MGB = WS_MG + 64 * MiB;
constexpr size_t WS_YM = WS_MGB + 32 * MiB;
constexpr size_t WS_U = WS_YM + 64 * MiB;
constexpr size_t WS_ACT = WS_U + 128 * MiB;
constexpr size_t WS_KIB = WS_ACT + 64 * MiB;
constexpr size_t WS_END = WS_KIB + 1 * MiB;
constexpr int CW_BAR = 4096;

constexpr int RING_BYTES = 139264, LDSCTL_OFF = RING_BYTES, MISC_OFF = LDSCTL_OFF + 320, LDS_BYTES = 147456;

#define LAS __attribute__((address_space(3)))
#define GAS __attribute__((address_space(1)))
typedef unsigned short bf16;
typedef float f32x4 __attribute__((ext_vector_type(4)));
typedef short bf16x8 __attribute__((ext_vector_type(8)));
typedef unsigned u32x4 __attribute__((ext_vector_type(4)));
typedef unsigned u32x2 __attribute__((ext_vector_type(2)));
#define LDS_WAIT() asm volatile("s_waitcnt lgkmcnt(0)" ::: "memory")

__device__ __forceinline__ unsigned f2bf(float f) { unsigned u = __builtin_bit_cast(unsigned, f); return (u + 0x7fffu + ((u >> 16) & 1u)) >> 16; }
__device__ __forceinline__ unsigned pk2(float lo, float hi) { return f2bf(lo) | (f2bf(hi) << 16); }
__device__ __forceinline__ unsigned cvtpk(float lo, float hi) { unsigned r; asm("v_cvt_pk_bf16_f32 %0, %1, %2" : "=v"(r) : "v"(lo), "v"(hi)); return r; }
__device__ __forceinline__ u32x2 pack8_fp8(const float (&f)[8]) { int lo = 0, hi = 0; lo = __builtin_amdgcn_cvt_pk_fp8_f32(f[0], f[1], lo, false); lo = __builtin_amdgcn_cvt_pk_fp8_f32(f[2], f[3], lo, true);
    hi = __builtin_amdgcn_cvt_pk_fp8_f32(f[4], f[5], hi, false); hi = __builtin_amdgcn_cvt_pk_fp8_f32(f[6], f[7], hi, true); u32x2 w; w.x = (unsigned)lo; w.y = (unsigned)hi; return w; }
__device__ __forceinline__ unsigned pack4_fp8(float a, float b, float c, float d) { int w = 0; w = __builtin_amdgcn_cvt_pk_fp8_f32(a, b, w, false); w = __builtin_amdgcn_cvt_pk_fp8_f32(c, d, w, true); return (unsigned)w; }
__device__ __forceinline__ float bflo(unsigned w) { return __uint_as_float(w << 16); }
__device__ __forceinline__ float bfhi(unsigned w) { return __uint_as_float(w & 0xffff0000u); }
__device__ __forceinline__ void unpack8(const u32x4 w, float (&f)[8]) { f[0] = bflo(w.x); f[1] = bfhi(w.x); f[2] = bflo(w.y); f[3] = bfhi(w.y); f[4] = bflo(w.z); f[5] = bfhi(w.z); f[6] = bflo(w.w); f[7] = bfhi(w.w); }
__device__ __forceinline__ u32x4 pack8(const float (&f)[8]) { u32x4 w; w.x = pk2(f[0], f[1]); w.y = pk2(f[2], f[3]); w.z = pk2(f[4], f[5]); w.w = pk2(f[6], f[7]); return w; }
__device__ __forceinline__ float wave_sum(float v) {
#pragma unroll
    for (int o = 1; o < 64; o <<= 1) v += __shfl_xor(v, o);
    return v;
}
__device__ __forceinline__ float wave_max(float v) {
#pragma unroll
    for (int o = 1; o < 64; o <<= 1) v = fmaxf(v, __shfl_xor(v, o));
    return v;
}
__device__ __forceinline__ float siluf_(float x) { return x / (1.0f + __expf(-x)); }
typedef short s16x4 __attribute__((ext_vector_type(4)));
__device__ __forceinline__ s16x4 lds_tr4(const LAS unsigned char* p) { return __builtin_bit_cast(s16x4, __builtin_amdgcn_ds_read_tr16_b64_v4i16((LAS s16x4*)p)); }

#define XB_TMO      128
#define XB_XCNT(j)  (256  + 64 * (j))
#define XB_XSUB(j)  (1280 + 64 * (j))
#define XB_XGEN(j)  (2304 + 64 * (j))
#define XB_TOP      3328
#define XB_TOPGEN   3392
#define XCD_BAR_WORDS 3456
#define XB_SPIN_CAP (1u << 18)

__device__ __forceinline__ unsigned xb_ld(unsigned* p)              { return __hip_atomic_load(p, __ATOMIC_RELAXED, __HIP_MEMORY_SCOPE_AGENT); }
__device__ __forceinline__ unsigned xb_add(unsigned* p, unsigned v) { return __hip_atomic_fetch_add(p, v, __ATOMIC_RELAXED, __HIP_MEMORY_SCOPE_AGENT); }
__device__ __forceinline__ unsigned xb_xcc_id() { return (unsigned)__builtin_amdgcn_s_getreg((3 << 11) | 20) & 0xFu; }
#define XB_SPIN(cond, bar) do { unsigned _sp = 0; while (cond) { __builtin_amdgcn_s_sleep(1); \
    if ((++_sp & 255u) == 0u) { if (xb_ld(&(bar)[XB_TMO])) break; if (_sp > XB_SPIN_CAP) { atomicAdd(&(bar)[XB_TMO], 1u); break; } } } } while (0)

struct XcdBarrier {
    unsigned* bar; unsigned x;
    volatile LAS unsigned* st;
};

__device__ __forceinline__ XcdBarrier xcd_barrier_post(unsigned* bar, volatile LAS unsigned* st) {
    XcdBarrier b; b.bar = bar; b.x = xb_xcc_id(); b.st = st;
    if (threadIdx.x == 0) (void)xb_add(&bar[XB_XCNT(b.x)], 1u);
    return b;
}
__device__ __forceinline__ void xcd_barrier_complete(unsigned* bar, unsigned x, unsigned& nloc, unsigned& nx) {
    const unsigned G = gridDim.x * gridDim.y * gridDim.z;
    unsigned sum, cnt, mine, sp = 0u;
    for (;;) {
        sum = 0u; cnt = 0u; mine = 0u;
#pragma unroll
        for (unsigned j = 0; j < 16; ++j) { const unsigned c = xb_ld(&bar[XB_XCNT(j)]); sum += c; cnt += (c > 0u) ? 1u : 0u; mine = (j == x) ? c : mine; }
        if (sum == G) break;
        __builtin_amdgcn_s_sleep(1);
        if ((++sp & 255u) == 0u) { if (xb_ld(&bar[XB_TMO])) break; if (sp > XB_SPIN_CAP) { atomicAdd(&bar[XB_TMO], 1u); break; } }
    }
    nloc = mine > 0u ? mine : 1u; nx = cnt > 0u ? cnt : 1u;
}

__device__ __forceinline__ void xcd_barrier(const XcdBarrier& b) {
    asm volatile("s_waitcnt vmcnt(0)" ::: "memory");
    __syncthreads();
    if (threadIdx.x == 0) {
        unsigned* bar = b.bar;
        __builtin_amdgcn_s_waitcnt(0);
        unsigned nloc = b.st[0], nx = b.st[1];
        if (nloc == 0u) { xcd_barrier_complete(bar, b.x, nloc, nx); b.st[0] = nloc; b.st[1] = nx; }
        const unsigned old = xb_add(&bar[XB_XSUB(b.x)], 1u);
        const unsigned gen = old / nloc;
        if (old + 1u == (gen + 1u) * nloc) {
            __builtin_amdgcn_fence(__ATOMIC_RELEASE, "agent");
            asm volatile("s_waitcnt vmcnt(0)" ::: "memory");
            const unsigned og = xb_add(&bar[XB_TOP], 1u);
            const unsigned tg = og / nx;
            if (og + 1u == (tg + 1u) * nx) xb_add(&bar[XB_TOPGEN], 1u);
            else XB_SPIN(xb_ld(&bar[XB_TOPGEN]) == tg, bar);
            __builtin_amdgcn_fence(__ATOMIC_ACQUIRE, "agent");
            xb_add(&bar[XB_XGEN(b.x)], 1u);
            asm volatile("s_waitcnt vmcnt(0)" ::: "memory");
        } else {
            XB_SPIN(xb_ld(&bar[XB_XGEN(b.x)]) == gen, bar);
            __builtin_amdgcn_fence(__ATOMIC_ACQUIRE, "agent");
            asm volatile("s_waitcnt vmcnt(0)" ::: "memory");
        }
    }
    __syncthreads();
}


template <bool XF32IN, bool HASY, bool XF32OUT, bool HF8 = false>
__device__ __forceinline__ void ph_resid_norm(const GAS bf16* Yb, const GAS float* gpost, const GAS float* gnext, const GAS float* Xf_in, const GAS bf16* Xb_in, GAS float* Xf_out, GAS bf16* Xb_out, GAS bf16* H, GAS unsigned char* H8,
                                              int gw, int ngw, int lane) {
    for (int m = gw; m < M; m += ngw) {
        float xv[4][8];
#pragma unroll
        for (int j = 0; j < 4; ++j) { const size_t e = (size_t)m * D + 8 * (lane + 64 * j);
            if (XF32IN) { const f32x4 a = *(const GAS f32x4*)(Xf_in + e), c = *(const GAS f32x4*)(Xf_in + e + 4); xv[j][0] = a.x; xv[j][1] = a.y; xv[j][2] = a.z; xv[j][3] = a.w; xv[j][4] = c.x; xv[j][5] = c.y; xv[j][6] = c.z; xv[j][7] = c.w; }
            else unpack8(*(const GAS u32x4*)(Xb_in + e), xv[j]); }
        if (HASY) {
            float yv[4][8]; float ss = 0.f;
#pragma unroll
            for (int j = 0; j < 4; ++j) { unpack8(*(const GAS u32x4*)(Yb + (size_t)m * D + 8 * (lane + 64 * j)), yv[j]);
#pragma unroll
                for (int i = 0; i < 8; ++i) ss += yv[j][i] * yv[j][i]; }
            const float rstd = rsqrtf(wave_sum(ss) * (1.0f / D) + EPS);
#pragma unroll
            for (int j = 0; j < 4; ++j) { const GAS float* gp = gpost + 8 * (lane + 64 * j); const f32x4 g0 = *(const GAS f32x4*)gp, g1 = *(const GAS f32x4*)(gp + 4);
                xv[j][0] += yv[j][0] * rstd * g0.x; xv[j][1] += yv[j][1] * rstd * g0.y; xv[j][2] += yv[j][2] * rstd * g0.z; xv[j][3] += yv[j][3] * rstd * g0.w;
                xv[j][4] += yv[j][4] * rstd * g1.x; xv[j][5] += yv[j][5] * rstd * g1.y; xv[j][6] += yv[j][6] * rstd * g1.z; xv[j][7] += yv[j][7] * rstd * g1.w; }
        }
#pragma unroll
        for (int j = 0; j < 4; ++j) { const size_t e = (size_t)m * D + 8 * (lane + 64 * j);
            if (XF32OUT) { *(GAS f32x4*)(Xf_out + e) = (f32x4){xv[j][0], xv[j][1], xv[j][2], xv[j][3]}; *(GAS f32x4*)(Xf_out + e + 4) = (f32x4){xv[j][4], xv[j][5], xv[j][6], xv[j][7]}; }
            else *(GAS u32x4*)(Xb_out + e) = pack8(xv[j]); }
        if (gnext) {
            float ss = 0.f;
#pragma unroll
            for (int j = 0; j < 4; ++j)
#pragma unroll
                for (int i = 0; i < 8; ++i) ss += xv[j][i] * xv[j][i];
            const float rstd = rsqrtf(wave_sum(ss) * (1.0f / D) + EPS);
#pragma unroll
            for (int j = 0; j < 4; ++j) { const GAS float* gp = gnext + 8 * (lane + 64 * j); const f32x4 g0 = *(const GAS f32x4*)gp, g1 = *(const GAS f32x4*)(gp + 4);
                float h[8] = {xv[j][0] * rstd * g0.x, xv[j][1] * rstd * g0.y, xv[j][2] * rstd * g0.z, xv[j][3] * rstd * g0.w, xv[j][4] * rstd * g1.x, xv[j][5] * rstd * g1.y, xv[j][6] * rstd * g1.z, xv[j][7] * rstd * g1.w};
                if (HF8) *(GAS u32x2*)((GAS unsigned char*)H + (size_t)m * D + 8 * (lane + 64 * j)) = pack8_fp8(h);
                else *(GAS u32x4*)(H + (size_t)m * D + 8 * (lane + 64 * j)) = pack8(h);
                if (H8) *(GAS u32x2*)(H8 + (size_t)m * D + 8 * (lane + 64 * j)) = pack8_fp8(h); }
        }
    }
}

__device__ __forceinline__ void tr_item(const GAS float* W, int ldw, int K, int k0, int nsrc, int ncols, GAS bf16* WT, int ndst, LAS unsigned char* tile, int lane) {
    const int c4 = (lane & 15) * 4, kr = lane >> 4;
    f32x4 v[16];
#pragma unroll
    for (int i = 0; i < 16; ++i) v[i] = (c4 < ncols) ? *(const GAS f32x4*)(W + (size_t)(k0 + 4 * i + kr) * ldw + nsrc + c4) : (f32x4){0.f, 0.f, 0.f, 0.f};
#pragma unroll
    for (int i = 0; i < 16; ++i) { u32x2 w; w.x = cvtpk(v[i].x, v[i].y); w.y = cvtpk(v[i].z, v[i].w); *(LAS u32x2*)(tile + (4 * i + kr) * 160 + (lane & 15) * 8) = w; }
    LDS_WAIT();
    const int g = lane >> 4, c16 = lane & 15;
    const LAS unsigned char* tb = tile + (8 * g + (c16 >> 2)) * 160 + (c16 & 3) * 8;
#pragma unroll
    for (int nt = 0; nt < 4; ++nt)
#pragma unroll
        for (int kh = 0; kh < 2; ++kh) {
            const s16x4 lo = lds_tr4(tb + (32 * kh) * 160 + nt * 32), hi = lds_tr4(tb + (32 * kh + 4) * 160 + nt * 32);
            *(GAS bf16x8*)(WT + (size_t)(ndst + 16 * nt + c16) * K + k0 + 32 * kh + 8 * g) = __builtin_shufflevector(lo, hi, 0, 1, 2, 3, 4, 5, 6, 7); }
    LDS_WAIT();
}
__device__ __forceinline__ void tr_item_fp8(const GAS float* W, int ldw, int K, int k0, int nsrc, GAS unsigned char* WT8, int ndst, LAS unsigned char* tile, int lane) {
    const int c4 = (lane & 15) * 4, kr = lane >> 4;
    f32x4 v[16];
#pragma unroll
    for (int i = 0; i < 16; ++i) v[i] = *(const GAS f32x4*)(W + (size_t)(k0 + 4 * i + kr) * ldw + nsrc + c4);
#pragma unroll
    for (int i = 0; i < 16; ++i) { u32x2 w; w.x = cvtpk(v[i].x, v[i].y); w.y = cvtpk(v[i].z, v[i].w); *(LAS u32x2*)(tile + (4 * i + kr) * 160 + (lane & 15) * 8) = w; }
    LDS_WAIT();
    const int g = lane >> 4, c16 = lane & 15;
    const LAS unsigned char* tb = tile + (16 * g + (c16 >> 2)) * 160 + (c16 & 3) * 8;
#pragma unroll
    for (int nt = 0; nt < 4; ++nt) { u32x4 o;
#pragma unroll
        for (int h = 0; h < 2; ++h) { const s16x4 lo = lds_tr4(tb + (8 * h) * 160 + nt * 32), hi = lds_tr4(tb + (8 * h + 4) * 160 + nt * 32);
            float f[8]; unpack8(__builtin_bit_cast(u32x4, __builtin_shufflevector(lo, hi, 0, 1, 2, 3, 4, 5, 6, 7)), f);
#pragma unroll
            for (int j = 0; j < 8; ++j) f[j] *= 64.0f;
            const u32x2 w = pack8_fp8(f); if (h == 0) { o.x = w.x; o.y = w.y; } else { o.z = w.x; o.w = w.y; } }
        *(GAS u32x4*)(WT8 + (size_t)(ndst + 16 * nt + c16) * K + k0 + 16 * g) = o; }
    LDS_WAIT();
}
__device__ __forceinline__ void win_map(int dstrow, int& src, int& ncols) {
    ncols = 64;
    if (dstrow < 10240) src = dstrow;
    else if (dstrow < 12288) src = dstrow - 10240 + 10304;
    else if (dstrow < 12800) src = dstrow - 12288 + 12352;
    else if (dstrow < 13312) src = dstrow - 12800 + 12864;
    else if (dstrow < 17408) src = dstrow - 13312 + 14480;
    else if (dstrow < 18432) src = dstrow - 17408 + 13376;
    else if (dstrow < 18496) src = dstrow - 18432 + 10240;
    else if (dstrow < 18560) src = dstrow - 18496 + 14400;
    else if (dstrow == 18560) { src = 14464; ncols = 16; }
    else { src = 0; ncols = 0; }
}
struct WPtrs { const GAS float *w_in, *w_ssm, *w_att, *w_mix, *w_up, *w_dn; };
__device__ __forceinline__ void ph_weights(const WPtrs wp, GAS unsigned char* ws, LAS unsigned char* tile, int gw, int ngw, int lane) {
    constexpr int I_IN = (NPAD / 64) * (D / 64), I_SSM = (D / 64) * (DI / 64), I_ATT = (D / 64) * (D / 64), I_MIX = I_ATT, I_UP = (FF2 / 64) * (D / 64), I_DN = (D / 64) * (FF / 64);
    constexpr int I_L = I_IN + I_SSM + I_ATT + I_MIX + I_UP + I_DN;
    for (int it = gw; it < DEPTH * I_L; it += ngw) {
        const int layer = it / I_L; int r = it % I_L;
        GAS unsigned char* wl = ws + WS_W + (size_t)layer * WL_SIZE;
        if (r < I_IN) { const int nblk = NPAD / 64, kb = r / nblk, nb = r % nblk; int src, nc; win_map(nb * 64, src, nc);
            if (layer >= F8_IN && nb * 64 < PQI) tr_item_fp8(wp.w_in + (size_t)layer * D * NIN, NIN, D, kb * 64, src, wl + WL_IN, nb * 64, tile, lane);
            else tr_item(wp.w_in + (size_t)layer * D * NIN, NIN, D, kb * 64, src, nc, (GAS bf16*)(wl + WL_IN), nb * 64, tile, lane);
            continue; }
        r -= I_IN;
        if (r < I_SSM) { const int nblk = D / 64, kb = r / nblk, nb = r % nblk; if (layer >= F8_OUT) tr_item_fp8(wp.w_ssm + (size_t)layer * DI * D, D, DI, kb * 64, nb * 64, wl + WL_SSM, nb * 64, tile, lane); else tr_item(wp.w_ssm + (size_t)layer * DI * D, D, DI, kb * 64, nb * 64, 64, (GAS bf16*)(wl + WL_SSM), nb * 64, tile, lane); continue; }
        r -= I_SSM;
        if (r < I_ATT) { const int nblk = D / 64, kb = r / nblk, nb = r % nblk; if (layer >= F8_OUT) tr_item_fp8(wp.w_att + (size_t)layer * D * D, D, D, kb * 64, nb * 64, wl + WL_ATT, nb * 64, tile, lane); else tr_item(wp.w_att + (size_t)layer * D * D, D, D, kb * 64, nb * 64, 64, (GAS bf16*)(wl + WL_ATT), nb * 64, tile, lane); continue; }
        r -= I_ATT;
        if (r < I_MIX) { const int nblk = D / 64, kb = r / nblk, nb = r % nblk; if (layer >= F8_MIX) tr_item_fp8(wp.w_mix + (size_t)layer * D * D, D, D, kb * 64, nb * 64, wl + WL_MIX, nb * 64, tile, lane); else tr_item(wp.w_mix + (size_t)layer * D * D, D, D, kb * 64, nb * 64, 64, (GAS bf16*)(wl + WL_MIX), nb * 64, tile, lane); continue; }
        r -= I_MIX;
        if (r < I_UP) { const int nblk = FF2 / 64, kb = r / nblk, nb = r % nblk;
            if (layer >= F8_UP) tr_item_fp8(wp.w_up + (size_t)layer * D * FF2, FF2, D, kb * 64, nb * 64, wl + WL_UP, nb * 64, tile, lane);
            else tr_item(wp.w_up + (size_t)layer * D * FF2, FF2, D, kb * 64, nb * 64, 64, (GAS bf16*)(wl + WL_UP), nb * 64, tile, lane);
            continue; }
        r -= I_UP;
        { const int nblk = D / 64, kb = r / nblk, nb = r % nblk;
          if (layer >= F8_DN) tr_item_fp8(wp.w_dn + (size_t)layer * FF * D, D, FF, kb * 64, nb * 64, wl + WL_DN, nb * 64, tile, lane);
          else tr_item(wp.w_dn + (size_t)layer * FF * D, D, FF, kb * 64, nb * 64, 64, (GAS bf16*)(wl + WL_DN), nb * 64, tile, lane); }
    }
}

__device__ __forceinline__ void ph_small_proj(const GAS bf16* H, const GAS bf16* Ws, GAS float* SM, GAS bf16* KIB, LAS unsigned char* lds, int blk, int nblk, int tid) {
    constexpr int HS = 4112;
    const int lane = tid & 63, wave = __builtin_amdgcn_readfirstlane(tid >> 6), g = lane >> 4, c16 = lane & 15;
    for (int rb = blk; rb < M / 32; rb += nblk) {
        __syncthreads();
#pragma unroll
        for (int i = 0; i < 16; ++i) { const int id = tid + 512 * i, r = id >> 8, ch = id & 255;
            *(LAS u32x4*)(lds + r * HS + ch * 16) = *(const GAS u32x4*)(H + (size_t)(rb * 32 + r) * D + ch * 8); }
        __syncthreads();
        f32x4 acc[2] = {(f32x4){0.f, 0.f, 0.f, 0.f}, (f32x4){0.f, 0.f, 0.f, 0.f}}, acc9[2] = {(f32x4){0.f, 0.f, 0.f, 0.f}, (f32x4){0.f, 0.f, 0.f, 0.f}};
        const GAS bf16* wrow = Ws + (size_t)(16 * wave + c16) * D + 8 * g;
        const GAS bf16* w9 = Ws + (size_t)(128 + c16) * D + 256 * wave + 8 * g;
        const LAS unsigned char* hb = lds + c16 * HS + g * 16;
#pragma unroll 8
        for (int ks = 0; ks < 64; ++ks) {
            const bf16x8 wf = *(const GAS bf16x8*)(wrow + 32 * ks);
            const bf16x8 h0 = *(const LAS bf16x8*)(hb + ks * 64), h1 = *(const LAS bf16x8*)(hb + 16 * HS + ks * 64);
            acc[0] = __builtin_amdgcn_mfma_f32_16x16x32_bf16(wf, h0, acc[0], 0, 0, 0); acc[1] = __builtin_amdgcn_mfma_f32_16x16x32_bf16(wf, h1, acc[1], 0, 0, 0);
        }
#pragma unroll
        for (int k8 = 0; k8 < 8; ++k8) { const int ks = 8 * wave + k8;
            const bf16x8 wf = *(const GAS bf16x8*)(w9 + 32 * k8);
            const bf16x8 h0 = *(const LAS bf16x8*)(hb + ks * 64), h1 = *(const LAS bf16x8*)(hb + 16 * HS + ks * 64);
            acc9[0] = __builtin_amdgcn_mfma_f32_16x16x32_bf16(wf, h0, acc9[0], 0, 0, 0); acc9[1] = __builtin_amdgcn_mfma_f32_16x16x32_bf16(wf, h1, acc9[1], 0, 0, 0);
        }
#pragma unroll
        for (int rt = 0; rt < 2; ++rt) { const size_t row = (size_t)(rb * 32 + 16 * rt + c16);
            *(GAS f32x4*)(SM + row * SMW + 16 * wave + 4 * g) = acc[rt];
            if (wave >= 4) { u32x2 w; w.x = cvtpk(acc[rt].x, acc[rt].y); w.y = cvtpk(acc[rt].z, acc[rt].w); *(GAS u32x2*)(KIB + row * IDD + 16 * (wave - 4) + 4 * g) = w; } }
        __syncthreads();
        *(LAS f32x4*)(lds + ((wave * 2 + 0) * 64 + lane) * 16) = acc9[0]; *(LAS f32x4*)(lds + ((wave * 2 + 1) * 64 + lane) * 16) = acc9[1];
        __syncthreads();
        if (wave < 2) { f32x4 s = (f32x4){0.f, 0.f, 0.f, 0.f};
#pragma unroll
            for (int w8 = 0; w8 < 8; ++w8) s += *(const LAS f32x4*)(lds + ((w8 * 2 + wave) * 64 + lane) * 16);
            *(GAS f32x4*)(SM + (size_t)(rb * 32 + 16 * wave + c16) * SMW + 128 + 4 * g) = s; }
    }
}

__device__ __forceinline__ void ph_index_scores(const GAS bf16* P, const GAS float* SM, const GAS bf16* KIB, GAS float* SC, LAS unsigned char* lds, int blk, int nblk, int tid) {
    constexpr int QS = 1040;
    const int lane = tid & 63, wave = __builtin_amdgcn_readfirstlane(tid >> 6);
    for (int u0 = blk; u0 < 256; u0 += nblk) {
#pragma unroll 1
        for (int half = 0; half < 2; ++half) {
            const int b = half, qt = half ? 255 - u0 : u0;
            const int q0 = b * SEQ + qt * 16, nkt = ((qt * 16) / 64 + 1) * 4;
            const int qrow = q0 + (lane & 15), kq = 8 * (lane >> 4);
            __syncthreads();
#pragma unroll
            for (int i = 0; i < 2; ++i) { const int id = tid + 512 * i, q = id >> 6, ch = id & 63;
                *(LAS u32x4*)(lds + q * QS + ch * 16) = *(const GAS u32x4*)(P + (size_t)(q0 + q) * NMAIN + PQI + 8 * IDD + ch * 8); }
            bf16x8 bq[8][2]; float w[IH];
#pragma unroll
            for (int h = 0; h < IH; ++h) {
                if (h < 8) {
#pragma unroll
                    for (int ks = 0; ks < 2; ++ks) bq[h][ks] = *(const GAS bf16x8*)(P + (size_t)qrow * NMAIN + PQI + h * IDD + ks * 32 + kq); }
                w[h] = SM[(size_t)qrow * SMW + SM_WI + h]; }
            __syncthreads();
            const LAS unsigned char* qb = lds + (lane & 15) * QS + kq * 2;
            for (int kt = wave; kt < nkt; kt += NWAVES) {
                const int key0 = kt * 16; const GAS bf16* kp = KIB + (size_t)(b * SEQ + key0 + (lane & 15)) * IDD + kq;
                const bf16x8 a0 = *(const GAS bf16x8*)kp, a1 = *(const GAS bf16x8*)(kp + 32);
                f32x4 sc = (f32x4){0.f, 0.f, 0.f, 0.f};
#pragma unroll
                for (int h = 0; h < IH; ++h) { f32x4 c = (f32x4){0.f, 0.f, 0.f, 0.f};
                    const bf16x8 b0 = h < 8 ? bq[h & 7][0] : *(const LAS bf16x8*)(qb + (h - 8) * 128), b1 = h < 8 ? bq[h & 7][1] : *(const LAS bf16x8*)(qb + (h - 8) * 128 + 64);
                    c = __builtin_amdgcn_mfma_f32_16x16x32_bf16(a0, b0, c, 0, 0, 0); c = __builtin_amdgcn_mfma_f32_16x16x32_bf16(a1, b1, c, 0, 0, 0);
                    sc.x += w[h] * fmaxf(c.x, 0.f); sc.y += w[h] * fmaxf(c.y, 0.f); sc.z += w[h] * fmaxf(c.z, 0.f); sc.w += w[h] * fmaxf(c.w, 0.f); }
                *(GAS f32x4*)(SC + (size_t)qrow * SEQ + key0 + 4 * (lane >> 4)) = sc;
            }
        }
    }
}

__device__ __forceinline__ void topk_bitwise(const GAS float* srow, GAS unsigned long long* mw, int limit, int lane) {
    unsigned u[64];
#pragma unroll
    for (int j = 0; j < 64; ++j) { const int key = j * 64 + lane; unsigned v = 0u;
        if (key < limit) { const unsigned bits = __float_as_uint(srow[key]); v = (bits & 0x80000000u) ? ~bits : (bits | 0x80000000u); }
        u[j] = v; }
    unsigned T = 0u;
#pragma unroll 1
    for (int bit = 31; bit >= 0; --bit) { const unsigned cand = T | (1u << bit); int cnt = 0;
#pragma unroll
        for (int j = 0; j < 64; ++j) cnt += __popcll(__ballot(u[j] >= cand));
        if (cnt >= TOPK) T = cand; }
    int cgt = 0;
#pragma unroll
    for (int j = 0; j < 64; ++j) cgt += __popcll(__ballot(u[j] > T));
    const int need_eq = TOPK - cgt; int eqbase = 0;
    const unsigned long long lt_mask = (1ull << lane) - 1ull;
#pragma unroll
    for (int j = 0; j < 64; ++j) {
        const bool gt = u[j] > T, eq = u[j] == T;
        const unsigned long long eqm = __ballot(eq);
        const bool take = gt || (eq && (eqbase + __popcll(eqm & lt_mask) < need_eq));
        const unsigned long long tm = __ballot(take);
        if (lane == 0 && j * 64 < limit) mw[j] = tm;
        eqbase += __popcll(eqm);
    }
}
__device__ __forceinline__ void ph_topk(const GAS float* SC, GAS unsigned long long* MASKW, LAS unsigned char* wl, int gw, int ngw, int lane) {
    constexpr int CAP = 1024;
    LAS unsigned* hist = (LAS unsigned*)wl;
    LAS unsigned* maskc = (LAS unsigned*)(wl + 1024);
    LAS float* cval = (LAS float*)(wl + 1536);
    LAS unsigned* ckey = (LAS unsigned*)(wl + 1536 + 4 * CAP);
    const unsigned long long lt_mask = (1ull << lane) - 1ull;
    for (int q = gw; q < M; q += ngw) {
        int m = q;
        if (ngw * 4 == M) { const int j = q / ngw; m = (j & 1) * SEQ + ((j & 2) ? SEQ - 1 - gw : gw); }
        const int t = m & (SEQ - 1), limit = (t / 64 + 1) * 64, nw = limit / 64;
        GAS unsigned long long* mw = MASKW + (size_t)m * 64;
        if (limit <= TOPK) { unsigned ones = 0xffffffffu; asm volatile("" : "+v"(ones)); if (lane < nw) mw[lane] = ((unsigned long long)ones << 32) | ones; continue; }
        const GAS float* srow = SC + (size_t)m * SEQ;
        float s[64]; float smax = -__builtin_inff(), smin = __builtin_inff();
#pragma unroll
        for (int j = 0; j < 64; ++j) { s[j] = (j < nw) ? srow[j * 64 + lane] : 0.f; if (j < nw) { smax = fmaxf(smax, s[j]); smin = fminf(smin, s[j]); } }
        smax = wave_max(smax); smin = -wave_max(-smin);
        const float scale = smax > smin ? 255.0f / (smax - smin) : 0.f;
        asm volatile("" ::: "memory");
        hist[lane] = 0u; hist[lane + 64] = 0u; hist[lane + 128] = 0u; hist[lane + 192] = 0u; maskc[lane] = 0u; maskc[lane + 64] = 0u;
        LDS_WAIT();
#pragma unroll
        for (int j = 0; j < 64; ++j) if (j < nw) { const int b = min(255, (int)((s[j] - smin) * scale)); __hip_atomic_fetch_add(&hist[b], 1u, __ATOMIC_RELAXED, __HIP_MEMORY_SCOPE_WORKGROUP); }
        LDS_WAIT();
        const unsigned c0 = hist[4 * lane], c1 = hist[4 * lane + 1], c2 = hist[4 * lane + 2], c3 = hist[4 * lane + 3];
        unsigned suf = c0 + c1 + c2 + c3;
#pragma unroll
        for (int o = 1; o < 64; o <<= 1) { const unsigned v = __shfl_down(suf, o); if (lane + o < 64) suf += v; }
        const unsigned above = suf - (c0 + c1 + c2 + c3);
        int bstar = -1; unsigned cab = 0u;
        { unsigned cum = above;
          if (cum < TOPK && cum + c3 >= TOPK) { bstar = 4 * lane + 3; cab = cum; } cum += c3;
          if (bstar < 0 && cum < TOPK && cum + c2 >= TOPK) { bstar = 4 * lane + 2; cab = cum; } cum += c2;
          if (bstar < 0 && cum < TOPK && cum + c1 >= TOPK) { bstar = 4 * lane + 1; cab = cum; } cum += c1;
          if (bstar < 0 && cum < TOPK && cum + c0 >= TOPK) { bstar = 4 * lane + 0; cab = cum; } }
        const unsigned long long who = __ballot(bstar >= 0);
        const int src = __builtin_ctzll(who);
        bstar = __shfl(bstar, src); cab = __shfl(cab, src);
        const int need = TOPK - (int)cab;
        const unsigned ncand = hist[bstar];
        if (ncand > (unsigned)CAP) { topk_bitwise(srow, mw, limit, lane); continue; }
        unsigned long long myword = 0ull; int base = 0;
#pragma unroll
        for (int j = 0; j < 64; ++j) if (j < nw) {
            const int b = min(255, (int)((s[j] - smin) * scale));
            const unsigned long long gm = __ballot(b > bstar), em = __ballot(b == bstar);
            if (lane == j) myword = gm;
            if (b == bstar) { const int pos = base + __popcll(em & lt_mask); cval[pos] = s[j]; ckey[pos] = (unsigned)(j * 64 + lane); }
            base += __popcll(em);
        }
        LDS_WAIT();
        for (int i = lane; i < base; i += 64) { const float vi = cval[i]; const unsigned ki = ckey[i]; int rank = 0;
            if (need < base) { for (int q = 0; q < base; ++q) { const float vq = cval[q]; const unsigned kq = ckey[q]; rank += (vq > vi || (vq == vi && kq < ki)) ? 1 : 0; } }
            if (rank < need) __hip_atomic_fetch_or(&maskc[ki >> 5], 1u << (ki & 31), __ATOMIC_RELAXED, __HIP_MEMORY_SCOPE_WORKGROUP); }
        LDS_WAIT();
        if (lane < nw) { const unsigned long long cw_ = ((unsigned long long)maskc[2 * lane + 1] << 32) | maskc[2 * lane]; mw[lane] = myword | cw_; }
        LDS_WAIT(); asm volatile("" ::: "memory");
    }
}

__device__ __forceinline__ float xmax16(float x) { auto r = __builtin_amdgcn_permlane16_swap(__float_as_uint(x), __float_as_uint(x), false, false); return fmaxf(__uint_as_float(r[0]), __uint_as_float(r[1])); }
__device__ __forceinline__ float xmax32(float x) { auto r = __builtin_amdgcn_permlane32_swap(__float_as_uint(x), __float_as_uint(x), false, false); return fmaxf(__uint_as_float(r[0]), __uint_as_float(r[1])); }
__device__ __forceinline__ float xsum16(float x) { auto r = __builtin_amdgcn_permlane16_swap(__float_as_uint(x), __float_as_uint(x), false, false); return __uint_as_float(r[0]) + __uint_as_float(r[1]); }
__device__ __forceinline__ float xsum32(float x) { auto r = __builtin_amdgcn_permlane32_swap(__float_as_uint(x), __float_as_uint(x), false, false); return __uint_as_float(r[0]) + __uint_as_float(r[1]); }
template <int VAR> __device__ __forceinline__ void ph_attn_dense(const GAS bf16* P, const GAS unsigned long long* MASKW, GAS bf16* AO, LAS unsigned char* lds, int blk, int nblk, int tid) {
    constexpr int KBUF = 64 * 256, VBUF = 64 * 256, VOFF = 2 * KBUF, MOFF = VOFF + 2 * VBUF;
    const int lane = tid & 63, wave = __builtin_amdgcn_readfirstlane(tid >> 6), g = lane >> 4, c16 = lane & 15;
    const int hq = wave >> 1, qh = (wave & 1) * 32;
    const float SCL = ATTN_SCALE * 1.4426950408889634f;
    for (int u0 = blk; u0 < 256; u0 += nblk) {
#pragma unroll 1
        for (int half = 0; half < 2; ++half) {
            const int b = (u0 >> 2) & 1, kvh = u0 & 3, cc = u0 >> 3, c = half ? 63 - cc : cc, nt = c + 1;
            const int m0 = b * SEQ + c * 64;
            bf16x8 qf[2][4];
#pragma unroll
            for (int qt = 0; qt < 2; ++qt)
#pragma unroll
                for (int kd = 0; kd < 4; ++kd) qf[qt][kd] = *(const GAS bf16x8*)(P + (size_t)(m0 + qh + 16 * qt + c16) * NMAIN + PQ + (kvh * 4 + hq) * AD + 32 * kd + 8 * g);
            f32x4 O[2][8];
#pragma unroll
            for (int qt = 0; qt < 2; ++qt)
#pragma unroll
                for (int dt = 0; dt < 8; ++dt) O[qt][dt] = (f32x4){0.f, 0.f, 0.f, 0.f};
            float mrun[2] = {-1e30f, -1e30f}, lrun[2] = {0.f, 0.f};
            const GAS bf16* kvbase = P + (size_t)(b * SEQ) * NMAIN + kvh * AD;
            const int srow = 8 * wave + (lane >> 4);
#define ATT_DMA(t, buf) do { _Pragma("unroll") for (int i = 0; i < 2; ++i) { const int r = srow + 4 * i; const GAS bf16* src = kvbase + (size_t)((t) * 64 + r) * NMAIN; \
                __builtin_amdgcn_global_load_lds((const GAS unsigned*)(src + PK + (((lane & 15) ^ (r & 15)) << 3)), (LAS unsigned*)(lds + (buf) * KBUF + (2 * wave + i) * 1024), 16, 0, 0); \
                __builtin_amdgcn_global_load_lds((const GAS unsigned*)(src + PV + (((lane & 15) ^ ((r & 7) << 1)) << 3)), (LAS unsigned*)(lds + VOFF + (buf) * VBUF + (2 * wave + i) * 1024), 16, 0, 0); } } while (0)
            __syncthreads();
            ATT_DMA(0, 0);
#pragma unroll
            for (int i = 0; i < 4; ++i) { const int id = tid + 512 * i; *(LAS u32x4*)(lds + MOFF + id * 16) = *(const GAS u32x4*)((const GAS unsigned char*)(MASKW + (size_t)m0 * 64) + id * 16); }
            const LAS unsigned long long* mrow0 = (const LAS unsigned long long*)(lds + MOFF) + (qh + c16) * 64; const LAS unsigned long long* mrow1 = mrow0 + 16 * 64;
            asm volatile("s_waitcnt vmcnt(0)" ::: "memory");
            __syncthreads();
            const int vsw = (4 * (g & 1) + (c16 >> 2)) << 1;
            for (int t = 0; t < nt; ++t) {
                const int buf = t & 1;
                if (t + 1 < nt) ATT_DMA(t + 1, buf ^ 1);
                const LAS unsigned char* kb = lds + buf * KBUF + c16 * 256;
                const LAS unsigned char* vb = lds + VOFF + buf * VBUF + (4 * g + (c16 >> 2)) * 256 + (c16 & 1) * 8;
                f32x4 S[2][4];
                bf16x8 kf[2][4];
#pragma unroll
                for (int kd = 0; kd < 4; ++kd) kf[0][kd] = *(const LAS bf16x8*)(kb + (((4 * kd + g) ^ c16) << 4));
#pragma unroll
                for (int kt = 0; kt < 4; ++kt) {
                    if (kt < 3) {
#pragma unroll
                        for (int kd = 0; kd < 4; ++kd) kf[(kt + 1) & 1][kd] = *(const LAS bf16x8*)(kb + (kt + 1) * 4096 + (((4 * kd + g) ^ c16) << 4)); }
#pragma unroll
                    for (int qt = 0; qt < 2; ++qt) { f32x4 s = (f32x4){0.f, 0.f, 0.f, 0.f};
#pragma unroll
                        for (int kd = 0; kd < 4; ++kd) s = __builtin_amdgcn_mfma_f32_16x16x32_bf16(kf[kt & 1][kd], qf[qt][kd], s, 0, 0, 0);
                        S[qt][kt] = s; }
                }
#define ATT_VRD(dt, ks, hi16) lds_tr4(vb + (32 * (ks) + (hi16)) * 256 + (((2 * (dt) + ((c16 >> 1) & 1)) ^ vsw) << 4))
                s16x4 vlo[8][2], vhi[8][2];
#pragma unroll
                for (int dt = 0; dt < 4; ++dt)
#pragma unroll
                    for (int ks = 0; ks < 2; ++ks) { vlo[dt][ks] = ATT_VRD(dt, ks, 0); vhi[dt][ks] = ATT_VRD(dt, ks, 16); }
                bf16x8 pf[2][2];
#pragma unroll
                for (int qt = 0; qt < 2; ++qt) {
                    const unsigned long long mw = (qt ? mrow1[t] : mrow0[t]) >> (4 * g);
                    const int mlo = (int)(unsigned)mw, mhi = (int)(unsigned)(mw >> 32);
                    float mx = fmaxf(fmaxf(S[qt][0][0], S[qt][0][1]), fmaxf(S[qt][0][2], S[qt][0][3]));
#pragma unroll
                    for (int kt = 1; kt < 4; ++kt) mx = fmaxf(fmaxf(mx, S[qt][kt][0]), fmaxf(fmaxf(S[qt][kt][1], S[qt][kt][2]), S[qt][kt][3]));
                    mx = xmax16(mx); mx = xmax32(mx);
                    const float mnew = fmaxf(mrun[qt], mx * SCL);
                    const float alpha = __builtin_amdgcn_exp2f(mrun[qt] - mnew);
                    float ps = 0.f;
#pragma unroll
                    for (int kt = 0; kt < 4; ++kt)
#pragma unroll
                        for (int j = 0; j < 4; ++j) { const int sel = __builtin_amdgcn_sbfe(kt < 2 ? mlo : mhi, (kt & 1) * 16 + j, 1);
                            const float p = __uint_as_float(__float_as_uint(__builtin_amdgcn_exp2f(__builtin_fmaf(S[qt][kt][j], SCL, -mnew))) & (unsigned)sel); S[qt][kt][j] = p; ps += p; }
                    ps = xsum16(ps); ps = xsum32(ps);
                    lrun[qt] = lrun[qt] * alpha + ps; mrun[qt] = mnew;
                    if (!__all(alpha == 1.0f)) {
#pragma unroll
                        for (int dt = 0; dt < 8; ++dt) O[qt][dt] *= alpha; }
#pragma unroll
                    for (int ks = 0; ks < 2; ++ks) { u32x4 w; w.x = cvtpk(S[qt][2 * ks][0], S[qt][2 * ks][1]); w.y = cvtpk(S[qt][2 * ks][2], S[qt][2 * ks][3]);
                        w.z = cvtpk(S[qt][2 * ks + 1][0], S[qt][2 * ks + 1][1]); w.w = cvtpk(S[qt][2 * ks + 1][2], S[qt][2 * ks + 1][3]); pf[qt][ks] = __builtin_bit_cast(bf16x8, w); }
                }
#pragma unroll
                for (int dt = 4; dt < 8; ++dt)
#pragma unroll
                    for (int ks = 0; ks < 2; ++ks) { vlo[dt][ks] = ATT_VRD(dt, ks, 0); vhi[dt][ks] = ATT_VRD(dt, ks, 16); }
#pragma unroll
                for (int dt = 0; dt < 8; ++dt)
#pragma unroll
                    for (int ks = 0; ks < 2; ++ks) {
                        const bf16x8 vf = __builtin_shufflevector(vlo[dt][ks], vhi[dt][ks], 0, 1, 2, 3, 4, 5, 6, 7);
                        O[0][dt] = __builtin_amdgcn_mfma_f32_16x16x32_bf16(vf, pf[0][ks], O[0][dt], 0, 0, 0);
                        O[1][dt] = __builtin_amdgcn_mfma_f32_16x16x32_bf16(vf, pf[1][ks], O[1][dt], 0, 0, 0);
                    }
                asm volatile("s_waitcnt vmcnt(0)" ::: "memory");
                __syncthreads();
            }
#undef ATT_DMA
#undef ATT_VRD
#pragma unroll
            for (int qt = 0; qt < 2; ++qt) { const float r = 1.0f / lrun[qt];
                const size_t oi = (size_t)(m0 + qh + 16 * qt + c16) * D + (kvh * 4 + hq) * AD + 4 * g;
#pragma unroll
                for (int dt = 0; dt < 8; ++dt) { const f32x4 o = O[qt][dt] * r;
                    if (VAR & 16) *(GAS unsigned*)((GAS unsigned char*)AO + oi + 16 * dt) = pack4_fp8(o.x, o.y, o.z, o.w);
                    else { u32x2 w; w.x = pk2(o.x, o.y); w.y = pk2(o.z, o.w); *(GAS u32x2*)(AO + oi + 16 * dt) = w; } } }
        }
    }
}

__device__ __forceinline__ void stage_conv(const GAS bf16* P, const GAS float* cw, const GAS float* cb, int m0, int tpos0, int ch0, int nch, LAS unsigned char* dst, int stride, int tid) {
    const int cpr = nch >> 3;
    for (int id = tid; id < 64 * cpr; id += NTHR) {
        const int s = id / cpr, k = id - s * cpr, ch = ch0 + 8 * k;
        float acc[8];
        { const f32x4 b0 = *(const GAS f32x4*)(cb + ch), b1 = *(const GAS f32x4*)(cb + ch + 4); acc[0] = b0.x; acc[1] = b0.y; acc[2] = b0.z; acc[3] = b0.w; acc[4] = b1.x; acc[5] = b1.y; acc[6] = b1.z; acc[7] = b1.w; }
#pragma unroll
        for (int i = 0; i < 4; ++i) { if (tpos0 + s - 3 + i >= 0) {
            float x[8]; unpack8(*(const GAS u32x4*)(P + (size_t)(m0 + s - 3 + i) * NMAIN + PXBC + ch), x);
            const f32x4 w0 = *(const GAS f32x4*)(cw + i * CONVD + ch), w1 = *(const GAS f32x4*)(cw + i * CONVD + ch + 4);
            acc[0] += w0.x * x[0]; acc[1] += w0.y * x[1]; acc[2] += w0.z * x[2]; acc[3] += w0.w * x[3]; acc[4] += w1.x * x[4]; acc[5] += w1.y * x[5]; acc[6] += w1.z * x[6]; acc[7] += w1.w * x[7]; } }
#pragma unroll
        for (int j = 0; j < 8; ++j) acc[j] = siluf_(acc[j]);
        *(LAS u32x4*)(dst + s * stride + k * 16) = pack8(acc);
    }
}
__device__ __forceinline__ void wave_dt_acs(const GAS float* SM, const GAS float* dt_bias, const GAS float* a_log, int m0, int head, LAS float* dtw, LAS float* acsw, int lane) {
    const float raw = SM[(size_t)(m0 + lane) * SMW + SM_DT + head] + dt_bias[head];
    const float dt = fmaxf(raw, 0.f) + log1pf(__expf(-fabsf(raw)));
    float x = dt * (-__expf(a_log[head]));
#pragma unroll
    for (int o = 1; o < 64; o <<= 1) { const float v = __shfl_up(x, o); if (lane >= o) x += v; }
    dtw[lane] = dt; acsw[lane] = x;
}
__device__ __forceinline__ bf16x8 tr8(const LAS unsigned char* p, int off_lo, int off_hi) {
    const s16x4 lo = lds_tr4(p + off_lo), hi = lds_tr4(p + off_hi); return __builtin_shufflevector(lo, hi, 0, 1, 2, 3, 4, 5, 6, 7);
}
template <int NOUT> __device__ __forceinline__ void conv_strip(const GAS bf16* src, int tpos_first_raw, const GAS float* cw, const GAS float* cb, u32x4 (&out)[NOUT]) {
    u32x4 raw[NOUT + 3];
#pragma unroll
    for (int i = 0; i < NOUT + 3; ++i) { const int tp = tpos_first_raw + i; raw[i] = *(const GAS u32x4*)(src + (size_t)(tp < 0 ? 3 : i) * NMAIN); if (tp < 0) raw[i] = (u32x4){0u, 0u, 0u, 0u}; }
    f32x4 w[4][2];
#pragma unroll
    for (int t = 0; t < 4; ++t) { w[t][0] = *(const GAS f32x4*)(cw + t * CONVD); w[t][1] = *(const GAS f32x4*)(cw + t * CONVD + 4); }
    const f32x4 b0 = *(const GAS f32x4*)cb, b1 = *(const GAS f32x4*)(cb + 4);
#pragma unroll
    for (int o = 0; o < NOUT; ++o) { f32x4 a0 = b0, a1 = b1;
#pragma unroll
        for (int t = 0; t < 4; ++t) { float x[8]; unpack8(raw[o + t], x); a0 += w[t][0] * (f32x4){x[0], x[1], x[2], x[3]}; a1 += w[t][1] * (f32x4){x[4], x[5], x[6], x[7]}; }
        float f[8] = {a0.x, a0.y, a0.z, a0.w, a1.x, a1.y, a1.z, a1.w};
#pragma unroll
        for (int j = 0; j < 8; ++j) f[j] = f[j] * __builtin_amdgcn_rcpf(1.0f + __expf(-f[j]));
        out[o] = pack8(f); }
}
__device__ __forceinline__ void ph_ssd_states(const GAS bf16* P, const GAS float* SM, const GAS float* cw, const GAS float* cb, const GAS float* dt_bias, const GAS float* a_log, GAS bf16* XC, GAS bf16* ST, GAS float* CD,
                                              LAS unsigned char* lds, int blk, int nblk, int tid) {
    constexpr int RSW = 160, XW = 64 * RSW, RSB = 288, BMB = 64 * RSB, O_BM = 8 * XW, O_DT = O_BM + 2 * BMB, O_ACS = O_DT + 2048;
    const int lane = tid & 63, wave = __builtin_amdgcn_readfirstlane(tid >> 6), gq = lane >> 4, c16 = lane & 15;
    LAS unsigned char* xw = lds + wave * XW;
    LAS float* dtw = (LAS float*)(lds + O_DT) + wave * 64; LAS float* acsw = (LAS float*)(lds + O_ACS) + wave * 64;
    int par = 0;
    for (int item = blk; item < BATCH * 64 * NG; item += nblk, par ^= 1) {
        const int bc = item >> 3, g = item & 7, m0 = bc * 64, tpos0 = (bc & 63) * 64, head = g * HPG + wave;
        LAS unsigned char* bm = lds + O_BM + par * BMB;
        asm volatile("" ::: "memory");
        { const int k16 = lane & 15, r0 = 8 * wave + 2 * gq, chB = DI + g * NS + 8 * k16;
          const GAS bf16* base = P + (size_t)(m0 + r0 - 3) * NMAIN + PXBC + chB;
          u32x4 ob[2], oc[2];
          conv_strip<2>(base, tpos0 + r0 - 3, cw + chB, cb + chB, ob);
          conv_strip<2>(base + NG * NS, tpos0 + r0 - 3, cw + chB + NG * NS, cb + chB + NG * NS, oc);
#pragma unroll
          for (int o = 0; o < 2; ++o) { *(LAS u32x4*)(bm + (r0 + o) * RSB + k16 * 16) = ob[o];
              *(GAS u32x4*)(XC + (size_t)(m0 + r0 + o) * CONVD + chB) = ob[o]; *(GAS u32x4*)(XC + (size_t)(m0 + r0 + o) * CONVD + chB + NG * NS) = oc[o]; } }
        { const int k8 = lane & 7, r0 = 8 * (lane >> 3), ch = head * HP + 8 * k8;
          u32x4 ox[8];
          conv_strip<8>(P + (size_t)(m0 + r0 - 3) * NMAIN + PXBC + ch, tpos0 + r0 - 3, cw + ch, cb + ch, ox);
#pragma unroll
          for (int o = 0; o < 8; ++o) { *(LAS u32x4*)(xw + (r0 + o) * RSW + k8 * 16) = ox[o]; *(GAS u32x4*)(XC + (size_t)(m0 + r0 + o) * CONVD + ch) = ox[o]; } }
        wave_dt_acs(SM, dt_bias, a_log, m0, head, dtw, acsw, lane);
        LDS_WAIT();
        __syncthreads();
        const float aend = acsw[63];
        if (lane == 0) CD[bc * NH + head] = __expf(aend);
        const LAS unsigned char* xb = xw + (4 * gq + (c16 >> 2)) * RSW + (c16 & 3) * 8;
        const LAS unsigned char* bb = bm + (4 * gq + (c16 >> 2)) * RSB + (c16 & 3) * 8;
        bf16x8 xf[4][2];
#pragma unroll
        for (int ks = 0; ks < 2; ++ks) { float w[8];
#pragma unroll
            for (int j = 0; j < 8; ++j) { const int s = 32 * ks + 16 * (j >> 2) + 4 * gq + (j & 3); w[j] = dtw[s] * __expf(aend - acsw[s]); }
#pragma unroll
            for (int pt = 0; pt < 4; ++pt) { const bf16x8 r = tr8(xb + pt * 32, (32 * ks) * RSW, (32 * ks + 16) * RSW); float f[8]; unpack8(__builtin_bit_cast(u32x4, r), f);
#pragma unroll
                for (int j = 0; j < 8; ++j) f[j] *= w[j];
                xf[pt][ks] = __builtin_bit_cast(bf16x8, pack8(f)); } }
        GAS bf16* dst = ST + (((size_t)bc * NH + head) * HP + c16) * NS + 4 * gq;
#pragma unroll 2
        for (int nt = 0; nt < 8; ++nt) {
            const bf16x8 a0 = tr8(bb + nt * 32, 0, 16 * RSB), a1 = tr8(bb + nt * 32, 32 * RSB, 48 * RSB);
#pragma unroll
            for (int pt = 0; pt < 4; ++pt) { f32x4 acc = (f32x4){0.f, 0.f, 0.f, 0.f};
                acc = __builtin_amdgcn_mfma_f32_16x16x32_bf16(a0, xf[pt][0], acc, 0, 0, 0); acc = __builtin_amdgcn_mfma_f32_16x16x32_bf16(a1, xf[pt][1], acc, 0, 0, 0);
                u32x2 o; o.x = pk2(acc.x, acc.y); o.y = pk2(acc.z, acc.w); *(GAS u32x2*)(dst + (size_t)(16 * pt) * NS + 16 * nt) = o; }
        }
        LDS_WAIT(); asm volatile("" ::: "memory");
    }
}
__device__ __forceinline__ void ph_ssd_scan(GAS bf16* ST, const GAS float* CD, int gtid, int nthr) {
    for (int it = gtid; it < BATCH * NH * HP * (NS / 8); it += nthr) {
        const int n8 = it & 15, p = (it >> 4) & 63, head = (it >> 10) & 63, b = it >> 16;
        float h[8];
#pragma unroll
        for (int j = 0; j < 8; ++j) h[j] = 0.f;
#pragma unroll 8
        for (int c = 0; c < 64; ++c) { GAS u32x4* q = (GAS u32x4*)(ST + ((((size_t)(b * 64 + c)) * NH + head) * HP + p) * NS) + n8;
            float v[8]; unpack8(*q, v); *q = pack8(h); const float dec = CD[(b * 64 + c) * NH + head];
#pragma unroll
            for (int j = 0; j < 8; ++j) h[j] = h[j] * dec + v[j]; }
    }
}
template <bool YF8> __device__ __forceinline__ void ph_ssd_out(const GAS bf16* P, const GAS float* SM, const GAS bf16* XC, const GAS float* dt_bias, const GAS float* a_log, const GAS bf16* ST,
                                           const GAS float* dskip, const GAS float* gnorm, GAS bf16* Y, LAS unsigned char* lds, int blk, int nblk, int tid) {
    constexpr int RSW = 160, XW = 64 * RSW, O_DT = 8 * XW, O_ACS = O_DT + 2048, O_SSQ = O_ACS + 2048;
    const int lane = tid & 63, wave = __builtin_amdgcn_readfirstlane(tid >> 6), gq = lane >> 4, c16 = lane & 15;
    LAS unsigned char* xw = lds + wave * XW;
    LAS float* dtw = (LAS float*)(lds + O_DT) + wave * 64; LAS float* acsw = (LAS float*)(lds + O_ACS) + wave * 64;
    int par = 0;
    for (int item = blk; item < BATCH * 64 * NG; item += nblk, par ^= 1) {
        const int bc = item >> 3, g = item & 7, m0 = bc * 64, head = g * HPG + wave;
        asm volatile("" ::: "memory");
        { u32x4 xr[8];
#pragma unroll
          for (int i = 0; i < 8; ++i) xr[i] = *(const GAS u32x4*)(XC + (size_t)(m0 + (lane >> 3) + 8 * i) * CONVD + head * HP + (lane & 7) * 8);
#pragma unroll
          for (int i = 0; i < 8; ++i) *(LAS u32x4*)(xw + ((lane >> 3) + 8 * i) * RSW + (lane & 7) * 16) = xr[i]; }
        wave_dt_acs(SM, dt_bias, a_log, m0, head, dtw, acsw, lane);
        const GAS bf16* cbase = XC + (size_t)(m0 + c16) * CONVD + DI + NG * NS + g * NS + 8 * gq;
        const GAS bf16* bbase = cbase - NG * NS;
        bf16x8 cf[4][4];
#pragma unroll
        for (int lt = 0; lt < 4; ++lt)
#pragma unroll
            for (int kn = 0; kn < 4; ++kn) cf[lt][kn] = *(const GAS bf16x8*)(cbase + (size_t)(16 * lt) * CONVD + 32 * kn);
        LDS_WAIT(); asm volatile("" ::: "memory");
        float al[4];
#pragma unroll
        for (int lt = 0; lt < 4; ++lt) al[lt] = acsw[16 * lt + c16];
        bf16x8 lf[2][4];
#pragma unroll
        for (int ks = 0; ks < 2; ++ks) {
            f32x4 lt4[2][4];
#pragma unroll
            for (int h2 = 0; h2 < 2; ++h2) { const int st = 2 * ks + h2;
                bf16x8 bfr[4];
#pragma unroll
                for (int kn = 0; kn < 4; ++kn) bfr[kn] = *(const GAS bf16x8*)(bbase + (size_t)(16 * st) * CONVD + 32 * kn);
                float as_[4], ds_[4];
#pragma unroll
                for (int j = 0; j < 4; ++j) { as_[j] = acsw[16 * st + 4 * gq + j]; ds_[j] = dtw[16 * st + 4 * gq + j]; }
#pragma unroll
                for (int lt = 0; lt < 4; ++lt) { f32x4 t4 = (f32x4){0.f, 0.f, 0.f, 0.f};
                    if (lt >= st) {
#pragma unroll
                        for (int kn = 0; kn < 4; ++kn) t4 = __builtin_amdgcn_mfma_f32_16x16x32_bf16(bfr[kn], cf[lt][kn], t4, 0, 0, 0);
#pragma unroll
                        for (int j = 0; j < 4; ++j) { const float e = __expf(fminf(al[lt] - as_[j], 0.f)) * ds_[j]; const bool ok = (lt > st) || (4 * gq + j <= c16); t4[j] = ok ? t4[j] * e : 0.f; } }
                    lt4[h2][lt] = t4; } }
#pragma unroll
            for (int lt = 0; lt < 4; ++lt) { u32x4 w; w.x = pk2(lt4[0][lt][0], lt4[0][lt][1]); w.y = pk2(lt4[0][lt][2], lt4[0][lt][3]); w.z = pk2(lt4[1][lt][0], lt4[1][lt][1]); w.w = pk2(lt4[1][lt][2], lt4[1][lt][3]);
                lf[ks][lt] = __builtin_bit_cast(bf16x8, w); }
        }
        f32x4 acc[4][4];
        const GAS bf16* hsrc = ST + (((size_t)bc * NH + head) * HP + c16) * NS + 8 * gq;
#pragma unroll
        for (int pt = 0; pt < 4; ++pt) { bf16x8 hf[4];
#pragma unroll
            for (int kn = 0; kn < 4; ++kn) hf[kn] = *(const GAS bf16x8*)(hsrc + (size_t)(16 * pt) * NS + 32 * kn);
#pragma unroll
            for (int lt = 0; lt < 4; ++lt) { f32x4 t4 = (f32x4){0.f, 0.f, 0.f, 0.f};
#pragma unroll
                for (int kn = 0; kn < 4; ++kn) t4 = __builtin_amdgcn_mfma_f32_16x16x32_bf16(hf[kn], cf[lt][kn], t4, 0, 0, 0);
                acc[pt][lt] = t4 * __expf(al[lt]); }
            asm volatile("" ::: "memory"); }
        const LAS unsigned char* xb = xw + (4 * gq + (c16 >> 2)) * RSW + (c16 & 3) * 8;
#pragma unroll
        for (int pt = 0; pt < 4; ++pt) {
            const bf16x8 x0 = tr8(xb + pt * 32, 0, 16 * RSW), x1 = tr8(xb + pt * 32, 32 * RSW, 48 * RSW);
#pragma unroll
            for (int lt = 0; lt < 4; ++lt) { acc[pt][lt] = __builtin_amdgcn_mfma_f32_16x16x32_bf16(x0, lf[0][lt], acc[pt][lt], 0, 0, 0);
                if (lt >= 2) acc[pt][lt] = __builtin_amdgcn_mfma_f32_16x16x32_bf16(x1, lf[1][lt], acc[pt][lt], 0, 0, 0); } }
        const float dk = dskip[head]; float ssq[4] = {0.f, 0.f, 0.f, 0.f};
#pragma unroll
        for (int lt = 0; lt < 4; ++lt) { const int l = 16 * lt + c16;
#pragma unroll
            for (int pt = 0; pt < 4; ++pt) { const int p0 = 16 * pt + 4 * gq;
                const u32x2 xv = *(const LAS u32x2*)(xw + l * RSW + p0 * 2); const u32x2 zw = *(const GAS u32x2*)(P + (size_t)(m0 + l) * NMAIN + PZ + head * HP + p0);
                const float xs4[4] = {bflo(xv.x), bfhi(xv.x), bflo(xv.y), bfhi(xv.y)}, z4[4] = {bflo(zw.x), bfhi(zw.x), bflo(zw.y), bfhi(zw.y)};
#pragma unroll
                for (int j = 0; j < 4; ++j) { const float y = (acc[pt][lt][j] + dk * xs4[j]) * z4[j] * __builtin_amdgcn_rcpf(1.0f + __expf(-z4[j])); acc[pt][lt][j] = y; ssq[lt] += y * y; } } }
        LAS float* ssqs = (LAS float*)(lds + O_SSQ) + par * 512;
#pragma unroll
        for (int lt = 0; lt < 4; ++lt) { float v = ssq[lt]; v += __shfl_xor(v, 16); v += __shfl_xor(v, 32); if (gq == 0) ssqs[wave * 64 + 16 * lt + c16] = v; }
        LDS_WAIT();
        __syncthreads();
#pragma unroll
        for (int lt = 0; lt < 4; ++lt) { const int l = 16 * lt + c16; float tot = 0.f;
#pragma unroll
            for (int w8 = 0; w8 < 8; ++w8) tot += ssqs[w8 * 64 + l];
            const float rstd = rsqrtf(tot * (1.0f / (HPG * HP)) + EPS);
#pragma unroll
            for (int pt = 0; pt < 4; ++pt) { const int ch = head * HP + 16 * pt + 4 * gq; const f32x4 gn = *(const GAS f32x4*)(gnorm + ch); const f32x4 o = acc[pt][lt] * rstd * gn;
                if (YF8) *(GAS unsigned*)((GAS unsigned char*)Y + (size_t)(m0 + l) * DI + ch) = pack4_fp8(o.x, o.y, o.z, o.w);
                else { u32x2 w; w.x = pk2(o.x, o.y); w.y = pk2(o.z, o.w); *(GAS u32x2*)(Y + (size_t)(m0 + l) * DI + ch) = w; } } }
        LDS_WAIT(); asm volatile("" ::: "memory");
    }
}

__device__ __forceinline__ float gelu_tanhf_(float x) { const float u = 0.7978845608028654f * (x + 0.044715f * x * x * x); return x * __builtin_amdgcn_rcpf(1.0f + __expf(-2.0f * u)); }
template <bool F8> __device__ __forceinline__ void ph_ffn_act(const GAS bf16* U, const GAS float* cw, const GAS float* cb, GAS bf16* ACT, int gtid, int nthr) {
    constexpr int NCG = FF / 8, R = 8;
    for (int it = gtid; it < (M / R) * NCG; it += nthr) {
        const int c0 = (it % NCG) * 8, m0 = (it / NCG) * R, t0 = m0 & (SEQ - 1);
        f32x4 wg[3][2], wv[3][2];
#pragma unroll
        for (int i = 0; i < 3; ++i) { wg[i][0] = *(const GAS f32x4*)(cw + i * FF2 + c0); wg[i][1] = *(const GAS f32x4*)(cw + i * FF2 + c0 + 4); wv[i][0] = *(const GAS f32x4*)(cw + i * FF2 + FF + c0); wv[i][1] = *(const GAS f32x4*)(cw + i * FF2 + FF + c0 + 4); }
        const f32x4 bg0 = *(const GAS f32x4*)(cb + c0), bg1 = *(const GAS f32x4*)(cb + c0 + 4), bv0 = *(const GAS f32x4*)(cb + FF + c0), bv1 = *(const GAS f32x4*)(cb + FF + c0 + 4);
        u32x4 rg[R + 2], rv[R + 2];
#pragma unroll
        for (int i = 0; i < R + 2; ++i) { const bool ok = (t0 + i - 2) >= 0; const GAS bf16* ur = U + (size_t)(m0 + (ok ? i - 2 : 0)) * FF2 + c0;
            rg[i] = *(const GAS u32x4*)ur; rv[i] = *(const GAS u32x4*)(ur + FF); if (!ok) { rg[i] = (u32x4){0u, 0u, 0u, 0u}; rv[i] = (u32x4){0u, 0u, 0u, 0u}; } }
#pragma unroll
        for (int o = 0; o < R; ++o) { f32x4 g0 = bg0, g1 = bg1, v0 = bv0, v1 = bv1;
#pragma unroll
            for (int i = 0; i < 3; ++i) { float xg[8], xv[8]; unpack8(rg[o + i], xg); unpack8(rv[o + i], xv);
                g0 += wg[i][0] * (f32x4){xg[0], xg[1], xg[2], xg[3]}; g1 += wg[i][1] * (f32x4){xg[4], xg[5], xg[6], xg[7]};
                v0 += wv[i][0] * (f32x4){xv[0], xv[1], xv[2], xv[3]}; v1 += wv[i][1] * (f32x4){xv[4], xv[5], xv[6], xv[7]}; }
            float r[8] = {gelu_tanhf_(g0.x) * v0.x, gelu_tanhf_(g0.y) * v0.y, gelu_tanhf_(g0.z) * v0.z, gelu_tanhf_(g0.w) * v0.w, gelu_tanhf_(g1.x) * v1.x, gelu_tanhf_(g1.y) * v1.y, gelu_tanhf_(g1.z) * v1.z, gelu_tanhf_(g1.w) * v1.w};
            if (F8) *(GAS u32x2*)((GAS unsigned char*)ACT + (size_t)(m0 + o) * FF + c0) = pack8_fp8(r);
            else *(GAS u32x4*)(ACT + (size_t)(m0 + o) * FF + c0) = pack8(r); }
    }
}

struct Args { const float* in[20]; float* out; unsigned char* ws; int ph_lo, ph_hi; };
constexpr int NP = 11, NPHASE = 1 + DEPTH * NP;

#define AIN(i) ((const GAS float*)args.in[i])
__global__ void __launch_bounds__(NTHR, 2) fwd(Args args) {
    extern __shared__ __attribute__((aligned(16))) unsigned char lds[];
    const int G = gridDim.x, blk = blockIdx.x;
    volatile LAS unsigned* MISC = (volatile LAS unsigned*)((LAS unsigned char*)lds + MISC_OFF);
    for (int u = threadIdx.x; u < (LDS_BYTES - LDSCTL_OFF) / 4; u += NTHR) ((LAS unsigned*)((LAS unsigned char*)lds + LDSCTL_OFF))[u] = 0u;
    __syncthreads();
    XcdBarrier bar; bar.bar = (unsigned*)(args.ws + WS_CTL) + CW_BAR; bar.x = 0; bar.st = nullptr;
    if (!MK_PER_PHASE) bar = xcd_barrier_post((unsigned*)(args.ws + WS_CTL) + CW_BAR, MISC + 8);
    const int lo = args.ph_lo, hi = args.ph_hi;
#define IN(k) (lo <= (k) && (k) < hi)
#define SEAM(k) do { if (IN(k) && IN((k) + 1)) xcd_barrier(bar); } while (0)
#define PH_BEGIN \
    int tid = threadIdx.x; asm volatile("" : "+v"(tid)); \
    const int lane = tid & 63, wave = __builtin_amdgcn_readfirstlane(tid >> 6); \
    const int gw = blk * NWAVES + wave, ngw = G * NWAVES, gtid = blk * NTHR + tid, nthr = G * NTHR; \
    GAS unsigned char* ws = (GAS unsigned char*)args.ws; asm volatile("" : "+s"(ws)); \
    LAS unsigned char* ring = (LAS unsigned char*)lds; \
    (void)lane; (void)wave; (void)gw; (void)ngw; (void)gtid; (void)nthr; (void)ring; \
    GAS float* X = (GAS float*)args.out; \
    GAS bf16* H = (GAS bf16*)(ws + WS_H); GAS bf16* P = (GAS bf16*)(ws + WS_P); GAS float* SM = (GAS float*)(ws + WS_SM); GAS bf16* XC = (GAS bf16*)(ws + WS_XC); \
    GAS float* CD = (GAS float*)(ws + WS_DT); GAS bf16* STB = (GAS bf16*)(ws + WS_ST); GAS bf16* Y = (GAS bf16*)(ws + WS_Y); \
    GAS float* SC = (GAS float*)(ws + WS_SC); GAS unsigned long long* MASKW = (GAS unsigned long long*)(ws + WS_IDX); GAS bf16* AO = (GAS bf16*)(ws + WS_AO); \
    GAS float* MG = (GAS float*)(ws + WS_MG); GAS unsigned char* H8 = ws + WS_MG + 32 * MiB; GAS bf16* MGB = (GAS bf16*)(ws + WS_MGB); GAS bf16* YMB = (GAS bf16*)(ws + WS_YM); GAS bf16* XB = (GAS bf16*)(ws + WS_YM + 32 * MiB); GAS bf16* U = (GAS bf16*)(ws + WS_U); \
    GAS bf16* ACT = (GAS bf16*)(ws + WS_ACT); GAS bf16* KIB = (GAS bf16*)(ws + WS_KIB); \
    (void)X; (void)H; (void)P; (void)SM; (void)XC; (void)CD; (void)STB; (void)Y; (void)SC; (void)MASKW; (void)AO; (void)MG; (void)H8; (void)MGB; (void)YMB; (void)XB; (void)U; (void)ACT; (void)KIB;

    if (IN(0)) { PH_BEGIN
        WPtrs wp{AIN(5), AIN(13), AIN(14), AIN(15), AIN(16), AIN(19)};
        REP(5) ph_weights(wp, ws, ring + wave * 10240, gw, ngw, lane);
        ph_resid_norm<true, false, false>(nullptr, nullptr, AIN(1), AIN(0), nullptr, nullptr, XB, H, F8_IN == 0 ? H8 : nullptr, gw, ngw, lane);
    }
    SEAM(0);

#pragma unroll 1
    for (int layer = 0; layer < DEPTH; ++layer) {
        const int pb = 1 + layer * NP;
#define WL (ws + WS_W + (size_t)layer * WL_SIZE)
        if (IN(pb + 0)) { PH_BEGIN
            if (layer >= F8_IN) {
                { pg8::Gemm g{(const GAS bf16*)H8, (const GAS bf16*)(WL + WL_IN), M, PQI, D / 2, 0x7f7f7f7f, 0x79797979}; pg8::StaticOrder S; S.init(M, PQI, G, blk);
                  pg8::EpiIn E{P, NMAIN, AIN(6) + (size_t)layer * 2 * D, PG / 256, 0};
                  pg8::gemm_phase<pg8::EpiIn, pg8::StaticOrder, true, true, true>(ring, g, S, E); }
                __syncthreads();
                { pg8::Gemm g{H, (const GAS bf16*)(WL + WL_IN) + (size_t)PQI * D, M, NMAIN - PQI, D}; pg8::StaticOrder S; S.init(M, NMAIN - PQI, G, (blk + G / 2) % G);
                  pg8::EpiIn E{P, NMAIN, AIN(6) + (size_t)layer * 2 * D, PG / 256, PQI / 256};
                  pg8::gemm_phase<pg8::EpiIn, pg8::StaticOrder, true, true>(ring, g, S, E); }
                __syncthreads();
            } else
            { pg8::Gemm g{H, (const GAS bf16*)(WL + WL_IN), M, NMAIN, D}; pg8::StaticOrder S; S.init(M, NMAIN, G, blk);
              pg8::EpiIn E{P, NMAIN, AIN(6) + (size_t)layer * 2 * D, PG / 256, 0};
              REP(1) { pg8::gemm_phase<pg8::EpiIn, pg8::StaticOrder, true, true>(ring, g, S, E); __syncthreads(); } }
            REP(2) { ph_small_proj(H, (const GAS bf16*)(WL + WL_IN) + (size_t)NMAIN * D, SM, KIB, ring, blk, G, tid); __syncthreads(); }
        }
        SEAM(pb + 0);
        if (IN(pb + 1)) { PH_BEGIN
            REP(20) { ph_ssd_states(P, SM, AIN(7) + (size_t)layer * 4 * CONVD, AIN(8) + (size_t)layer * CONVD, AIN(9) + layer * NH, AIN(10) + layer * NH, XC, STB, CD, ring, blk, G, tid); __syncthreads(); }
            REP(21) { ph_index_scores(P, SM, KIB, SC, ring, blk, G, tid); __syncthreads(); } }
        SEAM(pb + 1);
        if (IN(pb + 2)) { PH_BEGIN
            ph_ssd_scan(STB, CD, gtid, nthr); REP(30) ph_topk(SC, MASKW, ring + wave * 9728, gw, ngw, lane);
#if PROBE_DOUBLE == 31
            ph_ssd_scan((GAS bf16*)U, CD, gtid, nthr);
#endif
            }
        SEAM(pb + 2);
        if (IN(pb + 3)) { PH_BEGIN
            if (layer >= F8_OUT) { ph_ssd_out<true>(P, SM, XC, AIN(9) + layer * NH, AIN(10) + layer * NH, STB, AIN(11) + layer * NH, AIN(12) + (size_t)layer * DI, Y, ring, blk, G, tid); __syncthreads();
                ph_attn_dense<16>(P, MASKW, AO, ring, blk, G, tid); __syncthreads(); }
            else { REP(40) { ph_ssd_out<false>(P, SM, XC, AIN(9) + layer * NH, AIN(10) + layer * NH, STB, AIN(11) + layer * NH, AIN(12) + (size_t)layer * DI, Y, ring, blk, G, tid); __syncthreads(); }
                REP(41) { ph_attn_dense<0>(P, MASKW, AO, ring, blk, G, tid); __syncthreads(); } }
            }
        SEAM(pb + 3);
        if (IN(pb + 4)) {
            { PH_BEGIN
              pg8::StaticOrder S; S.init(M, D, G, blk); pg8::EpiGateMul E{MGB, D, P + PG, NMAIN};
              if (layer >= F8_OUT) { pg8::Gemm g{Y, (const GAS bf16*)(WL + WL_SSM), M, D, DI / 2, 0x7f7f7f7f, 0x79797979}; pg8::gemm_phase<pg8::EpiGateMul, pg8::StaticOrder, false, true, true>(ring, g, S, E); }
              else { pg8::Gemm g{Y, (const GAS bf16*)(WL + WL_SSM), M, D, DI}; pg8::gemm_phase<pg8::EpiGateMul, pg8::StaticOrder, false, true>(ring, g, S, E); } }
            __syncthreads();
            { PH_BEGIN
              pg8::StaticOrder S; S.init(M, D, G, blk); pg8::EpiGateAdd E{MGB, D, P + PG + D, NMAIN, layer >= F8_MIX ? (GAS unsigned char*)MG : nullptr};
              if (layer >= F8_OUT) { pg8::Gemm g{AO, (const GAS bf16*)(WL + WL_ATT), M, D, D / 2, 0x7f7f7f7f, 0x79797979}; pg8::gemm_phase<pg8::EpiGateAdd, pg8::StaticOrder, false, true, true>(ring, g, S, E); }
              else { pg8::Gemm g{AO, (const GAS bf16*)(WL + WL_ATT), M, D, D}; pg8::gemm_phase<pg8::EpiGateAdd, pg8::StaticOrder, false, true>(ring, g, S, E); } }
        }
        SEAM(pb + 4);
        if (IN(pb + 5)) { PH_BEGIN
            pg8::StaticOrder S; S.init(M, D, G, blk); pg8::EpiBf16<0> E{YMB, D, nullptr, 0, 0, 1.f};
            if (layer >= F8_MIX) { pg8::Gemm g{(const GAS bf16*)MG, (const GAS bf16*)(WL + WL_MIX), M, D, D / 2, 0x7f7f7f7f, 0x79797979}; pg8::gemm_phase<pg8::EpiBf16<0>, pg8::StaticOrder, false, true, true>(ring, g, S, E); }
            else { pg8::Gemm g{MGB, (const GAS bf16*)(WL + WL_MIX), M, D, D}; REP(60) { pg8::gemm_phase<pg8::EpiBf16<0>, pg8::StaticOrder, false, true>(ring, g, S, E); __syncthreads(); } } }
        SEAM(pb + 5);
        if (IN(pb + 6)) { PH_BEGIN
            if (layer >= F8_UP) ph_resid_norm<false, true, false, true>(YMB, AIN(2) + (size_t)layer * D, AIN(3) + (size_t)layer * D, nullptr, XB, nullptr, XB, H, nullptr, gw, ngw, lane);
            else ph_resid_norm<false, true, false>(YMB, AIN(2) + (size_t)layer * D, AIN(3) + (size_t)layer * D, nullptr, XB, nullptr, XB, H, nullptr, gw, ngw, lane); }
        SEAM(pb + 6);
        if (IN(pb + 7)) { PH_BEGIN
            pg8::StaticOrder S; S.init(M, FF2, G, blk); pg8::EpiBf16<0> E{U, FF2, nullptr, 0, 0, 1.f};
            if (layer >= F8_UP) { pg8::Gemm g{H, (const GAS bf16*)(WL + WL_UP), M, FF2, D / 2, 0x7f7f7f7f, 0x79797979}; pg8::gemm_phase<pg8::EpiBf16<0>, pg8::StaticOrder, true, true, true>(ring, g, S, E); }
            else { pg8::Gemm g{H, (const GAS bf16*)(WL + WL_UP), M, FF2, D}; REP(80) { pg8::gemm_phase<pg8::EpiBf16<0>, pg8::StaticOrder, true, true>(ring, g, S, E); __syncthreads(); } } }
        SEAM(pb + 7);
        if (IN(pb + 8)) { PH_BEGIN
            if (layer >= F8_DN) ph_ffn_act<true>(U, AIN(17) + (size_t)layer * 3 * FF2, AIN(18) + (size_t)layer * FF2, ACT, gtid, nthr);
            else REP(90) ph_ffn_act<false>(U, AIN(17) + (size_t)layer * 3 * FF2, AIN(18) + (size_t)layer * FF2, ACT, gtid, nthr); }
        SEAM(pb + 8);
        if (IN(pb + 9)) { PH_BEGIN
            pg8::StaticOrder S; S.init(M, D, G, blk); pg8::EpiBf16<0> E{YMB, D, nullptr, 0, 0, 1.f};
            if (layer >= F8_DN) { pg8::Gemm g{ACT, (const GAS bf16*)(WL + WL_DN), M, D, FF / 2, 0x7f7f7f7f, 0x79797979}; pg8::gemm_phase<pg8::EpiBf16<0>, pg8::StaticOrder, false, true, true>(ring, g, S, E); }
            else { pg8::Gemm g{ACT, (const GAS bf16*)(WL + WL_DN), M, D, FF}; REP(100) { pg8::gemm_phase<pg8::EpiBf16<0>, pg8::StaticOrder, false, true>(ring, g, S, E); __syncthreads(); } } }
        SEAM(pb + 9);
        if (IN(pb + 10)) { PH_BEGIN
            if (layer + 1 < DEPTH) ph_resid_norm<false, true, false>(YMB, AIN(4) + (size_t)layer * D, AIN(1) + (size_t)(layer + 1) * D, nullptr, XB, nullptr, XB, H, layer + 1 >= F8_IN ? H8 : nullptr, gw, ngw, lane);
            else ph_resid_norm<false, true, true>(YMB, AIN(4) + (size_t)layer * D, nullptr, nullptr, XB, X, nullptr, H, nullptr, gw, ngw, lane); }
        SEAM(pb + 10);
    }
#undef IN
#undef SEAM
#undef WL
#undef PH_BEGIN
}

extern "C" void kernel_launch(void* const* d_in, const int* in_sizes, int n_in, void* d_out, int out_size, void* d_ws, size_t ws_size, hipStream_t stream) {
    static int grid = 0;
    if (grid == 0) {
        if (n_in != 20 || in_sizes[0] != M * D || out_size != M * D || ws_size < WS_END) { fprintf(stderr, "kernel_launch: unexpected shapes (n_in %d, in0 %d, out %d, ws %zu < %zu)\n", n_in, n_in > 0 ? in_sizes[0] : -1, out_size, ws_size, (size_t)WS_END); grid = -1; return; }
        int dev = 0, cus = 0, per_cu = 0;
        if (hipGetDevice(&dev) != hipSuccess || hipDeviceGetAttribute(&cus, hipDeviceAttributeMultiprocessorCount, dev) != hipSuccess) { grid = -1; return; }
        if (hipFuncSetAttribute((const void*)fwd, hipFuncAttributeMaxDynamicSharedMemorySize, LDS_BYTES) != hipSuccess) { fprintf(stderr, "kernel_launch: hipFuncSetAttribute failed\n"); grid = -1; return; }
        if (hipOccupancyMaxActiveBlocksPerMultiprocessor(&per_cu, (const void*)fwd, NTHR, LDS_BYTES) != hipSuccess || per_cu < 1) fprintf(stderr, "kernel_launch: occupancy query reports %d blocks per CU\n", per_cu);
        (void)hipGetLastError();
        grid = cus;
    }
    if (grid < 0) return;
    if (hipMemsetAsync((char*)d_ws + WS_CTL, 0, CTL_ZERO_BYTES, stream) != hipSuccess) return;
    Args a{};
    for (int i = 0; i < 20; ++i) a.in[i] = (const float*)d_in[i];
    a.out = (float*)d_out; a.ws = (unsigned char*)d_ws;
#if MK_PER_PHASE
    for (int ph = 0; ph < NPHASE; ++ph) { a.ph_lo = ph; a.ph_hi = ph + 1; hipLaunchKernelGGL(fwd, dim3(grid), dim3(NTHR), LDS_BYTES, stream, a); }
#else
    a.ph_lo = 0; a.ph_hi = NPHASE; hipLaunchKernelGGL(fwd, dim3(grid), dim3(NTHR), LDS_BYTES, stream, a);
#endif
}
```

```cpp
#include <hip/hip_runtime.h>
#include <cstdio>
#include <cstdint>
#define MK_PER_PHASE 0
namespace pg8 {
#define PG8_LAS __attribute__((address_space(3)))
#define PG8_GAS __attribute__((address_space(1)))
typedef unsigned short bf16_t;
typedef short bf16x8 __attribute__((ext_vector_type(8)));
typedef float f32x4 __attribute__((ext_vector_type(4)));
typedef unsigned u32x4 __attribute__((ext_vector_type(4)));
constexpr int BM = 256, BK = 64, HALF = 128, HTB = HALF * BK * 2  , STAGE_BYTES = 8 * HTB, NXCD = 8, WGM = 8;

__host__ __device__ __forceinline__ int lds_byte(int r, int c) { const int st = (r >> 4) * 2 + (c >> 5), rr = r & 15, cc = c & 31, ob = rr * 64 + cc * 2; return st * 1024 + (ob ^ (((ob >> 9) & 1) << 5)); }
__host__ __device__ __forceinline__ void stage_rc(int b, int& R, int& C) { const int st = b / 1024, sb = b % 1024, swz = sb ^ (((sb >> 9) & 1) << 5); R = (st >> 1) * 16 + swz / 64; C = (st & 1) * 32 + (swz % 64) / 2; }
__host__ __device__ __forceinline__ int perm32(int rho) { const int n = rho >> 4, i = rho & 15; return 8 * (i >> 2) + 4 * n + (i & 3); }

struct Unit { int pm, pn; };
struct Gemm { const PG8_GAS bf16_t* A; const PG8_GAS bf16_t* Bt; int M, N, K; int sa, sb; };

struct StaticOrder {
    int nM, nN, nwg, G, c;
    __host__ __device__ void init(int M, int N, int G_, int c_) { nM = M / BM; nN = N / BM; nwg = nM * nN; G = G_; c = c_; }
    __host__ __device__ bool next(int i, Unit& u) const {
        const long L = (long)i * G + c; if (L >= nwg) return false;
        int wgid = (int)L; { const int q = nwg / NXCD, r = nwg % NXCD, xcd = wgid % NXCD, off = wgid / NXCD; wgid = (xcd < r ? xcd * (q + 1) : r * (q + 1) + (xcd - r) * q) + off; }
        const int nig = WGM * nN, gid = wgid / nig, fm = gid * WGM, gsz = (nM - fm) < WGM ? (nM - fm) : WGM;
        u.pm = fm + ((wgid % nig) % gsz); u.pn = (wgid % nig) / gsz; return true;
    }
    __device__ __forceinline__ void a_ready(const Unit&) const {}
    __device__ __forceinline__ void done(const Unit&) const {}
};

__device__ __forceinline__ unsigned cvt_pk_bf16(float lo, float hi) { unsigned r; asm volatile("v_cvt_pk_bf16_f32 %0, %1, %2" : "=v"(r) : "v"(lo), "v"(hi)); return r; }
typedef float f32x2 __attribute__((ext_vector_type(2)));
__device__ __forceinline__ f32x2 gelu_pk(f32x2 v) {
    const f32x2 av = __builtin_elementwise_abs(v), d = av * 0.2316418882f + 1.0f;
    f32x2 t; t.x = __builtin_amdgcn_rcpf(d.x); t.y = __builtin_amdgcn_rcpf(d.y);
    f32x2 q = t * 0.5307027145f + (-0.7265760135f); q = q * t + 0.7107068705f; q = q * t + (-0.142248368f); q = q * t + 0.127414796f; q = q * t;
    const f32x2 s = (v * v) * (-0.72134752044f);
    f32x2 e; e.x = __builtin_amdgcn_exp2f(s.x); e.y = __builtin_amdgcn_exp2f(s.y);
    const f32x2 m = v * (q * e), r = v - m;
    f32x2 o; o.x = v.x < 0.f ? m.x : r.x; o.y = v.y < 0.f ? m.y : r.y; return o;
}

template <int ACT  > struct EpiBf16 {
    static constexpr bool PERM = true, AFTER_DRAIN = false; static_assert(ACT == 0 || ACT == 1, "EpiBf16: ACT is 0 (none) or 1 (gelu_pk)");
    PG8_GAS bf16_t* O; int ldc; const PG8_GAS float* bias; int split_cols; size_t split_stride; float scale0;
    __device__ __forceinline__ void operator()(const f32x4 (&acc)[2][2][4][2], const Unit& u, int wr, int wc, int fr, int fq) const {
        const int row0 = u.pm * BM + wr * 64 + fr; int colt = u.pn * BM; PG8_GAS bf16_t* base = O;
        float sc = 1.f; if (split_cols) { const int t = colt / split_cols; base += (size_t)t * split_stride; colt -= t * split_cols; if (t == 0) sc = scale0; }
        const int col0 = colt + wc * 32 + 8 * fq, bcol0 = u.pn * BM + wc * 32 + 8 * fq;
        f32x4 bv[2][2];
#pragma unroll
        for (int bj = 0; bj < 2; ++bj)
#pragma unroll
            for (int n = 0; n < 2; ++n) bv[bj][n] = bias ? *(const PG8_GAS f32x4*)(bias + bcol0 + bj * HALF + 4 * n) : (f32x4){0.f, 0.f, 0.f, 0.f};
#pragma unroll
        for (int ai = 0; ai < 2; ++ai)
#pragma unroll
            for (int m = 0; m < 4; ++m) { PG8_GAS bf16_t* rowp = base + (size_t)(row0 + ai * HALF + m * 16) * ldc + col0;
#pragma unroll
                for (int bj = 0; bj < 2; ++bj) { f32x4 v0 = acc[ai][bj][m][0] + bv[bj][0], v1 = acc[ai][bj][m][1] + bv[bj][1];
                    if (ACT == 1) { f32x2 a = gelu_pk((f32x2){v0[0], v0[1]}), b = gelu_pk((f32x2){v0[2], v0[3]}), c = gelu_pk((f32x2){v1[0], v1[1]}), d = gelu_pk((f32x2){v1[2], v1[3]});
                        v0 = (f32x4){a.x, a.y, b.x, b.y}; v1 = (f32x4){c.x, c.y, d.x, d.y}; }
                    v0 = v0 * sc; v1 = v1 * sc; u32x4 w; w.x = cvt_pk_bf16(v0[0], v0[1]); w.y = cvt_pk_bf16(v0[2], v0[3]); w.z = cvt_pk_bf16(v1[0], v1[1]); w.w = cvt_pk_bf16(v1[2], v1[3]);
                    *(PG8_GAS u32x4*)(rowp + bj * HALF) = w; } }
    }
};

struct EpiF32 {
    static constexpr bool PERM = false, AFTER_DRAIN = false;
    PG8_GAS float* C; int ldc;
    __device__ __forceinline__ void operator()(const f32x4 (&acc)[2][2][4][2], const Unit& u, int wr, int wc, int fr, int fq) const {
        const int row0 = u.pm * BM + wr * 64 + fr, col0 = u.pn * BM + wc * 32 + 4 * fq;
#pragma unroll
        for (int ai = 0; ai < 2; ++ai)
#pragma unroll
            for (int m = 0; m < 4; ++m) { PG8_GAS float* rowp = C + (size_t)(row0 + ai * HALF + m * 16) * ldc + col0;
#pragma unroll
                for (int bj = 0; bj < 2; ++bj)
#pragma unroll
                    for (int n = 0; n < 2; ++n) *(PG8_GAS f32x4*)(rowp + bj * HALF + n * 16) = acc[ai][bj][m][n]; }
    }
};
__device__ __forceinline__ float bf_lo(unsigned w) { return __uint_as_float(w << 16); }
__device__ __forceinline__ float bf_hi(unsigned w) { return __uint_as_float(w & 0xffff0000u); }
__device__ __forceinline__ float sigmoidf_(float x) { return __builtin_amdgcn_rcpf(1.0f + __expf(-x)); }
struct EpiIn {
    static constexpr bool PERM = true, AFTER_DRAIN = false;
    PG8_GAS bf16_t* P; int ldp; const PG8_GAS float* bgate; int gate_tile0, tile0;
    __device__ __forceinline__ void operator()(const f32x4 (&acc)[2][2][4][2], const Unit& u, int wr, int wc, int fr, int fq) const {
        const int pn = u.pn + tile0, row0 = u.pm * BM + wr * 64 + fr, colt = pn * BM + wc * 32 + 8 * fq;
        {
            const bool gate = pn >= gate_tile0 && pn < gate_tile0 + 16;
            f32x4 bv[2][2];
#pragma unroll
            for (int bj = 0; bj < 2; ++bj)
#pragma unroll
                for (int n = 0; n < 2; ++n) bv[bj][n] = gate ? *(const PG8_GAS f32x4*)(bgate + (colt - gate_tile0 * BM) + bj * HALF + 4 * n) : (f32x4){0.f, 0.f, 0.f, 0.f};
#pragma unroll
            for (int ai = 0; ai < 2; ++ai)
#pragma unroll
                for (int m = 0; m < 4; ++m) { PG8_GAS bf16_t* rowp = P + (size_t)(row0 + ai * HALF + m * 16) * ldp + colt;
#pragma unroll
                    for (int bj = 0; bj < 2; ++bj) { f32x4 v0 = acc[ai][bj][m][0] + bv[bj][0], v1 = acc[ai][bj][m][1] + bv[bj][1];
                        if (gate) {
#pragma unroll
                            for (int j = 0; j < 4; ++j) { v0[j] = sigmoidf_(v0[j]); v1[j] = sigmoidf_(v1[j]); } }
                        u32x4 w; w.x = cvt_pk_bf16(v0[0], v0[1]); w.y = cvt_pk_bf16(v0[2], v0[3]); w.z = cvt_pk_bf16(v1[0], v1[1]); w.w = cvt_pk_bf16(v1[2], v1[3]);
                        *(PG8_GAS u32x4*)(rowp + bj * HALF) = w; } }
        }
    }
};
struct EpiGateMul {
    static constexpr bool PERM = true, AFTER_DRAIN = false;
    PG8_GAS bf16_t* O; int ldc; const PG8_GAS bf16_t* G; int ldg;
    __device__ __forceinline__ void operator()(const f32x4 (&acc)[2][2][4][2], const Unit& u, int wr, int wc, int fr, int fq) const {
        const int row0 = u.pm * BM + wr * 64 + fr, colt = u.pn * BM + wc * 32 + 8 * fq;
#pragma unroll
        for (int ai = 0; ai < 2; ++ai)
#pragma unroll
            for (int m = 0; m < 4; ++m) { const size_t row = (size_t)(row0 + ai * HALF + m * 16);
#pragma unroll
                for (int bj = 0; bj < 2; ++bj) { const u32x4 g = *(const PG8_GAS u32x4*)(G + row * ldg + colt + bj * HALF);
                    const f32x4 a0 = acc[ai][bj][m][0], a1 = acc[ai][bj][m][1];
                    u32x4 w; w.x = cvt_pk_bf16(a0[0] * bf_lo(g.x), a0[1] * bf_hi(g.x)); w.y = cvt_pk_bf16(a0[2] * bf_lo(g.y), a0[3] * bf_hi(g.y));
                    w.z = cvt_pk_bf16(a1[0] * bf_lo(g.z), a1[1] * bf_hi(g.z)); w.w = cvt_pk_bf16(a1[2] * bf_lo(g.w), a1[3] * bf_hi(g.w));
                    *(PG8_GAS u32x4*)(O + row * ldc + colt + bj * HALF) = w; } }
    }
};
struct EpiGateAdd {
    static constexpr bool PERM = true, AFTER_DRAIN = false;
    PG8_GAS bf16_t* O; int ldc; const PG8_GAS bf16_t* G; int ldg; PG8_GAS unsigned char* O8;
    __device__ __forceinline__ void operator()(const f32x4 (&acc)[2][2][4][2], const Unit& u, int wr, int wc, int fr, int fq) const {
        const int row0 = u.pm * BM + wr * 64 + fr, colt = u.pn * BM + wc * 32 + 8 * fq;
#pragma unroll
        for (int ai = 0; ai < 2; ++ai)
#pragma unroll
            for (int m = 0; m < 4; ++m) { const size_t row = (size_t)(row0 + ai * HALF + m * 16);
#pragma unroll
                for (int bj = 0; bj < 2; ++bj) { const u32x4 g = *(const PG8_GAS u32x4*)(G + row * ldg + colt + bj * HALF);
                    PG8_GAS u32x4* op = (PG8_GAS u32x4*)(O + row * ldc + colt + bj * HALF); const u32x4 p = *op;
                    const f32x4 a0 = acc[ai][bj][m][0], a1 = acc[ai][bj][m][1];
                    const float s0 = bf_lo(p.x) + a0[0] * bf_lo(g.x), s1 = bf_hi(p.x) + a0[1] * bf_hi(g.x), s2 = bf_lo(p.y) + a0[2] * bf_lo(g.y), s3 = bf_hi(p.y) + a0[3] * bf_hi(g.y);
                    const float s4 = bf_lo(p.z) + a1[0] * bf_lo(g.z), s5 = bf_hi(p.z) + a1[1] * bf_hi(g.z), s6 = bf_lo(p.w) + a1[2] * bf_lo(g.w), s7 = bf_hi(p.w) + a1[3] * bf_hi(g.w);
                    if (O8) { int lo = 0, hi = 0; lo = __builtin_amdgcn_cvt_pk_fp8_f32(s0, s1, lo, false); lo = __builtin_amdgcn_cvt_pk_fp8_f32(s2, s3, lo, true); hi = __builtin_amdgcn_cvt_pk_fp8_f32(s4, s5, hi, false); hi = __builtin_amdgcn_cvt_pk_fp8_f32(s6, s7, hi, true);
                        typedef unsigned u32x2e __attribute__((ext_vector_type(2))); u32x2e w8; w8.x = (unsigned)lo; w8.y = (unsigned)hi; *(PG8_GAS u32x2e*)(O8 + row * ldc + colt + bj * HALF) = w8; }
                    else { u32x4 w; w.x = cvt_pk_bf16(s0, s1); w.y = cvt_pk_bf16(s2, s3); w.z = cvt_pk_bf16(s4, s5); w.w = cvt_pk_bf16(s6, s7); *op = w; } } }
    }
};
template <class Epi, class Sched, bool ALIGN_EPI = false, bool SP2 = false, bool FP8 = false>
__device__ __forceinline__ void gemm_phase(PG8_LAS unsigned char* lds, const Gemm g, const Sched& S, const Epi& E) {
    int tid = threadIdx.x; asm volatile("" : "+v"(tid));
    const int wid = __builtin_amdgcn_readfirstlane(tid >> 6), lane = tid & 63, wr = wid >> 2, wc = wid & 3, fr = lane & 15, fq = lane >> 4;
    const int K = g.K, nt = K / BK;
    unsigned voffA[2], voffB[2];
#pragma unroll
    for (int i = 0; i < 2; ++i) { int R, C; stage_rc(tid * 16 + i * 8192, R, C); const int Rb = Epi::PERM ? ((R & ~31) + perm32(R & 31)) : R;
        voffA[i] = (unsigned)(R * K + C) * 2u; voffB[i] = (unsigned)(Rb * K + C) * 2u; }
    const size_t kstep = (size_t)(BK * 2);
    const size_t hstep = (size_t)HALF * K * 2;
    const size_t tstep = 2 * hstep;
    const unsigned ldsw = (unsigned)wid * 1024u;
    const int aoff = lds_byte(wr * 64 + fr, fq * 8), boff = lds_byte(wc * 32 + fr, fq * 8);
#define PG8_SA(b, h) (((b) * 2 + (h)) * HTB)
#define PG8_SB(b, h) ((4 + (b) * 2 + (h)) * HTB)
#define PG8_STAGE(bufoff, gbase, voff) do { _Pragma("unroll") for (int _i = 0; _i < 2; ++_i) \
        __builtin_amdgcn_global_load_lds((const PG8_GAS unsigned*)((const PG8_GAS char*)(gbase) + (voff)[_i]), (PG8_LAS unsigned*)(lds + (bufoff) + ldsw + _i * 8192), 16, 0, 0); } while (0)
typedef int pg8_v4i __attribute__((ext_vector_type(4))); typedef int pg8_v8i __attribute__((ext_vector_type(8)));
#define PG8_CAT(x, y) __builtin_shufflevector(__builtin_bit_cast(pg8_v4i, (x)), __builtin_bit_cast(pg8_v4i, (y)), 0, 1, 2, 3, 4, 5, 6, 7)
#define PG8_LDA(dst, b, h) do { if constexpr (FP8) { _Pragma("unroll") for (int m = 0; m < 4; ++m) dst##8[m] = PG8_CAT(*(const PG8_LAS bf16x8*)(lds + PG8_SA(b, h) + aoff + m * 2048), *(const PG8_LAS bf16x8*)(lds + PG8_SA(b, h) + aoff + m * 2048 + 1024)); } \
        else { _Pragma("unroll") for (int m = 0; m < 4; ++m) _Pragma("unroll") for (int k = 0; k < 2; ++k) dst[m][k] = *(const PG8_LAS bf16x8*)(lds + PG8_SA(b, h) + aoff + m * 2048 + k * 1024); } } while (0)
#define PG8_LDB(dst, b, h) do { if constexpr (FP8) { _Pragma("unroll") for (int n = 0; n < 2; ++n) dst##8[n] = PG8_CAT(*(const PG8_LAS bf16x8*)(lds + PG8_SB(b, h) + boff + n * 2048), *(const PG8_LAS bf16x8*)(lds + PG8_SB(b, h) + boff + n * 2048 + 1024)); } \
        else { _Pragma("unroll") for (int n = 0; n < 2; ++n) _Pragma("unroll") for (int k = 0; k < 2; ++k) dst[n][k] = *(const PG8_LAS bf16x8*)(lds + PG8_SB(b, h) + boff + n * 2048 + k * 1024); } } while (0)
#define PG8_MMA(ai, bj, At, Bt) do { __builtin_amdgcn_s_setprio(1); \
        if constexpr (FP8) { _Pragma("unroll") for (int m = 0; m < 4; ++m) _Pragma("unroll") for (int n = 0; n < 2; ++n) \
            asm volatile("v_mfma_scale_f32_16x16x128_f8f6f4 %0, %1, %2, %0, %3, %4 op_sel_hi:[0,0,0]" : "+v"(acc[ai][bj][m][n]) : "v"(Bt##8[n]), "v"(At##8[m]), "v"(sc_b), "v"(sc_a)); } \
        else { _Pragma("unroll") for (int m = 0; m < 4; ++m) _Pragma("unroll") for (int n = 0; n < 2; ++n) _Pragma("unroll") for (int k = 0; k < 2; ++k) \
            acc[ai][bj][m][n] = __builtin_amdgcn_mfma_f32_16x16x32_bf16(Bt[n][k], At[m][k], acc[ai][bj][m][n], 0, 0, 0); } \
        __builtin_amdgcn_s_setprio(0); } while (0)
#define PG8_WAIT_V(n) asm volatile("s_waitcnt vmcnt(" #n ")" ::: "memory")
#define PG8_WAIT_L(n) asm volatile("s_waitcnt lgkmcnt(" #n ")" ::: "memory")
#define PG8_BAR __builtin_amdgcn_s_barrier()
#define PG8_SCHED __builtin_amdgcn_sched_barrier(0)
    Unit cur, nxt; int ui = 0;
    if (!S.next(0, cur)) return;
    f32x4 acc[2][2][4][2];
#pragma unroll
    for (int a = 0; a < 2; ++a)
#pragma unroll
        for (int b = 0; b < 2; ++b)
#pragma unroll
            for (int m = 0; m < 4; ++m)
#pragma unroll
                for (int n = 0; n < 2; ++n) acc[a][b][m][n] = (f32x4){0.f, 0.f, 0.f, 0.f};
    const int sc_a = g.sa, sc_b = g.sb;
    bf16x8 At[4][2], B0[2][2], B1[2][2]; pg8_v8i At8[4], B08[2], B18[2];
    const PG8_GAS char* cA = (const PG8_GAS char*)g.A + (size_t)cur.pm * tstep; const PG8_GAS char* cB = (const PG8_GAS char*)g.Bt + (size_t)cur.pn * tstep;
    S.a_ready(cur);
    if constexpr (SP2) {
        PG8_STAGE(PG8_SB(0, 0), cB, voffB); PG8_STAGE(PG8_SB(0, 1), cB + hstep, voffB); PG8_STAGE(PG8_SA(0, 0), cA, voffA); PG8_STAGE(PG8_SA(0, 1), cA + hstep, voffA);
        if (wr == 1) PG8_BAR;
        PG8_WAIT_V(2); PG8_BAR;
        PG8_STAGE(PG8_SB(1, 0), cB + kstep, voffB); PG8_STAGE(PG8_SA(1, 0), cA + kstep, voffA); PG8_STAGE(PG8_SB(1, 1), cB + hstep + kstep, voffB);
        PG8_WAIT_V(6); PG8_BAR;
    } else {
        PG8_STAGE(PG8_SB(0, 0), cB, voffB); PG8_STAGE(PG8_SA(0, 0), cA, voffA); PG8_STAGE(PG8_SB(0, 1), cB + hstep, voffB); PG8_STAGE(PG8_SA(0, 1), cA + hstep, voffA);
        if (wr == 1) PG8_BAR;
        PG8_WAIT_V(4); PG8_BAR;
        PG8_STAGE(PG8_SB(1, 0), cB + kstep, voffB); PG8_STAGE(PG8_SA(1, 0), cA + kstep, voffA); PG8_STAGE(PG8_SB(1, 1), cB + hstep + kstep, voffB);
        PG8_WAIT_V(6); PG8_BAR;
    }
    for (;;) {
        const bool has_next = S.next(ui + 1, nxt);
        const PG8_GAS char* nA = has_next ? (const PG8_GAS char*)g.A + (size_t)nxt.pm * tstep : cA; const PG8_GAS char* nB = has_next ? (const PG8_GAS char*)g.Bt + (size_t)nxt.pn * tstep : cB;
        for (int t = 0; t < nt; t += 2) {
            const bool last = (t == nt - 2);
            const PG8_GAS char* a1 = cA + (size_t)(t + 1) * kstep;
            const PG8_GAS char* a2 = last ? nA : cA + (size_t)(t + 2) * kstep; const PG8_GAS char* b2 = last ? nB : cB + (size_t)(t + 2) * kstep;
            const PG8_GAS char* a3 = a2 + kstep; const PG8_GAS char* b3 = b2 + kstep;
            if (last && has_next) S.a_ready(nxt);
            if constexpr (SP2) {
            PG8_LDB(B0, 0, 0); PG8_LDB(B1, 0, 1); PG8_SCHED; PG8_LDA(At, 0, 0); PG8_STAGE(PG8_SA(1, 1), a1 + hstep, voffA);
            PG8_WAIT_V(8); PG8_WAIT_L(0); PG8_BAR; PG8_MMA(0, 0, At, B0); PG8_MMA(0, 1, At, B1); PG8_BAR; PG8_SCHED;
            PG8_LDA(At, 0, 1); PG8_STAGE(PG8_SB(0, 0), b2, voffB); PG8_STAGE(PG8_SB(0, 1), b2 + hstep, voffB); PG8_STAGE(PG8_SA(0, 0), a2, voffA);
            PG8_WAIT_V(8); PG8_WAIT_L(0); PG8_BAR; PG8_MMA(1, 0, At, B0); PG8_MMA(1, 1, At, B1); PG8_BAR; PG8_SCHED;
            PG8_LDB(B0, 1, 0); PG8_LDB(B1, 1, 1); PG8_SCHED; PG8_LDA(At, 1, 0); PG8_STAGE(PG8_SA(0, 1), a2 + hstep, voffA);
            PG8_WAIT_V(8); PG8_WAIT_L(0); PG8_BAR; PG8_MMA(0, 0, At, B0); PG8_MMA(0, 1, At, B1); PG8_BAR; PG8_SCHED;
            PG8_LDA(At, 1, 1); PG8_STAGE(PG8_SB(1, 0), b3, voffB); PG8_STAGE(PG8_SB(1, 1), b3 + hstep, voffB); PG8_STAGE(PG8_SA(1, 0), a3, voffA);
            PG8_WAIT_V(8); PG8_WAIT_L(0); PG8_BAR; PG8_MMA(1, 0, At, B0); PG8_MMA(1, 1, At, B1); PG8_BAR; PG8_SCHED;
            } else {
            PG8_LDB(B0, 0, 0); PG8_SCHED; PG8_LDA(At, 0, 0); PG8_STAGE(PG8_SA(1, 1), a1 + hstep, voffA);
            PG8_WAIT_L(8); PG8_BAR; PG8_WAIT_L(0); PG8_MMA(0, 0, At, B0); PG8_BAR; PG8_SCHED;
            PG8_LDB(B1, 0, 1); PG8_STAGE(PG8_SB(0, 0), b2, voffB);
            PG8_BAR; PG8_WAIT_L(0); PG8_MMA(0, 1, At, B1); PG8_BAR;
            PG8_LDA(At, 0, 1); PG8_STAGE(PG8_SA(0, 0), a2, voffA);
            PG8_BAR; PG8_WAIT_L(0); PG8_MMA(1, 0, At, B0); PG8_BAR; PG8_SCHED;
            PG8_STAGE(PG8_SB(0, 1), b2 + hstep, voffB);
            PG8_WAIT_V(6); PG8_BAR; PG8_MMA(1, 1, At, B1); PG8_BAR;
            PG8_LDB(B0, 1, 0); PG8_SCHED; PG8_LDA(At, 1, 0); PG8_STAGE(PG8_SA(0, 1), a2 + hstep, voffA);
            PG8_WAIT_L(8); PG8_BAR; PG8_WAIT_L(0); PG8_MMA(0, 0, At, B0); PG8_BAR; PG8_SCHED;
            PG8_LDB(B1, 1, 1); PG8_STAGE(PG8_SB(1, 0), b3, voffB);
            PG8_BAR; PG8_WAIT_L(0); PG8_MMA(0, 1, At, B1); PG8_BAR;
            PG8_LDA(At, 1, 1); PG8_STAGE(PG8_SA(1, 0), a3, voffA);
            PG8_BAR; PG8_WAIT_L(0); PG8_MMA(1, 0, At, B0); PG8_BAR; PG8_SCHED;
            PG8_STAGE(PG8_SB(1, 1), b3 + hstep, voffB);
            PG8_WAIT_V(6); PG8_BAR; PG8_MMA(1, 1, At, B1); PG8_BAR;
            }
        }
        if constexpr (FP8) asm volatile("s_nop 15\n\ts_nop 15" ::: "memory");
        if constexpr (ALIGN_EPI) { if (wr == 0) PG8_BAR; }
        if constexpr (!Epi::AFTER_DRAIN) { E(acc, cur, wr, wc, fr, fq); S.done(cur); }
        if (!has_next) break;
#pragma unroll
        for (int a = 0; a < 2; ++a)
#pragma unroll
            for (int b = 0; b < 2; ++b)
#pragma unroll
                for (int m = 0; m < 4; ++m)
#pragma unroll
                    for (int n = 0; n < 2; ++n) acc[a][b][m][n] = (f32x4){0.f, 0.f, 0.f, 0.f};
        cur = nxt; cA = nA; cB = nB; ++ui;
        if constexpr (ALIGN_EPI) { if (wr == 1) PG8_BAR; }
    }
    PG8_WAIT_V(0);
    if constexpr (!ALIGN_EPI) { if (wr == 0) PG8_BAR; }
    PG8_BAR;
    if constexpr (Epi::AFTER_DRAIN) { E.fused(acc, cur, wr, wc, fr, fq, lds, wid, lane); S.done(cur); }
#undef PG8_SA
#undef PG8_SB
#undef PG8_STAGE
#undef PG8_LDA
#undef PG8_LDB
#undef PG8_MMA
#undef PG8_WAIT_V
#undef PG8_WAIT_L
#undef PG8_BAR
#undef PG8_SCHED
}
}

#ifndef MK_PER_PHASE
#define MK_PER_PHASE 0
#endif
#ifndef PROBE_DOUBLE
#define PROBE_DOUBLE -1
#endif
#define REP(id) for (int rep_ = 0; rep_ < ((PROBE_DOUBLE == (id)) ? 2 : 1); ++rep_)
constexpr int NWAVES = 8, NTHR = 512;
constexpr int BATCH = 2, SEQ = 4096, M = BATCH * SEQ, D = 2048, DEPTH = 4;
constexpr int DI = 4096, NH = 64, HP = 64, NG = 8, HPG = 8, NS = 128, CONVD = 6144;
constexpr int QH = 16, KVH = 4, AD = 128, IH = 16, IDD = 64, TOPK = 256;
constexpr int FF = 4096, FF2 = 8192;
constexpr int NIN = 18576, NMAIN = 18432, NPAD = 18688;
constexpr int PZ = 0, PXBC = 4096, PQ = 10240, PK = 12288, PV = 12800, PG = 13312, PQI = 17408;
constexpr int SMW = 256, SM_DT = 0, SM_KI = 64, SM_WI = 128;
constexpr float EPS = 1e-6f;
constexpr int F8_DN = DEPTH - 2, F8_UP = DEPTH - 2, F8_MIX = DEPTH - 1, F8_OUT = DEPTH - 1, F8_IN = DEPTH - 1;
constexpr float ATTN_SCALE = 0.08838834764831845f;

constexpr size_t MiB = 1u << 20;
constexpr size_t WS_CTL = 0, CTL_ZERO_BYTES = 1 * MiB;
constexpr size_t WS_W = 2 * MiB;
constexpr size_t WL_IN = 0, WL_SSM = 73 * MiB, WL_ATT = 89 * MiB, WL_MIX = 97 * MiB, WL_UP = 105 * MiB, WL_DN = 137 * MiB, WL_SIZE = 153 * MiB;
constexpr size_t WS_H = WS_W + DEPTH * WL_SIZE;
constexpr size_t WS_P = WS_H + 32 * MiB;
constexpr size_t WS_SM = WS_P + 288 * MiB;
constexpr size_t WS_XC = WS_SM + 8 * MiB;
constexpr size_t WS_DT = WS_XC + 96 * MiB;
constexpr size_t WS_ACS = WS_DT + 2 * MiB;
constexpr size_t WS_ST = WS_ACS + 2 * MiB;
constexpr size_t WS_Y = WS_ST + 256 * MiB;
constexpr size_t WS_SC = WS_Y + 64 * MiB;
constexpr size_t WS_IDX = WS_SC + 128 * MiB;
constexpr size_t WS_CNT = WS_IDX + 8 * MiB;
constexpr size_t WS_AO = WS_CNT + 1 * MiB;
constexpr size_t WS_MG = WS_AO + 32 * MiB;
constexpr size_t WS_MGB = WS_MG + 64 * MiB;
constexpr size_t WS_YM = WS_MGB + 32 * MiB;
constexpr size_t WS_U = WS_YM + 64 * MiB;
constexpr size_t WS_ACT = WS_U + 128 * MiB;
constexpr size_t WS_KIB = WS_ACT + 64 * MiB;
constexpr size_t WS_END = WS_KIB + 1 * MiB;
constexpr int CW_BAR = 4096;

constexpr int RING_BYTES = 139264, LDSCTL_OFF = RING_BYTES, MISC_OFF = LDSCTL_OFF + 320, LDS_BYTES = 147456;

#define LAS __attribute__((address_space(3)))
#define GAS __attribute__((address_space(1)))
typedef unsigned short bf16;
typedef float f32x4 __attribute__((ext_vector_type(4)));
typedef short bf16x8 __attribute__((ext_vector_type(8)));
typedef unsigned u32x4 __attribute__((ext_vector_type(4)));
typedef unsigned u32x2 __attribute__((ext_vector_type(2)));
#define LDS_WAIT() asm volatile("s_waitcnt lgkmcnt(0)" ::: "memory")

__device__ __forceinline__ unsigned f2bf(float f) { unsigned u = __builtin_bit_cast(unsigned, f); return (u + 0x7fffu + ((u >> 16) & 1u)) >> 16; }
__device__ __forceinline__ unsigned pk2(float lo, float hi) { return f2bf(lo) | (f2bf(hi) << 16); }
__device__ __forceinline__ unsigned cvtpk(float lo, float hi) { unsigned r; asm("v_cvt_pk_bf16_f32 %0, %1, %2" : "=v"(r) : "v"(lo), "v"(hi)); return r; }
__device__ __forceinline__ u32x2 pack8_fp8(const float (&f)[8]) { int lo = 0, hi = 0; lo = __builtin_amdgcn_cvt_pk_fp8_f32(f[0], f[1], lo, false); lo = __builtin_amdgcn_cvt_pk_fp8_f32(f[2], f[3], lo, true);
    hi = __builtin_amdgcn_cvt_pk_fp8_f32(f[4], f[5], hi, false); hi = __builtin_amdgcn_cvt_pk_fp8_f32(f[6], f[7], hi, true); u32x2 w; w.x = (unsigned)lo; w.y = (unsigned)hi; return w; }
__device__ __forceinline__ unsigned pack4_fp8(float a, float b, float c, float d) { int w = 0; w = __builtin_amdgcn_cvt_pk_fp8_f32(a, b, w, false); w = __builtin_amdgcn_cvt_pk_fp8_f32(c, d, w, true); return (unsigned)w; }
__device__ __forceinline__ float bflo(unsigned w) { return __uint_as_float(w << 16); }
__device__ __forceinline__ float bfhi(unsigned w) { return __uint_as_float(w & 0xffff0000u); }
__device__ __forceinline__ void unpack8(const u32x4 w, float (&f)[8]) { f[0] = bflo(w.x); f[1] = bfhi(w.x); f[2] = bflo(w.y); f[3] = bfhi(w.y); f[4] = bflo(w.z); f[5] = bfhi(w.z); f[6] = bflo(w.w); f[7] = bfhi(w.w); }
__device__ __forceinline__ u32x4 pack8(const float (&f)[8]) { u32x4 w; w.x = pk2(f[0], f[1]); w.y = pk2(f[2], f[3]); w.z = pk2(f[4], f[5]); w.w = pk2(f[6], f[7]); return w; }
__device__ __forceinline__ float wave_sum(float v) {
#pragma unroll
    for (int o = 1; o < 64; o <<= 1) v += __shfl_xor(v, o);
    return v;
}
__device__ __forceinline__ float wave_max(float v) {
#pragma unroll
    for (int o = 1; o < 64; o <<= 1) v = fmaxf(v, __shfl_xor(v, o));
    return v;
}
__device__ __forceinline__ float siluf_(float x) { return x / (1.0f + __expf(-x)); }
typedef short s16x4 __attribute__((ext_vector_type(4)));
__device__ __forceinline__ s16x4 lds_tr4(const LAS unsigned char* p) { return __builtin_bit_cast(s16x4, __builtin_amdgcn_ds_read_tr16_b64_v4i16((LAS s16x4*)p)); }

#define XB_TMO      128
#define XB_XCNT(j)  (256  + 64 * (j))
#define XB_XSUB(j)  (1280 + 64 * (j))
#define XB_XGEN(j)  (2304 + 64 * (j))
#define XB_TOP      3328
#define XB_TOPGEN   3392
#define XCD_BAR_WORDS 3456
#define XB_SPIN_CAP (1u << 18)

__device__ __forceinline__ unsigned xb_ld(unsigned* p)              { return __hip_atomic_load(p, __ATOMIC_RELAXED, __HIP_MEMORY_SCOPE_AGENT); }
__device__ __forceinline__ unsigned xb_add(unsigned* p, unsigned v) { return __hip_atomic_fetch_add(p, v, __ATOMIC_RELAXED, __HIP_MEMORY_SCOPE_AGENT); }
__device__ __forceinline__ unsigned xb_xcc_id() { return (unsigned)__builtin_amdgcn_s_getreg((3 << 11) | 20) & 0xFu; }
#define XB_SPIN(cond, bar) do { unsigned _sp = 0; while (cond) { __builtin_amdgcn_s_sleep(1); \
    if ((++_sp & 255u) == 0u) { if (xb_ld(&(bar)[XB_TMO])) break; if (_sp > XB_SPIN_CAP) { atomicAdd(&(bar)[XB_TMO], 1u); break; } } } } while (0)

struct XcdBarrier {
    unsigned* bar; unsigned x;
    volatile LAS unsigned* st;
};

__device__ __forceinline__ XcdBarrier xcd_barrier_post(unsigned* bar, volatile LAS unsigned* st) {
    XcdBarrier b; b.bar = bar; b.x = xb_xcc_id(); b.st = st;
    if (threadIdx.x == 0) (void)xb_add(&bar[XB_XCNT(b.x)], 1u);
    return b;
}
__device__ __forceinline__ void xcd_barrier_complete(unsigned* bar, unsigned x, unsigned& nloc, unsigned& nx) {
    const unsigned G = gridDim.x * gridDim.y * gridDim.z;
    unsigned sum, cnt, mine, sp = 0u;
    for (;;) {
        sum = 0u; cnt = 0u; mine = 0u;
#pragma unroll
        for (unsigned j = 0; j < 16; ++j) { const unsigned c = xb_ld(&bar[XB_XCNT(j)]); sum += c; cnt += (c > 0u) ? 1u : 0u; mine = (j == x) ? c : mine; }
        if (sum == G) break;
        __builtin_amdgcn_s_sleep(1);
        if ((++sp & 255u) == 0u) { if (xb_ld(&bar[XB_TMO])) break; if (sp > XB_SPIN_CAP) { atomicAdd(&bar[XB_TMO], 1u); break; } }
    }
    nloc = mine > 0u ? mine : 1u; nx = cnt > 0u ? cnt : 1u;
}

__device__ __forceinline__ void xcd_barrier(const XcdBarrier& b) {
    asm volatile("s_waitcnt vmcnt(0)" ::: "memory");
    __syncthreads();
    if (threadIdx.x == 0) {
        unsigned* bar = b.bar;
        __builtin_amdgcn_s_waitcnt(0);
        unsigned nloc = b.st[0], nx = b.st[1];
        if (nloc == 0u) { xcd_barrier_complete(bar, b.x, nloc, nx); b.st[0] = nloc; b.st[1] = nx; }
        const unsigned old = xb_add(&bar[XB_XSUB(b.x)], 1u);
        const unsigned gen = old / nloc;
        if (old + 1u == (gen + 1u) * nloc) {
            __builtin_amdgcn_fence(__ATOMIC_RELEASE, "agent");
            asm volatile("s_waitcnt vmcnt(0)" ::: "memory");
            const unsigned og = xb_add(&bar[XB_TOP], 1u);
            const unsigned tg = og / nx;
            if (og + 1u == (tg + 1u) * nx) xb_add(&bar[XB_TOPGEN], 1u);
            else XB_SPIN(xb_ld(&bar[XB_TOPGEN]) == tg, bar);
            __builtin_amdgcn_fence(__ATOMIC_ACQUIRE, "agent");
            xb_add(&bar[XB_XGEN(b.x)], 1u);
            asm volatile("s_waitcnt vmcnt(0)" ::: "memory");
        } else {
            XB_SPIN(xb_ld(&bar[XB_XGEN(b.x)]) == gen, bar);
            __builtin_amdgcn_fence(__ATOMIC_ACQUIRE, "agent");
            asm volatile("s_waitcnt vmcnt(0)" ::: "memory");
        }
    }
    __syncthreads();
}


template <bool XF32IN, bool HASY, bool XF32OUT, bool HF8 = false>
__device__ __forceinline__ void ph_resid_norm(const GAS bf16* Yb, const GAS float* gpost, const GAS float* gnext, const GAS float* Xf_in, const GAS bf16* Xb_in, GAS float* Xf_out, GAS bf16* Xb_out, GAS bf16* H, GAS unsigned char* H8,
                                              int gw, int ngw, int lane) {
    for (int m = gw; m < M; m += ngw) {
        float xv[4][8];
#pragma unroll
        for (int j = 0; j < 4; ++j) { const size_t e = (size_t)m * D + 8 * (lane + 64 * j);
            if (XF32IN) { const f32x4 a = *(const GAS f32x4*)(Xf_in + e), c = *(const GAS f32x4*)(Xf_in + e + 4); xv[j][0] = a.x; xv[j][1] = a.y; xv[j][2] = a.z; xv[j][3] = a.w; xv[j][4] = c.x; xv[j][5] = c.y; xv[j][6] = c.z; xv[j][7] = c.w; }
            else unpack8(*(const GAS u32x4*)(Xb_in + e), xv[j]); }
        if (HASY) {
            float yv[4][8]; float ss = 0.f;
#pragma unroll
            for (int j = 0; j < 4; ++j) { unpack8(*(const GAS u32x4*)(Yb + (size_t)m * D + 8 * (lane + 64 * j)), yv[j]);
#pragma unroll
                for (int i = 0; i < 8; ++i) ss += yv[j][i] * yv[j][i]; }
            const float rstd = rsqrtf(wave_sum(ss) * (1.0f / D) + EPS);
#pragma unroll
            for (int j = 0; j < 4; ++j) { const GAS float* gp = gpost + 8 * (lane + 64 * j); const f32x4 g0 = *(const GAS f32x4*)gp, g1 = *(const GAS f32x4*)(gp + 4);
                xv[j][0] += yv[j][0] * rstd * g0.x; xv[j][1] += yv[j][1] * rstd * g0.y; xv[j][2] += yv[j][2] * rstd * g0.z; xv[j][3] += yv[j][3] * rstd * g0.w;
                xv[j][4] += yv[j][4] * rstd * g1.x; xv[j][5] += yv[j][5] * rstd * g1.y; xv[j][6] += yv[j][6] * rstd * g1.z; xv[j][7] += yv[j][7] * rstd * g1.w; }
        }
#pragma unroll
        for (int j = 0; j < 4; ++j) { const size_t e = (size_t)m * D + 8 * (lane + 64 * j);
            if (XF32OUT) { *(GAS f32x4*)(Xf_out + e) = (f32x4){xv[j][0], xv[j][1], xv[j][2], xv[j][3]}; *(GAS f32x4*)(Xf_out + e + 4) = (f32x4){xv[j][4], xv[j][5], xv[j][6], xv[j][7]}; }
            else *(GAS u32x4*)(Xb_out + e) = pack8(xv[j]); }
        if (gnext) {
            float ss = 0.f;
#pragma unroll
            for (int j = 0; j < 4; ++j)
#pragma unroll
                for (int i = 0; i < 8; ++i) ss += xv[j][i] * xv[j][i];
            const float rstd = rsqrtf(wave_sum(ss) * (1.0f / D) + EPS);
#pragma unroll
            for (int j = 0; j < 4; ++j) { const GAS float* gp = gnext + 8 * (lane + 64 * j); const f32x4 g0 = *(const GAS f32x4*)gp, g1 = *(const GAS f32x4*)(gp + 4);
                float h[8] = {xv[j][0] * rstd * g0.x, xv[j][1] * rstd * g0.y, xv[j][2] * rstd * g0.z, xv[j][3] * rstd * g0.w, xv[j][4] * rstd * g1.x, xv[j][5] * rstd * g1.y, xv[j][6] * rstd * g1.z, xv[j][7] * rstd * g1.w};
                if (HF8) *(GAS u32x2*)((GAS unsigned char*)H + (size_t)m * D + 8 * (lane + 64 * j)) = pack8_fp8(h);
                else *(GAS u32x4*)(H + (size_t)m * D + 8 * (lane + 64 * j)) = pack8(h);
                if (H8) *(GAS u32x2*)(H8 + (size_t)m * D + 8 * (lane + 64 * j)) = pack8_fp8(h); }
        }
    }
}

__device__ __forceinline__ void tr_item(const GAS float* W, int ldw, int K, int k0, int nsrc, int ncols, GAS bf16* WT, int ndst, LAS unsigned char* tile, int lane) {
    const int c4 = (lane & 15) * 4, kr = lane >> 4;
    f32x4 v[16];
#pragma unroll
    for (int i = 0; i < 16; ++i) v[i] = (c4 < ncols) ? *(const GAS f32x4*)(W + (size_t)(k0 + 4 * i + kr) * ldw + nsrc + c4) : (f32x4){0.f, 0.f, 0.f, 0.f};
#pragma unroll
    for (int i = 0; i < 16; ++i) { u32x2 w; w.x = cvtpk(v[i].x, v[i].y); w.y = cvtpk(v[i].z, v[i].w); *(LAS u32x2*)(tile + (4 * i + kr) * 160 + (lane & 15) * 8) = w; }
    LDS_WAIT();
    const int g = lane >> 4, c16 = lane & 15;
    const LAS unsigned char* tb = tile + (8 * g + (c16 >> 2)) * 160 + (c16 & 3) * 8;
#pragma unroll
    for (int nt = 0; nt < 4; ++nt)
#pragma unroll
        for (int kh = 0; kh < 2; ++kh) {
            const s16x4 lo = lds_tr4(tb + (32 * kh) * 160 + nt * 32), hi = lds_tr4(tb + (32 * kh + 4) * 160 + nt * 32);
            *(GAS bf16x8*)(WT + (size_t)(ndst + 16 * nt + c16) * K + k0 + 32 * kh + 8 * g) = __builtin_shufflevector(lo, hi, 0, 1, 2, 3, 4, 5, 6, 7); }
    LDS_WAIT();
}
__device__ __forceinline__ void tr_item_fp8(const GAS float* W, int ldw, int K, int k0, int nsrc, GAS unsigned char* WT8, int ndst, LAS unsigned char* tile, int lane) {
    const int c4 = (lane & 15) * 4, kr = lane >> 4;
    f32x4 v[16];
#pragma unroll
    for (int i = 0; i < 16; ++i) v[i] = *(const GAS f32x4*)(W + (size_t)(k0 + 4 * i + kr) * ldw + nsrc + c4);
#pragma unroll
    for (int i = 0; i < 16; ++i) { u32x2 w; w.x = cvtpk(v[i].x, v[i].y); w.y = cvtpk(v[i].z, v[i].w); *(LAS u32x2*)(tile + (4 * i + kr) * 160 + (lane & 15) * 8) = w; }
    LDS_WAIT();
    const int g = lane >> 4, c16 = lane & 15;
    const LAS unsigned char* tb = tile + (16 * g + (c16 >> 2)) * 160 + (c16 & 3) * 8;
#pragma unroll
    for (int nt = 0; nt < 4; ++nt) { u32x4 o;
#pragma unroll
        for (int h = 0; h < 2; ++h) { const s16x4 lo = lds_tr4(tb + (8 * h) * 160 + nt * 32), hi = lds_tr4(tb + (8 * h + 4) * 160 + nt * 32);
            float f[8]; unpack8(__builtin_bit_cast(u32x4, __builtin_shufflevector(lo, hi, 0, 1, 2, 3, 4, 5, 6, 7)), f);
#pragma unroll
            for (int j = 0; j < 8; ++j) f[j] *= 64.0f;
            const u32x2 w = pack8_fp8(f); if (h == 0) { o.x = w.x; o.y = w.y; } else { o.z = w.x; o.w = w.y; } }
        *(GAS u32x4*)(WT8 + (size_t)(ndst + 16 * nt + c16) * K + k0 + 16 * g) = o; }
    LDS_WAIT();
}
__device__ __forceinline__ void win_map(int dstrow, int& src, int& ncols) {
    ncols = 64;
    if (dstrow < 10240) src = dstrow;
    else if (dstrow < 12288) src = dstrow - 10240 + 10304;
    else if (dstrow < 12800) src = dstrow - 12288 + 12352;
    else if (dstrow < 13312) src = dstrow - 12800 + 12864;
    else if (dstrow < 17408) src = dstrow - 13312 + 14480;
    else if (dstrow < 18432) src = dstrow - 17408 + 13376;
    else if (dstrow < 18496) src = dstrow - 18432 + 10240;
    else if (dstrow < 18560) src = dstrow - 18496 + 14400;
    else if (dstrow == 18560) { src = 14464; ncols = 16; }
    else { src = 0; ncols = 0; }
}
struct WPtrs { const GAS float *w_in, *w_ssm, *w_att, *w_mix, *w_up, *w_dn; };
__device__ __forceinline__ void ph_weights(const WPtrs wp, GAS unsigned char* ws, LAS unsigned char* tile, int gw, int ngw, int lane) {
    constexpr int I_IN = (NPAD / 64) * (D / 64), I_SSM = (D / 64) * (DI / 64), I_ATT = (D / 64) * (D / 64), I_MIX = I_ATT, I_UP = (FF2 / 64) * (D / 64), I_DN = (D / 64) * (FF / 64);
    constexpr int I_L = I_IN + I_SSM + I_ATT + I_MIX + I_UP + I_DN;
    for (int it = gw; it < DEPTH * I_L; it += ngw) {
        const int layer = it / I_L; int r = it % I_L;
        GAS unsigned char* wl = ws + WS_W + (size_t)layer * WL_SIZE;
        if (r < I_IN) { const int nblk = NPAD / 64, kb = r / nblk, nb = r % nblk; int src, nc; win_map(nb * 64, src, nc);
            if (layer >= F8_IN && nb * 64 < PQI) tr_item_fp8(wp.w_in + (size_t)layer * D * NIN, NIN, D, kb * 64, src, wl + WL_IN, nb * 64, tile, lane);
            else tr_item(wp.w_in + (size_t)layer * D * NIN, NIN, D, kb * 64, src, nc, (GAS bf16*)(wl + WL_IN), nb * 64, tile, lane);
            continue; }
        r -= I_IN;
        if (r < I_SSM) { const int nblk = D / 64, kb = r / nblk, nb = r % nblk; if (layer >= F8_OUT) tr_item_fp8(wp.w_ssm + (size_t)layer * DI * D, D, DI, kb * 64, nb * 64, wl + WL_SSM, nb * 64, tile, lane); else tr_item(wp.w_ssm + (size_t)layer * DI * D, D, DI, kb * 64, nb * 64, 64, (GAS bf16*)(wl + WL_SSM), nb * 64, tile, lane); continue; }
        r -= I_SSM;
        if (r < I_ATT) { const int nblk = D / 64, kb = r / nblk, nb = r % nblk; if (layer >= F8_OUT) tr_item_fp8(wp.w_att + (size_t)layer * D * D, D, D, kb * 64, nb * 64, wl + WL_ATT, nb * 64, tile, lane); else tr_item(wp.w_att + (size_t)layer * D * D, D, D, kb * 64, nb * 64, 64, (GAS bf16*)(wl + WL_ATT), nb * 64, tile, lane); continue; }
        r -= I_ATT;
        if (r < I_MIX) { const int nblk = D / 64, kb = r / nblk, nb = r % nblk; if (layer >= F8_MIX) tr_item_fp8(wp.w_mix + (size_t)layer * D * D, D, D, kb * 64, nb * 64, wl + WL_MIX, nb * 64, tile, lane); else tr_item(wp.w_mix + (size_t)layer * D * D, D, D, kb * 64, nb * 64, 64, (GAS bf16*)(wl + WL_MIX), nb * 64, tile, lane); continue; }
        r -= I_MIX;
        if (r < I_UP) { const int nblk = FF2 / 64, kb = r / nblk, nb = r % nblk;
            if (layer >= F8_UP) tr_item_fp8(wp.w_up + (size_t)layer * D * FF2, FF2, D, kb * 64, nb * 64, wl + WL_UP, nb * 64, tile, lane);
            else tr_item(wp.w_up + (size_t)layer * D * FF2, FF2, D, kb * 64, nb * 64, 64, (GAS bf16*)(wl + WL_UP), nb * 64, tile, lane);
            continue; }
        r -= I_UP;
        { const int nblk = D / 64, kb = r / nblk, nb = r % nblk;
          if (layer >= F8_DN) tr_item_fp8(wp.w_dn + (size_t)layer * FF * D, D, FF, kb * 64, nb * 64, wl + WL_DN, nb * 64, tile, lane);
          else tr_item(wp.w_dn + (size_t)layer * FF * D, D, FF, kb * 64, nb * 64, 64, (GAS bf16*)(wl + WL_DN), nb * 64, tile, lane); }
    }
}

__device__ __forceinline__ void ph_small_proj(const GAS bf16* H, const GAS bf16* Ws, GAS float* SM, GAS bf16* KIB, LAS unsigned char* lds, int blk, int nblk, int tid) {
    constexpr int HS = 4112;
    const int lane = tid & 63, wave = __builtin_amdgcn_readfirstlane(tid >> 6), g = lane >> 4, c16 = lane & 15;
    for (int rb = blk; rb < M / 32; rb += nblk) {
        __syncthreads();
#pragma unroll
        for (int i = 0; i < 16; ++i) { const int id = tid + 512 * i, r = id >> 8, ch = id & 255;
            *(LAS u32x4*)(lds + r * HS + ch * 16) = *(const GAS u32x4*)(H + (size_t)(rb * 32 + r) * D + ch * 8); }
        __syncthreads();
        f32x4 acc[2] = {(f32x4){0.f, 0.f, 0.f, 0.f}, (f32x4){0.f, 0.f, 0.f, 0.f}}, acc9[2] = {(f32x4){0.f, 0.f, 0.f, 0.f}, (f32x4){0.f, 0.f, 0.f, 0.f}};
        const GAS bf16* wrow = Ws + (size_t)(16 * wave + c16) * D + 8 * g;
        const GAS bf16* w9 = Ws + (size_t)(128 + c16) * D + 256 * wave + 8 * g;
        const LAS unsigned char* hb = lds + c16 * HS + g * 16;
#pragma unroll 8
        for (int ks = 0; ks < 64; ++ks) {
            const bf16x8 wf = *(const GAS bf16x8*)(wrow + 32 * ks);
            const bf16x8 h0 = *(const LAS bf16x8*)(hb + ks * 64), h1 = *(const LAS bf16x8*)(hb + 16 * HS + ks * 64);
            acc[0] = __builtin_amdgcn_mfma_f32_16x16x32_bf16(wf, h0, acc[0], 0, 0, 0); acc[1] = __builtin_amdgcn_mfma_f32_16x16x32_bf16(wf, h1, acc[1], 0, 0, 0);
        }
#pragma unroll
        for (int k8 = 0; k8 < 8; ++k8) { const int ks = 8 * wave + k8;
            const bf16x8 wf = *(const GAS bf16x8*)(w9 + 32 * k8);
            const bf16x8 h0 = *(const LAS bf16x8*)(hb + ks * 64), h1 = *(const LAS bf16x8*)(hb + 16 * HS + ks * 64);
            acc9[0] = __builtin_amdgcn_mfma_f32_16x16x32_bf16(wf, h0, acc9[0], 0, 0, 0); acc9[1] = __builtin_amdgcn_mfma_f32_16x16x32_bf16(wf, h1, acc9[1], 0, 0, 0);
        }
#pragma unroll
        for (int rt = 0; rt < 2; ++rt) { const size_t row = (size_t)(rb * 32 + 16 * rt + c16);
            *(GAS f32x4*)(SM + row * SMW + 16 * wave + 4 * g) = acc[rt];
            if (wave >= 4) { u32x2 w; w.x = cvtpk(acc[rt].x, acc[rt].y); w.y = cvtpk(acc[rt].z, acc[rt].w); *(GAS u32x2*)(KIB + row * IDD + 16 * (wave - 4) + 4 * g) = w; } }
        __syncthreads();
        *(LAS f32x4*)(lds + ((wave * 2 + 0) * 64 + lane) * 16) = acc9[0]; *(LAS f32x4*)(lds + ((wave * 2 + 1) * 64 + lane) * 16) = acc9[1];
        __syncthreads();
        if (wave < 2) { f32x4 s = (f32x4){0.f, 0.f, 0.f, 0.f};
#pragma unroll
            for (int w8 = 0; w8 < 8; ++w8) s += *(const LAS f32x4*)(lds + ((w8 * 2 + wave) * 64 + lane) * 16);
            *(GAS f32x4*)(SM + (size_t)(rb * 32 + 16 * wave + c16) * SMW + 128 + 4 * g) = s; }
    }
}

__device__ __forceinline__ void ph_index_scores(const GAS bf16* P, const GAS float* SM, const GAS bf16* KIB, GAS _Float16* SC, LAS unsigned char* lds, int blk, int nblk, int tid) {
    constexpr int QS = 1040;
    const int lane = tid & 63, wave = __builtin_amdgcn_readfirstlane(tid >> 6);
    for (int u0 = blk; u0 < 256; u0 += nblk) {
#pragma unroll 1
        for (int half = 0; half < 2; ++half) {
            const int b = half, qt = half ? 255 - u0 : u0;
            const int q0 = b * SEQ + qt * 16, nkt = ((qt * 16) / 64 + 1) * 4;
            const int qrow = q0 + (lane & 15), kq = 8 * (lane >> 4);
            __syncthreads();
#pragma unroll
            for (int i = 0; i < 2; ++i) { const int id = tid + 512 * i, q = id >> 6, ch = id & 63;
                *(LAS u32x4*)(lds + q * QS + ch * 16) = *(const GAS u32x4*)(P + (size_t)(q0 + q) * NMAIN + PQI + 8 * IDD + ch * 8); }
            bf16x8 bq[8][2]; float w[IH];
#pragma unroll
            for (int h = 0; h < IH; ++h) {
                if (h < 8) {
#pragma unroll
                    for (int ks = 0; ks < 2; ++ks) bq[h][ks] = *(const GAS bf16x8*)(P + (size_t)qrow * NMAIN + PQI + h * IDD + ks * 32 + kq); }
                w[h] = SM[(size_t)qrow * SMW + SM_WI + h]; }
            __syncthreads();
            const LAS unsigned char* qb = lds + (lane & 15) * QS + kq * 2;
            for (int kt = wave; kt < nkt; kt += NWAVES) {
                const int key0 = kt * 16; const GAS bf16* kp = KIB + (size_t)(b * SEQ + key0 + (lane & 15)) * IDD + kq;
                const bf16x8 a0 = *(const GAS bf16x8*)kp, a1 = *(const GAS bf16x8*)(kp + 32);
                f32x4 sc = (f32x4){0.f, 0.f, 0.f, 0.f};
#pragma unroll
                for (int h = 0; h < IH; ++h) { f32x4 c = (f32x4){0.f, 0.f, 0.f, 0.f};
                    const bf16x8 b0 = h < 8 ? bq[h & 7][0] : *(const LAS bf16x8*)(qb + (h - 8) * 128), b1 = h < 8 ? bq[h & 7][1] : *(const LAS bf16x8*)(qb + (h - 8) * 128 + 64);
                    c = __builtin_amdgcn_mfma_f32_16x16x32_bf16(a0, b0, c, 0, 0, 0); c = __builtin_amdgcn_mfma_f32_16x16x32_bf16(a1, b1, c, 0, 0, 0);
                    sc.x += w[h] * fmaxf(c.x, 0.f); sc.y += w[h] * fmaxf(c.y, 0.f); sc.z += w[h] * fmaxf(c.z, 0.f); sc.w += w[h] * fmaxf(c.w, 0.f); }
                { typedef _Float16 h16x4 __attribute__((ext_vector_type(4))); h16x4 hv; hv.x = (_Float16)sc.x; hv.y = (_Float16)sc.y; hv.z = (_Float16)sc.z; hv.w = (_Float16)sc.w;
                  *(GAS h16x4*)(SC + (size_t)qrow * SEQ + key0 + 4 * (lane >> 4)) = hv; }
            }
        }
    }
}

__device__ __forceinline__ void topk_bitwise(const GAS _Float16* srow, GAS unsigned long long* mw, int limit, int lane) {
    unsigned u[64];
#pragma unroll
    for (int j = 0; j < 64; ++j) { const int key = j * 64 + lane; unsigned v = 0u;
        if (key < limit) { const unsigned bits = __float_as_uint((float)srow[key]); v = (bits & 0x80000000u) ? ~bits : (bits | 0x80000000u); }
        u[j] = v; }
    unsigned T = 0u;
#pragma unroll 1
    for (int bit = 31; bit >= 0; --bit) { const unsigned cand = T | (1u << bit); int cnt = 0;
#pragma unroll
        for (int j = 0; j < 64; ++j) cnt += __popcll(__ballot(u[j] >= cand));
        if (cnt >= TOPK) T = cand; }
    int cgt = 0;
#pragma unroll
    for (int j = 0; j < 64; ++j) cgt += __popcll(__ballot(u[j] > T));
    const int need_eq = TOPK - cgt; int eqbase = 0;
    const unsigned long long lt_mask = (1ull << lane) - 1ull;
#pragma unroll
    for (int j = 0; j < 64; ++j) {
        const bool gt = u[j] > T, eq = u[j] == T;
        const unsigned long long eqm = __ballot(eq);
        const bool take = gt || (eq && (eqbase + __popcll(eqm & lt_mask) < need_eq));
        const unsigned long long tm = __ballot(take);
        if (lane == 0 && j * 64 < limit) mw[j] = tm;
        eqbase += __popcll(eqm);
    }
}
__device__ __forceinline__ void ph_topk(const GAS _Float16* SC, GAS unsigned long long* MASKW, LAS unsigned char* wl, int gw, int ngw, int lane) {
    constexpr int CAP = 1024;
    LAS unsigned* hist = (LAS unsigned*)wl;
    LAS unsigned* maskc = (LAS unsigned*)(wl + 1024);
    LAS float* cval = (LAS float*)(wl + 1536);
    LAS unsigned* ckey = (LAS unsigned*)(wl + 1536 + 4 * CAP);
    const unsigned long long lt_mask = (1ull << lane) - 1ull;
    for (int q = gw; q < M; q += ngw) {
        int m = q;
        if (ngw * 4 == M) { const int j = q / ngw; m = (j & 1) * SEQ + ((j & 2) ? SEQ - 1 - gw : gw); }
        const int t = m & (SEQ - 1), limit = (t / 64 + 1) * 64, nw = limit / 64;
        GAS unsigned long long* mw = MASKW + (size_t)m * 64;
        if (limit <= TOPK) { unsigned ones = 0xffffffffu; asm volatile("" : "+v"(ones)); if (lane < nw) mw[lane] = ((unsigned long long)ones << 32) | ones; continue; }
        const GAS _Float16* srow = SC + (size_t)m * SEQ;
        float s[64]; float smax = -__builtin_inff(), smin = __builtin_inff();
#pragma unroll
        for (int j = 0; j < 64; ++j) { s[j] = (j < nw) ? (float)srow[j * 64 + lane] : 0.f; if (j < nw) { smax = fmaxf(smax, s[j]); smin = fminf(smin, s[j]); } }
        smax = wave_max(smax); smin = -wave_max(-smin);
        const float scale = smax > smin ? 255.0f / (smax - smin) : 0.f;
        asm volatile("" ::: "memory");
        hist[lane] = 0u; hist[lane + 64] = 0u; hist[lane + 128] = 0u; hist[lane + 192] = 0u; maskc[lane] = 0u; maskc[lane + 64] = 0u;
        LDS_WAIT();
#pragma unroll
        for (int j = 0; j < 64; ++j) if (j < nw) { const int b = min(255, (int)((s[j] - smin) * scale)); __hip_atomic_fetch_add(&hist[b], 1u, __ATOMIC_RELAXED, __HIP_MEMORY_SCOPE_WORKGROUP); }
        LDS_WAIT();
        const unsigned c0 = hist[4 * lane], c1 = hist[4 * lane + 1], c2 = hist[4 * lane + 2], c3 = hist[4 * lane + 3];
        unsigned suf = c0 + c1 + c2 + c3;
#pragma unroll
        for (int o = 1; o < 64; o <<= 1) { const unsigned v = __shfl_down(suf, o); if (lane + o < 64) suf += v; }
        const unsigned above = suf - (c0 + c1 + c2 + c3);
        int bstar = -1; unsigned cab = 0u;
        { unsigned cum = above;
          if (cum < TOPK && cum + c3 >= TOPK) { bstar = 4 * lane + 3; cab = cum; } cum += c3;
          if (bstar < 0 && cum < TOPK && cum + c2 >= TOPK) { bstar = 4 * lane + 2; cab = cum; } cum += c2;
          if (bstar < 0 && cum < TOPK && cum + c1 >= TOPK) { bstar = 4 * lane + 1; cab = cum; } cum += c1;
          if (bstar < 0 && cum < TOPK && cum + c0 >= TOPK) { bstar = 4 * lane + 0; cab = cum; } }
        const unsigned long long who = __ballot(bstar >= 0);
        const int src = __builtin_ctzll(who);
        bstar = __shfl(bstar, src); cab = __shfl(cab, src);
        const int need = TOPK - (int)cab;
        const unsigned ncand = hist[bstar];
        if (ncand > (unsigned)CAP) { topk_bitwise(srow, mw, limit, lane); continue; }
        unsigned long long myword = 0ull; int base = 0;
#pragma unroll
        for (int j = 0; j < 64; ++j) if (j < nw) {
            const int b = min(255, (int)((s[j] - smin) * scale));
            const unsigned long long gm = __ballot(b > bstar), em = __ballot(b == bstar);
            if (lane == j) myword = gm;
            if (b == bstar) { const int pos = base + __popcll(em & lt_mask); cval[pos] = s[j]; ckey[pos] = (unsigned)(j * 64 + lane); }
            base += __popcll(em);
        }
        LDS_WAIT();
        for (int i = lane; i < base; i += 64) { const float vi = cval[i]; const unsigned ki = ckey[i]; int rank = 0;
            if (need < base) { for (int q = 0; q < base; ++q) { const float vq = cval[q]; const unsigned kq = ckey[q]; rank += (vq > vi || (vq == vi && kq < ki)) ? 1 : 0; } }
            if (rank < need) __hip_atomic_fetch_or(&maskc[ki >> 5], 1u << (ki & 31), __ATOMIC_RELAXED, __HIP_MEMORY_SCOPE_WORKGROUP); }
        LDS_WAIT();
        if (lane < nw) { const unsigned long long cw_ = ((unsigned long long)maskc[2 * lane + 1] << 32) | maskc[2 * lane]; mw[lane] = myword | cw_; }
        LDS_WAIT(); asm volatile("" ::: "memory");
    }
}

__device__ __forceinline__ float xmax16(float x) { auto r = __builtin_amdgcn_permlane16_swap(__float_as_uint(x), __float_as_uint(x), false, false); return fmaxf(__uint_as_float(r[0]), __uint_as_float(r[1])); }
__device__ __forceinline__ float xmax32(float x) { auto r = __builtin_amdgcn_permlane32_swap(__float_as_uint(x), __float_as_uint(x), false, false); return fmaxf(__uint_as_float(r[0]), __uint_as_float(r[1])); }
__device__ __forceinline__ float xsum16(float x) { auto r = __builtin_amdgcn_permlane16_swap(__float_as_uint(x), __float_as_uint(x), false, false); return __uint_as_float(r[0]) + __uint_as_float(r[1]); }
__device__ __forceinline__ float xsum32(float x) { auto r = __builtin_amdgcn_permlane32_swap(__float_as_uint(x), __float_as_uint(x), false, false); return __uint_as_float(r[0]) + __uint_as_float(r[1]); }
template <int VAR> __device__ __forceinline__ void ph_attn_dense(const GAS bf16* P, const GAS unsigned long long* MASKW, GAS bf16* AO, LAS unsigned char* lds, int blk, int nblk, int tid) {
    constexpr int KBUF = 64 * 256, VBUF = 64 * 256, VOFF = 2 * KBUF, MOFF = VOFF + 2 * VBUF;
    const int lane = tid & 63, wave = __builtin_amdgcn_readfirstlane(tid >> 6), g = lane >> 4, c16 = lane & 15;
    const int hq = wave >> 1, qh = (wave & 1) * 32;
    const float SCL = ATTN_SCALE * 1.4426950408889634f;
    for (int u0 = blk; u0 < 256; u0 += nblk) {
#pragma unroll 1
        for (int half = 0; half < 2; ++half) {
            const int b = (u0 >> 2) & 1, kvh = u0 & 3, cc = u0 >> 3, c = half ? 63 - cc : cc, nt = c + 1;
            const int m0 = b * SEQ + c * 64;
            bf16x8 qf[2][4];
#pragma unroll
            for (int qt = 0; qt < 2; ++qt)
#pragma unroll
                for (int kd = 0; kd < 4; ++kd) qf[qt][kd] = *(const GAS bf16x8*)(P + (size_t)(m0 + qh + 16 * qt + c16) * NMAIN + PQ + (kvh * 4 + hq) * AD + 32 * kd + 8 * g);
            f32x4 O[2][8];
#pragma unroll
            for (int qt = 0; qt < 2; ++qt)
#pragma unroll
                for (int dt = 0; dt < 8; ++dt) O[qt][dt] = (f32x4){0.f, 0.f, 0.f, 0.f};
            float mrun[2] = {-1e30f, -1e30f}, lrun[2] = {0.f, 0.f};
            const GAS bf16* kvbase = P + (size_t)(b * SEQ) * NMAIN + kvh * AD;
            const int srow = 8 * wave + (lane >> 4);
#define ATT_DMA(t, buf) do { _Pragma("unroll") for (int i = 0; i < 2; ++i) { const int r = srow + 4 * i; const GAS bf16* src = kvbase + (size_t)((t) * 64 + r) * NMAIN; \
                __builtin_amdgcn_global_load_lds((const GAS unsigned*)(src + PK + (((lane & 15) ^ (r & 15)) << 3)), (LAS unsigned*)(lds + (buf) * KBUF + (2 * wave + i) * 1024), 16, 0, 0); \
                __builtin_amdgcn_global_load_lds((const GAS unsigned*)(src + PV + (((lane & 15) ^ ((r & 7) << 1)) << 3)), (LAS unsigned*)(lds + VOFF + (buf) * VBUF + (2 * wave + i) * 1024), 16, 0, 0); } } while (0)
            __syncthreads();
            ATT_DMA(0, 0);
#pragma unroll
            for (int i = 0; i < 4; ++i) { const int id = tid + 512 * i; *(LAS u32x4*)(lds + MOFF + id * 16) = *(const GAS u32x4*)((const GAS unsigned char*)(MASKW + (size_t)m0 * 64) + id * 16); }
            const LAS unsigned long long* mrow0 = (const LAS unsigned long long*)(lds + MOFF) + (qh + c16) * 64; const LAS unsigned long long* mrow1 = mrow0 + 16 * 64;
            asm volatile("s_waitcnt vmcnt(0)" ::: "memory");
            __syncthreads();
            const int vsw = (4 * (g & 1) + (c16 >> 2)) << 1;
            for (int t = 0; t < nt; ++t) {
                const int buf = t & 1;
                if (t + 1 < nt) ATT_DMA(t + 1, buf ^ 1);
                const LAS unsigned char* kb = lds + buf * KBUF + c16 * 256;
                const LAS unsigned char* vb = lds + VOFF + buf * VBUF + (4 * g + (c16 >> 2)) * 256 + (c16 & 1) * 8;
                f32x4 S[2][4];
                bf16x8 kf[2][4];
#pragma unroll
                for (int kd = 0; kd < 4; ++kd) kf[0][kd] = *(const LAS bf16x8*)(kb + (((4 * kd + g) ^ c16) << 4));
#pragma unroll
                for (int kt = 0; kt < 4; ++kt) {
                    if (kt < 3) {
#pragma unroll
                        for (int kd = 0; kd < 4; ++kd) kf[(kt + 1) & 1][kd] = *(const LAS bf16x8*)(kb + (kt + 1) * 4096 + (((4 * kd + g) ^ c16) << 4)); }
#pragma unroll
                    for (int qt = 0; qt < 2; ++qt) { f32x4 s = (f32x4){0.f, 0.f, 0.f, 0.f};
#pragma unroll
                        for (int kd = 0; kd < 4; ++kd) s = __builtin_amdgcn_mfma_f32_16x16x32_bf16(kf[kt & 1][kd], qf[qt][kd], s, 0, 0, 0);
                        S[qt][kt] = s; }
                }
#define ATT_VRD(dt, ks, hi16) lds_tr4(vb + (32 * (ks) + (hi16)) * 256 + (((2 * (dt) + ((c16 >> 1) & 1)) ^ vsw) << 4))
                s16x4 vlo[8][2], vhi[8][2];
#pragma unroll
                for (int dt = 0; dt < 4; ++dt)
#pragma unroll
                    for (int ks = 0; ks < 2; ++ks) { vlo[dt][ks] = ATT_VRD(dt, ks, 0); vhi[dt][ks] = ATT_VRD(dt, ks, 16); }
                bf16x8 pf[2][2];
#pragma unroll
                for (int qt = 0; qt < 2; ++qt) {
                    const unsigned long long mw = (qt ? mrow1[t] : mrow0[t]) >> (4 * g);
                    const int mlo = (int)(unsigned)mw, mhi = (int)(unsigned)(mw >> 32);
                    float mx = fmaxf(fmaxf(S[qt][0][0], S[qt][0][1]), fmaxf(S[qt][0][2], S[qt][0][3]));
#pragma unroll
                    for (int kt = 1; kt < 4; ++kt) mx = fmaxf(fmaxf(mx, S[qt][kt][0]), fmaxf(fmaxf(S[qt][kt][1], S[qt][kt][2]), S[qt][kt][3]));
                    mx = xmax16(mx); mx = xmax32(mx);
                    const float mnew = fmaxf(mrun[qt], mx * SCL);
                    const float alpha = __builtin_amdgcn_exp2f(mrun[qt] - mnew);
                    float ps = 0.f;
#pragma unroll
                    for (int kt = 0; kt < 4; ++kt)
#pragma unroll
                        for (int j = 0; j < 4; ++j) { const int sel = __builtin_amdgcn_sbfe(kt < 2 ? mlo : mhi, (kt & 1) * 16 + j, 1);
                            const float p = __uint_as_float(__float_as_uint(__builtin_amdgcn_exp2f(__builtin_fmaf(S[qt][kt][j], SCL, -mnew))) & (unsigned)sel); S[qt][kt][j] = p; ps += p; }
                    ps = xsum16(ps); ps = xsum32(ps);
                    lrun[qt] = lrun[qt] * alpha + ps; mrun[qt] = mnew;
                    if (!__all(alpha == 1.0f)) {
#pragma unroll
                        for (int dt = 0; dt < 8; ++dt) O[qt][dt] *= alpha; }
#pragma unroll
                    for (int ks = 0; ks < 2; ++ks) { u32x4 w; w.x = cvtpk(S[qt][2 * ks][0], S[qt][2 * ks][1]); w.y = cvtpk(S[qt][2 * ks][2], S[qt][2 * ks][3]);
                        w.z = cvtpk(S[qt][2 * ks + 1][0], S[qt][2 * ks + 1][1]); w.w = cvtpk(S[qt][2 * ks + 1][2], S[qt][2 * ks + 1][3]); pf[qt][ks] = __builtin_bit_cast(bf16x8, w); }
                }
#pragma unroll
                for (int dt = 4; dt < 8; ++dt)
#pragma unroll
                    for (int ks = 0; ks < 2; ++ks) { vlo[dt][ks] = ATT_VRD(dt, ks, 0); vhi[dt][ks] = ATT_VRD(dt, ks, 16); }
#pragma unroll
                for (int dt = 0; dt < 8; ++dt)
#pragma unroll
                    for (int ks = 0; ks < 2; ++ks) {
                        const bf16x8 vf = __builtin_shufflevector(vlo[dt][ks], vhi[dt][ks], 0, 1, 2, 3, 4, 5, 6, 7);
                        O[0][dt] = __builtin_amdgcn_mfma_f32_16x16x32_bf16(vf, pf[0][ks], O[0][dt], 0, 0, 0);
                        O[1][dt] = __builtin_amdgcn_mfma_f32_16x16x32_bf16(vf, pf[1][ks], O[1][dt], 0, 0, 0);
                    }
                asm volatile("s_waitcnt vmcnt(0)" ::: "memory");
                __syncthreads();
            }
#undef ATT_DMA
#undef ATT_VRD
#pragma unroll
            for (int qt = 0; qt < 2; ++qt) { const float r = 1.0f / lrun[qt];
                const size_t oi = (size_t)(m0 + qh + 16 * qt + c16) * D + (kvh * 4 + hq) * AD + 4 * g;
#pragma unroll
                for (int dt = 0; dt < 8; ++dt) { const f32x4 o = O[qt][dt] * r;
                    if (VAR & 16) *(GAS unsigned*)((GAS unsigned char*)AO + oi + 16 * dt) = pack4_fp8(o.x, o.y, o.z, o.w);
                    else { u32x2 w; w.x = pk2(o.x, o.y); w.y = pk2(o.z, o.w); *(GAS u32x2*)(AO + oi + 16 * dt) = w; } } }
        }
    }
}

__device__ __forceinline__ void stage_conv(const GAS bf16* P, const GAS float* cw, const GAS float* cb, int m0, int tpos0, int ch0, int nch, LAS unsigned char* dst, int stride, int tid) {
    const int cpr = nch >> 3;
    for (int id = tid; id < 64 * cpr; id += NTHR) {
        const int s = id / cpr, k = id - s * cpr, ch = ch0 + 8 * k;
        float acc[8];
        { const f32x4 b0 = *(const GAS f32x4*)(cb + ch), b1 = *(const GAS f32x4*)(cb + ch + 4); acc[0] = b0.x; acc[1] = b0.y; acc[2] = b0.z; acc[3] = b0.w; acc[4] = b1.x; acc[5] = b1.y; acc[6] = b1.z; acc[7] = b1.w; }
#pragma unroll
        for (int i = 0; i < 4; ++i) { if (tpos0 + s - 3 + i >= 0) {
            float x[8]; unpack8(*(const GAS u32x4*)(P + (size_t)(m0 + s - 3 + i) * NMAIN + PXBC + ch), x);
            const f32x4 w0 = *(const GAS f32x4*)(cw + i * CONVD + ch), w1 = *(const GAS f32x4*)(cw + i * CONVD + ch + 4);
            acc[0] += w0.x * x[0]; acc[1] += w0.y * x[1]; acc[2] += w0.z * x[2]; acc[3] += w0.w * x[3]; acc[4] += w1.x * x[4]; acc[5] += w1.y * x[5]; acc[6] += w1.z * x[6]; acc[7] += w1.w * x[7]; } }
#pragma unroll
        for (int j = 0; j < 8; ++j) acc[j] = siluf_(acc[j]);
        *(LAS u32x4*)(dst + s * stride + k * 16) = pack8(acc);
    }
}
__device__ __forceinline__ void wave_dt_acs(const GAS float* SM, const GAS float* dt_bias, const GAS float* a_log, int m0, int head, LAS float* dtw, LAS float* acsw, int lane) {
    const float raw = SM[(size_t)(m0 + lane) * SMW + SM_DT + head] + dt_bias[head];
    const float dt = fmaxf(raw, 0.f) + log1pf(__expf(-fabsf(raw)));
    float x = dt * (-__expf(a_log[head]));
#pragma unroll
    for (int o = 1; o < 64; o <<= 1) { const float v = __shfl_up(x, o); if (lane >= o) x += v; }
    dtw[lane] = dt; acsw[lane] = x;
}
__device__ __forceinline__ bf16x8 tr8(const LAS unsigned char* p, int off_lo, int off_hi) {
    const s16x4 lo = lds_tr4(p + off_lo), hi = lds_tr4(p + off_hi); return __builtin_shufflevector(lo, hi, 0, 1, 2, 3, 4, 5, 6, 7);
}
template <int NOUT> __device__ __forceinline__ void conv_strip(const GAS bf16* src, int tpos_first_raw, const GAS float* cw, const GAS float* cb, u32x4 (&out)[NOUT]) {
    u32x4 raw[NOUT + 3];
#pragma unroll
    for (int i = 0; i < NOUT + 3; ++i) { const int tp = tpos_first_raw + i; raw[i] = *(const GAS u32x4*)(src + (size_t)(tp < 0 ? 3 : i) * NMAIN); if (tp < 0) raw[i] = (u32x4){0u, 0u, 0u, 0u}; }
    f32x4 w[4][2];
#pragma unroll
    for (int t = 0; t < 4; ++t) { w[t][0] = *(const GAS f32x4*)(cw + t * CONVD); w[t][1] = *(const GAS f32x4*)(cw + t * CONVD + 4); }
    const f32x4 b0 = *(const GAS f32x4*)cb, b1 = *(const GAS f32x4*)(cb + 4);
#pragma unroll
    for (int o = 0; o < NOUT; ++o) { f32x4 a0 = b0, a1 = b1;
#pragma unroll
        for (int t = 0; t < 4; ++t) { float x[8]; unpack8(raw[o + t], x); a0 += w[t][0] * (f32x4){x[0], x[1], x[2], x[3]}; a1 += w[t][1] * (f32x4){x[4], x[5], x[6], x[7]}; }
        float f[8] = {a0.x, a0.y, a0.z, a0.w, a1.x, a1.y, a1.z, a1.w};
#pragma unroll
        for (int j = 0; j < 8; ++j) f[j] = f[j] * __builtin_amdgcn_rcpf(1.0f + __expf(-f[j]));
        out[o] = pack8(f); }
}
__device__ __forceinline__ void ph_ssd_states(const GAS bf16* P, const GAS float* SM, const GAS float* cw, const GAS float* cb, const GAS float* dt_bias, const GAS float* a_log, GAS bf16* XC, GAS bf16* ST, GAS float* CD,
                                              LAS unsigned char* lds, int blk, int nblk, int tid) {
    constexpr int RSW = 160, XW = 64 * RSW, RSB = 288, BMB = 64 * RSB, O_BM = 8 * XW, O_DT = O_BM + 2 * BMB, O_ACS = O_DT + 2048;
    const int lane = tid & 63, wave = __builtin_amdgcn_readfirstlane(tid >> 6), gq = lane >> 4, c16 = lane & 15;
    LAS unsigned char* xw = lds + wave * XW;
    LAS float* dtw = (LAS float*)(lds + O_DT) + wave * 64; LAS float* acsw = (LAS float*)(lds + O_ACS) + wave * 64;
    int par = 0;
    for (int item = blk; item < BATCH * 64 * NG; item += nblk, par ^= 1) {
        const int bc = item >> 3, g = item & 7, m0 = bc * 64, tpos0 = (bc & 63) * 64, head = g * HPG + wave;
        LAS unsigned char* bm = lds + O_BM + par * BMB;
        asm volatile("" ::: "memory");
        { const int k16 = lane & 15, r0 = 8 * wave + 2 * gq, chB = DI + g * NS + 8 * k16;
          const GAS bf16* base = P + (size_t)(m0 + r0 - 3) * NMAIN + PXBC + chB;
          u32x4 ob[2], oc[2];
          conv_strip<2>(base, tpos0 + r0 - 3, cw + chB, cb + chB, ob);
          conv_strip<2>(base + NG * NS, tpos0 + r0 - 3, cw + chB + NG * NS, cb + chB + NG * NS, oc);
#pragma unroll
          for (int o = 0; o < 2; ++o) { *(LAS u32x4*)(bm + (r0 + o) * RSB + k16 * 16) = ob[o];
              *(GAS u32x4*)(XC + (size_t)(m0 + r0 + o) * CONVD + chB) = ob[o]; *(GAS u32x4*)(XC + (size_t)(m0 + r0 + o) * CONVD + chB + NG * NS) = oc[o]; } }
        { const int k8 = lane & 7, r0 = 8 * (lane >> 3), ch = head * HP + 8 * k8;
          u32x4 ox[8];
          conv_strip<8>(P + (size_t)(m0 + r0 - 3) * NMAIN + PXBC + ch, tpos0 + r0 - 3, cw + ch, cb + ch, ox);
#pragma unroll
          for (int o = 0; o < 8; ++o) { *(LAS u32x4*)(xw + (r0 + o) * RSW + k8 * 16) = ox[o]; *(GAS u32x4*)(XC + (size_t)(m0 + r0 + o) * CONVD + ch) = ox[o]; } }
        wave_dt_acs(SM, dt_bias, a_log, m0, head, dtw, acsw, lane);
        LDS_WAIT();
        __syncthreads();
        const float aend = acsw[63];
        if (lane == 0) CD[bc * NH + head] = __expf(aend);
        const LAS unsigned char* xb = xw + (4 * gq + (c16 >> 2)) * RSW + (c16 & 3) * 8;
        const LAS unsigned char* bb = bm + (4 * gq + (c16 >> 2)) * RSB + (c16 & 3) * 8;
        bf16x8 xf[4][2];
#pragma unroll
        for (int ks = 0; ks < 2; ++ks) { float w[8];
#pragma unroll
            for (int j = 0; j < 8; ++j) { const int s = 32 * ks + 16 * (j >> 2) + 4 * gq + (j & 3); w[j] = dtw[s] * __expf(aend - acsw[s]); }
#pragma unroll
            for (int pt = 0; pt < 4; ++pt) { const bf16x8 r = tr8(xb + pt * 32, (32 * ks) * RSW, (32 * ks + 16) * RSW); float f[8]; unpack8(__builtin_bit_cast(u32x4, r), f);
#pragma unroll
                for (int j = 0; j < 8; ++j) f[j] *= w[j];
                xf[pt][ks] = __builtin_bit_cast(bf16x8, pack8(f)); } }
        GAS bf16* dst = ST + (((size_t)bc * NH + head) * HP + c16) * NS + 4 * gq;
#pragma unroll 2
        for (int nt = 0; nt < 8; ++nt) {
            const bf16x8 a0 = tr8(bb + nt * 32, 0, 16 * RSB), a1 = tr8(bb + nt * 32, 32 * RSB, 48 * RSB);
#pragma unroll
            for (int pt = 0; pt < 4; ++pt) { f32x4 acc = (f32x4){0.f, 0.f, 0.f, 0.f};
                acc = __builtin_amdgcn_mfma_f32_16x16x32_bf16(a0, xf[pt][0], acc, 0, 0, 0); acc = __builtin_amdgcn_mfma_f32_16x16x32_bf16(a1, xf[pt][1], acc, 0, 0, 0);
                u32x2 o; o.x = pk2(acc.x, acc.y); o.y = pk2(acc.z, acc.w); *(GAS u32x2*)(dst + (size_t)(16 * pt) * NS + 16 * nt) = o; }
        }
        LDS_WAIT(); asm volatile("" ::: "memory");
    }
}
__device__ __forceinline__ void ph_ssd_scan(GAS bf16* ST, const GAS float* CD, int gtid, int nthr) {
    for (int it = gtid; it < BATCH * NH * HP * (NS / 8); it += nthr) {
        const int n8 = it & 15, p = (it >> 4) & 63, head = (it >> 10) & 63, b = it >> 16;
        float h[8];
#pragma unroll
        for (int j = 0; j < 8; ++j) h[j] = 0.f;
#pragma unroll 8
        for (int c = 0; c < 64; ++c) { GAS u32x4* q = (GAS u32x4*)(ST + ((((size_t)(b * 64 + c)) * NH + head) * HP + p) * NS) + n8;
            float v[8]; unpack8(*q, v); *q = pack8(h); const float dec = CD[(b * 64 + c) * NH + head];
#pragma unroll
            for (int j = 0; j < 8; ++j) h[j] = h[j] * dec + v[j]; }
    }
}
template <bool YF8> __device__ __forceinline__ void ph_ssd_out(const GAS bf16* P, const GAS float* SM, const GAS bf16* XC, const GAS float* dt_bias, const GAS float* a_log, const GAS bf16* ST,
                                           const GAS float* dskip, const GAS float* gnorm, GAS bf16* Y, LAS unsigned char* lds, int blk, int nblk, int tid) {
    constexpr int RSW = 160, XW = 64 * RSW, O_DT = 8 * XW, O_ACS = O_DT + 2048, O_SSQ = O_ACS + 2048;
    const int lane = tid & 63, wave = __builtin_amdgcn_readfirstlane(tid >> 6), gq = lane >> 4, c16 = lane & 15;
    LAS unsigned char* xw = lds + wave * XW;
    LAS float* dtw = (LAS float*)(lds + O_DT) + wave * 64; LAS float* acsw = (LAS float*)(lds + O_ACS) + wave * 64;
    int par = 0;
    for (int item = blk; item < BATCH * 64 * NG; item += nblk, par ^= 1) {
        const int bc = item >> 3, g = item & 7, m0 = bc * 64, head = g * HPG + wave;
        asm volatile("" ::: "memory");
        { u32x4 xr[8];
#pragma unroll
          for (int i = 0; i < 8; ++i) xr[i] = *(const GAS u32x4*)(XC + (size_t)(m0 + (lane >> 3) + 8 * i) * CONVD + head * HP + (lane & 7) * 8);
#pragma unroll
          for (int i = 0; i < 8; ++i) *(LAS u32x4*)(xw + ((lane >> 3) + 8 * i) * RSW + (lane & 7) * 16) = xr[i]; }
        wave_dt_acs(SM, dt_bias, a_log, m0, head, dtw, acsw, lane);
        const GAS bf16* cbase = XC + (size_t)(m0 + c16) * CONVD + DI + NG * NS + g * NS + 8 * gq;
        const GAS bf16* bbase = cbase - NG * NS;
        bf16x8 cf[4][4];
#pragma unroll
        for (int lt = 0; lt < 4; ++lt)
#pragma unroll
            for (int kn = 0; kn < 4; ++kn) cf[lt][kn] = *(const GAS bf16x8*)(cbase + (size_t)(16 * lt) * CONVD + 32 * kn);
        LDS_WAIT(); asm volatile("" ::: "memory");
        float al[4];
#pragma unroll
        for (int lt = 0; lt < 4; ++lt) al[lt] = acsw[16 * lt + c16];
        bf16x8 lf[2][4];
#pragma unroll
        for (int ks = 0; ks < 2; ++ks) {
            f32x4 lt4[2][4];
#pragma unroll
            for (int h2 = 0; h2 < 2; ++h2) { const int st = 2 * ks + h2;
                bf16x8 bfr[4];
#pragma unroll
                for (int kn = 0; kn < 4; ++kn) bfr[kn] = *(const GAS bf16x8*)(bbase + (size_t)(16 * st) * CONVD + 32 * kn);
                float as_[4], ds_[4];
#pragma unroll
                for (int j = 0; j < 4; ++j) { as_[j] = acsw[16 * st + 4 * gq + j]; ds_[j] = dtw[16 * st + 4 * gq + j]; }
#pragma unroll
                for (int lt = 0; lt < 4; ++lt) { f32x4 t4 = (f32x4){0.f, 0.f, 0.f, 0.f};
                    if (lt >= st) {
#pragma unroll
                        for (int kn = 0; kn < 4; ++kn) t4 = __builtin_amdgcn_mfma_f32_16x16x32_bf16(bfr[kn], cf[lt][kn], t4, 0, 0, 0);
#pragma unroll
                        for (int j = 0; j < 4; ++j) { const float e = __expf(fminf(al[lt] - as_[j], 0.f)) * ds_[j]; const bool ok = (lt > st) || (4 * gq + j <= c16); t4[j] = ok ? t4[j] * e : 0.f; } }
                    lt4[h2][lt] = t4; } }
#pragma unroll
            for (int lt = 0; lt < 4; ++lt) { u32x4 w; w.x = pk2(lt4[0][lt][0], lt4[0][lt][1]); w.y = pk2(lt4[0][lt][2], lt4[0][lt][3]); w.z = pk2(lt4[1][lt][0], lt4[1][lt][1]); w.w = pk2(lt4[1][lt][2], lt4[1][lt][3]);
                lf[ks][lt] = __builtin_bit_cast(bf16x8, w); }
        }
        f32x4 acc[4][4];
        const GAS bf16* hsrc = ST + (((size_t)bc * NH + head) * HP + c16) * NS + 8 * gq;
#pragma unroll
        for (int pt = 0; pt < 4; ++pt) { bf16x8 hf[4];
#pragma unroll
            for (int kn = 0; kn < 4; ++kn) hf[kn] = *(const GAS bf16x8*)(hsrc + (size_t)(16 * pt) * NS + 32 * kn);
#pragma unroll
            for (int lt = 0; lt < 4; ++lt) { f32x4 t4 = (f32x4){0.f, 0.f, 0.f, 0.f};
#pragma unroll
                for (int kn = 0; kn < 4; ++kn) t4 = __builtin_amdgcn_mfma_f32_16x16x32_bf16(hf[kn], cf[lt][kn], t4, 0, 0, 0);
                acc[pt][lt] = t4 * __expf(al[lt]); }
            asm volatile("" ::: "memory"); }
        const LAS unsigned char* xb = xw + (4 * gq + (c16 >> 2)) * RSW + (c16 & 3) * 8;
#pragma unroll
        for (int pt = 0; pt < 4; ++pt) {
            const bf16x8 x0 = tr8(xb + pt * 32, 0, 16 * RSW), x1 = tr8(xb + pt * 32, 32 * RSW, 48 * RSW);
#pragma unroll
            for (int lt = 0; lt < 4; ++lt) { acc[pt][lt] = __builtin_amdgcn_mfma_f32_16x16x32_bf16(x0, lf[0][lt], acc[pt][lt], 0, 0, 0);
                if (lt >= 2) acc[pt][lt] = __builtin_amdgcn_mfma_f32_16x16x32_bf16(x1, lf[1][lt], acc[pt][lt], 0, 0, 0); } }
        const float dk = dskip[head]; float ssq[4] = {0.f, 0.f, 0.f, 0.f};
#pragma unroll
        for (int lt = 0; lt < 4; ++lt) { const int l = 16 * lt + c16;
#pragma unroll
            for (int pt = 0; pt < 4; ++pt) { const int p0 = 16 * pt + 4 * gq;
                const u32x2 xv = *(const LAS u32x2*)(xw + l * RSW + p0 * 2); const u32x2 zw = *(const GAS u32x2*)(P + (size_t)(m0 + l) * NMAIN + PZ + head * HP + p0);
                const float xs4[4] = {bflo(xv.x), bfhi(xv.x), bflo(xv.y), bfhi(xv.y)}, z4[4] = {bflo(zw.x), bfhi(zw.x), bflo(zw.y), bfhi(zw.y)};
#pragma unroll
                for (int j = 0; j < 4; ++j) { const float y = (acc[pt][lt][j] + dk * xs4[j]) * z4[j] * __builtin_amdgcn_rcpf(1.0f + __expf(-z4[j])); acc[pt][lt][j] = y; ssq[lt] += y * y; } } }
        LAS float* ssqs = (LAS float*)(lds + O_SSQ) + par * 512;
#pragma unroll
        for (int lt = 0; lt < 4; ++lt) { float v = ssq[lt]; v += __shfl_xor(v, 16); v += __shfl_xor(v, 32); if (gq == 0) ssqs[wave * 64 + 16 * lt + c16] = v; }
        LDS_WAIT();
        __syncthreads();
#pragma unroll
        for (int lt = 0; lt < 4; ++lt) { const int l = 16 * lt + c16; float tot = 0.f;
#pragma unroll
            for (int w8 = 0; w8 < 8; ++w8) tot += ssqs[w8 * 64 + l];
            const float rstd = rsqrtf(tot * (1.0f / (HPG * HP)) + EPS);
#pragma unroll
            for (int pt = 0; pt < 4; ++pt) { const int ch = head * HP + 16 * pt + 4 * gq; const f32x4 gn = *(const GAS f32x4*)(gnorm + ch); const f32x4 o = acc[pt][lt] * rstd * gn;
                if (YF8) *(GAS unsigned*)((GAS unsigned char*)Y + (size_t)(m0 + l) * DI + ch) = pack4_fp8(o.x, o.y, o.z, o.w);
                else { u32x2 w; w.x = pk2(o.x, o.y); w.y = pk2(o.z, o.w); *(GAS u32x2*)(Y + (size_t)(m0 + l) * DI + ch) = w; } } }
        LDS_WAIT(); asm volatile("" ::: "memory");
    }
}

__device__ __forceinline__ float gelu_tanhf_(float x) { const float u = 0.7978845608028654f * (x + 0.044715f * x * x * x); return x * __builtin_amdgcn_rcpf(1.0f + __expf(-2.0f * u)); }
template <bool F8> __device__ __forceinline__ void ph_ffn_act(const GAS bf16* U, const GAS float* cw, const GAS float* cb, GAS bf16* ACT, int gtid, int nthr) {
    constexpr int NCG = FF / 8, R = 8;
    for (int it = gtid; it < (M / R) * NCG; it += nthr) {
        const int c0 = (it % NCG) * 8, m0 = (it / NCG) * R, t0 = m0 & (SEQ - 1);
        f32x4 wg[3][2], wv[3][2];
#pragma unroll
        for (int i = 0; i < 3; ++i) { wg[i][0] = *(const GAS f32x4*)(cw + i * FF2 + c0); wg[i][1] = *(const GAS f32x4*)(cw + i * FF2 + c0 + 4); wv[i][0] = *(const GAS f32x4*)(cw + i * FF2 + FF + c0); wv[i][1] = *(const GAS f32x4*)(cw + i * FF2 + FF + c0 + 4); }
        const f32x4 bg0 = *(const GAS f32x4*)(cb + c0), bg1 = *(const GAS f32x4*)(cb + c0 + 4), bv0 = *(const GAS f32x4*)(cb + FF + c0), bv1 = *(const GAS f32x4*)(cb + FF + c0 + 4);
        u32x4 rg[R + 2], rv[R + 2];
#pragma unroll
        for (int i = 0; i < R + 2; ++i) { const bool ok = (t0 + i - 2) >= 0; const GAS bf16* ur = U + (size_t)(m0 + (ok ? i - 2 : 0)) * FF2 + c0;
            rg[i] = *(const GAS u32x4*)ur; rv[i] = *(const GAS u32x4*)(ur + FF); if (!ok) { rg[i] = (u32x4){0u, 0u, 0u, 0u}; rv[i] = (u32x4){0u, 0u, 0u, 0u}; } }
#pragma unroll
        for (int o = 0; o < R; ++o) { f32x4 g0 = bg0, g1 = bg1, v0 = bv0, v1 = bv1;
#pragma unroll
            for (int i = 0; i < 3; ++i) { float xg[8], xv[8]; unpack8(rg[o + i], xg); unpack8(rv[o + i], xv);
                g0 += wg[i][0] * (f32x4){xg[0], xg[1], xg[2], xg[3]}; g1 += wg[i][1] * (f32x4){xg[4], xg[5], xg[6], xg[7]};
                v0 += wv[i][0] * (f32x4){xv[0], xv[1], xv[2], xv[3]}; v1 += wv[i][1] * (f32x4){xv[4], xv[5], xv[6], xv[7]}; }
            float r[8] = {gelu_tanhf_(g0.x) * v0.x, gelu_tanhf_(g0.y) * v0.y, gelu_tanhf_(g0.z) * v0.z, gelu_tanhf_(g0.w) * v0.w, gelu_tanhf_(g1.x) * v1.x, gelu_tanhf_(g1.y) * v1.y, gelu_tanhf_(g1.z) * v1.z, gelu_tanhf_(g1.w) * v1.w};
            if (F8) *(GAS u32x2*)((GAS unsigned char*)ACT + (size_t)(m0 + o) * FF + c0) = pack8_fp8(r);
            else *(GAS u32x4*)(ACT + (size_t)(m0 + o) * FF + c0) = pack8(r); }
    }
}

struct Args { const float* in[20]; float* out; unsigned char* ws; int ph_lo, ph_hi; };
constexpr int NP = 11, NPHASE = 1 + DEPTH * NP;

#define AIN(i) ((const GAS float*)args.in[i])
__global__ void __launch_bounds__(NTHR, 2) fwd(Args args) {
    extern __shared__ __attribute__((aligned(16))) unsigned char lds[];
    const int G = gridDim.x, blk = blockIdx.x;
    volatile LAS unsigned* MISC = (volatile LAS unsigned*)((LAS unsigned char*)lds + MISC_OFF);
    for (int u = threadIdx.x; u < (LDS_BYTES - LDSCTL_OFF) / 4; u += NTHR) ((LAS unsigned*)((LAS unsigned char*)lds + LDSCTL_OFF))[u] = 0u;
    __syncthreads();
    XcdBarrier bar; bar.bar = (unsigned*)(args.ws + WS_CTL) + CW_BAR; bar.x = 0; bar.st = nullptr;
    if (!MK_PER_PHASE) bar = xcd_barrier_post((unsigned*)(args.ws + WS_CTL) + CW_BAR, MISC + 8);
    const int lo = args.ph_lo, hi = args.ph_hi;
#define IN(k) (lo <= (k) && (k) < hi)
#define SEAM(k) do { if (IN(k) && IN((k) + 1)) xcd_barrier(bar); } while (0)
#define PH_BEGIN \
    int tid = threadIdx.x; asm volatile("" : "+v"(tid)); \
    const int lane = tid & 63, wave = __builtin_amdgcn_readfirstlane(tid >> 6); \
    const int gw = blk * NWAVES + wave, ngw = G * NWAVES, gtid = blk * NTHR + tid, nthr = G * NTHR; \
    GAS unsigned char* ws = (GAS unsigned char*)args.ws; asm volatile("" : "+s"(ws)); \
    LAS unsigned char* ring = (LAS unsigned char*)lds; \
    (void)lane; (void)wave; (void)gw; (void)ngw; (void)gtid; (void)nthr; (void)ring; \
    GAS float* X = (GAS float*)args.out; \
    GAS bf16* H = (GAS bf16*)(ws + WS_H); GAS bf16* P = (GAS bf16*)(ws + WS_P); GAS float* SM = (GAS float*)(ws + WS_SM); GAS bf16* XC = (GAS bf16*)(ws + WS_XC); \
    GAS float* CD = (GAS float*)(ws + WS_DT); GAS bf16* STB = (GAS bf16*)(ws + WS_ST); GAS bf16* Y = (GAS bf16*)(ws + WS_Y); \
    GAS _Float16* SC = (GAS _Float16*)(ws + WS_SC); GAS unsigned long long* MASKW = (GAS unsigned long long*)(ws + WS_IDX); GAS bf16* AO = (GAS bf16*)(ws + WS_AO); \
    GAS float* MG = (GAS float*)(ws + WS_MG); GAS unsigned char* H8 = ws + WS_MG + 32 * MiB; GAS bf16* MGB = (GAS bf16*)(ws + WS_MGB); GAS bf16* YMB = (GAS bf16*)(ws + WS_YM); GAS bf16* XB = (GAS bf16*)(ws + WS_YM + 32 * MiB); GAS bf16* U = (GAS bf16*)(ws + WS_U); \
    GAS bf16* ACT = (GAS bf16*)(ws + WS_ACT); GAS bf16* KIB = (GAS bf16*)(ws + WS_KIB); \
    (void)X; (void)H; (void)P; (void)SM; (void)XC; (void)CD; (void)STB; (void)Y; (void)SC; (void)MASKW; (void)AO; (void)MG; (void)H8; (void)MGB; (void)YMB; (void)XB; (void)U; (void)ACT; (void)KIB;

    if (IN(0)) { PH_BEGIN
        WPtrs wp{AIN(5), AIN(13), AIN(14), AIN(15), AIN(16), AIN(19)};
        REP(5) ph_weights(wp, ws, ring + wave * 10240, gw, ngw, lane);
        ph_resid_norm<true, false, false>(nullptr, nullptr, AIN(1), AIN(0), nullptr, nullptr, XB, H, F8_IN == 0 ? H8 : nullptr, gw, ngw, lane);
    }
    SEAM(0);

#pragma unroll 1
    for (int layer = 0; layer < DEPTH; ++layer) {
        const int pb = 1 + layer * NP;
#define WL (ws + WS_W + (size_t)layer * WL_SIZE)
        if (IN(pb + 0)) { PH_BEGIN
            if (layer >= F8_IN) {
                { pg8::Gemm g{(const GAS bf16*)H8, (const GAS bf16*)(WL + WL_IN), M, PQI, D / 2, 0x7f7f7f7f, 0x79797979}; pg8::StaticOrder S; S.init(M, PQI, G, blk);
                  pg8::EpiIn E{P, NMAIN, AIN(6) + (size_t)layer * 2 * D, PG / 256, 0};
                  pg8::gemm_phase<pg8::EpiIn, pg8::StaticOrder, true, true, true>(ring, g, S, E); }
                __syncthreads();
                { pg8::Gemm g{H, (const GAS bf16*)(WL + WL_IN) + (size_t)PQI * D, M, NMAIN - PQI, D}; pg8::StaticOrder S; S.init(M, NMAIN - PQI, G, (blk + G / 2) % G);
                  pg8::EpiIn E{P, NMAIN, AIN(6) + (size_t)layer * 2 * D, PG / 256, PQI / 256};
                  pg8::gemm_phase<pg8::EpiIn, pg8::StaticOrder, true, true>(ring, g, S, E); }
                __syncthreads();
            } else
            { pg8::Gemm g{H, (const GAS bf16*)(WL + WL_IN), M, NMAIN, D}; pg8::StaticOrder S; S.init(M, NMAIN, G, blk);
              pg8::EpiIn E{P, NMAIN, AIN(6) + (size_t)layer * 2 * D, PG / 256, 0};
              REP(1) { pg8::gemm_phase<pg8::EpiIn, pg8::StaticOrder, true, true>(ring, g, S, E); __syncthreads(); } }
            REP(2) { ph_small_proj(H, (const GAS bf16*)(WL + WL_IN) + (size_t)NMAIN * D, SM, KIB, ring, blk, G, tid); __syncthreads(); }
        }
        SEAM(pb + 0);
        if (IN(pb + 1)) { PH_BEGIN
            REP(20) { ph_ssd_states(P, SM, AIN(7) + (size_t)layer * 4 * CONVD, AIN(8) + (size_t)layer * CONVD, AIN(9) + layer * NH, AIN(10) + layer * NH, XC, STB, CD, ring, blk, G, tid); __syncthreads(); }
            REP(21) { ph_index_scores(P, SM, KIB, SC, ring, blk, G, tid); __syncthreads(); } }
        SEAM(pb + 1);
        if (IN(pb + 2)) { PH_BEGIN
            ph_ssd_scan(STB, CD, gtid, nthr); REP(30) ph_topk(SC, MASKW, ring + wave * 9728, gw, ngw, lane);
#if PROBE_DOUBLE == 31
            ph_ssd_scan((GAS bf16*)U, CD, gtid, nthr);
#endif
            }
        SEAM(pb + 2);
        if (IN(pb + 3)) { PH_BEGIN
            if (layer >= F8_OUT) { ph_ssd_out<true>(P, SM, XC, AIN(9) + layer * NH, AIN(10) + layer * NH, STB, AIN(11) + layer * NH, AIN(12) + (size_t)layer * DI, Y, ring, blk, G, tid); __syncthreads();
                ph_attn_dense<16>(P, MASKW, AO, ring, blk, G, tid); __syncthreads(); }
            else { REP(40) { ph_ssd_out<false>(P, SM, XC, AIN(9) + layer * NH, AIN(10) + layer * NH, STB, AIN(11) + layer * NH, AIN(12) + (size_t)layer * DI, Y, ring, blk, G, tid); __syncthreads(); }
                REP(41) { ph_attn_dense<0>(P, MASKW, AO, ring, blk, G, tid); __syncthreads(); } }
            }
        SEAM(pb + 3);
        if (IN(pb + 4)) {
            { PH_BEGIN
              pg8::StaticOrder S; S.init(M, D, G, blk); pg8::EpiGateMul E{MGB, D, P + PG, NMAIN};
              if (layer >= F8_OUT) { pg8::Gemm g{Y, (const GAS bf16*)(WL + WL_SSM), M, D, DI / 2, 0x7f7f7f7f, 0x79797979}; pg8::gemm_phase<pg8::EpiGateMul, pg8::StaticOrder, false, true, true>(ring, g, S, E); }
              else { pg8::Gemm g{Y, (const GAS bf16*)(WL + WL_SSM), M, D, DI}; pg8::gemm_phase<pg8::EpiGateMul, pg8::StaticOrder, false, true>(ring, g, S, E); } }
            __syncthreads();
            { PH_BEGIN
              pg8::StaticOrder S; S.init(M, D, G, blk); pg8::EpiGateAdd E{MGB, D, P + PG + D, NMAIN, layer >= F8_MIX ? (GAS unsigned char*)MG : nullptr};
              if (layer >= F8_OUT) { pg8::Gemm g{AO, (const GAS bf16*)(WL + WL_ATT), M, D, D / 2, 0x7f7f7f7f, 0x79797979}; pg8::gemm_phase<pg8::EpiGateAdd, pg8::StaticOrder, false, true, true>(ring, g, S, E); }
              else { pg8::Gemm g{AO, (const GAS bf16*)(WL + WL_ATT), M, D, D}; pg8::gemm_phase<pg8::EpiGateAdd, pg8::StaticOrder, false, true>(ring, g, S, E); } }
        }
        SEAM(pb + 4);
        if (IN(pb + 5)) { PH_BEGIN
            pg8::StaticOrder S; S.init(M, D, G, blk); pg8::EpiBf16<0> E{YMB, D, nullptr, 0, 0, 1.f};
            if (layer >= F8_MIX) { pg8::Gemm g{(const GAS bf16*)MG, (const GAS bf16*)(WL + WL_MIX), M, D, D / 2, 0x7f7f7f7f, 0x79797979}; pg8::gemm_phase<pg8::EpiBf16<0>, pg8::StaticOrder, false, true, true>(ring, g, S, E); }
            else { pg8::Gemm g{MGB, (const GAS bf16*)(WL + WL_MIX), M, D, D}; REP(60) { pg8::gemm_phase<pg8::EpiBf16<0>, pg8::StaticOrder, false, true>(ring, g, S, E); __syncthreads(); } } }
        SEAM(pb + 5);
        if (IN(pb + 6)) { PH_BEGIN
            if (layer >= F8_UP) ph_resid_norm<false, true, false, true>(YMB, AIN(2) + (size_t)layer * D, AIN(3) + (size_t)layer * D, nullptr, XB, nullptr, XB, H, nullptr, gw, ngw, lane);
            else ph_resid_norm<false, true, false>(YMB, AIN(2) + (size_t)layer * D, AIN(3) + (size_t)layer * D, nullptr, XB, nullptr, XB, H, nullptr, gw, ngw, lane); }
        SEAM(pb + 6);
        if (IN(pb + 7)) { PH_BEGIN
            pg8::StaticOrder S; S.init(M, FF2, G, blk); pg8::EpiBf16<0> E{U, FF2, nullptr, 0, 0, 1.f};
            if (layer >= F8_UP) { pg8::Gemm g{H, (const GAS bf16*)(WL + WL_UP), M, FF2, D / 2, 0x7f7f7f7f, 0x79797979}; pg8::gemm_phase<pg8::EpiBf16<0>, pg8::StaticOrder, true, true, true>(ring, g, S, E); }
            else { pg8::Gemm g{H, (const GAS bf16*)(WL + WL_UP), M, FF2, D}; REP(80) { pg8::gemm_phase<pg8::EpiBf16<0>, pg8::StaticOrder, true, true>(ring, g, S, E); __syncthreads(); } } }
        SEAM(pb + 7);
        if (IN(pb + 8)) { PH_BEGIN
            if (layer >= F8_DN) ph_ffn_act<true>(U, AIN(17) + (size_t)layer * 3 * FF2, AIN(18) + (size_t)layer * FF2, ACT, gtid, nthr);
            else REP(90) ph_ffn_act<false>(U, AIN(17) + (size_t)layer * 3 * FF2, AIN(18) + (size_t)layer * FF2, ACT, gtid, nthr); }
        SEAM(pb + 8);
        if (IN(pb + 9)) { PH_BEGIN
            pg8::StaticOrder S; S.init(M, D, G, blk); pg8::EpiBf16<0> E{YMB, D, nullptr, 0, 0, 1.f};
            if (layer >= F8_DN) { pg8::Gemm g{ACT, (const GAS bf16*)(WL + WL_DN), M, D, FF / 2, 0x7f7f7f7f, 0x79797979}; pg8::gemm_phase<pg8::EpiBf16<0>, pg8::StaticOrder, false, true, true>(ring, g, S, E); }
            else { pg8::Gemm g{ACT, (const GAS bf16*)(WL + WL_DN), M, D, FF}; REP(100) { pg8::gemm_phase<pg8::EpiBf16<0>, pg8::StaticOrder, false, true>(ring, g, S, E); __syncthreads(); } } }
        SEAM(pb + 9);
        if (IN(pb + 10)) { PH_BEGIN
            if (layer + 1 < DEPTH) ph_resid_norm<false, true, false>(YMB, AIN(4) + (size_t)layer * D, AIN(1) + (size_t)(layer + 1) * D, nullptr, XB, nullptr, XB, H, layer + 1 >= F8_IN ? H8 : nullptr, gw, ngw, lane);
            else ph_resid_norm<false, true, true>(YMB, AIN(4) + (size_t)layer * D, nullptr, nullptr, XB, X, nullptr, H, nullptr, gw, ngw, lane); }
        SEAM(pb + 10);
    }
#undef IN
#undef SEAM
#undef WL
#undef PH_BEGIN
}

extern "C" void kernel_launch(void* const* d_in, const int* in_sizes, int n_in, void* d_out, int out_size, void* d_ws, size_t ws_size, hipStream_t stream) {
    static int grid = 0;
    if (grid == 0) {
        if (n_in != 20 || in_sizes[0] != M * D || out_size != M * D || ws_size < WS_END) { fprintf(stderr, "kernel_launch: unexpected shapes (n_in %d, in0 %d, out %d, ws %zu < %zu)\n", n_in, n_in > 0 ? in_sizes[0] : -1, out_size, ws_size, (size_t)WS_END); grid = -1; return; }
        int dev = 0, cus = 0, per_cu = 0;
        if (hipGetDevice(&dev) != hipSuccess || hipDeviceGetAttribute(&cus, hipDeviceAttributeMultiprocessorCount, dev) != hipSuccess) { grid = -1; return; }
        if (hipFuncSetAttribute((const void*)fwd, hipFuncAttributeMaxDynamicSharedMemorySize, LDS_BYTES) != hipSuccess) { fprintf(stderr, "kernel_launch: hipFuncSetAttribute failed\n"); grid = -1; return; }
        if (hipOccupancyMaxActiveBlocksPerMultiprocessor(&per_cu, (const void*)fwd, NTHR, LDS_BYTES) != hipSuccess || per_cu < 1) fprintf(stderr, "kernel_launch: occupancy query reports %d blocks per CU\n", per_cu);
        (void)hipGetLastError();
        grid = cus;
    }
    if (grid < 0) return;
    if (hipMemsetAsync((char*)d_ws + WS_CTL, 0, CTL_ZERO_BYTES, stream) != hipSuccess) return;
    Args a{};
    for (int i = 0; i < 20; ++i) a.in[i] = (const float*)d_in[i];
    a.out = (float*)d_out; a.ws = (unsigned char*)d_ws;
#if MK_PER_PHASE
    for (int ph = 0; ph < NPHASE; ++ph) { a.ph_lo = ph; a.ph_hi = ph + 1; hipLaunchKernelGGL(fwd, dim3(grid), dim3(NTHR), LDS_BYTES, stream, a); }
#else
    a.ph_lo = 0; a.ph_hi = NPHASE; hipLaunchKernelGGL(fwd, dim3(grid), dim3(NTHR), LDS_BYTES, stream, a);
#endif
}
```
